# Optimizing an MI355X kernel written in HIP

```python
import math
import jax
import jax.numpy as jnp
from jax import lax
import numpy as np

D_MODEL = 1024
BATCH = 16
SEQ = 2048
DEPTH = 2

HEAD_DIM = 64
N_SLOTS = D_MODEL // HEAD_DIM
A_HEADS = 8
A_LATENT = 128
IDX_HEADS = 8
IDX_DIM = 64
A_TOPK_MAX = 256
B_HEADS = 8
B_KV_HEADS = 2
B_WINDOW = 128
C_HEADS = 16
C_KV_HEADS = 2
CMP_BLOCK = 32
CMP_STRIDE = 16
CMP_HIDDEN = 128
SLC_BLOCK = 64
SLC_COUNT = 8
C_WINDOW = 512
MEM_LEN = 256
X_HEADS = 4
X_HEAD_DIM = 128
D_FF = 2816
N_EXPERTS = 8
TOP_K = 2
D_FF_EXPERT = 3584
REL_BUCKETS = 32
REL_MAX_DIST = 128
Q_BLOCK = 128
SLC_Q_BLOCK = 32
LN_EPS = 1e-5
NEG_INF = -1e30
FORCE_BONUS = 1e6
ALPHA = (2 * DEPTH) ** 0.25
BETA = (8 * DEPTH) ** -0.25
N_EVEN = (DEPTH + 1) // 2
N_ODD = DEPTH // 2
EVEN_WIDTHS = (A_HEADS * HEAD_DIM, A_LATENT, IDX_HEADS * IDX_DIM, IDX_DIM, IDX_HEADS,
               B_HEADS * HEAD_DIM, B_KV_HEADS * HEAD_DIM, B_KV_HEADS * HEAD_DIM)
EVEN_COLS = sum(EVEN_WIDTHS)
ODD_WIDTHS = (C_HEADS * HEAD_DIM,) + (C_KV_HEADS * HEAD_DIM,) * 6 + (3 * C_HEADS,)
ODD_COLS = sum(ODD_WIDTHS)

kernel_name = "hybrid_dsa_swa_nsa_moe_deepnorm"


def split_cols(a, widths):
    cuts = [int(c) for c in np.cumsum(widths)[:-1]]
    return jnp.split(a, cuts, axis=-1)


def layer_norm(x, g, b):
    xf = x.astype(jnp.float32)
    mu = jnp.mean(xf, -1, keepdims=True)
    var = jnp.mean(jnp.square(xf - mu), -1, keepdims=True)
    return ((xf - mu) * lax.rsqrt(var + LN_EPS)).astype(x.dtype) * g + b


def rms_norm(x, g):
    xf = x.astype(jnp.float32)
    y = xf * lax.rsqrt(jnp.mean(jnp.square(xf), -1, keepdims=True) + LN_EPS)
    return y.astype(x.dtype) * g


def rel_bucket(dist):
    n = jnp.maximum(dist, 0)
    max_exact = REL_BUCKETS // 2
    nf = jnp.maximum(n, 1).astype(jnp.float32)
    log_b = max_exact + (jnp.log(nf / max_exact) / math.log(REL_MAX_DIST / max_exact)
                         * (REL_BUCKETS - max_exact)).astype(jnp.int32)
    return jnp.where(n < max_exact, n, jnp.minimum(log_b, REL_BUCKETS - 1))


def banded_attention(q, k, v, rel_tbl, window, sinks=None):
    B, S, H, D = q.shape
    kvh = k.shape[2]
    g = H // kvh
    pad = -(-window // Q_BLOCK) * Q_BLOCK
    span = pad + Q_BLOCK
    kp = jnp.pad(k, ((0, 0), (pad, 0), (0, 0), (0, 0)))
    vp = jnp.pad(v, ((0, 0), (pad, 0), (0, 0), (0, 0)))
    dist = np.arange(Q_BLOCK)[:, None] + pad - np.arange(span)[None, :]
    band = jnp.asarray((dist >= 0) & (dist < window))
    bias = rel_tbl.astype(jnp.float32)[rel_bucket(jnp.asarray(dist))]
    bias = bias.transpose(2, 0, 1).reshape(kvh, g, Q_BLOCK, span)
    key_off = jnp.arange(span) - pad

    def block(n):
        t0 = n * Q_BLOCK
        qb = lax.dynamic_slice_in_dim(q, t0, Q_BLOCK, 1).reshape(B, Q_BLOCK, kvh, g, D)
        kb = lax.dynamic_slice_in_dim(kp, t0, span, 1)
        vb = lax.dynamic_slice_in_dim(vp, t0, span, 1)
        logits = jnp.einsum('bqkgd,bskd->bkgqs', qb, kb).astype(jnp.float32) * D ** -0.5 + bias
        ok = band & (t0 + key_off >= 0)[None, :]
        logits = jnp.where(ok, logits, NEG_INF)
        if sinks is None:
            p = jax.nn.softmax(logits, axis=-1)
        else:
            s = sinks.astype(jnp.float32).reshape(kvh, g, 1, 1)
            m = jnp.maximum(jnp.max(logits, -1, keepdims=True), s)
            e = jnp.exp(logits - m)
            p = e / (jnp.sum(e, -1, keepdims=True) + jnp.exp(s - m))
        o = jnp.einsum('bkgqs,bskd->bqkgd', p.astype(v.dtype), vb)
        return o.reshape(B, Q_BLOCK, H, D)

    out = lax.map(block, jnp.arange(S // Q_BLOCK))
    return jnp.moveaxis(out, 0, 1).reshape(B, S, H, D)


def dsa_attention(q_a, c_kv, q_i, k_i, w_i, ckv_gain, w_uk, w_uv, rel_tbl):
    B, S, _ = q_a.shape
    topk = min(A_TOPK_MAX, S // 4)
    q_lat = jnp.einsum('bshd,hdc->bshc', q_a.reshape(B, S, A_HEADS, HEAD_DIM), w_uk)
    c = rms_norm(c_kv, ckv_gain)
    qi = q_i.reshape(B, S, IDX_HEADS, IDX_DIM)
    wi = w_i * IDX_HEADS ** -0.5
    tbl = rel_tbl.astype(jnp.float32)
    kpos = jnp.arange(S)

    def block(n):
        t0 = n * Q_BLOCK
        qpos = t0 + jnp.arange(Q_BLOCK)
        qi_b = lax.dynamic_slice_in_dim(qi, t0, Q_BLOCK, 1)
        wi_b = lax.dynamic_slice_in_dim(wi, t0, Q_BLOCK, 1)
        ql_b = lax.dynamic_slice_in_dim(q_lat, t0, Q_BLOCK, 1)
        act = jax.nn.relu(jnp.einsum('bqhd,bsd->bqhs', qi_b, k_i) * IDX_DIM ** -0.5)
        score = jnp.einsum('bqh,bqhs->bqs', wi_b, act).astype(jnp.float32)
        score = jnp.where(kpos[None, :] <= qpos[:, None], score, NEG_INF)
        _, sel = lax.top_k(score, topk)
        c_sel = jax.vmap(lambda cb, sb: cb[sb])(c, sel)
        dist = qpos[None, :, None] - sel
        bias = tbl[rel_bucket(dist)].transpose(0, 1, 3, 2)
        lg = jnp.einsum('bqhc,bqkc->bqhk', ql_b, c_sel).astype(jnp.float32) * HEAD_DIM ** -0.5 + bias
        lg = jnp.where((dist >= 0)[:, :, None, :], lg, NEG_INF)
        p = jax.nn.softmax(lg, axis=-1).astype(c.dtype)
        o_lat = jnp.einsum('bqhk,bqkc->bqhc', p, c_sel)
        return jnp.einsum('bqhc,hcd->bqhd', o_lat, w_uv)

    out = lax.map(block, jnp.arange(S // Q_BLOCK))
    return jnp.moveaxis(out, 0, 1).reshape(B, S, A_HEADS, HEAD_DIM)


def compress_blocks(kv, pe, w1, w2):
    B, S, G, D = kv.shape
    n_cmp = (S - CMP_BLOCK) // CMP_STRIDE + 1
    idx = np.arange(n_cmp)[:, None] * CMP_STRIDE + np.arange(CMP_BLOCK)[None, :]
    blk = kv[:, idx] + pe[None, None, :, None, :]
    blk = blk.transpose(0, 1, 3, 2, 4).reshape(B, n_cmp, G, CMP_BLOCK * D)
    return jax.nn.gelu(blk @ w1) @ w2


def nsa_attention(q, k_cmp, v_cmp, k_slc, v_slc, k_win, v_win, gate_logits,
                  pe_k, w1_k, w2_k, pe_v, w1_v, w2_v, rel_tbl):
    B, S, H, D = q.shape
    G = C_KV_HEADS
    hpg = H // G
    qg = q.reshape(B, S, G, hpg, D)
    scale = D ** -0.5
    tbl = rel_tbl.astype(jnp.float32)
    pos = np.arange(S)

    n_cmp = (S - CMP_BLOCK) // CMP_STRIDE + 1
    kc = compress_blocks(k_cmp, pe_k, w1_k, w2_k)
    vc = compress_blocks(v_cmp, pe_v, w1_v, w2_v)
    cmp_end = np.arange(n_cmp) * CMP_STRIDE + CMP_BLOCK - 1
    dist_c = pos[:, None] - cmp_end[None, :]
    valid_c = jnp.asarray(dist_c >= 0)
    bias_c = tbl[rel_bucket(jnp.asarray(dist_c))].transpose(2, 0, 1).reshape(G, hpg, S, n_cmp)
    lg = jnp.einsum('bsghd,bngd->bghsn', qg, kc).astype(jnp.float32) * scale + bias_c
    p_cmp = jax.nn.softmax(jnp.where(valid_c, lg, NEG_INF), axis=-1) * valid_c
    o_cmp = jnp.einsum('bghsn,bngd->bsghd', p_cmp.astype(vc.dtype), vc).reshape(B, S, H, D)

    n_slc = S // SLC_BLOCK
    n_sel = min(SLC_COUNT, n_slc)
    cs = np.arange(n_cmp)[:, None] * CMP_STRIDE
    ss = np.arange(n_slc)[None, :] * SLC_BLOCK
    overlap = jnp.asarray(((cs < ss + SLC_BLOCK) & (cs + CMP_BLOCK > ss)).astype(np.float32))
    p_slc = jnp.einsum('bghsn,nj->bgsj', p_cmp, overlap)
    blk = pos // SLC_BLOCK
    jj = np.arange(n_slc)
    forced = (jj[None, :] == 0) | (jj[None, :] == blk[:, None]) | (jj[None, :] == blk[:, None] - 1)
    admissible = jj[None, :] * SLC_BLOCK <= pos[:, None]
    score = jnp.where(jnp.asarray(admissible),
                      p_slc + FORCE_BONUS * jnp.asarray(forced.astype(np.float32)), NEG_INF)
    _, sel = lax.top_k(score, n_sel)

    kb = k_slc.reshape(B, n_slc, SLC_BLOCK, G, D).transpose(0, 3, 1, 2, 4)
    vb = v_slc.reshape(B, n_slc, SLC_BLOCK, G, D).transpose(0, 3, 1, 2, 4)
    bi = jnp.arange(B)[:, None, None, None]
    gi = jnp.arange(G)[None, :, None, None]
    tbl_g = tbl.reshape(REL_BUCKETS, G, hpg).transpose(1, 0, 2)
    in_blk = jnp.arange(SLC_BLOCK)
    n_keys = n_sel * SLC_BLOCK

    def slc_block(n):
        t0 = n * SLC_Q_BLOCK
        qpos = t0 + jnp.arange(SLC_Q_BLOCK)
        qb = lax.dynamic_slice_in_dim(qg, t0, SLC_Q_BLOCK, 1)
        sb = lax.dynamic_slice_in_dim(sel, t0, SLC_Q_BLOCK, 2)
        ks = kb[bi, gi, sb].reshape(B, G, SLC_Q_BLOCK, n_keys, D)
        vs = vb[bi, gi, sb].reshape(B, G, SLC_Q_BLOCK, n_keys, D)
        kpos = (sb[..., None] * SLC_BLOCK + in_blk).reshape(B, G, SLC_Q_BLOCK, n_keys)
        dist = qpos[None, None, :, None] - kpos
        bias = tbl_g[gi, rel_bucket(dist)].transpose(0, 1, 4, 2, 3)
        lg2 = jnp.einsum('bqghd,bgqsd->bghqs', qb, ks).astype(jnp.float32) * scale + bias
        lg2 = jnp.where((dist >= 0)[:, :, None], lg2, NEG_INF)
        p = jax.nn.softmax(lg2, axis=-1).astype(vs.dtype)
        o = jnp.einsum('bghqs,bgqsd->bqghd', p, vs)
        return o.reshape(B, SLC_Q_BLOCK, H, D)

    o_slc = lax.map(slc_block, jnp.arange(S // SLC_Q_BLOCK))
    o_slc = jnp.moveaxis(o_slc, 0, 1).reshape(B, S, H, D)

    o_win = banded_attention(q, k_win, v_win, rel_tbl, C_WINDOW)

    gt = jax.nn.sigmoid(gate_logits).reshape(B, S, H, 3)
    return gt[..., 0:1] * o_cmp + gt[..., 1:2] * o_slc + gt[..., 2:3] * o_win


def even_mixer(x, w_in, ckv_gain, w_uk, w_uv, sinks, w_out, rel_table):
    B, S, _ = x.shape
    q_a, c_kv, q_i, k_i, w_i, q_b, k_b, v_b = split_cols(x @ w_in, EVEN_WIDTHS)
    o_a = dsa_attention(q_a, c_kv, q_i, k_i, w_i, ckv_gain, w_uk, w_uv, rel_table[:, :A_HEADS])
    o_b = banded_attention(q_b.reshape(B, S, B_HEADS, HEAD_DIM),
                           k_b.reshape(B, S, B_KV_HEADS, HEAD_DIM),
                           v_b.reshape(B, S, B_KV_HEADS, HEAD_DIM),
                           rel_table[:, A_HEADS:A_HEADS + B_HEADS], B_WINDOW, sinks)
    o = jnp.concatenate([o_a.reshape(B, S, -1), o_b.reshape(B, S, -1)], axis=-1)
    return o @ w_out


def odd_mixer(x, w_in, pe_k, w1_k, w2_k, pe_v, w1_v, w2_v, w_out, rel_table):
    B, S, _ = x.shape
    q, kc, vc, ks, vs, kw, vw, gl = split_cols(x @ w_in, ODD_WIDTHS)
    r = lambda a, h: a.reshape(B, S, h, HEAD_DIM)
    o = nsa_attention(r(q, C_HEADS), r(kc, C_KV_HEADS), r(vc, C_KV_HEADS), r(ks, C_KV_HEADS),
                      r(vs, C_KV_HEADS), r(kw, C_KV_HEADS), r(vw, C_KV_HEADS), gl,
                      pe_k, w1_k, w2_k, pe_v, w1_v, w2_v, rel_table[:, :C_HEADS])
    return o.reshape(B, S, C_HEADS * HEAD_DIM) @ w_out


def cross_attention(x, mem, w_q, w_k, w_v, w_o):
    B, S, _ = x.shape
    M = mem.shape[1]
    q = (x @ w_q).reshape(B, S, X_HEADS, X_HEAD_DIM)
    k = (mem @ w_k).reshape(B, M, X_HEADS, X_HEAD_DIM)
    v = (mem @ w_v).reshape(B, M, X_HEADS, X_HEAD_DIM)
    lg = jnp.einsum('bshd,bmhd->bhsm', q, k).astype(jnp.float32) * X_HEAD_DIM ** -0.5
    p = jax.nn.softmax(lg, axis=-1).astype(v.dtype)
    o = jnp.einsum('bhsm,bmhd->bshd', p, v).reshape(B, S, X_HEADS * X_HEAD_DIM)
    return o @ w_o


def dense_swiglu(x, w_gate, w_up, w_down):
    return (jax.nn.silu(x @ w_gate) * (x @ w_up)) @ w_down


def moe_swiglu(x, w_router, w_gate, w_up, w_down):
    logits = (x @ w_router).astype(jnp.float32)
    top_val, top_idx = lax.top_k(logits, TOP_K)
    top_w = jax.nn.softmax(top_val, axis=-1)
    gate = jnp.einsum('bsk,bske->bse', top_w,
                      jax.nn.one_hot(top_idx, N_EXPERTS, dtype=jnp.float32)).astype(x.dtype)
    y = jnp.zeros_like(x)
    for e in range(N_EXPERTS):
        h = jax.nn.silu(x @ w_gate[e]) * (x @ w_up[e])
        y = y + gate[..., e:e + 1] * (h @ w_down[e])
    return y


def setup_inputs(seed: int = 0) -> dict:
    key = jax.random.key(seed)
    ks = iter(jax.random.split(key, 32))

    def nrm(shape, scale):
        return jax.random.normal(next(ks), shape, jnp.float32) * scale

    D = D_MODEL
    XW = X_HEADS * X_HEAD_DIM
    CW = CMP_BLOCK * HEAD_DIM
    return {
        'x': nrm((BATCH, SEQ, D), 1.0),
        'mem': nrm((BATCH, MEM_LEN, D), 1.0),
        'rel_table': nrm((REL_BUCKETS, N_SLOTS), 0.2),
        'ev_w_in': nrm((N_EVEN, D, EVEN_COLS), D ** -0.5),
        'ev_ckv_gain': 1.0 + nrm((N_EVEN, A_LATENT), 0.02),
        'ev_w_uk': nrm((N_EVEN, A_HEADS, HEAD_DIM, A_LATENT), HEAD_DIM ** -0.5),
        'ev_w_uv': nrm((N_EVEN, A_HEADS, A_LATENT, HEAD_DIM), A_LATENT ** -0.5),
        'ev_sinks': nrm((N_EVEN, B_HEADS), 0.5),
        'ev_w_out': nrm((N_EVEN, N_SLOTS * HEAD_DIM, D), BETA * (N_SLOTS * HEAD_DIM) ** -0.5),
        'od_w_in': nrm((N_ODD, D, ODD_COLS), D ** -0.5),
        'od_pe_k': nrm((N_ODD, CMP_BLOCK, HEAD_DIM), 0.1),
        'od_w1_k': nrm((N_ODD, CW, CMP_HIDDEN), CW ** -0.5),
        'od_w2_k': nrm((N_ODD, CMP_HIDDEN, HEAD_DIM), CMP_HIDDEN ** -0.5),
        'od_pe_v': nrm((N_ODD, CMP_BLOCK, HEAD_DIM), 0.1),
        'od_w1_v': nrm((N_ODD, CW, CMP_HIDDEN), CW ** -0.5),
        'od_w2_v': nrm((N_ODD, CMP_HIDDEN, HEAD_DIM), CMP_HIDDEN ** -0.5),
        'od_w_out': nrm((N_ODD, C_HEADS * HEAD_DIM, D), BETA * (C_HEADS * HEAD_DIM) ** -0.5),
        'xa_w_q': nrm((DEPTH, D, XW), D ** -0.5),
        'xa_w_k': nrm((DEPTH, D, XW), D ** -0.5),
        'xa_w_v': nrm((DEPTH, D, XW), D ** -0.5),
        'xa_w_o': nrm((DEPTH, XW, D), BETA * XW ** -0.5),
        'ff_w_gate': nrm((N_EVEN, D, D_FF), D ** -0.5),
        'ff_w_up': nrm((N_EVEN, D, D_FF), D ** -0.5),
        'ff_w_down': nrm((N_EVEN, D_FF, D), BETA * D_FF ** -0.5),
        'moe_w_router': nrm((N_ODD, D, N_EXPERTS), D ** -0.5),
        'moe_w_gate': nrm((N_ODD, N_EXPERTS, D, D_FF_EXPERT), D ** -0.5),
        'moe_w_up': nrm((N_ODD, N_EXPERTS, D, D_FF_EXPERT), D ** -0.5),
        'moe_w_down': nrm((N_ODD, N_EXPERTS, D_FF_EXPERT, D), BETA * D_FF_EXPERT ** -0.5),
        'ln_g': 1.0 + nrm((DEPTH, 3, D), 0.02),
        'ln_b': nrm((DEPTH, 3, D), 0.02),
    }


def reference(x, mem, rel_table, ev_w_in, ev_ckv_gain, ev_w_uk, ev_w_uv, ev_sinks, ev_w_out,
              od_w_in, od_pe_k, od_w1_k, od_w2_k, od_pe_v, od_w1_v, od_w2_v, od_w_out,
              xa_w_q, xa_w_k, xa_w_v, xa_w_o, ff_w_gate, ff_w_up, ff_w_down,
              moe_w_router, moe_w_gate, moe_w_up, moe_w_down, ln_g, ln_b):
    h = x
    for i in range(DEPTH):
        j = i // 2
        if i % 2 == 0:
            mix = even_mixer(h, ev_w_in[j], ev_ckv_gain[j], ev_w_uk[j], ev_w_uv[j], ev_sinks[j],
                             ev_w_out[j], rel_table)
        else:
            mix = odd_mixer(h, od_w_in[j], od_pe_k[j], od_w1_k[j], od_w2_k[j], od_pe_v[j],
                            od_w1_v[j], od_w2_v[j], od_w_out[j], rel_table)
        h = layer_norm(ALPHA * h + mix, ln_g[i, 0], ln_b[i, 0])
        xa = cross_attention(h, mem, xa_w_q[i], xa_w_k[i], xa_w_v[i], xa_w_o[i])
        h = layer_norm(ALPHA * h + xa, ln_g[i, 1], ln_b[i, 1])
        if i % 2 == 0:
            ff = dense_swiglu(h, ff_w_gate[j], ff_w_up[j], ff_w_down[j])
        else:
            ff = moe_swiglu(h, moe_w_router[j], moe_w_gate[j], moe_w_up[j], moe_w_down[j])
        h = layer_norm(ALPHA * h + ff, ln_g[i, 2], ln_b[i, 2])
    return h
```

```cpp
#include <hip/hip_runtime.h>
#include <cstdio>
#include <cstdint>

#ifndef MK_ONE_LAUNCH
#define MK_ONE_LAUNCH 0
#endif

constexpr size_t ROWTOK_OFF = 5u * 1048576u + 512u * 1024u, ROWW_OFF = 6u * 1048576u, TILEEXP_OFF = 6u * 1048576u + 512u * 1024u, DUMMY_OFF = 7u * 1048576u;
namespace pg8 {
#define PG8_LAS __attribute__((address_space(3)))
typedef unsigned short bf16_t;
typedef short bf16x8 __attribute__((ext_vector_type(8)));
typedef float f32x4 __attribute__((ext_vector_type(4)));
typedef unsigned u32x4 __attribute__((ext_vector_type(4)));
constexpr int BM = 256, BK = 64, HALF = 128, HTB = HALF * BK * 2, STAGE_BYTES = 8 * HTB, NXCD = 8, WGM = 8;

__host__ __device__ __forceinline__ int lds_byte(int r, int c) { const int st = (r >> 4) * 2 + (c >> 5), rr = r & 15, cc = c & 31, ob = rr * 64 + cc * 2; return st * 1024 + (ob ^ (((ob >> 9) & 1) << 5)); }
__host__ __device__ __forceinline__ void stage_rc(int b, int& R, int& C) { const int st = b / 1024, sb = b % 1024, swz = sb ^ (((sb >> 9) & 1) << 5); R = (st >> 1) * 16 + swz / 64; C = (st & 1) * 32 + (swz % 64) / 2; }
__host__ __device__ __forceinline__ int perm32(int rho) { const int n = rho >> 4, i = rho & 15; return 8 * (i >> 2) + 4 * n + (i & 3); }

__device__ __forceinline__ const void* opaque_uniform(const void* p) {
    unsigned lo = __builtin_amdgcn_readfirstlane((unsigned)(unsigned long long)p), hi = __builtin_amdgcn_readfirstlane((unsigned)((unsigned long long)p >> 32));
    asm volatile("" : "+s"(lo), "+s"(hi)); return (const void*)(((unsigned long long)hi << 32) | lo); }
struct Unit { int pm, pn, aux; const char* a; const char* b; };

__device__ __forceinline__ void tile_of(int wgid, int nM, int nN, int& pm, int& pn) {
    const int nwg = nM * nN;
    { const int q = nwg / NXCD, r = nwg % NXCD, xcd = wgid % NXCD, off = wgid / NXCD; wgid = (xcd < r ? xcd * (q + 1) : r * (q + 1) + (xcd - r) * q) + off; }
    const int nig = WGM * nN, gid = wgid / nig, fm = gid * WGM, gsz = (nM - fm) < WGM ? (nM - fm) : WGM;
    pm = fm + ((wgid % nig) % gsz); pn = (wgid % nig) / gsz;
}
template <size_t A_TILE, size_t B_TILE>
struct StaticSched {
    const char* A; const char* B; int nM, nN, G, c, wave;
    __device__ __forceinline__ bool next(int i, Unit& u) const {
        const long L = (long)i * G + c; if (L >= (long)nM * nN) return false;
        int pm, pn; tile_of((int)L, nM, nN, pm, pn);
        u.pm = pm; u.pn = pn; u.aux = 0; u.a = A + (size_t)pm * A_TILE; u.b = B + (size_t)pn * B_TILE; return true;
    }
};
template <size_t A_OFF, size_t B_OFF, size_t A_TILE, size_t B_TILE, size_t B_EXP, int A_LOCAL>
struct MoeSched {
    const unsigned char* ws; int t0, nT, nN, G, c, wave;
    __device__ __forceinline__ bool next(int i, Unit& u) const {
        const long L = (long)i * G + c; if (L >= (long)nT * nN) return false;
        int pml, pn; tile_of((int)L, nT, nN, pml, pn);
        const unsigned char* wsb = (const unsigned char*)opaque_uniform(ws);
        const int pm = t0 + pml; const int e = __builtin_amdgcn_readfirstlane(((const int*)(wsb + TILEEXP_OFF))[pm]);
        u.pm = pm; u.pn = pn; u.aux = pml; u.a = (const char*)wsb + A_OFF + (size_t)(A_LOCAL ? pml : pm) * A_TILE; u.b = (const char*)wsb + B_OFF + (size_t)e * B_EXP + (size_t)pn * B_TILE; return true;
    }
};

__device__ __forceinline__ unsigned cvt_pk_bf16(float lo, float hi) { unsigned r; asm volatile("v_cvt_pk_bf16_f32 %0, %1, %2" : "=v"(r) : "v"(lo), "v"(hi)); return r; }

struct EpiBf16 {
    static constexpr bool PERM = true;
    bf16_t* O; int ldc;
    __device__ __forceinline__ void operator()(const f32x4 (&acc)[2][2][4][2], const Unit& u, int wr, int wc, int fr, int fq) const {
        const int row0 = u.pm * BM + wr * 64 + fr, col0 = u.pn * BM + wc * 32 + 8 * fq;
#pragma unroll
        for (int ai = 0; ai < 2; ++ai)
#pragma unroll
            for (int m = 0; m < 4; ++m) { bf16_t* rowp = O + (size_t)(row0 + ai * HALF + m * 16) * ldc + col0;
#pragma unroll
                for (int bj = 0; bj < 2; ++bj) { const f32x4 v0 = acc[ai][bj][m][0], v1 = acc[ai][bj][m][1];
                    u32x4 w; w.x = cvt_pk_bf16(v0[0], v0[1]); w.y = cvt_pk_bf16(v0[2], v0[3]); w.z = cvt_pk_bf16(v1[0], v1[1]); w.w = cvt_pk_bf16(v1[2], v1[3]);
                    *(u32x4*)(rowp + bj * HALF) = w; } }
    }
};
struct EpiAcc {
    static constexpr bool PERM = false;
    float* C; int ldc;
    __device__ __forceinline__ void operator()(const f32x4 (&acc)[2][2][4][2], const Unit& u, int wr, int wc, int fr, int fq) const {
        const int row0 = u.pm * BM + wr * 64 + fr, col0 = u.pn * BM + wc * 32 + 4 * fq;
#pragma unroll
        for (int ai = 0; ai < 2; ++ai)
#pragma unroll
            for (int m = 0; m < 4; ++m) { float* rowp = C + (size_t)(row0 + ai * HALF + m * 16) * ldc + col0;
                f32x4 o[2][2];
#pragma unroll
                for (int bj = 0; bj < 2; ++bj)
#pragma unroll
                    for (int n = 0; n < 2; ++n) o[bj][n] = *(const f32x4*)(rowp + bj * HALF + n * 16);
#pragma unroll
                for (int bj = 0; bj < 2; ++bj)
#pragma unroll
                    for (int n = 0; n < 2; ++n) *(f32x4*)(rowp + bj * HALF + n * 16) = o[bj][n] + acc[ai][bj][m][n]; }
    }
};
__device__ __forceinline__ float silu_f(float x) { return x / (1.0f + __expf(-x)); }
struct EpiSwiglu {
    static constexpr bool PERM = true;
    bf16_t* O; int ldc; int row_local;
    __device__ __forceinline__ void operator()(const f32x4 (&acc)[2][2][4][2], const Unit& u, int wr, int wc, int fr, int fq) const {
        const int row0 = (row_local ? u.aux : u.pm) * BM + wr * 64 + fr, col0 = u.pn * HALF + wc * 32 + 8 * fq;
#pragma unroll
        for (int ai = 0; ai < 2; ++ai)
#pragma unroll
            for (int m = 0; m < 4; ++m) { bf16_t* rowp = O + (size_t)(row0 + ai * HALF + m * 16) * ldc + col0;
                const f32x4 g0 = acc[ai][0][m][0], g1 = acc[ai][0][m][1], u0 = acc[ai][1][m][0], u1 = acc[ai][1][m][1];
                float h[8];
#pragma unroll
                for (int j = 0; j < 4; ++j) { h[j] = silu_f(g0[j]) * u0[j]; h[4 + j] = silu_f(g1[j]) * u1[j]; }
                u32x4 w; w.x = cvt_pk_bf16(h[0], h[1]); w.y = cvt_pk_bf16(h[2], h[3]); w.z = cvt_pk_bf16(h[4], h[5]); w.w = cvt_pk_bf16(h[6], h[7]);
                *(u32x4*)rowp = w; }
    }
};
struct EpiMoeDown {
    static constexpr bool PERM = false;
    float* C; unsigned char* ws;
    __device__ __forceinline__ void operator()(const f32x4 (&acc)[2][2][4][2], const Unit& u, int wr, int wc, int fr, int fq) const {
        const int row0 = u.pm * BM + wr * 64 + fr, col0 = u.pn * BM + wc * 32 + 4 * fq;
        unsigned char* wsb = (unsigned char*)opaque_uniform(ws);
        const int* rowtok = (const int*)(wsb + ROWTOK_OFF); const float* roww = (const float*)(wsb + ROWW_OFF); float* dummy = (float*)(wsb + DUMMY_OFF);
#pragma unroll
        for (int ai = 0; ai < 2; ++ai)
#pragma unroll
            for (int m = 0; m < 4; ++m) { const int r = row0 + ai * HALF + m * 16; const int tok = rowtok[r]; const float w = roww[r];
                float* rowp = (tok >= 0 ? C + (size_t)tok * 1024 : dummy) + col0;
                f32x4 o[2][2];
#pragma unroll
                for (int bj = 0; bj < 2; ++bj)
#pragma unroll
                    for (int n = 0; n < 2; ++n) o[bj][n] = *(const f32x4*)(rowp + bj * HALF + n * 16);
#pragma unroll
                for (int bj = 0; bj < 2; ++bj)
#pragma unroll
                    for (int n = 0; n < 2; ++n) *(f32x4*)(rowp + bj * HALF + n * 16) = o[bj][n] + acc[ai][bj][m][n] * w; }
    }
};

template <int K, int lda_b, int ldb_b, class Epi, class Sched>
__device__ __forceinline__ void gemm_phase(PG8_LAS unsigned char* lds, const Sched& S, const Epi& E) {
    int tid_ = (int)__builtin_amdgcn_mbcnt_hi(~0u, __builtin_amdgcn_mbcnt_lo(~0u, 0u)); asm volatile("" : "+v"(tid_)); tid_ += S.wave * 64;
    const int tid = tid_, wid = __builtin_amdgcn_readfirstlane(tid >> 6), lane = tid & 63, wr = wid >> 2, wc = wid & 3, fr = lane & 15, fq = lane >> 4;
    constexpr int nt = K / BK;
    unsigned voffA[2], voffB[2];
#pragma unroll
    for (int i = 0; i < 2; ++i) { int R, C; stage_rc(tid * 16 + i * 8192, R, C); const int Rb = Epi::PERM ? ((R & ~31) + perm32(R & 31)) : R;
        voffA[i] = (unsigned)(R * lda_b + C * 2); voffB[i] = (unsigned)(Rb * ldb_b + C * 2); }
    const size_t kstep = (size_t)(BK * 2);
    const size_t hstepA = (size_t)HALF * lda_b, hstepB = (size_t)HALF * ldb_b;
    const unsigned ldsw = (unsigned)wid * 1024u;
    const int aoff = lds_byte(wr * 64 + fr, fq * 8), boff = lds_byte(wc * 32 + fr, fq * 8);
#define PG8_SA(b, h) (((b) * 2 + (h)) * HTB)
#define PG8_SB(b, h) ((4 + (b) * 2 + (h)) * HTB)
#define PG8_STAGE(bufoff, gbase, voff) do { _Pragma("unroll") for (int _i = 0; _i < 2; ++_i) \
        __builtin_amdgcn_global_load_lds((const unsigned*)((const char*)(gbase) + (voff)[_i]), (PG8_LAS unsigned*)(lds + (bufoff) + ldsw + _i * 8192), 16, 0, 0); } while (0)
#define PG8_LDA(dst, b, h) do { _Pragma("unroll") for (int m = 0; m < 4; ++m) _Pragma("unroll") for (int k = 0; k < 2; ++k) dst[m][k] = *(const PG8_LAS bf16x8*)(lds + PG8_SA(b, h) + aoff + m * 2048 + k * 1024); } while (0)
#define PG8_LDB(dst, b, h) do { _Pragma("unroll") for (int n = 0; n < 2; ++n) _Pragma("unroll") for (int k = 0; k < 2; ++k) dst[n][k] = *(const PG8_LAS bf16x8*)(lds + PG8_SB(b, h) + boff + n * 2048 + k * 1024); } while (0)
#define PG8_MMA(ai, bj, At, Bt) do { __builtin_amdgcn_s_setprio(1); _Pragma("unroll") for (int m = 0; m < 4; ++m) _Pragma("unroll") for (int n = 0; n < 2; ++n) _Pragma("unroll") for (int k = 0; k < 2; ++k) \
        acc[ai][bj][m][n] = __builtin_amdgcn_mfma_f32_16x16x32_bf16(Bt[n][k], At[m][k], acc[ai][bj][m][n], 0, 0, 0); __builtin_amdgcn_s_setprio(0); } while (0)
#define PG8_WAIT_V(n) asm volatile("s_waitcnt vmcnt(" #n ")" ::: "memory")
#define PG8_WAIT_L(n) asm volatile("s_waitcnt lgkmcnt(" #n ")" ::: "memory")
#define PG8_BAR __builtin_amdgcn_s_barrier()
#define PG8_SCHED __builtin_amdgcn_sched_barrier(0)
    Unit cur, nxt; int ui = 0;
    if (!S.next(0, cur)) return;
    f32x4 acc[2][2][4][2];
#pragma unroll
    for (int a = 0; a < 2; ++a)
#pragma unroll
        for (int b = 0; b < 2; ++b)
#pragma unroll
            for (int m = 0; m < 4; ++m)
#pragma unroll
                for (int n = 0; n < 2; ++n) acc[a][b][m][n] = (f32x4){0.f, 0.f, 0.f, 0.f};
    bf16x8 At[4][2], B0[2][2], B1[2][2];
    const char* cA = cur.a; const char* cB = cur.b;
    PG8_STAGE(PG8_SB(0, 0), cB, voffB); PG8_STAGE(PG8_SB(0, 1), cB + hstepB, voffB); PG8_STAGE(PG8_SA(0, 0), cA, voffA); PG8_STAGE(PG8_SA(0, 1), cA + hstepA, voffA);
    if (wr == 1) PG8_BAR;
    PG8_WAIT_V(2); PG8_BAR;
    PG8_STAGE(PG8_SB(1, 0), cB + kstep, voffB); PG8_STAGE(PG8_SA(1, 0), cA + kstep, voffA); PG8_STAGE(PG8_SB(1, 1), cB + hstepB + kstep, voffB);
    PG8_WAIT_V(6); PG8_BAR;
    for (;;) {
        const bool has_next = S.next(ui + 1, nxt);
        const char* nA = has_next ? nxt.a : cA; const char* nB = has_next ? nxt.b : cB;
        for (int t = 0; t < nt; t += 2) {
            const bool last = (t == nt - 2);
            const char* a1 = cA + (size_t)(t + 1) * kstep;
            const char* a2 = last ? nA : cA + (size_t)(t + 2) * kstep; const char* b2 = last ? nB : cB + (size_t)(t + 2) * kstep;
            const char* a3 = a2 + kstep; const char* b3 = b2 + kstep;
            PG8_LDB(B0, 0, 0); PG8_LDB(B1, 0, 1); PG8_SCHED; PG8_LDA(At, 0, 0); PG8_STAGE(PG8_SA(1, 1), a1 + hstepA, voffA);
            PG8_WAIT_V(8); PG8_WAIT_L(0); PG8_BAR; PG8_MMA(0, 0, At, B0); PG8_MMA(0, 1, At, B1); PG8_BAR; PG8_SCHED;
            PG8_LDA(At, 0, 1); PG8_STAGE(PG8_SB(0, 0), b2, voffB); PG8_STAGE(PG8_SB(0, 1), b2 + hstepB, voffB); PG8_STAGE(PG8_SA(0, 0), a2, voffA);
            PG8_WAIT_V(8); PG8_WAIT_L(0); PG8_BAR; PG8_MMA(1, 0, At, B0); PG8_MMA(1, 1, At, B1); PG8_BAR; PG8_SCHED;
            PG8_LDB(B0, 1, 0); PG8_LDB(B1, 1, 1); PG8_SCHED; PG8_LDA(At, 1, 0); PG8_STAGE(PG8_SA(0, 1), a2 + hstepA, voffA);
            PG8_WAIT_V(8); PG8_WAIT_L(0); PG8_BAR; PG8_MMA(0, 0, At, B0); PG8_MMA(0, 1, At, B1); PG8_BAR; PG8_SCHED;
            PG8_LDA(At, 1, 1); PG8_STAGE(PG8_SB(1, 0), b3, voffB); PG8_STAGE(PG8_SB(1, 1), b3 + hstepB, voffB); PG8_STAGE(PG8_SA(1, 0), a3, voffA);
            PG8_WAIT_V(8); PG8_WAIT_L(0); PG8_BAR; PG8_MMA(1, 0, At, B0); PG8_MMA(1, 1, At, B1); PG8_BAR; PG8_SCHED;
        }
        if (wr == 0) PG8_BAR;
        E(acc, cur, wr, wc, fr, fq);
        if (!has_next) break;
#pragma unroll
        for (int a = 0; a < 2; ++a)
#pragma unroll
            for (int b = 0; b < 2; ++b)
#pragma unroll
                for (int m = 0; m < 4; ++m)
#pragma unroll
                    for (int n = 0; n < 2; ++n) acc[a][b][m][n] = (f32x4){0.f, 0.f, 0.f, 0.f};
        cur = nxt; cA = nA; cB = nB; ++ui;
        if (wr == 1) PG8_BAR;
    }
    PG8_WAIT_V(0);
    PG8_BAR;
#undef PG8_SA
#undef PG8_SB
#undef PG8_STAGE
#undef PG8_LDA
#undef PG8_LDB
#undef PG8_MMA
#undef PG8_WAIT_V
#undef PG8_WAIT_L
#undef PG8_BAR
#undef PG8_SCHED
}
}

constexpr int NWAVES = 8;
constexpr int D = 1024, NB = 16, S = 2048, M = NB * S, MEML = 256, MMEM = NB * MEML;
constexpr float LN_EPS = 1e-5f, ALPHA = 1.41421356237f;
constexpr int P0_LD = 2560, C0_QLAT = 0, C0_QB = 1024, C0_CKV = 1536, C0_QI = 1664, C0_KI = 2176, C0_KB = 2240, C0_VB = 2368, C0_WI = 2496;
constexpr int P1_LD = 2048, C1_Q = 0, C1_KC = 1024, C1_VC = 1152, C1_KS = 1280, C1_VS = 1408, C1_KW = 1536, C1_VW = 1664, C1_GL = 1792;
constexpr int EVEN_COLS = 1992, ODD_COLS = 1840;
constexpr int DFF = 2816, DFFE = 3584, NE = 8, NCMP = 127;
constexpr int MOE_CHUNK_TILES = 68, MOE_MAX_TILES = 272;

constexpr size_t MiB = 1u << 20;
constexpr size_t WS_CTL = 0, CTL_ZERO_BYTES = 1 * MiB;
constexpr size_t WS_KC = 2 * MiB, WS_VC = 3 * MiB;
constexpr size_t WS_SELM = 4 * MiB;
constexpr size_t WS_RTE = 4 * MiB + 512 * 1024;
constexpr size_t WS_RTW = 5 * MiB;
constexpr size_t WS_ROWTOK = ROWTOK_OFF; static_assert(ROWTOK_OFF == 5 * MiB + 512 * 1024, "");
constexpr size_t WS_ROWW = ROWW_OFF;
constexpr size_t WS_TILEEXP = TILEEXP_OFF; constexpr size_t WS_DUMMY = DUMMY_OFF;
constexpr size_t WS_W = 8 * MiB;
constexpr size_t W_IN0 = WS_W;
constexpr size_t W_OUT0 = W_IN0 + (size_t)2560 * 1024 * 2;
constexpr size_t W_IN1 = W_OUT0 + (size_t)1024 * 1536 * 2;
constexpr size_t W_OUT1 = W_IN1 + (size_t)2048 * 1024 * 2;
constexpr size_t W_XQ = W_OUT1 + (size_t)1024 * 1024 * 2;
constexpr size_t W_XKV = W_XQ + (size_t)2 * 512 * 1024 * 2;
constexpr size_t W_XO = W_XKV + (size_t)2 * 1024 * 1024 * 2;
constexpr size_t W_FGU = W_XO + (size_t)2 * 1024 * 512 * 2;
constexpr size_t W_FD = W_FGU + (size_t)5632 * 1024 * 2;
constexpr size_t W_MGU = W_FD + (size_t)1024 * 2816 * 2;
constexpr size_t W_MD = W_MGU + (size_t)8 * 7168 * 1024 * 2;
constexpr size_t W_END = W_MD + (size_t)8 * 1024 * 3584 * 2;
static_assert(W_END <= 215 * MiB, "weights");
constexpr size_t WS_HB = 215 * MiB;
constexpr size_t WS_XKV = 279 * MiB;
constexpr size_t WS_SCR = 295 * MiB;
constexpr size_t WS_P0 = WS_SCR;
constexpr size_t WS_CN = WS_SCR + 160 * MiB;
constexpr size_t WS_MASK = WS_SCR + 168 * MiB;
constexpr size_t WS_MEMB = WS_SCR + 176 * MiB;
constexpr size_t WS_QX0 = WS_SCR + 184 * MiB, WS_OX0 = WS_SCR + 216 * MiB;
constexpr size_t WS_HID = WS_SCR;
constexpr size_t WS_P1 = WS_SCR;
constexpr size_t WS_OCMP = WS_SCR + 128 * MiB, WS_OSLC = WS_SCR + 192 * MiB;
constexpr size_t WS_QX1 = WS_SCR, WS_OX1 = WS_SCR + 32 * MiB;
constexpr size_t WS_PERMA = WS_SCR;
constexpr size_t WS_HIDM = WS_SCR + 136 * MiB;
constexpr size_t WS_END = WS_SCR + 256 * MiB;
static_assert(WS_HIDM + (size_t)MOE_CHUNK_TILES * 256 * DFFE * 2 <= WS_END, "ws");
constexpr int CW_BAR = 4096;
constexpr int CW_CNT = 16384;
constexpr int CW_CUR = 16384 + 64;

constexpr int RING_BYTES = 131072, LDSCTL_OFF = RING_BYTES, MISC_OFF = LDSCTL_OFF + 320, LDS_BYTES = 147456;

#define GAS __attribute__((address_space(1)))
#define LAS __attribute__((address_space(3)))
typedef unsigned short bf16;
typedef unsigned v4u __attribute__((ext_vector_type(4)));
typedef unsigned v2u __attribute__((ext_vector_type(2)));
typedef float f32x4 __attribute__((ext_vector_type(4)));
#define LDS_WAIT() asm volatile("s_waitcnt lgkmcnt(0)" ::: "memory")
#define WAVE_SYNC() asm volatile("s_waitcnt vmcnt(0) lgkmcnt(0)" ::: "memory")
__device__ __forceinline__ unsigned f2bf(float f) { unsigned u = __builtin_bit_cast(unsigned, f); return (u + 0x7fffu + ((u >> 16) & 1u)) >> 16; }
__device__ __forceinline__ unsigned pk2(float lo, float hi) { return f2bf(lo) | (f2bf(hi) << 16); }
__device__ __forceinline__ float bf2f(bf16 b) { return __builtin_bit_cast(float, (unsigned)b << 16); }
__device__ __forceinline__ float bflo(unsigned w) { return __builtin_bit_cast(float, w << 16); }
__device__ __forceinline__ float bfhi(unsigned w) { return __builtin_bit_cast(float, w & 0xffff0000u); }
__device__ __forceinline__ void ld8bf(const bf16* p, float* f) { const v4u w = *(const v4u*)p; f[0] = bflo(w.x); f[1] = bfhi(w.x); f[2] = bflo(w.y); f[3] = bfhi(w.y); f[4] = bflo(w.z); f[5] = bfhi(w.z); f[6] = bflo(w.w); f[7] = bfhi(w.w); }
__device__ __forceinline__ float wave_sum(float v) {
#pragma unroll
    for (int o = 1; o < 64; o <<= 1) v += __shfl_xor(v, o);
    return v;
}
__device__ __forceinline__ float wave_max(float v) {
#pragma unroll
    for (int o = 1; o < 64; o <<= 1) v = fmaxf(v, __shfl_xor(v, o));
    return v;
}
__device__ const unsigned char BKT[112] = {16, 16, 16, 17, 17, 18, 18, 18, 19, 19, 19, 20, 20, 20, 20, 21, 21, 21, 21, 22, 22, 22, 22, 22, 23, 23, 23, 23, 23, 23, 24, 24, 24, 24, 24, 24, 25, 25, 25, 25, 25, 25, 25, 26, 26, 26, 26, 26, 26, 26, 26,
    27, 27, 27, 27, 27, 27, 27, 27, 27, 27, 28, 28, 28, 28, 28, 28, 28, 28, 28, 28, 29, 29, 29, 29, 29, 29, 29, 29, 29, 29, 29, 29, 30, 30, 30, 30, 30, 30, 30, 30, 30, 30, 30, 30, 30, 30, 31, 31, 31, 31, 31, 31, 31, 31, 31, 31, 31, 31, 31, 31, 31};
__device__ __forceinline__ int rel_bucket(int n) { return n < 16 ? n : (n >= 128 ? 31 : (int)BKT[n - 16]); }

#define XB_TMO      128
#define XB_XCNT(j)  (256  + 64 * (j))
#define XB_XSUB(j)  (1280 + 64 * (j))
#define XB_XGEN(j)  (2304 + 64 * (j))
#define XB_TOP      3328
#define XB_TOPGEN   3392
#define XCD_BAR_WORDS 3456
#define XB_SPIN_CAP (1u << 22)
__device__ __forceinline__ unsigned xb_ld(unsigned* p)              { return __hip_atomic_load(p, __ATOMIC_RELAXED, __HIP_MEMORY_SCOPE_AGENT); }
__device__ __forceinline__ unsigned xb_add(unsigned* p, unsigned v) { return __hip_atomic_fetch_add(p, v, __ATOMIC_RELAXED, __HIP_MEMORY_SCOPE_AGENT); }
__device__ __forceinline__ unsigned xb_xcc_id() { return (unsigned)__builtin_amdgcn_s_getreg((3 << 11) | 20) & 0xFu; }
#define XB_SPIN(cond, bar) do { unsigned _sp = 0; while (cond) { __builtin_amdgcn_s_sleep(1); \
    if ((++_sp & 255u) == 0u) { if (xb_ld(&(bar)[XB_TMO])) break; if (_sp > XB_SPIN_CAP) { atomicAdd(&(bar)[XB_TMO], 1u); break; } } } } while (0)
struct XcdBarrier { unsigned* bar; unsigned x; volatile LAS unsigned* st; };
__device__ __forceinline__ XcdBarrier xcd_barrier_post(unsigned* bar, volatile LAS unsigned* st) {
    XcdBarrier b; b.bar = bar; b.x = xb_xcc_id(); b.st = st;
    if (threadIdx.x == 0) (void)xb_add(&bar[XB_XCNT(b.x)], 1u);
    return b;
}
__device__ __forceinline__ void xcd_barrier_complete(unsigned* bar, unsigned x, unsigned& nloc, unsigned& nx) {
    const unsigned G = gridDim.x * gridDim.y * gridDim.z;
    unsigned sum, cnt, mine, sp = 0u;
    for (;;) {
        sum = 0u; cnt = 0u; mine = 0u;
#pragma unroll
        for (unsigned j = 0; j < 16; ++j) { const unsigned c = xb_ld(&bar[XB_XCNT(j)]); sum += c; cnt += (c > 0u) ? 1u : 0u; mine = (j == x) ? c : mine; }
        if (sum == G) break;
        __builtin_amdgcn_s_sleep(1);
        if ((++sp & 255u) == 0u) { if (xb_ld(&bar[XB_TMO])) break; if (sp > XB_SPIN_CAP) { atomicAdd(&bar[XB_TMO], 1u); break; } }
    }
    nloc = mine > 0u ? mine : 1u; nx = cnt > 0u ? cnt : 1u;
}
__device__ __forceinline__ void xcd_barrier(const XcdBarrier& b) {
    asm volatile("s_waitcnt vmcnt(0)" ::: "memory");
    __syncthreads();
    if (threadIdx.x == 0) {
        unsigned* bar = b.bar;
        __builtin_amdgcn_s_waitcnt(0);
        unsigned nloc = b.st[0], nx = b.st[1];
        const unsigned old = xb_add(&bar[XB_XSUB(b.x)], 1u);
        const unsigned gen = old / nloc;
        if (old + 1u == (gen + 1u) * nloc) {
            __builtin_amdgcn_fence(__ATOMIC_RELEASE, "agent");
            asm volatile("s_waitcnt vmcnt(0)" ::: "memory");
            const unsigned og = xb_add(&bar[XB_TOP], 1u);
            const unsigned tg = og / nx;
            if (og + 1u == (tg + 1u) * nx) xb_add(&bar[XB_TOPGEN], 1u);
            else XB_SPIN(xb_ld(&bar[XB_TOPGEN]) == tg, bar);
            __builtin_amdgcn_fence(__ATOMIC_ACQUIRE, "agent");
            xb_add(&bar[XB_XGEN(b.x)], 1u);
            asm volatile("s_waitcnt vmcnt(0)" ::: "memory");
        } else {
            XB_SPIN(xb_ld(&bar[XB_XGEN(b.x)]) == gen, bar);
            __builtin_amdgcn_fence(__ATOMIC_ACQUIRE, "agent");
            asm volatile("s_waitcnt vmcnt(0)" ::: "memory");
        }
    }
    __syncthreads();
}

struct Args { const float* in[30]; float* out; unsigned char* ws; int ph_lo, ph_hi; };
enum { I_X = 0, I_MEM, I_REL, I_EV_WIN, I_EV_GAIN, I_EV_WUK, I_EV_WUV, I_EV_SINK, I_EV_WOUT, I_OD_WIN, I_OD_PEK, I_OD_W1K, I_OD_W2K, I_OD_PEV, I_OD_W1V, I_OD_W2V, I_OD_WOUT,
       I_XA_WQ, I_XA_WK, I_XA_WV, I_XA_WO, I_FF_G, I_FF_U, I_FF_D, I_MOE_R, I_MOE_G, I_MOE_U, I_MOE_D, I_LN_G, I_LN_B };

struct Frame {
    LAS unsigned char* lds;
    unsigned char* ws; float* acc;
    const float* const* in;
    int tid, lane, wave, G, gw, NGW;
};

__device__ __forceinline__ bool fresh(Frame& F) { int l = (int)__builtin_amdgcn_mbcnt_hi(~0u, __builtin_amdgcn_mbcnt_lo(~0u, 0u)); asm volatile("" : "+v"(l)); F.lane = l; F.tid = F.wave * 64 + l; return true; }
__device__ __forceinline__ void tconv_item(const float* W, int ldw, int ncols, bf16* WT, int ldt, int grp, int gstride, LAS float* scr, int kb, int nb, int lane) {
    const int k0 = 64 * kb, n0 = 32 * nb;
#pragma unroll 8
    for (int i = 0; i < 32; ++i) { const int kk = 2 * i + (lane >> 5), n = n0 + (lane & 31); scr[kk * 33 + (lane & 31)] = (n < ncols) ? W[(size_t)(k0 + kk) * ldw + n] : 0.f; }
    LDS_WAIT();
    const int c = lane & 7;
#pragma unroll
    for (int j = 0; j < 4; ++j) { const int nn = (lane >> 3) + 8 * j, n = n0 + nn; const LAS float* s = scr + (8 * c) * 33 + nn;
        v4u o; o.x = pk2(s[0 * 33], s[1 * 33]); o.y = pk2(s[2 * 33], s[3 * 33]); o.z = pk2(s[4 * 33], s[5 * 33]); o.w = pk2(s[6 * 33], s[7 * 33]);
        const int row = (n / grp) * gstride + (n % grp);
        *(v4u*)(WT + (size_t)row * ldt + k0 + 8 * c) = o; }
    LDS_WAIT();
}
__device__ __forceinline__ void tconv(const Frame& F, const float* W, int ldw, int K, int ncols, int npad, bf16* WT, int ldt, int grp, int gstride) {
    LAS float* scr = (LAS float*)(F.lds + F.wave * 16384);
    const int nkb = K / 64, nnb = npad / 32;
    for (int it = F.gw; it < nkb * nnb; it += F.NGW) tconv_item(W, ldw, ncols, WT, ldt, grp, gstride, scr, it / nnb, it % nnb, F.lane);
}
constexpr int NOGRP = 1 << 30;

__device__ __forceinline__ void prologue(const Frame& F) {
    unsigned char* ws = F.ws;
    const int gt = F.gw * 64 + F.lane, NT = F.NGW * 64;
    bf16* win0 = (bf16*)(ws + W_IN0);
    const float* evw = F.in[I_EV_WIN];
    tconv(F, evw + 512, EVEN_COLS, 1024, 128, 128, win0 + (size_t)C0_CKV * 1024, 1024, NOGRP, 0);
    tconv(F, evw + 640, EVEN_COLS, 1024, 512, 512, win0 + (size_t)C0_QI * 1024, 1024, NOGRP, 0);
    tconv(F, evw + 1152, EVEN_COLS, 1024, 64, 64, win0 + (size_t)C0_KI * 1024, 1024, NOGRP, 0);
    tconv(F, evw + 1216, EVEN_COLS, 1024, 8, 64, win0 + (size_t)C0_WI * 1024, 1024, NOGRP, 0);
    tconv(F, evw + 1224, EVEN_COLS, 1024, 512, 512, win0 + (size_t)C0_QB * 1024, 1024, NOGRP, 0);
    tconv(F, evw + 1736, EVEN_COLS, 1024, 128, 128, win0 + (size_t)C0_KB * 1024, 1024, NOGRP, 0);
    tconv(F, evw + 1864, EVEN_COLS, 1024, 128, 128, win0 + (size_t)C0_VB * 1024, 1024, NOGRP, 0);
    {
        const float* wuk = F.in[I_EV_WUK];
        for (int idx = gt; idx < 1024 * 1024; idx += NT) { const int r = idx >> 10, k = idx & 1023, h = r >> 7, c = r & 127;
            const float* wr = evw + (size_t)k * EVEN_COLS + h * 64; const float* uk = wuk + (size_t)h * 64 * 128 + c; float s = 0.f;
#pragma unroll 8
            for (int d = 0; d < 64; ++d) s += wr[d] * uk[d * 128];
            win0[(size_t)(C0_QLAT + r) * 1024 + k] = (bf16)f2bf(s); }
    }
    bf16* wout0 = (bf16*)(ws + W_OUT0);
    const float* evo = F.in[I_EV_WOUT];
    tconv(F, evo + (size_t)512 * 1024, 1024, 512, 1024, 1024, wout0 + 1024, 1536, NOGRP, 0);
    {
        const float* wuv = F.in[I_EV_WUV];
        for (int idx = gt; idx < 1024 * 1024; idx += NT) { const int n = idx >> 10, kk = idx & 1023, h = kk >> 7;
            const float* uv = wuv + (size_t)kk * 64; const float* wo = evo + (size_t)h * 64 * 1024 + n; float s = 0.f;
#pragma unroll 8
            for (int d = 0; d < 64; ++d) s += uv[d] * wo[(size_t)d * 1024];
            wout0[(size_t)n * 1536 + kk] = (bf16)f2bf(s); }
    }
    tconv(F, F.in[I_OD_WIN], ODD_COLS, 1024, ODD_COLS, 2048, (bf16*)(ws + W_IN1), 1024, NOGRP, 0);
    tconv(F, F.in[I_OD_WOUT], 1024, 1024, 1024, 1024, (bf16*)(ws + W_OUT1), 1024, NOGRP, 0);
    for (int i = 0; i < 2; ++i) {
        tconv(F, F.in[I_XA_WQ] + (size_t)i * 1024 * 512, 512, 1024, 512, 512, (bf16*)(ws + W_XQ) + (size_t)i * 512 * 1024, 1024, NOGRP, 0);
        tconv(F, F.in[I_XA_WK] + (size_t)i * 1024 * 512, 512, 1024, 512, 512, (bf16*)(ws + W_XKV) + (size_t)i * 1024 * 1024, 1024, NOGRP, 0);
        tconv(F, F.in[I_XA_WV] + (size_t)i * 1024 * 512, 512, 1024, 512, 512, (bf16*)(ws + W_XKV) + (size_t)i * 1024 * 1024 + (size_t)512 * 1024, 1024, NOGRP, 0);
        tconv(F, F.in[I_XA_WO] + (size_t)i * 512 * 1024, 1024, 512, 1024, 1024, (bf16*)(ws + W_XO) + (size_t)i * 1024 * 512, 512, NOGRP, 0);
    }
    tconv(F, F.in[I_FF_G], DFF, 1024, DFF, DFF, (bf16*)(ws + W_FGU), 1024, 128, 256);
    tconv(F, F.in[I_FF_U], DFF, 1024, DFF, DFF, (bf16*)(ws + W_FGU) + (size_t)128 * 1024, 1024, 128, 256);
    tconv(F, F.in[I_FF_D], 1024, DFF, 1024, 1024, (bf16*)(ws + W_FD), DFF, NOGRP, 0);
    for (int e = 0; e < NE; ++e) {
        tconv(F, F.in[I_MOE_G] + (size_t)e * 1024 * DFFE, DFFE, 1024, DFFE, DFFE, (bf16*)(ws + W_MGU) + (size_t)e * 7168 * 1024, 1024, 128, 256);
        tconv(F, F.in[I_MOE_U] + (size_t)e * 1024 * DFFE, DFFE, 1024, DFFE, DFFE, (bf16*)(ws + W_MGU) + (size_t)e * 7168 * 1024 + (size_t)128 * 1024, 1024, 128, 256);
        tconv(F, F.in[I_MOE_D] + (size_t)e * DFFE * 1024, 1024, DFFE, 1024, 1024, (bf16*)(ws + W_MD) + (size_t)e * 1024 * DFFE, DFFE, NOGRP, 0);
    }
    {
        const f32x4* x4 = (const f32x4*)F.in[I_X]; v2u* hb = (v2u*)(ws + WS_HB); f32x4* a4 = (f32x4*)F.acc;
        for (int i = gt; i < M * D / 4; i += NT) { const f32x4 v = x4[i]; v2u o; o.x = pk2(v.x, v.y); o.y = pk2(v.z, v.w); hb[i] = o; a4[i] = v * ALPHA; }
        const f32x4* m4 = (const f32x4*)F.in[I_MEM]; v2u* mb = (v2u*)(ws + WS_MEMB);
        for (int i = gt; i < MMEM * D / 4; i += NT) { const f32x4 v = m4[i]; v2u o; o.x = pk2(v.x, v.y); o.y = pk2(v.z, v.w); mb[i] = o; }
    }
}

template <int MODE>
__device__ __forceinline__ void ln_phase(const Frame& F, int li) {
    const float* g = F.in[I_LN_G] + (size_t)li * D; const float* bb = F.in[I_LN_B] + (size_t)li * D;
    LAS int* lcnt = (LAS int*)F.lds;
    if (MODE == 1) { if (F.tid < 16) lcnt[F.tid] = 0; __syncthreads(); }
    for (int row = F.gw; row < M; row += F.NGW) {
        f32x4* p = (f32x4*)(F.acc + (size_t)row * D) + F.lane;
        f32x4 v[4]; float s = 0.f;
#pragma unroll
        for (int j = 0; j < 4; ++j) { v[j] = p[64 * j]; s += (v[j].x + v[j].y) + (v[j].z + v[j].w); }
        const float mean = wave_sum(s) * (1.f / D); float s2 = 0.f;
#pragma unroll
        for (int j = 0; j < 4; ++j) { v[j] = v[j] - mean; s2 += (v[j].x * v[j].x + v[j].y * v[j].y) + (v[j].z * v[j].z + v[j].w * v[j].w); }
        const float rstd = 1.f / sqrtf(wave_sum(s2) * (1.f / D) + LN_EPS);
#pragma unroll
        for (int j = 0; j < 4; ++j) { const f32x4 gg = ((const f32x4*)g)[F.lane + 64 * j], b4 = ((const f32x4*)bb)[F.lane + 64 * j]; v[j] = v[j] * rstd * gg + b4; }
        if (MODE == 2) {
#pragma unroll
            for (int j = 0; j < 4; ++j) p[64 * j] = v[j];
        } else {
            v2u* hb = (v2u*)(F.ws + WS_HB + (size_t)row * D * 2) + F.lane;
#pragma unroll
            for (int j = 0; j < 4; ++j) { v2u o; o.x = pk2(v[j].x, v[j].y); o.y = pk2(v[j].z, v[j].w); hb[64 * j] = o; p[64 * j] = v[j] * ALPHA; }
        }
        if (MODE == 1) {
            const float* wr = F.in[I_MOE_R]; float lg[8];
#pragma unroll
            for (int e = 0; e < 8; ++e) lg[e] = 0.f;
#pragma unroll
            for (int j = 0; j < 4; ++j)
#pragma unroll
                for (int i = 0; i < 4; ++i) { const int c = 4 * (F.lane + 64 * j) + i; const f32x4 w0 = *(const f32x4*)(wr + (size_t)c * 8), w1 = *(const f32x4*)(wr + (size_t)c * 8 + 4); const float y = v[j][i];
                    lg[0] += y * w0.x; lg[1] += y * w0.y; lg[2] += y * w0.z; lg[3] += y * w0.w; lg[4] += y * w1.x; lg[5] += y * w1.y; lg[6] += y * w1.z; lg[7] += y * w1.w; }
#pragma unroll
            for (int e = 0; e < 8; ++e) lg[e] = wave_sum(lg[e]);
            int e0 = 0; float v0 = lg[0];
#pragma unroll
            for (int e = 1; e < 8; ++e) if (lg[e] > v0) { v0 = lg[e]; e0 = e; }
            int e1 = -1; float v1 = -3.0e38f;
#pragma unroll
            for (int e = 0; e < 8; ++e) if (e != e0 && lg[e] > v1) { v1 = lg[e]; e1 = e; }
            const float w0 = 1.f / (1.f + __expf(v1 - v0)), w1 = 1.f - w0;
            if (F.lane == 0) { int* rte = (int*)(F.ws + WS_RTE); float* rtw = (float*)(F.ws + WS_RTW); rte[2 * row] = e0; rte[2 * row + 1] = e1; rtw[2 * row] = w0; rtw[2 * row + 1] = w1;
                atomicAdd((int*)&lcnt[e0], 1); atomicAdd((int*)&lcnt[8 + e1], 1); }
        }
    }
    if (MODE == 1) { __syncthreads(); if (F.tid < 16) { const int c = lcnt[F.tid]; if (c) atomicAdd((unsigned*)(F.ws + WS_CTL) + CW_CNT + F.tid, (unsigned)c); } }
}

__device__ __forceinline__ void moe_dispatch(const Frame& F) {
    unsigned* ctl = (unsigned*)(F.ws + WS_CTL);
    int* tile_exp = (int*)(F.ws + WS_TILEEXP); int* rowtok = (int*)(F.ws + WS_ROWTOK); float* roww = (float*)(F.ws + WS_ROWW);
    LAS int* seg = (LAS int*)F.lds;
    if (F.tid == 0) { int run = 0;
#pragma unroll 1
        for (int sgi = 0; sgi < 16; ++sgi) { if ((sgi & 7) == 0) seg[32 + (sgi >> 3)] = run >> 8; seg[sgi] = run; const int c = (int)__hip_atomic_load(ctl + CW_CNT + sgi, __ATOMIC_RELAXED, __HIP_MEMORY_SCOPE_AGENT); seg[16 + sgi] = c; run += (c + 255) & ~255; }
        seg[34] = run >> 8; }
    __syncthreads();
    if (blockIdx.x == 0) {
#pragma unroll 1
        for (int sgi = 0; sgi < 16; ++sgi) { const int c = seg[16 + sgi], st = seg[sgi], en = st + ((c + 255) & ~255);
            for (int t = (st >> 8) + F.tid; t < (en >> 8); t += 512) tile_exp[t] = sgi & 7;
            for (int r = st + c + F.tid; r < en; r += 512) { rowtok[r] = -1; roww[r] = 0.f; } }
        if (F.tid < 3) tile_exp[512 + F.tid] = seg[32 + F.tid];
    }
    const int* rte = (const int*)(F.ws + WS_RTE); const float* rtw = (const float*)(F.ws + WS_RTW);
    for (int base = F.gw * 64; base < M; base += F.NGW * 64) {
        const int tok = base + F.lane; const int e0 = rte[2 * tok], e1 = rte[2 * tok + 1]; const float w0 = rtw[2 * tok], w1 = rtw[2 * tok + 1];
        int pos0 = 0, pos1 = 0;
#pragma unroll 1
        for (int sgi = 0; sgi < 16; ++sgi) { const bool mine = (sgi < 8) ? (e0 == sgi) : (e1 == sgi - 8);
            const unsigned long long bal = __ballot(mine);
            if (bal) { const int n = __popcll(bal); unsigned b0 = 0; if (F.lane == 0) b0 = atomicAdd(ctl + CW_CUR + sgi, (unsigned)n); b0 = __shfl(b0, 0);
                const int rank = __popcll(bal & ((1ull << F.lane) - 1ull));
                if (mine) { const int pos = seg[sgi] + (int)b0 + rank; if (sgi < 8) pos0 = pos; else pos1 = pos; } } }
        rowtok[pos0] = tok; roww[pos0] = w0; rowtok[pos1] = tok; roww[pos1] = w1;
#pragma unroll 1
        for (int i = 0; i < 64; ++i) { const int tk = base + i; const int p0 = __shfl(pos0, i), p1 = __shfl(pos1, i);
            const v4u* src = (const v4u*)(F.ws + WS_HB + (size_t)tk * D * 2);
            v4u* d0 = (v4u*)(F.ws + WS_PERMA + (size_t)p0 * D * 2); v4u* d1 = (v4u*)(F.ws + WS_PERMA + (size_t)p1 * D * 2);
            const v4u a = src[F.lane], b = src[F.lane + 64]; d0[F.lane] = a; d0[F.lane + 64] = b; d1[F.lane] = a; d1[F.lane + 64] = b; }
    }
    __syncthreads();
}

__device__ __forceinline__ void cn_phase(const Frame& F) {
    const bf16* P0 = (const bf16*)(F.ws + WS_P0); bf16* CN = (bf16*)(F.ws + WS_CN); const float* gain = F.in[I_EV_GAIN];
    for (int row = F.gw; row < M; row += F.NGW) {
        const unsigned w = *(const unsigned*)(P0 + (size_t)row * P0_LD + C0_CKV + 2 * F.lane); const float a = bflo(w), b = bfhi(w);
        const float ms = wave_sum(a * a + b * b) * (1.f / 128.f); const float r = 1.f / sqrtf(ms + LN_EPS);
        *(unsigned*)(CN + (size_t)row * 128 + 2 * F.lane) = pk2(a * r * gain[2 * F.lane], b * r * gain[2 * F.lane + 1]);
    }
}

__device__ __forceinline__ unsigned fkey(float x) { unsigned b = __builtin_bit_cast(unsigned, x); if (b == 0x80000000u) b = 0u; return (b & 0x80000000u) ? ~b : (b | 0x80000000u); }
__device__ __forceinline__ void idx_phase(const Frame& F) {
    const bf16* P0 = (const bf16*)(F.ws + WS_P0); unsigned* MASK = (unsigned*)(F.ws + WS_MASK);
    LAS float* qi_s = (LAS float*)F.lds; LAS float* wi_s = qi_s + 4096; LAS float* sc = wi_s + 64;
    for (int item = blockIdx.x; item < NB * (S / 8); item += F.G) {
        const int b = item / (S / 8), t0 = (item % (S / 8)) * 8;
        for (int i = F.tid; i < 4096; i += 512) { const int q = i >> 9, e = i & 511; qi_s[i] = bf2f(P0[(size_t)(b * S + t0 + q) * P0_LD + C0_QI + e]); }
        if (F.tid < 64) { const int q = F.tid >> 3, h = F.tid & 7; wi_s[F.tid] = bf2f(P0[(size_t)(b * S + t0 + q) * P0_LD + C0_WI + h]) * (0.35355339059f * 0.125f); }
        __syncthreads();
        const int nk = t0 + 8;
        for (int s = F.tid; s < nk; s += 512) {
            float kf[64]; const bf16* kr = P0 + (size_t)(b * S + s) * P0_LD + C0_KI;
#pragma unroll
            for (int j = 0; j < 8; ++j) ld8bf(kr + 8 * j, kf + 8 * j);
#pragma unroll 1
            for (int q = 0; q < 8; ++q) { float a = 0.f;
#pragma unroll 1
                for (int h = 0; h < 8; ++h) { const LAS float* qp = qi_s + q * 512 + h * 64; float dot = 0.f;
#pragma unroll
                    for (int d = 0; d < 64; ++d) dot += qp[d] * kf[d];
                    a += wi_s[q * 8 + h] * fmaxf(dot, 0.f); }
                sc[q * 2048 + s] = a; }
        }
        __syncthreads();
        {
            const int q = F.wave, t = t0 + q, n = t + 1, row = b * S + t; unsigned myword = 0u;
            if (n <= 256) { const int cb = n - 32 * F.lane; myword = cb >= 32 ? 0xffffffffu : (cb <= 0 ? 0u : ((1u << cb) - 1u)); }
            else {
                LAS unsigned* uk = (LAS unsigned*)(sc + q * 2048);
#pragma unroll 4
                for (int i = 0; i < 32; ++i) { const int s = F.lane + 64 * i; const unsigned k = (s < n) ? fkey(sc[q * 2048 + s]) : 0u; uk[s] = k; }
                LDS_WAIT();
                unsigned prefix = 0u;
#pragma unroll 1
                for (int bit = 31; bit >= 0; --bit) { const unsigned cand = prefix | (1u << bit); int c = 0;
#pragma unroll 8
                    for (int i = 0; i < 32; ++i) c += (uk[F.lane + 64 * i] >= cand) ? 1 : 0;
#pragma unroll
                    for (int o = 1; o < 64; o <<= 1) c += __shfl_xor(c, o);
                    if (c >= 256) prefix = cand; }
                int cgt = 0;
#pragma unroll 8
                for (int i = 0; i < 32; ++i) cgt += (uk[F.lane + 64 * i] > prefix) ? 1 : 0;
#pragma unroll
                for (int o = 1; o < 64; o <<= 1) cgt += __shfl_xor(cgt, o);
                const int need = 256 - cgt; int run = 0;
#pragma unroll 1
                for (int i = 0; i < 32; ++i) { const unsigned u = uk[F.lane + 64 * i]; const bool eq = (u == prefix); const unsigned long long em = __ballot(eq); const int rank = run + __popcll(em & ((1ull << F.lane) - 1ull));
                    const bool sel = (u > prefix) || (eq && rank < need); run += __popcll(em);
                    const unsigned long long sm = __ballot(sel);
                    if (F.lane == 2 * i) myword = (unsigned)sm; if (F.lane == 2 * i + 1) myword = (unsigned)(sm >> 32); }
            }
            MASK[(size_t)row * 64 + F.lane] = myword;
        }
        __syncthreads();
    }
}

__device__ __forceinline__ void dsa_phase(const Frame& F) {
    bf16* P0 = (bf16*)(F.ws + WS_P0); const bf16* CN = (const bf16*)(F.ws + WS_CN); const unsigned* MASK = (const unsigned*)(F.ws + WS_MASK); const float* rel = F.in[I_REL];
    LAS float* ql = (LAS float*)(F.lds + F.wave * 13312); LAS float* pl = ql + 1024; LAS int* idx = (LAS int*)(pl + 2048);
    for (int row = F.gw; row < M; row += F.NGW) {
        const int b = row / S, t = row % S;
        const unsigned w = MASK[(size_t)row * 64 + F.lane]; const int c = __popc(w);
        int incl = c;
#pragma unroll
        for (int o = 1; o < 64; o <<= 1) { const int v = __shfl_up(incl, o); if (F.lane >= o) incl += v; }
        const int total = __shfl(incl, 63); int pos = incl - c; unsigned ww = w;
        while (ww) { const int bit = __ffs(ww) - 1; idx[pos++] = 32 * F.lane + bit; ww &= ww - 1u; }
#pragma unroll
        for (int i = 0; i < 16; ++i) ql[F.lane + 64 * i] = bf2f(P0[(size_t)row * P0_LD + C0_QLAT + F.lane + 64 * i]);
        WAVE_SYNC();
        float lg[4][8]; bool val[4];
#pragma unroll
        for (int kk = 0; kk < 4; ++kk) { const int k = F.lane + 64 * kk; val[kk] = k < total; const int key = val[kk] ? idx[k] : 0;
            float a[8];
#pragma unroll
            for (int h = 0; h < 8; ++h) a[h] = 0.f;
            const bf16* cr = CN + (size_t)(b * S + key) * 128;
#pragma unroll 1
            for (int j = 0; j < 16; ++j) { float cv[8]; ld8bf(cr + 8 * j, cv);
#pragma unroll
                for (int h = 0; h < 8; ++h)
#pragma unroll
                    for (int i = 0; i < 8; ++i) a[h] += ql[h * 128 + 8 * j + i] * cv[i]; }
            const int bk = rel_bucket(t - key);
#pragma unroll
            for (int h = 0; h < 8; ++h) lg[kk][h] = val[kk] ? (a[h] * 0.125f + rel[bk * 16 + h]) : -1.0e30f;
        }
#pragma unroll
        for (int h = 0; h < 8; ++h) { float m = fmaxf(fmaxf(lg[0][h], lg[1][h]), fmaxf(lg[2][h], lg[3][h])); m = wave_max(m);
            float e[4], s = 0.f;
#pragma unroll
            for (int kk = 0; kk < 4; ++kk) { e[kk] = val[kk] ? __expf(lg[kk][h] - m) : 0.f; s += e[kk]; }
            s = wave_sum(s); const float inv = 1.f / s;
#pragma unroll
            for (int kk = 0; kk < 4; ++kk) pl[h * 256 + F.lane + 64 * kk] = e[kk] * inv; }
        WAVE_SYNC();
        float a0[8], a1[8];
#pragma unroll
        for (int h = 0; h < 8; ++h) { a0[h] = 0.f; a1[h] = 0.f; }
        for (int k = 0; k < total; ++k) { const int key = idx[k]; const unsigned pr = *(const unsigned*)(CN + (size_t)(b * S + key) * 128 + 2 * F.lane); const float vx = bflo(pr), vy = bfhi(pr);
#pragma unroll
            for (int h = 0; h < 8; ++h) { const float p = pl[h * 256 + k]; a0[h] += p * vx; a1[h] += p * vy; } }
#pragma unroll
        for (int h = 0; h < 8; ++h) *(unsigned*)(P0 + (size_t)row * P0_LD + C0_QLAT + h * 128 + 2 * F.lane) = pk2(a0[h], a1[h]);
        WAVE_SYNC();
    }
}

template <int W, int NH, int GRPSZ, bool SINK, bool NSA>
__device__ __forceinline__ void banded_phase(const Frame& F, bf16* P, int ld, int cq, int ck, int cv, int relc0) {
    const float* rel = F.in[I_REL]; const float* sinks = F.in[I_EV_SINK];
    const bf16* OC = (const bf16*)(F.ws + WS_OCMP); const bf16* OS = (const bf16*)(F.ws + WS_OSLC);
    constexpr int NTG = S / 64;
    for (int it = F.gw; it < NB * NH * NTG; it += F.NGW) {
        const int tg = it % NTG, h = (it / NTG) % NH, b = it / (NTG * NH);
        const int t = tg * 64 + F.lane, row = b * S + t, kvh = h / GRPSZ;
        float q[64], acc[64];
        { const bf16* qr = P + (size_t)row * ld + cq + h * 64;
#pragma unroll
          for (int j = 0; j < 8; ++j) ld8bf(qr + 8 * j, q + 8 * j); }
#pragma unroll
        for (int d = 0; d < 64; ++d) acc[d] = 0.f;
        float m = SINK ? sinks[h] : -1.0e30f, l = SINK ? 1.f : 0.f;
#pragma unroll 1
        for (int j = 0; j < W; ++j) { const int s = t - j;
            const float bias = rel[rel_bucket(j) * 16 + relc0 + h];
            if (s >= 0) { const bf16* kr = P + (size_t)(b * S + s) * ld + ck + kvh * 64; float dot = 0.f;
#pragma unroll
                for (int jj = 0; jj < 8; ++jj) { float kf[8]; ld8bf(kr + 8 * jj, kf);
#pragma unroll
                    for (int i = 0; i < 8; ++i) dot += q[8 * jj + i] * kf[i]; }
                const float lgt = dot * 0.125f + bias, mn = fmaxf(m, lgt), corr = __expf(m - mn), p = __expf(lgt - mn);
                l = l * corr + p; m = mn;
                const bf16* vr = P + (size_t)(b * S + s) * ld + cv + kvh * 64;
#pragma unroll
                for (int jj = 0; jj < 8; ++jj) { float vf[8]; ld8bf(vr + 8 * jj, vf);
#pragma unroll
                    for (int i = 0; i < 8; ++i) acc[8 * jj + i] = acc[8 * jj + i] * corr + p * vf[i]; } } }
        const float inv = 1.f / l;
        float g0 = 0.f, g1 = 0.f, g2 = 1.f;
        if (NSA) { const bf16* gr = P + (size_t)row * ld + C1_GL + h * 3; g0 = 1.f / (1.f + __expf(-bf2f(gr[0]))); g1 = 1.f / (1.f + __expf(-bf2f(gr[1]))); g2 = 1.f / (1.f + __expf(-bf2f(gr[2]))); }
        bf16* orow = P + (size_t)row * ld + cq + h * 64;
#pragma unroll
        for (int jj = 0; jj < 8; ++jj) { float o[8];
#pragma unroll
            for (int i = 0; i < 8; ++i) o[i] = acc[8 * jj + i] * inv;
            if (NSA) { float c8[8], s8[8]; ld8bf(OC + (size_t)row * D + h * 64 + 8 * jj, c8); ld8bf(OS + (size_t)row * D + h * 64 + 8 * jj, s8);
#pragma unroll
                for (int i = 0; i < 8; ++i) o[i] = g0 * c8[i] + g1 * s8[i] + g2 * o[i]; }
            v4u w; w.x = pk2(o[0], o[1]); w.y = pk2(o[2], o[3]); w.z = pk2(o[4], o[5]); w.w = pk2(o[6], o[7]);
            *(v4u*)(orow + 8 * jj) = w; }
    }
}

__device__ __forceinline__ void xattn_phase(const Frame& F, const bf16* Q, const bf16* KV, bf16* O) {
    for (int it = F.gw; it < NB * 4 * (S / 32); it += F.NGW) {
        const int tg = it % (S / 32), h = (it / (S / 32)) % 4, b = it / ((S / 32) * 4);
        const int tok = tg * 32 + (F.lane >> 1), half = F.lane & 1, row = b * S + tok;
        float q[64], acc[64];
        { const bf16* qr = Q + (size_t)row * 512 + h * 128 + half * 64;
#pragma unroll
          for (int j = 0; j < 8; ++j) ld8bf(qr + 8 * j, q + 8 * j); }
#pragma unroll
        for (int d = 0; d < 64; ++d) acc[d] = 0.f;
        float m = -1.0e30f, l = 0.f;
#pragma unroll 1
        for (int mm = 0; mm < MEML; ++mm) { const bf16* kr = KV + (size_t)(b * MEML + mm) * 1024 + h * 128 + half * 64; float dot = 0.f;
#pragma unroll
            for (int jj = 0; jj < 8; ++jj) { float kf[8]; ld8bf(kr + 8 * jj, kf);
#pragma unroll
                for (int i = 0; i < 8; ++i) dot += q[8 * jj + i] * kf[i]; }
            dot += __shfl_xor(dot, 1);
            const float lgt = dot * 0.08838834764831845f, mn = fmaxf(m, lgt), corr = __expf(m - mn), p = __expf(lgt - mn);
            l = l * corr + p; m = mn;
            const bf16* vr = kr + 512;
#pragma unroll
            for (int jj = 0; jj < 8; ++jj) { float vf[8]; ld8bf(vr + 8 * jj, vf);
#pragma unroll
                for (int i = 0; i < 8; ++i) acc[8 * jj + i] = acc[8 * jj + i] * corr + p * vf[i]; } }
        const float inv = 1.f / l; bf16* orow = O + (size_t)row * 512 + h * 128 + half * 64;
#pragma unroll
        for (int jj = 0; jj < 8; ++jj) { v4u w; w.x = pk2(acc[8 * jj] * inv, acc[8 * jj + 1] * inv); w.y = pk2(acc[8 * jj + 2] * inv, acc[8 * jj + 3] * inv); w.z = pk2(acc[8 * jj + 4] * inv, acc[8 * jj + 5] * inv); w.w = pk2(acc[8 * jj + 6] * inv, acc[8 * jj + 7] * inv);
            *(v4u*)(orow + 8 * jj) = w; }
    }
}

__device__ __forceinline__ float gelu_tanh(float x) { const float u = 0.7978845608028654f * (x + 0.044715f * x * x * x); return 0.5f * x * (1.f + tanhf(u)); }
__device__ __forceinline__ void cmp_mlp_phase(const Frame& F) {
    const bf16* P1 = (const bf16*)(F.ws + WS_P1);
    LAS float* blk = (LAS float*)F.lds; LAS float* part = blk + 2048; LAS float* hid = part + 512;
    for (int item = blockIdx.x; item < 2 * NB * NCMP * 2; item += F.G) {
        const int g = item & 1, n = (item >> 1) % NCMP, b = ((item >> 1) / NCMP) % NB, which = (item >> 1) / (NCMP * NB);
        const float* pe = which ? F.in[I_OD_PEV] : F.in[I_OD_PEK]; const float* w1 = which ? F.in[I_OD_W1V] : F.in[I_OD_W1K]; const float* w2 = which ? F.in[I_OD_W2V] : F.in[I_OD_W2K];
        float* outp = (float*)(F.ws + (which ? WS_VC : WS_KC)) + ((size_t)(b * NCMP + n) * 2 + g) * 64;
        const int col0 = (which ? C1_VC : C1_KC) + g * 64;
        for (int i = F.tid; i < 2048; i += 512) { const int l = i >> 6, d = i & 63; blk[i] = bf2f(P1[(size_t)(b * S + 16 * n + l) * P1_LD + col0 + d]) + pe[i]; }
        __syncthreads();
        { const int j = F.tid & 127, pp = F.tid >> 7; float a = 0.f; const float* wp = w1 + (size_t)(pp * 512) * 128 + j; const LAS float* bp = blk + pp * 512;
#pragma unroll 8
          for (int kk = 0; kk < 512; ++kk) a += bp[kk] * wp[(size_t)kk * 128];
          part[F.tid] = a; }
        __syncthreads();
        if (F.tid < 128) hid[F.tid] = gelu_tanh((part[F.tid] + part[F.tid + 128]) + (part[F.tid + 256] + part[F.tid + 384]));
        __syncthreads();
        if (F.tid < 64) { float a = 0.f;
#pragma unroll 8
            for (int j = 0; j < 128; ++j) a += hid[j] * w2[j * 64 + F.tid];
            outp[F.tid] = a; }
        __syncthreads();
    }
}

__device__ __forceinline__ void cmp_attn_phase(const Frame& F) {
    const bf16* P1 = (const bf16*)(F.ws + WS_P1); const float* KC = (const float*)(F.ws + WS_KC); const float* VC = (const float*)(F.ws + WS_VC);
    bf16* OC = (bf16*)(F.ws + WS_OCMP); unsigned* SELM = (unsigned*)(F.ws + WS_SELM); const float* rel = F.in[I_REL];
    LAS float* qs = (LAS float*)(F.lds + F.wave * 8192); LAS float* pl = qs + 512; LAS float* psum = pl + 1024;
    for (int it = F.gw; it < M * 2; it += F.NGW) {
        const int g = it & 1, row = it >> 1, b = row / S, t = row % S;
        const int nv = (t >= 31) ? ((t - 31) / 16 + 1) : 0;
#pragma unroll
        for (int i = 0; i < 8; ++i) qs[F.lane + 64 * i] = bf2f(P1[(size_t)row * P1_LD + C1_Q + g * 512 + F.lane + 64 * i]);
        WAVE_SYNC();
        float lg[2][8]; bool val[2];
#pragma unroll
        for (int kk = 0; kk < 2; ++kk) { const int n = F.lane + 64 * kk; val[kk] = n < nv; const int nn = val[kk] ? n : 0;
            const float* kr = KC + ((size_t)(b * NCMP + nn) * 2 + g) * 64; float a[8];
#pragma unroll
            for (int h = 0; h < 8; ++h) a[h] = 0.f;
#pragma unroll 1
            for (int j = 0; j < 16; ++j) { const f32x4 kv = *(const f32x4*)(kr + 4 * j);
#pragma unroll
                for (int h = 0; h < 8; ++h) a[h] += qs[h * 64 + 4 * j] * kv.x + qs[h * 64 + 4 * j + 1] * kv.y + qs[h * 64 + 4 * j + 2] * kv.z + qs[h * 64 + 4 * j + 3] * kv.w; }
            const int bk = rel_bucket(val[kk] ? (t - (16 * nn + 31)) : 0);
#pragma unroll
            for (int h = 0; h < 8; ++h) lg[kk][h] = val[kk] ? (a[h] * 0.125f + rel[bk * 16 + g * 8 + h]) : -1.0e30f; }
        float ps[2] = {0.f, 0.f};
#pragma unroll
        for (int h = 0; h < 8; ++h) { float m = wave_max(fmaxf(lg[0][h], lg[1][h]));
            float e0 = val[0] ? __expf(lg[0][h] - m) : 0.f, e1 = val[1] ? __expf(lg[1][h] - m) : 0.f;
            const float s = wave_sum(e0 + e1); const float inv = (nv > 0) ? 1.f / s : 0.f; e0 *= inv; e1 *= inv;
            pl[h * 128 + F.lane] = e0; pl[h * 128 + 64 + F.lane] = e1; ps[0] += e0; ps[1] += e1; }
        psum[F.lane] = ps[0]; psum[64 + F.lane] = ps[1];
        WAVE_SYNC();
        float scj = -3.0e38f; bool adm = false;
        if (F.lane < 32) { const int j = F.lane; float p = 0.f;
#pragma unroll
            for (int n = 4 * j - 1; n <= 4 * j + 3; ++n) if (n >= 0 && n < NCMP) p += psum[n];
            const int blkq = t >> 6; adm = (64 * j <= t); const bool forced = (j == 0) || (j == blkq) || (j == blkq - 1);
            scj = adm ? (p + (forced ? 1.0e6f : 0.f)) : -1.0e30f; }
        int rank = 0;
#pragma unroll 1
        for (int i = 0; i < 32; ++i) { const float si = __shfl(scj, i); rank += (si > scj || (si == scj && i < F.lane)) ? 1 : 0; }
        const unsigned long long sm = __ballot(F.lane < 32 && adm && rank < 8);
        if (F.lane == 0) SELM[(size_t)row * 2 + g] = (unsigned)sm;
        float o[8];
#pragma unroll
        for (int h = 0; h < 8; ++h) o[h] = 0.f;
        for (int n = 0; n < nv; ++n) { const float v = VC[((size_t)(b * NCMP + n) * 2 + g) * 64 + F.lane];
#pragma unroll
            for (int h = 0; h < 8; ++h) o[h] += pl[h * 128 + n] * v; }
#pragma unroll
        for (int h = 0; h < 8; ++h) OC[(size_t)row * D + (g * 8 + h) * 64 + F.lane] = (bf16)f2bf(o[h]);
        WAVE_SYNC();
    }
}

__device__ __forceinline__ void slc_attn_phase(const Frame& F) {
    const bf16* P1 = (const bf16*)(F.ws + WS_P1); const unsigned* SELM = (const unsigned*)(F.ws + WS_SELM); bf16* OS = (bf16*)(F.ws + WS_OSLC); const float* rel = F.in[I_REL];
    LAS float* qs = (LAS float*)(F.lds + F.wave * 4096); LAS float* pb = qs + 512;
    for (int it = F.gw; it < M * 2; it += F.NGW) {
        const int g = it & 1, row = it >> 1, b = row / S, t = row % S;
#pragma unroll
        for (int i = 0; i < 8; ++i) qs[F.lane + 64 * i] = bf2f(P1[(size_t)row * P1_LD + C1_Q + g * 512 + F.lane + 64 * i]);
        WAVE_SYNC();
        unsigned sel = SELM[(size_t)row * 2 + g];
        float m[8], l[8], acc[8];
#pragma unroll
        for (int h = 0; h < 8; ++h) { m[h] = -1.0e30f; l[h] = 0.f; acc[h] = 0.f; }
        while (sel) { const int jb = __ffs(sel) - 1; sel &= sel - 1u;
            const int kpos = 64 * jb + F.lane; const bool valid = kpos <= t;
            const bf16* kr = P1 + (size_t)(b * S + kpos) * P1_LD + C1_KS + g * 64; float a[8];
#pragma unroll
            for (int h = 0; h < 8; ++h) a[h] = 0.f;
#pragma unroll 1
            for (int j = 0; j < 8; ++j) { float kf[8]; ld8bf(kr + 8 * j, kf);
#pragma unroll
                for (int h = 0; h < 8; ++h)
#pragma unroll
                    for (int i = 0; i < 8; ++i) a[h] += qs[h * 64 + 8 * j + i] * kf[i]; }
            const int bk = rel_bucket(valid ? (t - kpos) : 0);
            float corr[8];
#pragma unroll
            for (int h = 0; h < 8; ++h) { const float lgt = valid ? (a[h] * 0.125f + rel[bk * 16 + g * 8 + h]) : -1.0e30f;
                const float bm = wave_max(lgt), mn = fmaxf(m[h], bm); corr[h] = __expf(m[h] - mn); const float p = valid ? __expf(lgt - mn) : 0.f;
                l[h] = l[h] * corr[h] + wave_sum(p); m[h] = mn; pb[h * 64 + F.lane] = p; }
            WAVE_SYNC();
            const bf16* vb = P1 + (size_t)(b * S + 64 * jb) * P1_LD + C1_VS + g * 64 + F.lane;
            float add[8];
#pragma unroll
            for (int h = 0; h < 8; ++h) add[h] = 0.f;
            for (int k = 0; k < 64; ++k) { const float v = bf2f(vb[(size_t)k * P1_LD]);
#pragma unroll
                for (int h = 0; h < 8; ++h) add[h] += pb[h * 64 + k] * v; }
#pragma unroll
            for (int h = 0; h < 8; ++h) acc[h] = acc[h] * corr[h] + add[h];
            WAVE_SYNC();
        }
#pragma unroll
        for (int h = 0; h < 8; ++h) OS[(size_t)row * D + (g * 8 + h) * 64 + F.lane] = (bf16)f2bf(acc[h] / l[h]);
    }
}

constexpr int NPHASE = 34;
__global__ void __launch_bounds__(NWAVES * 64, 2) skel_fwd(Args args) {
    extern __shared__ __attribute__((aligned(16))) unsigned char lds[];
    Frame F;
    F.lds = (LAS unsigned char*)lds; F.ws = args.ws; F.acc = args.out; F.in = args.in;
    F.tid = threadIdx.x; F.lane = F.tid & 63; F.wave = __builtin_amdgcn_readfirstlane(F.tid >> 6);
    F.G = gridDim.x; F.gw = blockIdx.x * NWAVES + F.wave; F.NGW = F.G * NWAVES;
    volatile LAS unsigned* MISC = (volatile LAS unsigned*)(F.lds + MISC_OFF);
    for (int u = F.tid; u < (LDS_BYTES - LDSCTL_OFF) / 4; u += NWAVES * 64) ((LAS unsigned*)(F.lds + LDSCTL_OFF))[u] = 0u;
    __syncthreads();
    unsigned* ctl = (unsigned*)(args.ws + WS_CTL);
    XcdBarrier bar; bar.bar = ctl + CW_BAR; bar.x = 0; bar.st = nullptr;
    const int lo = args.ph_lo, hi = args.ph_hi;
    if (hi - lo > 1) {
        bar = xcd_barrier_post(ctl + CW_BAR, MISC + 8);
        if (threadIdx.x == 0) { unsigned nloc, nx; xcd_barrier_complete(ctl + CW_BAR, bar.x, nloc, nx); MISC[8] = nloc; MISC[9] = nx; }
        __syncthreads();
    }
#ifndef PH_LO
#define PH_LO 0
#define PH_HI 99
#endif
#define IN(k) ((k) >= PH_LO && (k) < PH_HI && lo <= (k) && (k) < hi && fresh(F))
#define SEAM(k) do { if (IN(k) && IN((k) + 1)) xcd_barrier(bar); } while (0)
    unsigned char* ws = args.ws;
    const int bx = blockIdx.x;

    if (IN(0)) { prologue(F); } SEAM(0);
    if (IN(1)) {
        { pg8::StaticSched<256 * 2048, 256 * 2048> Sd{(const char*)(ws + WS_HB), (const char*)(ws + W_IN0), M / 256, P0_LD / 256, F.G, bx, F.wave};
          pg8::EpiBf16 E{(bf16*)(ws + WS_P0), P0_LD}; pg8::gemm_phase<1024, 2048, 2048>(F.lds, Sd, E); }
        for (int i = 0; i < 2; ++i) {
          pg8::StaticSched<256 * 2048, 256 * 2048> Sd{(const char*)(ws + WS_MEMB), (const char*)(ws + W_XKV + (size_t)i * 1024 * 1024 * 2), MMEM / 256, 4, F.G, (bx + 128 * (i + 1)) % F.G, F.wave};
          pg8::EpiBf16 E{(bf16*)(ws + WS_XKV + (size_t)i * MMEM * 1024 * 2), 1024}; pg8::gemm_phase<1024, 2048, 2048>(F.lds, Sd, E); }
    } SEAM(1);
    if (IN(2)) { cn_phase(F); idx_phase(F); banded_phase<128, 8, 4, true, false>(F, (bf16*)(ws + WS_P0), P0_LD, C0_QB, C0_KB, C0_VB, 8); } SEAM(2);
    if (IN(3)) { dsa_phase(F); } SEAM(3);
    if (IN(4)) { pg8::StaticSched<256 * P0_LD * 2, 256 * 1536 * 2> Sd{(const char*)(ws + WS_P0), (const char*)(ws + W_OUT0), M / 256, 4, F.G, bx, F.wave};
                 pg8::EpiAcc E{F.acc, D}; pg8::gemm_phase<1536, P0_LD * 2, 1536 * 2>(F.lds, Sd, E); } SEAM(4);
    if (IN(5)) { ln_phase<0>(F, 0); } SEAM(5);
    if (IN(6)) { pg8::StaticSched<256 * 2048, 256 * 2048> Sd{(const char*)(ws + WS_HB), (const char*)(ws + W_XQ), M / 256, 2, F.G, bx, F.wave};
                 pg8::EpiBf16 E{(bf16*)(ws + WS_QX0), 512}; pg8::gemm_phase<1024, 2048, 2048>(F.lds, Sd, E); } SEAM(6);
    if (IN(7)) { xattn_phase(F, (const bf16*)(ws + WS_QX0), (const bf16*)(ws + WS_XKV), (bf16*)(ws + WS_OX0)); } SEAM(7);
    if (IN(8)) { pg8::StaticSched<256 * 1024, 256 * 1024> Sd{(const char*)(ws + WS_OX0), (const char*)(ws + W_XO), M / 256, 4, F.G, bx, F.wave};
                 pg8::EpiAcc E{F.acc, D}; pg8::gemm_phase<512, 1024, 1024>(F.lds, Sd, E); } SEAM(8);
    if (IN(9)) { ln_phase<0>(F, 1); } SEAM(9);
    if (IN(10)) { pg8::StaticSched<256 * 2048, 256 * 2048> Sd{(const char*)(ws + WS_HB), (const char*)(ws + W_FGU), M / 256, 2 * DFF / 256, F.G, bx, F.wave};
                  pg8::EpiSwiglu E{(bf16*)(ws + WS_HID), DFF, 0}; pg8::gemm_phase<1024, 2048, 2048>(F.lds, Sd, E); } SEAM(10);
    if (IN(11)) { pg8::StaticSched<256 * DFF * 2, 256 * DFF * 2> Sd{(const char*)(ws + WS_HID), (const char*)(ws + W_FD), M / 256, 4, F.G, bx, F.wave};
                  pg8::EpiAcc E{F.acc, D}; pg8::gemm_phase<DFF, DFF * 2, DFF * 2>(F.lds, Sd, E); } SEAM(11);
    if (IN(12)) { ln_phase<0>(F, 2); } SEAM(12);
    if (IN(13)) { pg8::StaticSched<256 * 2048, 256 * 2048> Sd{(const char*)(ws + WS_HB), (const char*)(ws + W_IN1), M / 256, P1_LD / 256, F.G, bx, F.wave};
                  pg8::EpiBf16 E{(bf16*)(ws + WS_P1), P1_LD}; pg8::gemm_phase<1024, 2048, 2048>(F.lds, Sd, E); } SEAM(13);
    if (IN(14)) { cmp_mlp_phase(F); } SEAM(14);
    if (IN(15)) { cmp_attn_phase(F); } SEAM(15);
    if (IN(16)) { slc_attn_phase(F); } SEAM(16);
    if (IN(17)) { banded_phase<512, 16, 8, false, true>(F, (bf16*)(ws + WS_P1), P1_LD, C1_Q, C1_KW, C1_VW, 0); } SEAM(17);
    if (IN(18)) { pg8::StaticSched<256 * P1_LD * 2, 256 * 2048> Sd{(const char*)(ws + WS_P1), (const char*)(ws + W_OUT1), M / 256, 4, F.G, bx, F.wave};
                  pg8::EpiAcc E{F.acc, D}; pg8::gemm_phase<1024, P1_LD * 2, 2048>(F.lds, Sd, E); } SEAM(18);
    if (IN(19)) { ln_phase<0>(F, 3); } SEAM(19);
    if (IN(20)) { pg8::StaticSched<256 * 2048, 256 * 2048> Sd{(const char*)(ws + WS_HB), (const char*)(ws + W_XQ + (size_t)512 * 1024 * 2), M / 256, 2, F.G, bx, F.wave};
                  pg8::EpiBf16 E{(bf16*)(ws + WS_QX1), 512}; pg8::gemm_phase<1024, 2048, 2048>(F.lds, Sd, E); } SEAM(20);
    if (IN(21)) { xattn_phase(F, (const bf16*)(ws + WS_QX1), (const bf16*)(ws + WS_XKV + (size_t)MMEM * 1024 * 2), (bf16*)(ws + WS_OX1)); } SEAM(21);
    if (IN(22)) { pg8::StaticSched<256 * 1024, 256 * 1024> Sd{(const char*)(ws + WS_OX1), (const char*)(ws + W_XO + (size_t)1024 * 512 * 2), M / 256, 4, F.G, bx, F.wave};
                  pg8::EpiAcc E{F.acc, D}; pg8::gemm_phase<512, 1024, 1024>(F.lds, Sd, E); } SEAM(22);
    if (IN(23)) { ln_phase<1>(F, 4); } SEAM(23);
    if (IN(24)) { moe_dispatch(F); } SEAM(24);
#pragma unroll 1
    for (int ch = 0; ch < 4; ++ch) {
        const int pa = 25 + 2 * ch, pb = 26 + 2 * ch;
        const int* tile_exp = (const int*)(ws + WS_TILEEXP);
        if (IN(pa) || IN(pb)) {
            const int slot = ch >> 1; const int s0 = tile_exp[512 + slot], s1 = tile_exp[512 + slot + 1];
            int t0 = s0 + (ch & 1) * MOE_CHUNK_TILES, t1 = (ch & 1) ? s1 : (s0 + MOE_CHUNK_TILES < s1 ? s0 + MOE_CHUNK_TILES : s1);
            if (t0 > s1) t0 = s1; int nT = t1 - t0; if (nT < 0) nT = 0; if (nT > MOE_CHUNK_TILES) nT = MOE_CHUNK_TILES;
            if (IN(pa)) { pg8::MoeSched<WS_PERMA, W_MGU, 256 * 2048, 256 * 2048, (size_t)7168 * 2048, 0> Sd{ws, t0, nT, 2 * DFFE / 256, F.G, bx, F.wave};
                          pg8::EpiSwiglu E{(bf16*)(ws + WS_HIDM), DFFE, 1}; pg8::gemm_phase<1024, 2048, 2048>(F.lds, Sd, E); }
            if (IN(pa) && IN(pb)) xcd_barrier(bar);
            if (IN(pb)) { pg8::MoeSched<WS_HIDM, W_MD, 256 * DFFE * 2, 256 * DFFE * 2, (size_t)1024 * DFFE * 2, 1> Sd{ws, t0, nT, 4, F.G, bx, F.wave};
                          pg8::EpiMoeDown E{F.acc, ws}; pg8::gemm_phase<DFFE, DFFE * 2, DFFE * 2>(F.lds, Sd, E); }
            if (IN(pb) && IN(pb + 1)) xcd_barrier(bar);
        }
    }
    if (IN(33)) { ln_phase<2>(F, 5); }
#undef IN
#undef SEAM
}

extern "C" void kernel_launch(void* const* d_in, const int* in_sizes, int n_in, void* d_out, int out_size, void* d_ws, size_t ws_size, hipStream_t stream) {
    static int grid = 0;
    if (grid == 0) {
        if (n_in != 30 || out_size != M * D || ws_size < WS_END) { fprintf(stderr, "kernel_launch: unexpected shapes (n_in %d, out %d, ws %zu < %zu); nothing launched\n", n_in, out_size, ws_size, (size_t)WS_END); grid = -1; return; }
        int dev = 0, cus = 0, per_cu = 0;
        if (hipGetDevice(&dev) != hipSuccess || hipDeviceGetAttribute(&cus, hipDeviceAttributeMultiprocessorCount, dev) != hipSuccess) { grid = -1; return; }
        if (hipFuncSetAttribute((const void*)skel_fwd, hipFuncAttributeMaxDynamicSharedMemorySize, LDS_BYTES) != hipSuccess) { fprintf(stderr, "kernel_launch: hipFuncSetAttribute failed\n"); grid = -1; return; }
        if (hipOccupancyMaxActiveBlocksPerMultiprocessor(&per_cu, (const void*)skel_fwd, NWAVES * 64, LDS_BYTES) != hipSuccess || per_cu < 1)
            fprintf(stderr, "kernel_launch: occupancy query reports %d workgroups per CU\n", per_cu);
        (void)hipGetLastError();
        grid = cus;
    }
    if (grid < 0) return;
    if (hipMemsetAsync((char*)d_ws + WS_CTL, 0, CTL_ZERO_BYTES, stream) != hipSuccess) return;
    Args a{};
    for (int i = 0; i < 30; ++i) a.in[i] = (const float*)d_in[i];
    a.out = (float*)d_out; a.ws = (unsigned char*)d_ws;
#if MK_ONE_LAUNCH
    a.ph_lo = 0; a.ph_hi = NPHASE;
    hipLaunchKernelGGL(skel_fwd, dim3(grid), dim3(NWAVES * 64), LDS_BYTES, stream, a);
#else
    for (int p = 0; p < NPHASE; ++p) { a.ph_lo = p; a.ph_hi = p + 1; hipLaunchKernelGGL(skel_fwd, dim3(grid), dim3(NWAVES * 64), LDS_BYTES, stream, a); }
#endif
}
```

```cpp
#include <hip/hip_runtime.h>
#include <cstdio>
#include <cstdint>

#ifndef MK_ONE_LAUNCH
#define MK_ONE_LAUNCH 1
#endif

constexpr size_t ROWTOK_OFF = 5u * 1048576u + 512u * 1024u, ROWW_OFF = 6u * 1048576u, TILEEXP_OFF = 6u * 1048576u + 512u * 1024u, DUMMY_OFF = 7u * 1048576u;
namespace pg8 {
#define PG8_LAS __attribute__((address_space(3)))
typedef unsigned short bf16_t;
typedef short bf16x8 __attribute__((ext_vector_type(8)));
typedef float f32x4 __attribute__((ext_vector_type(4)));
typedef unsigned u32x4 __attribute__((ext_vector_type(4)));
constexpr int BM = 256, BK = 64, HALF = 128, HTB = HALF * BK * 2, STAGE_BYTES = 8 * HTB, NXCD = 8, WGM = 8;

__host__ __device__ __forceinline__ int lds_byte(int r, int c) { const int st = (r >> 4) * 2 + (c >> 5), rr = r & 15, cc = c & 31, ob = rr * 64 + cc * 2; return st * 1024 + (ob ^ (((ob >> 9) & 1) << 5)); }
__host__ __device__ __forceinline__ void stage_rc(int b, int& R, int& C) { const int st = b / 1024, sb = b % 1024, swz = sb ^ (((sb >> 9) & 1) << 5); R = (st >> 1) * 16 + swz / 64; C = (st & 1) * 32 + (swz % 64) / 2; }
__host__ __device__ __forceinline__ int perm32(int rho) { const int n = rho >> 4, i = rho & 15; return 8 * (i >> 2) + 4 * n + (i & 3); }

__device__ __forceinline__ const void* opaque_uniform(const void* p) {
    unsigned lo = __builtin_amdgcn_readfirstlane((unsigned)(unsigned long long)p), hi = __builtin_amdgcn_readfirstlane((unsigned)((unsigned long long)p >> 32));
    asm volatile("" : "+s"(lo), "+s"(hi)); return (const void*)(((unsigned long long)hi << 32) | lo); }
struct Unit { int pm, pn, aux; const char* a; const char* b; };

__device__ __forceinline__ void tile_of(int wgid, int nM, int nN, int& pm, int& pn) {
    const int nwg = nM * nN;
    { const int q = nwg / NXCD, r = nwg % NXCD, xcd = wgid % NXCD, off = wgid / NXCD; wgid = (xcd < r ? xcd * (q + 1) : r * (q + 1) + (xcd - r) * q) + off; }
    const int nig = WGM * nN, gid = wgid / nig, fm = gid * WGM, gsz = (nM - fm) < WGM ? (nM - fm) : WGM;
    pm = fm + ((wgid % nig) % gsz); pn = (wgid % nig) / gsz;
}
template <size_t A_TILE, size_t B_TILE>
struct StaticSched {
    const char* A; const char* B; int nM, nN, G, c, wave;
    __device__ __forceinline__ bool next(int i, Unit& u) const {
        const long L = (long)i * G + c; if (L >= (long)nM * nN) return false;
        int pm, pn; tile_of((int)L, nM, nN, pm, pn);
        u.pm = pm; u.pn = pn; u.aux = 0; u.a = A + (size_t)pm * A_TILE; u.b = B + (size_t)pn * B_TILE; return true;
    }
};
template <size_t A_OFF, size_t B_OFF, size_t A_TILE, size_t B_TILE, size_t B_EXP, int A_LOCAL>
struct MoeSched {
    const unsigned char* ws; int t0, nT, nN, G, c, wave;
    __device__ __forceinline__ bool next(int i, Unit& u) const {
        const long L = (long)i * G + c; if (L >= (long)nT * nN) return false;
        int pml, pn; tile_of((int)L, nT, nN, pml, pn);
        const unsigned char* wsb = (const unsigned char*)opaque_uniform(ws);
        const int pm = t0 + pml; const int e = __builtin_amdgcn_readfirstlane(((const int*)(wsb + TILEEXP_OFF))[pm]);
        u.pm = pm; u.pn = pn; u.aux = pml; u.a = (const char*)wsb + A_OFF + (size_t)(A_LOCAL ? pml : pm) * A_TILE; u.b = (const char*)wsb + B_OFF + (size_t)e * B_EXP + (size_t)pn * B_TILE; return true;
    }
};

__device__ __forceinline__ unsigned cvt_pk_bf16(float lo, float hi) { unsigned r; asm volatile("v_cvt_pk_bf16_f32 %0, %1, %2" : "=v"(r) : "v"(lo), "v"(hi)); return r; }

struct EpiBf16 {
    static constexpr bool PERM = true;
    bf16_t* O; int ldc;
    __device__ __forceinline__ void operator()(const f32x4 (&acc)[2][2][4][2], const Unit& u, int wr, int wc, int fr, int fq) const {
        const int row0 = u.pm * BM + wr * 64 + fr, col0 = u.pn * BM + wc * 32 + 8 * fq;
#pragma unroll
        for (int ai = 0; ai < 2; ++ai)
#pragma unroll
            for (int m = 0; m < 4; ++m) { bf16_t* rowp = O + (size_t)(row0 + ai * HALF + m * 16) * ldc + col0;
#pragma unroll
                for (int bj = 0; bj < 2; ++bj) { const f32x4 v0 = acc[ai][bj][m][0], v1 = acc[ai][bj][m][1];
                    u32x4 w; w.x = cvt_pk_bf16(v0[0], v0[1]); w.y = cvt_pk_bf16(v0[2], v0[3]); w.z = cvt_pk_bf16(v1[0], v1[1]); w.w = cvt_pk_bf16(v1[2], v1[3]);
                    *(u32x4*)(rowp + bj * HALF) = w; } }
    }
};
struct EpiAcc {
    static constexpr bool PERM = false;
    float* C; int ldc;
    __device__ __forceinline__ void operator()(const f32x4 (&acc)[2][2][4][2], const Unit& u, int wr, int wc, int fr, int fq) const {
        const int row0 = u.pm * BM + wr * 64 + fr, col0 = u.pn * BM + wc * 32 + 4 * fq;
#pragma unroll
        for (int ai = 0; ai < 2; ++ai)
#pragma unroll
            for (int m = 0; m < 4; ++m) { float* rowp = C + (size_t)(row0 + ai * HALF + m * 16) * ldc + col0;
                f32x4 o[2][2];
#pragma unroll
                for (int bj = 0; bj < 2; ++bj)
#pragma unroll
                    for (int n = 0; n < 2; ++n) o[bj][n] = *(const f32x4*)(rowp + bj * HALF + n * 16);
#pragma unroll
                for (int bj = 0; bj < 2; ++bj)
#pragma unroll
                    for (int n = 0; n < 2; ++n) *(f32x4*)(rowp + bj * HALF + n * 16) = o[bj][n] + acc[ai][bj][m][n]; }
    }
};
__device__ __forceinline__ float silu_f(float x) { return x / (1.0f + __expf(-x)); }
struct EpiSwiglu {
    static constexpr bool PERM = true;
    bf16_t* O; int ldc; int row_local;
    __device__ __forceinline__ void operator()(const f32x4 (&acc)[2][2][4][2], const Unit& u, int wr, int wc, int fr, int fq) const {
        const int row0 = (row_local ? u.aux : u.pm) * BM + wr * 64 + fr, col0 = u.pn * HALF + wc * 32 + 8 * fq;
#pragma unroll
        for (int ai = 0; ai < 2; ++ai)
#pragma unroll
            for (int m = 0; m < 4; ++m) { bf16_t* rowp = O + (size_t)(row0 + ai * HALF + m * 16) * ldc + col0;
                const f32x4 g0 = acc[ai][0][m][0], g1 = acc[ai][0][m][1], u0 = acc[ai][1][m][0], u1 = acc[ai][1][m][1];
                float h[8];
#pragma unroll
                for (int j = 0; j < 4; ++j) { h[j] = silu_f(g0[j]) * u0[j]; h[4 + j] = silu_f(g1[j]) * u1[j]; }
                u32x4 w; w.x = cvt_pk_bf16(h[0], h[1]); w.y = cvt_pk_bf16(h[2], h[3]); w.z = cvt_pk_bf16(h[4], h[5]); w.w = cvt_pk_bf16(h[6], h[7]);
                *(u32x4*)rowp = w; }
    }
};
struct EpiMoeDown {
    static constexpr bool PERM = false;
    float* C; unsigned char* ws;
    __device__ __forceinline__ void operator()(const f32x4 (&acc)[2][2][4][2], const Unit& u, int wr, int wc, int fr, int fq) const {
        const int row0 = u.pm * BM + wr * 64 + fr, col0 = u.pn * BM + wc * 32 + 4 * fq;
        unsigned char* wsb = (unsigned char*)opaque_uniform(ws);
        const int* rowtok = (const int*)(wsb + ROWTOK_OFF); const float* roww = (const float*)(wsb + ROWW_OFF); float* dummy = (float*)(wsb + DUMMY_OFF);
#pragma unroll
        for (int ai = 0; ai < 2; ++ai)
#pragma unroll
            for (int m = 0; m < 4; ++m) { const int r = row0 + ai * HALF + m * 16; const int tok = rowtok[r]; const float w = roww[r];
                float* rowp = (tok >= 0 ? C + (size_t)tok * 1024 : dummy) + col0;
                f32x4 o[2][2];
#pragma unroll
                for (int bj = 0; bj < 2; ++bj)
#pragma unroll
                    for (int n = 0; n < 2; ++n) o[bj][n] = *(const f32x4*)(rowp + bj * HALF + n * 16);
#pragma unroll
                for (int bj = 0; bj < 2; ++bj)
#pragma unroll
                    for (int n = 0; n < 2; ++n) *(f32x4*)(rowp + bj * HALF + n * 16) = o[bj][n] + acc[ai][bj][m][n] * w; }
    }
};

template <int K, int lda_b, int ldb_b, class Epi, class Sched>
__device__ __forceinline__ void gemm_phase(PG8_LAS unsigned char* lds, const Sched& S, const Epi& E) {
    int tid_ = (int)__builtin_amdgcn_mbcnt_hi(~0u, __builtin_amdgcn_mbcnt_lo(~0u, 0u)); asm volatile("" : "+v"(tid_)); tid_ += S.wave * 64;
    const int tid = tid_, wid = __builtin_amdgcn_readfirstlane(tid >> 6), lane = tid & 63, wr = wid >> 2, wc = wid & 3, fr = lane & 15, fq = lane >> 4;
    constexpr int nt = K / BK;
    unsigned voffA[2], voffB[2];
#pragma unroll
    for (int i = 0; i < 2; ++i) { int R, C; stage_rc(tid * 16 + i * 8192, R, C); const int Rb = Epi::PERM ? ((R & ~31) + perm32(R & 31)) : R;
        voffA[i] = (unsigned)(R * lda_b + C * 2); voffB[i] = (unsigned)(Rb * ldb_b + C * 2); }
    const size_t kstep = (size_t)(BK * 2);
    const size_t hstepA = (size_t)HALF * lda_b, hstepB = (size_t)HALF * ldb_b;
    const unsigned ldsw = (unsigned)wid * 1024u;
    const int aoff = lds_byte(wr * 64 + fr, fq * 8), boff = lds_byte(wc * 32 + fr, fq * 8);
#define PG8_SA(b, h) (((b) * 2 + (h)) * HTB)
#define PG8_SB(b, h) ((4 + (b) * 2 + (h)) * HTB)
#define PG8_STAGE(bufoff, gbase, voff) do { _Pragma("unroll") for (int _i = 0; _i < 2; ++_i) \
        __builtin_amdgcn_global_load_lds((const unsigned*)((const char*)(gbase) + (voff)[_i]), (PG8_LAS unsigned*)(lds + (bufoff) + ldsw + _i * 8192), 16, 0, 0); } while (0)
#define PG8_LDA(dst, b, h) do { _Pragma("unroll") for (int m = 0; m < 4; ++m) _Pragma("unroll") for (int k = 0; k < 2; ++k) dst[m][k] = *(const PG8_LAS bf16x8*)(lds + PG8_SA(b, h) + aoff + m * 2048 + k * 1024); } while (0)
#define PG8_LDB(dst, b, h) do { _Pragma("unroll") for (int n = 0; n < 2; ++n) _Pragma("unroll") for (int k = 0; k < 2; ++k) dst[n][k] = *(const PG8_LAS bf16x8*)(lds + PG8_SB(b, h) + boff + n * 2048 + k * 1024); } while (0)
#define PG8_MMA(ai, bj, At, Bt) do { __builtin_amdgcn_s_setprio(1); _Pragma("unroll") for (int m = 0; m < 4; ++m) _Pragma("unroll") for (int n = 0; n < 2; ++n) _Pragma("unroll") for (int k = 0; k < 2; ++k) \
        acc[ai][bj][m][n] = __builtin_amdgcn_mfma_f32_16x16x32_bf16(Bt[n][k], At[m][k], acc[ai][bj][m][n], 0, 0, 0); __builtin_amdgcn_s_setprio(0); } while (0)
#define PG8_WAIT_V(n) asm volatile("s_waitcnt vmcnt(" #n ")" ::: "memory")
#define PG8_WAIT_L(n) asm volatile("s_waitcnt lgkmcnt(" #n ")" ::: "memory")
#define PG8_BAR __builtin_amdgcn_s_barrier()
#define PG8_SCHED __builtin_amdgcn_sched_barrier(0)
    Unit cur, nxt; int ui = 0;
    if (!S.next(0, cur)) return;
    f32x4 acc[2][2][4][2];
#pragma unroll
    for (int a = 0; a < 2; ++a)
#pragma unroll
        for (int b = 0; b < 2; ++b)
#pragma unroll
            for (int m = 0; m < 4; ++m)
#pragma unroll
                for (int n = 0; n < 2; ++n) acc[a][b][m][n] = (f32x4){0.f, 0.f, 0.f, 0.f};
    bf16x8 At[4][2], B0[2][2], B1[2][2];
    const char* cA = cur.a; const char* cB = cur.b;
    PG8_STAGE(PG8_SB(0, 0), cB, voffB); PG8_STAGE(PG8_SB(0, 1), cB + hstepB, voffB); PG8_STAGE(PG8_SA(0, 0), cA, voffA); PG8_STAGE(PG8_SA(0, 1), cA + hstepA, voffA);
    if (wr == 1) PG8_BAR;
    PG8_WAIT_V(2); PG8_BAR;
    PG8_STAGE(PG8_SB(1, 0), cB + kstep, voffB); PG8_STAGE(PG8_SA(1, 0), cA + kstep, voffA); PG8_STAGE(PG8_SB(1, 1), cB + hstepB + kstep, voffB);
    PG8_WAIT_V(6); PG8_BAR;
    for (;;) {
        const bool has_next = S.next(ui + 1, nxt);
        const char* nA = has_next ? nxt.a : cA; const char* nB = has_next ? nxt.b : cB;
        for (int t = 0; t < nt; t += 2) {
            const bool last = (t == nt - 2);
            const char* a1 = cA + (size_t)(t + 1) * kstep;
            const char* a2 = last ? nA : cA + (size_t)(t + 2) * kstep; const char* b2 = last ? nB : cB + (size_t)(t + 2) * kstep;
            const char* a3 = a2 + kstep; const char* b3 = b2 + kstep;
            PG8_LDB(B0, 0, 0); PG8_LDB(B1, 0, 1); PG8_SCHED; PG8_LDA(At, 0, 0); PG8_STAGE(PG8_SA(1, 1), a1 + hstepA, voffA);
            PG8_WAIT_V(8); PG8_WAIT_L(0); PG8_BAR; PG8_MMA(0, 0, At, B0); PG8_MMA(0, 1, At, B1); PG8_BAR; PG8_SCHED;
            PG8_LDA(At, 0, 1); PG8_STAGE(PG8_SB(0, 0), b2, voffB); PG8_STAGE(PG8_SB(0, 1), b2 + hstepB, voffB); PG8_STAGE(PG8_SA(0, 0), a2, voffA);
            PG8_WAIT_V(8); PG8_WAIT_L(0); PG8_BAR; PG8_MMA(1, 0, At, B0); PG8_MMA(1, 1, At, B1); PG8_BAR; PG8_SCHED;
            PG8_LDB(B0, 1, 0); PG8_LDB(B1, 1, 1); PG8_SCHED; PG8_LDA(At, 1, 0); PG8_STAGE(PG8_SA(0, 1), a2 + hstepA, voffA);
            PG8_WAIT_V(8); PG8_WAIT_L(0); PG8_BAR; PG8_MMA(0, 0, At, B0); PG8_MMA(0, 1, At, B1); PG8_BAR; PG8_SCHED;
            PG8_LDA(At, 1, 1); PG8_STAGE(PG8_SB(1, 0), b3, voffB); PG8_STAGE(PG8_SB(1, 1), b3 + hstepB, voffB); PG8_STAGE(PG8_SA(1, 0), a3, voffA);
            PG8_WAIT_V(8); PG8_WAIT_L(0); PG8_BAR; PG8_MMA(1, 0, At, B0); PG8_MMA(1, 1, At, B1); PG8_BAR; PG8_SCHED;
        }
        if (wr == 0) PG8_BAR;
        E(acc, cur, wr, wc, fr, fq);
        if (!has_next) break;
#pragma unroll
        for (int a = 0; a < 2; ++a)
#pragma unroll
            for (int b = 0; b < 2; ++b)
#pragma unroll
                for (int m = 0; m < 4; ++m)
#pragma unroll
                    for (int n = 0; n < 2; ++n) acc[a][b][m][n] = (f32x4){0.f, 0.f, 0.f, 0.f};
        cur = nxt; cA = nA; cB = nB; ++ui;
        if (wr == 1) PG8_BAR;
    }
    PG8_WAIT_V(0);
    PG8_BAR;
#undef PG8_SA
#undef PG8_SB
#undef PG8_STAGE
#undef PG8_LDA
#undef PG8_LDB
#undef PG8_MMA
#undef PG8_WAIT_V
#undef PG8_WAIT_L
#undef PG8_BAR
#undef PG8_SCHED
}
}

constexpr int NWAVES = 8;
constexpr int D = 1024, NB = 16, S = 2048, M = NB * S, MEML = 256, MMEM = NB * MEML;
constexpr float LN_EPS = 1e-5f, ALPHA = 1.41421356237f;
constexpr int P0_LD = 2560, C0_QLAT = 0, C0_QB = 1024, C0_CKV = 1536, C0_QI = 1664, C0_KI = 2176, C0_KB = 2240, C0_VB = 2368, C0_WI = 2496;
constexpr int P1_LD = 2048, C1_Q = 0, C1_KC = 1024, C1_VC = 1152, C1_KS = 1280, C1_VS = 1408, C1_KW = 1536, C1_VW = 1664, C1_GL = 1792;
constexpr int EVEN_COLS = 1992, ODD_COLS = 1840;
constexpr int DFF = 2816, DFFE = 3584, NE = 8, NCMP = 127;
constexpr int MOE_CHUNK_TILES = 68, MOE_MAX_TILES = 272;

constexpr size_t MiB = 1u << 20;
constexpr size_t WS_CTL = 0, CTL_ZERO_BYTES = 1 * MiB;
constexpr size_t WS_KC = 2 * MiB, WS_VC = 3 * MiB;
constexpr size_t WS_SELM = 4 * MiB;
constexpr size_t WS_RTE = 4 * MiB + 512 * 1024;
constexpr size_t WS_RTW = 5 * MiB;
constexpr size_t WS_ROWTOK = ROWTOK_OFF; static_assert(ROWTOK_OFF == 5 * MiB + 512 * 1024, "");
constexpr size_t WS_ROWW = ROWW_OFF;
constexpr size_t WS_TILEEXP = TILEEXP_OFF; constexpr size_t WS_DUMMY = DUMMY_OFF;
constexpr size_t WS_W = 8 * MiB;
constexpr size_t W_IN0 = WS_W;
constexpr size_t W_OUT0 = W_IN0 + (size_t)2560 * 1024 * 2;
constexpr size_t W_IN1 = W_OUT0 + (size_t)1024 * 1536 * 2;
constexpr size_t W_OUT1 = W_IN1 + (size_t)2048 * 1024 * 2;
constexpr size_t W_XQ = W_OUT1 + (size_t)1024 * 1024 * 2;
constexpr size_t W_XKV = W_XQ + (size_t)2 * 512 * 1024 * 2;
constexpr size_t W_XO = W_XKV + (size_t)2 * 1024 * 1024 * 2;
constexpr size_t W_FGU = W_XO + (size_t)2 * 1024 * 512 * 2;
constexpr size_t W_FD = W_FGU + (size_t)5632 * 1024 * 2;
constexpr size_t W_MGU = W_FD + (size_t)1024 * 2816 * 2;
constexpr size_t W_MD = W_MGU + (size_t)8 * 7168 * 1024 * 2;
constexpr size_t W_END = W_MD + (size_t)8 * 1024 * 3584 * 2;
static_assert(W_END <= 215 * MiB, "weights");
constexpr size_t WS_HB = 215 * MiB;
constexpr size_t WS_XKV = 279 * MiB;
constexpr size_t WS_SCR = 295 * MiB;
constexpr size_t WS_P0 = WS_SCR;
constexpr size_t WS_CN = WS_SCR + 160 * MiB;
constexpr size_t WS_MASK = WS_SCR + 168 * MiB;
constexpr size_t WS_MEMB = WS_SCR + 176 * MiB;
constexpr size_t WS_QX0 = WS_SCR + 184 * MiB, WS_OX0 = WS_SCR + 216 * MiB;
constexpr size_t WS_HID = WS_SCR;
constexpr size_t WS_P1 = WS_SCR;
constexpr size_t WS_OCMP = WS_SCR + 128 * MiB, WS_OSLC = WS_SCR + 192 * MiB;
constexpr size_t WS_QX1 = WS_SCR, WS_OX1 = WS_SCR + 32 * MiB;
constexpr size_t WS_PERMA = WS_SCR;
constexpr size_t WS_HIDM = WS_SCR + 136 * MiB;
constexpr size_t WS_END = WS_SCR + 256 * MiB;
static_assert(WS_HIDM + (size_t)MOE_CHUNK_TILES * 256 * DFFE * 2 <= WS_END, "ws");
constexpr int CW_BAR = 4096;
constexpr int CW_CNT = 16384;
constexpr int CW_CUR = 16384 + 64;

constexpr int RING_BYTES = 131072, LDSCTL_OFF = RING_BYTES, MISC_OFF = LDSCTL_OFF + 320, LDS_BYTES = 147456;

#define GAS __attribute__((address_space(1)))
#define LAS __attribute__((address_space(3)))
typedef unsigned short bf16;
typedef unsigned v4u __attribute__((ext_vector_type(4)));
typedef unsigned v2u __attribute__((ext_vector_type(2)));
typedef float f32x4 __attribute__((ext_vector_type(4)));
#define LDS_WAIT() asm volatile("s_waitcnt lgkmcnt(0)" ::: "memory")
#define WAVE_SYNC() asm volatile("s_waitcnt vmcnt(0) lgkmcnt(0)" ::: "memory")
__device__ __forceinline__ unsigned f2bf(float f) { unsigned u = __builtin_bit_cast(unsigned, f); return (u + 0x7fffu + ((u >> 16) & 1u)) >> 16; }
__device__ __forceinline__ unsigned pk2(float lo, float hi) { return f2bf(lo) | (f2bf(hi) << 16); }
__device__ __forceinline__ float bf2f(bf16 b) { return __builtin_bit_cast(float, (unsigned)b << 16); }
__device__ __forceinline__ float bflo(unsigned w) { return __builtin_bit_cast(float, w << 16); }
__device__ __forceinline__ float bfhi(unsigned w) { return __builtin_bit_cast(float, w & 0xffff0000u); }
__device__ __forceinline__ void ld8bf(const bf16* p, float* f) { const v4u w = *(const v4u*)p; f[0] = bflo(w.x); f[1] = bfhi(w.x); f[2] = bflo(w.y); f[3] = bfhi(w.y); f[4] = bflo(w.z); f[5] = bfhi(w.z); f[6] = bflo(w.w); f[7] = bfhi(w.w); }
__device__ __forceinline__ float wave_sum(float v) {
#pragma unroll
    for (int o = 1; o < 64; o <<= 1) v += __shfl_xor(v, o);
    return v;
}
__device__ __forceinline__ float wave_max(float v) {
#pragma unroll
    for (int o = 1; o < 64; o <<= 1) v = fmaxf(v, __shfl_xor(v, o));
    return v;
}
__device__ const unsigned char BKT[112] = {16, 16, 16, 17, 17, 18, 18, 18, 19, 19, 19, 20, 20, 20, 20, 21, 21, 21, 21, 22, 22, 22, 22, 22, 23, 23, 23, 23, 23, 23, 24, 24, 24, 24, 24, 24, 25, 25, 25, 25, 25, 25, 25, 26, 26, 26, 26, 26, 26, 26, 26,
    27, 27, 27, 27, 27, 27, 27, 27, 27, 27, 28, 28, 28, 28, 28, 28, 28, 28, 28, 28, 29, 29, 29, 29, 29, 29, 29, 29, 29, 29, 29, 29, 30, 30, 30, 30, 30, 30, 30, 30, 30, 30, 30, 30, 30, 30, 31, 31, 31, 31, 31, 31, 31, 31, 31, 31, 31, 31, 31, 31, 31};
__device__ __forceinline__ int rel_bucket(int n) { return n < 16 ? n : (n >= 128 ? 31 : (int)BKT[n - 16]); }

#define XB_TMO      128
#define XB_XCNT(j)  (256  + 64 * (j))
#define XB_XSUB(j)  (1280 + 64 * (j))
#define XB_XGEN(j)  (2304 + 64 * (j))
#define XB_TOP      3328
#define XB_TOPGEN   3392
#define XCD_BAR_WORDS 3456
#define XB_SPIN_CAP (1u << 22)
__device__ __forceinline__ unsigned xb_ld(unsigned* p)              { return __hip_atomic_load(p, __ATOMIC_RELAXED, __HIP_MEMORY_SCOPE_AGENT); }
__device__ __forceinline__ unsigned xb_add(unsigned* p, unsigned v) { return __hip_atomic_fetch_add(p, v, __ATOMIC_RELAXED, __HIP_MEMORY_SCOPE_AGENT); }
__device__ __forceinline__ unsigned xb_xcc_id() { return (unsigned)__builtin_amdgcn_s_getreg((3 << 11) | 20) & 0xFu; }
#define XB_SPIN(cond, bar) do { unsigned _sp = 0; while (cond) { __builtin_amdgcn_s_sleep(1); \
    if ((++_sp & 255u) == 0u) { if (xb_ld(&(bar)[XB_TMO])) break; if (_sp > XB_SPIN_CAP) { atomicAdd(&(bar)[XB_TMO], 1u); break; } } } } while (0)
struct XcdBarrier { unsigned* bar; unsigned x; volatile LAS unsigned* st; };
__device__ __forceinline__ XcdBarrier xcd_barrier_post(unsigned* bar, volatile LAS unsigned* st) {
    XcdBarrier b; b.bar = bar; b.x = xb_xcc_id(); b.st = st;
    if (threadIdx.x == 0) (void)xb_add(&bar[XB_XCNT(b.x)], 1u);
    return b;
}
__device__ __forceinline__ void xcd_barrier_complete(unsigned* bar, unsigned x, unsigned& nloc, unsigned& nx) {
    const unsigned G = gridDim.x * gridDim.y * gridDim.z;
    unsigned sum, cnt, mine, sp = 0u;
    for (;;) {
        sum = 0u; cnt = 0u; mine = 0u;
#pragma unroll
        for (unsigned j = 0; j < 16; ++j) { const unsigned c = xb_ld(&bar[XB_XCNT(j)]); sum += c; cnt += (c > 0u) ? 1u : 0u; mine = (j == x) ? c : mine; }
        if (sum == G) break;
        __builtin_amdgcn_s_sleep(1);
        if ((++sp & 255u) == 0u) { if (xb_ld(&bar[XB_TMO])) break; if (sp > XB_SPIN_CAP) { atomicAdd(&bar[XB_TMO], 1u); break; } }
    }
    nloc = mine > 0u ? mine : 1u; nx = cnt > 0u ? cnt : 1u;
}
__device__ __forceinline__ void xcd_barrier(const XcdBarrier& b) {
    asm volatile("s_waitcnt vmcnt(0)" ::: "memory");
    __syncthreads();
    if (threadIdx.x == 0) {
        unsigned* bar = b.bar;
        __builtin_amdgcn_s_waitcnt(0);
        unsigned nloc = b.st[0], nx = b.st[1];
        const unsigned old = xb_add(&bar[XB_XSUB(b.x)], 1u);
        const unsigned gen = old / nloc;
        if (old + 1u == (gen + 1u) * nloc) {
            __builtin_amdgcn_fence(__ATOMIC_RELEASE, "agent");
            asm volatile("s_waitcnt vmcnt(0)" ::: "memory");
            const unsigned og = xb_add(&bar[XB_TOP], 1u);
            const unsigned tg = og / nx;
            if (og + 1u == (tg + 1u) * nx) xb_add(&bar[XB_TOPGEN], 1u);
            else XB_SPIN(xb_ld(&bar[XB_TOPGEN]) == tg, bar);
            __builtin_amdgcn_fence(__ATOMIC_ACQUIRE, "agent");
            xb_add(&bar[XB_XGEN(b.x)], 1u);
            asm volatile("s_waitcnt vmcnt(0)" ::: "memory");
        } else {
            XB_SPIN(xb_ld(&bar[XB_XGEN(b.x)]) == gen, bar);
            __builtin_amdgcn_fence(__ATOMIC_ACQUIRE, "agent");
            asm volatile("s_waitcnt vmcnt(0)" ::: "memory");
        }
    }
    __syncthreads();
}

struct Args { const float* in[30]; float* out; unsigned char* ws; int ph_lo, ph_hi; };
enum { I_X = 0, I_MEM, I_REL, I_EV_WIN, I_EV_GAIN, I_EV_WUK, I_EV_WUV, I_EV_SINK, I_EV_WOUT, I_OD_WIN, I_OD_PEK, I_OD_W1K, I_OD_W2K, I_OD_PEV, I_OD_W1V, I_OD_W2V, I_OD_WOUT,
       I_XA_WQ, I_XA_WK, I_XA_WV, I_XA_WO, I_FF_G, I_FF_U, I_FF_D, I_MOE_R, I_MOE_G, I_MOE_U, I_MOE_D, I_LN_G, I_LN_B };

struct Frame {
    LAS unsigned char* lds;
    unsigned char* ws; float* acc;
    const float* const* in;
    int tid, lane, wave, G, gw, NGW;
};

__device__ __forceinline__ bool fresh(Frame& F) { int l = (int)__builtin_amdgcn_mbcnt_hi(~0u, __builtin_amdgcn_mbcnt_lo(~0u, 0u)); asm volatile("" : "+v"(l)); F.lane = l; F.tid = F.wave * 64 + l; return true; }
__device__ __forceinline__ void tconv_item(const float* W, int ldw, int ncols, bf16* WT, int ldt, int grp, int gstride, LAS float* scr, int kb, int nb, int lane) {
    const int k0 = 64 * kb, n0 = 32 * nb;
#pragma unroll 8
    for (int i = 0; i < 32; ++i) { const int kk = 2 * i + (lane >> 5), n = n0 + (lane & 31); scr[kk * 33 + (lane & 31)] = (n < ncols) ? W[(size_t)(k0 + kk) * ldw + n] : 0.f; }
    LDS_WAIT();
    const int c = lane & 7;
#pragma unroll
    for (int j = 0; j < 4; ++j) { const int nn = (lane >> 3) + 8 * j, n = n0 + nn; const LAS float* s = scr + (8 * c) * 33 + nn;
        v4u o; o.x = pk2(s[0 * 33], s[1 * 33]); o.y = pk2(s[2 * 33], s[3 * 33]); o.z = pk2(s[4 * 33], s[5 * 33]); o.w = pk2(s[6 * 33], s[7 * 33]);
        const int row = (n / grp) * gstride + (n % grp);
        *(v4u*)(WT + (size_t)row * ldt + k0 + 8 * c) = o; }
    LDS_WAIT();
}
__device__ __forceinline__ void tconv(const Frame& F, const float* W, int ldw, int K, int ncols, int npad, bf16* WT, int ldt, int grp, int gstride) {
    LAS float* scr = (LAS float*)(F.lds + F.wave * 16384);
    const int nkb = K / 64, nnb = npad / 32;
    for (int it = F.gw; it < nkb * nnb; it += F.NGW) tconv_item(W, ldw, ncols, WT, ldt, grp, gstride, scr, it / nnb, it % nnb, F.lane);
}
constexpr int NOGRP = 1 << 30;

__device__ __forceinline__ void prologue(const Frame& F) {
    unsigned char* ws = F.ws;
    const int gt = F.gw * 64 + F.lane, NT = F.NGW * 64;
    bf16* win0 = (bf16*)(ws + W_IN0);
    const float* evw = F.in[I_EV_WIN];
    tconv(F, evw + 512, EVEN_COLS, 1024, 128, 128, win0 + (size_t)C0_CKV * 1024, 1024, NOGRP, 0);
    tconv(F, evw + 640, EVEN_COLS, 1024, 512, 512, win0 + (size_t)C0_QI * 1024, 1024, NOGRP, 0);
    tconv(F, evw + 1152, EVEN_COLS, 1024, 64, 64, win0 + (size_t)C0_KI * 1024, 1024, NOGRP, 0);
    tconv(F, evw + 1216, EVEN_COLS, 1024, 8, 64, win0 + (size_t)C0_WI * 1024, 1024, NOGRP, 0);
    tconv(F, evw + 1224, EVEN_COLS, 1024, 512, 512, win0 + (size_t)C0_QB * 1024, 1024, NOGRP, 0);
    tconv(F, evw + 1736, EVEN_COLS, 1024, 128, 128, win0 + (size_t)C0_KB * 1024, 1024, NOGRP, 0);
    tconv(F, evw + 1864, EVEN_COLS, 1024, 128, 128, win0 + (size_t)C0_VB * 1024, 1024, NOGRP, 0);
    {
        const float* wuk = F.in[I_EV_WUK];
        for (int idx = gt; idx < 1024 * 1024; idx += NT) { const int r = idx >> 10, k = idx & 1023, h = r >> 7, c = r & 127;
            const float* wr = evw + (size_t)k * EVEN_COLS + h * 64; const float* uk = wuk + (size_t)h * 64 * 128 + c; float s = 0.f;
#pragma unroll 8
            for (int d = 0; d < 64; ++d) s += wr[d] * uk[d * 128];
            win0[(size_t)(C0_QLAT + r) * 1024 + k] = (bf16)f2bf(s); }
    }
    bf16* wout0 = (bf16*)(ws + W_OUT0);
    const float* evo = F.in[I_EV_WOUT];
    tconv(F, evo + (size_t)512 * 1024, 1024, 512, 1024, 1024, wout0 + 1024, 1536, NOGRP, 0);
    {
        const float* wuv = F.in[I_EV_WUV];
        for (int idx = gt; idx < 1024 * 1024; idx += NT) { const int n = idx >> 10, kk = idx & 1023, h = kk >> 7;
            const float* uv = wuv + (size_t)kk * 64; const float* wo = evo + (size_t)h * 64 * 1024 + n; float s = 0.f;
#pragma unroll 8
            for (int d = 0; d < 64; ++d) s += uv[d] * wo[(size_t)d * 1024];
            wout0[(size_t)n * 1536 + kk] = (bf16)f2bf(s); }
    }
    tconv(F, F.in[I_OD_WIN], ODD_COLS, 1024, ODD_COLS, 2048, (bf16*)(ws + W_IN1), 1024, NOGRP, 0);
    tconv(F, F.in[I_OD_WOUT], 1024, 1024, 1024, 1024, (bf16*)(ws + W_OUT1), 1024, NOGRP, 0);
    for (int i = 0; i < 2; ++i) {
        tconv(F, F.in[I_XA_WQ] + (size_t)i * 1024 * 512, 512, 1024, 512, 512, (bf16*)(ws + W_XQ) + (size_t)i * 512 * 1024, 1024, NOGRP, 0);
        tconv(F, F.in[I_XA_WK] + (size_t)i * 1024 * 512, 512, 1024, 512, 512, (bf16*)(ws + W_XKV) + (size_t)i * 1024 * 1024, 1024, NOGRP, 0);
        tconv(F, F.in[I_XA_WV] + (size_t)i * 1024 * 512, 512, 1024, 512, 512, (bf16*)(ws + W_XKV) + (size_t)i * 1024 * 1024 + (size_t)512 * 1024, 1024, NOGRP, 0);
        tconv(F, F.in[I_XA_WO] + (size_t)i * 512 * 1024, 1024, 512, 1024, 1024, (bf16*)(ws + W_XO) + (size_t)i * 1024 * 512, 512, NOGRP, 0);
    }
    tconv(F, F.in[I_FF_G], DFF, 1024, DFF, DFF, (bf16*)(ws + W_FGU), 1024, 128, 256);
    tconv(F, F.in[I_FF_U], DFF, 1024, DFF, DFF, (bf16*)(ws + W_FGU) + (size_t)128 * 1024, 1024, 128, 256);
    tconv(F, F.in[I_FF_D], 1024, DFF, 1024, 1024, (bf16*)(ws + W_FD), DFF, NOGRP, 0);
    for (int e = 0; e < NE; ++e) {
        tconv(F, F.in[I_MOE_G] + (size_t)e * 1024 * DFFE, DFFE, 1024, DFFE, DFFE, (bf16*)(ws + W_MGU) + (size_t)e * 7168 * 1024, 1024, 128, 256);
        tconv(F, F.in[I_MOE_U] + (size_t)e * 1024 * DFFE, DFFE, 1024, DFFE, DFFE, (bf16*)(ws + W_MGU) + (size_t)e * 7168 * 1024 + (size_t)128 * 1024, 1024, 128, 256);
        tconv(F, F.in[I_MOE_D] + (size_t)e * DFFE * 1024, 1024, DFFE, 1024, 1024, (bf16*)(ws + W_MD) + (size_t)e * 1024 * DFFE, DFFE, NOGRP, 0);
    }
    {
        const f32x4* x4 = (const f32x4*)F.in[I_X]; v2u* hb = (v2u*)(ws + WS_HB); f32x4* a4 = (f32x4*)F.acc;
        for (int i = gt; i < M * D / 4; i += NT) { const f32x4 v = x4[i]; v2u o; o.x = pk2(v.x, v.y); o.y = pk2(v.z, v.w); hb[i] = o; a4[i] = v * ALPHA; }
        const f32x4* m4 = (const f32x4*)F.in[I_MEM]; v2u* mb = (v2u*)(ws + WS_MEMB);
        for (int i = gt; i < MMEM * D / 4; i += NT) { const f32x4 v = m4[i]; v2u o; o.x = pk2(v.x, v.y); o.y = pk2(v.z, v.w); mb[i] = o; }
    }
}

template <int MODE>
__device__ __forceinline__ void ln_phase(const Frame& F, int li) {
    const float* g = F.in[I_LN_G] + (size_t)li * D; const float* bb = F.in[I_LN_B] + (size_t)li * D;
    LAS int* lcnt = (LAS int*)F.lds;
    if (MODE == 1) { if (F.tid < 16) lcnt[F.tid] = 0; __syncthreads(); }
    for (int row = F.gw; row < M; row += F.NGW) {
        f32x4* p = (f32x4*)(F.acc + (size_t)row * D) + F.lane;
        f32x4 v[4]; float s = 0.f;
#pragma unroll
        for (int j = 0; j < 4; ++j) { v[j] = p[64 * j]; s += (v[j].x + v[j].y) + (v[j].z + v[j].w); }
        const float mean = wave_sum(s) * (1.f / D); float s2 = 0.f;
#pragma unroll
        for (int j = 0; j < 4; ++j) { v[j] = v[j] - mean; s2 += (v[j].x * v[j].x + v[j].y * v[j].y) + (v[j].z * v[j].z + v[j].w * v[j].w); }
        const float rstd = 1.f / sqrtf(wave_sum(s2) * (1.f / D) + LN_EPS);
#pragma unroll
        for (int j = 0; j < 4; ++j) { const f32x4 gg = ((const f32x4*)g)[F.lane + 64 * j], b4 = ((const f32x4*)bb)[F.lane + 64 * j]; v[j] = v[j] * rstd * gg + b4; }
        if (MODE == 2) {
#pragma unroll
            for (int j = 0; j < 4; ++j) p[64 * j] = v[j];
        } else {
            v2u* hb = (v2u*)(F.ws + WS_HB + (size_t)row * D * 2) + F.lane;
#pragma unroll
            for (int j = 0; j < 4; ++j) { v2u o; o.x = pk2(v[j].x, v[j].y); o.y = pk2(v[j].z, v[j].w); hb[64 * j] = o; p[64 * j] = v[j] * ALPHA; }
        }
        if (MODE == 1) {
            const float* wr = F.in[I_MOE_R]; float lg[8];
#pragma unroll
            for (int e = 0; e < 8; ++e) lg[e] = 0.f;
#pragma unroll
            for (int j = 0; j < 4; ++j)
#pragma unroll
                for (int i = 0; i < 4; ++i) { const int c = 4 * (F.lane + 64 * j) + i; const f32x4 w0 = *(const f32x4*)(wr + (size_t)c * 8), w1 = *(const f32x4*)(wr + (size_t)c * 8 + 4); const float y = v[j][i];
                    lg[0] += y * w0.x; lg[1] += y * w0.y; lg[2] += y * w0.z; lg[3] += y * w0.w; lg[4] += y * w1.x; lg[5] += y * w1.y; lg[6] += y * w1.z; lg[7] += y * w1.w; }
#pragma unroll
            for (int e = 0; e < 8; ++e) lg[e] = wave_sum(lg[e]);
            int e0 = 0; float v0 = lg[0];
#pragma unroll
            for (int e = 1; e < 8; ++e) if (lg[e] > v0) { v0 = lg[e]; e0 = e; }
            int e1 = -1; float v1 = -3.0e38f;
#pragma unroll
            for (int e = 0; e < 8; ++e) if (e != e0 && lg[e] > v1) { v1 = lg[e]; e1 = e; }
            const float w0 = 1.f / (1.f + __expf(v1 - v0)), w1 = 1.f - w0;
            if (F.lane == 0) { int* rte = (int*)(F.ws + WS_RTE); float* rtw = (float*)(F.ws + WS_RTW); rte[2 * row] = e0; rte[2 * row + 1] = e1; rtw[2 * row] = w0; rtw[2 * row + 1] = w1;
                atomicAdd((int*)&lcnt[e0], 1); atomicAdd((int*)&lcnt[8 + e1], 1); }
        }
    }
    if (MODE == 1) { __syncthreads(); if (F.tid < 16) { const int c = lcnt[F.tid]; if (c) atomicAdd((unsigned*)(F.ws + WS_CTL) + CW_CNT + F.tid, (unsigned)c); } }
}

__device__ __forceinline__ void moe_dispatch(const Frame& F) {
    unsigned* ctl = (unsigned*)(F.ws + WS_CTL);
    int* tile_exp = (int*)(F.ws + WS_TILEEXP); int* rowtok = (int*)(F.ws + WS_ROWTOK); float* roww = (float*)(F.ws + WS_ROWW);
    LAS int* seg = (LAS int*)F.lds;
    if (F.tid == 0) { int run = 0;
#pragma unroll 1
        for (int sgi = 0; sgi < 16; ++sgi) { if ((sgi & 7) == 0) seg[32 + (sgi >> 3)] = run >> 8; seg[sgi] = run; const int c = (int)__hip_atomic_load(ctl + CW_CNT + sgi, __ATOMIC_RELAXED, __HIP_MEMORY_SCOPE_AGENT); seg[16 + sgi] = c; run += (c + 255) & ~255; }
        seg[34] = run >> 8; }
    __syncthreads();
    if (blockIdx.x == 0) {
#pragma unroll 1
        for (int sgi = 0; sgi < 16; ++sgi) { const int c = seg[16 + sgi], st = seg[sgi], en = st + ((c + 255) & ~255);
            for (int t = (st >> 8) + F.tid; t < (en >> 8); t += 512) tile_exp[t] = sgi & 7;
            for (int r = st + c + F.tid; r < en; r += 512) { rowtok[r] = -1; roww[r] = 0.f; } }
        if (F.tid < 3) tile_exp[512 + F.tid] = seg[32 + F.tid];
    }
    const int* rte = (const int*)(F.ws + WS_RTE); const float* rtw = (const float*)(F.ws + WS_RTW);
    for (int base = F.gw * 64; base < M; base += F.NGW * 64) {
        const int tok = base + F.lane; const int e0 = rte[2 * tok], e1 = rte[2 * tok + 1]; const float w0 = rtw[2 * tok], w1 = rtw[2 * tok + 1];
        int pos0 = 0, pos1 = 0;
#pragma unroll 1
        for (int sgi = 0; sgi < 16; ++sgi) { const bool mine = (sgi < 8) ? (e0 == sgi) : (e1 == sgi - 8);
            const unsigned long long bal = __ballot(mine);
            if (bal) { const int n = __popcll(bal); unsigned b0 = 0; if (F.lane == 0) b0 = atomicAdd(ctl + CW_CUR + sgi, (unsigned)n); b0 = __shfl(b0, 0);
                const int rank = __popcll(bal & ((1ull << F.lane) - 1ull));
                if (mine) { const int pos = seg[sgi] + (int)b0 + rank; if (sgi < 8) pos0 = pos; else pos1 = pos; } } }
        rowtok[pos0] = tok; roww[pos0] = w0; rowtok[pos1] = tok; roww[pos1] = w1;
#pragma unroll 1
        for (int i = 0; i < 64; ++i) { const int tk = base + i; const int p0 = __shfl(pos0, i), p1 = __shfl(pos1, i);
            const v4u* src = (const v4u*)(F.ws + WS_HB + (size_t)tk * D * 2);
            v4u* d0 = (v4u*)(F.ws + WS_PERMA + (size_t)p0 * D * 2); v4u* d1 = (v4u*)(F.ws + WS_PERMA + (size_t)p1 * D * 2);
            const v4u a = src[F.lane], b = src[F.lane + 64]; d0[F.lane] = a; d0[F.lane + 64] = b; d1[F.lane] = a; d1[F.lane + 64] = b; }
    }
    __syncthreads();
}

__device__ __forceinline__ void cn_phase(const Frame& F) {
    const bf16* P0 = (const bf16*)(F.ws + WS_P0); bf16* CN = (bf16*)(F.ws + WS_CN); const float* gain = F.in[I_EV_GAIN];
    for (int row = F.gw; row < M; row += F.NGW) {
        const unsigned w = *(const unsigned*)(P0 + (size_t)row * P0_LD + C0_CKV + 2 * F.lane); const float a = bflo(w), b = bfhi(w);
        const float ms = wave_sum(a * a + b * b) * (1.f / 128.f); const float r = 1.f / sqrtf(ms + LN_EPS);
        *(unsigned*)(CN + (size_t)row * 128 + 2 * F.lane) = pk2(a * r * gain[2 * F.lane], b * r * gain[2 * F.lane + 1]);
    }
}

__device__ __forceinline__ unsigned fkey(float x) { unsigned b = __builtin_bit_cast(unsigned, x); if (b == 0x80000000u) b = 0u; return (b & 0x80000000u) ? ~b : (b | 0x80000000u); }
__device__ __forceinline__ void idx_phase(const Frame& F) {
    const bf16* P0 = (const bf16*)(F.ws + WS_P0); unsigned* MASK = (unsigned*)(F.ws + WS_MASK);
    LAS float* qi_s = (LAS float*)F.lds; LAS float* wi_s = qi_s + 4096; LAS float* sc = wi_s + 64;
    for (int item = blockIdx.x; item < NB * (S / 8); item += F.G) {
        const int b = item / (S / 8), t0 = (item % (S / 8)) * 8;
        for (int i = F.tid; i < 4096; i += 512) { const int q = i >> 9, e = i & 511; qi_s[i] = bf2f(P0[(size_t)(b * S + t0 + q) * P0_LD + C0_QI + e]); }
        if (F.tid < 64) { const int q = F.tid >> 3, h = F.tid & 7; wi_s[F.tid] = bf2f(P0[(size_t)(b * S + t0 + q) * P0_LD + C0_WI + h]) * (0.35355339059f * 0.125f); }
        __syncthreads();
        const int nk = t0 + 8;
        for (int s = F.tid; s < nk; s += 512) {
            float kf[64]; const bf16* kr = P0 + (size_t)(b * S + s) * P0_LD + C0_KI;
#pragma unroll
            for (int j = 0; j < 8; ++j) ld8bf(kr + 8 * j, kf + 8 * j);
#pragma unroll 1
            for (int q = 0; q < 8; ++q) { float a = 0.f;
#pragma unroll 1
                for (int h = 0; h < 8; ++h) { const LAS float* qp = qi_s + q * 512 + h * 64; float dot = 0.f;
#pragma unroll
                    for (int d = 0; d < 64; ++d) dot += qp[d] * kf[d];
                    a += wi_s[q * 8 + h] * fmaxf(dot, 0.f); }
                sc[q * 2048 + s] = a; }
        }
        __syncthreads();
        {
            const int q = F.wave, t = t0 + q, n = t + 1, row = b * S + t; unsigned myword = 0u;
            if (n <= 256) { const int cb = n - 32 * F.lane; myword = cb >= 32 ? 0xffffffffu : (cb <= 0 ? 0u : ((1u << cb) - 1u)); }
            else {
                LAS unsigned* uk = (LAS unsigned*)(sc + q * 2048);
#pragma unroll 4
                for (int i = 0; i < 32; ++i) { const int s = F.lane + 64 * i; const unsigned k = (s < n) ? fkey(sc[q * 2048 + s]) : 0u; uk[s] = k; }
                LDS_WAIT();
                unsigned prefix = 0u;
#pragma unroll 1
                for (int bit = 31; bit >= 0; --bit) { const unsigned cand = prefix | (1u << bit); int c = 0;
#pragma unroll 8
                    for (int i = 0; i < 32; ++i) c += (uk[F.lane + 64 * i] >= cand) ? 1 : 0;
#pragma unroll
                    for (int o = 1; o < 64; o <<= 1) c += __shfl_xor(c, o);
                    if (c >= 256) prefix = cand; }
                int cgt = 0;
#pragma unroll 8
                for (int i = 0; i < 32; ++i) cgt += (uk[F.lane + 64 * i] > prefix) ? 1 : 0;
#pragma unroll
                for (int o = 1; o < 64; o <<= 1) cgt += __shfl_xor(cgt, o);
                const int need = 256 - cgt; int run = 0;
#pragma unroll 1
                for (int i = 0; i < 32; ++i) { const unsigned u = uk[F.lane + 64 * i]; const bool eq = (u == prefix); const unsigned long long em = __ballot(eq); const int rank = run + __popcll(em & ((1ull << F.lane) - 1ull));
                    const bool sel = (u > prefix) || (eq && rank < need); run += __popcll(em);
                    const unsigned long long sm = __ballot(sel);
                    if (F.lane == 2 * i) myword = (unsigned)sm; if (F.lane == 2 * i + 1) myword = (unsigned)(sm >> 32); }
            }
            MASK[(size_t)row * 64 + F.lane] = myword;
        }
        __syncthreads();
    }
}

__device__ __forceinline__ void dsa_phase(const Frame& F) {
    bf16* P0 = (bf16*)(F.ws + WS_P0); const bf16* CN = (const bf16*)(F.ws + WS_CN); const unsigned* MASK = (const unsigned*)(F.ws + WS_MASK); const float* rel = F.in[I_REL];
    LAS float* ql = (LAS float*)(F.lds + F.wave * 13312); LAS float* pl = ql + 1024; LAS int* idx = (LAS int*)(pl + 2048);
    for (int row = F.gw; row < M; row += F.NGW) {
        const int b = row / S, t = row % S;
        const unsigned w = MASK[(size_t)row * 64 + F.lane]; const int c = __popc(w);
        int incl = c;
#pragma unroll
        for (int o = 1; o < 64; o <<= 1) { const int v = __shfl_up(incl, o); if (F.lane >= o) incl += v; }
        const int total = __shfl(incl, 63); int pos = incl - c; unsigned ww = w;
        while (ww) { const int bit = __ffs(ww) - 1; idx[pos++] = 32 * F.lane + bit; ww &= ww - 1u; }
#pragma unroll
        for (int i = 0; i < 16; ++i) ql[F.lane + 64 * i] = bf2f(P0[(size_t)row * P0_LD + C0_QLAT + F.lane + 64 * i]);
        WAVE_SYNC();
        float lg[4][8]; bool val[4];
#pragma unroll
        for (int kk = 0; kk < 4; ++kk) { const int k = F.lane + 64 * kk; val[kk] = k < total; const int key = val[kk] ? idx[k] : 0;
            float a[8];
#pragma unroll
            for (int h = 0; h < 8; ++h) a[h] = 0.f;
            const bf16* cr = CN + (size_t)(b * S + key) * 128;
#pragma unroll 1
            for (int j = 0; j < 16; ++j) { float cv[8]; ld8bf(cr + 8 * j, cv);
#pragma unroll
                for (int h = 0; h < 8; ++h)
#pragma unroll
                    for (int i = 0; i < 8; ++i) a[h] += ql[h * 128 + 8 * j + i] * cv[i]; }
            const int bk = rel_bucket(t - key);
#pragma unroll
            for (int h = 0; h < 8; ++h) lg[kk][h] = val[kk] ? (a[h] * 0.125f + rel[bk * 16 + h]) : -1.0e30f;
        }
#pragma unroll
        for (int h = 0; h < 8; ++h) { float m = fmaxf(fmaxf(lg[0][h], lg[1][h]), fmaxf(lg[2][h], lg[3][h])); m = wave_max(m);
            float e[4], s = 0.f;
#pragma unroll
            for (int kk = 0; kk < 4; ++kk) { e[kk] = val[kk] ? __expf(lg[kk][h] - m) : 0.f; s += e[kk]; }
            s = wave_sum(s); const float inv = 1.f / s;
#pragma unroll
            for (int kk = 0; kk < 4; ++kk) pl[h * 256 + F.lane + 64 * kk] = e[kk] * inv; }
        WAVE_SYNC();
        float a0[8], a1[8];
#pragma unroll
        for (int h = 0; h < 8; ++h) { a0[h] = 0.f; a1[h] = 0.f; }
        for (int k = 0; k < total; ++k) { const int key = idx[k]; const unsigned pr = *(const unsigned*)(CN + (size_t)(b * S + key) * 128 + 2 * F.lane); const float vx = bflo(pr), vy = bfhi(pr);
#pragma unroll
            for (int h = 0; h < 8; ++h) { const float p = pl[h * 256 + k]; a0[h] += p * vx; a1[h] += p * vy; } }
#pragma unroll
        for (int h = 0; h < 8; ++h) *(unsigned*)(P0 + (size_t)row * P0_LD + C0_QLAT + h * 128 + 2 * F.lane) = pk2(a0[h], a1[h]);
        WAVE_SYNC();
    }
}

template <int W, int NH, int GRPSZ, bool SINK, bool NSA>
__device__ __forceinline__ void banded_phase(const Frame& F, bf16* P, int ld, int cq, int ck, int cv, int relc0) {
    const float* rel = F.in[I_REL]; const float* sinks = F.in[I_EV_SINK];
    const bf16* OC = (const bf16*)(F.ws + WS_OCMP); const bf16* OS = (const bf16*)(F.ws + WS_OSLC);
    constexpr int NTG = S / 64;
    for (int it = F.gw; it < NB * NH * NTG; it += F.NGW) {
        const int tg = it % NTG, h = (it / NTG) % NH, b = it / (NTG * NH);
        const int t = tg * 64 + F.lane, row = b * S + t, kvh = h / GRPSZ;
        float q[64], acc[64];
        { const bf16* qr = P + (size_t)row * ld + cq + h * 64;
#pragma unroll
          for (int j = 0; j < 8; ++j) ld8bf(qr + 8 * j, q + 8 * j); }
#pragma unroll
        for (int d = 0; d < 64; ++d) acc[d] = 0.f;
        float m = SINK ? sinks[h] : -1.0e30f, l = SINK ? 1.f : 0.f;
#pragma unroll 1
        for (int j = 0; j < W; ++j) { const int s = t - j;
            const float bias = rel[rel_bucket(j) * 16 + relc0 + h];
            if (s >= 0) { const bf16* kr = P + (size_t)(b * S + s) * ld + ck + kvh * 64; float dot = 0.f;
#pragma unroll
                for (int jj = 0; jj < 8; ++jj) { float kf[8]; ld8bf(kr + 8 * jj, kf);
#pragma unroll
                    for (int i = 0; i < 8; ++i) dot += q[8 * jj + i] * kf[i]; }
                const float lgt = dot * 0.125f + bias, mn = fmaxf(m, lgt), corr = __expf(m - mn), p = __expf(lgt - mn);
                l = l * corr + p; m = mn;
                const bf16* vr = P + (size_t)(b * S + s) * ld + cv + kvh * 64;
#pragma unroll
                for (int jj = 0; jj < 8; ++jj) { float vf[8]; ld8bf(vr + 8 * jj, vf);
#pragma unroll
                    for (int i = 0; i < 8; ++i) acc[8 * jj + i] = acc[8 * jj + i] * corr + p * vf[i]; } } }
        const float inv = 1.f / l;
        float g0 = 0.f, g1 = 0.f, g2 = 1.f;
        if (NSA) { const bf16* gr = P + (size_t)row * ld + C1_GL + h * 3; g0 = 1.f / (1.f + __expf(-bf2f(gr[0]))); g1 = 1.f / (1.f + __expf(-bf2f(gr[1]))); g2 = 1.f / (1.f + __expf(-bf2f(gr[2]))); }
        bf16* orow = P + (size_t)row * ld + cq + h * 64;
#pragma unroll
        for (int jj = 0; jj < 8; ++jj) { float o[8];
#pragma unroll
            for (int i = 0; i < 8; ++i) o[i] = acc[8 * jj + i] * inv;
            if (NSA) { float c8[8], s8[8]; ld8bf(OC + (size_t)row * D + h * 64 + 8 * jj, c8); ld8bf(OS + (size_t)row * D + h * 64 + 8 * jj, s8);
#pragma unroll
                for (int i = 0; i < 8; ++i) o[i] = g0 * c8[i] + g1 * s8[i] + g2 * o[i]; }
            v4u w; w.x = pk2(o[0], o[1]); w.y = pk2(o[2], o[3]); w.z = pk2(o[4], o[5]); w.w = pk2(o[6], o[7]);
            *(v4u*)(orow + 8 * jj) = w; }
    }
}

__device__ __forceinline__ void xattn_phase(const Frame& F, const bf16* Q, const bf16* KV, bf16* O) {
    for (int it = F.gw; it < NB * 4 * (S / 32); it += F.NGW) {
        const int tg = it % (S / 32), h = (it / (S / 32)) % 4, b = it / ((S / 32) * 4);
        const int tok = tg * 32 + (F.lane >> 1), half = F.lane & 1, row = b * S + tok;
        float q[64], acc[64];
        { const bf16* qr = Q + (size_t)row * 512 + h * 128 + half * 64;
#pragma unroll
          for (int j = 0; j < 8; ++j) ld8bf(qr + 8 * j, q + 8 * j); }
#pragma unroll
        for (int d = 0; d < 64; ++d) acc[d] = 0.f;
        float m = -1.0e30f, l = 0.f;
#pragma unroll 1
        for (int mm = 0; mm < MEML; ++mm) { const bf16* kr = KV + (size_t)(b * MEML + mm) * 1024 + h * 128 + half * 64; float dot = 0.f;
#pragma unroll
            for (int jj = 0; jj < 8; ++jj) { float kf[8]; ld8bf(kr + 8 * jj, kf);
#pragma unroll
                for (int i = 0; i < 8; ++i) dot += q[8 * jj + i] * kf[i]; }
            dot += __shfl_xor(dot, 1);
            const float lgt = dot * 0.08838834764831845f, mn = fmaxf(m, lgt), corr = __expf(m - mn), p = __expf(lgt - mn);
            l = l * corr + p; m = mn;
            const bf16* vr = kr + 512;
#pragma unroll
            for (int jj = 0; jj < 8; ++jj) { float vf[8]; ld8bf(vr + 8 * jj, vf);
#pragma unroll
                for (int i = 0; i < 8; ++i) acc[8 * jj + i] = acc[8 * jj + i] * corr + p * vf[i]; } }
        const float inv = 1.f / l; bf16* orow = O + (size_t)row * 512 + h * 128 + half * 64;
#pragma unroll
        for (int jj = 0; jj < 8; ++jj) { v4u w; w.x = pk2(acc[8 * jj] * inv, acc[8 * jj + 1] * inv); w.y = pk2(acc[8 * jj + 2] * inv, acc[8 * jj + 3] * inv); w.z = pk2(acc[8 * jj + 4] * inv, acc[8 * jj + 5] * inv); w.w = pk2(acc[8 * jj + 6] * inv, acc[8 * jj + 7] * inv);
            *(v4u*)(orow + 8 * jj) = w; }
    }
}

__device__ __forceinline__ float gelu_tanh(float x) { const float u = 0.7978845608028654f * (x + 0.044715f * x * x * x); return 0.5f * x * (1.f + tanhf(u)); }
__device__ __forceinline__ void cmp_mlp_phase(const Frame& F) {
    const bf16* P1 = (const bf16*)(F.ws + WS_P1);
    LAS float* blk = (LAS float*)F.lds; LAS float* part = blk + 2048; LAS float* hid = part + 512;
    for (int item = blockIdx.x; item < 2 * NB * NCMP * 2; item += F.G) {
        const int g = item & 1, n = (item >> 1) % NCMP, b = ((item >> 1) / NCMP) % NB, which = (item >> 1) / (NCMP * NB);
        const float* pe = which ? F.in[I_OD_PEV] : F.in[I_OD_PEK]; const float* w1 = which ? F.in[I_OD_W1V] : F.in[I_OD_W1K]; const float* w2 = which ? F.in[I_OD_W2V] : F.in[I_OD_W2K];
        float* outp = (float*)(F.ws + (which ? WS_VC : WS_KC)) + ((size_t)(b * NCMP + n) * 2 + g) * 64;
        const int col0 = (which ? C1_VC : C1_KC) + g * 64;
        for (int i = F.tid; i < 2048; i += 512) { const int l = i >> 6, d = i & 63; blk[i] = bf2f(P1[(size_t)(b * S + 16 * n + l) * P1_LD + col0 + d]) + pe[i]; }
        __syncthreads();
        { const int j = F.tid & 127, pp = F.tid >> 7; float a = 0.f; const float* wp = w1 + (size_t)(pp * 512) * 128 + j; const LAS float* bp = blk + pp * 512;
#pragma unroll 8
          for (int kk = 0; kk < 512; ++kk) a += bp[kk] * wp[(size_t)kk * 128];
          part[F.tid] = a; }
        __syncthreads();
        if (F.tid < 128) hid[F.tid] = gelu_tanh((part[F.tid] + part[F.tid + 128]) + (part[F.tid + 256] + part[F.tid + 384]));
        __syncthreads();
        if (F.tid < 64) { float a = 0.f;
#pragma unroll 8
            for (int j = 0; j < 128; ++j) a += hid[j] * w2[j * 64 + F.tid];
            outp[F.tid] = a; }
        __syncthreads();
    }
}

__device__ __forceinline__ void cmp_attn_phase(const Frame& F) {
    const bf16* P1 = (const bf16*)(F.ws + WS_P1); const float* KC = (const float*)(F.ws + WS_KC); const float* VC = (const float*)(F.ws + WS_VC);
    bf16* OC = (bf16*)(F.ws + WS_OCMP); unsigned* SELM = (unsigned*)(F.ws + WS_SELM); const float* rel = F.in[I_REL];
    LAS float* qs = (LAS float*)(F.lds + F.wave * 8192); LAS float* pl = qs + 512; LAS float* psum = pl + 1024;
    for (int it = F.gw; it < M * 2; it += F.NGW) {
        const int g = it & 1, row = it >> 1, b = row / S, t = row % S;
        const int nv = (t >= 31) ? ((t - 31) / 16 + 1) : 0;
#pragma unroll
        for (int i = 0; i < 8; ++i) qs[F.lane + 64 * i] = bf2f(P1[(size_t)row * P1_LD + C1_Q + g * 512 + F.lane + 64 * i]);
        WAVE_SYNC();
        float lg[2][8]; bool val[2];
#pragma unroll
        for (int kk = 0; kk < 2; ++kk) { const int n = F.lane + 64 * kk; val[kk] = n < nv; const int nn = val[kk] ? n : 0;
            const float* kr = KC + ((size_t)(b * NCMP + nn) * 2 + g) * 64; float a[8];
#pragma unroll
            for (int h = 0; h < 8; ++h) a[h] = 0.f;
#pragma unroll 1
            for (int j = 0; j < 16; ++j) { const f32x4 kv = *(const f32x4*)(kr + 4 * j);
#pragma unroll
                for (int h = 0; h < 8; ++h) a[h] += qs[h * 64 + 4 * j] * kv.x + qs[h * 64 + 4 * j + 1] * kv.y + qs[h * 64 + 4 * j + 2] * kv.z + qs[h * 64 + 4 * j + 3] * kv.w; }
            const int bk = rel_bucket(val[kk] ? (t - (16 * nn + 31)) : 0);
#pragma unroll
            for (int h = 0; h < 8; ++h) lg[kk][h] = val[kk] ? (a[h] * 0.125f + rel[bk * 16 + g * 8 + h]) : -1.0e30f; }
        float ps[2] = {0.f, 0.f};
#pragma unroll
        for (int h = 0; h < 8; ++h) { float m = wave_max(fmaxf(lg[0][h], lg[1][h]));
            float e0 = val[0] ? __expf(lg[0][h] - m) : 0.f, e1 = val[1] ? __expf(lg[1][h] - m) : 0.f;
            const float s = wave_sum(e0 + e1); const float inv = (nv > 0) ? 1.f / s : 0.f; e0 *= inv; e1 *= inv;
            pl[h * 128 + F.lane] = e0; pl[h * 128 + 64 + F.lane] = e1; ps[0] += e0; ps[1] += e1; }
        psum[F.lane] = ps[0]; psum[64 + F.lane] = ps[1];
        WAVE_SYNC();
        float scj = -3.0e38f; bool adm = false;
        if (F.lane < 32) { const int j = F.lane; float p = 0.f;
#pragma unroll
            for (int n = 4 * j - 1; n <= 4 * j + 3; ++n) if (n >= 0 && n < NCMP) p += psum[n];
            const int blkq = t >> 6; adm = (64 * j <= t); const bool forced = (j == 0) || (j == blkq) || (j == blkq - 1);
            scj = adm ? (p + (forced ? 1.0e6f : 0.f)) : -1.0e30f; }
        int rank = 0;
#pragma unroll 1
        for (int i = 0; i < 32; ++i) { const float si = __shfl(scj, i); rank += (si > scj || (si == scj && i < F.lane)) ? 1 : 0; }
        const unsigned long long sm = __ballot(F.lane < 32 && adm && rank < 8);
        if (F.lane == 0) SELM[(size_t)row * 2 + g] = (unsigned)sm;
        float o[8];
#pragma unroll
        for (int h = 0; h < 8; ++h) o[h] = 0.f;
        for (int n = 0; n < nv; ++n) { const float v = VC[((size_t)(b * NCMP + n) * 2 + g) * 64 + F.lane];
#pragma unroll
            for (int h = 0; h < 8; ++h) o[h] += pl[h * 128 + n] * v; }
#pragma unroll
        for (int h = 0; h < 8; ++h) OC[(size_t)row * D + (g * 8 + h) * 64 + F.lane] = (bf16)f2bf(o[h]);
        WAVE_SYNC();
    }
}

__device__ __forceinline__ void slc_attn_phase(const Frame& F) {
    const bf16* P1 = (const bf16*)(F.ws + WS_P1); const unsigned* SELM = (const unsigned*)(F.ws + WS_SELM); bf16* OS = (bf16*)(F.ws + WS_OSLC); const float* rel = F.in[I_REL];
    LAS float* qs = (LAS float*)(F.lds + F.wave * 4096); LAS float* pb = qs + 512;
    for (int it = F.gw; it < M * 2; it += F.NGW) {
        const int g = it & 1, row = it >> 1, b = row / S, t = row % S;
#pragma unroll
        for (int i = 0; i < 8; ++i) qs[F.lane + 64 * i] = bf2f(P1[(size_t)row * P1_LD + C1_Q + g * 512 + F.lane + 64 * i]);
        WAVE_SYNC();
        unsigned sel = SELM[(size_t)row * 2 + g];
        float m[8], l[8], acc[8];
#pragma unroll
        for (int h = 0; h < 8; ++h) { m[h] = -1.0e30f; l[h] = 0.f; acc[h] = 0.f; }
        while (sel) { const int jb = __ffs(sel) - 1; sel &= sel - 1u;
            const int kpos = 64 * jb + F.lane; const bool valid = kpos <= t;
            const bf16* kr = P1 + (size_t)(b * S + kpos) * P1_LD + C1_KS + g * 64; float a[8];
#pragma unroll
            for (int h = 0; h < 8; ++h) a[h] = 0.f;
#pragma unroll 1
            for (int j = 0; j < 8; ++j) { float kf[8]; ld8bf(kr + 8 * j, kf);
#pragma unroll
                for (int h = 0; h < 8; ++h)
#pragma unroll
                    for (int i = 0; i < 8; ++i) a[h] += qs[h * 64 + 8 * j + i] * kf[i]; }
            const int bk = rel_bucket(valid ? (t - kpos) : 0);
            float corr[8];
#pragma unroll
            for (int h = 0; h < 8; ++h) { const float lgt = valid ? (a[h] * 0.125f + rel[bk * 16 + g * 8 + h]) : -1.0e30f;
                const float bm = wave_max(lgt), mn = fmaxf(m[h], bm); corr[h] = __expf(m[h] - mn); const float p = valid ? __expf(lgt - mn) : 0.f;
                l[h] = l[h] * corr[h] + wave_sum(p); m[h] = mn; pb[h * 64 + F.lane] = p; }
            WAVE_SYNC();
            const bf16* vb = P1 + (size_t)(b * S + 64 * jb) * P1_LD + C1_VS + g * 64 + F.lane;
            float add[8];
#pragma unroll
            for (int h = 0; h < 8; ++h) add[h] = 0.f;
            for (int k = 0; k < 64; ++k) { const float v = bf2f(vb[(size_t)k * P1_LD]);
#pragma unroll
                for (int h = 0; h < 8; ++h) add[h] += pb[h * 64 + k] * v; }
#pragma unroll
            for (int h = 0; h < 8; ++h) acc[h] = acc[h] * corr[h] + add[h];
            WAVE_SYNC();
        }
#pragma unroll
        for (int h = 0; h < 8; ++h) OS[(size_t)row * D + (g * 8 + h) * 64 + F.lane] = (bf16)f2bf(acc[h] / l[h]);
    }
}

constexpr int NPHASE = 34;
__global__ void __launch_bounds__(NWAVES * 64, 2) skel_fwd(Args args) {
    extern __shared__ __attribute__((aligned(16))) unsigned char lds[];
    Frame F;
    F.lds = (LAS unsigned char*)lds; F.ws = args.ws; F.acc = args.out; F.in = args.in;
    F.tid = threadIdx.x; F.lane = F.tid & 63; F.wave = __builtin_amdgcn_readfirstlane(F.tid >> 6);
    F.G = gridDim.x; F.gw = blockIdx.x * NWAVES + F.wave; F.NGW = F.G * NWAVES;
    volatile LAS unsigned* MISC = (volatile LAS unsigned*)(F.lds + MISC_OFF);
    for (int u = F.tid; u < (LDS_BYTES - LDSCTL_OFF) / 4; u += NWAVES * 64) ((LAS unsigned*)(F.lds + LDSCTL_OFF))[u] = 0u;
    __syncthreads();
    unsigned* ctl = (unsigned*)(args.ws + WS_CTL);
    XcdBarrier bar; bar.bar = ctl + CW_BAR; bar.x = 0; bar.st = nullptr;
    const int lo = args.ph_lo, hi = args.ph_hi;
    if (hi - lo > 1) {
        bar = xcd_barrier_post(ctl + CW_BAR, MISC + 8);
        if (threadIdx.x == 0) { unsigned nloc, nx; xcd_barrier_complete(ctl + CW_BAR, bar.x, nloc, nx); MISC[8] = nloc; MISC[9] = nx; }
        __syncthreads();
    }
#ifndef PH_LO
#define PH_LO 0
#define PH_HI 99
#endif
#define IN(k) ((k) >= PH_LO && (k) < PH_HI && lo <= (k) && (k) < hi && fresh(F))
#define SEAM(k) do { if (IN(k) && IN((k) + 1)) xcd_barrier(bar); } while (0)
    unsigned char* ws = args.ws;
    const int bx = blockIdx.x;

    if (IN(0)) { prologue(F); } SEAM(0);
    if (IN(1)) {
        { pg8::StaticSched<256 * 2048, 256 * 2048> Sd{(const char*)(ws + WS_HB), (const char*)(ws + W_IN0), M / 256, P0_LD / 256, F.G, bx, F.wave};
          pg8::EpiBf16 E{(bf16*)(ws + WS_P0), P0_LD}; pg8::gemm_phase<1024, 2048, 2048>(F.lds, Sd, E); }
        for (int i = 0; i < 2; ++i) {
          pg8::StaticSched<256 * 2048, 256 * 2048> Sd{(const char*)(ws + WS_MEMB), (const char*)(ws + W_XKV + (size_t)i * 1024 * 1024 * 2), MMEM / 256, 4, F.G, (bx + 128 * (i + 1)) % F.G, F.wave};
          pg8::EpiBf16 E{(bf16*)(ws + WS_XKV + (size_t)i * MMEM * 1024 * 2), 1024}; pg8::gemm_phase<1024, 2048, 2048>(F.lds, Sd, E); }
    } SEAM(1);
    if (IN(2)) { cn_phase(F); idx_phase(F); banded_phase<128, 8, 4, true, false>(F, (bf16*)(ws + WS_P0), P0_LD, C0_QB, C0_KB, C0_VB, 8); } SEAM(2);
    if (IN(3)) { dsa_phase(F); } SEAM(3);
    if (IN(4)) { pg8::StaticSched<256 * P0_LD * 2, 256 * 1536 * 2> Sd{(const char*)(ws + WS_P0), (const char*)(ws + W_OUT0), M / 256, 4, F.G, bx, F.wave};
                 pg8::EpiAcc E{F.acc, D}; pg8::gemm_phase<1536, P0_LD * 2, 1536 * 2>(F.lds, Sd, E); } SEAM(4);
    if (IN(5)) { ln_phase<0>(F, 0); } SEAM(5);
    if (IN(6)) { pg8::StaticSched<256 * 2048, 256 * 2048> Sd{(const char*)(ws + WS_HB), (const char*)(ws + W_XQ), M / 256, 2, F.G, bx, F.wave};
                 pg8::EpiBf16 E{(bf16*)(ws + WS_QX0), 512}; pg8::gemm_phase<1024, 2048, 2048>(F.lds, Sd, E); } SEAM(6);
    if (IN(7)) { xattn_phase(F, (const bf16*)(ws + WS_QX0), (const bf16*)(ws + WS_XKV), (bf16*)(ws + WS_OX0)); } SEAM(7);
    if (IN(8)) { pg8::StaticSched<256 * 1024, 256 * 1024> Sd{(const char*)(ws + WS_OX0), (const char*)(ws + W_XO), M / 256, 4, F.G, bx, F.wave};
                 pg8::EpiAcc E{F.acc, D}; pg8::gemm_phase<512, 1024, 1024>(F.lds, Sd, E); } SEAM(8);
    if (IN(9)) { ln_phase<0>(F, 1); } SEAM(9);
    if (IN(10)) { pg8::StaticSched<256 * 2048, 256 * 2048> Sd{(const char*)(ws + WS_HB), (const char*)(ws + W_FGU), M / 256, 2 * DFF / 256, F.G, bx, F.wave};
                  pg8::EpiSwiglu E{(bf16*)(ws + WS_HID), DFF, 0}; pg8::gemm_phase<1024, 2048, 2048>(F.lds, Sd, E); } SEAM(10);
    if (IN(11)) { pg8::StaticSched<256 * DFF * 2, 256 * DFF * 2> Sd{(const char*)(ws + WS_HID), (const char*)(ws + W_FD), M / 256, 4, F.G, bx, F.wave};
                  pg8::EpiAcc E{F.acc, D}; pg8::gemm_phase<DFF, DFF * 2, DFF * 2>(F.lds, Sd, E); } SEAM(11);
    if (IN(12)) { ln_phase<0>(F, 2); } SEAM(12);
    if (IN(13)) { pg8::StaticSched<256 * 2048, 256 * 2048> Sd{(const char*)(ws + WS_HB), (const char*)(ws + W_IN1), M / 256, P1_LD / 256, F.G, bx, F.wave};
                  pg8::EpiBf16 E{(bf16*)(ws + WS_P1), P1_LD}; pg8::gemm_phase<1024, 2048, 2048>(F.lds, Sd, E); } SEAM(13);
    if (IN(14)) { cmp_mlp_phase(F); } SEAM(14);
    if (IN(15)) { cmp_attn_phase(F); } SEAM(15);
    if (IN(16)) { slc_attn_phase(F); } SEAM(16);
    if (IN(17)) { banded_phase<512, 16, 8, false, true>(F, (bf16*)(ws + WS_P1), P1_LD, C1_Q, C1_KW, C1_VW, 0); } SEAM(17);
    if (IN(18)) { pg8::StaticSched<256 * P1_LD * 2, 256 * 2048> Sd{(const char*)(ws + WS_P1), (const char*)(ws + W_OUT1), M / 256, 4, F.G, bx, F.wave};
                  pg8::EpiAcc E{F.acc, D}; pg8::gemm_phase<1024, P1_LD * 2, 2048>(F.lds, Sd, E); } SEAM(18);
    if (IN(19)) { ln_phase<0>(F, 3); } SEAM(19);
    if (IN(20)) { pg8::StaticSched<256 * 2048, 256 * 2048> Sd{(const char*)(ws + WS_HB), (const char*)(ws + W_XQ + (size_t)512 * 1024 * 2), M / 256, 2, F.G, bx, F.wave};
                  pg8::EpiBf16 E{(bf16*)(ws + WS_QX1), 512}; pg8::gemm_phase<1024, 2048, 2048>(F.lds, Sd, E); } SEAM(20);
    if (IN(21)) { xattn_phase(F, (const bf16*)(ws + WS_QX1), (const bf16*)(ws + WS_XKV + (size_t)MMEM * 1024 * 2), (bf16*)(ws + WS_OX1)); } SEAM(21);
    if (IN(22)) { pg8::StaticSched<256 * 1024, 256 * 1024> Sd{(const char*)(ws + WS_OX1), (const char*)(ws + W_XO + (size_t)1024 * 512 * 2), M / 256, 4, F.G, bx, F.wave};
                  pg8::EpiAcc E{F.acc, D}; pg8::gemm_phase<512, 1024, 1024>(F.lds, Sd, E); } SEAM(22);
    if (IN(23)) { ln_phase<1>(F, 4); } SEAM(23);
    if (IN(24)) { moe_dispatch(F); } SEAM(24);
#pragma unroll 1
    for (int ch = 0; ch < 4; ++ch) {
        const int pa = 25 + 2 * ch, pb = 26 + 2 * ch;
        const int* tile_exp = (const int*)(ws + WS_TILEEXP);
        if (IN(pa) || IN(pb)) {
            const int slot = ch >> 1; const int s0 = tile_exp[512 + slot], s1 = tile_exp[512 + slot + 1];
            int t0 = s0 + (ch & 1) * MOE_CHUNK_TILES, t1 = (ch & 1) ? s1 : (s0 + MOE_CHUNK_TILES < s1 ? s0 + MOE_CHUNK_TILES : s1);
            if (t0 > s1) t0 = s1; int nT = t1 - t0; if (nT < 0) nT = 0; if (nT > MOE_CHUNK_TILES) nT = MOE_CHUNK_TILES;
            if (IN(pa)) { pg8::MoeSched<WS_PERMA, W_MGU, 256 * 2048, 256 * 2048, (size_t)7168 * 2048, 0> Sd{ws, t0, nT, 2 * DFFE / 256, F.G, bx, F.wave};
                          pg8::EpiSwiglu E{(bf16*)(ws + WS_HIDM), DFFE, 1}; pg8::gemm_phase<1024, 2048, 2048>(F.lds, Sd, E); }
            if (IN(pa) && IN(pb)) xcd_barrier(bar);
            if (IN(pb)) { pg8::MoeSched<WS_HIDM, W_MD, 256 * DFFE * 2, 256 * DFFE * 2, (size_t)1024 * DFFE * 2, 1> Sd{ws, t0, nT, 4, F.G, bx, F.wave};
                          pg8::EpiMoeDown E{F.acc, ws}; pg8::gemm_phase<DFFE, DFFE * 2, DFFE * 2>(F.lds, Sd, E); }
            if (IN(pb) && IN(pb + 1)) xcd_barrier(bar);
        }
    }
    if (IN(33)) { ln_phase<2>(F, 5); }
#undef IN
#undef SEAM
}

extern "C" void kernel_launch(void* const* d_in, const int* in_sizes, int n_in, void* d_out, int out_size, void* d_ws, size_t ws_size, hipStream_t stream) {
    static int grid = 0;
    if (grid == 0) {
        if (n_in != 30 || out_size != M * D || ws_size < WS_END) { fprintf(stderr, "kernel_launch: unexpected shapes (n_in %d, out %d, ws %zu < %zu); nothing launched\n", n_in, out_size, ws_size, (size_t)WS_END); grid = -1; return; }
        int dev = 0, cus = 0, per_cu = 0;
        if (hipGetDevice(&dev) != hipSuccess || hipDeviceGetAttribute(&cus, hipDeviceAttributeMultiprocessorCount, dev) != hipSuccess) { grid = -1; return; }
        if (hipFuncSetAttribute((const void*)skel_fwd, hipFuncAttributeMaxDynamicSharedMemorySize, LDS_BYTES) != hipSuccess) { fprintf(stderr, "kernel_launch: hipFuncSetAttribute failed\n"); grid = -1; return; }
        if (hipOccupancyMaxActiveBlocksPerMultiprocessor(&per_cu, (const void*)skel_fwd, NWAVES * 64, LDS_BYTES) != hipSuccess || per_cu < 1)
            fprintf(stderr, "kernel_launch: occupancy query reports %d workgroups per CU\n", per_cu);
        (void)hipGetLastError();
        grid = cus;
    }
    if (grid < 0) return;
    if (hipMemsetAsync((char*)d_ws + WS_CTL, 0, CTL_ZERO_BYTES, stream) != hipSuccess) return;
    Args a{};
    for (int i = 0; i < 30; ++i) a.in[i] = (const float*)d_in[i];
    a.out = (float*)d_out; a.ws = (unsigned char*)d_ws;
#if MK_ONE_LAUNCH
    a.ph_lo = 0; a.ph_hi = NPHASE;
    hipLaunchKernelGGL(skel_fwd, dim3(grid), dim3(NWAVES * 64), LDS_BYTES, stream, a);
#else
    for (int p = 0; p < NPHASE; ++p) { a.ph_lo = p; a.ph_hi = p + 1; hipLaunchKernelGGL(skel_fwd, dim3(grid), dim3(NWAVES * 64), LDS_BYTES, stream, a); }
#endif
}
```

```cpp
#include <hip/hip_runtime.h>
#include <cstdio>
#include <cstdint>

#ifndef MK_ONE_LAUNCH
#define MK_ONE_LAUNCH 1
#endif

constexpr size_t ROWTOK_OFF = 5u * 1048576u + 512u * 1024u, ROWW_OFF = 6u * 1048576u, TILEEXP_OFF = 6u * 1048576u + 512u * 1024u, DUMMY_OFF = 7u * 1048576u;
namespace pg8 {
#define PG8_LAS __attribute__((address_space(3)))
typedef unsigned short bf16_t;
typedef short bf16x8 __attribute__((ext_vector_type(8)));
typedef float f32x4 __attribute__((ext_vector_type(4)));
typedef unsigned u32x4 __attribute__((ext_vector_type(4)));
constexpr int BM = 256, BK = 64, HALF = 128, HTB = HALF * BK * 2, STAGE_BYTES = 8 * HTB, NXCD = 8, WGM = 8;

__host__ __device__ __forceinline__ int lds_byte(int r, int c) { const int st = (r >> 4) * 2 + (c >> 5), rr = r & 15, cc = c & 31, ob = rr * 64 + cc * 2; return st * 1024 + (ob ^ (((ob >> 9) & 1) << 5)); }
__host__ __device__ __forceinline__ void stage_rc(int b, int& R, int& C) { const int st = b / 1024, sb = b % 1024, swz = sb ^ (((sb >> 9) & 1) << 5); R = (st >> 1) * 16 + swz / 64; C = (st & 1) * 32 + (swz % 64) / 2; }
__host__ __device__ __forceinline__ int perm32(int rho) { const int n = rho >> 4, i = rho & 15; return 8 * (i >> 2) + 4 * n + (i & 3); }

__device__ __forceinline__ const void* opaque_uniform(const void* p) {
    unsigned lo = __builtin_amdgcn_readfirstlane((unsigned)(unsigned long long)p), hi = __builtin_amdgcn_readfirstlane((unsigned)((unsigned long long)p >> 32));
    asm volatile("" : "+s"(lo), "+s"(hi)); return (const void*)(((unsigned long long)hi << 32) | lo); }
struct Unit { int pm, pn, aux; const char* a; const char* b; };

__device__ __forceinline__ void tile_of(int wgid, int nM, int nN, int& pm, int& pn) {
    const int nwg = nM * nN;
    { const int q = nwg / NXCD, r = nwg % NXCD, xcd = wgid % NXCD, off = wgid / NXCD; wgid = (xcd < r ? xcd * (q + 1) : r * (q + 1) + (xcd - r) * q) + off; }
    const int nig = WGM * nN, gid = wgid / nig, fm = gid * WGM, gsz = (nM - fm) < WGM ? (nM - fm) : WGM;
    pm = fm + ((wgid % nig) % gsz); pn = (wgid % nig) / gsz;
}
template <size_t A_TILE, size_t B_TILE>
struct StaticSched {
    const char* A; const char* B; int nM, nN, G, c, wave;
    __device__ __forceinline__ bool next(int i, Unit& u) const {
        const long L = (long)i * G + c; if (L >= (long)nM * nN) return false;
        int pm, pn; tile_of((int)L, nM, nN, pm, pn);
        u.pm = pm; u.pn = pn; u.aux = 0; u.a = A + (size_t)pm * A_TILE; u.b = B + (size_t)pn * B_TILE; return true;
    }
};
template <size_t A_OFF, size_t B_OFF, size_t A_TILE, size_t B_TILE, size_t B_EXP, int A_LOCAL>
struct MoeSched {
    const unsigned char* ws; int t0, nT, nN, G, c, wave;
    __device__ __forceinline__ bool next(int i, Unit& u) const {
        const long L = (long)i * G + c; if (L >= (long)nT * nN) return false;
        int pml, pn; tile_of((int)L, nT, nN, pml, pn);
        const unsigned char* wsb = (const unsigned char*)opaque_uniform(ws);
        const int pm = t0 + pml; const int e = __builtin_amdgcn_readfirstlane(((const int*)(wsb + TILEEXP_OFF))[pm]);
        u.pm = pm; u.pn = pn; u.aux = pml; u.a = (const char*)wsb + A_OFF + (size_t)(A_LOCAL ? pml : pm) * A_TILE; u.b = (const char*)wsb + B_OFF + (size_t)e * B_EXP + (size_t)pn * B_TILE; return true;
    }
};

__device__ __forceinline__ unsigned cvt_pk_bf16(float lo, float hi) { unsigned r; asm volatile("v_cvt_pk_bf16_f32 %0, %1, %2" : "=v"(r) : "v"(lo), "v"(hi)); return r; }

struct EpiBf16 {
    static constexpr bool PERM = true;
    bf16_t* O; int ldc;
    __device__ __forceinline__ void operator()(const f32x4 (&acc)[2][2][4][2], const Unit& u, int wr, int wc, int fr, int fq) const {
        const int row0 = u.pm * BM + wr * 64 + fr, col0 = u.pn * BM + wc * 32 + 8 * fq;
#pragma unroll
        for (int ai = 0; ai < 2; ++ai)
#pragma unroll
            for (int m = 0; m < 4; ++m) { bf16_t* rowp = O + (size_t)(row0 + ai * HALF + m * 16) * ldc + col0;
#pragma unroll
                for (int bj = 0; bj < 2; ++bj) { const f32x4 v0 = acc[ai][bj][m][0], v1 = acc[ai][bj][m][1];
                    u32x4 w; w.x = cvt_pk_bf16(v0[0], v0[1]); w.y = cvt_pk_bf16(v0[2], v0[3]); w.z = cvt_pk_bf16(v1[0], v1[1]); w.w = cvt_pk_bf16(v1[2], v1[3]);
                    *(u32x4*)(rowp + bj * HALF) = w; } }
    }
};
struct EpiAcc {
    static constexpr bool PERM = false;
    float* C; int ldc;
    __device__ __forceinline__ void operator()(const f32x4 (&acc)[2][2][4][2], const Unit& u, int wr, int wc, int fr, int fq) const {
        const int row0 = u.pm * BM + wr * 64 + fr, col0 = u.pn * BM + wc * 32 + 4 * fq;
#pragma unroll
        for (int ai = 0; ai < 2; ++ai)
#pragma unroll
            for (int m = 0; m < 4; ++m) { float* rowp = C + (size_t)(row0 + ai * HALF + m * 16) * ldc + col0;
                f32x4 o[2][2];
#pragma unroll
                for (int bj = 0; bj < 2; ++bj)
#pragma unroll
                    for (int n = 0; n < 2; ++n) o[bj][n] = *(const f32x4*)(rowp + bj * HALF + n * 16);
#pragma unroll
                for (int bj = 0; bj < 2; ++bj)
#pragma unroll
                    for (int n = 0; n < 2; ++n) *(f32x4*)(rowp + bj * HALF + n * 16) = o[bj][n] + acc[ai][bj][m][n]; }
    }
};
__device__ __forceinline__ float silu_f(float x) { return x / (1.0f + __expf(-x)); }
struct EpiSwiglu {
    static constexpr bool PERM = true;
    bf16_t* O; int ldc; int row_local;
    __device__ __forceinline__ void operator()(const f32x4 (&acc)[2][2][4][2], const Unit& u, int wr, int wc, int fr, int fq) const {
        const int row0 = (row_local ? u.aux : u.pm) * BM + wr * 64 + fr, col0 = u.pn * HALF + wc * 32 + 8 * fq;
#pragma unroll
        for (int ai = 0; ai < 2; ++ai)
#pragma unroll
            for (int m = 0; m < 4; ++m) { bf16_t* rowp = O + (size_t)(row0 + ai * HALF + m * 16) * ldc + col0;
                const f32x4 g0 = acc[ai][0][m][0], g1 = acc[ai][0][m][1], u0 = acc[ai][1][m][0], u1 = acc[ai][1][m][1];
                float h[8];
#pragma unroll
                for (int j = 0; j < 4; ++j) { h[j] = silu_f(g0[j]) * u0[j]; h[4 + j] = silu_f(g1[j]) * u1[j]; }
                u32x4 w; w.x = cvt_pk_bf16(h[0], h[1]); w.y = cvt_pk_bf16(h[2], h[3]); w.z = cvt_pk_bf16(h[4], h[5]); w.w = cvt_pk_bf16(h[6], h[7]);
                *(u32x4*)rowp = w; }
    }
};
struct EpiMoeDown {
    static constexpr bool PERM = false;
    float* C; unsigned char* ws;
    __device__ __forceinline__ void operator()(const f32x4 (&acc)[2][2][4][2], const Unit& u, int wr, int wc, int fr, int fq) const {
        const int row0 = u.pm * BM + wr * 64 + fr, col0 = u.pn * BM + wc * 32 + 4 * fq;
        unsigned char* wsb = (unsigned char*)opaque_uniform(ws);
        const int* rowtok = (const int*)(wsb + ROWTOK_OFF); const float* roww = (const float*)(wsb + ROWW_OFF); float* dummy = (float*)(wsb + DUMMY_OFF);
#pragma unroll
        for (int ai = 0; ai < 2; ++ai)
#pragma unroll
            for (int m = 0; m < 4; ++m) { const int r = row0 + ai * HALF + m * 16; const int tok = rowtok[r]; const float w = roww[r];
                float* rowp = (tok >= 0 ? C + (size_t)tok * 1024 : dummy) + col0;
                f32x4 o[2][2];
#pragma unroll
                for (int bj = 0; bj < 2; ++bj)
#pragma unroll
                    for (int n = 0; n < 2; ++n) o[bj][n] = *(const f32x4*)(rowp + bj * HALF + n * 16);
#pragma unroll
                for (int bj = 0; bj < 2; ++bj)
#pragma unroll
                    for (int n = 0; n < 2; ++n) *(f32x4*)(rowp + bj * HALF + n * 16) = o[bj][n] + acc[ai][bj][m][n] * w; }
    }
};

template <int K, int lda_b, int ldb_b, class Epi, class Sched>
__device__ __forceinline__ void gemm_phase(PG8_LAS unsigned char* lds, const Sched& S, const Epi& E) {
    int tid_ = (int)__builtin_amdgcn_mbcnt_hi(~0u, __builtin_amdgcn_mbcnt_lo(~0u, 0u)); asm volatile("" : "+v"(tid_)); tid_ += S.wave * 64;
    const int tid = tid_, wid = __builtin_amdgcn_readfirstlane(tid >> 6), lane = tid & 63, wr = wid >> 2, wc = wid & 3, fr = lane & 15, fq = lane >> 4;
    constexpr int nt = K / BK;
    unsigned voffA[2], voffB[2];
#pragma unroll
    for (int i = 0; i < 2; ++i) { int R, C; stage_rc(tid * 16 + i * 8192, R, C); const int Rb = Epi::PERM ? ((R & ~31) + perm32(R & 31)) : R;
        voffA[i] = (unsigned)(R * lda_b + C * 2); voffB[i] = (unsigned)(Rb * ldb_b + C * 2); }
    const size_t kstep = (size_t)(BK * 2);
    const size_t hstepA = (size_t)HALF * lda_b, hstepB = (size_t)HALF * ldb_b;
    const unsigned ldsw = (unsigned)wid * 1024u;
    const int aoff = lds_byte(wr * 64 + fr, fq * 8), boff = lds_byte(wc * 32 + fr, fq * 8);
#define PG8_SA(b, h) (((b) * 2 + (h)) * HTB)
#define PG8_SB(b, h) ((4 + (b) * 2 + (h)) * HTB)
#define PG8_STAGE(bufoff, gbase, voff) do { _Pragma("unroll") for (int _i = 0; _i < 2; ++_i) \
        __builtin_amdgcn_global_load_lds((const unsigned*)((const char*)(gbase) + (voff)[_i]), (PG8_LAS unsigned*)(lds + (bufoff) + ldsw + _i * 8192), 16, 0, 0); } while (0)
#define PG8_LDA(dst, b, h) do { _Pragma("unroll") for (int m = 0; m < 4; ++m) _Pragma("unroll") for (int k = 0; k < 2; ++k) dst[m][k] = *(const PG8_LAS bf16x8*)(lds + PG8_SA(b, h) + aoff + m * 2048 + k * 1024); } while (0)
#define PG8_LDB(dst, b, h) do { _Pragma("unroll") for (int n = 0; n < 2; ++n) _Pragma("unroll") for (int k = 0; k < 2; ++k) dst[n][k] = *(const PG8_LAS bf16x8*)(lds + PG8_SB(b, h) + boff + n * 2048 + k * 1024); } while (0)
#define PG8_MMA(ai, bj, At, Bt) do { __builtin_amdgcn_s_setprio(1); _Pragma("unroll") for (int m = 0; m < 4; ++m) _Pragma("unroll") for (int n = 0; n < 2; ++n) _Pragma("unroll") for (int k = 0; k < 2; ++k) \
        acc[ai][bj][m][n] = __builtin_amdgcn_mfma_f32_16x16x32_bf16(Bt[n][k], At[m][k], acc[ai][bj][m][n], 0, 0, 0); __builtin_amdgcn_s_setprio(0); } while (0)
#define PG8_WAIT_V(n) asm volatile("s_waitcnt vmcnt(" #n ")" ::: "memory")
#define PG8_WAIT_L(n) asm volatile("s_waitcnt lgkmcnt(" #n ")" ::: "memory")
#define PG8_BAR __builtin_amdgcn_s_barrier()
#define PG8_SCHED __builtin_amdgcn_sched_barrier(0)
    Unit cur, nxt; int ui = 0;
    if (!S.next(0, cur)) return;
    f32x4 acc[2][2][4][2];
#pragma unroll
    for (int a = 0; a < 2; ++a)
#pragma unroll
        for (int b = 0; b < 2; ++b)
#pragma unroll
            for (int m = 0; m < 4; ++m)
#pragma unroll
                for (int n = 0; n < 2; ++n) acc[a][b][m][n] = (f32x4){0.f, 0.f, 0.f, 0.f};
    bf16x8 At[4][2], B0[2][2], B1[2][2];
    const char* cA = cur.a; const char* cB = cur.b;
    PG8_STAGE(PG8_SB(0, 0), cB, voffB); PG8_STAGE(PG8_SB(0, 1), cB + hstepB, voffB); PG8_STAGE(PG8_SA(0, 0), cA, voffA); PG8_STAGE(PG8_SA(0, 1), cA + hstepA, voffA);
    if (wr == 1) PG8_BAR;
    PG8_WAIT_V(2); PG8_BAR;
    PG8_STAGE(PG8_SB(1, 0), cB + kstep, voffB); PG8_STAGE(PG8_SA(1, 0), cA + kstep, voffA); PG8_STAGE(PG8_SB(1, 1), cB + hstepB + kstep, voffB);
    PG8_WAIT_V(6); PG8_BAR;
    for (;;) {
        const bool has_next = S.next(ui + 1, nxt);
        const char* nA = has_next ? nxt.a : cA; const char* nB = has_next ? nxt.b : cB;
        for (int t = 0; t < nt; t += 2) {
            const bool last = (t == nt - 2);
            const char* a1 = cA + (size_t)(t + 1) * kstep;
            const char* a2 = last ? nA : cA + (size_t)(t + 2) * kstep; const char* b2 = last ? nB : cB + (size_t)(t + 2) * kstep;
            const char* a3 = a2 + kstep; const char* b3 = b2 + kstep;
            PG8_LDB(B0, 0, 0); PG8_LDB(B1, 0, 1); PG8_SCHED; PG8_LDA(At, 0, 0); PG8_STAGE(PG8_SA(1, 1), a1 + hstepA, voffA);
            PG8_WAIT_V(8); PG8_WAIT_L(0); PG8_BAR; PG8_MMA(0, 0, At, B0); PG8_MMA(0, 1, At, B1); PG8_BAR; PG8_SCHED;
            PG8_LDA(At, 0, 1); PG8_STAGE(PG8_SB(0, 0), b2, voffB); PG8_STAGE(PG8_SB(0, 1), b2 + hstepB, voffB); PG8_STAGE(PG8_SA(0, 0), a2, voffA);
            PG8_WAIT_V(8); PG8_WAIT_L(0); PG8_BAR; PG8_MMA(1, 0, At, B0); PG8_MMA(1, 1, At, B1); PG8_BAR; PG8_SCHED;
            PG8_LDB(B0, 1, 0); PG8_LDB(B1, 1, 1); PG8_SCHED; PG8_LDA(At, 1, 0); PG8_STAGE(PG8_SA(0, 1), a2 + hstepA, voffA);
            PG8_WAIT_V(8); PG8_WAIT_L(0); PG8_BAR; PG8_MMA(0, 0, At, B0); PG8_MMA(0, 1, At, B1); PG8_BAR; PG8_SCHED;
            PG8_LDA(At, 1, 1); PG8_STAGE(PG8_SB(1, 0), b3, voffB); PG8_STAGE(PG8_SB(1, 1), b3 + hstepB, voffB); PG8_STAGE(PG8_SA(1, 0), a3, voffA);
            PG8_WAIT_V(8); PG8_WAIT_L(0); PG8_BAR; PG8_MMA(1, 0, At, B0); PG8_MMA(1, 1, At, B1); PG8_BAR; PG8_SCHED;
        }
        if (wr == 0) PG8_BAR;
        E(acc, cur, wr, wc, fr, fq);
        if (!has_next) break;
#pragma unroll
        for (int a = 0; a < 2; ++a)
#pragma unroll
            for (int b = 0; b < 2; ++b)
#pragma unroll
                for (int m = 0; m < 4; ++m)
#pragma unroll
                    for (int n = 0; n < 2; ++n) acc[a][b][m][n] = (f32x4){0.f, 0.f, 0.f, 0.f};
        cur = nxt; cA = nA; cB = nB; ++ui;
        if (wr == 1) PG8_BAR;
    }
    PG8_WAIT_V(0);
    PG8_BAR;
#undef PG8_SA
#undef PG8_SB
#undef PG8_STAGE
#undef PG8_LDA
#undef PG8_LDB
#undef PG8_MMA
#undef PG8_WAIT_V
#undef PG8_WAIT_L
#undef PG8_BAR
#undef PG8_SCHED
}
}

constexpr int NWAVES = 8;
constexpr int D = 1024, NB = 16, S = 2048, M = NB * S, MEML = 256, MMEM = NB * MEML;
constexpr float LN_EPS = 1e-5f, ALPHA = 1.41421356237f;
constexpr int P0_LD = 2560, C0_QLAT = 0, C0_QB = 1024, C0_CKV = 1536, C0_QI = 1664, C0_KI = 2176, C0_KB = 2240, C0_VB = 2368, C0_WI = 2496;
constexpr int P1_LD = 2048, C1_Q = 0, C1_KC = 1024, C1_VC = 1152, C1_KS = 1280, C1_VS = 1408, C1_KW = 1536, C1_VW = 1664, C1_GL = 1792;
constexpr int EVEN_COLS = 1992, ODD_COLS = 1840;
constexpr int DFF = 2816, DFFE = 3584, NE = 8, NCMP = 127;
constexpr int MOE_CHUNK_TILES = 68, MOE_MAX_TILES = 272;

constexpr size_t MiB = 1u << 20;
constexpr size_t WS_CTL = 0, CTL_ZERO_BYTES = 1 * MiB;
constexpr size_t WS_KC = 2 * MiB, WS_VC = 3 * MiB;
constexpr size_t WS_SELM = 4 * MiB;
constexpr size_t WS_RTE = 4 * MiB + 512 * 1024;
constexpr size_t WS_RTW = 5 * MiB;
constexpr size_t WS_ROWTOK = ROWTOK_OFF; static_assert(ROWTOK_OFF == 5 * MiB + 512 * 1024, "");
constexpr size_t WS_ROWW = ROWW_OFF;
constexpr size_t WS_TILEEXP = TILEEXP_OFF; constexpr size_t WS_DUMMY = DUMMY_OFF;
constexpr size_t WS_W = 8 * MiB;
constexpr size_t W_IN0 = WS_W;
constexpr size_t W_OUT0 = W_IN0 + (size_t)2560 * 1024 * 2;
constexpr size_t W_IN1 = W_OUT0 + (size_t)1024 * 1536 * 2;
constexpr size_t W_OUT1 = W_IN1 + (size_t)2048 * 1024 * 2;
constexpr size_t W_XQ = W_OUT1 + (size_t)1024 * 1024 * 2;
constexpr size_t W_XKV = W_XQ + (size_t)2 * 512 * 1024 * 2;
constexpr size_t W_XO = W_XKV + (size_t)2 * 1024 * 1024 * 2;
constexpr size_t W_FGU = W_XO + (size_t)2 * 1024 * 512 * 2;
constexpr size_t W_FD = W_FGU + (size_t)5632 * 1024 * 2;
constexpr size_t W_MGU = W_FD + (size_t)1024 * 2816 * 2;
constexpr size_t W_MD = W_MGU + (size_t)8 * 7168 * 1024 * 2;
constexpr size_t W_END = W_MD + (size_t)8 * 1024 * 3584 * 2;
static_assert(W_END <= 215 * MiB, "weights");
constexpr size_t WS_HB = 215 * MiB;
constexpr size_t WS_XKV = 279 * MiB;
constexpr size_t WS_SCR = 295 * MiB;
constexpr size_t WS_P0 = WS_SCR;
constexpr size_t WS_CN = WS_SCR + 160 * MiB;
constexpr size_t WS_MASK = WS_SCR + 168 * MiB;
constexpr size_t WS_MEMB = WS_SCR + 176 * MiB;
constexpr size_t WS_QX0 = WS_SCR + 184 * MiB, WS_OX0 = WS_SCR + 216 * MiB;
constexpr size_t WS_HID = WS_SCR;
constexpr size_t WS_P1 = WS_SCR;
constexpr size_t WS_OCMP = WS_SCR + 128 * MiB, WS_OSLC = WS_SCR + 192 * MiB;
constexpr size_t WS_QX1 = WS_SCR, WS_OX1 = WS_SCR + 32 * MiB;
constexpr size_t WS_PERMA = WS_SCR;
constexpr size_t WS_HIDM = WS_SCR + 136 * MiB;
constexpr size_t WS_END = WS_SCR + 256 * MiB;
static_assert(WS_HIDM + (size_t)MOE_CHUNK_TILES * 256 * DFFE * 2 <= WS_END, "ws");
constexpr int CW_BAR = 4096;
constexpr int CW_CNT = 16384;
constexpr int CW_CUR = 16384 + 64;

constexpr int RING_BYTES = 131072, LDSCTL_OFF = RING_BYTES, MISC_OFF = LDSCTL_OFF + 320, LDS_BYTES = 147456;

#define GAS __attribute__((address_space(1)))
#define LAS __attribute__((address_space(3)))
typedef unsigned short bf16;
typedef unsigned v4u __attribute__((ext_vector_type(4)));
typedef unsigned v2u __attribute__((ext_vector_type(2)));
typedef float f32x4 __attribute__((ext_vector_type(4)));
#define LDS_WAIT() asm volatile("s_waitcnt lgkmcnt(0)" ::: "memory")
#define WAVE_SYNC() asm volatile("s_waitcnt vmcnt(0) lgkmcnt(0)" ::: "memory")
__device__ __forceinline__ unsigned f2bf(float f) { unsigned u = __builtin_bit_cast(unsigned, f); return (u + 0x7fffu + ((u >> 16) & 1u)) >> 16; }
__device__ __forceinline__ unsigned pk2(float lo, float hi) { return f2bf(lo) | (f2bf(hi) << 16); }
__device__ __forceinline__ float bf2f(bf16 b) { return __builtin_bit_cast(float, (unsigned)b << 16); }
__device__ __forceinline__ float bflo(unsigned w) { return __builtin_bit_cast(float, w << 16); }
__device__ __forceinline__ float bfhi(unsigned w) { return __builtin_bit_cast(float, w & 0xffff0000u); }
__device__ __forceinline__ void ld8bf(const bf16* p, float* f) { const v4u w = *(const v4u*)p; f[0] = bflo(w.x); f[1] = bfhi(w.x); f[2] = bflo(w.y); f[3] = bfhi(w.y); f[4] = bflo(w.z); f[5] = bfhi(w.z); f[6] = bflo(w.w); f[7] = bfhi(w.w); }
__device__ __forceinline__ float wave_sum(float v) {
#pragma unroll
    for (int o = 1; o < 64; o <<= 1) v += __shfl_xor(v, o);
    return v;
}
__device__ __forceinline__ float wave_max(float v) {
#pragma unroll
    for (int o = 1; o < 64; o <<= 1) v = fmaxf(v, __shfl_xor(v, o));
    return v;
}
__device__ const unsigned char BKT[112] = {16, 16, 16, 17, 17, 18, 18, 18, 19, 19, 19, 20, 20, 20, 20, 21, 21, 21, 21, 22, 22, 22, 22, 22, 23, 23, 23, 23, 23, 23, 24, 24, 24, 24, 24, 24, 25, 25, 25, 25, 25, 25, 25, 26, 26, 26, 26, 26, 26, 26, 26,
    27, 27, 27, 27, 27, 27, 27, 27, 27, 27, 28, 28, 28, 28, 28, 28, 28, 28, 28, 28, 29, 29, 29, 29, 29, 29, 29, 29, 29, 29, 29, 29, 30, 30, 30, 30, 30, 30, 30, 30, 30, 30, 30, 30, 30, 30, 31, 31, 31, 31, 31, 31, 31, 31, 31, 31, 31, 31, 31, 31, 31};
__device__ __forceinline__ int rel_bucket(int n) { return n < 16 ? n : (n >= 128 ? 31 : (int)BKT[n - 16]); }

#define XB_TMO      128
#define XB_XCNT(j)  (256  + 64 * (j))
#define XB_XSUB(j)  (1280 + 64 * (j))
#define XB_XGEN(j)  (2304 + 64 * (j))
#define XB_TOP      3328
#define XB_TOPGEN   3392
#define XCD_BAR_WORDS 3456
#define XB_SPIN_CAP (1u << 22)
__device__ __forceinline__ unsigned xb_ld(unsigned* p)              { return __hip_atomic_load(p, __ATOMIC_RELAXED, __HIP_MEMORY_SCOPE_AGENT); }
__device__ __forceinline__ unsigned xb_add(unsigned* p, unsigned v) { return __hip_atomic_fetch_add(p, v, __ATOMIC_RELAXED, __HIP_MEMORY_SCOPE_AGENT); }
__device__ __forceinline__ unsigned xb_xcc_id() { return (unsigned)__builtin_amdgcn_s_getreg((3 << 11) | 20) & 0xFu; }
#define XB_SPIN(cond, bar) do { unsigned _sp = 0; while (cond) { __builtin_amdgcn_s_sleep(1); \
    if ((++_sp & 255u) == 0u) { if (xb_ld(&(bar)[XB_TMO])) break; if (_sp > XB_SPIN_CAP) { atomicAdd(&(bar)[XB_TMO], 1u); break; } } } } while (0)
struct XcdBarrier { unsigned* bar; unsigned x; volatile LAS unsigned* st; };
__device__ __forceinline__ XcdBarrier xcd_barrier_post(unsigned* bar, volatile LAS unsigned* st) {
    XcdBarrier b; b.bar = bar; b.x = xb_xcc_id(); b.st = st;
    if (threadIdx.x == 0) (void)xb_add(&bar[XB_XCNT(b.x)], 1u);
    return b;
}
__device__ __forceinline__ void xcd_barrier_complete(unsigned* bar, unsigned x, unsigned& nloc, unsigned& nx) {
    const unsigned G = gridDim.x * gridDim.y * gridDim.z;
    unsigned sum, cnt, mine, sp = 0u;
    for (;;) {
        sum = 0u; cnt = 0u; mine = 0u;
#pragma unroll
        for (unsigned j = 0; j < 16; ++j) { const unsigned c = xb_ld(&bar[XB_XCNT(j)]); sum += c; cnt += (c > 0u) ? 1u : 0u; mine = (j == x) ? c : mine; }
        if (sum == G) break;
        __builtin_amdgcn_s_sleep(1);
        if ((++sp & 255u) == 0u) { if (xb_ld(&bar[XB_TMO])) break; if (sp > XB_SPIN_CAP) { atomicAdd(&bar[XB_TMO], 1u); break; } }
    }
    nloc = mine > 0u ? mine : 1u; nx = cnt > 0u ? cnt : 1u;
}
__device__ __forceinline__ void xcd_barrier(const XcdBarrier& b) {
    asm volatile("s_waitcnt vmcnt(0)" ::: "memory");
    __syncthreads();
    if (threadIdx.x == 0) {
        unsigned* bar = b.bar;
        __builtin_amdgcn_s_waitcnt(0);
        unsigned nloc = b.st[0], nx = b.st[1];
        const unsigned old = xb_add(&bar[XB_XSUB(b.x)], 1u);
        const unsigned gen = old / nloc;
        if (old + 1u == (gen + 1u) * nloc) {
            __builtin_amdgcn_fence(__ATOMIC_RELEASE, "agent");
            asm volatile("s_waitcnt vmcnt(0)" ::: "memory");
            const unsigned og = xb_add(&bar[XB_TOP], 1u);
            const unsigned tg = og / nx;
            if (og + 1u == (tg + 1u) * nx) xb_add(&bar[XB_TOPGEN], 1u);
            else XB_SPIN(xb_ld(&bar[XB_TOPGEN]) == tg, bar);
            __builtin_amdgcn_fence(__ATOMIC_ACQUIRE, "agent");
            xb_add(&bar[XB_XGEN(b.x)], 1u);
            asm volatile("s_waitcnt vmcnt(0)" ::: "memory");
        } else {
            XB_SPIN(xb_ld(&bar[XB_XGEN(b.x)]) == gen, bar);
            __builtin_amdgcn_fence(__ATOMIC_ACQUIRE, "agent");
            asm volatile("s_waitcnt vmcnt(0)" ::: "memory");
        }
    }
    __syncthreads();
}

struct Args { const float* in[30]; float* out; unsigned char* ws; int ph_lo, ph_hi; };
enum { I_X = 0, I_MEM, I_REL, I_EV_WIN, I_EV_GAIN, I_EV_WUK, I_EV_WUV, I_EV_SINK, I_EV_WOUT, I_OD_WIN, I_OD_PEK, I_OD_W1K, I_OD_W2K, I_OD_PEV, I_OD_W1V, I_OD_W2V, I_OD_WOUT,
       I_XA_WQ, I_XA_WK, I_XA_WV, I_XA_WO, I_FF_G, I_FF_U, I_FF_D, I_MOE_R, I_MOE_G, I_MOE_U, I_MOE_D, I_LN_G, I_LN_B };

struct Frame {
    LAS unsigned char* lds;
    unsigned char* ws; float* acc;
    const float* const* in;
    int tid, lane, wave, G, gw, NGW;
};

__device__ __forceinline__ bool fresh(Frame& F) { int l = (int)__builtin_amdgcn_mbcnt_hi(~0u, __builtin_amdgcn_mbcnt_lo(~0u, 0u)); asm volatile("" : "+v"(l)); F.lane = l; F.tid = F.wave * 64 + l; return true; }
__device__ __forceinline__ void tconv_item(const float* W, int ldw, int ncols, bf16* WT, int ldt, int grp, int gstride, LAS float* scr, int kb, int nb, int lane) {
    const int k0 = 64 * kb, n0 = 32 * nb;
#pragma unroll 8
    for (int i = 0; i < 32; ++i) { const int kk = 2 * i + (lane >> 5), n = n0 + (lane & 31); scr[kk * 33 + (lane & 31)] = (n < ncols) ? W[(size_t)(k0 + kk) * ldw + n] : 0.f; }
    LDS_WAIT();
    const int c = lane & 7;
#pragma unroll
    for (int j = 0; j < 4; ++j) { const int nn = (lane >> 3) + 8 * j, n = n0 + nn; const LAS float* s = scr + (8 * c) * 33 + nn;
        v4u o; o.x = pk2(s[0 * 33], s[1 * 33]); o.y = pk2(s[2 * 33], s[3 * 33]); o.z = pk2(s[4 * 33], s[5 * 33]); o.w = pk2(s[6 * 33], s[7 * 33]);
        const int row = (n / grp) * gstride + (n % grp);
        *(v4u*)(WT + (size_t)row * ldt + k0 + 8 * c) = o; }
    LDS_WAIT();
}
__device__ __forceinline__ void tconv(const Frame& F, const float* W, int ldw, int K, int ncols, int npad, bf16* WT, int ldt, int grp, int gstride) {
    LAS float* scr = (LAS float*)(F.lds + F.wave * 16384);
    const int nkb = K / 64, nnb = npad / 32;
    for (int it = F.gw; it < nkb * nnb; it += F.NGW) tconv_item(W, ldw, ncols, WT, ldt, grp, gstride, scr, it / nnb, it % nnb, F.lane);
}
constexpr int NOGRP = 1 << 30;

__device__ __forceinline__ void prologue(const Frame& F) {
    unsigned char* ws = F.ws;
    const int gt = F.gw * 64 + F.lane, NT = F.NGW * 64;
    bf16* win0 = (bf16*)(ws + W_IN0);
    const float* evw = F.in[I_EV_WIN];
    tconv(F, evw + 512, EVEN_COLS, 1024, 128, 128, win0 + (size_t)C0_CKV * 1024, 1024, NOGRP, 0);
    tconv(F, evw + 640, EVEN_COLS, 1024, 512, 512, win0 + (size_t)C0_QI * 1024, 1024, NOGRP, 0);
    tconv(F, evw + 1152, EVEN_COLS, 1024, 64, 64, win0 + (size_t)C0_KI * 1024, 1024, NOGRP, 0);
    tconv(F, evw + 1216, EVEN_COLS, 1024, 8, 64, win0 + (size_t)C0_WI * 1024, 1024, NOGRP, 0);
    tconv(F, evw + 1224, EVEN_COLS, 1024, 512, 512, win0 + (size_t)C0_QB * 1024, 1024, NOGRP, 0);
    tconv(F, evw + 1736, EVEN_COLS, 1024, 128, 128, win0 + (size_t)C0_KB * 1024, 1024, NOGRP, 0);
    tconv(F, evw + 1864, EVEN_COLS, 1024, 128, 128, win0 + (size_t)C0_VB * 1024, 1024, NOGRP, 0);
    {
        const float* wuk = F.in[I_EV_WUK];
        for (int idx = gt; idx < 1024 * 1024; idx += NT) { const int r = idx >> 10, k = idx & 1023, h = r >> 7, c = r & 127;
            const float* wr = evw + (size_t)k * EVEN_COLS + h * 64; const float* uk = wuk + (size_t)h * 64 * 128 + c; float s = 0.f;
#pragma unroll 8
            for (int d = 0; d < 64; ++d) s += wr[d] * uk[d * 128];
            win0[(size_t)(C0_QLAT + r) * 1024 + k] = (bf16)f2bf(s); }
    }
    bf16* wout0 = (bf16*)(ws + W_OUT0);
    const float* evo = F.in[I_EV_WOUT];
    tconv(F, evo + (size_t)512 * 1024, 1024, 512, 1024, 1024, wout0 + 1024, 1536, NOGRP, 0);
    {
        const float* wuv = F.in[I_EV_WUV];
        for (int idx = gt; idx < 1024 * 1024; idx += NT) { const int n = idx >> 10, kk = idx & 1023, h = kk >> 7;
            const float* uv = wuv + (size_t)kk * 64; const float* wo = evo + (size_t)h * 64 * 1024 + n; float s = 0.f;
#pragma unroll 8
            for (int d = 0; d < 64; ++d) s += uv[d] * wo[(size_t)d * 1024];
            wout0[(size_t)n * 1536 + kk] = (bf16)f2bf(s); }
    }
    tconv(F, F.in[I_OD_WIN], ODD_COLS, 1024, ODD_COLS, 2048, (bf16*)(ws + W_IN1), 1024, NOGRP, 0);
    tconv(F, F.in[I_OD_WOUT], 1024, 1024, 1024, 1024, (bf16*)(ws + W_OUT1), 1024, NOGRP, 0);
    for (int i = 0; i < 2; ++i) {
        tconv(F, F.in[I_XA_WQ] + (size_t)i * 1024 * 512, 512, 1024, 512, 512, (bf16*)(ws + W_XQ) + (size_t)i * 512 * 1024, 1024, NOGRP, 0);
        tconv(F, F.in[I_XA_WK] + (size_t)i * 1024 * 512, 512, 1024, 512, 512, (bf16*)(ws + W_XKV) + (size_t)i * 1024 * 1024, 1024, NOGRP, 0);
        tconv(F, F.in[I_XA_WV] + (size_t)i * 1024 * 512, 512, 1024, 512, 512, (bf16*)(ws + W_XKV) + (size_t)i * 1024 * 1024 + (size_t)512 * 1024, 1024, NOGRP, 0);
        tconv(F, F.in[I_XA_WO] + (size_t)i * 512 * 1024, 1024, 512, 1024, 1024, (bf16*)(ws + W_XO) + (size_t)i * 1024 * 512, 512, NOGRP, 0);
    }
    tconv(F, F.in[I_FF_G], DFF, 1024, DFF, DFF, (bf16*)(ws + W_FGU), 1024, 128, 256);
    tconv(F, F.in[I_FF_U], DFF, 1024, DFF, DFF, (bf16*)(ws + W_FGU) + (size_t)128 * 1024, 1024, 128, 256);
    tconv(F, F.in[I_FF_D], 1024, DFF, 1024, 1024, (bf16*)(ws + W_FD), DFF, NOGRP, 0);
    for (int e = 0; e < NE; ++e) {
        tconv(F, F.in[I_MOE_G] + (size_t)e * 1024 * DFFE, DFFE, 1024, DFFE, DFFE, (bf16*)(ws + W_MGU) + (size_t)e * 7168 * 1024, 1024, 128, 256);
        tconv(F, F.in[I_MOE_U] + (size_t)e * 1024 * DFFE, DFFE, 1024, DFFE, DFFE, (bf16*)(ws + W_MGU) + (size_t)e * 7168 * 1024 + (size_t)128 * 1024, 1024, 128, 256);
        tconv(F, F.in[I_MOE_D] + (size_t)e * DFFE * 1024, 1024, DFFE, 1024, 1024, (bf16*)(ws + W_MD) + (size_t)e * 1024 * DFFE, DFFE, NOGRP, 0);
    }
    {
        const f32x4* x4 = (const f32x4*)F.in[I_X]; v2u* hb = (v2u*)(ws + WS_HB); f32x4* a4 = (f32x4*)F.acc;
        for (int i = gt; i < M * D / 4; i += NT) { const f32x4 v = x4[i]; v2u o; o.x = pk2(v.x, v.y); o.y = pk2(v.z, v.w); hb[i] = o; a4[i] = v * ALPHA; }
        const f32x4* m4 = (const f32x4*)F.in[I_MEM]; v2u* mb = (v2u*)(ws + WS_MEMB);
        for (int i = gt; i < MMEM * D / 4; i += NT) { const f32x4 v = m4[i]; v2u o; o.x = pk2(v.x, v.y); o.y = pk2(v.z, v.w); mb[i] = o; }
    }
}

template <int MODE>
__device__ __forceinline__ void ln_phase(const Frame& F, int li) {
    const float* g = F.in[I_LN_G] + (size_t)li * D; const float* bb = F.in[I_LN_B] + (size_t)li * D;
    LAS int* lcnt = (LAS int*)F.lds;
    if (MODE == 1) { if (F.tid < 16) lcnt[F.tid] = 0; __syncthreads(); }
    for (int row = F.gw; row < M; row += F.NGW) {
        f32x4* p = (f32x4*)(F.acc + (size_t)row * D) + F.lane;
        f32x4 v[4]; float s = 0.f;
#pragma unroll
        for (int j = 0; j < 4; ++j) { v[j] = p[64 * j]; s += (v[j].x + v[j].y) + (v[j].z + v[j].w); }
        const float mean = wave_sum(s) * (1.f / D); float s2 = 0.f;
#pragma unroll
        for (int j = 0; j < 4; ++j) { v[j] = v[j] - mean; s2 += (v[j].x * v[j].x + v[j].y * v[j].y) + (v[j].z * v[j].z + v[j].w * v[j].w); }
        const float rstd = 1.f / sqrtf(wave_sum(s2) * (1.f / D) + LN_EPS);
#pragma unroll
        for (int j = 0; j < 4; ++j) { const f32x4 gg = ((const f32x4*)g)[F.lane + 64 * j], b4 = ((const f32x4*)bb)[F.lane + 64 * j]; v[j] = v[j] * rstd * gg + b4; }
        if (MODE == 2) {
#pragma unroll
            for (int j = 0; j < 4; ++j) p[64 * j] = v[j];
        } else {
            v2u* hb = (v2u*)(F.ws + WS_HB + (size_t)row * D * 2) + F.lane;
#pragma unroll
            for (int j = 0; j < 4; ++j) { v2u o; o.x = pk2(v[j].x, v[j].y); o.y = pk2(v[j].z, v[j].w); hb[64 * j] = o; p[64 * j] = v[j] * ALPHA; }
        }
        if (MODE == 1) {
            const float* wr = F.in[I_MOE_R]; float lg[8];
#pragma unroll
            for (int e = 0; e < 8; ++e) lg[e] = 0.f;
#pragma unroll
            for (int j = 0; j < 4; ++j)
#pragma unroll
                for (int i = 0; i < 4; ++i) { const int c = 4 * (F.lane + 64 * j) + i; const f32x4 w0 = *(const f32x4*)(wr + (size_t)c * 8), w1 = *(const f32x4*)(wr + (size_t)c * 8 + 4); const float y = v[j][i];
                    lg[0] += y * w0.x; lg[1] += y * w0.y; lg[2] += y * w0.z; lg[3] += y * w0.w; lg[4] += y * w1.x; lg[5] += y * w1.y; lg[6] += y * w1.z; lg[7] += y * w1.w; }
#pragma unroll
            for (int e = 0; e < 8; ++e) lg[e] = wave_sum(lg[e]);
            int e0 = 0; float v0 = lg[0];
#pragma unroll
            for (int e = 1; e < 8; ++e) if (lg[e] > v0) { v0 = lg[e]; e0 = e; }
            int e1 = -1; float v1 = -3.0e38f;
#pragma unroll
            for (int e = 0; e < 8; ++e) if (e != e0 && lg[e] > v1) { v1 = lg[e]; e1 = e; }
            const float w0 = 1.f / (1.f + __expf(v1 - v0)), w1 = 1.f - w0;
            if (F.lane == 0) { int* rte = (int*)(F.ws + WS_RTE); float* rtw = (float*)(F.ws + WS_RTW); rte[2 * row] = e0; rte[2 * row + 1] = e1; rtw[2 * row] = w0; rtw[2 * row + 1] = w1;
                atomicAdd((int*)&lcnt[e0], 1); atomicAdd((int*)&lcnt[8 + e1], 1); }
        }
    }
    if (MODE == 1) { __syncthreads(); if (F.tid < 16) { const int c = lcnt[F.tid]; if (c) atomicAdd((unsigned*)(F.ws + WS_CTL) + CW_CNT + F.tid, (unsigned)c); } }
}

__device__ __forceinline__ void moe_dispatch(const Frame& F) {
    unsigned* ctl = (unsigned*)(F.ws + WS_CTL);
    int* tile_exp = (int*)(F.ws + WS_TILEEXP); int* rowtok = (int*)(F.ws + WS_ROWTOK); float* roww = (float*)(F.ws + WS_ROWW);
    LAS int* seg = (LAS int*)F.lds;
    if (F.tid == 0) { int run = 0;
#pragma unroll 1
        for (int sgi = 0; sgi < 16; ++sgi) { if ((sgi & 7) == 0) seg[32 + (sgi >> 3)] = run >> 8; seg[sgi] = run; const int c = (int)__hip_atomic_load(ctl + CW_CNT + sgi, __ATOMIC_RELAXED, __HIP_MEMORY_SCOPE_AGENT); seg[16 + sgi] = c; run += (c + 255) & ~255; }
        seg[34] = run >> 8; }
    __syncthreads();
    if (blockIdx.x == 0) {
#pragma unroll 1
        for (int sgi = 0; sgi < 16; ++sgi) { const int c = seg[16 + sgi], st = seg[sgi], en = st + ((c + 255) & ~255);
            for (int t = (st >> 8) + F.tid; t < (en >> 8); t += 512) tile_exp[t] = sgi & 7;
            for (int r = st + c + F.tid; r < en; r += 512) { rowtok[r] = -1; roww[r] = 0.f; } }
        if (F.tid < 3) tile_exp[512 + F.tid] = seg[32 + F.tid];
    }
    const int* rte = (const int*)(F.ws + WS_RTE); const float* rtw = (const float*)(F.ws + WS_RTW);
    for (int base = F.gw * 64; base < M; base += F.NGW * 64) {
        const int tok = base + F.lane; const int e0 = rte[2 * tok], e1 = rte[2 * tok + 1]; const float w0 = rtw[2 * tok], w1 = rtw[2 * tok + 1];
        int pos0 = 0, pos1 = 0;
#pragma unroll 1
        for (int sgi = 0; sgi < 16; ++sgi) { const bool mine = (sgi < 8) ? (e0 == sgi) : (e1 == sgi - 8);
            const unsigned long long bal = __ballot(mine);
            if (bal) { const int n = __popcll(bal); unsigned b0 = 0; if (F.lane == 0) b0 = atomicAdd(ctl + CW_CUR + sgi, (unsigned)n); b0 = __shfl(b0, 0);
                const int rank = __popcll(bal & ((1ull << F.lane) - 1ull));
                if (mine) { const int pos = seg[sgi] + (int)b0 + rank; if (sgi < 8) pos0 = pos; else pos1 = pos; } } }
        rowtok[pos0] = tok; roww[pos0] = w0; rowtok[pos1] = tok; roww[pos1] = w1;
#pragma unroll 1
        for (int i = 0; i < 64; ++i) { const int tk = base + i; const int p0 = __shfl(pos0, i), p1 = __shfl(pos1, i);
            const v4u* src = (const v4u*)(F.ws + WS_HB + (size_t)tk * D * 2);
            v4u* d0 = (v4u*)(F.ws + WS_PERMA + (size_t)p0 * D * 2); v4u* d1 = (v4u*)(F.ws + WS_PERMA + (size_t)p1 * D * 2);
            const v4u a = src[F.lane], b = src[F.lane + 64]; d0[F.lane] = a; d0[F.lane + 64] = b; d1[F.lane] = a; d1[F.lane + 64] = b; }
    }
    __syncthreads();
}

__device__ __forceinline__ void cn_phase(const Frame& F) {
    const bf16* P0 = (const bf16*)(F.ws + WS_P0); bf16* CN = (bf16*)(F.ws + WS_CN); const float* gain = F.in[I_EV_GAIN];
    for (int row = F.gw; row < M; row += F.NGW) {
        const unsigned w = *(const unsigned*)(P0 + (size_t)row * P0_LD + C0_CKV + 2 * F.lane); const float a = bflo(w), b = bfhi(w);
        const float ms = wave_sum(a * a + b * b) * (1.f / 128.f); const float r = 1.f / sqrtf(ms + LN_EPS);
        *(unsigned*)(CN + (size_t)row * 128 + 2 * F.lane) = pk2(a * r * gain[2 * F.lane], b * r * gain[2 * F.lane + 1]);
    }
}

__device__ __forceinline__ unsigned fkey(float x) { unsigned b = __builtin_bit_cast(unsigned, x); if (b == 0x80000000u) b = 0u; return (b & 0x80000000u) ? ~b : (b | 0x80000000u); }
__device__ __forceinline__ void idx_phase(const Frame& F) {
    const bf16* P0 = (const bf16*)(F.ws + WS_P0); unsigned* MASK = (unsigned*)(F.ws + WS_MASK);
    LAS float* qi_s = (LAS float*)F.lds; LAS float* wi_s = qi_s + 4096; LAS float* sc = wi_s + 64;
    for (int item = blockIdx.x; item < NB * (S / 8); item += F.G) {
        const int b = item / (S / 8), t0 = (item % (S / 8)) * 8;
        for (int i = F.tid; i < 4096; i += 512) { const int q = i >> 9, e = i & 511; qi_s[i] = bf2f(P0[(size_t)(b * S + t0 + q) * P0_LD + C0_QI + e]); }
        if (F.tid < 64) { const int q = F.tid >> 3, h = F.tid & 7; wi_s[F.tid] = bf2f(P0[(size_t)(b * S + t0 + q) * P0_LD + C0_WI + h]) * (0.35355339059f * 0.125f); }
        __syncthreads();
        const int nk = t0 + 8;
        for (int s = F.tid; s < nk; s += 512) {
            float kf[64]; const bf16* kr = P0 + (size_t)(b * S + s) * P0_LD + C0_KI;
#pragma unroll
            for (int j = 0; j < 8; ++j) ld8bf(kr + 8 * j, kf + 8 * j);
#pragma unroll 1
            for (int q = 0; q < 8; ++q) { float a = 0.f;
#pragma unroll 1
                for (int h = 0; h < 8; ++h) { const LAS float* qp = qi_s + q * 512 + h * 64; float dot = 0.f;
#pragma unroll
                    for (int d = 0; d < 64; ++d) dot += qp[d] * kf[d];
                    a += wi_s[q * 8 + h] * fmaxf(dot, 0.f); }
                sc[q * 2048 + s] = a; }
        }
        __syncthreads();
        {
            const int q = F.wave, t = t0 + q, n = t + 1, row = b * S + t; unsigned myword = 0u;
            if (n <= 256) { const int cb = n - 32 * F.lane; myword = cb >= 32 ? 0xffffffffu : (cb <= 0 ? 0u : ((1u << cb) - 1u)); }
            else {
                LAS unsigned* uk = (LAS unsigned*)(sc + q * 2048);
#pragma unroll 4
                for (int i = 0; i < 32; ++i) { const int s = F.lane + 64 * i; const unsigned k = (s < n) ? fkey(sc[q * 2048 + s]) : 0u; uk[s] = k; }
                LDS_WAIT();
                unsigned prefix = 0u;
#pragma unroll 1
                for (int bit = 31; bit >= 0; --bit) { const unsigned cand = prefix | (1u << bit); int c = 0;
#pragma unroll 8
                    for (int i = 0; i < 32; ++i) c += (uk[F.lane + 64 * i] >= cand) ? 1 : 0;
#pragma unroll
                    for (int o = 1; o < 64; o <<= 1) c += __shfl_xor(c, o);
                    if (c >= 256) prefix = cand; }
                int cgt = 0;
#pragma unroll 8
                for (int i = 0; i < 32; ++i) cgt += (uk[F.lane + 64 * i] > prefix) ? 1 : 0;
#pragma unroll
                for (int o = 1; o < 64; o <<= 1) cgt += __shfl_xor(cgt, o);
                const int need = 256 - cgt; int run = 0;
#pragma unroll 1
                for (int i = 0; i < 32; ++i) { const unsigned u = uk[F.lane + 64 * i]; const bool eq = (u == prefix); const unsigned long long em = __ballot(eq); const int rank = run + __popcll(em & ((1ull << F.lane) - 1ull));
                    const bool sel = (u > prefix) || (eq && rank < need); run += __popcll(em);
                    const unsigned long long sm = __ballot(sel);
                    if (F.lane == 2 * i) myword = (unsigned)sm; if (F.lane == 2 * i + 1) myword = (unsigned)(sm >> 32); }
            }
            MASK[(size_t)row * 64 + F.lane] = myword;
        }
        __syncthreads();
    }
}

__device__ __forceinline__ void dsa_phase(const Frame& F) {
    bf16* P0 = (bf16*)(F.ws + WS_P0); const bf16* CN = (const bf16*)(F.ws + WS_CN); const unsigned* MASK = (const unsigned*)(F.ws + WS_MASK); const float* rel = F.in[I_REL];
    LAS float* ql = (LAS float*)(F.lds + F.wave * 13312); LAS float* pl = ql + 1024; LAS int* idx = (LAS int*)(pl + 2048);
    for (int row = F.gw; row < M; row += F.NGW) {
        const int b = row / S, t = row % S;
        const unsigned w = MASK[(size_t)row * 64 + F.lane]; const int c = __popc(w);
        int incl = c;
#pragma unroll
        for (int o = 1; o < 64; o <<= 1) { const int v = __shfl_up(incl, o); if (F.lane >= o) incl += v; }
        const int total = __shfl(incl, 63); int pos = incl - c; unsigned ww = w;
        while (ww) { const int bit = __ffs(ww) - 1; idx[pos++] = 32 * F.lane + bit; ww &= ww - 1u; }
#pragma unroll
        for (int i = 0; i < 16; ++i) ql[F.lane + 64 * i] = bf2f(P0[(size_t)row * P0_LD + C0_QLAT + F.lane + 64 * i]);
        WAVE_SYNC();
        float lg[4][8]; bool val[4];
#pragma unroll
        for (int kk = 0; kk < 4; ++kk) { const int k = F.lane + 64 * kk; val[kk] = k < total; const int key = val[kk] ? idx[k] : 0;
            float a[8];
#pragma unroll
            for (int h = 0; h < 8; ++h) a[h] = 0.f;
            const bf16* cr = CN + (size_t)(b * S + key) * 128;
#pragma unroll 1
            for (int j = 0; j < 16; ++j) { float cv[8]; ld8bf(cr + 8 * j, cv);
#pragma unroll
                for (int h = 0; h < 8; ++h)
#pragma unroll
                    for (int i = 0; i < 8; ++i) a[h] += ql[h * 128 + 8 * j + i] * cv[i]; }
            const int bk = rel_bucket(t - key);
#pragma unroll
            for (int h = 0; h < 8; ++h) lg[kk][h] = val[kk] ? (a[h] * 0.125f + rel[bk * 16 + h]) : -1.0e30f;
        }
#pragma unroll
        for (int h = 0; h < 8; ++h) { float m = fmaxf(fmaxf(lg[0][h], lg[1][h]), fmaxf(lg[2][h], lg[3][h])); m = wave_max(m);
            float e[4], s = 0.f;
#pragma unroll
            for (int kk = 0; kk < 4; ++kk) { e[kk] = val[kk] ? __expf(lg[kk][h] - m) : 0.f; s += e[kk]; }
            s = wave_sum(s); const float inv = 1.f / s;
#pragma unroll
            for (int kk = 0; kk < 4; ++kk) pl[h * 256 + F.lane + 64 * kk] = e[kk] * inv; }
        WAVE_SYNC();
        float a0[8], a1[8];
#pragma unroll
        for (int h = 0; h < 8; ++h) { a0[h] = 0.f; a1[h] = 0.f; }
        for (int k = 0; k < total; ++k) { const int key = idx[k]; const unsigned pr = *(const unsigned*)(CN + (size_t)(b * S + key) * 128 + 2 * F.lane); const float vx = bflo(pr), vy = bfhi(pr);
#pragma unroll
            for (int h = 0; h < 8; ++h) { const float p = pl[h * 256 + k]; a0[h] += p * vx; a1[h] += p * vy; } }
#pragma unroll
        for (int h = 0; h < 8; ++h) *(unsigned*)(P0 + (size_t)row * P0_LD + C0_QLAT + h * 128 + 2 * F.lane) = pk2(a0[h], a1[h]);
        WAVE_SYNC();
    }
}

template <int W, int NH, int GRPSZ, bool SINK, bool NSA>
__device__ __forceinline__ void banded_phase(const Frame& F, bf16* P, int ld, int cq, int ck, int cv, int relc0) {
    const float* rel = F.in[I_REL]; const float* sinks = F.in[I_EV_SINK];
    const bf16* OC = (const bf16*)(F.ws + WS_OCMP); const bf16* OS = (const bf16*)(F.ws + WS_OSLC);
    constexpr int NTG = S / 64;
    for (int it = F.gw; it < NB * NH * NTG; it += F.NGW) {
        const int tg = it % NTG, h = (it / NTG) % NH, b = it / (NTG * NH);
        const int t = tg * 64 + F.lane, row = b * S + t, kvh = h / GRPSZ;
        float q[64], acc[64];
        { const bf16* qr = P + (size_t)row * ld + cq + h * 64;
#pragma unroll
          for (int j = 0; j < 8; ++j) ld8bf(qr + 8 * j, q + 8 * j); }
#pragma unroll
        for (int d = 0; d < 64; ++d) acc[d] = 0.f;
        float m = SINK ? sinks[h] : -1.0e30f, l = SINK ? 1.f : 0.f;
#pragma unroll 1
        for (int j = 0; j < W; ++j) { const int s = t - j;
            const float bias = rel[rel_bucket(j) * 16 + relc0 + h];
            if (s >= 0) { const bf16* kr = P + (size_t)(b * S + s) * ld + ck + kvh * 64; float dot = 0.f;
#pragma unroll
                for (int jj = 0; jj < 8; ++jj) { float kf[8]; ld8bf(kr + 8 * jj, kf);
#pragma unroll
                    for (int i = 0; i < 8; ++i) dot += q[8 * jj + i] * kf[i]; }
                const float lgt = dot * 0.125f + bias, mn = fmaxf(m, lgt), corr = __expf(m - mn), p = __expf(lgt - mn);
                l = l * corr + p; m = mn;
                const bf16* vr = P + (size_t)(b * S + s) * ld + cv + kvh * 64;
#pragma unroll
                for (int jj = 0; jj < 8; ++jj) { float vf[8]; ld8bf(vr + 8 * jj, vf);
#pragma unroll
                    for (int i = 0; i < 8; ++i) acc[8 * jj + i] = acc[8 * jj + i] * corr + p * vf[i]; } } }
        const float inv = 1.f / l;
        float g0 = 0.f, g1 = 0.f, g2 = 1.f;
        if (NSA) { const bf16* gr = P + (size_t)row * ld + C1_GL + h * 3; g0 = 1.f / (1.f + __expf(-bf2f(gr[0]))); g1 = 1.f / (1.f + __expf(-bf2f(gr[1]))); g2 = 1.f / (1.f + __expf(-bf2f(gr[2]))); }
        bf16* orow = P + (size_t)row * ld + cq + h * 64;
#pragma unroll
        for (int jj = 0; jj < 8; ++jj) { float o[8];
#pragma unroll
            for (int i = 0; i < 8; ++i) o[i] = acc[8 * jj + i] * inv;
            if (NSA) { float c8[8], s8[8]; ld8bf(OC + (size_t)row * D + h * 64 + 8 * jj, c8); ld8bf(OS + (size_t)row * D + h * 64 + 8 * jj, s8);
#pragma unroll
                for (int i = 0; i < 8; ++i) o[i] = g0 * c8[i] + g1 * s8[i] + g2 * o[i]; }
            v4u w; w.x = pk2(o[0], o[1]); w.y = pk2(o[2], o[3]); w.z = pk2(o[4], o[5]); w.w = pk2(o[6], o[7]);
            *(v4u*)(orow + 8 * jj) = w; }
    }
}

__device__ __forceinline__ void xattn_phase(const Frame& F, const bf16* Q, const bf16* KV, bf16* O) {
    for (int it = F.gw; it < NB * 4 * (S / 32); it += F.NGW) {
        const int tg = it % (S / 32), h = (it / (S / 32)) % 4, b = it / ((S / 32) * 4);
        const int tok = tg * 32 + (F.lane >> 1), half = F.lane & 1, row = b * S + tok;
        float q[64], acc[64];
        { const bf16* qr = Q + (size_t)row * 512 + h * 128 + half * 64;
#pragma unroll
          for (int j = 0; j < 8; ++j) ld8bf(qr + 8 * j, q + 8 * j); }
#pragma unroll
        for (int d = 0; d < 64; ++d) acc[d] = 0.f;
        float m = -1.0e30f, l = 0.f;
#pragma unroll 1
        for (int mm = 0; mm < MEML; ++mm) { const bf16* kr = KV + (size_t)(b * MEML + mm) * 1024 + h * 128 + half * 64; float dot = 0.f;
#pragma unroll
            for (int jj = 0; jj < 8; ++jj) { float kf[8]; ld8bf(kr + 8 * jj, kf);
#pragma unroll
                for (int i = 0; i < 8; ++i) dot += q[8 * jj + i] * kf[i]; }
            dot += __shfl_xor(dot, 1);
            const float lgt = dot * 0.08838834764831845f, mn = fmaxf(m, lgt), corr = __expf(m - mn), p = __expf(lgt - mn);
            l = l * corr + p; m = mn;
            const bf16* vr = kr + 512;
#pragma unroll
            for (int jj = 0; jj < 8; ++jj) { float vf[8]; ld8bf(vr + 8 * jj, vf);
#pragma unroll
                for (int i = 0; i < 8; ++i) acc[8 * jj + i] = acc[8 * jj + i] * corr + p * vf[i]; } }
        const float inv = 1.f / l; bf16* orow = O + (size_t)row * 512 + h * 128 + half * 64;
#pragma unroll
        for (int jj = 0; jj < 8; ++jj) { v4u w; w.x = pk2(acc[8 * jj] * inv, acc[8 * jj + 1] * inv); w.y = pk2(acc[8 * jj + 2] * inv, acc[8 * jj + 3] * inv); w.z = pk2(acc[8 * jj + 4] * inv, acc[8 * jj + 5] * inv); w.w = pk2(acc[8 * jj + 6] * inv, acc[8 * jj + 7] * inv);
            *(v4u*)(orow + 8 * jj) = w; }
    }
}

__device__ __forceinline__ float gelu_tanh(float x) { const float u = 0.7978845608028654f * (x + 0.044715f * x * x * x); return 0.5f * x * (1.f + tanhf(u)); }
__device__ __forceinline__ void cmp_mlp_phase(const Frame& F) {
    const bf16* P1 = (const bf16*)(F.ws + WS_P1);
    LAS float* blk = (LAS float*)F.lds; LAS float* part = blk + 2048; LAS float* hid = part + 512;
    for (int item = blockIdx.x; item < 2 * NB * NCMP * 2; item += F.G) {
        const int g = item & 1, n = (item >> 1) % NCMP, b = ((item >> 1) / NCMP) % NB, which = (item >> 1) / (NCMP * NB);
        const float* pe = which ? F.in[I_OD_PEV] : F.in[I_OD_PEK]; const float* w1 = which ? F.in[I_OD_W1V] : F.in[I_OD_W1K]; const float* w2 = which ? F.in[I_OD_W2V] : F.in[I_OD_W2K];
        float* outp = (float*)(F.ws + (which ? WS_VC : WS_KC)) + ((size_t)(b * NCMP + n) * 2 + g) * 64;
        const int col0 = (which ? C1_VC : C1_KC) + g * 64;
        for (int i = F.tid; i < 2048; i += 512) { const int l = i >> 6, d = i & 63; blk[i] = bf2f(P1[(size_t)(b * S + 16 * n + l) * P1_LD + col0 + d]) + pe[i]; }
        __syncthreads();
        { const int j = F.tid & 127, pp = F.tid >> 7; float a = 0.f; const float* wp = w1 + (size_t)(pp * 512) * 128 + j; const LAS float* bp = blk + pp * 512;
#pragma unroll 8
          for (int kk = 0; kk < 512; ++kk) a += bp[kk] * wp[(size_t)kk * 128];
          part[F.tid] = a; }
        __syncthreads();
        if (F.tid < 128) hid[F.tid] = gelu_tanh((part[F.tid] + part[F.tid + 128]) + (part[F.tid + 256] + part[F.tid + 384]));
        __syncthreads();
        if (F.tid < 64) { float a = 0.f;
#pragma unroll 8
            for (int j = 0; j < 128; ++j) a += hid[j] * w2[j * 64 + F.tid];
            outp[F.tid] = a; }
        __syncthreads();
    }
}

__device__ __forceinline__ void cmp_attn_phase(const Frame& F) {
    const bf16* P1 = (const bf16*)(F.ws + WS_P1); const float* KC = (const float*)(F.ws + WS_KC); const float* VC = (const float*)(F.ws + WS_VC);
    bf16* OC = (bf16*)(F.ws + WS_OCMP); unsigned* SELM = (unsigned*)(F.ws + WS_SELM); const float* rel = F.in[I_REL];
    LAS float* qs = (LAS float*)(F.lds + F.wave * 8192); LAS float* pl = qs + 512; LAS float* psum = pl + 1024;
    for (int it = F.gw; it < M * 2; it += F.NGW) {
        const int g = it & 1, row = it >> 1, b = row / S, t = row % S;
        const int nv = (t >= 31) ? ((t - 31) / 16 + 1) : 0;
#pragma unroll
        for (int i = 0; i < 8; ++i) qs[F.lane + 64 * i] = bf2f(P1[(size_t)row * P1_LD + C1_Q + g * 512 + F.lane + 64 * i]);
        WAVE_SYNC();
        float lg[2][8]; bool val[2];
#pragma unroll
        for (int kk = 0; kk < 2; ++kk) { const int n = F.lane + 64 * kk; val[kk] = n < nv; const int nn = val[kk] ? n : 0;
            const float* kr = KC + ((size_t)(b * NCMP + nn) * 2 + g) * 64; float a[8];
#pragma unroll
            for (int h = 0; h < 8; ++h) a[h] = 0.f;
#pragma unroll 1
            for (int j = 0; j < 16; ++j) { const f32x4 kv = *(const f32x4*)(kr + 4 * j);
#pragma unroll
                for (int h = 0; h < 8; ++h) a[h] += qs[h * 64 + 4 * j] * kv.x + qs[h * 64 + 4 * j + 1] * kv.y + qs[h * 64 + 4 * j + 2] * kv.z + qs[h * 64 + 4 * j + 3] * kv.w; }
            const int bk = rel_bucket(val[kk] ? (t - (16 * nn + 31)) : 0);
#pragma unroll
            for (int h = 0; h < 8; ++h) lg[kk][h] = val[kk] ? (a[h] * 0.125f + rel[bk * 16 + g * 8 + h]) : -1.0e30f; }
        float ps[2] = {0.f, 0.f};
#pragma unroll
        for (int h = 0; h < 8; ++h) { float m = wave_max(fmaxf(lg[0][h], lg[1][h]));
            float e0 = val[0] ? __expf(lg[0][h] - m) : 0.f, e1 = val[1] ? __expf(lg[1][h] - m) : 0.f;
            const float s = wave_sum(e0 + e1); const float inv = (nv > 0) ? 1.f / s : 0.f; e0 *= inv; e1 *= inv;
            pl[h * 128 + F.lane] = e0; pl[h * 128 + 64 + F.lane] = e1; ps[0] += e0; ps[1] += e1; }
        psum[F.lane] = ps[0]; psum[64 + F.lane] = ps[1];
        WAVE_SYNC();
        float scj = -3.0e38f; bool adm = false;
        if (F.lane < 32) { const int j = F.lane; float p = 0.f;
#pragma unroll
            for (int n = 4 * j - 1; n <= 4 * j + 3; ++n) if (n >= 0 && n < NCMP) p += psum[n];
            const int blkq = t >> 6; adm = (64 * j <= t); const bool forced = (j == 0) || (j == blkq) || (j == blkq - 1);
            scj = adm ? (p + (forced ? 1.0e6f : 0.f)) : -1.0e30f; }
        int rank = 0;
#pragma unroll 1
        for (int i = 0; i < 32; ++i) { const float si = __shfl(scj, i); rank += (si > scj || (si == scj && i < F.lane)) ? 1 : 0; }
        const unsigned long long sm = __ballot(F.lane < 32 && adm && rank < 8);
        if (F.lane == 0) SELM[(size_t)row * 2 + g] = (unsigned)sm;
        float o[8];
#pragma unroll
        for (int h = 0; h < 8; ++h) o[h] = 0.f;
        for (int n = 0; n < nv; ++n) { const float v = VC[((size_t)(b * NCMP + n) * 2 + g) * 64 + F.lane];
#pragma unroll
            for (int h = 0; h < 8; ++h) o[h] += pl[h * 128 + n] * v; }
#pragma unroll
        for (int h = 0; h < 8; ++h) OC[(size_t)row * D + (g * 8 + h) * 64 + F.lane] = (bf16)f2bf(o[h]);
        WAVE_SYNC();
    }
}

__device__ __forceinline__ void slc_attn_phase(const Frame& F) {
    const bf16* P1 = (const bf16*)(F.ws + WS_P1); const unsigned* SELM = (const unsigned*)(F.ws + WS_SELM); bf16* OS = (bf16*)(F.ws + WS_OSLC); const float* rel = F.in[I_REL];
    LAS float* qs = (LAS float*)(F.lds + F.wave * 4096); LAS float* pb = qs + 512;
    for (int it = F.gw; it < M * 2; it += F.NGW) {
        const int g = it & 1, row = it >> 1, b = row / S, t = row % S;
#pragma unroll
        for (int i = 0; i < 8; ++i) qs[F.lane + 64 * i] = bf2f(P1[(size_t)row * P1_LD + C1_Q + g * 512 + F.lane + 64 * i]);
        WAVE_SYNC();
        unsigned sel = SELM[(size_t)row * 2 + g];
        float m[8], l[8], acc[8];
#pragma unroll
        for (int h = 0; h < 8; ++h) { m[h] = -1.0e30f; l[h] = 0.f; acc[h] = 0.f; }
        while (sel) { const int jb = __ffs(sel) - 1; sel &= sel - 1u;
            const int kpos = 64 * jb + F.lane; const bool valid = kpos <= t;
            const bf16* kr = P1 + (size_t)(b * S + kpos) * P1_LD + C1_KS + g * 64; float a[8];
#pragma unroll
            for (int h = 0; h < 8; ++h) a[h] = 0.f;
#pragma unroll 1
            for (int j = 0; j < 8; ++j) { float kf[8]; ld8bf(kr + 8 * j, kf);
#pragma unroll
                for (int h = 0; h < 8; ++h)
#pragma unroll
                    for (int i = 0; i < 8; ++i) a[h] += qs[h * 64 + 8 * j + i] * kf[i]; }
            const int bk = rel_bucket(valid ? (t - kpos) : 0);
            float corr[8];
#pragma unroll
            for (int h = 0; h < 8; ++h) { const float lgt = valid ? (a[h] * 0.125f + rel[bk * 16 + g * 8 + h]) : -1.0e30f;
                const float bm = wave_max(lgt), mn = fmaxf(m[h], bm); corr[h] = __expf(m[h] - mn); const float p = valid ? __expf(lgt - mn) : 0.f;
                l[h] = l[h] * corr[h] + wave_sum(p); m[h] = mn; pb[h * 64 + F.lane] = p; }
            WAVE_SYNC();
            const bf16* vb = P1 + (size_t)(b * S + 64 * jb) * P1_LD + C1_VS + g * 64 + F.lane;
            float add[8];
#pragma unroll
            for (int h = 0; h < 8; ++h) add[h] = 0.f;
            for (int k = 0; k < 64; ++k) { const float v = bf2f(vb[(size_t)k * P1_LD]);
#pragma unroll
                for (int h = 0; h < 8; ++h) add[h] += pb[h * 64 + k] * v; }
#pragma unroll
            for (int h = 0; h < 8; ++h) acc[h] = acc[h] * corr[h] + add[h];
            WAVE_SYNC();
        }
#pragma unroll
        for (int h = 0; h < 8; ++h) OS[(size_t)row * D + (g * 8 + h) * 64 + F.lane] = (bf16)f2bf(acc[h] / l[h]);
    }
}

namespace fa {
typedef short bf16x8 __attribute__((ext_vector_type(8)));
typedef short bf16x4 __attribute__((ext_vector_type(4)));
typedef float f32x16 __attribute__((ext_vector_type(16)));
constexpr int VSTR = 68;
template <int HDK, int HDV> struct Geo { static constexpr int KSTR = HDK + 8, KBYTES = 64 * KSTR * 2, VBYTES = HDV * VSTR * 2, BUF = KBYTES + VBYTES; };
template <int HDK, int HDV, bool KV_SAME> struct Stage { v4u k[HDK / 64]; v4u v[KV_SAME ? 1 : HDV / 64]; };

template <int HDK, int HDV, bool KV_SAME, class P>
__device__ __forceinline__ void load_tile(Stage<HDK, HDV, KV_SAME>& st, const P& pol, int j, int tid) {
#pragma unroll
    for (int i = 0; i < HDK / 64; ++i) { const int c = tid + 512 * i, r = c / (HDK / 8), ch = c % (HDK / 8); st.k[i] = *(const v4u*)(pol.krow(j, r) + 8 * ch); }
    if (!KV_SAME) {
#pragma unroll
        for (int i = 0; i < HDV / 64; ++i) { const int c = tid + 512 * i, r = c / (HDV / 8), ch = c % (HDV / 8); st.v[i] = *(const v4u*)(pol.vrow(j, r) + 8 * ch); }
    }
}
template <int HDK, int HDV, bool KV_SAME>
__device__ __forceinline__ void store_tile(const Stage<HDK, HDV, KV_SAME>& st, LAS unsigned char* buf, int tid) {
    typedef Geo<HDK, HDV> G;
    LAS bf16* Ks = (LAS bf16*)buf; LAS bf16* Vt = (LAS bf16*)(buf + G::KBYTES);
#pragma unroll
    for (int i = 0; i < HDK / 64; ++i) { const int c = tid + 512 * i, r = c / (HDK / 8), ch = c % (HDK / 8); *(LAS v4u*)(Ks + r * G::KSTR + 8 * ch) = st.k[i]; }
#pragma unroll
    for (int i = 0; i < HDV / 64; ++i) { const int c = tid + 512 * i, r = c / (HDV / 8), ch = c % (HDV / 8); const v4u w = KV_SAME ? st.k[i] : st.v[i];
        LAS bf16* vp = Vt + (8 * ch) * VSTR + r;
        vp[0 * VSTR] = (bf16)(w.x & 0xffffu); vp[1 * VSTR] = (bf16)(w.x >> 16); vp[2 * VSTR] = (bf16)(w.y & 0xffffu); vp[3 * VSTR] = (bf16)(w.y >> 16);
        vp[4 * VSTR] = (bf16)(w.z & 0xffffu); vp[5 * VSTR] = (bf16)(w.z >> 16); vp[6 * VSTR] = (bf16)(w.w & 0xffffu); vp[7 * VSTR] = (bf16)(w.w >> 16); }
}
template <int HDK, int HDV, class P>
__device__ __forceinline__ void compute_tile(const LAS unsigned char* buf, const P& pol, int j, int lane, const bf16x8 (&qf)[HDK / 16], f32x16 (&o)[HDV / 32], float& m, float& l) {
    typedef Geo<HDK, HDV> G;
    const LAS bf16* Ks = (const LAS bf16*)buf; const LAS bf16* Vt = (const LAS bf16*)(buf + G::KBYTES);
    const int r = lane & 31, h = lane >> 5;
    f32x16 s[2];
#pragma unroll
    for (int kb = 0; kb < 2; ++kb) {
#pragma unroll
        for (int e = 0; e < 16; ++e) s[kb][e] = 0.f;
#pragma unroll
        for (int ks = 0; ks < HDK / 16; ++ks) { const bf16x8 a = *(const LAS bf16x8*)(Ks + (32 * kb + r) * G::KSTR + 16 * ks + 8 * h);
            s[kb] = __builtin_amdgcn_mfma_f32_32x32x16_bf16(a, qf[ks], s[kb], 0, 0, 0); }
    }
    pol.transform(j, s, lane);
    float mx = -INFINITY;
#pragma unroll
    for (int kb = 0; kb < 2; ++kb)
#pragma unroll
        for (int e = 0; e < 16; ++e) mx = fmaxf(mx, s[kb][e]);
    mx = fmaxf(mx, __shfl_xor(mx, 32));
    const float mn = fmaxf(m, mx), mref = (mn == -INFINITY) ? 0.f : mn;
    const float corr = __expf(m - mref);
    float rs = 0.f;
#pragma unroll
    for (int kb = 0; kb < 2; ++kb)
#pragma unroll
        for (int e = 0; e < 16; ++e) { s[kb][e] = __expf(s[kb][e] - mref); rs += s[kb][e]; }
    rs += __shfl_xor(rs, 32);
    l = l * corr + rs; m = mn;
#pragma unroll
    for (int blk = 0; blk < HDV / 32; ++blk)
#pragma unroll
        for (int e = 0; e < 16; ++e) o[blk][e] *= corr;
#pragma unroll
    for (int kb = 0; kb < 2; ++kb)
#pragma unroll
        for (int s2 = 0; s2 < 2; ++s2) {
            v4u pw; pw.x = pg8::cvt_pk_bf16(s[kb][8 * s2 + 0], s[kb][8 * s2 + 1]); pw.y = pg8::cvt_pk_bf16(s[kb][8 * s2 + 2], s[kb][8 * s2 + 3]);
            pw.z = pg8::cvt_pk_bf16(s[kb][8 * s2 + 4], s[kb][8 * s2 + 5]); pw.w = pg8::cvt_pk_bf16(s[kb][8 * s2 + 6], s[kb][8 * s2 + 7]);
            const bf16x8 pf = __builtin_bit_cast(bf16x8, pw);
#pragma unroll
            for (int blk = 0; blk < HDV / 32; ++blk) { const LAS bf16* vp = Vt + (32 * blk + r) * VSTR + 32 * kb + 16 * s2 + 4 * h;
                const bf16x4 lo = *(const LAS bf16x4*)vp, hi = *(const LAS bf16x4*)(vp + 8);
                const bf16x8 a = __builtin_shufflevector(lo, hi, 0, 1, 2, 3, 4, 5, 6, 7);
                o[blk] = __builtin_amdgcn_mfma_f32_32x32x16_bf16(a, pf, o[blk], 0, 0, 0); }
        }
}
template <int HDK, int HDV, bool KV_SAME, class P>
__device__ __forceinline__ void run(LAS unsigned char* lds, const P& pol, unsigned tmask, int tid, int lane, const bf16x8 (&qf)[HDK / 16], f32x16 (&o)[HDV / 32], float& m, float& l) {
    typedef Geo<HDK, HDV> G;
    if (tmask == 0u) return;
    Stage<HDK, HDV, KV_SAME> st;
    int j = __builtin_ctz(tmask); tmask &= tmask - 1u; int cur = 0;
    load_tile<HDK, HDV, KV_SAME>(st, pol, j, tid); store_tile<HDK, HDV, KV_SAME>(st, lds, tid);
    __syncthreads();
    for (;;) {
        const bool more = tmask != 0u; int jn = 0;
        if (more) { jn = __builtin_ctz(tmask); tmask &= tmask - 1u; load_tile<HDK, HDV, KV_SAME>(st, pol, jn, tid); }
        compute_tile<HDK, HDV>(lds + cur * G::BUF, pol, j, lane, qf, o, m, l);
        if (!more) break;
        store_tile<HDK, HDV, KV_SAME>(st, lds + (cur ^ 1) * G::BUF, tid);
        __syncthreads();
        cur ^= 1; j = jn;
    }
    __syncthreads();
}
}

__device__ __forceinline__ void build_bias_table(const Frame& F, LAS float* tab, int nheads, int relc0) {
    const float* rel = F.in[I_REL];
    for (int i = F.tid; i < nheads * 129; i += 512) { const int hh = i / 129, d = i % 129; tab[hh * 132 + d] = rel[rel_bucket(d) * 16 + relc0 + hh]; }
    __syncthreads();
}
struct BandPol {
    const bf16* kbase; const bf16* vbase; int ld; int tq, tq0, W; const LAS float* bl;
    __device__ __forceinline__ const bf16* krow(int j, int r) const { return kbase + (size_t)(64 * j + r) * ld; }
    __device__ __forceinline__ const bf16* vrow(int j, int r) const { return vbase + (size_t)(64 * j + r) * ld; }
    __device__ __forceinline__ void transform(int j, fa::f32x16 (&s)[2], int lane) const {
        const int k0 = 64 * j, h = lane >> 5;
        if (tq0 - (k0 + 63) >= 128 && (tq0 + 31) - k0 < W) {
            const float b31 = bl[128];
#pragma unroll
            for (int kb = 0; kb < 2; ++kb)
#pragma unroll
                for (int e = 0; e < 16; ++e) s[kb][e] = s[kb][e] * 0.125f + b31;
        } else {
#pragma unroll
            for (int kb = 0; kb < 2; ++kb)
#pragma unroll
                for (int e = 0; e < 16; ++e) { const int key = k0 + 32 * kb + 8 * (e >> 2) + 4 * h + (e & 3); const int dist = tq - key;
                    const int di = dist < 0 ? 0 : (dist > 128 ? 128 : dist);
                    const float v = s[kb][e] * 0.125f + bl[di];
                    s[kb][e] = (dist >= 0 && dist < W) ? v : -INFINITY; }
        }
    }
};
__device__ __forceinline__ void win_phase_mfma(const Frame& F) {
    bf16* P1 = (bf16*)(F.ws + WS_P1); const bf16* OC = (const bf16*)(F.ws + WS_OCMP); const bf16* OS = (const bf16*)(F.ws + WS_OSLC);
    LAS float* tab = (LAS float*)(F.lds + 36864);
    build_bias_table(F, tab, 16, 0);
    const int h = F.lane >> 5;
    for (int u = blockIdx.x; u < NB * 2 * 64; u += F.G) {
        const int b = u >> 7, g = (u >> 6) & 1, qt = u & 63, tq0 = 32 * qt, head = g * 8 + F.wave, tq = tq0 + (F.lane & 31);
        const size_t row = (size_t)b * S + tq;
        fa::bf16x8 qf[4];
#pragma unroll
        for (int ks = 0; ks < 4; ++ks) qf[ks] = *(const fa::bf16x8*)(P1 + row * P1_LD + C1_Q + head * 64 + 16 * ks + 8 * h);
        fa::f32x16 o[2];
#pragma unroll
        for (int blk = 0; blk < 2; ++blk)
#pragma unroll
            for (int e = 0; e < 16; ++e) o[blk][e] = 0.f;
        float m = -INFINITY, l = 0.f;
        const int jlo = (tq0 - 511 > 0 ? tq0 - 511 : 0) >> 6, jhi = (tq0 + 31) >> 6;
        const unsigned tmask = (jhi >= 31 ? 0xffffffffu : ((1u << (jhi + 1)) - 1u)) & ~((1u << jlo) - 1u);
        BandPol pol{P1 + (size_t)b * S * P1_LD + C1_KW + g * 64, P1 + (size_t)b * S * P1_LD + C1_VW + g * 64, P1_LD, tq, tq0, 512, tab + head * 132};
        fa::run<64, 64, false>(F.lds, pol, tmask, F.tid, F.lane, qf, o, m, l);
        const float inv = 1.f / l;
        const bf16* gr = P1 + row * P1_LD + C1_GL + head * 3;
        const float g0 = 1.f / (1.f + __expf(-bf2f(gr[0]))), g1 = 1.f / (1.f + __expf(-bf2f(gr[1]))), g2 = 1.f / (1.f + __expf(-bf2f(gr[2])));
#pragma unroll
        for (int blk = 0; blk < 2; ++blk)
#pragma unroll
            for (int jj = 0; jj < 4; ++jj) { const int d0 = 32 * blk + 8 * jj + 4 * h;
                const v2u cw = *(const v2u*)(OC + row * D + head * 64 + d0), sw = *(const v2u*)(OS + row * D + head * 64 + d0);
                const float r0 = g0 * bflo(cw.x) + g1 * bflo(sw.x) + g2 * o[blk][4 * jj + 0] * inv, r1 = g0 * bfhi(cw.x) + g1 * bfhi(sw.x) + g2 * o[blk][4 * jj + 1] * inv;
                const float r2 = g0 * bflo(cw.y) + g1 * bflo(sw.y) + g2 * o[blk][4 * jj + 2] * inv, r3 = g0 * bfhi(cw.y) + g1 * bfhi(sw.y) + g2 * o[blk][4 * jj + 3] * inv;
                v2u ow; ow.x = pk2(r0, r1); ow.y = pk2(r2, r3);
                *(v2u*)(P1 + row * P1_LD + C1_Q + head * 64 + d0) = ow; }
    }
}
__device__ __forceinline__ void swa_phase_mfma(const Frame& F) {
    bf16* P0 = (bf16*)(F.ws + WS_P0); const float* sinks = F.in[I_EV_SINK];
    LAS float* tab = (LAS float*)(F.lds + 36864);
    build_bias_table(F, tab, 8, 8);
    const int h = F.lane >> 5;
    for (int u = blockIdx.x; u < NB * 2 * 32; u += F.G) {
        const int b = u >> 6, kvh = (u >> 5) & 1, t0 = 64 * (u & 31), head = kvh * 4 + (F.wave & 3), tq0 = t0 + 32 * (F.wave >> 2), tq = tq0 + (F.lane & 31);
        const size_t row = (size_t)b * S + tq;
        fa::bf16x8 qf[4];
#pragma unroll
        for (int ks = 0; ks < 4; ++ks) qf[ks] = *(const fa::bf16x8*)(P0 + row * P0_LD + C0_QB + head * 64 + 16 * ks + 8 * h);
        fa::f32x16 o[2];
#pragma unroll
        for (int blk = 0; blk < 2; ++blk)
#pragma unroll
            for (int e = 0; e < 16; ++e) o[blk][e] = 0.f;
        float m = sinks[head], l = 1.f;
        const int jlo = (t0 - 127 > 0 ? t0 - 127 : 0) >> 6, jhi = t0 >> 6;
        const unsigned tmask = (jhi >= 31 ? 0xffffffffu : ((1u << (jhi + 1)) - 1u)) & ~((1u << jlo) - 1u);
        BandPol pol{P0 + (size_t)b * S * P0_LD + C0_KB + kvh * 64, P0 + (size_t)b * S * P0_LD + C0_VB + kvh * 64, P0_LD, tq, tq0, 128, tab + head * 132};
        fa::run<64, 64, false>(F.lds, pol, tmask, F.tid, F.lane, qf, o, m, l);
        const float inv = 1.f / l;
#pragma unroll
        for (int blk = 0; blk < 2; ++blk)
#pragma unroll
            for (int jj = 0; jj < 4; ++jj) { const int d0 = 32 * blk + 8 * jj + 4 * h;
                v2u ow; ow.x = pk2(o[blk][4 * jj + 0] * inv, o[blk][4 * jj + 1] * inv); ow.y = pk2(o[blk][4 * jj + 2] * inv, o[blk][4 * jj + 3] * inv);
                *(v2u*)(P0 + row * P0_LD + C0_QB + head * 64 + d0) = ow; }
    }
}

struct XaPol {
    const bf16* kbase;
    __device__ __forceinline__ const bf16* krow(int j, int r) const { return kbase + (size_t)(64 * j + r) * 1024; }
    __device__ __forceinline__ const bf16* vrow(int j, int r) const { return kbase + (size_t)(64 * j + r) * 1024 + 512; }
    __device__ __forceinline__ void transform(int, fa::f32x16 (&s)[2], int) const {
#pragma unroll
        for (int kb = 0; kb < 2; ++kb)
#pragma unroll
            for (int e = 0; e < 16; ++e) s[kb][e] *= 0.08838834764831845f;
    }
};
__device__ __forceinline__ void xattn_phase_mfma(const Frame& F, const bf16* Q, const bf16* KV, bf16* O) {
    const int h = F.lane >> 5;
    for (int u = blockIdx.x; u < NB * 4 * 8; u += F.G) {
        const int b = u >> 5, head = (u >> 3) & 3, qt = u & 7, tq = 256 * qt + 32 * F.wave + (F.lane & 31);
        const size_t row = (size_t)b * S + tq;
        fa::bf16x8 qf[8];
#pragma unroll
        for (int ks = 0; ks < 8; ++ks) qf[ks] = *(const fa::bf16x8*)(Q + row * 512 + head * 128 + 16 * ks + 8 * h);
        fa::f32x16 o[4];
#pragma unroll
        for (int blk = 0; blk < 4; ++blk)
#pragma unroll
            for (int e = 0; e < 16; ++e) o[blk][e] = 0.f;
        float m = -INFINITY, l = 0.f;
        XaPol pol{KV + (size_t)b * MEML * 1024 + head * 128};
        fa::run<128, 128, false>(F.lds, pol, 0xFu, F.tid, F.lane, qf, o, m, l);
        const float inv = 1.f / l;
#pragma unroll
        for (int blk = 0; blk < 4; ++blk)
#pragma unroll
            for (int jj = 0; jj < 4; ++jj) { const int d0 = 32 * blk + 8 * jj + 4 * h;
                v2u ow; ow.x = pk2(o[blk][4 * jj + 0] * inv, o[blk][4 * jj + 1] * inv); ow.y = pk2(o[blk][4 * jj + 2] * inv, o[blk][4 * jj + 3] * inv);
                *(v2u*)(O + row * 512 + head * 128 + d0) = ow; }
    }
}
struct DsaPol {
    const bf16* cbase; const unsigned* mrow; int tq; const LAS float* bl;
    __device__ __forceinline__ const bf16* krow(int j, int r) const { return cbase + (size_t)(64 * j + r) * 128; }
    __device__ __forceinline__ const bf16* vrow(int j, int r) const { return krow(j, r); }
    __device__ __forceinline__ void transform(int j, fa::f32x16 (&s)[2], int lane) const {
        const int k0 = 64 * j, h = lane >> 5; const v2u mw = *(const v2u*)(mrow + 2 * j);
#pragma unroll
        for (int kb = 0; kb < 2; ++kb) { const unsigned w = kb ? mw.y : mw.x;
#pragma unroll
            for (int e = 0; e < 16; ++e) { const int kin = 8 * (e >> 2) + 4 * h + (e & 3); const int dist = tq - (k0 + 32 * kb + kin);
                const int di = dist < 0 ? 0 : (dist > 128 ? 128 : dist);
                const float v = s[kb][e] * 0.125f + bl[di];
                s[kb][e] = ((w >> kin) & 1u) ? v : -INFINITY; } }
    }
};
__device__ __forceinline__ void dsa_phase_mfma(const Frame& F) {
    bf16* P0 = (bf16*)(F.ws + WS_P0); const bf16* CN = (const bf16*)(F.ws + WS_CN); const unsigned* MASK = (const unsigned*)(F.ws + WS_MASK);
    LAS float* tab = (LAS float*)(F.lds + 73728);
    build_bias_table(F, tab, 8, 0);
    const int h = F.lane >> 5;
    for (int u = blockIdx.x; u < NB * 64; u += F.G) {
        const int rr = u / F.G, c = u % F.G; const int qt = (rr & 1) ? 63 - (c & 63) : (c & 63), b = (rr * (F.G >> 6) + (c >> 6)) % NB;
        const int tq0 = 32 * qt, tq = tq0 + (F.lane & 31), head = F.wave;
        const size_t row = (size_t)b * S + tq;
        fa::bf16x8 qf[8];
#pragma unroll
        for (int ks = 0; ks < 8; ++ks) qf[ks] = *(const fa::bf16x8*)(P0 + row * P0_LD + C0_QLAT + head * 128 + 16 * ks + 8 * h);
        fa::f32x16 o[4];
#pragma unroll
        for (int blk = 0; blk < 4; ++blk)
#pragma unroll
            for (int e = 0; e < 16; ++e) o[blk][e] = 0.f;
        float m = -INFINITY, l = 0.f;
        const int jhi = (tq0 + 31) >> 6; const unsigned tmask = jhi >= 31 ? 0xffffffffu : ((1u << (jhi + 1)) - 1u);
        DsaPol pol{CN + (size_t)b * S * 128, MASK + row * 64, tq, tab + head * 132};
        fa::run<128, 128, true>(F.lds, pol, tmask, F.tid, F.lane, qf, o, m, l);
        const float inv = 1.f / l;
#pragma unroll
        for (int blk = 0; blk < 4; ++blk)
#pragma unroll
            for (int jj = 0; jj < 4; ++jj) { const int d0 = 32 * blk + 8 * jj + 4 * h;
                v2u ow; ow.x = pk2(o[blk][4 * jj + 0] * inv, o[blk][4 * jj + 1] * inv); ow.y = pk2(o[blk][4 * jj + 2] * inv, o[blk][4 * jj + 3] * inv);
                *(v2u*)(P0 + row * P0_LD + C0_QLAT + head * 128 + d0) = ow; }
    }
}
struct SlcPol {
    const bf16* kbase; const bf16* vbase; unsigned sel; int tq; const LAS float* bl;
    __device__ __forceinline__ const bf16* krow(int j, int r) const { return kbase + (size_t)(64 * j + r) * P1_LD; }
    __device__ __forceinline__ const bf16* vrow(int j, int r) const { return vbase + (size_t)(64 * j + r) * P1_LD; }
    __device__ __forceinline__ void transform(int j, fa::f32x16 (&s)[2], int lane) const {
        const int k0 = 64 * j, h = lane >> 5; const bool on = (sel >> j) & 1u;
#pragma unroll
        for (int kb = 0; kb < 2; ++kb)
#pragma unroll
            for (int e = 0; e < 16; ++e) { const int dist = tq - (k0 + 32 * kb + 8 * (e >> 2) + 4 * h + (e & 3));
                const int di = dist < 0 ? 0 : (dist > 128 ? 128 : dist);
                const float v = s[kb][e] * 0.125f + bl[di];
                s[kb][e] = (on && dist >= 0) ? v : -INFINITY; }
    }
};
__device__ __forceinline__ void slc_phase_mfma(const Frame& F) {
    const bf16* P1 = (const bf16*)(F.ws + WS_P1); const unsigned* SELM = (const unsigned*)(F.ws + WS_SELM); bf16* OS = (bf16*)(F.ws + WS_OSLC);
    LAS float* tab = (LAS float*)(F.lds + 36864);
    build_bias_table(F, tab, 16, 0);
    const int h = F.lane >> 5;
    for (int u = blockIdx.x; u < NB * 2 * 64; u += F.G) {
        const int rr = u / F.G, c = u % F.G; const int qt = (rr & 1) ? 63 - (c & 63) : (c & 63), bg = (rr * (F.G >> 6) + (c >> 6)) % (NB * 2), b = bg >> 1, g = bg & 1;
        const int tq0 = 32 * qt, tq = tq0 + (F.lane & 31), head = g * 8 + F.wave;
        const size_t row = (size_t)b * S + tq;
        fa::bf16x8 qf[4];
#pragma unroll
        for (int ks = 0; ks < 4; ++ks) qf[ks] = *(const fa::bf16x8*)(P1 + row * P1_LD + C1_Q + head * 64 + 16 * ks + 8 * h);
        fa::f32x16 o[2];
#pragma unroll
        for (int blk = 0; blk < 2; ++blk)
#pragma unroll
            for (int e = 0; e < 16; ++e) o[blk][e] = 0.f;
        float m = -INFINITY, l = 0.f;
        const unsigned sel = SELM[row * 2 + g]; unsigned tm = sel;
#pragma unroll
        for (int of = 1; of < 32; of <<= 1) tm |= (unsigned)__shfl_xor((int)tm, of);
        tm = (unsigned)__builtin_amdgcn_readfirstlane((int)tm);
        SlcPol pol{P1 + (size_t)b * S * P1_LD + C1_KS + g * 64, P1 + (size_t)b * S * P1_LD + C1_VS + g * 64, sel, tq, tab + head * 132};
        fa::run<64, 64, false>(F.lds, pol, tm, F.tid, F.lane, qf, o, m, l);
        const float inv = 1.f / l;
#pragma unroll
        for (int blk = 0; blk < 2; ++blk)
#pragma unroll
            for (int jj = 0; jj < 4; ++jj) { const int d0 = 32 * blk + 8 * jj + 4 * h;
                v2u ow; ow.x = pk2(o[blk][4 * jj + 0] * inv, o[blk][4 * jj + 1] * inv); ow.y = pk2(o[blk][4 * jj + 2] * inv, o[blk][4 * jj + 3] * inv);
                *(v2u*)(OS + row * D + head * 64 + d0) = ow; }
    }
}

constexpr int NPHASE = 34;
__global__ void __launch_bounds__(NWAVES * 64, 2) skel_fwd(Args args) {
    extern __shared__ __attribute__((aligned(16))) unsigned char lds[];
    Frame F;
    F.lds = (LAS unsigned char*)lds; F.ws = args.ws; F.acc = args.out; F.in = args.in;
    F.tid = threadIdx.x; F.lane = F.tid & 63; F.wave = __builtin_amdgcn_readfirstlane(F.tid >> 6);
    F.G = gridDim.x; F.gw = blockIdx.x * NWAVES + F.wave; F.NGW = F.G * NWAVES;
    volatile LAS unsigned* MISC = (volatile LAS unsigned*)(F.lds + MISC_OFF);
    for (int u = F.tid; u < (LDS_BYTES - LDSCTL_OFF) / 4; u += NWAVES * 64) ((LAS unsigned*)(F.lds + LDSCTL_OFF))[u] = 0u;
    __syncthreads();
    unsigned* ctl = (unsigned*)(args.ws + WS_CTL);
    XcdBarrier bar; bar.bar = ctl + CW_BAR; bar.x = 0; bar.st = nullptr;
    const int lo = args.ph_lo, hi = args.ph_hi;
    if (hi - lo > 1) {
        bar = xcd_barrier_post(ctl + CW_BAR, MISC + 8);
        if (threadIdx.x == 0) { unsigned nloc, nx; xcd_barrier_complete(ctl + CW_BAR, bar.x, nloc, nx); MISC[8] = nloc; MISC[9] = nx; }
        __syncthreads();
    }
#ifndef PH_LO
#define PH_LO 0
#define PH_HI 99
#endif
#define IN(k) ((k) >= PH_LO && (k) < PH_HI && lo <= (k) && (k) < hi && fresh(F))
#define SEAM(k) do { if (IN(k) && IN((k) + 1)) xcd_barrier(bar); } while (0)
    unsigned char* ws = args.ws;
    const int bx = blockIdx.x;

    if (IN(0)) { prologue(F); } SEAM(0);
    if (IN(1)) {
        { pg8::StaticSched<256 * 2048, 256 * 2048> Sd{(const char*)(ws + WS_HB), (const char*)(ws + W_IN0), M / 256, P0_LD / 256, F.G, bx, F.wave};
          pg8::EpiBf16 E{(bf16*)(ws + WS_P0), P0_LD}; pg8::gemm_phase<1024, 2048, 2048>(F.lds, Sd, E); }
        for (int i = 0; i < 2; ++i) {
          pg8::StaticSched<256 * 2048, 256 * 2048> Sd{(const char*)(ws + WS_MEMB), (const char*)(ws + W_XKV + (size_t)i * 1024 * 1024 * 2), MMEM / 256, 4, F.G, (bx + 128 * (i + 1)) % F.G, F.wave};
          pg8::EpiBf16 E{(bf16*)(ws + WS_XKV + (size_t)i * MMEM * 1024 * 2), 1024}; pg8::gemm_phase<1024, 2048, 2048>(F.lds, Sd, E); }
    } SEAM(1);
    if (IN(2)) { cn_phase(F); idx_phase(F); swa_phase_mfma(F); } SEAM(2);
    if (IN(3)) { dsa_phase_mfma(F); } SEAM(3);
    if (IN(4)) { pg8::StaticSched<256 * P0_LD * 2, 256 * 1536 * 2> Sd{(const char*)(ws + WS_P0), (const char*)(ws + W_OUT0), M / 256, 4, F.G, bx, F.wave};
                 pg8::EpiAcc E{F.acc, D}; pg8::gemm_phase<1536, P0_LD * 2, 1536 * 2>(F.lds, Sd, E); } SEAM(4);
    if (IN(5)) { ln_phase<0>(F, 0); } SEAM(5);
    if (IN(6)) { pg8::StaticSched<256 * 2048, 256 * 2048> Sd{(const char*)(ws + WS_HB), (const char*)(ws + W_XQ), M / 256, 2, F.G, bx, F.wave};
                 pg8::EpiBf16 E{(bf16*)(ws + WS_QX0), 512}; pg8::gemm_phase<1024, 2048, 2048>(F.lds, Sd, E); } SEAM(6);
    if (IN(7)) { xattn_phase_mfma(F, (const bf16*)(ws + WS_QX0), (const bf16*)(ws + WS_XKV), (bf16*)(ws + WS_OX0)); } SEAM(7);
    if (IN(8)) { pg8::StaticSched<256 * 1024, 256 * 1024> Sd{(const char*)(ws + WS_OX0), (const char*)(ws + W_XO), M / 256, 4, F.G, bx, F.wave};
                 pg8::EpiAcc E{F.acc, D}; pg8::gemm_phase<512, 1024, 1024>(F.lds, Sd, E); } SEAM(8);
    if (IN(9)) { ln_phase<0>(F, 1); } SEAM(9);
    if (IN(10)) { pg8::StaticSched<256 * 2048, 256 * 2048> Sd{(const char*)(ws + WS_HB), (const char*)(ws + W_FGU), M / 256, 2 * DFF / 256, F.G, bx, F.wave};
                  pg8::EpiSwiglu E{(bf16*)(ws + WS_HID), DFF, 0}; pg8::gemm_phase<1024, 2048, 2048>(F.lds, Sd, E); } SEAM(10);
    if (IN(11)) { pg8::StaticSched<256 * DFF * 2, 256 * DFF * 2> Sd{(const char*)(ws + WS_HID), (const char*)(ws + W_FD), M / 256, 4, F.G, bx, F.wave};
                  pg8::EpiAcc E{F.acc, D}; pg8::gemm_phase<DFF, DFF * 2, DFF * 2>(F.lds, Sd, E); } SEAM(11);
    if (IN(12)) { ln_phase<0>(F, 2); } SEAM(12);
    if (IN(13)) { pg8::StaticSched<256 * 2048, 256 * 2048> Sd{(const char*)(ws + WS_HB), (const char*)(ws + W_IN1), M / 256, P1_LD / 256, F.G, bx, F.wave};
                  pg8::EpiBf16 E{(bf16*)(ws + WS_P1), P1_LD}; pg8::gemm_phase<1024, 2048, 2048>(F.lds, Sd, E); } SEAM(13);
    if (IN(14)) { cmp_mlp_phase(F); } SEAM(14);
    if (IN(15)) { cmp_attn_phase(F); } SEAM(15);
    if (IN(16)) { slc_phase_mfma(F); } SEAM(16);
    if (IN(17)) { win_phase_mfma(F); } SEAM(17);
    if (IN(18)) { pg8::StaticSched<256 * P1_LD * 2, 256 * 2048> Sd{(const char*)(ws + WS_P1), (const char*)(ws + W_OUT1), M / 256, 4, F.G, bx, F.wave};
                  pg8::EpiAcc E{F.acc, D}; pg8::gemm_phase<1024, P1_LD * 2, 2048>(F.lds, Sd, E); } SEAM(18);
    if (IN(19)) { ln_phase<0>(F, 3); } SEAM(19);
    if (IN(20)) { pg8::StaticSched<256 * 2048, 256 * 2048> Sd{(const char*)(ws + WS_HB), (const char*)(ws + W_XQ + (size_t)512 * 1024 * 2), M / 256, 2, F.G, bx, F.wave};
                  pg8::EpiBf16 E{(bf16*)(ws + WS_QX1), 512}; pg8::gemm_phase<1024, 2048, 2048>(F.lds, Sd, E); } SEAM(20);
    if (IN(21)) { xattn_phase_mfma(F, (const bf16*)(ws + WS_QX1), (const bf16*)(ws + WS_XKV + (size_t)MMEM * 1024 * 2), (bf16*)(ws + WS_OX1)); } SEAM(21);
    if (IN(22)) { pg8::StaticSched<256 * 1024, 256 * 1024> Sd{(const char*)(ws + WS_OX1), (const char*)(ws + W_XO + (size_t)1024 * 512 * 2), M / 256, 4, F.G, bx, F.wave};
                  pg8::EpiAcc E{F.acc, D}; pg8::gemm_phase<512, 1024, 1024>(F.lds, Sd, E); } SEAM(22);
    if (IN(23)) { ln_phase<1>(F, 4); } SEAM(23);
    if (IN(24)) { moe_dispatch(F); } SEAM(24);
#pragma unroll 1
    for (int ch = 0; ch < 4; ++ch) {
        const int pa = 25 + 2 * ch, pb = 26 + 2 * ch;
        const int* tile_exp = (const int*)(ws + WS_TILEEXP);
        if (IN(pa) || IN(pb)) {
            const int slot = ch >> 1; const int s0 = tile_exp[512 + slot], s1 = tile_exp[512 + slot + 1];
            int t0 = s0 + (ch & 1) * MOE_CHUNK_TILES, t1 = (ch & 1) ? s1 : (s0 + MOE_CHUNK_TILES < s1 ? s0 + MOE_CHUNK_TILES : s1);
            if (t0 > s1) t0 = s1; int nT = t1 - t0; if (nT < 0) nT = 0; if (nT > MOE_CHUNK_TILES) nT = MOE_CHUNK_TILES;
            if (IN(pa)) { pg8::MoeSched<WS_PERMA, W_MGU, 256 * 2048, 256 * 2048, (size_t)7168 * 2048, 0> Sd{ws, t0, nT, 2 * DFFE / 256, F.G, bx, F.wave};
                          pg8::EpiSwiglu E{(bf16*)(ws + WS_HIDM), DFFE, 1}; pg8::gemm_phase<1024, 2048, 2048>(F.lds, Sd, E); }
            if (IN(pa) && IN(pb)) xcd_barrier(bar);
            if (IN(pb)) { pg8::MoeSched<WS_HIDM, W_MD, 256 * DFFE * 2, 256 * DFFE * 2, (size_t)1024 * DFFE * 2, 1> Sd{ws, t0, nT, 4, F.G, bx, F.wave};
                          pg8::EpiMoeDown E{F.acc, ws}; pg8::gemm_phase<DFFE, DFFE * 2, DFFE * 2>(F.lds, Sd, E); }
            if (IN(pb) && IN(pb + 1)) xcd_barrier(bar);
        }
    }
    if (IN(33)) { ln_phase<2>(F, 5); }
#undef IN
#undef SEAM
}

extern "C" void kernel_launch(void* const* d_in, const int* in_sizes, int n_in, void* d_out, int out_size, void* d_ws, size_t ws_size, hipStream_t stream) {
    static int grid = 0;
    if (grid == 0) {
        if (n_in != 30 || out_size != M * D || ws_size < WS_END) { fprintf(stderr, "kernel_launch: unexpected shapes (n_in %d, out %d, ws %zu < %zu); nothing launched\n", n_in, out_size, ws_size, (size_t)WS_END); grid = -1; return; }
        int dev = 0, cus = 0, per_cu = 0;
        if (hipGetDevice(&dev) != hipSuccess || hipDeviceGetAttribute(&cus, hipDeviceAttributeMultiprocessorCount, dev) != hipSuccess) { grid = -1; return; }
        if (hipFuncSetAttribute((const void*)skel_fwd, hipFuncAttributeMaxDynamicSharedMemorySize, LDS_BYTES) != hipSuccess) { fprintf(stderr, "kernel_launch: hipFuncSetAttribute failed\n"); grid = -1; return; }
        if (hipOccupancyMaxActiveBlocksPerMultiprocessor(&per_cu, (const void*)skel_fwd, NWAVES * 64, LDS_BYTES) != hipSuccess || per_cu < 1)
            fprintf(stderr, "kernel_launch: occupancy query reports %d workgroups per CU\n", per_cu);
        (void)hipGetLastError();
        grid = cus;
    }
    if (grid < 0) return;
    if (hipMemsetAsync((char*)d_ws + WS_CTL, 0, CTL_ZERO_BYTES, stream) != hipSuccess) return;
    Args a{};
    for (int i = 0; i < 30; ++i) a.in[i] = (const float*)d_in[i];
    a.out = (float*)d_out; a.ws = (unsigned char*)d_ws;
#if MK_ONE_LAUNCH
    a.ph_lo = 0; a.ph_hi = NPHASE;
    hipLaunchKernelGGL(skel_fwd, dim3(grid), dim3(NWAVES * 64), LDS_BYTES, stream, a);
#else
    for (int p = 0; p < NPHASE; ++p) { a.ph_lo = p; a.ph_hi = p + 1; hipLaunchKernelGGL(skel_fwd, dim3(grid), dim3(NWAVES * 64), LDS_BYTES, stream, a); }
#endif
}
```

```cpp
#include <hip/hip_runtime.h>
#include <cstdio>
#include <cstdint>

#ifndef MK_ONE_LAUNCH
#define MK_ONE_LAUNCH 1
#endif

constexpr size_t ROWTOK_OFF = 5u * 1048576u + 512u * 1024u, ROWW_OFF = 6u * 1048576u, TILEEXP_OFF = 6u * 1048576u + 512u * 1024u, DUMMY_OFF = 7u * 1048576u;
namespace pg8 {
#define PG8_LAS __attribute__((address_space(3)))
typedef unsigned short bf16_t;
typedef short bf16x8 __attribute__((ext_vector_type(8)));
typedef float f32x4 __attribute__((ext_vector_type(4)));
typedef unsigned u32x4 __attribute__((ext_vector_type(4)));
constexpr int BM = 256, BK = 64, HALF = 128, HTB = HALF * BK * 2, STAGE_BYTES = 8 * HTB, NXCD = 8, WGM = 8;

__host__ __device__ __forceinline__ int lds_byte(int r, int c) { const int st = (r >> 4) * 2 + (c >> 5), rr = r & 15, cc = c & 31, ob = rr * 64 + cc * 2; return st * 1024 + (ob ^ (((ob >> 9) & 1) << 5)); }
__host__ __device__ __forceinline__ void stage_rc(int b, int& R, int& C) { const int st = b / 1024, sb = b % 1024, swz = sb ^ (((sb >> 9) & 1) << 5); R = (st >> 1) * 16 + swz / 64; C = (st & 1) * 32 + (swz % 64) / 2; }
__host__ __device__ __forceinline__ int perm32(int rho) { const int n = rho >> 4, i = rho & 15; return 8 * (i >> 2) + 4 * n + (i & 3); }

__device__ __forceinline__ const void* opaque_uniform(const void* p) {
    unsigned lo = __builtin_amdgcn_readfirstlane((unsigned)(unsigned long long)p), hi = __builtin_amdgcn_readfirstlane((unsigned)((unsigned long long)p >> 32));
    asm volatile("" : "+s"(lo), "+s"(hi)); return (const void*)(((unsigned long long)hi << 32) | lo); }
struct Unit { int pm, pn, aux; const char* a; const char* b; };

__device__ __forceinline__ void tile_of(int wgid, int nM, int nN, int& pm, int& pn) {
    const int nwg = nM * nN;
    { const int q = nwg / NXCD, r = nwg % NXCD, xcd = wgid % NXCD, off = wgid / NXCD; wgid = (xcd < r ? xcd * (q + 1) : r * (q + 1) + (xcd - r) * q) + off; }
    const int nig = WGM * nN, gid = wgid / nig, fm = gid * WGM, gsz = (nM - fm) < WGM ? (nM - fm) : WGM;
    pm = fm + ((wgid % nig) % gsz); pn = (wgid % nig) / gsz;
}
template <size_t A_TILE, size_t B_TILE>
struct StaticSched {
    const char* A; const char* B; int nM, nN, G, c, wave;
    __device__ __forceinline__ bool next(int i, Unit& u) const {
        const long L = (long)i * G + c; if (L >= (long)nM * nN) return false;
        int pm, pn; tile_of((int)L, nM, nN, pm, pn);
        u.pm = pm; u.pn = pn; u.aux = 0; u.a = A + (size_t)pm * A_TILE; u.b = B + (size_t)pn * B_TILE; return true;
    }
};
template <size_t A_OFF, size_t B_OFF, size_t A_TILE, size_t B_TILE, size_t B_EXP, int A_LOCAL>
struct MoeSched {
    const unsigned char* ws; int t0, nT, nN, G, c, wave;
    __device__ __forceinline__ bool next(int i, Unit& u) const {
        const long L = (long)i * G + c; if (L >= (long)nT * nN) return false;
        int pml, pn; tile_of((int)L, nT, nN, pml, pn);
        const unsigned char* wsb = (const unsigned char*)opaque_uniform(ws);
        const int pm = t0 + pml; const int e = __builtin_amdgcn_readfirstlane(((const int*)(wsb + TILEEXP_OFF))[pm]);
        u.pm = pm; u.pn = pn; u.aux = pml; u.a = (const char*)wsb + A_OFF + (size_t)(A_LOCAL ? pml : pm) * A_TILE; u.b = (const char*)wsb + B_OFF + (size_t)e * B_EXP + (size_t)pn * B_TILE; return true;
    }
};

__device__ __forceinline__ unsigned cvt_pk_bf16(float lo, float hi) { unsigned r; asm volatile("v_cvt_pk_bf16_f32 %0, %1, %2" : "=v"(r) : "v"(lo), "v"(hi)); return r; }

struct EpiBf16 {
    static constexpr bool PERM = true;
    bf16_t* O; int ldc;
    __device__ __forceinline__ void operator()(const f32x4 (&acc)[2][2][4][2], const Unit& u, int wr, int wc, int fr, int fq) const {
        const int row0 = u.pm * BM + wr * 64 + fr, col0 = u.pn * BM + wc * 32 + 8 * fq;
#pragma unroll
        for (int ai = 0; ai < 2; ++ai)
#pragma unroll
            for (int m = 0; m < 4; ++m) { bf16_t* rowp = O + (size_t)(row0 + ai * HALF + m * 16) * ldc + col0;
#pragma unroll
                for (int bj = 0; bj < 2; ++bj) { const f32x4 v0 = acc[ai][bj][m][0], v1 = acc[ai][bj][m][1];
                    u32x4 w; w.x = cvt_pk_bf16(v0[0], v0[1]); w.y = cvt_pk_bf16(v0[2], v0[3]); w.z = cvt_pk_bf16(v1[0], v1[1]); w.w = cvt_pk_bf16(v1[2], v1[3]);
                    *(u32x4*)(rowp + bj * HALF) = w; } }
    }
};
struct EpiAcc {
    static constexpr bool PERM = false;
    float* C; int ldc;
    __device__ __forceinline__ void operator()(const f32x4 (&acc)[2][2][4][2], const Unit& u, int wr, int wc, int fr, int fq) const {
        const int row0 = u.pm * BM + wr * 64 + fr, col0 = u.pn * BM + wc * 32 + 4 * fq;
#pragma unroll
        for (int ai = 0; ai < 2; ++ai)
#pragma unroll
            for (int m = 0; m < 4; ++m) { float* rowp = C + (size_t)(row0 + ai * HALF + m * 16) * ldc + col0;
                f32x4 o[2][2];
#pragma unroll
                for (int bj = 0; bj < 2; ++bj)
#pragma unroll
                    for (int n = 0; n < 2; ++n) o[bj][n] = *(const f32x4*)(rowp + bj * HALF + n * 16);
#pragma unroll
                for (int bj = 0; bj < 2; ++bj)
#pragma unroll
                    for (int n = 0; n < 2; ++n) *(f32x4*)(rowp + bj * HALF + n * 16) = o[bj][n] + acc[ai][bj][m][n]; }
    }
};
__device__ __forceinline__ float silu_f(float x) { return x / (1.0f + __expf(-x)); }
struct EpiSwiglu {
    static constexpr bool PERM = true;
    bf16_t* O; int ldc; int row_local;
    __device__ __forceinline__ void operator()(const f32x4 (&acc)[2][2][4][2], const Unit& u, int wr, int wc, int fr, int fq) const {
        const int row0 = (row_local ? u.aux : u.pm) * BM + wr * 64 + fr, col0 = u.pn * HALF + wc * 32 + 8 * fq;
#pragma unroll
        for (int ai = 0; ai < 2; ++ai)
#pragma unroll
            for (int m = 0; m < 4; ++m) { bf16_t* rowp = O + (size_t)(row0 + ai * HALF + m * 16) * ldc + col0;
                const f32x4 g0 = acc[ai][0][m][0], g1 = acc[ai][0][m][1], u0 = acc[ai][1][m][0], u1 = acc[ai][1][m][1];
                float h[8];
#pragma unroll
                for (int j = 0; j < 4; ++j) { h[j] = silu_f(g0[j]) * u0[j]; h[4 + j] = silu_f(g1[j]) * u1[j]; }
                u32x4 w; w.x = cvt_pk_bf16(h[0], h[1]); w.y = cvt_pk_bf16(h[2], h[3]); w.z = cvt_pk_bf16(h[4], h[5]); w.w = cvt_pk_bf16(h[6], h[7]);
                *(u32x4*)rowp = w; }
    }
};
struct EpiMoeDown {
    static constexpr bool PERM = false;
    float* C; unsigned char* ws;
    __device__ __forceinline__ void operator()(const f32x4 (&acc)[2][2][4][2], const Unit& u, int wr, int wc, int fr, int fq) const {
        const int row0 = u.pm * BM + wr * 64 + fr, col0 = u.pn * BM + wc * 32 + 4 * fq;
        unsigned char* wsb = (unsigned char*)opaque_uniform(ws);
        const int* rowtok = (const int*)(wsb + ROWTOK_OFF); const float* roww = (const float*)(wsb + ROWW_OFF); float* dummy = (float*)(wsb + DUMMY_OFF);
#pragma unroll
        for (int ai = 0; ai < 2; ++ai)
#pragma unroll
            for (int m = 0; m < 4; ++m) { const int r = row0 + ai * HALF + m * 16; const int tok = rowtok[r]; const float w = roww[r];
                float* rowp = (tok >= 0 ? C + (size_t)tok * 1024 : dummy) + col0;
                f32x4 o[2][2];
#pragma unroll
                for (int bj = 0; bj < 2; ++bj)
#pragma unroll
                    for (int n = 0; n < 2; ++n) o[bj][n] = *(const f32x4*)(rowp + bj * HALF + n * 16);
#pragma unroll
                for (int bj = 0; bj < 2; ++bj)
#pragma unroll
                    for (int n = 0; n < 2; ++n) *(f32x4*)(rowp + bj * HALF + n * 16) = o[bj][n] + acc[ai][bj][m][n] * w; }
    }
};

template <int K, int lda_b, int ldb_b, class Epi, class Sched>
__device__ __forceinline__ void gemm_phase(PG8_LAS unsigned char* lds, const Sched& S, const Epi& E) {
    int tid_ = (int)__builtin_amdgcn_mbcnt_hi(~0u, __builtin_amdgcn_mbcnt_lo(~0u, 0u)); asm volatile("" : "+v"(tid_)); tid_ += S.wave * 64;
    const int tid = tid_, wid = __builtin_amdgcn_readfirstlane(tid >> 6), lane = tid & 63, wr = wid >> 2, wc = wid & 3, fr = lane & 15, fq = lane >> 4;
    constexpr int nt = K / BK;
    unsigned voffA[2], voffB[2];
#pragma unroll
    for (int i = 0; i < 2; ++i) { int R, C; stage_rc(tid * 16 + i * 8192, R, C); const int Rb = Epi::PERM ? ((R & ~31) + perm32(R & 31)) : R;
        voffA[i] = (unsigned)(R * lda_b + C * 2); voffB[i] = (unsigned)(Rb * ldb_b + C * 2); }
    const size_t kstep = (size_t)(BK * 2);
    const size_t hstepA = (size_t)HALF * lda_b, hstepB = (size_t)HALF * ldb_b;
    const unsigned ldsw = (unsigned)wid * 1024u;
    const int aoff = lds_byte(wr * 64 + fr, fq * 8), boff = lds_byte(wc * 32 + fr, fq * 8);
#define PG8_SA(b, h) (((b) * 2 + (h)) * HTB)
#define PG8_SB(b, h) ((4 + (b) * 2 + (h)) * HTB)
#define PG8_STAGE(bufoff, gbase, voff) do { _Pragma("unroll") for (int _i = 0; _i < 2; ++_i) \
        __builtin_amdgcn_global_load_lds((const unsigned*)((const char*)(gbase) + (voff)[_i]), (PG8_LAS unsigned*)(lds + (bufoff) + ldsw + _i * 8192), 16, 0, 0); } while (0)
#define PG8_LDA(dst, b, h) do { _Pragma("unroll") for (int m = 0; m < 4; ++m) _Pragma("unroll") for (int k = 0; k < 2; ++k) dst[m][k] = *(const PG8_LAS bf16x8*)(lds + PG8_SA(b, h) + aoff + m * 2048 + k * 1024); } while (0)
#define PG8_LDB(dst, b, h) do { _Pragma("unroll") for (int n = 0; n < 2; ++n) _Pragma("unroll") for (int k = 0; k < 2; ++k) dst[n][k] = *(const PG8_LAS bf16x8*)(lds + PG8_SB(b, h) + boff + n * 2048 + k * 1024); } while (0)
#define PG8_MMA(ai, bj, At, Bt) do { __builtin_amdgcn_s_setprio(1); _Pragma("unroll") for (int m = 0; m < 4; ++m) _Pragma("unroll") for (int n = 0; n < 2; ++n) _Pragma("unroll") for (int k = 0; k < 2; ++k) \
        acc[ai][bj][m][n] = __builtin_amdgcn_mfma_f32_16x16x32_bf16(Bt[n][k], At[m][k], acc[ai][bj][m][n], 0, 0, 0); __builtin_amdgcn_s_setprio(0); } while (0)
#define PG8_WAIT_V(n) asm volatile("s_waitcnt vmcnt(" #n ")" ::: "memory")
#define PG8_WAIT_L(n) asm volatile("s_waitcnt lgkmcnt(" #n ")" ::: "memory")
#define PG8_BAR __builtin_amdgcn_s_barrier()
#define PG8_SCHED __builtin_amdgcn_sched_barrier(0)
    Unit cur, nxt; int ui = 0;
    if (!S.next(0, cur)) return;
    f32x4 acc[2][2][4][2];
#pragma unroll
    for (int a = 0; a < 2; ++a)
#pragma unroll
        for (int b = 0; b < 2; ++b)
#pragma unroll
            for (int m = 0; m < 4; ++m)
#pragma unroll
                for (int n = 0; n < 2; ++n) acc[a][b][m][n] = (f32x4){0.f, 0.f, 0.f, 0.f};
    bf16x8 At[4][2], B0[2][2], B1[2][2];
    const char* cA = cur.a; const char* cB = cur.b;
    PG8_STAGE(PG8_SB(0, 0), cB, voffB); PG8_STAGE(PG8_SB(0, 1), cB + hstepB, voffB); PG8_STAGE(PG8_SA(0, 0), cA, voffA); PG8_STAGE(PG8_SA(0, 1), cA + hstepA, voffA);
    if (wr == 1) PG8_BAR;
    PG8_WAIT_V(2); PG8_BAR;
    PG8_STAGE(PG8_SB(1, 0), cB + kstep, voffB); PG8_STAGE(PG8_SA(1, 0), cA + kstep, voffA); PG8_STAGE(PG8_SB(1, 1), cB + hstepB + kstep, voffB);
    PG8_WAIT_V(6); PG8_BAR;
    for (;;) {
        const bool has_next = S.next(ui + 1, nxt);
        const char* nA = has_next ? nxt.a : cA; const char* nB = has_next ? nxt.b : cB;
        for (int t = 0; t < nt; t += 2) {
            const bool last = (t == nt - 2);
            const char* a1 = cA + (size_t)(t + 1) * kstep;
            const char* a2 = last ? nA : cA + (size_t)(t + 2) * kstep; const char* b2 = last ? nB : cB + (size_t)(t + 2) * kstep;
            const char* a3 = a2 + kstep; const char* b3 = b2 + kstep;
            PG8_LDB(B0, 0, 0); PG8_LDB(B1, 0, 1); PG8_SCHED; PG8_LDA(At, 0, 0); PG8_STAGE(PG8_SA(1, 1), a1 + hstepA, voffA);
            PG8_WAIT_V(8); PG8_WAIT_L(0); PG8_BAR; PG8_MMA(0, 0, At, B0); PG8_MMA(0, 1, At, B1); PG8_BAR; PG8_SCHED;
            PG8_LDA(At, 0, 1); PG8_STAGE(PG8_SB(0, 0), b2, voffB); PG8_STAGE(PG8_SB(0, 1), b2 + hstepB, voffB); PG8_STAGE(PG8_SA(0, 0), a2, voffA);
            PG8_WAIT_V(8); PG8_WAIT_L(0); PG8_BAR; PG8_MMA(1, 0, At, B0); PG8_MMA(1, 1, At, B1); PG8_BAR; PG8_SCHED;
            PG8_LDB(B0, 1, 0); PG8_LDB(B1, 1, 1); PG8_SCHED; PG8_LDA(At, 1, 0); PG8_STAGE(PG8_SA(0, 1), a2 + hstepA, voffA);
            PG8_WAIT_V(8); PG8_WAIT_L(0); PG8_BAR; PG8_MMA(0, 0, At, B0); PG8_MMA(0, 1, At, B1); PG8_BAR; PG8_SCHED;
            PG8_LDA(At, 1, 1); PG8_STAGE(PG8_SB(1, 0), b3, voffB); PG8_STAGE(PG8_SB(1, 1), b3 + hstepB, voffB); PG8_STAGE(PG8_SA(1, 0), a3, voffA);
            PG8_WAIT_V(8); PG8_WAIT_L(0); PG8_BAR; PG8_MMA(1, 0, At, B0); PG8_MMA(1, 1, At, B1); PG8_BAR; PG8_SCHED;
        }
        if (wr == 0) PG8_BAR;
        E(acc, cur, wr, wc, fr, fq);
        if (!has_next) break;
#pragma unroll
        for (int a = 0; a < 2; ++a)
#pragma unroll
            for (int b = 0; b < 2; ++b)
#pragma unroll
                for (int m = 0; m < 4; ++m)
#pragma unroll
                    for (int n = 0; n < 2; ++n) acc[a][b][m][n] = (f32x4){0.f, 0.f, 0.f, 0.f};
        cur = nxt; cA = nA; cB = nB; ++ui;
        if (wr == 1) PG8_BAR;
    }
    PG8_WAIT_V(0);
    PG8_BAR;
#undef PG8_SA
#undef PG8_SB
#undef PG8_STAGE
#undef PG8_LDA
#undef PG8_LDB
#undef PG8_MMA
#undef PG8_WAIT_V
#undef PG8_WAIT_L
#undef PG8_BAR
#undef PG8_SCHED
}
}

constexpr int NWAVES = 8;
constexpr int D = 1024, NB = 16, S = 2048, M = NB * S, MEML = 256, MMEM = NB * MEML;
constexpr float LN_EPS = 1e-5f, ALPHA = 1.41421356237f;
constexpr int P0_LD = 2560, C0_QLAT = 0, C0_QB = 1024, C0_CKV = 1536, C0_QI = 1664, C0_KI = 2176, C0_KB = 2240, C0_VB = 2368, C0_WI = 2496;
constexpr int P1_LD = 2048, C1_Q = 0, C1_KC = 1024, C1_VC = 1152, C1_KS = 1280, C1_VS = 1408, C1_KW = 1536, C1_VW = 1664, C1_GL = 1792;
constexpr int EVEN_COLS = 1992, ODD_COLS = 1840;
constexpr int DFF = 2816, DFFE = 3584, NE = 8, NCMP = 127;
constexpr int MOE_CHUNK_TILES = 68, MOE_MAX_TILES = 272;

constexpr size_t MiB = 1u << 20;
constexpr size_t WS_CTL = 0, CTL_ZERO_BYTES = 1 * MiB;
constexpr size_t WS_KC = 2 * MiB, WS_VC = 3 * MiB;
constexpr size_t WS_SELM = 4 * MiB;
constexpr size_t WS_RTE = 4 * MiB + 512 * 1024;
constexpr size_t WS_RTW = 5 * MiB;
constexpr size_t WS_ROWTOK = ROWTOK_OFF; static_assert(ROWTOK_OFF == 5 * MiB + 512 * 1024, "");
constexpr size_t WS_ROWW = ROWW_OFF;
constexpr size_t WS_TILEEXP = TILEEXP_OFF; constexpr size_t WS_DUMMY = DUMMY_OFF;
constexpr size_t WS_W = 8 * MiB;
constexpr size_t W_IN0 = WS_W;
constexpr size_t W_OUT0 = W_IN0 + (size_t)2560 * 1024 * 2;
constexpr size_t W_IN1 = W_OUT0 + (size_t)1024 * 1536 * 2;
constexpr size_t W_OUT1 = W_IN1 + (size_t)2048 * 1024 * 2;
constexpr size_t W_XQ = W_OUT1 + (size_t)1024 * 1024 * 2;
constexpr size_t W_XKV = W_XQ + (size_t)2 * 512 * 1024 * 2;
constexpr size_t W_XO = W_XKV + (size_t)2 * 1024 * 1024 * 2;
constexpr size_t W_FGU = W_XO + (size_t)2 * 1024 * 512 * 2;
constexpr size_t W_FD = W_FGU + (size_t)5632 * 1024 * 2;
constexpr size_t W_MGU = W_FD + (size_t)1024 * 2816 * 2;
constexpr size_t W_MD = W_MGU + (size_t)8 * 7168 * 1024 * 2;
constexpr size_t W_END = W_MD + (size_t)8 * 1024 * 3584 * 2;
static_assert(W_END <= 215 * MiB, "weights");
constexpr size_t WS_HB = 215 * MiB;
constexpr size_t WS_XKV = 279 * MiB;
constexpr size_t WS_SCR = 295 * MiB;
constexpr size_t WS_P0 = WS_SCR;
constexpr size_t WS_CN = WS_SCR + 160 * MiB;
constexpr size_t WS_MASK = WS_SCR + 168 * MiB;
constexpr size_t WS_MEMB = WS_SCR + 176 * MiB;
constexpr size_t WS_QX0 = WS_SCR + 184 * MiB, WS_OX0 = WS_SCR + 216 * MiB;
constexpr size_t WS_HID = WS_SCR;
constexpr size_t WS_P1 = WS_SCR;
constexpr size_t WS_OCMP = WS_SCR + 128 * MiB, WS_OSLC = WS_SCR + 192 * MiB;
constexpr size_t WS_QX1 = WS_SCR, WS_OX1 = WS_SCR + 32 * MiB;
constexpr size_t WS_PERMA = WS_SCR;
constexpr size_t WS_HIDM = WS_SCR + 136 * MiB;
constexpr size_t WS_END = WS_SCR + 256 * MiB;
static_assert(WS_HIDM + (size_t)MOE_CHUNK_TILES * 256 * DFFE * 2 <= WS_END, "ws");
constexpr int CW_BAR = 4096;
constexpr int CW_CNT = 16384;
constexpr int CW_CUR = 16384 + 64;

constexpr int RING_BYTES = 131072, LDSCTL_OFF = RING_BYTES, MISC_OFF = LDSCTL_OFF + 320, LDS_BYTES = 147456;

#define GAS __attribute__((address_space(1)))
#define LAS __attribute__((address_space(3)))
typedef unsigned short bf16;
typedef unsigned v4u __attribute__((ext_vector_type(4)));
typedef unsigned v2u __attribute__((ext_vector_type(2)));
typedef float f32x4 __attribute__((ext_vector_type(4)));
#define LDS_WAIT() asm volatile("s_waitcnt lgkmcnt(0)" ::: "memory")
#define WAVE_SYNC() asm volatile("s_waitcnt vmcnt(0) lgkmcnt(0)" ::: "memory")
__device__ __forceinline__ unsigned f2bf(float f) { unsigned u = __builtin_bit_cast(unsigned, f); return (u + 0x7fffu + ((u >> 16) & 1u)) >> 16; }
__device__ __forceinline__ unsigned pk2(float lo, float hi) { return f2bf(lo) | (f2bf(hi) << 16); }
__device__ __forceinline__ float bf2f(bf16 b) { return __builtin_bit_cast(float, (unsigned)b << 16); }
__device__ __forceinline__ float bflo(unsigned w) { return __builtin_bit_cast(float, w << 16); }
__device__ __forceinline__ float bfhi(unsigned w) { return __builtin_bit_cast(float, w & 0xffff0000u); }
__device__ __forceinline__ void ld8bf(const bf16* p, float* f) { const v4u w = *(const v4u*)p; f[0] = bflo(w.x); f[1] = bfhi(w.x); f[2] = bflo(w.y); f[3] = bfhi(w.y); f[4] = bflo(w.z); f[5] = bfhi(w.z); f[6] = bflo(w.w); f[7] = bfhi(w.w); }
__device__ __forceinline__ float wave_sum(float v) {
#pragma unroll
    for (int o = 1; o < 64; o <<= 1) v += __shfl_xor(v, o);
    return v;
}
__device__ __forceinline__ float wave_max(float v) {
#pragma unroll
    for (int o = 1; o < 64; o <<= 1) v = fmaxf(v, __shfl_xor(v, o));
    return v;
}
__device__ const unsigned char BKT[112] = {16, 16, 16, 17, 17, 18, 18, 18, 19, 19, 19, 20, 20, 20, 20, 21, 21, 21, 21, 22, 22, 22, 22, 22, 23, 23, 23, 23, 23, 23, 24, 24, 24, 24, 24, 24, 25, 25, 25, 25, 25, 25, 25, 26, 26, 26, 26, 26, 26, 26, 26,
    27, 27, 27, 27, 27, 27, 27, 27, 27, 27, 28, 28, 28, 28, 28, 28, 28, 28, 28, 28, 29, 29, 29, 29, 29, 29, 29, 29, 29, 29, 29, 29, 30, 30, 30, 30, 30, 30, 30, 30, 30, 30, 30, 30, 30, 30, 31, 31, 31, 31, 31, 31, 31, 31, 31, 31, 31, 31, 31, 31, 31};
__device__ __forceinline__ int rel_bucket(int n) { return n < 16 ? n : (n >= 128 ? 31 : (int)BKT[n - 16]); }

#define XB_TMO      128
#define XB_XCNT(j)  (256  + 64 * (j))
#define XB_XSUB(j)  (1280 + 64 * (j))
#define XB_XGEN(j)  (2304 + 64 * (j))
#define XB_TOP      3328
#define XB_TOPGEN   3392
#define XCD_BAR_WORDS 3456
#define XB_SPIN_CAP (1u << 22)
__device__ __forceinline__ unsigned xb_ld(unsigned* p)              { return __hip_atomic_load(p, __ATOMIC_RELAXED, __HIP_MEMORY_SCOPE_AGENT); }
__device__ __forceinline__ unsigned xb_add(unsigned* p, unsigned v) { return __hip_atomic_fetch_add(p, v, __ATOMIC_RELAXED, __HIP_MEMORY_SCOPE_AGENT); }
__device__ __forceinline__ unsigned xb_xcc_id() { return (unsigned)__builtin_amdgcn_s_getreg((3 << 11) | 20) & 0xFu; }
#define XB_SPIN(cond, bar) do { unsigned _sp = 0; while (cond) { __builtin_amdgcn_s_sleep(1); \
    if ((++_sp & 255u) == 0u) { if (xb_ld(&(bar)[XB_TMO])) break; if (_sp > XB_SPIN_CAP) { atomicAdd(&(bar)[XB_TMO], 1u); break; } } } } while (0)
struct XcdBarrier { unsigned* bar; unsigned x; volatile LAS unsigned* st; };
__device__ __forceinline__ XcdBarrier xcd_barrier_post(unsigned* bar, volatile LAS unsigned* st) {
    XcdBarrier b; b.bar = bar; b.x = xb_xcc_id(); b.st = st;
    if (threadIdx.x == 0) (void)xb_add(&bar[XB_XCNT(b.x)], 1u);
    return b;
}
__device__ __forceinline__ void xcd_barrier_complete(unsigned* bar, unsigned x, unsigned& nloc, unsigned& nx) {
    const unsigned G = gridDim.x * gridDim.y * gridDim.z;
    unsigned sum, cnt, mine, sp = 0u;
    for (;;) {
        sum = 0u; cnt = 0u; mine = 0u;
#pragma unroll
        for (unsigned j = 0; j < 16; ++j) { const unsigned c = xb_ld(&bar[XB_XCNT(j)]); sum += c; cnt += (c > 0u) ? 1u : 0u; mine = (j == x) ? c : mine; }
        if (sum == G) break;
        __builtin_amdgcn_s_sleep(1);
        if ((++sp & 255u) == 0u) { if (xb_ld(&bar[XB_TMO])) break; if (sp > XB_SPIN_CAP) { atomicAdd(&bar[XB_TMO], 1u); break; } }
    }
    nloc = mine > 0u ? mine : 1u; nx = cnt > 0u ? cnt : 1u;
}
__device__ __forceinline__ void xcd_barrier(const XcdBarrier& b) {
    asm volatile("s_waitcnt vmcnt(0)" ::: "memory");
    __syncthreads();
    if (threadIdx.x == 0) {
        unsigned* bar = b.bar;
        __builtin_amdgcn_s_waitcnt(0);
        unsigned nloc = b.st[0], nx = b.st[1];
        const unsigned old = xb_add(&bar[XB_XSUB(b.x)], 1u);
        const unsigned gen = old / nloc;
        if (old + 1u == (gen + 1u) * nloc) {
            __builtin_amdgcn_fence(__ATOMIC_RELEASE, "agent");
            asm volatile("s_waitcnt vmcnt(0)" ::: "memory");
            const unsigned og = xb_add(&bar[XB_TOP], 1u);
            const unsigned tg = og / nx;
            if (og + 1u == (tg + 1u) * nx) xb_add(&bar[XB_TOPGEN], 1u);
            else XB_SPIN(xb_ld(&bar[XB_TOPGEN]) == tg, bar);
            __builtin_amdgcn_fence(__ATOMIC_ACQUIRE, "agent");
            xb_add(&bar[XB_XGEN(b.x)], 1u);
            asm volatile("s_waitcnt vmcnt(0)" ::: "memory");
        } else {
            XB_SPIN(xb_ld(&bar[XB_XGEN(b.x)]) == gen, bar);
            __builtin_amdgcn_fence(__ATOMIC_ACQUIRE, "agent");
            asm volatile("s_waitcnt vmcnt(0)" ::: "memory");
        }
    }
    __syncthreads();
}

struct Args { const float* in[30]; float* out; unsigned char* ws; int ph_lo, ph_hi; };
enum { I_X = 0, I_MEM, I_REL, I_EV_WIN, I_EV_GAIN, I_EV_WUK, I_EV_WUV, I_EV_SINK, I_EV_WOUT, I_OD_WIN, I_OD_PEK, I_OD_W1K, I_OD_W2K, I_OD_PEV, I_OD_W1V, I_OD_W2V, I_OD_WOUT,
       I_XA_WQ, I_XA_WK, I_XA_WV, I_XA_WO, I_FF_G, I_FF_U, I_FF_D, I_MOE_R, I_MOE_G, I_MOE_U, I_MOE_D, I_LN_G, I_LN_B };

struct Frame {
    LAS unsigned char* lds;
    unsigned char* ws; float* acc;
    const float* const* in;
    int tid, lane, wave, G, gw, NGW;
};

__device__ __forceinline__ bool fresh(Frame& F) { int l = (int)__builtin_amdgcn_mbcnt_hi(~0u, __builtin_amdgcn_mbcnt_lo(~0u, 0u)); asm volatile("" : "+v"(l)); F.lane = l; F.tid = F.wave * 64 + l; return true; }
__device__ __forceinline__ void tconv_item(const float* W, int ldw, int ncols, bf16* WT, int ldt, int grp, int gstride, LAS float* scr, int kb, int nb, int lane) {
    const int k0 = 64 * kb, n0 = 32 * nb;
#pragma unroll 8
    for (int i = 0; i < 32; ++i) { const int kk = 2 * i + (lane >> 5), n = n0 + (lane & 31); scr[kk * 33 + (lane & 31)] = (n < ncols) ? W[(size_t)(k0 + kk) * ldw + n] : 0.f; }
    LDS_WAIT();
    const int c = lane & 7;
#pragma unroll
    for (int j = 0; j < 4; ++j) { const int nn = (lane >> 3) + 8 * j, n = n0 + nn; const LAS float* s = scr + (8 * c) * 33 + nn;
        v4u o; o.x = pk2(s[0 * 33], s[1 * 33]); o.y = pk2(s[2 * 33], s[3 * 33]); o.z = pk2(s[4 * 33], s[5 * 33]); o.w = pk2(s[6 * 33], s[7 * 33]);
        const int row = (n / grp) * gstride + (n % grp);
        *(v4u*)(WT + (size_t)row * ldt + k0 + 8 * c) = o; }
    LDS_WAIT();
}
__device__ __forceinline__ void tconv(const Frame& F, const float* W, int ldw, int K, int ncols, int npad, bf16* WT, int ldt, int grp, int gstride) {
    LAS float* scr = (LAS float*)(F.lds + F.wave * 16384);
    const int nkb = K / 64, nnb = npad / 32;
    for (int it = F.gw; it < nkb * nnb; it += F.NGW) tconv_item(W, ldw, ncols, WT, ldt, grp, gstride, scr, it / nnb, it % nnb, F.lane);
}
constexpr int NOGRP = 1 << 30;

__device__ __forceinline__ void prologue(const Frame& F) {
    unsigned char* ws = F.ws;
    const int gt = F.gw * 64 + F.lane, NT = F.NGW * 64;
    bf16* win0 = (bf16*)(ws + W_IN0);
    const float* evw = F.in[I_EV_WIN];
    tconv(F, evw + 512, EVEN_COLS, 1024, 128, 128, win0 + (size_t)C0_CKV * 1024, 1024, NOGRP, 0);
    tconv(F, evw + 640, EVEN_COLS, 1024, 512, 512, win0 + (size_t)C0_QI * 1024, 1024, NOGRP, 0);
    tconv(F, evw + 1152, EVEN_COLS, 1024, 64, 64, win0 + (size_t)C0_KI * 1024, 1024, NOGRP, 0);
    tconv(F, evw + 1216, EVEN_COLS, 1024, 8, 64, win0 + (size_t)C0_WI * 1024, 1024, NOGRP, 0);
    tconv(F, evw + 1224, EVEN_COLS, 1024, 512, 512, win0 + (size_t)C0_QB * 1024, 1024, NOGRP, 0);
    tconv(F, evw + 1736, EVEN_COLS, 1024, 128, 128, win0 + (size_t)C0_KB * 1024, 1024, NOGRP, 0);
    tconv(F, evw + 1864, EVEN_COLS, 1024, 128, 128, win0 + (size_t)C0_VB * 1024, 1024, NOGRP, 0);
    {
        const float* wuk = F.in[I_EV_WUK];
        for (int idx = gt; idx < 1024 * 1024; idx += NT) { const int r = idx >> 10, k = idx & 1023, h = r >> 7, c = r & 127;
            const float* wr = evw + (size_t)k * EVEN_COLS + h * 64; const float* uk = wuk + (size_t)h * 64 * 128 + c; float s = 0.f;
#pragma unroll 8
            for (int d = 0; d < 64; ++d) s += wr[d] * uk[d * 128];
            win0[(size_t)(C0_QLAT + r) * 1024 + k] = (bf16)f2bf(s); }
    }
    bf16* wout0 = (bf16*)(ws + W_OUT0);
    const float* evo = F.in[I_EV_WOUT];
    tconv(F, evo + (size_t)512 * 1024, 1024, 512, 1024, 1024, wout0 + 1024, 1536, NOGRP, 0);
    {
        const float* wuv = F.in[I_EV_WUV];
        for (int idx = gt; idx < 1024 * 1024; idx += NT) { const int n = idx >> 10, kk = idx & 1023, h = kk >> 7;
            const float* uv = wuv + (size_t)kk * 64; const float* wo = evo + (size_t)h * 64 * 1024 + n; float s = 0.f;
#pragma unroll 8
            for (int d = 0; d < 64; ++d) s += uv[d] * wo[(size_t)d * 1024];
            wout0[(size_t)n * 1536 + kk] = (bf16)f2bf(s); }
    }
    tconv(F, F.in[I_OD_WIN], ODD_COLS, 1024, ODD_COLS, 2048, (bf16*)(ws + W_IN1), 1024, NOGRP, 0);
    tconv(F, F.in[I_OD_WOUT], 1024, 1024, 1024, 1024, (bf16*)(ws + W_OUT1), 1024, NOGRP, 0);
    for (int i = 0; i < 2; ++i) {
        tconv(F, F.in[I_XA_WQ] + (size_t)i * 1024 * 512, 512, 1024, 512, 512, (bf16*)(ws + W_XQ) + (size_t)i * 512 * 1024, 1024, NOGRP, 0);
        tconv(F, F.in[I_XA_WK] + (size_t)i * 1024 * 512, 512, 1024, 512, 512, (bf16*)(ws + W_XKV) + (size_t)i * 1024 * 1024, 1024, NOGRP, 0);
        tconv(F, F.in[I_XA_WV] + (size_t)i * 1024 * 512, 512, 1024, 512, 512, (bf16*)(ws + W_XKV) + (size_t)i * 1024 * 1024 + (size_t)512 * 1024, 1024, NOGRP, 0);
        tconv(F, F.in[I_XA_WO] + (size_t)i * 512 * 1024, 1024, 512, 1024, 1024, (bf16*)(ws + W_XO) + (size_t)i * 1024 * 512, 512, NOGRP, 0);
    }
    tconv(F, F.in[I_FF_G], DFF, 1024, DFF, DFF, (bf16*)(ws + W_FGU), 1024, 128, 256);
    tconv(F, F.in[I_FF_U], DFF, 1024, DFF, DFF, (bf16*)(ws + W_FGU) + (size_t)128 * 1024, 1024, 128, 256);
    tconv(F, F.in[I_FF_D], 1024, DFF, 1024, 1024, (bf16*)(ws + W_FD), DFF, NOGRP, 0);
    for (int e = 0; e < NE; ++e) {
        tconv(F, F.in[I_MOE_G] + (size_t)e * 1024 * DFFE, DFFE, 1024, DFFE, DFFE, (bf16*)(ws + W_MGU) + (size_t)e * 7168 * 1024, 1024, 128, 256);
        tconv(F, F.in[I_MOE_U] + (size_t)e * 1024 * DFFE, DFFE, 1024, DFFE, DFFE, (bf16*)(ws + W_MGU) + (size_t)e * 7168 * 1024 + (size_t)128 * 1024, 1024, 128, 256);
        tconv(F, F.in[I_MOE_D] + (size_t)e * DFFE * 1024, 1024, DFFE, 1024, 1024, (bf16*)(ws + W_MD) + (size_t)e * 1024 * DFFE, DFFE, NOGRP, 0);
    }
    {
        const f32x4* x4 = (const f32x4*)F.in[I_X]; v2u* hb = (v2u*)(ws + WS_HB); f32x4* a4 = (f32x4*)F.acc;
        for (int i = gt; i < M * D / 4; i += NT) { const f32x4 v = x4[i]; v2u o; o.x = pk2(v.x, v.y); o.y = pk2(v.z, v.w); hb[i] = o; a4[i] = v * ALPHA; }
        const f32x4* m4 = (const f32x4*)F.in[I_MEM]; v2u* mb = (v2u*)(ws + WS_MEMB);
        for (int i = gt; i < MMEM * D / 4; i += NT) { const f32x4 v = m4[i]; v2u o; o.x = pk2(v.x, v.y); o.y = pk2(v.z, v.w); mb[i] = o; }
    }
}

template <int MODE>
__device__ __forceinline__ void ln_phase(const Frame& F, int li) {
    const float* g = F.in[I_LN_G] + (size_t)li * D; const float* bb = F.in[I_LN_B] + (size_t)li * D;
    LAS int* lcnt = (LAS int*)F.lds;
    if (MODE == 1) { if (F.tid < 16) lcnt[F.tid] = 0; __syncthreads(); }
    for (int row = F.gw; row < M; row += F.NGW) {
        f32x4* p = (f32x4*)(F.acc + (size_t)row * D) + F.lane;
        f32x4 v[4]; float s = 0.f;
#pragma unroll
        for (int j = 0; j < 4; ++j) { v[j] = p[64 * j]; s += (v[j].x + v[j].y) + (v[j].z + v[j].w); }
        const float mean = wave_sum(s) * (1.f / D); float s2 = 0.f;
#pragma unroll
        for (int j = 0; j < 4; ++j) { v[j] = v[j] - mean; s2 += (v[j].x * v[j].x + v[j].y * v[j].y) + (v[j].z * v[j].z + v[j].w * v[j].w); }
        const float rstd = 1.f / sqrtf(wave_sum(s2) * (1.f / D) + LN_EPS);
#pragma unroll
        for (int j = 0; j < 4; ++j) { const f32x4 gg = ((const f32x4*)g)[F.lane + 64 * j], b4 = ((const f32x4*)bb)[F.lane + 64 * j]; v[j] = v[j] * rstd * gg + b4; }
        if (MODE == 2) {
#pragma unroll
            for (int j = 0; j < 4; ++j) p[64 * j] = v[j];
        } else {
            v2u* hb = (v2u*)(F.ws + WS_HB + (size_t)row * D * 2) + F.lane;
#pragma unroll
            for (int j = 0; j < 4; ++j) { v2u o; o.x = pk2(v[j].x, v[j].y); o.y = pk2(v[j].z, v[j].w); hb[64 * j] = o; p[64 * j] = v[j] * ALPHA; }
        }
        if (MODE == 1) {
            const float* wr = F.in[I_MOE_R]; float lg[8];
#pragma unroll
            for (int e = 0; e < 8; ++e) lg[e] = 0.f;
#pragma unroll
            for (int j = 0; j < 4; ++j)
#pragma unroll
                for (int i = 0; i < 4; ++i) { const int c = 4 * (F.lane + 64 * j) + i; const f32x4 w0 = *(const f32x4*)(wr + (size_t)c * 8), w1 = *(const f32x4*)(wr + (size_t)c * 8 + 4); const float y = v[j][i];
                    lg[0] += y * w0.x; lg[1] += y * w0.y; lg[2] += y * w0.z; lg[3] += y * w0.w; lg[4] += y * w1.x; lg[5] += y * w1.y; lg[6] += y * w1.z; lg[7] += y * w1.w; }
#pragma unroll
            for (int e = 0; e < 8; ++e) lg[e] = wave_sum(lg[e]);
            int e0 = 0; float v0 = lg[0];
#pragma unroll
            for (int e = 1; e < 8; ++e) if (lg[e] > v0) { v0 = lg[e]; e0 = e; }
            int e1 = -1; float v1 = -3.0e38f;
#pragma unroll
            for (int e = 0; e < 8; ++e) if (e != e0 && lg[e] > v1) { v1 = lg[e]; e1 = e; }
            const float w0 = 1.f / (1.f + __expf(v1 - v0)), w1 = 1.f - w0;
            if (F.lane == 0) { int* rte = (int*)(F.ws + WS_RTE); float* rtw = (float*)(F.ws + WS_RTW); rte[2 * row] = e0; rte[2 * row + 1] = e1; rtw[2 * row] = w0; rtw[2 * row + 1] = w1;
                atomicAdd((int*)&lcnt[e0], 1); atomicAdd((int*)&lcnt[8 + e1], 1); }
        }
    }
    if (MODE == 1) { __syncthreads(); if (F.tid < 16) { const int c = lcnt[F.tid]; if (c) atomicAdd((unsigned*)(F.ws + WS_CTL) + CW_CNT + F.tid, (unsigned)c); } }
}

__device__ __forceinline__ void moe_dispatch(const Frame& F) {
    unsigned* ctl = (unsigned*)(F.ws + WS_CTL);
    int* tile_exp = (int*)(F.ws + WS_TILEEXP); int* rowtok = (int*)(F.ws + WS_ROWTOK); float* roww = (float*)(F.ws + WS_ROWW);
    LAS int* seg = (LAS int*)F.lds;
    if (F.tid == 0) { int run = 0;
#pragma unroll 1
        for (int sgi = 0; sgi < 16; ++sgi) { if ((sgi & 7) == 0) seg[32 + (sgi >> 3)] = run >> 8; seg[sgi] = run; const int c = (int)__hip_atomic_load(ctl + CW_CNT + sgi, __ATOMIC_RELAXED, __HIP_MEMORY_SCOPE_AGENT); seg[16 + sgi] = c; run += (c + 255) & ~255; }
        seg[34] = run >> 8; }
    __syncthreads();
    if (blockIdx.x == 0) {
#pragma unroll 1
        for (int sgi = 0; sgi < 16; ++sgi) { const int c = seg[16 + sgi], st = seg[sgi], en = st + ((c + 255) & ~255);
            for (int t = (st >> 8) + F.tid; t < (en >> 8); t += 512) tile_exp[t] = sgi & 7;
            for (int r = st + c + F.tid; r < en; r += 512) { rowtok[r] = -1; roww[r] = 0.f; } }
        if (F.tid < 3) tile_exp[512 + F.tid] = seg[32 + F.tid];
    }
    const int* rte = (const int*)(F.ws + WS_RTE); const float* rtw = (const float*)(F.ws + WS_RTW);
    for (int base = F.gw * 64; base < M; base += F.NGW * 64) {
        const int tok = base + F.lane; const int e0 = rte[2 * tok], e1 = rte[2 * tok + 1]; const float w0 = rtw[2 * tok], w1 = rtw[2 * tok + 1];
        int pos0 = 0, pos1 = 0;
#pragma unroll 1
        for (int sgi = 0; sgi < 16; ++sgi) { const bool mine = (sgi < 8) ? (e0 == sgi) : (e1 == sgi - 8);
            const unsigned long long bal = __ballot(mine);
            if (bal) { const int n = __popcll(bal); unsigned b0 = 0; if (F.lane == 0) b0 = atomicAdd(ctl + CW_CUR + sgi, (unsigned)n); b0 = __shfl(b0, 0);
                const int rank = __popcll(bal & ((1ull << F.lane) - 1ull));
                if (mine) { const int pos = seg[sgi] + (int)b0 + rank; if (sgi < 8) pos0 = pos; else pos1 = pos; } } }
        rowtok[pos0] = tok; roww[pos0] = w0; rowtok[pos1] = tok; roww[pos1] = w1;
#pragma unroll 1
        for (int i = 0; i < 64; ++i) { const int tk = base + i; const int p0 = __shfl(pos0, i), p1 = __shfl(pos1, i);
            const v4u* src = (const v4u*)(F.ws + WS_HB + (size_t)tk * D * 2);
            v4u* d0 = (v4u*)(F.ws + WS_PERMA + (size_t)p0 * D * 2); v4u* d1 = (v4u*)(F.ws + WS_PERMA + (size_t)p1 * D * 2);
            const v4u a = src[F.lane], b = src[F.lane + 64]; d0[F.lane] = a; d0[F.lane + 64] = b; d1[F.lane] = a; d1[F.lane + 64] = b; }
    }
    __syncthreads();
}

__device__ __forceinline__ void cn_phase(const Frame& F) {
    const bf16* P0 = (const bf16*)(F.ws + WS_P0); bf16* CN = (bf16*)(F.ws + WS_CN); const float* gain = F.in[I_EV_GAIN];
    for (int row = F.gw; row < M; row += F.NGW) {
        const unsigned w = *(const unsigned*)(P0 + (size_t)row * P0_LD + C0_CKV + 2 * F.lane); const float a = bflo(w), b = bfhi(w);
        const float ms = wave_sum(a * a + b * b) * (1.f / 128.f); const float r = 1.f / sqrtf(ms + LN_EPS);
        *(unsigned*)(CN + (size_t)row * 128 + 2 * F.lane) = pk2(a * r * gain[2 * F.lane], b * r * gain[2 * F.lane + 1]);
    }
}

__device__ __forceinline__ unsigned fkey(float x) { unsigned b = __builtin_bit_cast(unsigned, x); if (b == 0x80000000u) b = 0u; return (b & 0x80000000u) ? ~b : (b | 0x80000000u); }
__device__ __forceinline__ void idx_phase(const Frame& F) {
    const bf16* P0 = (const bf16*)(F.ws + WS_P0); unsigned* MASK = (unsigned*)(F.ws + WS_MASK);
    LAS float* qi_s = (LAS float*)F.lds; LAS float* wi_s = qi_s + 4096; LAS float* sc = wi_s + 64;
    for (int item = blockIdx.x; item < NB * (S / 8); item += F.G) {
        const int b = item / (S / 8), t0 = (item % (S / 8)) * 8;
        for (int i = F.tid; i < 4096; i += 512) { const int q = i >> 9, e = i & 511; qi_s[i] = bf2f(P0[(size_t)(b * S + t0 + q) * P0_LD + C0_QI + e]); }
        if (F.tid < 64) { const int q = F.tid >> 3, h = F.tid & 7; wi_s[F.tid] = bf2f(P0[(size_t)(b * S + t0 + q) * P0_LD + C0_WI + h]) * (0.35355339059f * 0.125f); }
        __syncthreads();
        const int nk = t0 + 8;
        for (int s = F.tid; s < nk; s += 512) {
            float kf[64]; const bf16* kr = P0 + (size_t)(b * S + s) * P0_LD + C0_KI;
#pragma unroll
            for (int j = 0; j < 8; ++j) ld8bf(kr + 8 * j, kf + 8 * j);
#pragma unroll 1
            for (int q = 0; q < 8; ++q) { float a = 0.f;
#pragma unroll 1
                for (int h = 0; h < 8; ++h) { const LAS float* qp = qi_s + q * 512 + h * 64; float dot = 0.f;
#pragma unroll
                    for (int d = 0; d < 64; ++d) dot += qp[d] * kf[d];
                    a += wi_s[q * 8 + h] * fmaxf(dot, 0.f); }
                sc[q * 2048 + s] = a; }
        }
        __syncthreads();
        {
            const int q = F.wave, t = t0 + q, n = t + 1, row = b * S + t; unsigned myword = 0u;
            if (n <= 256) { const int cb = n - 32 * F.lane; myword = cb >= 32 ? 0xffffffffu : (cb <= 0 ? 0u : ((1u << cb) - 1u)); }
            else {
                LAS unsigned* uk = (LAS unsigned*)(sc + q * 2048);
#pragma unroll 4
                for (int i = 0; i < 32; ++i) { const int s = F.lane + 64 * i; const unsigned k = (s < n) ? fkey(sc[q * 2048 + s]) : 0u; uk[s] = k; }
                LDS_WAIT();
                unsigned prefix = 0u;
#pragma unroll 1
                for (int bit = 31; bit >= 0; --bit) { const unsigned cand = prefix | (1u << bit); int c = 0;
#pragma unroll 8
                    for (int i = 0; i < 32; ++i) c += (uk[F.lane + 64 * i] >= cand) ? 1 : 0;
#pragma unroll
                    for (int o = 1; o < 64; o <<= 1) c += __shfl_xor(c, o);
                    if (c >= 256) prefix = cand; }
                int cgt = 0;
#pragma unroll 8
                for (int i = 0; i < 32; ++i) cgt += (uk[F.lane + 64 * i] > prefix) ? 1 : 0;
#pragma unroll
                for (int o = 1; o < 64; o <<= 1) cgt += __shfl_xor(cgt, o);
                const int need = 256 - cgt; int run = 0;
#pragma unroll 1
                for (int i = 0; i < 32; ++i) { const unsigned u = uk[F.lane + 64 * i]; const bool eq = (u == prefix); const unsigned long long em = __ballot(eq); const int rank = run + __popcll(em & ((1ull << F.lane) - 1ull));
                    const bool sel = (u > prefix) || (eq && rank < need); run += __popcll(em);
                    const unsigned long long sm = __ballot(sel);
                    if (F.lane == 2 * i) myword = (unsigned)sm; if (F.lane == 2 * i + 1) myword = (unsigned)(sm >> 32); }
            }
            MASK[(size_t)row * 64 + F.lane] = myword;
        }
        __syncthreads();
    }
}

__device__ __forceinline__ void dsa_phase(const Frame& F) {
    bf16* P0 = (bf16*)(F.ws + WS_P0); const bf16* CN = (const bf16*)(F.ws + WS_CN); const unsigned* MASK = (const unsigned*)(F.ws + WS_MASK); const float* rel = F.in[I_REL];
    LAS float* ql = (LAS float*)(F.lds + F.wave * 13312); LAS float* pl = ql + 1024; LAS int* idx = (LAS int*)(pl + 2048);
    for (int row = F.gw; row < M; row += F.NGW) {
        const int b = row / S, t = row % S;
        const unsigned w = MASK[(size_t)row * 64 + F.lane]; const int c = __popc(w);
        int incl = c;
#pragma unroll
        for (int o = 1; o < 64; o <<= 1) { const int v = __shfl_up(incl, o); if (F.lane >= o) incl += v; }
        const int total = __shfl(incl, 63); int pos = incl - c; unsigned ww = w;
        while (ww) { const int bit = __ffs(ww) - 1; idx[pos++] = 32 * F.lane + bit; ww &= ww - 1u; }
#pragma unroll
        for (int i = 0; i < 16; ++i) ql[F.lane + 64 * i] = bf2f(P0[(size_t)row * P0_LD + C0_QLAT + F.lane + 64 * i]);
        WAVE_SYNC();
        float lg[4][8]; bool val[4];
#pragma unroll
        for (int kk = 0; kk < 4; ++kk) { const int k = F.lane + 64 * kk; val[kk] = k < total; const int key = val[kk] ? idx[k] : 0;
            float a[8];
#pragma unroll
            for (int h = 0; h < 8; ++h) a[h] = 0.f;
            const bf16* cr = CN + (size_t)(b * S + key) * 128;
#pragma unroll 1
            for (int j = 0; j < 16; ++j) { float cv[8]; ld8bf(cr + 8 * j, cv);
#pragma unroll
                for (int h = 0; h < 8; ++h)
#pragma unroll
                    for (int i = 0; i < 8; ++i) a[h] += ql[h * 128 + 8 * j + i] * cv[i]; }
            const int bk = rel_bucket(t - key);
#pragma unroll
            for (int h = 0; h < 8; ++h) lg[kk][h] = val[kk] ? (a[h] * 0.125f + rel[bk * 16 + h]) : -1.0e30f;
        }
#pragma unroll
        for (int h = 0; h < 8; ++h) { float m = fmaxf(fmaxf(lg[0][h], lg[1][h]), fmaxf(lg[2][h], lg[3][h])); m = wave_max(m);
            float e[4], s = 0.f;
#pragma unroll
            for (int kk = 0; kk < 4; ++kk) { e[kk] = val[kk] ? __expf(lg[kk][h] - m) : 0.f; s += e[kk]; }
            s = wave_sum(s); const float inv = 1.f / s;
#pragma unroll
            for (int kk = 0; kk < 4; ++kk) pl[h * 256 + F.lane + 64 * kk] = e[kk] * inv; }
        WAVE_SYNC();
        float a0[8], a1[8];
#pragma unroll
        for (int h = 0; h < 8; ++h) { a0[h] = 0.f; a1[h] = 0.f; }
        for (int k = 0; k < total; ++k) { const int key = idx[k]; const unsigned pr = *(const unsigned*)(CN + (size_t)(b * S + key) * 128 + 2 * F.lane); const float vx = bflo(pr), vy = bfhi(pr);
#pragma unroll
            for (int h = 0; h < 8; ++h) { const float p = pl[h * 256 + k]; a0[h] += p * vx; a1[h] += p * vy; } }
#pragma unroll
        for (int h = 0; h < 8; ++h) *(unsigned*)(P0 + (size_t)row * P0_LD + C0_QLAT + h * 128 + 2 * F.lane) = pk2(a0[h], a1[h]);
        WAVE_SYNC();
    }
}

template <int W, int NH, int GRPSZ, bool SINK, bool NSA>
__device__ __forceinline__ void banded_phase(const Frame& F, bf16* P, int ld, int cq, int ck, int cv, int relc0) {
    const float* rel = F.in[I_REL]; const float* sinks = F.in[I_EV_SINK];
    const bf16* OC = (const bf16*)(F.ws + WS_OCMP); const bf16* OS = (const bf16*)(F.ws + WS_OSLC);
    constexpr int NTG = S / 64;
    for (int it = F.gw; it < NB * NH * NTG; it += F.NGW) {
        const int tg = it % NTG, h = (it / NTG) % NH, b = it / (NTG * NH);
        const int t = tg * 64 + F.lane, row = b * S + t, kvh = h / GRPSZ;
        float q[64], acc[64];
        { const bf16* qr = P + (size_t)row * ld + cq + h * 64;
#pragma unroll
          for (int j = 0; j < 8; ++j) ld8bf(qr + 8 * j, q + 8 * j); }
#pragma unroll
        for (int d = 0; d < 64; ++d) acc[d] = 0.f;
        float m = SINK ? sinks[h] : -1.0e30f, l = SINK ? 1.f : 0.f;
#pragma unroll 1
        for (int j = 0; j < W; ++j) { const int s = t - j;
            const float bias = rel[rel_bucket(j) * 16 + relc0 + h];
            if (s >= 0) { const bf16* kr = P + (size_t)(b * S + s) * ld + ck + kvh * 64; float dot = 0.f;
#pragma unroll
                for (int jj = 0; jj < 8; ++jj) { float kf[8]; ld8bf(kr + 8 * jj, kf);
#pragma unroll
                    for (int i = 0; i < 8; ++i) dot += q[8 * jj + i] * kf[i]; }
                const float lgt = dot * 0.125f + bias, mn = fmaxf(m, lgt), corr = __expf(m - mn), p = __expf(lgt - mn);
                l = l * corr + p; m = mn;
                const bf16* vr = P + (size_t)(b * S + s) * ld + cv + kvh * 64;
#pragma unroll
                for (int jj = 0; jj < 8; ++jj) { float vf[8]; ld8bf(vr + 8 * jj, vf);
#pragma unroll
                    for (int i = 0; i < 8; ++i) acc[8 * jj + i] = acc[8 * jj + i] * corr + p * vf[i]; } } }
        const float inv = 1.f / l;
        float g0 = 0.f, g1 = 0.f, g2 = 1.f;
        if (NSA) { const bf16* gr = P + (size_t)row * ld + C1_GL + h * 3; g0 = 1.f / (1.f + __expf(-bf2f(gr[0]))); g1 = 1.f / (1.f + __expf(-bf2f(gr[1]))); g2 = 1.f / (1.f + __expf(-bf2f(gr[2]))); }
        bf16* orow = P + (size_t)row * ld + cq + h * 64;
#pragma unroll
        for (int jj = 0; jj < 8; ++jj) { float o[8];
#pragma unroll
            for (int i = 0; i < 8; ++i) o[i] = acc[8 * jj + i] * inv;
            if (NSA) { float c8[8], s8[8]; ld8bf(OC + (size_t)row * D + h * 64 + 8 * jj, c8); ld8bf(OS + (size_t)row * D + h * 64 + 8 * jj, s8);
#pragma unroll
                for (int i = 0; i < 8; ++i) o[i] = g0 * c8[i] + g1 * s8[i] + g2 * o[i]; }
            v4u w; w.x = pk2(o[0], o[1]); w.y = pk2(o[2], o[3]); w.z = pk2(o[4], o[5]); w.w = pk2(o[6], o[7]);
            *(v4u*)(orow + 8 * jj) = w; }
    }
}

__device__ __forceinline__ void xattn_phase(const Frame& F, const bf16* Q, const bf16* KV, bf16* O) {
    for (int it = F.gw; it < NB * 4 * (S / 32); it += F.NGW) {
        const int tg = it % (S / 32), h = (it / (S / 32)) % 4, b = it / ((S / 32) * 4);
        const int tok = tg * 32 + (F.lane >> 1), half = F.lane & 1, row = b * S + tok;
        float q[64], acc[64];
        { const bf16* qr = Q + (size_t)row * 512 + h * 128 + half * 64;
#pragma unroll
          for (int j = 0; j < 8; ++j) ld8bf(qr + 8 * j, q + 8 * j); }
#pragma unroll
        for (int d = 0; d < 64; ++d) acc[d] = 0.f;
        float m = -1.0e30f, l = 0.f;
#pragma unroll 1
        for (int mm = 0; mm < MEML; ++mm) { const bf16* kr = KV + (size_t)(b * MEML + mm) * 1024 + h * 128 + half * 64; float dot = 0.f;
#pragma unroll
            for (int jj = 0; jj < 8; ++jj) { float kf[8]; ld8bf(kr + 8 * jj, kf);
#pragma unroll
                for (int i = 0; i < 8; ++i) dot += q[8 * jj + i] * kf[i]; }
            dot += __shfl_xor(dot, 1);
            const float lgt = dot * 0.08838834764831845f, mn = fmaxf(m, lgt), corr = __expf(m - mn), p = __expf(lgt - mn);
            l = l * corr + p; m = mn;
            const bf16* vr = kr + 512;
#pragma unroll
            for (int jj = 0; jj < 8; ++jj) { float vf[8]; ld8bf(vr + 8 * jj, vf);
#pragma unroll
                for (int i = 0; i < 8; ++i) acc[8 * jj + i] = acc[8 * jj + i] * corr + p * vf[i]; } }
        const float inv = 1.f / l; bf16* orow = O + (size_t)row * 512 + h * 128 + half * 64;
#pragma unroll
        for (int jj = 0; jj < 8; ++jj) { v4u w; w.x = pk2(acc[8 * jj] * inv, acc[8 * jj + 1] * inv); w.y = pk2(acc[8 * jj + 2] * inv, acc[8 * jj + 3] * inv); w.z = pk2(acc[8 * jj + 4] * inv, acc[8 * jj + 5] * inv); w.w = pk2(acc[8 * jj + 6] * inv, acc[8 * jj + 7] * inv);
            *(v4u*)(orow + 8 * jj) = w; }
    }
}

__device__ __forceinline__ float gelu_tanh(float x) { const float u = 0.7978845608028654f * (x + 0.044715f * x * x * x); return 0.5f * x * (1.f + tanhf(u)); }
__device__ __forceinline__ void cmp_mlp_phase(const Frame& F) {
    const bf16* P1 = (const bf16*)(F.ws + WS_P1);
    LAS float* blk = (LAS float*)F.lds; LAS float* part = blk + 2048; LAS float* hid = part + 512;
    for (int item = blockIdx.x; item < 2 * NB * NCMP * 2; item += F.G) {
        const int g = item & 1, n = (item >> 1) % NCMP, b = ((item >> 1) / NCMP) % NB, which = (item >> 1) / (NCMP * NB);
        const float* pe = which ? F.in[I_OD_PEV] : F.in[I_OD_PEK]; const float* w1 = which ? F.in[I_OD_W1V] : F.in[I_OD_W1K]; const float* w2 = which ? F.in[I_OD_W2V] : F.in[I_OD_W2K];
        bf16* outp = (bf16*)(F.ws + (which ? WS_VC : WS_KC)) + ((size_t)(b * 2 + g) * 128 + n) * 64;
        const int col0 = (which ? C1_VC : C1_KC) + g * 64;
        for (int i = F.tid; i < 2048; i += 512) { const int l = i >> 6, d = i & 63; blk[i] = bf2f(P1[(size_t)(b * S + 16 * n + l) * P1_LD + col0 + d]) + pe[i]; }
        __syncthreads();
        { const int j = F.tid & 127, pp = F.tid >> 7; float a = 0.f; const float* wp = w1 + (size_t)(pp * 512) * 128 + j; const LAS float* bp = blk + pp * 512;
#pragma unroll 8
          for (int kk = 0; kk < 512; ++kk) a += bp[kk] * wp[(size_t)kk * 128];
          part[F.tid] = a; }
        __syncthreads();
        if (F.tid < 128) hid[F.tid] = gelu_tanh((part[F.tid] + part[F.tid + 128]) + (part[F.tid + 256] + part[F.tid + 384]));
        __syncthreads();
        if (F.tid < 64) { float a = 0.f;
#pragma unroll 8
            for (int j = 0; j < 128; ++j) a += hid[j] * w2[j * 64 + F.tid];
            outp[F.tid] = (bf16)f2bf(a); if (n == NCMP - 1) outp[64 + F.tid] = 0; }
        __syncthreads();
    }
}

__device__ __forceinline__ void cmp_attn_phase(const Frame& F) {
    const bf16* P1 = (const bf16*)(F.ws + WS_P1); const float* KC = (const float*)(F.ws + WS_KC); const float* VC = (const float*)(F.ws + WS_VC);
    bf16* OC = (bf16*)(F.ws + WS_OCMP); unsigned* SELM = (unsigned*)(F.ws + WS_SELM); const float* rel = F.in[I_REL];
    LAS float* qs = (LAS float*)(F.lds + F.wave * 8192); LAS float* pl = qs + 512; LAS float* psum = pl + 1024;
    for (int it = F.gw; it < M * 2; it += F.NGW) {
        const int g = it & 1, row = it >> 1, b = row / S, t = row % S;
        const int nv = (t >= 31) ? ((t - 31) / 16 + 1) : 0;
#pragma unroll
        for (int i = 0; i < 8; ++i) qs[F.lane + 64 * i] = bf2f(P1[(size_t)row * P1_LD + C1_Q + g * 512 + F.lane + 64 * i]);
        WAVE_SYNC();
        float lg[2][8]; bool val[2];
#pragma unroll
        for (int kk = 0; kk < 2; ++kk) { const int n = F.lane + 64 * kk; val[kk] = n < nv; const int nn = val[kk] ? n : 0;
            const float* kr = KC + ((size_t)(b * NCMP + nn) * 2 + g) * 64; float a[8];
#pragma unroll
            for (int h = 0; h < 8; ++h) a[h] = 0.f;
#pragma unroll 1
            for (int j = 0; j < 16; ++j) { const f32x4 kv = *(const f32x4*)(kr + 4 * j);
#pragma unroll
                for (int h = 0; h < 8; ++h) a[h] += qs[h * 64 + 4 * j] * kv.x + qs[h * 64 + 4 * j + 1] * kv.y + qs[h * 64 + 4 * j + 2] * kv.z + qs[h * 64 + 4 * j + 3] * kv.w; }
            const int bk = rel_bucket(val[kk] ? (t - (16 * nn + 31)) : 0);
#pragma unroll
            for (int h = 0; h < 8; ++h) lg[kk][h] = val[kk] ? (a[h] * 0.125f + rel[bk * 16 + g * 8 + h]) : -1.0e30f; }
        float ps[2] = {0.f, 0.f};
#pragma unroll
        for (int h = 0; h < 8; ++h) { float m = wave_max(fmaxf(lg[0][h], lg[1][h]));
            float e0 = val[0] ? __expf(lg[0][h] - m) : 0.f, e1 = val[1] ? __expf(lg[1][h] - m) : 0.f;
            const float s = wave_sum(e0 + e1); const float inv = (nv > 0) ? 1.f / s : 0.f; e0 *= inv; e1 *= inv;
            pl[h * 128 + F.lane] = e0; pl[h * 128 + 64 + F.lane] = e1; ps[0] += e0; ps[1] += e1; }
        psum[F.lane] = ps[0]; psum[64 + F.lane] = ps[1];
        WAVE_SYNC();
        float scj = -3.0e38f; bool adm = false;
        if (F.lane < 32) { const int j = F.lane; float p = 0.f;
#pragma unroll
            for (int n = 4 * j - 1; n <= 4 * j + 3; ++n) if (n >= 0 && n < NCMP) p += psum[n];
            const int blkq = t >> 6; adm = (64 * j <= t); const bool forced = (j == 0) || (j == blkq) || (j == blkq - 1);
            scj = adm ? (p + (forced ? 1.0e6f : 0.f)) : -1.0e30f; }
        int rank = 0;
#pragma unroll 1
        for (int i = 0; i < 32; ++i) { const float si = __shfl(scj, i); rank += (si > scj || (si == scj && i < F.lane)) ? 1 : 0; }
        const unsigned long long sm = __ballot(F.lane < 32 && adm && rank < 8);
        if (F.lane == 0) SELM[(size_t)row * 2 + g] = (unsigned)sm;
        float o[8];
#pragma unroll
        for (int h = 0; h < 8; ++h) o[h] = 0.f;
        for (int n = 0; n < nv; ++n) { const float v = VC[((size_t)(b * NCMP + n) * 2 + g) * 64 + F.lane];
#pragma unroll
            for (int h = 0; h < 8; ++h) o[h] += pl[h * 128 + n] * v; }
#pragma unroll
        for (int h = 0; h < 8; ++h) OC[(size_t)row * D + (g * 8 + h) * 64 + F.lane] = (bf16)f2bf(o[h]);
        WAVE_SYNC();
    }
}

__device__ __forceinline__ void slc_attn_phase(const Frame& F) {
    const bf16* P1 = (const bf16*)(F.ws + WS_P1); const unsigned* SELM = (const unsigned*)(F.ws + WS_SELM); bf16* OS = (bf16*)(F.ws + WS_OSLC); const float* rel = F.in[I_REL];
    LAS float* qs = (LAS float*)(F.lds + F.wave * 4096); LAS float* pb = qs + 512;
    for (int it = F.gw; it < M * 2; it += F.NGW) {
        const int g = it & 1, row = it >> 1, b = row / S, t = row % S;
#pragma unroll
        for (int i = 0; i < 8; ++i) qs[F.lane + 64 * i] = bf2f(P1[(size_t)row * P1_LD + C1_Q + g * 512 + F.lane + 64 * i]);
        WAVE_SYNC();
        unsigned sel = SELM[(size_t)row * 2 + g];
        float m[8], l[8], acc[8];
#pragma unroll
        for (int h = 0; h < 8; ++h) { m[h] = -1.0e30f; l[h] = 0.f; acc[h] = 0.f; }
        while (sel) { const int jb = __ffs(sel) - 1; sel &= sel - 1u;
            const int kpos = 64 * jb + F.lane; const bool valid = kpos <= t;
            const bf16* kr = P1 + (size_t)(b * S + kpos) * P1_LD + C1_KS + g * 64; float a[8];
#pragma unroll
            for (int h = 0; h < 8; ++h) a[h] = 0.f;
#pragma unroll 1
            for (int j = 0; j < 8; ++j) { float kf[8]; ld8bf(kr + 8 * j, kf);
#pragma unroll
                for (int h = 0; h < 8; ++h)
#pragma unroll
                    for (int i = 0; i < 8; ++i) a[h] += qs[h * 64 + 8 * j + i] * kf[i]; }
            const int bk = rel_bucket(valid ? (t - kpos) : 0);
            float corr[8];
#pragma unroll
            for (int h = 0; h < 8; ++h) { const float lgt = valid ? (a[h] * 0.125f + rel[bk * 16 + g * 8 + h]) : -1.0e30f;
                const float bm = wave_max(lgt), mn = fmaxf(m[h], bm); corr[h] = __expf(m[h] - mn); const float p = valid ? __expf(lgt - mn) : 0.f;
                l[h] = l[h] * corr[h] + wave_sum(p); m[h] = mn; pb[h * 64 + F.lane] = p; }
            WAVE_SYNC();
            const bf16* vb = P1 + (size_t)(b * S + 64 * jb) * P1_LD + C1_VS + g * 64 + F.lane;
            float add[8];
#pragma unroll
            for (int h = 0; h < 8; ++h) add[h] = 0.f;
            for (int k = 0; k < 64; ++k) { const float v = bf2f(vb[(size_t)k * P1_LD]);
#pragma unroll
                for (int h = 0; h < 8; ++h) add[h] += pb[h * 64 + k] * v; }
#pragma unroll
            for (int h = 0; h < 8; ++h) acc[h] = acc[h] * corr[h] + add[h];
            WAVE_SYNC();
        }
#pragma unroll
        for (int h = 0; h < 8; ++h) OS[(size_t)row * D + (g * 8 + h) * 64 + F.lane] = (bf16)f2bf(acc[h] / l[h]);
    }
}

namespace fa {
typedef short bf16x8 __attribute__((ext_vector_type(8)));
typedef short bf16x4 __attribute__((ext_vector_type(4)));
typedef float f32x16 __attribute__((ext_vector_type(16)));
constexpr int VSTR = 68;
template <int HDK, int HDV> struct Geo { static constexpr int KSTR = HDK + 8, KBYTES = 64 * KSTR * 2, VBYTES = HDV * VSTR * 2, BUF = KBYTES + VBYTES; };
template <int HDK, int HDV, bool KV_SAME> struct Stage { v4u k[HDK / 64]; v4u v[KV_SAME ? 1 : HDV / 64]; };

template <int HDK, int HDV, bool KV_SAME, class P>
__device__ __forceinline__ void load_tile(Stage<HDK, HDV, KV_SAME>& st, const P& pol, int j, int tid) {
#pragma unroll
    for (int i = 0; i < HDK / 64; ++i) { const int c = tid + 512 * i, r = c / (HDK / 8), ch = c % (HDK / 8); st.k[i] = *(const v4u*)(pol.krow(j, r) + 8 * ch); }
    if (!KV_SAME) {
#pragma unroll
        for (int i = 0; i < HDV / 64; ++i) { const int c = tid + 512 * i, r = c / (HDV / 8), ch = c % (HDV / 8); st.v[i] = *(const v4u*)(pol.vrow(j, r) + 8 * ch); }
    }
}
template <int HDK, int HDV, bool KV_SAME>
__device__ __forceinline__ void store_tile(const Stage<HDK, HDV, KV_SAME>& st, LAS unsigned char* buf, int tid) {
    typedef Geo<HDK, HDV> G;
    LAS bf16* Ks = (LAS bf16*)buf; LAS bf16* Vt = (LAS bf16*)(buf + G::KBYTES);
#pragma unroll
    for (int i = 0; i < HDK / 64; ++i) { const int c = tid + 512 * i, r = c / (HDK / 8), ch = c % (HDK / 8); *(LAS v4u*)(Ks + r * G::KSTR + 8 * ch) = st.k[i]; }
#pragma unroll
    for (int i = 0; i < HDV / 64; ++i) { const int c = tid + 512 * i, r = c / (HDV / 8), ch = c % (HDV / 8); const v4u w = KV_SAME ? st.k[i] : st.v[i];
        LAS bf16* vp = Vt + (8 * ch) * VSTR + r;
        vp[0 * VSTR] = (bf16)(w.x & 0xffffu); vp[1 * VSTR] = (bf16)(w.x >> 16); vp[2 * VSTR] = (bf16)(w.y & 0xffffu); vp[3 * VSTR] = (bf16)(w.y >> 16);
        vp[4 * VSTR] = (bf16)(w.z & 0xffffu); vp[5 * VSTR] = (bf16)(w.z >> 16); vp[6 * VSTR] = (bf16)(w.w & 0xffffu); vp[7 * VSTR] = (bf16)(w.w >> 16); }
}
template <int HDK, int HDV, class P>
__device__ __forceinline__ void compute_tile(const LAS unsigned char* buf, const P& pol, int j, int lane, const bf16x8 (&qf)[HDK / 16], f32x16 (&o)[HDV / 32], float& m, float& l) {
    typedef Geo<HDK, HDV> G;
    const LAS bf16* Ks = (const LAS bf16*)buf; const LAS bf16* Vt = (const LAS bf16*)(buf + G::KBYTES);
    const int r = lane & 31, h = lane >> 5;
    f32x16 s[2];
#pragma unroll
    for (int kb = 0; kb < 2; ++kb) {
#pragma unroll
        for (int e = 0; e < 16; ++e) s[kb][e] = 0.f;
#pragma unroll
        for (int ks = 0; ks < HDK / 16; ++ks) { const bf16x8 a = *(const LAS bf16x8*)(Ks + (32 * kb + r) * G::KSTR + 16 * ks + 8 * h);
            s[kb] = __builtin_amdgcn_mfma_f32_32x32x16_bf16(a, qf[ks], s[kb], 0, 0, 0); }
    }
    pol.transform(j, s, lane);
    float mx = -INFINITY;
#pragma unroll
    for (int kb = 0; kb < 2; ++kb)
#pragma unroll
        for (int e = 0; e < 16; ++e) mx = fmaxf(mx, s[kb][e]);
    mx = fmaxf(mx, __shfl_xor(mx, 32));
    const float mn = fmaxf(m, mx), mref = (mn == -INFINITY) ? 0.f : mn;
    const float corr = __expf(m - mref);
    float rs = 0.f;
#pragma unroll
    for (int kb = 0; kb < 2; ++kb)
#pragma unroll
        for (int e = 0; e < 16; ++e) { s[kb][e] = __expf(s[kb][e] - mref); rs += s[kb][e]; }
    rs += __shfl_xor(rs, 32);
    l = l * corr + rs; m = mn;
#pragma unroll
    for (int blk = 0; blk < HDV / 32; ++blk)
#pragma unroll
        for (int e = 0; e < 16; ++e) o[blk][e] *= corr;
#pragma unroll
    for (int kb = 0; kb < 2; ++kb)
#pragma unroll
        for (int s2 = 0; s2 < 2; ++s2) {
            v4u pw; pw.x = pg8::cvt_pk_bf16(s[kb][8 * s2 + 0], s[kb][8 * s2 + 1]); pw.y = pg8::cvt_pk_bf16(s[kb][8 * s2 + 2], s[kb][8 * s2 + 3]);
            pw.z = pg8::cvt_pk_bf16(s[kb][8 * s2 + 4], s[kb][8 * s2 + 5]); pw.w = pg8::cvt_pk_bf16(s[kb][8 * s2 + 6], s[kb][8 * s2 + 7]);
            const bf16x8 pf = __builtin_bit_cast(bf16x8, pw);
#pragma unroll
            for (int blk = 0; blk < HDV / 32; ++blk) { const LAS bf16* vp = Vt + (32 * blk + r) * VSTR + 32 * kb + 16 * s2 + 4 * h;
                const bf16x4 lo = *(const LAS bf16x4*)vp, hi = *(const LAS bf16x4*)(vp + 8);
                const bf16x8 a = __builtin_shufflevector(lo, hi, 0, 1, 2, 3, 4, 5, 6, 7);
                o[blk] = __builtin_amdgcn_mfma_f32_32x32x16_bf16(a, pf, o[blk], 0, 0, 0); }
        }
}
template <int HDK, int HDV, bool KV_SAME, class P>
__device__ __forceinline__ void run(LAS unsigned char* lds, const P& pol, unsigned tmask, int tid, int lane, const bf16x8 (&qf)[HDK / 16], f32x16 (&o)[HDV / 32], float& m, float& l) {
    typedef Geo<HDK, HDV> G;
    if (tmask == 0u) return;
    Stage<HDK, HDV, KV_SAME> st;
    int j = __builtin_ctz(tmask); tmask &= tmask - 1u; int cur = 0;
    load_tile<HDK, HDV, KV_SAME>(st, pol, j, tid); store_tile<HDK, HDV, KV_SAME>(st, lds, tid);
    __syncthreads();
    for (;;) {
        const bool more = tmask != 0u; int jn = 0;
        if (more) { jn = __builtin_ctz(tmask); tmask &= tmask - 1u; load_tile<HDK, HDV, KV_SAME>(st, pol, jn, tid); }
        compute_tile<HDK, HDV>(lds + cur * G::BUF, pol, j, lane, qf, o, m, l);
        if (!more) break;
        store_tile<HDK, HDV, KV_SAME>(st, lds + (cur ^ 1) * G::BUF, tid);
        __syncthreads();
        cur ^= 1; j = jn;
    }
    __syncthreads();
}
}

__device__ __forceinline__ void build_bias_table(const Frame& F, LAS float* tab, int nheads, int relc0) {
    const float* rel = F.in[I_REL];
    for (int i = F.tid; i < nheads * 129; i += 512) { const int hh = i / 129, d = i % 129; tab[hh * 132 + d] = rel[rel_bucket(d) * 16 + relc0 + hh]; }
    __syncthreads();
}
struct BandPol {
    const bf16* kbase; const bf16* vbase; int ld; int tq, tq0, W; const LAS float* bl;
    __device__ __forceinline__ const bf16* krow(int j, int r) const { return kbase + (size_t)(64 * j + r) * ld; }
    __device__ __forceinline__ const bf16* vrow(int j, int r) const { return vbase + (size_t)(64 * j + r) * ld; }
    __device__ __forceinline__ void transform(int j, fa::f32x16 (&s)[2], int lane) const {
        const int k0 = 64 * j, h = lane >> 5;
        if (tq0 - (k0 + 63) >= 128 && (tq0 + 31) - k0 < W) {
            const float b31 = bl[128];
#pragma unroll
            for (int kb = 0; kb < 2; ++kb)
#pragma unroll
                for (int e = 0; e < 16; ++e) s[kb][e] = s[kb][e] * 0.125f + b31;
        } else {
#pragma unroll
            for (int kb = 0; kb < 2; ++kb)
#pragma unroll
                for (int e = 0; e < 16; ++e) { const int key = k0 + 32 * kb + 8 * (e >> 2) + 4 * h + (e & 3); const int dist = tq - key;
                    const int di = dist < 0 ? 0 : (dist > 128 ? 128 : dist);
                    const float v = s[kb][e] * 0.125f + bl[di];
                    s[kb][e] = (dist >= 0 && dist < W) ? v : -INFINITY; }
        }
    }
};
__device__ __forceinline__ void win_phase_mfma(const Frame& F) {
    bf16* P1 = (bf16*)(F.ws + WS_P1); const bf16* OC = (const bf16*)(F.ws + WS_OCMP); const bf16* OS = (const bf16*)(F.ws + WS_OSLC);
    LAS float* tab = (LAS float*)(F.lds + 36864);
    build_bias_table(F, tab, 16, 0);
    const int h = F.lane >> 5;
    for (int u = blockIdx.x; u < NB * 2 * 64; u += F.G) {
        const int b = u >> 7, g = (u >> 6) & 1, qt = u & 63, tq0 = 32 * qt, head = g * 8 + F.wave, tq = tq0 + (F.lane & 31);
        const size_t row = (size_t)b * S + tq;
        fa::bf16x8 qf[4];
#pragma unroll
        for (int ks = 0; ks < 4; ++ks) qf[ks] = *(const fa::bf16x8*)(P1 + row * P1_LD + C1_Q + head * 64 + 16 * ks + 8 * h);
        fa::f32x16 o[2];
#pragma unroll
        for (int blk = 0; blk < 2; ++blk)
#pragma unroll
            for (int e = 0; e < 16; ++e) o[blk][e] = 0.f;
        float m = -INFINITY, l = 0.f;
        const int jlo = (tq0 - 511 > 0 ? tq0 - 511 : 0) >> 6, jhi = (tq0 + 31) >> 6;
        const unsigned tmask = (jhi >= 31 ? 0xffffffffu : ((1u << (jhi + 1)) - 1u)) & ~((1u << jlo) - 1u);
        BandPol pol{P1 + (size_t)b * S * P1_LD + C1_KW + g * 64, P1 + (size_t)b * S * P1_LD + C1_VW + g * 64, P1_LD, tq, tq0, 512, tab + head * 132};
        fa::run<64, 64, false>(F.lds, pol, tmask, F.tid, F.lane, qf, o, m, l);
        const float inv = 1.f / l;
        const bf16* gr = P1 + row * P1_LD + C1_GL + head * 3;
        const float g0 = 1.f / (1.f + __expf(-bf2f(gr[0]))), g1 = 1.f / (1.f + __expf(-bf2f(gr[1]))), g2 = 1.f / (1.f + __expf(-bf2f(gr[2])));
#pragma unroll
        for (int blk = 0; blk < 2; ++blk)
#pragma unroll
            for (int jj = 0; jj < 4; ++jj) { const int d0 = 32 * blk + 8 * jj + 4 * h;
                const v2u cw = *(const v2u*)(OC + row * D + head * 64 + d0), sw = *(const v2u*)(OS + row * D + head * 64 + d0);
                const float r0 = g0 * bflo(cw.x) + g1 * bflo(sw.x) + g2 * o[blk][4 * jj + 0] * inv, r1 = g0 * bfhi(cw.x) + g1 * bfhi(sw.x) + g2 * o[blk][4 * jj + 1] * inv;
                const float r2 = g0 * bflo(cw.y) + g1 * bflo(sw.y) + g2 * o[blk][4 * jj + 2] * inv, r3 = g0 * bfhi(cw.y) + g1 * bfhi(sw.y) + g2 * o[blk][4 * jj + 3] * inv;
                v2u ow; ow.x = pk2(r0, r1); ow.y = pk2(r2, r3);
                *(v2u*)(P1 + row * P1_LD + C1_Q + head * 64 + d0) = ow; }
    }
}
__device__ __forceinline__ void swa_phase_mfma(const Frame& F) {
    bf16* P0 = (bf16*)(F.ws + WS_P0); const float* sinks = F.in[I_EV_SINK];
    LAS float* tab = (LAS float*)(F.lds + 36864);
    build_bias_table(F, tab, 8, 8);
    const int h = F.lane >> 5;
    for (int u = blockIdx.x; u < NB * 2 * 32; u += F.G) {
        const int b = u >> 6, kvh = (u >> 5) & 1, t0 = 64 * (u & 31), head = kvh * 4 + (F.wave & 3), tq0 = t0 + 32 * (F.wave >> 2), tq = tq0 + (F.lane & 31);
        const size_t row = (size_t)b * S + tq;
        fa::bf16x8 qf[4];
#pragma unroll
        for (int ks = 0; ks < 4; ++ks) qf[ks] = *(const fa::bf16x8*)(P0 + row * P0_LD + C0_QB + head * 64 + 16 * ks + 8 * h);
        fa::f32x16 o[2];
#pragma unroll
        for (int blk = 0; blk < 2; ++blk)
#pragma unroll
            for (int e = 0; e < 16; ++e) o[blk][e] = 0.f;
        float m = sinks[head], l = 1.f;
        const int jlo = (t0 - 127 > 0 ? t0 - 127 : 0) >> 6, jhi = t0 >> 6;
        const unsigned tmask = (jhi >= 31 ? 0xffffffffu : ((1u << (jhi + 1)) - 1u)) & ~((1u << jlo) - 1u);
        BandPol pol{P0 + (size_t)b * S * P0_LD + C0_KB + kvh * 64, P0 + (size_t)b * S * P0_LD + C0_VB + kvh * 64, P0_LD, tq, tq0, 128, tab + head * 132};
        fa::run<64, 64, false>(F.lds, pol, tmask, F.tid, F.lane, qf, o, m, l);
        const float inv = 1.f / l;
#pragma unroll
        for (int blk = 0; blk < 2; ++blk)
#pragma unroll
            for (int jj = 0; jj < 4; ++jj) { const int d0 = 32 * blk + 8 * jj + 4 * h;
                v2u ow; ow.x = pk2(o[blk][4 * jj + 0] * inv, o[blk][4 * jj + 1] * inv); ow.y = pk2(o[blk][4 * jj + 2] * inv, o[blk][4 * jj + 3] * inv);
                *(v2u*)(P0 + row * P0_LD + C0_QB + head * 64 + d0) = ow; }
    }
}

struct XaPol {
    const bf16* kbase;
    __device__ __forceinline__ const bf16* krow(int j, int r) const { return kbase + (size_t)(64 * j + r) * 1024; }
    __device__ __forceinline__ const bf16* vrow(int j, int r) const { return kbase + (size_t)(64 * j + r) * 1024 + 512; }
    __device__ __forceinline__ void transform(int, fa::f32x16 (&s)[2], int) const {
#pragma unroll
        for (int kb = 0; kb < 2; ++kb)
#pragma unroll
            for (int e = 0; e < 16; ++e) s[kb][e] *= 0.08838834764831845f;
    }
};
__device__ __forceinline__ void xattn_phase_mfma(const Frame& F, const bf16* Q, const bf16* KV, bf16* O) {
    const int h = F.lane >> 5;
    for (int u = blockIdx.x; u < NB * 4 * 8; u += F.G) {
        const int b = u >> 5, head = (u >> 3) & 3, qt = u & 7, tq = 256 * qt + 32 * F.wave + (F.lane & 31);
        const size_t row = (size_t)b * S + tq;
        fa::bf16x8 qf[8];
#pragma unroll
        for (int ks = 0; ks < 8; ++ks) qf[ks] = *(const fa::bf16x8*)(Q + row * 512 + head * 128 + 16 * ks + 8 * h);
        fa::f32x16 o[4];
#pragma unroll
        for (int blk = 0; blk < 4; ++blk)
#pragma unroll
            for (int e = 0; e < 16; ++e) o[blk][e] = 0.f;
        float m = -INFINITY, l = 0.f;
        XaPol pol{KV + (size_t)b * MEML * 1024 + head * 128};
        fa::run<128, 128, false>(F.lds, pol, 0xFu, F.tid, F.lane, qf, o, m, l);
        const float inv = 1.f / l;
#pragma unroll
        for (int blk = 0; blk < 4; ++blk)
#pragma unroll
            for (int jj = 0; jj < 4; ++jj) { const int d0 = 32 * blk + 8 * jj + 4 * h;
                v2u ow; ow.x = pk2(o[blk][4 * jj + 0] * inv, o[blk][4 * jj + 1] * inv); ow.y = pk2(o[blk][4 * jj + 2] * inv, o[blk][4 * jj + 3] * inv);
                *(v2u*)(O + row * 512 + head * 128 + d0) = ow; }
    }
}
struct DsaPol {
    const bf16* cbase; const unsigned* mrow; int tq; const LAS float* bl;
    __device__ __forceinline__ const bf16* krow(int j, int r) const { return cbase + (size_t)(64 * j + r) * 128; }
    __device__ __forceinline__ const bf16* vrow(int j, int r) const { return krow(j, r); }
    __device__ __forceinline__ void transform(int j, fa::f32x16 (&s)[2], int lane) const {
        const int k0 = 64 * j, h = lane >> 5; const v2u mw = *(const v2u*)(mrow + 2 * j);
#pragma unroll
        for (int kb = 0; kb < 2; ++kb) { const unsigned w = kb ? mw.y : mw.x;
#pragma unroll
            for (int e = 0; e < 16; ++e) { const int kin = 8 * (e >> 2) + 4 * h + (e & 3); const int dist = tq - (k0 + 32 * kb + kin);
                const int di = dist < 0 ? 0 : (dist > 128 ? 128 : dist);
                const float v = s[kb][e] * 0.125f + bl[di];
                s[kb][e] = ((w >> kin) & 1u) ? v : -INFINITY; } }
    }
};
__device__ __forceinline__ void dsa_phase_mfma(const Frame& F) {
    bf16* P0 = (bf16*)(F.ws + WS_P0); const bf16* CN = (const bf16*)(F.ws + WS_CN); const unsigned* MASK = (const unsigned*)(F.ws + WS_MASK);
    LAS float* tab = (LAS float*)(F.lds + 73728);
    build_bias_table(F, tab, 8, 0);
    const int h = F.lane >> 5;
    for (int u = blockIdx.x; u < NB * 64; u += F.G) {
        const int rr = u / F.G, c = u % F.G; const int qt = (rr & 1) ? 63 - (c & 63) : (c & 63), b = (rr * (F.G >> 6) + (c >> 6)) % NB;
        const int tq0 = 32 * qt, tq = tq0 + (F.lane & 31), head = F.wave;
        const size_t row = (size_t)b * S + tq;
        fa::bf16x8 qf[8];
#pragma unroll
        for (int ks = 0; ks < 8; ++ks) qf[ks] = *(const fa::bf16x8*)(P0 + row * P0_LD + C0_QLAT + head * 128 + 16 * ks + 8 * h);
        fa::f32x16 o[4];
#pragma unroll
        for (int blk = 0; blk < 4; ++blk)
#pragma unroll
            for (int e = 0; e < 16; ++e) o[blk][e] = 0.f;
        float m = -INFINITY, l = 0.f;
        const int jhi = (tq0 + 31) >> 6; const unsigned tmask = jhi >= 31 ? 0xffffffffu : ((1u << (jhi + 1)) - 1u);
        DsaPol pol{CN + (size_t)b * S * 128, MASK + row * 64, tq, tab + head * 132};
        fa::run<128, 128, true>(F.lds, pol, tmask, F.tid, F.lane, qf, o, m, l);
        const float inv = 1.f / l;
#pragma unroll
        for (int blk = 0; blk < 4; ++blk)
#pragma unroll
            for (int jj = 0; jj < 4; ++jj) { const int d0 = 32 * blk + 8 * jj + 4 * h;
                v2u ow; ow.x = pk2(o[blk][4 * jj + 0] * inv, o[blk][4 * jj + 1] * inv); ow.y = pk2(o[blk][4 * jj + 2] * inv, o[blk][4 * jj + 3] * inv);
                *(v2u*)(P0 + row * P0_LD + C0_QLAT + head * 128 + d0) = ow; }
    }
}
struct SlcPol {
    const bf16* kbase; const bf16* vbase; unsigned sel; int tq; const LAS float* bl;
    __device__ __forceinline__ const bf16* krow(int j, int r) const { return kbase + (size_t)(64 * j + r) * P1_LD; }
    __device__ __forceinline__ const bf16* vrow(int j, int r) const { return vbase + (size_t)(64 * j + r) * P1_LD; }
    __device__ __forceinline__ void transform(int j, fa::f32x16 (&s)[2], int lane) const {
        const int k0 = 64 * j, h = lane >> 5; const bool on = (sel >> j) & 1u;
#pragma unroll
        for (int kb = 0; kb < 2; ++kb)
#pragma unroll
            for (int e = 0; e < 16; ++e) { const int dist = tq - (k0 + 32 * kb + 8 * (e >> 2) + 4 * h + (e & 3));
                const int di = dist < 0 ? 0 : (dist > 128 ? 128 : dist);
                const float v = s[kb][e] * 0.125f + bl[di];
                s[kb][e] = (on && dist >= 0) ? v : -INFINITY; }
    }
};
__device__ __forceinline__ void slc_phase_mfma(const Frame& F) {
    const bf16* P1 = (const bf16*)(F.ws + WS_P1); const unsigned* SELM = (const unsigned*)(F.ws + WS_SELM); bf16* OS = (bf16*)(F.ws + WS_OSLC);
    LAS float* tab = (LAS float*)(F.lds + 36864);
    build_bias_table(F, tab, 16, 0);
    const int h = F.lane >> 5;
    for (int u = blockIdx.x; u < NB * 2 * 64; u += F.G) {
        const int rr = u / F.G, c = u % F.G; const int qt = (rr & 1) ? 63 - (c & 63) : (c & 63), bg = (rr * (F.G >> 6) + (c >> 6)) % (NB * 2), b = bg >> 1, g = bg & 1;
        const int tq0 = 32 * qt, tq = tq0 + (F.lane & 31), head = g * 8 + F.wave;
        const size_t row = (size_t)b * S + tq;
        fa::bf16x8 qf[4];
#pragma unroll
        for (int ks = 0; ks < 4; ++ks) qf[ks] = *(const fa::bf16x8*)(P1 + row * P1_LD + C1_Q + head * 64 + 16 * ks + 8 * h);
        fa::f32x16 o[2];
#pragma unroll
        for (int blk = 0; blk < 2; ++blk)
#pragma unroll
            for (int e = 0; e < 16; ++e) o[blk][e] = 0.f;
        float m = -INFINITY, l = 0.f;
        const unsigned sel = SELM[row * 2 + g]; unsigned tm = sel;
#pragma unroll
        for (int of = 1; of < 32; of <<= 1) tm |= (unsigned)__shfl_xor((int)tm, of);
        tm = (unsigned)__builtin_amdgcn_readfirstlane((int)tm);
        SlcPol pol{P1 + (size_t)b * S * P1_LD + C1_KS + g * 64, P1 + (size_t)b * S * P1_LD + C1_VS + g * 64, sel, tq, tab + head * 132};
        fa::run<64, 64, false>(F.lds, pol, tm, F.tid, F.lane, qf, o, m, l);
        const float inv = 1.f / l;
#pragma unroll
        for (int blk = 0; blk < 2; ++blk)
#pragma unroll
            for (int jj = 0; jj < 4; ++jj) { const int d0 = 32 * blk + 8 * jj + 4 * h;
                v2u ow; ow.x = pk2(o[blk][4 * jj + 0] * inv, o[blk][4 * jj + 1] * inv); ow.y = pk2(o[blk][4 * jj + 2] * inv, o[blk][4 * jj + 3] * inv);
                *(v2u*)(OS + row * D + head * 64 + d0) = ow; }
    }
}

__device__ __forceinline__ void idx_phase_mfma(const Frame& F) {
    const bf16* P0 = (const bf16*)(F.ws + WS_P0); unsigned* MASK = (unsigned*)(F.ws + WS_MASK);
    LAS float* sc = (LAS float*)F.lds;
    const int r = F.lane & 31, hh = F.lane >> 5;
    const int head_r = (r & 3) + 4 * ((r >> 3) & 1), ql_r = 2 * (r >> 4) + ((r >> 2) & 1);
    for (int item = blockIdx.x; item < NB * (S / 8); item += F.G) {
        const int b = item / (S / 8), t0 = (item % (S / 8)) * 8;
        const int rb = F.wave & 1, kq = F.wave >> 1;
        fa::bf16x8 qa[4];
        { const bf16* qp = P0 + (size_t)(b * S + t0 + 4 * rb + ql_r) * P0_LD + C0_QI + head_r * 64 + 8 * hh;
#pragma unroll
          for (int ks = 0; ks < 4; ++ks) qa[ks] = *(const fa::bf16x8*)(qp + 16 * ks); }
        float wv[2][8];
#pragma unroll
        for (int qq = 0; qq < 2; ++qq) { ld8bf(P0 + (size_t)(b * S + t0 + 4 * rb + 2 * qq + hh) * P0_LD + C0_WI, wv[qq]);
#pragma unroll
            for (int e = 0; e < 8; ++e) wv[qq][e] *= (0.35355339059f * 0.125f); }
        const int nkb = (t0 + 8 + 31) >> 5;
        for (int kb = kq; kb < nkb; kb += 4) {
            const bf16* kp = P0 + (size_t)(b * S + 32 * kb + r) * P0_LD + C0_KI + 8 * hh;
            fa::f32x16 c;
#pragma unroll
            for (int e = 0; e < 16; ++e) c[e] = 0.f;
#pragma unroll
            for (int ks = 0; ks < 4; ++ks) { const fa::bf16x8 kf = *(const fa::bf16x8*)(kp + 16 * ks); c = __builtin_amdgcn_mfma_f32_32x32x16_bf16(qa[ks], kf, c, 0, 0, 0); }
            float s0 = 0.f, s1 = 0.f;
#pragma unroll
            for (int e = 0; e < 8; ++e) { s0 += wv[0][e] * fmaxf(c[e], 0.f); s1 += wv[1][e] * fmaxf(c[8 + e], 0.f); }
            sc[(4 * rb + hh) * 2048 + 32 * kb + r] = s0; sc[(4 * rb + 2 + hh) * 2048 + 32 * kb + r] = s1;
        }
        __syncthreads();
        {
            const int q = F.wave, t = t0 + q, n = t + 1, row = b * S + t; unsigned myword = 0u;
            if (n <= 256) { const int cb = n - 32 * F.lane; myword = cb >= 32 ? 0xffffffffu : (cb <= 0 ? 0u : ((1u << cb) - 1u)); }
            else {
                LAS unsigned* uk = (LAS unsigned*)(sc + q * 2048);
#pragma unroll 4
                for (int i = 0; i < 32; ++i) { const int s = F.lane + 64 * i; const unsigned k = (s < n) ? fkey(sc[q * 2048 + s]) : 0u; uk[s] = k; }
                LDS_WAIT();
                unsigned prefix = 0u;
#pragma unroll 1
                for (int bit = 31; bit >= 0; --bit) { const unsigned cand = prefix | (1u << bit); int c = 0;
#pragma unroll 8
                    for (int i = 0; i < 32; ++i) c += (uk[F.lane + 64 * i] >= cand) ? 1 : 0;
#pragma unroll
                    for (int o = 1; o < 64; o <<= 1) c += __shfl_xor(c, o);
                    if (c >= 256) prefix = cand; }
                int cgt = 0;
#pragma unroll 8
                for (int i = 0; i < 32; ++i) cgt += (uk[F.lane + 64 * i] > prefix) ? 1 : 0;
#pragma unroll
                for (int o = 1; o < 64; o <<= 1) cgt += __shfl_xor(cgt, o);
                const int need = 256 - cgt; int run = 0;
#pragma unroll 1
                for (int i = 0; i < 32; ++i) { const unsigned u = uk[F.lane + 64 * i]; const bool eq = (u == prefix); const unsigned long long em = __ballot(eq); const int rank = run + __popcll(em & ((1ull << F.lane) - 1ull));
                    const bool sel = (u > prefix) || (eq && rank < need); run += __popcll(em);
                    const unsigned long long sm = __ballot(sel);
                    if (F.lane == 2 * i) myword = (unsigned)sm; if (F.lane == 2 * i + 1) myword = (unsigned)(sm >> 32); }
            }
            MASK[(size_t)row * 64 + F.lane] = myword;
        }
        __syncthreads();
    }
}
__device__ __forceinline__ void cmp_phase_mfma(const Frame& F) {
    typedef fa::Geo<64, 64> G;
    const bf16* P1 = (const bf16*)(F.ws + WS_P1); const bf16* KC = (const bf16*)(F.ws + WS_KC); const bf16* VC = (const bf16*)(F.ws + WS_VC);
    bf16* OC = (bf16*)(F.ws + WS_OCMP); unsigned* SELM = (unsigned*)(F.ws + WS_SELM);
    LAS float* tab = (LAS float*)(F.lds + 36864); LAS float* part = (LAS float*)(F.lds + 49152);
    build_bias_table(F, tab, 16, 0);
    const int r = F.lane & 31, h = F.lane >> 5;
    for (int u = blockIdx.x; u < NB * 2 * 64; u += F.G) {
        const int b = u >> 7, g = (u >> 6) & 1, qt = u & 63, tq0 = 32 * qt, head = g * 8 + F.wave, tq = tq0 + r;
        const size_t row = (size_t)b * S + tq;
        const int nv = (tq >= 31) ? ((tq - 31) / 16 + 1) : 0;
        const int ntile = (tq0 >= 1024) ? 2 : 1;
        {
            struct CPol { const bf16* kb; const bf16* vb; __device__ __forceinline__ const bf16* krow(int j, int rr) const { return kb + (size_t)(64 * j + rr) * 64; } __device__ __forceinline__ const bf16* vrow(int j, int rr) const { return vb + (size_t)(64 * j + rr) * 64; } };
            CPol cp{KC + (size_t)(b * 2 + g) * 128 * 64, VC + (size_t)(b * 2 + g) * 128 * 64};
            for (int t = 0; t < ntile; ++t) { fa::Stage<64, 64, false> st; fa::load_tile<64, 64, false>(st, cp, t, F.tid); fa::store_tile<64, 64, false>(st, F.lds + t * G::BUF, F.tid); }
        }
        fa::bf16x8 qf[4];
#pragma unroll
        for (int ks = 0; ks < 4; ++ks) qf[ks] = *(const fa::bf16x8*)(P1 + row * P1_LD + C1_Q + head * 64 + 16 * ks + 8 * h);
        __syncthreads();
        fa::f32x16 s[2][2];
        const LAS float* bl = tab + head * 132;
#pragma unroll
        for (int t = 0; t < 2; ++t) {
            const LAS bf16* Ks = (const LAS bf16*)(F.lds + t * G::BUF);
#pragma unroll
            for (int kb = 0; kb < 2; ++kb) {
#pragma unroll
                for (int e = 0; e < 16; ++e) s[t][kb][e] = 0.f;
                if (t < ntile) {
#pragma unroll
                    for (int ks = 0; ks < 4; ++ks) { const fa::bf16x8 a = *(const LAS fa::bf16x8*)(Ks + (32 * kb + r) * G::KSTR + 16 * ks + 8 * h); s[t][kb] = __builtin_amdgcn_mfma_f32_32x32x16_bf16(a, qf[ks], s[t][kb], 0, 0, 0); }
                }
#pragma unroll
                for (int e = 0; e < 16; ++e) { const int n = 64 * t + 32 * kb + 8 * (e >> 2) + 4 * h + (e & 3); const int dist = tq - (16 * n + 31); const int di = dist < 0 ? 0 : (dist > 128 ? 128 : dist);
                    s[t][kb][e] = (n < nv) ? (s[t][kb][e] * 0.125f + bl[di]) : -INFINITY; }
            }
        }
        float mx = -INFINITY;
#pragma unroll
        for (int t = 0; t < 2; ++t)
#pragma unroll
            for (int kb = 0; kb < 2; ++kb)
#pragma unroll
                for (int e = 0; e < 16; ++e) mx = fmaxf(mx, s[t][kb][e]);
        mx = fmaxf(mx, __shfl_xor(mx, 32));
        const float mref = (mx == -INFINITY) ? 0.f : mx; float rs = 0.f;
#pragma unroll
        for (int t = 0; t < 2; ++t)
#pragma unroll
            for (int kb = 0; kb < 2; ++kb)
#pragma unroll
                for (int e = 0; e < 16; ++e) { s[t][kb][e] = __expf(s[t][kb][e] - mref); rs += s[t][kb][e]; }
        rs += __shfl_xor(rs, 32);
        const float inv = (nv > 0) ? 1.f / rs : 0.f;
#pragma unroll
        for (int t = 0; t < 2; ++t)
#pragma unroll
            for (int kb = 0; kb < 2; ++kb)
#pragma unroll
                for (int e = 0; e < 16; ++e) s[t][kb][e] *= inv;
        {
            float sum4[16], p3[16];
#pragma unroll
            for (int t = 0; t < 2; ++t)
#pragma unroll
                for (int kb = 0; kb < 2; ++kb)
#pragma unroll
                    for (int jj = 0; jj < 4; ++jj) { const int G4 = 8 * t + 4 * kb + jj; sum4[G4] = (s[t][kb][4 * jj] + s[t][kb][4 * jj + 1]) + (s[t][kb][4 * jj + 2] + s[t][kb][4 * jj + 3]); p3[G4] = s[t][kb][4 * jj + 3]; }
            LAS float* pw = part + (F.wave * 32 + r) * 32;
#pragma unroll
            for (int G4 = 0; G4 < 16; ++G4) { const float pr = __shfl_xor(p3[G4], 32);
                const float prm1 = (G4 > 0) ? __shfl_xor(p3[G4 > 0 ? G4 - 1 : 0], 32) : 0.f;
                const float v = sum4[G4] + (h ? pr : prm1);
                pw[2 * G4 + h] = v; }
        }
        fa::f32x16 o[2];
#pragma unroll
        for (int blk = 0; blk < 2; ++blk)
#pragma unroll
            for (int e = 0; e < 16; ++e) o[blk][e] = 0.f;
#pragma unroll
        for (int t = 0; t < 2; ++t) {
            if (t < ntile) {
                const LAS bf16* Vt = (const LAS bf16*)(F.lds + t * G::BUF + G::KBYTES);
#pragma unroll
                for (int kb = 0; kb < 2; ++kb)
#pragma unroll
                    for (int s2 = 0; s2 < 2; ++s2) {
                        v4u pw4; pw4.x = pg8::cvt_pk_bf16(s[t][kb][8 * s2 + 0], s[t][kb][8 * s2 + 1]); pw4.y = pg8::cvt_pk_bf16(s[t][kb][8 * s2 + 2], s[t][kb][8 * s2 + 3]);
                        pw4.z = pg8::cvt_pk_bf16(s[t][kb][8 * s2 + 4], s[t][kb][8 * s2 + 5]); pw4.w = pg8::cvt_pk_bf16(s[t][kb][8 * s2 + 6], s[t][kb][8 * s2 + 7]);
                        const fa::bf16x8 pf = __builtin_bit_cast(fa::bf16x8, pw4);
#pragma unroll
                        for (int blk = 0; blk < 2; ++blk) { const LAS bf16* vp = Vt + (32 * blk + r) * fa::VSTR + 32 * kb + 16 * s2 + 4 * h;
                            const fa::bf16x4 lo = *(const LAS fa::bf16x4*)vp, hi = *(const LAS fa::bf16x4*)(vp + 8);
                            o[blk] = __builtin_amdgcn_mfma_f32_32x32x16_bf16(__builtin_shufflevector(lo, hi, 0, 1, 2, 3, 4, 5, 6, 7), pf, o[blk], 0, 0, 0); }
                    }
            }
        }
#pragma unroll
        for (int blk = 0; blk < 2; ++blk)
#pragma unroll
            for (int jj = 0; jj < 4; ++jj) { const int d0 = 32 * blk + 8 * jj + 4 * h;
                v2u ow; ow.x = pk2(o[blk][4 * jj + 0], o[blk][4 * jj + 1]); ow.y = pk2(o[blk][4 * jj + 2], o[blk][4 * jj + 3]);
                *(v2u*)(OC + row * D + head * 64 + d0) = ow; }
        __syncthreads();
#pragma unroll 1
        for (int it = 0; it < 2; ++it) {
            const int ql = 4 * F.wave + 2 * it + h, j = r, t = tq0 + ql; float p = 0.f;
#pragma unroll
            for (int w8 = 0; w8 < 8; ++w8) p += part[(w8 * 32 + ql) * 32 + j];
            const int blkq = t >> 6; const bool adm = (64 * j <= t); const bool forced = (j == 0) || (j == blkq) || (j == blkq - 1);
            const float scj = adm ? (p + (forced ? 1.0e6f : 0.f)) : -1.0e30f;
            int rank = 0;
#pragma unroll 1
            for (int i = 0; i < 32; ++i) { const float si = __shfl(scj, (F.lane & 32) | i); rank += (si > scj || (si == scj && i < j)) ? 1 : 0; }
            const unsigned long long sm = __ballot(adm && rank < 8);
            if (r == 0) SELM[((size_t)b * S + t) * 2 + g] = h ? (unsigned)(sm >> 32) : (unsigned)sm;
        }
        __syncthreads();
    }
}

constexpr int NPHASE = 34;
__global__ void __launch_bounds__(NWAVES * 64, 2) skel_fwd(Args args) {
    extern __shared__ __attribute__((aligned(16))) unsigned char lds[];
    Frame F;
    F.lds = (LAS unsigned char*)lds; F.ws = args.ws; F.acc = args.out; F.in = args.in;
    F.tid = threadIdx.x; F.lane = F.tid & 63; F.wave = __builtin_amdgcn_readfirstlane(F.tid >> 6);
    F.G = gridDim.x; F.gw = blockIdx.x * NWAVES + F.wave; F.NGW = F.G * NWAVES;
    volatile LAS unsigned* MISC = (volatile LAS unsigned*)(F.lds + MISC_OFF);
    for (int u = F.tid; u < (LDS_BYTES - LDSCTL_OFF) / 4; u += NWAVES * 64) ((LAS unsigned*)(F.lds + LDSCTL_OFF))[u] = 0u;
    __syncthreads();
    unsigned* ctl = (unsigned*)(args.ws + WS_CTL);
    XcdBarrier bar; bar.bar = ctl + CW_BAR; bar.x = 0; bar.st = nullptr;
    const int lo = args.ph_lo, hi = args.ph_hi;
    if (hi - lo > 1) {
        bar = xcd_barrier_post(ctl + CW_BAR, MISC + 8);
        if (threadIdx.x == 0) { unsigned nloc, nx; xcd_barrier_complete(ctl + CW_BAR, bar.x, nloc, nx); MISC[8] = nloc; MISC[9] = nx; }
        __syncthreads();
    }
#ifndef PH_LO
#define PH_LO 0
#define PH_HI 99
#endif
#define IN(k) ((k) >= PH_LO && (k) < PH_HI && lo <= (k) && (k) < hi && fresh(F))
#define SEAM(k) do { if (IN(k) && IN((k) + 1)) xcd_barrier(bar); } while (0)
    unsigned char* ws = args.ws;
    const int bx = blockIdx.x;

    if (IN(0)) { prologue(F); } SEAM(0);
    if (IN(1)) {
        { pg8::StaticSched<256 * 2048, 256 * 2048> Sd{(const char*)(ws + WS_HB), (const char*)(ws + W_IN0), M / 256, P0_LD / 256, F.G, bx, F.wave};
          pg8::EpiBf16 E{(bf16*)(ws + WS_P0), P0_LD}; pg8::gemm_phase<1024, 2048, 2048>(F.lds, Sd, E); }
        for (int i = 0; i < 2; ++i) {
          pg8::StaticSched<256 * 2048, 256 * 2048> Sd{(const char*)(ws + WS_MEMB), (const char*)(ws + W_XKV + (size_t)i * 1024 * 1024 * 2), MMEM / 256, 4, F.G, (bx + 128 * (i + 1)) % F.G, F.wave};
          pg8::EpiBf16 E{(bf16*)(ws + WS_XKV + (size_t)i * MMEM * 1024 * 2), 1024}; pg8::gemm_phase<1024, 2048, 2048>(F.lds, Sd, E); }
    } SEAM(1);
    if (IN(2)) { cn_phase(F); idx_phase_mfma(F); swa_phase_mfma(F); } SEAM(2);
    if (IN(3)) { dsa_phase_mfma(F); } SEAM(3);
    if (IN(4)) { pg8::StaticSched<256 * P0_LD * 2, 256 * 1536 * 2> Sd{(const char*)(ws + WS_P0), (const char*)(ws + W_OUT0), M / 256, 4, F.G, bx, F.wave};
                 pg8::EpiAcc E{F.acc, D}; pg8::gemm_phase<1536, P0_LD * 2, 1536 * 2>(F.lds, Sd, E); } SEAM(4);
    if (IN(5)) { ln_phase<0>(F, 0); } SEAM(5);
    if (IN(6)) { pg8::StaticSched<256 * 2048, 256 * 2048> Sd{(const char*)(ws + WS_HB), (const char*)(ws + W_XQ), M / 256, 2, F.G, bx, F.wave};
                 pg8::EpiBf16 E{(bf16*)(ws + WS_QX0), 512}; pg8::gemm_phase<1024, 2048, 2048>(F.lds, Sd, E); } SEAM(6);
    if (IN(7)) { xattn_phase_mfma(F, (const bf16*)(ws + WS_QX0), (const bf16*)(ws + WS_XKV), (bf16*)(ws + WS_OX0)); } SEAM(7);
    if (IN(8)) { pg8::StaticSched<256 * 1024, 256 * 1024> Sd{(const char*)(ws + WS_OX0), (const char*)(ws + W_XO), M / 256, 4, F.G, bx, F.wave};
                 pg8::EpiAcc E{F.acc, D}; pg8::gemm_phase<512, 1024, 1024>(F.lds, Sd, E); } SEAM(8);
    if (IN(9)) { ln_phase<0>(F, 1); } SEAM(9);
    if (IN(10)) { pg8::StaticSched<256 * 2048, 256 * 2048> Sd{(const char*)(ws + WS_HB), (const char*)(ws + W_FGU), M / 256, 2 * DFF / 256, F.G, bx, F.wave};
                  pg8::EpiSwiglu E{(bf16*)(ws + WS_HID), DFF, 0}; pg8::gemm_phase<1024, 2048, 2048>(F.lds, Sd, E); } SEAM(10);
    if (IN(11)) { pg8::StaticSched<256 * DFF * 2, 256 * DFF * 2> Sd{(const char*)(ws + WS_HID), (const char*)(ws + W_FD), M / 256, 4, F.G, bx, F.wave};
                  pg8::EpiAcc E{F.acc, D}; pg8::gemm_phase<DFF, DFF * 2, DFF * 2>(F.lds, Sd, E); } SEAM(11);
    if (IN(12)) { ln_phase<0>(F, 2); } SEAM(12);
    if (IN(13)) { pg8::StaticSched<256 * 2048, 256 * 2048> Sd{(const char*)(ws + WS_HB), (const char*)(ws + W_IN1), M / 256, P1_LD / 256, F.G, bx, F.wave};
                  pg8::EpiBf16 E{(bf16*)(ws + WS_P1), P1_LD}; pg8::gemm_phase<1024, 2048, 2048>(F.lds, Sd, E); } SEAM(13);
    if (IN(14)) { cmp_mlp_phase(F); } SEAM(14);
    if (IN(15)) { cmp_phase_mfma(F); } SEAM(15);
    if (IN(16)) { slc_phase_mfma(F); } SEAM(16);
    if (IN(17)) { win_phase_mfma(F); } SEAM(17);
    if (IN(18)) { pg8::StaticSched<256 * P1_LD * 2, 256 * 2048> Sd{(const char*)(ws + WS_P1), (const char*)(ws + W_OUT1), M / 256, 4, F.G, bx, F.wave};
                  pg8::EpiAcc E{F.acc, D}; pg8::gemm_phase<1024, P1_LD * 2, 2048>(F.lds, Sd, E); } SEAM(18);
    if (IN(19)) { ln_phase<0>(F, 3); } SEAM(19);
    if (IN(20)) { pg8::StaticSched<256 * 2048, 256 * 2048> Sd{(const char*)(ws + WS_HB), (const char*)(ws + W_XQ + (size_t)512 * 1024 * 2), M / 256, 2, F.G, bx, F.wave};
                  pg8::EpiBf16 E{(bf16*)(ws + WS_QX1), 512}; pg8::gemm_phase<1024, 2048, 2048>(F.lds, Sd, E); } SEAM(20);
    if (IN(21)) { xattn_phase_mfma(F, (const bf16*)(ws + WS_QX1), (const bf16*)(ws + WS_XKV + (size_t)MMEM * 1024 * 2), (bf16*)(ws + WS_OX1)); } SEAM(21);
    if (IN(22)) { pg8::StaticSched<256 * 1024, 256 * 1024> Sd{(const char*)(ws + WS_OX1), (const char*)(ws + W_XO + (size_t)1024 * 512 * 2), M / 256, 4, F.G, bx, F.wave};
                  pg8::EpiAcc E{F.acc, D}; pg8::gemm_phase<512, 1024, 1024>(F.lds, Sd, E); } SEAM(22);
    if (IN(23)) { ln_phase<1>(F, 4); } SEAM(23);
    if (IN(24)) { moe_dispatch(F); } SEAM(24);
#pragma unroll 1
    for (int ch = 0; ch < 4; ++ch) {
        const int pa = 25 + 2 * ch, pb = 26 + 2 * ch;
        const int* tile_exp = (const int*)(ws + WS_TILEEXP);
        if (IN(pa) || IN(pb)) {
            const int slot = ch >> 1; const int s0 = tile_exp[512 + slot], s1 = tile_exp[512 + slot + 1];
            int t0 = s0 + (ch & 1) * MOE_CHUNK_TILES, t1 = (ch & 1) ? s1 : (s0 + MOE_CHUNK_TILES < s1 ? s0 + MOE_CHUNK_TILES : s1);
            if (t0 > s1) t0 = s1; int nT = t1 - t0; if (nT < 0) nT = 0; if (nT > MOE_CHUNK_TILES) nT = MOE_CHUNK_TILES;
            if (IN(pa)) { pg8::MoeSched<WS_PERMA, W_MGU, 256 * 2048, 256 * 2048, (size_t)7168 * 2048, 0> Sd{ws, t0, nT, 2 * DFFE / 256, F.G, bx, F.wave};
                          pg8::EpiSwiglu E{(bf16*)(ws + WS_HIDM), DFFE, 1}; pg8::gemm_phase<1024, 2048, 2048>(F.lds, Sd, E); }
            if (IN(pa) && IN(pb)) xcd_barrier(bar);
            if (IN(pb)) { pg8::MoeSched<WS_HIDM, W_MD, 256 * DFFE * 2, 256 * DFFE * 2, (size_t)1024 * DFFE * 2, 1> Sd{ws, t0, nT, 4, F.G, bx, F.wave};
                          pg8::EpiMoeDown E{F.acc, ws}; pg8::gemm_phase<DFFE, DFFE * 2, DFFE * 2>(F.lds, Sd, E); }
            if (IN(pb) && IN(pb + 1)) xcd_barrier(bar);
        }
    }
    if (IN(33)) { ln_phase<2>(F, 5); }
#undef IN
#undef SEAM
}

extern "C" void kernel_launch(void* const* d_in, const int* in_sizes, int n_in, void* d_out, int out_size, void* d_ws, size_t ws_size, hipStream_t stream) {
    static int grid = 0;
    if (grid == 0) {
        if (n_in != 30 || out_size != M * D || ws_size < WS_END) { fprintf(stderr, "kernel_launch: unexpected shapes (n_in %d, out %d, ws %zu < %zu); nothing launched\n", n_in, out_size, ws_size, (size_t)WS_END); grid = -1; return; }
        int dev = 0, cus = 0, per_cu = 0;
        if (hipGetDevice(&dev) != hipSuccess || hipDeviceGetAttribute(&cus, hipDeviceAttributeMultiprocessorCount, dev) != hipSuccess) { grid = -1; return; }
        if (hipFuncSetAttribute((const void*)skel_fwd, hipFuncAttributeMaxDynamicSharedMemorySize, LDS_BYTES) != hipSuccess) { fprintf(stderr, "kernel_launch: hipFuncSetAttribute failed\n"); grid = -1; return; }
        if (hipOccupancyMaxActiveBlocksPerMultiprocessor(&per_cu, (const void*)skel_fwd, NWAVES * 64, LDS_BYTES) != hipSuccess || per_cu < 1)
            fprintf(stderr, "kernel_launch: occupancy query reports %d workgroups per CU\n", per_cu);
        (void)hipGetLastError();
        grid = cus;
    }
    if (grid < 0) return;
    if (hipMemsetAsync((char*)d_ws + WS_CTL, 0, CTL_ZERO_BYTES, stream) != hipSuccess) return;
    Args a{};
    for (int i = 0; i < 30; ++i) a.in[i] = (const float*)d_in[i];
    a.out = (float*)d_out; a.ws = (unsigned char*)d_ws;
#if MK_ONE_LAUNCH
    a.ph_lo = 0; a.ph_hi = NPHASE;
    hipLaunchKernelGGL(skel_fwd, dim3(grid), dim3(NWAVES * 64), LDS_BYTES, stream, a);
#else
    for (int p = 0; p < NPHASE; ++p) { a.ph_lo = p; a.ph_hi = p + 1; hipLaunchKernelGGL(skel_fwd, dim3(grid), dim3(NWAVES * 64), LDS_BYTES, stream, a); }
#endif
}
```

```cpp
#include <hip/hip_runtime.h>
#include <cstdio>
#include <cstdint>

#ifndef MK_ONE_LAUNCH
#define MK_ONE_LAUNCH 1
#endif

constexpr size_t ROWTOK_OFF = 5u * 1048576u + 512u * 1024u, ROWW_OFF = 6u * 1048576u, TILEEXP_OFF = 6u * 1048576u + 512u * 1024u, DUMMY_OFF = 7u * 1048576u;
namespace pg8 {
#define PG8_LAS __attribute__((address_space(3)))
typedef unsigned short bf16_t;
typedef short bf16x8 __attribute__((ext_vector_type(8)));
typedef float f32x4 __attribute__((ext_vector_type(4)));
typedef unsigned u32x4 __attribute__((ext_vector_type(4)));
constexpr int BM = 256, BK = 64, HALF = 128, HTB = HALF * BK * 2, STAGE_BYTES = 8 * HTB, NXCD = 8, WGM = 8;

__host__ __device__ __forceinline__ int lds_byte(int r, int c) { const int st = (r >> 4) * 2 + (c >> 5), rr = r & 15, cc = c & 31, ob = rr * 64 + cc * 2; return st * 1024 + (ob ^ (((ob >> 9) & 1) << 5)); }
__host__ __device__ __forceinline__ void stage_rc(int b, int& R, int& C) { const int st = b / 1024, sb = b % 1024, swz = sb ^ (((sb >> 9) & 1) << 5); R = (st >> 1) * 16 + swz / 64; C = (st & 1) * 32 + (swz % 64) / 2; }
__host__ __device__ __forceinline__ int perm32(int rho) { const int n = rho >> 4, i = rho & 15; return 8 * (i >> 2) + 4 * n + (i & 3); }

__device__ __forceinline__ const void* opaque_uniform(const void* p) {
    unsigned lo = __builtin_amdgcn_readfirstlane((unsigned)(unsigned long long)p), hi = __builtin_amdgcn_readfirstlane((unsigned)((unsigned long long)p >> 32));
    asm volatile("" : "+s"(lo), "+s"(hi)); return (const void*)(((unsigned long long)hi << 32) | lo); }
struct Unit { int pm, pn, aux; const char* a; const char* b; };

__device__ __forceinline__ void tile_of(int wgid, int nM, int nN, int& pm, int& pn) {
    const int nwg = nM * nN;
    { const int q = nwg / NXCD, r = nwg % NXCD, xcd = wgid % NXCD, off = wgid / NXCD; wgid = (xcd < r ? xcd * (q + 1) : r * (q + 1) + (xcd - r) * q) + off; }
    const int nig = WGM * nN, gid = wgid / nig, fm = gid * WGM, gsz = (nM - fm) < WGM ? (nM - fm) : WGM;
    pm = fm + ((wgid % nig) % gsz); pn = (wgid % nig) / gsz;
}
template <size_t A_TILE, size_t B_TILE>
struct StaticSched {
    const char* A; const char* B; int nM, nN, G, c, wave;
    __device__ __forceinline__ bool next(int i, Unit& u) const {
        const long L = (long)i * G + c; if (L >= (long)nM * nN) return false;
        int pm, pn; tile_of((int)L, nM, nN, pm, pn);
        u.pm = pm; u.pn = pn; u.aux = 0; u.a = A + (size_t)pm * A_TILE; u.b = B + (size_t)pn * B_TILE; return true;
    }
};
template <size_t A_OFF, size_t B_OFF, size_t A_TILE, size_t B_TILE, size_t B_EXP, int A_LOCAL>
struct MoeSched {
    const unsigned char* ws; int t0, nT, nN, G, c, wave;
    __device__ __forceinline__ bool next(int i, Unit& u) const {
        const long L = (long)i * G + c; if (L >= (long)nT * nN) return false;
        int pml, pn; tile_of((int)L, nT, nN, pml, pn);
        const unsigned char* wsb = (const unsigned char*)opaque_uniform(ws);
        const int pm = t0 + pml; const int e = __builtin_amdgcn_readfirstlane(((const int*)(wsb + TILEEXP_OFF))[pm]);
        u.pm = pm; u.pn = pn; u.aux = pml; u.a = (const char*)wsb + A_OFF + (size_t)(A_LOCAL ? pml : pm) * A_TILE; u.b = (const char*)wsb + B_OFF + (size_t)e * B_EXP + (size_t)pn * B_TILE; return true;
    }
};

__device__ __forceinline__ unsigned cvt_pk_bf16(float lo, float hi) { unsigned r; asm volatile("v_cvt_pk_bf16_f32 %0, %1, %2" : "=v"(r) : "v"(lo), "v"(hi)); return r; }

struct EpiBf16 {
    static constexpr bool PERM = true;
    bf16_t* O; int ldc;
    __device__ __forceinline__ void operator()(const f32x4 (&acc)[2][2][4][2], const Unit& u, int wr, int wc, int fr, int fq) const {
        const int row0 = u.pm * BM + wr * 64 + fr, col0 = u.pn * BM + wc * 32 + 8 * fq;
#pragma unroll
        for (int ai = 0; ai < 2; ++ai)
#pragma unroll
            for (int m = 0; m < 4; ++m) { bf16_t* rowp = O + (size_t)(row0 + ai * HALF + m * 16) * ldc + col0;
#pragma unroll
                for (int bj = 0; bj < 2; ++bj) { const f32x4 v0 = acc[ai][bj][m][0], v1 = acc[ai][bj][m][1];
                    u32x4 w; w.x = cvt_pk_bf16(v0[0], v0[1]); w.y = cvt_pk_bf16(v0[2], v0[3]); w.z = cvt_pk_bf16(v1[0], v1[1]); w.w = cvt_pk_bf16(v1[2], v1[3]);
                    *(u32x4*)(rowp + bj * HALF) = w; } }
    }
};
struct EpiAcc {
    static constexpr bool PERM = false;
    float* C; int ldc;
    __device__ __forceinline__ void operator()(const f32x4 (&acc)[2][2][4][2], const Unit& u, int wr, int wc, int fr, int fq) const {
        const int row0 = u.pm * BM + wr * 64 + fr, col0 = u.pn * BM + wc * 32 + 4 * fq;
#pragma unroll
        for (int ai = 0; ai < 2; ++ai)
#pragma unroll
            for (int m = 0; m < 4; ++m) { float* rowp = C + (size_t)(row0 + ai * HALF + m * 16) * ldc + col0;
                f32x4 o[2][2];
#pragma unroll
                for (int bj = 0; bj < 2; ++bj)
#pragma unroll
                    for (int n = 0; n < 2; ++n) o[bj][n] = *(const f32x4*)(rowp + bj * HALF + n * 16);
#pragma unroll
                for (int bj = 0; bj < 2; ++bj)
#pragma unroll
                    for (int n = 0; n < 2; ++n) *(f32x4*)(rowp + bj * HALF + n * 16) = o[bj][n] + acc[ai][bj][m][n]; }
    }
};
__device__ __forceinline__ float silu_f(float x) { return x / (1.0f + __expf(-x)); }
struct EpiSwiglu {
    static constexpr bool PERM = true;
    bf16_t* O; int ldc; int row_local;
    __device__ __forceinline__ void operator()(const f32x4 (&acc)[2][2][4][2], const Unit& u, int wr, int wc, int fr, int fq) const {
        const int row0 = (row_local ? u.aux : u.pm) * BM + wr * 64 + fr, col0 = u.pn * HALF + wc * 32 + 8 * fq;
#pragma unroll
        for (int ai = 0; ai < 2; ++ai)
#pragma unroll
            for (int m = 0; m < 4; ++m) { bf16_t* rowp = O + (size_t)(row0 + ai * HALF + m * 16) * ldc + col0;
                const f32x4 g0 = acc[ai][0][m][0], g1 = acc[ai][0][m][1], u0 = acc[ai][1][m][0], u1 = acc[ai][1][m][1];
                float h[8];
#pragma unroll
                for (int j = 0; j < 4; ++j) { h[j] = silu_f(g0[j]) * u0[j]; h[4 + j] = silu_f(g1[j]) * u1[j]; }
                u32x4 w; w.x = cvt_pk_bf16(h[0], h[1]); w.y = cvt_pk_bf16(h[2], h[3]); w.z = cvt_pk_bf16(h[4], h[5]); w.w = cvt_pk_bf16(h[6], h[7]);
                *(u32x4*)rowp = w; }
    }
};
struct EpiMoeDown {
    static constexpr bool PERM = false;
    float* C; unsigned char* ws;
    __device__ __forceinline__ void operator()(const f32x4 (&acc)[2][2][4][2], const Unit& u, int wr, int wc, int fr, int fq) const {
        const int row0 = u.pm * BM + wr * 64 + fr, col0 = u.pn * BM + wc * 32 + 4 * fq;
        unsigned char* wsb = (unsigned char*)opaque_uniform(ws);
        const int* rowtok = (const int*)(wsb + ROWTOK_OFF); const float* roww = (const float*)(wsb + ROWW_OFF); float* dummy = (float*)(wsb + DUMMY_OFF);
#pragma unroll
        for (int ai = 0; ai < 2; ++ai)
#pragma unroll
            for (int m = 0; m < 4; ++m) { const int r = row0 + ai * HALF + m * 16; const int tok = rowtok[r]; const float w = roww[r];
                float* rowp = (tok >= 0 ? C + (size_t)tok * 1024 : dummy) + col0;
                f32x4 o[2][2];
#pragma unroll
                for (int bj = 0; bj < 2; ++bj)
#pragma unroll
                    for (int n = 0; n < 2; ++n) o[bj][n] = *(const f32x4*)(rowp + bj * HALF + n * 16);
#pragma unroll
                for (int bj = 0; bj < 2; ++bj)
#pragma unroll
                    for (int n = 0; n < 2; ++n) *(f32x4*)(rowp + bj * HALF + n * 16) = o[bj][n] + acc[ai][bj][m][n] * w; }
    }
};

__device__ __forceinline__ float gelu_tanh_f(float x) { const float u = 0.7978845608028654f * (x + 0.044715f * x * x * x); const float e = __expf(2.f * u); return 0.5f * x * (1.f + (1.f - 2.f / (e + 1.f))); }
struct EpiCmpHid {
    static constexpr bool PERM = false;
    float* Hd; const float* bias;
    __device__ __forceinline__ void operator()(const f32x4 (&acc)[2][2][4][2], const Unit& u, int wr, int wc, int fr, int fq) const {
        const int row0 = u.pm * BM + wr * 64 + fr, col0 = wc * 32 + 4 * fq;
        f32x4 bv[2];
#pragma unroll
        for (int n = 0; n < 2; ++n) bv[n] = *(const f32x4*)(bias + u.aux * 128 + col0 + n * 16);
#pragma unroll
        for (int ai = 0; ai < 2; ++ai)
#pragma unroll
            for (int m = 0; m < 4; ++m) { float* rowp = Hd + (size_t)(row0 + ai * HALF + m * 16) * 128 + col0;
#pragma unroll
                for (int n = 0; n < 2; ++n) { const f32x4 v = acc[ai][0][m][n] + bv[n]; f32x4 o;
#pragma unroll
                    for (int j = 0; j < 4; ++j) o[j] = gelu_tanh_f(v[j]);
                    *(f32x4*)(rowp + n * 16) = o; } }
    }
};
struct CmpSched {
    const char* P1b; const char* W1T; int G, c, wave;
    __device__ __forceinline__ bool next(int i, Unit& u) const {
        const int L = i * G + c; if (L >= 32) return false;
        const int which = L >> 4, tile = L & 15, g = tile >> 3, b0 = 2 * (tile & 7);
        u.pm = L; u.pn = 0; u.aux = which; u.a = P1b + ((size_t)b0 * 2048 * 2048 + (which ? 1152 : 1024) + g * 64) * 2; u.b = W1T + (size_t)which * 256 * 2048 * 2; return true;
    }
};

template <int K, int lda_b, int ldb_b, long KSTEP_A = 128, long HSTEP_A = 128L * lda_b, class Epi, class Sched>
__device__ __forceinline__ void gemm_phase(PG8_LAS unsigned char* lds, const Sched& S, const Epi& E) {
    int tid_ = (int)__builtin_amdgcn_mbcnt_hi(~0u, __builtin_amdgcn_mbcnt_lo(~0u, 0u)); asm volatile("" : "+v"(tid_)); tid_ += S.wave * 64;
    const int tid = tid_, wid = __builtin_amdgcn_readfirstlane(tid >> 6), lane = tid & 63, wr = wid >> 2, wc = wid & 3, fr = lane & 15, fq = lane >> 4;
    constexpr int nt = K / BK;
    unsigned voffA[2], voffB[2];
#pragma unroll
    for (int i = 0; i < 2; ++i) { int R, C; stage_rc(tid * 16 + i * 8192, R, C); const int Rb = Epi::PERM ? ((R & ~31) + perm32(R & 31)) : R;
        voffA[i] = (unsigned)(R * lda_b + C * 2); voffB[i] = (unsigned)(Rb * ldb_b + C * 2); }
    const size_t kstep = (size_t)(BK * 2), kstepA = (size_t)KSTEP_A;
    const size_t hstepA = (size_t)HSTEP_A, hstepB = (size_t)HALF * ldb_b;
    const unsigned ldsw = (unsigned)wid * 1024u;
    const int aoff = lds_byte(wr * 64 + fr, fq * 8), boff = lds_byte(wc * 32 + fr, fq * 8);
#define PG8_SA(b, h) (((b) * 2 + (h)) * HTB)
#define PG8_SB(b, h) ((4 + (b) * 2 + (h)) * HTB)
#define PG8_STAGE(bufoff, gbase, voff) do { _Pragma("unroll") for (int _i = 0; _i < 2; ++_i) \
        __builtin_amdgcn_global_load_lds((const unsigned*)((const char*)(gbase) + (voff)[_i]), (PG8_LAS unsigned*)(lds + (bufoff) + ldsw + _i * 8192), 16, 0, 0); } while (0)
#define PG8_LDA(dst, b, h) do { _Pragma("unroll") for (int m = 0; m < 4; ++m) _Pragma("unroll") for (int k = 0; k < 2; ++k) dst[m][k] = *(const PG8_LAS bf16x8*)(lds + PG8_SA(b, h) + aoff + m * 2048 + k * 1024); } while (0)
#define PG8_LDB(dst, b, h) do { _Pragma("unroll") for (int n = 0; n < 2; ++n) _Pragma("unroll") for (int k = 0; k < 2; ++k) dst[n][k] = *(const PG8_LAS bf16x8*)(lds + PG8_SB(b, h) + boff + n * 2048 + k * 1024); } while (0)
#define PG8_MMA(ai, bj, At, Bt) do { __builtin_amdgcn_s_setprio(1); _Pragma("unroll") for (int m = 0; m < 4; ++m) _Pragma("unroll") for (int n = 0; n < 2; ++n) _Pragma("unroll") for (int k = 0; k < 2; ++k) \
        acc[ai][bj][m][n] = __builtin_amdgcn_mfma_f32_16x16x32_bf16(Bt[n][k], At[m][k], acc[ai][bj][m][n], 0, 0, 0); __builtin_amdgcn_s_setprio(0); } while (0)
#define PG8_WAIT_V(n) asm volatile("s_waitcnt vmcnt(" #n ")" ::: "memory")
#define PG8_WAIT_L(n) asm volatile("s_waitcnt lgkmcnt(" #n ")" ::: "memory")
#define PG8_BAR __builtin_amdgcn_s_barrier()
#define PG8_SCHED __builtin_amdgcn_sched_barrier(0)
    Unit cur, nxt; int ui = 0;
    if (!S.next(0, cur)) return;
    f32x4 acc[2][2][4][2];
#pragma unroll
    for (int a = 0; a < 2; ++a)
#pragma unroll
        for (int b = 0; b < 2; ++b)
#pragma unroll
            for (int m = 0; m < 4; ++m)
#pragma unroll
                for (int n = 0; n < 2; ++n) acc[a][b][m][n] = (f32x4){0.f, 0.f, 0.f, 0.f};
    bf16x8 At[4][2], B0[2][2], B1[2][2];
    const char* cA = cur.a; const char* cB = cur.b;
    PG8_STAGE(PG8_SB(0, 0), cB, voffB); PG8_STAGE(PG8_SB(0, 1), cB + hstepB, voffB); PG8_STAGE(PG8_SA(0, 0), cA, voffA); PG8_STAGE(PG8_SA(0, 1), cA + hstepA, voffA);
    if (wr == 1) PG8_BAR;
    PG8_WAIT_V(2); PG8_BAR;
    PG8_STAGE(PG8_SB(1, 0), cB + kstep, voffB); PG8_STAGE(PG8_SA(1, 0), cA + kstepA, voffA); PG8_STAGE(PG8_SB(1, 1), cB + hstepB + kstep, voffB);
    PG8_WAIT_V(6); PG8_BAR;
    for (;;) {
        const bool has_next = S.next(ui + 1, nxt);
        const char* nA = has_next ? nxt.a : cA; const char* nB = has_next ? nxt.b : cB;
        for (int t = 0; t < nt; t += 2) {
            const bool last = (t == nt - 2);
            const char* a1 = cA + (size_t)(t + 1) * kstepA;
            const char* a2 = last ? nA : cA + (size_t)(t + 2) * kstepA; const char* b2 = last ? nB : cB + (size_t)(t + 2) * kstep;
            const char* a3 = a2 + kstepA; const char* b3 = b2 + kstep;
            PG8_LDB(B0, 0, 0); PG8_LDB(B1, 0, 1); PG8_SCHED; PG8_LDA(At, 0, 0); PG8_STAGE(PG8_SA(1, 1), a1 + hstepA, voffA);
            PG8_WAIT_V(8); PG8_WAIT_L(0); PG8_BAR; PG8_MMA(0, 0, At, B0); PG8_MMA(0, 1, At, B1); PG8_BAR; PG8_SCHED;
            PG8_LDA(At, 0, 1); PG8_STAGE(PG8_SB(0, 0), b2, voffB); PG8_STAGE(PG8_SB(0, 1), b2 + hstepB, voffB); PG8_STAGE(PG8_SA(0, 0), a2, voffA);
            PG8_WAIT_V(8); PG8_WAIT_L(0); PG8_BAR; PG8_MMA(1, 0, At, B0); PG8_MMA(1, 1, At, B1); PG8_BAR; PG8_SCHED;
            PG8_LDB(B0, 1, 0); PG8_LDB(B1, 1, 1); PG8_SCHED; PG8_LDA(At, 1, 0); PG8_STAGE(PG8_SA(0, 1), a2 + hstepA, voffA);
            PG8_WAIT_V(8); PG8_WAIT_L(0); PG8_BAR; PG8_MMA(0, 0, At, B0); PG8_MMA(0, 1, At, B1); PG8_BAR; PG8_SCHED;
            PG8_LDA(At, 1, 1); PG8_STAGE(PG8_SB(1, 0), b3, voffB); PG8_STAGE(PG8_SB(1, 1), b3 + hstepB, voffB); PG8_STAGE(PG8_SA(1, 0), a3, voffA);
            PG8_WAIT_V(8); PG8_WAIT_L(0); PG8_BAR; PG8_MMA(1, 0, At, B0); PG8_MMA(1, 1, At, B1); PG8_BAR; PG8_SCHED;
        }
        if (wr == 0) PG8_BAR;
        E(acc, cur, wr, wc, fr, fq);
        if (!has_next) break;
#pragma unroll
        for (int a = 0; a < 2; ++a)
#pragma unroll
            for (int b = 0; b < 2; ++b)
#pragma unroll
                for (int m = 0; m < 4; ++m)
#pragma unroll
                    for (int n = 0; n < 2; ++n) acc[a][b][m][n] = (f32x4){0.f, 0.f, 0.f, 0.f};
        cur = nxt; cA = nA; cB = nB; ++ui;
        if (wr == 1) PG8_BAR;
    }
    PG8_WAIT_V(0);
    PG8_BAR;
#undef PG8_SA
#undef PG8_SB
#undef PG8_STAGE
#undef PG8_LDA
#undef PG8_LDB
#undef PG8_MMA
#undef PG8_WAIT_V
#undef PG8_WAIT_L
#undef PG8_BAR
#undef PG8_SCHED
}
}

constexpr int NWAVES = 8;
constexpr int D = 1024, NB = 16, S = 2048, M = NB * S, MEML = 256, MMEM = NB * MEML;
constexpr float LN_EPS = 1e-5f, ALPHA = 1.41421356237f;
constexpr int P0_LD = 2560, C0_QLAT = 0, C0_QB = 1024, C0_CKV = 1536, C0_QI = 1664, C0_KI = 2176, C0_KB = 2240, C0_VB = 2368, C0_WI = 2496;
constexpr int P1_LD = 2048, C1_Q = 0, C1_KC = 1024, C1_VC = 1152, C1_KS = 1280, C1_VS = 1408, C1_KW = 1536, C1_VW = 1664, C1_GL = 1792;
constexpr int EVEN_COLS = 1992, ODD_COLS = 1840;
constexpr int DFF = 2816, DFFE = 3584, NE = 8, NCMP = 127;
constexpr int MOE_CHUNK_TILES = 68, MOE_MAX_TILES = 272;

constexpr size_t MiB = 1u << 20;
constexpr size_t WS_CTL = 0, CTL_ZERO_BYTES = 1 * MiB;
constexpr size_t WS_KC = 2 * MiB, WS_VC = 3 * MiB;
constexpr size_t WS_SELM = 4 * MiB;
constexpr size_t WS_RTE = 4 * MiB + 512 * 1024;
constexpr size_t WS_RTW = 5 * MiB;
constexpr size_t WS_ROWTOK = ROWTOK_OFF; static_assert(ROWTOK_OFF == 5 * MiB + 512 * 1024, "");
constexpr size_t WS_ROWW = ROWW_OFF;
constexpr size_t WS_TILEEXP = TILEEXP_OFF; constexpr size_t WS_DUMMY = DUMMY_OFF;
constexpr size_t WS_W = 8 * MiB;
constexpr size_t W_IN0 = WS_W;
constexpr size_t W_OUT0 = W_IN0 + (size_t)2560 * 1024 * 2;
constexpr size_t W_IN1 = W_OUT0 + (size_t)1024 * 1536 * 2;
constexpr size_t W_OUT1 = W_IN1 + (size_t)2048 * 1024 * 2;
constexpr size_t W_XQ = W_OUT1 + (size_t)1024 * 1024 * 2;
constexpr size_t W_XKV = W_XQ + (size_t)2 * 512 * 1024 * 2;
constexpr size_t W_XO = W_XKV + (size_t)2 * 1024 * 1024 * 2;
constexpr size_t W_FGU = W_XO + (size_t)2 * 1024 * 512 * 2;
constexpr size_t W_FD = W_FGU + (size_t)5632 * 1024 * 2;
constexpr size_t W_MGU = W_FD + (size_t)1024 * 2816 * 2;
constexpr size_t W_MD = W_MGU + (size_t)8 * 7168 * 1024 * 2;
constexpr size_t W_END = W_MD + (size_t)8 * 1024 * 3584 * 2;
static_assert(W_END <= 215 * MiB, "weights");
constexpr size_t WS_HB = 215 * MiB;
constexpr size_t WS_XKV = 279 * MiB;
constexpr size_t WS_SCR = 295 * MiB;
constexpr size_t WS_P0 = WS_SCR;
constexpr size_t WS_CN = WS_SCR + 160 * MiB;
constexpr size_t WS_MASK = WS_SCR + 168 * MiB;
constexpr size_t WS_MEMB = WS_SCR + 176 * MiB;
constexpr size_t WS_QX0 = WS_SCR + 184 * MiB, WS_OX0 = WS_SCR + 216 * MiB;
constexpr size_t WS_HID = WS_SCR;
constexpr size_t WS_P1 = WS_SCR;
constexpr size_t WS_OCMP = WS_SCR + 128 * MiB, WS_OSLC = WS_SCR + 192 * MiB;
constexpr size_t WS_W1T = WS_SCR + 192 * MiB, WS_HIDC = WS_SCR + 196 * MiB, WS_PEB = WS_SCR + 200 * MiB;
constexpr size_t WS_QX1 = WS_SCR, WS_OX1 = WS_SCR + 32 * MiB;
constexpr size_t WS_PERMA = WS_SCR;
constexpr size_t WS_HIDM = WS_SCR + 136 * MiB;
constexpr size_t WS_END = WS_SCR + 256 * MiB;
static_assert(WS_HIDM + (size_t)MOE_CHUNK_TILES * 256 * DFFE * 2 <= WS_END, "ws");
constexpr int CW_BAR = 4096;
constexpr int CW_CNT = 16384;
constexpr int CW_CUR = 16384 + 64;

constexpr int RING_BYTES = 131072, LDSCTL_OFF = RING_BYTES, MISC_OFF = LDSCTL_OFF + 320, LDS_BYTES = 147456;

#define GAS __attribute__((address_space(1)))
#define LAS __attribute__((address_space(3)))
typedef unsigned short bf16;
typedef unsigned v4u __attribute__((ext_vector_type(4)));
typedef unsigned v2u __attribute__((ext_vector_type(2)));
typedef float f32x4 __attribute__((ext_vector_type(4)));
#define LDS_WAIT() asm volatile("s_waitcnt lgkmcnt(0)" ::: "memory")
#define WAVE_SYNC() asm volatile("s_waitcnt vmcnt(0) lgkmcnt(0)" ::: "memory")
__device__ __forceinline__ unsigned f2bf(float f) { unsigned u = __builtin_bit_cast(unsigned, f); return (u + 0x7fffu + ((u >> 16) & 1u)) >> 16; }
__device__ __forceinline__ unsigned pk2(float lo, float hi) { return f2bf(lo) | (f2bf(hi) << 16); }
__device__ __forceinline__ float bf2f(bf16 b) { return __builtin_bit_cast(float, (unsigned)b << 16); }
__device__ __forceinline__ float bflo(unsigned w) { return __builtin_bit_cast(float, w << 16); }
__device__ __forceinline__ float bfhi(unsigned w) { return __builtin_bit_cast(float, w & 0xffff0000u); }
__device__ __forceinline__ void ld8bf(const bf16* p, float* f) { const v4u w = *(const v4u*)p; f[0] = bflo(w.x); f[1] = bfhi(w.x); f[2] = bflo(w.y); f[3] = bfhi(w.y); f[4] = bflo(w.z); f[5] = bfhi(w.z); f[6] = bflo(w.w); f[7] = bfhi(w.w); }
__device__ __forceinline__ float wave_sum(float v) {
#pragma unroll
    for (int o = 1; o < 64; o <<= 1) v += __shfl_xor(v, o);
    return v;
}
__device__ __forceinline__ float wave_max(float v) {
#pragma unroll
    for (int o = 1; o < 64; o <<= 1) v = fmaxf(v, __shfl_xor(v, o));
    return v;
}
__device__ const unsigned char BKT[112] = {16, 16, 16, 17, 17, 18, 18, 18, 19, 19, 19, 20, 20, 20, 20, 21, 21, 21, 21, 22, 22, 22, 22, 22, 23, 23, 23, 23, 23, 23, 24, 24, 24, 24, 24, 24, 25, 25, 25, 25, 25, 25, 25, 26, 26, 26, 26, 26, 26, 26, 26,
    27, 27, 27, 27, 27, 27, 27, 27, 27, 27, 28, 28, 28, 28, 28, 28, 28, 28, 28, 28, 29, 29, 29, 29, 29, 29, 29, 29, 29, 29, 29, 29, 30, 30, 30, 30, 30, 30, 30, 30, 30, 30, 30, 30, 30, 30, 31, 31, 31, 31, 31, 31, 31, 31, 31, 31, 31, 31, 31, 31, 31};
__device__ __forceinline__ int rel_bucket(int n) { return n < 16 ? n : (n >= 128 ? 31 : (int)BKT[n - 16]); }

#define XB_TMO      128
#define XB_XCNT(j)  (256  + 64 * (j))
#define XB_XSUB(j)  (1280 + 64 * (j))
#define XB_XGEN(j)  (2304 + 64 * (j))
#define XB_TOP      3328
#define XB_TOPGEN   3392
#define XCD_BAR_WORDS 3456
#define XB_SPIN_CAP (1u << 22)
__device__ __forceinline__ unsigned xb_ld(unsigned* p)              { return __hip_atomic_load(p, __ATOMIC_RELAXED, __HIP_MEMORY_SCOPE_AGENT); }
__device__ __forceinline__ unsigned xb_add(unsigned* p, unsigned v) { return __hip_atomic_fetch_add(p, v, __ATOMIC_RELAXED, __HIP_MEMORY_SCOPE_AGENT); }
__device__ __forceinline__ unsigned xb_xcc_id() { return (unsigned)__builtin_amdgcn_s_getreg((3 << 11) | 20) & 0xFu; }
#define XB_SPIN(cond, bar) do { unsigned _sp = 0; while (cond) { __builtin_amdgcn_s_sleep(1); \
    if ((++_sp & 255u) == 0u) { if (xb_ld(&(bar)[XB_TMO])) break; if (_sp > XB_SPIN_CAP) { atomicAdd(&(bar)[XB_TMO], 1u); break; } } } } while (0)
struct XcdBarrier { unsigned* bar; unsigned x; volatile LAS unsigned* st; };
__device__ __forceinline__ XcdBarrier xcd_barrier_post(unsigned* bar, volatile LAS unsigned* st) {
    XcdBarrier b; b.bar = bar; b.x = xb_xcc_id(); b.st = st;
    if (threadIdx.x == 0) (void)xb_add(&bar[XB_XCNT(b.x)], 1u);
    return b;
}
__device__ __forceinline__ void xcd_barrier_complete(unsigned* bar, unsigned x, unsigned& nloc, unsigned& nx) {
    const unsigned G = gridDim.x * gridDim.y * gridDim.z;
    unsigned sum, cnt, mine, sp = 0u;
    for (;;) {
        sum = 0u; cnt = 0u; mine = 0u;
#pragma unroll
        for (unsigned j = 0; j < 16; ++j) { const unsigned c = xb_ld(&bar[XB_XCNT(j)]); sum += c; cnt += (c > 0u) ? 1u : 0u; mine = (j == x) ? c : mine; }
        if (sum == G) break;
        __builtin_amdgcn_s_sleep(1);
        if ((++sp & 255u) == 0u) { if (xb_ld(&bar[XB_TMO])) break; if (sp > XB_SPIN_CAP) { atomicAdd(&bar[XB_TMO], 1u); break; } }
    }
    nloc = mine > 0u ? mine : 1u; nx = cnt > 0u ? cnt : 1u;
}
__device__ __forceinline__ void xcd_barrier(const XcdBarrier& b) {
    asm volatile("s_waitcnt vmcnt(0)" ::: "memory");
    __syncthreads();
    if (threadIdx.x == 0) {
        unsigned* bar = b.bar;
        __builtin_amdgcn_s_waitcnt(0);
        unsigned nloc = b.st[0], nx = b.st[1];
        const unsigned old = xb_add(&bar[XB_XSUB(b.x)], 1u);
        const unsigned gen = old / nloc;
        if (old + 1u == (gen + 1u) * nloc) {
            __builtin_amdgcn_fence(__ATOMIC_RELEASE, "agent");
            asm volatile("s_waitcnt vmcnt(0)" ::: "memory");
            const unsigned og = xb_add(&bar[XB_TOP], 1u);
            const unsigned tg = og / nx;
            if (og + 1u == (tg + 1u) * nx) xb_add(&bar[XB_TOPGEN], 1u);
            else XB_SPIN(xb_ld(&bar[XB_TOPGEN]) == tg, bar);
            __builtin_amdgcn_fence(__ATOMIC_ACQUIRE, "agent");
            xb_add(&bar[XB_XGEN(b.x)], 1u);
            asm volatile("s_waitcnt vmcnt(0)" ::: "memory");
        } else {
            XB_SPIN(xb_ld(&bar[XB_XGEN(b.x)]) == gen, bar);
            __builtin_amdgcn_fence(__ATOMIC_ACQUIRE, "agent");
            asm volatile("s_waitcnt vmcnt(0)" ::: "memory");
        }
    }
    __syncthreads();
}

struct Args { const float* in[30]; float* out; unsigned char* ws; int ph_lo, ph_hi; };
enum { I_X = 0, I_MEM, I_REL, I_EV_WIN, I_EV_GAIN, I_EV_WUK, I_EV_WUV, I_EV_SINK, I_EV_WOUT, I_OD_WIN, I_OD_PEK, I_OD_W1K, I_OD_W2K, I_OD_PEV, I_OD_W1V, I_OD_W2V, I_OD_WOUT,
       I_XA_WQ, I_XA_WK, I_XA_WV, I_XA_WO, I_FF_G, I_FF_U, I_FF_D, I_MOE_R, I_MOE_G, I_MOE_U, I_MOE_D, I_LN_G, I_LN_B };

struct Frame {
    LAS unsigned char* lds;
    unsigned char* ws; float* acc;
    const float* const* in;
    int tid, lane, wave, G, gw, NGW;
};

__device__ __forceinline__ bool fresh(Frame& F) { int l = (int)__builtin_amdgcn_mbcnt_hi(~0u, __builtin_amdgcn_mbcnt_lo(~0u, 0u)); asm volatile("" : "+v"(l)); F.lane = l; F.tid = F.wave * 64 + l; return true; }
__device__ __forceinline__ void tconv_item(const float* W, int ldw, int ncols, bf16* WT, int ldt, int grp, int gstride, LAS float* scr, int kb, int nb, int lane) {
    const int k0 = 64 * kb, n0 = 32 * nb;
#pragma unroll 8
    for (int i = 0; i < 32; ++i) { const int kk = 2 * i + (lane >> 5), n = n0 + (lane & 31); scr[kk * 33 + (lane & 31)] = (n < ncols) ? W[(size_t)(k0 + kk) * ldw + n] : 0.f; }
    LDS_WAIT();
    const int c = lane & 7;
#pragma unroll
    for (int j = 0; j < 4; ++j) { const int nn = (lane >> 3) + 8 * j, n = n0 + nn; const LAS float* s = scr + (8 * c) * 33 + nn;
        v4u o; o.x = pk2(s[0 * 33], s[1 * 33]); o.y = pk2(s[2 * 33], s[3 * 33]); o.z = pk2(s[4 * 33], s[5 * 33]); o.w = pk2(s[6 * 33], s[7 * 33]);
        const int row = (n / grp) * gstride + (n % grp);
        *(v4u*)(WT + (size_t)row * ldt + k0 + 8 * c) = o; }
    LDS_WAIT();
}
__device__ __forceinline__ void tconv(const Frame& F, const float* W, int ldw, int K, int ncols, int npad, bf16* WT, int ldt, int grp, int gstride) {
    LAS float* scr = (LAS float*)(F.lds + F.wave * 16384);
    const int nkb = K / 64, nnb = npad / 32;
    for (int it = F.gw; it < nkb * nnb; it += F.NGW) tconv_item(W, ldw, ncols, WT, ldt, grp, gstride, scr, it / nnb, it % nnb, F.lane);
}
constexpr int NOGRP = 1 << 30;

__device__ __forceinline__ void prologue(const Frame& F) {
    unsigned char* ws = F.ws;
    const int gt = F.gw * 64 + F.lane, NT = F.NGW * 64;
    bf16* win0 = (bf16*)(ws + W_IN0);
    const float* evw = F.in[I_EV_WIN];
    tconv(F, evw + 512, EVEN_COLS, 1024, 128, 128, win0 + (size_t)C0_CKV * 1024, 1024, NOGRP, 0);
    tconv(F, evw + 640, EVEN_COLS, 1024, 512, 512, win0 + (size_t)C0_QI * 1024, 1024, NOGRP, 0);
    tconv(F, evw + 1152, EVEN_COLS, 1024, 64, 64, win0 + (size_t)C0_KI * 1024, 1024, NOGRP, 0);
    tconv(F, evw + 1216, EVEN_COLS, 1024, 8, 64, win0 + (size_t)C0_WI * 1024, 1024, NOGRP, 0);
    tconv(F, evw + 1224, EVEN_COLS, 1024, 512, 512, win0 + (size_t)C0_QB * 1024, 1024, NOGRP, 0);
    tconv(F, evw + 1736, EVEN_COLS, 1024, 128, 128, win0 + (size_t)C0_KB * 1024, 1024, NOGRP, 0);
    tconv(F, evw + 1864, EVEN_COLS, 1024, 128, 128, win0 + (size_t)C0_VB * 1024, 1024, NOGRP, 0);
    {
        const float* wuk = F.in[I_EV_WUK];
        for (int idx = gt; idx < 1024 * 1024; idx += NT) { const int r = idx >> 10, k = idx & 1023, h = r >> 7, c = r & 127;
            const float* wr = evw + (size_t)k * EVEN_COLS + h * 64; const float* uk = wuk + (size_t)h * 64 * 128 + c; float s = 0.f;
#pragma unroll 8
            for (int d = 0; d < 64; ++d) s += wr[d] * uk[d * 128];
            win0[(size_t)(C0_QLAT + r) * 1024 + k] = (bf16)f2bf(s); }
    }
    bf16* wout0 = (bf16*)(ws + W_OUT0);
    const float* evo = F.in[I_EV_WOUT];
    tconv(F, evo + (size_t)512 * 1024, 1024, 512, 1024, 1024, wout0 + 1024, 1536, NOGRP, 0);
    {
        const float* wuv = F.in[I_EV_WUV];
        for (int idx = gt; idx < 1024 * 1024; idx += NT) { const int n = idx >> 10, kk = idx & 1023, h = kk >> 7;
            const float* uv = wuv + (size_t)kk * 64; const float* wo = evo + (size_t)h * 64 * 1024 + n; float s = 0.f;
#pragma unroll 8
            for (int d = 0; d < 64; ++d) s += uv[d] * wo[(size_t)d * 1024];
            wout0[(size_t)n * 1536 + kk] = (bf16)f2bf(s); }
    }
    tconv(F, F.in[I_OD_WIN], ODD_COLS, 1024, ODD_COLS, 2048, (bf16*)(ws + W_IN1), 1024, NOGRP, 0);
    tconv(F, F.in[I_OD_WOUT], 1024, 1024, 1024, 1024, (bf16*)(ws + W_OUT1), 1024, NOGRP, 0);
    for (int i = 0; i < 2; ++i) {
        tconv(F, F.in[I_XA_WQ] + (size_t)i * 1024 * 512, 512, 1024, 512, 512, (bf16*)(ws + W_XQ) + (size_t)i * 512 * 1024, 1024, NOGRP, 0);
        tconv(F, F.in[I_XA_WK] + (size_t)i * 1024 * 512, 512, 1024, 512, 512, (bf16*)(ws + W_XKV) + (size_t)i * 1024 * 1024, 1024, NOGRP, 0);
        tconv(F, F.in[I_XA_WV] + (size_t)i * 1024 * 512, 512, 1024, 512, 512, (bf16*)(ws + W_XKV) + (size_t)i * 1024 * 1024 + (size_t)512 * 1024, 1024, NOGRP, 0);
        tconv(F, F.in[I_XA_WO] + (size_t)i * 512 * 1024, 1024, 512, 1024, 1024, (bf16*)(ws + W_XO) + (size_t)i * 1024 * 512, 512, NOGRP, 0);
    }
    tconv(F, F.in[I_FF_G], DFF, 1024, DFF, DFF, (bf16*)(ws + W_FGU), 1024, 128, 256);
    tconv(F, F.in[I_FF_U], DFF, 1024, DFF, DFF, (bf16*)(ws + W_FGU) + (size_t)128 * 1024, 1024, 128, 256);
    tconv(F, F.in[I_FF_D], 1024, DFF, 1024, 1024, (bf16*)(ws + W_FD), DFF, NOGRP, 0);
    for (int e = 0; e < NE; ++e) {
        tconv(F, F.in[I_MOE_G] + (size_t)e * 1024 * DFFE, DFFE, 1024, DFFE, DFFE, (bf16*)(ws + W_MGU) + (size_t)e * 7168 * 1024, 1024, 128, 256);
        tconv(F, F.in[I_MOE_U] + (size_t)e * 1024 * DFFE, DFFE, 1024, DFFE, DFFE, (bf16*)(ws + W_MGU) + (size_t)e * 7168 * 1024 + (size_t)128 * 1024, 1024, 128, 256);
        tconv(F, F.in[I_MOE_D] + (size_t)e * DFFE * 1024, 1024, DFFE, 1024, 1024, (bf16*)(ws + W_MD) + (size_t)e * 1024 * DFFE, DFFE, NOGRP, 0);
    }
    {
        const f32x4* x4 = (const f32x4*)F.in[I_X]; v2u* hb = (v2u*)(ws + WS_HB); f32x4* a4 = (f32x4*)F.acc;
        for (int i = gt; i < M * D / 4; i += NT) { const f32x4 v = x4[i]; v2u o; o.x = pk2(v.x, v.y); o.y = pk2(v.z, v.w); hb[i] = o; a4[i] = v * ALPHA; }
        const f32x4* m4 = (const f32x4*)F.in[I_MEM]; v2u* mb = (v2u*)(ws + WS_MEMB);
        for (int i = gt; i < MMEM * D / 4; i += NT) { const f32x4 v = m4[i]; v2u o; o.x = pk2(v.x, v.y); o.y = pk2(v.z, v.w); mb[i] = o; }
    }
}

template <int MODE>
__device__ __forceinline__ void ln_phase(const Frame& F, int li) {
    const float* g = F.in[I_LN_G] + (size_t)li * D; const float* bb = F.in[I_LN_B] + (size_t)li * D;
    LAS int* lcnt = (LAS int*)F.lds;
    if (MODE == 1) { if (F.tid < 16) lcnt[F.tid] = 0; __syncthreads(); }
    for (int row = F.gw; row < M; row += F.NGW) {
        f32x4* p = (f32x4*)(F.acc + (size_t)row * D) + F.lane;
        f32x4 v[4]; float s = 0.f;
#pragma unroll
        for (int j = 0; j < 4; ++j) { v[j] = p[64 * j]; s += (v[j].x + v[j].y) + (v[j].z + v[j].w); }
        const float mean = wave_sum(s) * (1.f / D); float s2 = 0.f;
#pragma unroll
        for (int j = 0; j < 4; ++j) { v[j] = v[j] - mean; s2 += (v[j].x * v[j].x + v[j].y * v[j].y) + (v[j].z * v[j].z + v[j].w * v[j].w); }
        const float rstd = 1.f / sqrtf(wave_sum(s2) * (1.f / D) + LN_EPS);
#pragma unroll
        for (int j = 0; j < 4; ++j) { const f32x4 gg = ((const f32x4*)g)[F.lane + 64 * j], b4 = ((const f32x4*)bb)[F.lane + 64 * j]; v[j] = v[j] * rstd * gg + b4; }
        if (MODE == 2) {
#pragma unroll
            for (int j = 0; j < 4; ++j) p[64 * j] = v[j];
        } else {
            v2u* hb = (v2u*)(F.ws + WS_HB + (size_t)row * D * 2) + F.lane;
#pragma unroll
            for (int j = 0; j < 4; ++j) { v2u o; o.x = pk2(v[j].x, v[j].y); o.y = pk2(v[j].z, v[j].w); hb[64 * j] = o; p[64 * j] = v[j] * ALPHA; }
        }
        if (MODE == 1) {
            const float* wr = F.in[I_MOE_R]; float lg[8];
#pragma unroll
            for (int e = 0; e < 8; ++e) lg[e] = 0.f;
#pragma unroll
            for (int j = 0; j < 4; ++j)
#pragma unroll
                for (int i = 0; i < 4; ++i) { const int c = 4 * (F.lane + 64 * j) + i; const f32x4 w0 = *(const f32x4*)(wr + (size_t)c * 8), w1 = *(const f32x4*)(wr + (size_t)c * 8 + 4); const float y = v[j][i];
                    lg[0] += y * w0.x; lg[1] += y * w0.y; lg[2] += y * w0.z; lg[3] += y * w0.w; lg[4] += y * w1.x; lg[5] += y * w1.y; lg[6] += y * w1.z; lg[7] += y * w1.w; }
#pragma unroll
            for (int e = 0; e < 8; ++e) lg[e] = wave_sum(lg[e]);
            int e0 = 0; float v0 = lg[0];
#pragma unroll
            for (int e = 1; e < 8; ++e) if (lg[e] > v0) { v0 = lg[e]; e0 = e; }
            int e1 = -1; float v1 = -3.0e38f;
#pragma unroll
            for (int e = 0; e < 8; ++e) if (e != e0 && lg[e] > v1) { v1 = lg[e]; e1 = e; }
            const float w0 = 1.f / (1.f + __expf(v1 - v0)), w1 = 1.f - w0;
            if (F.lane == 0) { int* rte = (int*)(F.ws + WS_RTE); float* rtw = (float*)(F.ws + WS_RTW); rte[2 * row] = e0; rte[2 * row + 1] = e1; rtw[2 * row] = w0; rtw[2 * row + 1] = w1;
                atomicAdd((int*)&lcnt[e0], 1); atomicAdd((int*)&lcnt[8 + e1], 1); }
        }
    }
    if (MODE == 1) { __syncthreads(); if (F.tid < 16) { const int c = lcnt[F.tid]; if (c) atomicAdd((unsigned*)(F.ws + WS_CTL) + CW_CNT + F.tid, (unsigned)c); } }
}

__device__ __forceinline__ void moe_dispatch(const Frame& F) {
    unsigned* ctl = (unsigned*)(F.ws + WS_CTL);
    int* tile_exp = (int*)(F.ws + WS_TILEEXP); int* rowtok = (int*)(F.ws + WS_ROWTOK); float* roww = (float*)(F.ws + WS_ROWW);
    LAS int* seg = (LAS int*)F.lds;
    if (F.tid == 0) { int run = 0;
#pragma unroll 1
        for (int sgi = 0; sgi < 16; ++sgi) { if ((sgi & 7) == 0) seg[32 + (sgi >> 3)] = run >> 8; seg[sgi] = run; const int c = (int)__hip_atomic_load(ctl + CW_CNT + sgi, __ATOMIC_RELAXED, __HIP_MEMORY_SCOPE_AGENT); seg[16 + sgi] = c; run += (c + 255) & ~255; }
        seg[34] = run >> 8; }
    __syncthreads();
    if (blockIdx.x == 0) {
#pragma unroll 1
        for (int sgi = 0; sgi < 16; ++sgi) { const int c = seg[16 + sgi], st = seg[sgi], en = st + ((c + 255) & ~255);
            for (int t = (st >> 8) + F.tid; t < (en >> 8); t += 512) tile_exp[t] = sgi & 7;
            for (int r = st + c + F.tid; r < en; r += 512) { rowtok[r] = -1; roww[r] = 0.f; } }
        if (F.tid < 3) tile_exp[512 + F.tid] = seg[32 + F.tid];
    }
    const int* rte = (const int*)(F.ws + WS_RTE); const float* rtw = (const float*)(F.ws + WS_RTW);
    for (int base = F.gw * 64; base < M; base += F.NGW * 64) {
        const int tok = base + F.lane; const int e0 = rte[2 * tok], e1 = rte[2 * tok + 1]; const float w0 = rtw[2 * tok], w1 = rtw[2 * tok + 1];
        int pos0 = 0, pos1 = 0;
#pragma unroll 1
        for (int sgi = 0; sgi < 16; ++sgi) { const bool mine = (sgi < 8) ? (e0 == sgi) : (e1 == sgi - 8);
            const unsigned long long bal = __ballot(mine);
            if (bal) { const int n = __popcll(bal); unsigned b0 = 0; if (F.lane == 0) b0 = atomicAdd(ctl + CW_CUR + sgi, (unsigned)n); b0 = __shfl(b0, 0);
                const int rank = __popcll(bal & ((1ull << F.lane) - 1ull));
                if (mine) { const int pos = seg[sgi] + (int)b0 + rank; if (sgi < 8) pos0 = pos; else pos1 = pos; } } }
        rowtok[pos0] = tok; roww[pos0] = w0; rowtok[pos1] = tok; roww[pos1] = w1;
#pragma unroll 1
        for (int i = 0; i < 64; ++i) { const int tk = base + i; const int p0 = __shfl(pos0, i), p1 = __shfl(pos1, i);
            const v4u* src = (const v4u*)(F.ws + WS_HB + (size_t)tk * D * 2);
            v4u* d0 = (v4u*)(F.ws + WS_PERMA + (size_t)p0 * D * 2); v4u* d1 = (v4u*)(F.ws + WS_PERMA + (size_t)p1 * D * 2);
            const v4u a = src[F.lane], b = src[F.lane + 64]; d0[F.lane] = a; d0[F.lane + 64] = b; d1[F.lane] = a; d1[F.lane + 64] = b; }
    }
    __syncthreads();
}

__device__ __forceinline__ void cn_phase(const Frame& F) {
    const bf16* P0 = (const bf16*)(F.ws + WS_P0); bf16* CN = (bf16*)(F.ws + WS_CN); const float* gain = F.in[I_EV_GAIN];
    for (int row = F.gw; row < M; row += F.NGW) {
        const unsigned w = *(const unsigned*)(P0 + (size_t)row * P0_LD + C0_CKV + 2 * F.lane); const float a = bflo(w), b = bfhi(w);
        const float ms = wave_sum(a * a + b * b) * (1.f / 128.f); const float r = 1.f / sqrtf(ms + LN_EPS);
        *(unsigned*)(CN + (size_t)row * 128 + 2 * F.lane) = pk2(a * r * gain[2 * F.lane], b * r * gain[2 * F.lane + 1]);
    }
}

__device__ __forceinline__ unsigned fkey(float x) { unsigned b = __builtin_bit_cast(unsigned, x); if (b == 0x80000000u) b = 0u; return (b & 0x80000000u) ? ~b : (b | 0x80000000u); }
__device__ __forceinline__ void idx_phase(const Frame& F) {
    const bf16* P0 = (const bf16*)(F.ws + WS_P0); unsigned* MASK = (unsigned*)(F.ws + WS_MASK);
    LAS float* qi_s = (LAS float*)F.lds; LAS float* wi_s = qi_s + 4096; LAS float* sc = wi_s + 64;
    for (int item = blockIdx.x; item < NB * (S / 8); item += F.G) {
        const int b = item / (S / 8), t0 = (item % (S / 8)) * 8;
        for (int i = F.tid; i < 4096; i += 512) { const int q = i >> 9, e = i & 511; qi_s[i] = bf2f(P0[(size_t)(b * S + t0 + q) * P0_LD + C0_QI + e]); }
        if (F.tid < 64) { const int q = F.tid >> 3, h = F.tid & 7; wi_s[F.tid] = bf2f(P0[(size_t)(b * S + t0 + q) * P0_LD + C0_WI + h]) * (0.35355339059f * 0.125f); }
        __syncthreads();
        const int nk = t0 + 8;
        for (int s = F.tid; s < nk; s += 512) {
            float kf[64]; const bf16* kr = P0 + (size_t)(b * S + s) * P0_LD + C0_KI;
#pragma unroll
            for (int j = 0; j < 8; ++j) ld8bf(kr + 8 * j, kf + 8 * j);
#pragma unroll 1
            for (int q = 0; q < 8; ++q) { float a = 0.f;
#pragma unroll 1
                for (int h = 0; h < 8; ++h) { const LAS float* qp = qi_s + q * 512 + h * 64; float dot = 0.f;
#pragma unroll
                    for (int d = 0; d < 64; ++d) dot += qp[d] * kf[d];
                    a += wi_s[q * 8 + h] * fmaxf(dot, 0.f); }
                sc[q * 2048 + s] = a; }
        }
        __syncthreads();
        {
            const int q = F.wave, t = t0 + q, n = t + 1, row = b * S + t; unsigned myword = 0u;
            if (n <= 256) { const int cb = n - 32 * F.lane; myword = cb >= 32 ? 0xffffffffu : (cb <= 0 ? 0u : ((1u << cb) - 1u)); }
            else {
                LAS unsigned* uk = (LAS unsigned*)(sc + q * 2048);
#pragma unroll 4
                for (int i = 0; i < 32; ++i) { const int s = F.lane + 64 * i; const unsigned k = (s < n) ? fkey(sc[q * 2048 + s]) : 0u; uk[s] = k; }
                LDS_WAIT();
                unsigned prefix = 0u;
#pragma unroll 1
                for (int bit = 31; bit >= 0; --bit) { const unsigned cand = prefix | (1u << bit); int c = 0;
#pragma unroll 8
                    for (int i = 0; i < 32; ++i) c += (uk[F.lane + 64 * i] >= cand) ? 1 : 0;
#pragma unroll
                    for (int o = 1; o < 64; o <<= 1) c += __shfl_xor(c, o);
                    if (c >= 256) prefix = cand; }
                int cgt = 0;
#pragma unroll 8
                for (int i = 0; i < 32; ++i) cgt += (uk[F.lane + 64 * i] > prefix) ? 1 : 0;
#pragma unroll
                for (int o = 1; o < 64; o <<= 1) cgt += __shfl_xor(cgt, o);
                const int need = 256 - cgt; int run = 0;
#pragma unroll 1
                for (int i = 0; i < 32; ++i) { const unsigned u = uk[F.lane + 64 * i]; const bool eq = (u == prefix); const unsigned long long em = __ballot(eq); const int rank = run + __popcll(em & ((1ull << F.lane) - 1ull));
                    const bool sel = (u > prefix) || (eq && rank < need); run += __popcll(em);
                    const unsigned long long sm = __ballot(sel);
                    if (F.lane == 2 * i) myword = (unsigned)sm; if (F.lane == 2 * i + 1) myword = (unsigned)(sm >> 32); }
            }
            MASK[(size_t)row * 64 + F.lane] = myword;
        }
        __syncthreads();
    }
}

__device__ __forceinline__ void dsa_phase(const Frame& F) {
    bf16* P0 = (bf16*)(F.ws + WS_P0); const bf16* CN = (const bf16*)(F.ws + WS_CN); const unsigned* MASK = (const unsigned*)(F.ws + WS_MASK); const float* rel = F.in[I_REL];
    LAS float* ql = (LAS float*)(F.lds + F.wave * 13312); LAS float* pl = ql + 1024; LAS int* idx = (LAS int*)(pl + 2048);
    for (int row = F.gw; row < M; row += F.NGW) {
        const int b = row / S, t = row % S;
        const unsigned w = MASK[(size_t)row * 64 + F.lane]; const int c = __popc(w);
        int incl = c;
#pragma unroll
        for (int o = 1; o < 64; o <<= 1) { const int v = __shfl_up(incl, o); if (F.lane >= o) incl += v; }
        const int total = __shfl(incl, 63); int pos = incl - c; unsigned ww = w;
        while (ww) { const int bit = __ffs(ww) - 1; idx[pos++] = 32 * F.lane + bit; ww &= ww - 1u; }
#pragma unroll
        for (int i = 0; i < 16; ++i) ql[F.lane + 64 * i] = bf2f(P0[(size_t)row * P0_LD + C0_QLAT + F.lane + 64 * i]);
        WAVE_SYNC();
        float lg[4][8]; bool val[4];
#pragma unroll
        for (int kk = 0; kk < 4; ++kk) { const int k = F.lane + 64 * kk; val[kk] = k < total; const int key = val[kk] ? idx[k] : 0;
            float a[8];
#pragma unroll
            for (int h = 0; h < 8; ++h) a[h] = 0.f;
            const bf16* cr = CN + (size_t)(b * S + key) * 128;
#pragma unroll 1
            for (int j = 0; j < 16; ++j) { float cv[8]; ld8bf(cr + 8 * j, cv);
#pragma unroll
                for (int h = 0; h < 8; ++h)
#pragma unroll
                    for (int i = 0; i < 8; ++i) a[h] += ql[h * 128 + 8 * j + i] * cv[i]; }
            const int bk = rel_bucket(t - key);
#pragma unroll
            for (int h = 0; h < 8; ++h) lg[kk][h] = val[kk] ? (a[h] * 0.125f + rel[bk * 16 + h]) : -1.0e30f;
        }
#pragma unroll
        for (int h = 0; h < 8; ++h) { float m = fmaxf(fmaxf(lg[0][h], lg[1][h]), fmaxf(lg[2][h], lg[3][h])); m = wave_max(m);
            float e[4], s = 0.f;
#pragma unroll
            for (int kk = 0; kk < 4; ++kk) { e[kk] = val[kk] ? __expf(lg[kk][h] - m) : 0.f; s += e[kk]; }
            s = wave_sum(s); const float inv = 1.f / s;
#pragma unroll
            for (int kk = 0; kk < 4; ++kk) pl[h * 256 + F.lane + 64 * kk] = e[kk] * inv; }
        WAVE_SYNC();
        float a0[8], a1[8];
#pragma unroll
        for (int h = 0; h < 8; ++h) { a0[h] = 0.f; a1[h] = 0.f; }
        for (int k = 0; k < total; ++k) { const int key = idx[k]; const unsigned pr = *(const unsigned*)(CN + (size_t)(b * S + key) * 128 + 2 * F.lane); const float vx = bflo(pr), vy = bfhi(pr);
#pragma unroll
            for (int h = 0; h < 8; ++h) { const float p = pl[h * 256 + k]; a0[h] += p * vx; a1[h] += p * vy; } }
#pragma unroll
        for (int h = 0; h < 8; ++h) *(unsigned*)(P0 + (size_t)row * P0_LD + C0_QLAT + h * 128 + 2 * F.lane) = pk2(a0[h], a1[h]);
        WAVE_SYNC();
    }
}

template <int W, int NH, int GRPSZ, bool SINK, bool NSA>
__device__ __forceinline__ void banded_phase(const Frame& F, bf16* P, int ld, int cq, int ck, int cv, int relc0) {
    const float* rel = F.in[I_REL]; const float* sinks = F.in[I_EV_SINK];
    const bf16* OC = (const bf16*)(F.ws + WS_OCMP); const bf16* OS = (const bf16*)(F.ws + WS_OSLC);
    constexpr int NTG = S / 64;
    for (int it = F.gw; it < NB * NH * NTG; it += F.NGW) {
        const int tg = it % NTG, h = (it / NTG) % NH, b = it / (NTG * NH);
        const int t = tg * 64 + F.lane, row = b * S + t, kvh = h / GRPSZ;
        float q[64], acc[64];
        { const bf16* qr = P + (size_t)row * ld + cq + h * 64;
#pragma unroll
          for (int j = 0; j < 8; ++j) ld8bf(qr + 8 * j, q + 8 * j); }
#pragma unroll
        for (int d = 0; d < 64; ++d) acc[d] = 0.f;
        float m = SINK ? sinks[h] : -1.0e30f, l = SINK ? 1.f : 0.f;
#pragma unroll 1
        for (int j = 0; j < W; ++j) { const int s = t - j;
            const float bias = rel[rel_bucket(j) * 16 + relc0 + h];
            if (s >= 0) { const bf16* kr = P + (size_t)(b * S + s) * ld + ck + kvh * 64; float dot = 0.f;
#pragma unroll
                for (int jj = 0; jj < 8; ++jj) { float kf[8]; ld8bf(kr + 8 * jj, kf);
#pragma unroll
                    for (int i = 0; i < 8; ++i) dot += q[8 * jj + i] * kf[i]; }
                const float lgt = dot * 0.125f + bias, mn = fmaxf(m, lgt), corr = __expf(m - mn), p = __expf(lgt - mn);
                l = l * corr + p; m = mn;
                const bf16* vr = P + (size_t)(b * S + s) * ld + cv + kvh * 64;
#pragma unroll
                for (int jj = 0; jj < 8; ++jj) { float vf[8]; ld8bf(vr + 8 * jj, vf);
#pragma unroll
                    for (int i = 0; i < 8; ++i) acc[8 * jj + i] = acc[8 * jj + i] * corr + p * vf[i]; } } }
        const float inv = 1.f / l;
        float g0 = 0.f, g1 = 0.f, g2 = 1.f;
        if (NSA) { const bf16* gr = P + (size_t)row * ld + C1_GL + h * 3; g0 = 1.f / (1.f + __expf(-bf2f(gr[0]))); g1 = 1.f / (1.f + __expf(-bf2f(gr[1]))); g2 = 1.f / (1.f + __expf(-bf2f(gr[2]))); }
        bf16* orow = P + (size_t)row * ld + cq + h * 64;
#pragma unroll
        for (int jj = 0; jj < 8; ++jj) { float o[8];
#pragma unroll
            for (int i = 0; i < 8; ++i) o[i] = acc[8 * jj + i] * inv;
            if (NSA) { float c8[8], s8[8]; ld8bf(OC + (size_t)row * D + h * 64 + 8 * jj, c8); ld8bf(OS + (size_t)row * D + h * 64 + 8 * jj, s8);
#pragma unroll
                for (int i = 0; i < 8; ++i) o[i] = g0 * c8[i] + g1 * s8[i] + g2 * o[i]; }
            v4u w; w.x = pk2(o[0], o[1]); w.y = pk2(o[2], o[3]); w.z = pk2(o[4], o[5]); w.w = pk2(o[6], o[7]);
            *(v4u*)(orow + 8 * jj) = w; }
    }
}

__device__ __forceinline__ void xattn_phase(const Frame& F, const bf16* Q, const bf16* KV, bf16* O) {
    for (int it = F.gw; it < NB * 4 * (S / 32); it += F.NGW) {
        const int tg = it % (S / 32), h = (it / (S / 32)) % 4, b = it / ((S / 32) * 4);
        const int tok = tg * 32 + (F.lane >> 1), half = F.lane & 1, row = b * S + tok;
        float q[64], acc[64];
        { const bf16* qr = Q + (size_t)row * 512 + h * 128 + half * 64;
#pragma unroll
          for (int j = 0; j < 8; ++j) ld8bf(qr + 8 * j, q + 8 * j); }
#pragma unroll
        for (int d = 0; d < 64; ++d) acc[d] = 0.f;
        float m = -1.0e30f, l = 0.f;
#pragma unroll 1
        for (int mm = 0; mm < MEML; ++mm) { const bf16* kr = KV + (size_t)(b * MEML + mm) * 1024 + h * 128 + half * 64; float dot = 0.f;
#pragma unroll
            for (int jj = 0; jj < 8; ++jj) { float kf[8]; ld8bf(kr + 8 * jj, kf);
#pragma unroll
                for (int i = 0; i < 8; ++i) dot += q[8 * jj + i] * kf[i]; }
            dot += __shfl_xor(dot, 1);
            const float lgt = dot * 0.08838834764831845f, mn = fmaxf(m, lgt), corr = __expf(m - mn), p = __expf(lgt - mn);
            l = l * corr + p; m = mn;
            const bf16* vr = kr + 512;
#pragma unroll
            for (int jj = 0; jj < 8; ++jj) { float vf[8]; ld8bf(vr + 8 * jj, vf);
#pragma unroll
                for (int i = 0; i < 8; ++i) acc[8 * jj + i] = acc[8 * jj + i] * corr + p * vf[i]; } }
        const float inv = 1.f / l; bf16* orow = O + (size_t)row * 512 + h * 128 + half * 64;
#pragma unroll
        for (int jj = 0; jj < 8; ++jj) { v4u w; w.x = pk2(acc[8 * jj] * inv, acc[8 * jj + 1] * inv); w.y = pk2(acc[8 * jj + 2] * inv, acc[8 * jj + 3] * inv); w.z = pk2(acc[8 * jj + 4] * inv, acc[8 * jj + 5] * inv); w.w = pk2(acc[8 * jj + 6] * inv, acc[8 * jj + 7] * inv);
            *(v4u*)(orow + 8 * jj) = w; }
    }
}

__device__ __forceinline__ float gelu_tanh(float x) { const float u = 0.7978845608028654f * (x + 0.044715f * x * x * x); return 0.5f * x * (1.f + tanhf(u)); }
__device__ __forceinline__ void cmp_mlp_phase(const Frame& F) {
    const bf16* P1 = (const bf16*)(F.ws + WS_P1);
    LAS float* blk = (LAS float*)F.lds; LAS float* part = blk + 2048; LAS float* hid = part + 512;
    for (int item = blockIdx.x; item < 2 * NB * NCMP * 2; item += F.G) {
        const int g = item & 1, n = (item >> 1) % NCMP, b = ((item >> 1) / NCMP) % NB, which = (item >> 1) / (NCMP * NB);
        const float* pe = which ? F.in[I_OD_PEV] : F.in[I_OD_PEK]; const float* w1 = which ? F.in[I_OD_W1V] : F.in[I_OD_W1K]; const float* w2 = which ? F.in[I_OD_W2V] : F.in[I_OD_W2K];
        bf16* outp = (bf16*)(F.ws + (which ? WS_VC : WS_KC)) + ((size_t)(b * 2 + g) * 128 + n) * 64;
        const int col0 = (which ? C1_VC : C1_KC) + g * 64;
        for (int i = F.tid; i < 2048; i += 512) { const int l = i >> 6, d = i & 63; blk[i] = bf2f(P1[(size_t)(b * S + 16 * n + l) * P1_LD + col0 + d]) + pe[i]; }
        __syncthreads();
        { const int j = F.tid & 127, pp = F.tid >> 7; float a = 0.f; const float* wp = w1 + (size_t)(pp * 512) * 128 + j; const LAS float* bp = blk + pp * 512;
#pragma unroll 8
          for (int kk = 0; kk < 512; ++kk) a += bp[kk] * wp[(size_t)kk * 128];
          part[F.tid] = a; }
        __syncthreads();
        if (F.tid < 128) hid[F.tid] = gelu_tanh((part[F.tid] + part[F.tid + 128]) + (part[F.tid + 256] + part[F.tid + 384]));
        __syncthreads();
        if (F.tid < 64) { float a = 0.f;
#pragma unroll 8
            for (int j = 0; j < 128; ++j) a += hid[j] * w2[j * 64 + F.tid];
            outp[F.tid] = (bf16)f2bf(a); if (n == NCMP - 1) outp[64 + F.tid] = 0; }
        __syncthreads();
    }
}

__device__ __forceinline__ void cmp_attn_phase(const Frame& F) {
    const bf16* P1 = (const bf16*)(F.ws + WS_P1); const float* KC = (const float*)(F.ws + WS_KC); const float* VC = (const float*)(F.ws + WS_VC);
    bf16* OC = (bf16*)(F.ws + WS_OCMP); unsigned* SELM = (unsigned*)(F.ws + WS_SELM); const float* rel = F.in[I_REL];
    LAS float* qs = (LAS float*)(F.lds + F.wave * 8192); LAS float* pl = qs + 512; LAS float* psum = pl + 1024;
    for (int it = F.gw; it < M * 2; it += F.NGW) {
        const int g = it & 1, row = it >> 1, b = row / S, t = row % S;
        const int nv = (t >= 31) ? ((t - 31) / 16 + 1) : 0;
#pragma unroll
        for (int i = 0; i < 8; ++i) qs[F.lane + 64 * i] = bf2f(P1[(size_t)row * P1_LD + C1_Q + g * 512 + F.lane + 64 * i]);
        WAVE_SYNC();
        float lg[2][8]; bool val[2];
#pragma unroll
        for (int kk = 0; kk < 2; ++kk) { const int n = F.lane + 64 * kk; val[kk] = n < nv; const int nn = val[kk] ? n : 0;
            const float* kr = KC + ((size_t)(b * NCMP + nn) * 2 + g) * 64; float a[8];
#pragma unroll
            for (int h = 0; h < 8; ++h) a[h] = 0.f;
#pragma unroll 1
            for (int j = 0; j < 16; ++j) { const f32x4 kv = *(const f32x4*)(kr + 4 * j);
#pragma unroll
                for (int h = 0; h < 8; ++h) a[h] += qs[h * 64 + 4 * j] * kv.x + qs[h * 64 + 4 * j + 1] * kv.y + qs[h * 64 + 4 * j + 2] * kv.z + qs[h * 64 + 4 * j + 3] * kv.w; }
            const int bk = rel_bucket(val[kk] ? (t - (16 * nn + 31)) : 0);
#pragma unroll
            for (int h = 0; h < 8; ++h) lg[kk][h] = val[kk] ? (a[h] * 0.125f + rel[bk * 16 + g * 8 + h]) : -1.0e30f; }
        float ps[2] = {0.f, 0.f};
#pragma unroll
        for (int h = 0; h < 8; ++h) { float m = wave_max(fmaxf(lg[0][h], lg[1][h]));
            float e0 = val[0] ? __expf(lg[0][h] - m) : 0.f, e1 = val[1] ? __expf(lg[1][h] - m) : 0.f;
            const float s = wave_sum(e0 + e1); const float inv = (nv > 0) ? 1.f / s : 0.f; e0 *= inv; e1 *= inv;
            pl[h * 128 + F.lane] = e0; pl[h * 128 + 64 + F.lane] = e1; ps[0] += e0; ps[1] += e1; }
        psum[F.lane] = ps[0]; psum[64 + F.lane] = ps[1];
        WAVE_SYNC();
        float scj = -3.0e38f; bool adm = false;
        if (F.lane < 32) { const int j = F.lane; float p = 0.f;
#pragma unroll
            for (int n = 4 * j - 1; n <= 4 * j + 3; ++n) if (n >= 0 && n < NCMP) p += psum[n];
            const int blkq = t >> 6; adm = (64 * j <= t); const bool forced = (j == 0) || (j == blkq) || (j == blkq - 1);
            scj = adm ? (p + (forced ? 1.0e6f : 0.f)) : -1.0e30f; }
        int rank = 0;
#pragma unroll 1
        for (int i = 0; i < 32; ++i) { const float si = __shfl(scj, i); rank += (si > scj || (si == scj && i < F.lane)) ? 1 : 0; }
        const unsigned long long sm = __ballot(F.lane < 32 && adm && rank < 8);
        if (F.lane == 0) SELM[(size_t)row * 2 + g] = (unsigned)sm;
        float o[8];
#pragma unroll
        for (int h = 0; h < 8; ++h) o[h] = 0.f;
        for (int n = 0; n < nv; ++n) { const float v = VC[((size_t)(b * NCMP + n) * 2 + g) * 64 + F.lane];
#pragma unroll
            for (int h = 0; h < 8; ++h) o[h] += pl[h * 128 + n] * v; }
#pragma unroll
        for (int h = 0; h < 8; ++h) OC[(size_t)row * D + (g * 8 + h) * 64 + F.lane] = (bf16)f2bf(o[h]);
        WAVE_SYNC();
    }
}

__device__ __forceinline__ void slc_attn_phase(const Frame& F) {
    const bf16* P1 = (const bf16*)(F.ws + WS_P1); const unsigned* SELM = (const unsigned*)(F.ws + WS_SELM); bf16* OS = (bf16*)(F.ws + WS_OSLC); const float* rel = F.in[I_REL];
    LAS float* qs = (LAS float*)(F.lds + F.wave * 4096); LAS float* pb = qs + 512;
    for (int it = F.gw; it < M * 2; it += F.NGW) {
        const int g = it & 1, row = it >> 1, b = row / S, t = row % S;
#pragma unroll
        for (int i = 0; i < 8; ++i) qs[F.lane + 64 * i] = bf2f(P1[(size_t)row * P1_LD + C1_Q + g * 512 + F.lane + 64 * i]);
        WAVE_SYNC();
        unsigned sel = SELM[(size_t)row * 2 + g];
        float m[8], l[8], acc[8];
#pragma unroll
        for (int h = 0; h < 8; ++h) { m[h] = -1.0e30f; l[h] = 0.f; acc[h] = 0.f; }
        while (sel) { const int jb = __ffs(sel) - 1; sel &= sel - 1u;
            const int kpos = 64 * jb + F.lane; const bool valid = kpos <= t;
            const bf16* kr = P1 + (size_t)(b * S + kpos) * P1_LD + C1_KS + g * 64; float a[8];
#pragma unroll
            for (int h = 0; h < 8; ++h) a[h] = 0.f;
#pragma unroll 1
            for (int j = 0; j < 8; ++j) { float kf[8]; ld8bf(kr + 8 * j, kf);
#pragma unroll
                for (int h = 0; h < 8; ++h)
#pragma unroll
                    for (int i = 0; i < 8; ++i) a[h] += qs[h * 64 + 8 * j + i] * kf[i]; }
            const int bk = rel_bucket(valid ? (t - kpos) : 0);
            float corr[8];
#pragma unroll
            for (int h = 0; h < 8; ++h) { const float lgt = valid ? (a[h] * 0.125f + rel[bk * 16 + g * 8 + h]) : -1.0e30f;
                const float bm = wave_max(lgt), mn = fmaxf(m[h], bm); corr[h] = __expf(m[h] - mn); const float p = valid ? __expf(lgt - mn) : 0.f;
                l[h] = l[h] * corr[h] + wave_sum(p); m[h] = mn; pb[h * 64 + F.lane] = p; }
            WAVE_SYNC();
            const bf16* vb = P1 + (size_t)(b * S + 64 * jb) * P1_LD + C1_VS + g * 64 + F.lane;
            float add[8];
#pragma unroll
            for (int h = 0; h < 8; ++h) add[h] = 0.f;
            for (int k = 0; k < 64; ++k) { const float v = bf2f(vb[(size_t)k * P1_LD]);
#pragma unroll
                for (int h = 0; h < 8; ++h) add[h] += pb[h * 64 + k] * v; }
#pragma unroll
            for (int h = 0; h < 8; ++h) acc[h] = acc[h] * corr[h] + add[h];
            WAVE_SYNC();
        }
#pragma unroll
        for (int h = 0; h < 8; ++h) OS[(size_t)row * D + (g * 8 + h) * 64 + F.lane] = (bf16)f2bf(acc[h] / l[h]);
    }
}

namespace fa {
typedef short bf16x8 __attribute__((ext_vector_type(8)));
typedef short bf16x4 __attribute__((ext_vector_type(4)));
typedef float f32x16 __attribute__((ext_vector_type(16)));
constexpr int VSTR = 68;
template <int HDK, int HDV> struct Geo { static constexpr int KSTR = HDK + 8, KBYTES = 64 * KSTR * 2, VBYTES = HDV * VSTR * 2, BUF = KBYTES + VBYTES; };
template <int HDK, int HDV, bool KV_SAME> struct Stage { v4u k[HDK / 64]; v4u v[KV_SAME ? 1 : HDV / 64]; };

template <int HDK, int HDV, bool KV_SAME, class P>
__device__ __forceinline__ void load_tile(Stage<HDK, HDV, KV_SAME>& st, const P& pol, int j, int tid) {
#pragma unroll
    for (int i = 0; i < HDK / 64; ++i) { const int c = tid + 512 * i, r = c / (HDK / 8), ch = c % (HDK / 8); st.k[i] = *(const v4u*)(pol.krow(j, r) + 8 * ch); }
    if (!KV_SAME) {
#pragma unroll
        for (int i = 0; i < HDV / 64; ++i) { const int c = tid + 512 * i, r = c / (HDV / 8), ch = c % (HDV / 8); st.v[i] = *(const v4u*)(pol.vrow(j, r) + 8 * ch); }
    }
}
template <int HDK, int HDV, bool KV_SAME>
__device__ __forceinline__ void store_tile(const Stage<HDK, HDV, KV_SAME>& st, LAS unsigned char* buf, int tid) {
    typedef Geo<HDK, HDV> G;
    LAS bf16* Ks = (LAS bf16*)buf; LAS bf16* Vt = (LAS bf16*)(buf + G::KBYTES);
#pragma unroll
    for (int i = 0; i < HDK / 64; ++i) { const int c = tid + 512 * i, r = c / (HDK / 8), ch = c % (HDK / 8); *(LAS v4u*)(Ks + r * G::KSTR + 8 * ch) = st.k[i]; }
#pragma unroll
    for (int i = 0; i < HDV / 64; ++i) { const int c = tid + 512 * i, r = c / (HDV / 8), ch = c % (HDV / 8); const v4u w = KV_SAME ? st.k[i] : st.v[i];
        LAS bf16* vp = Vt + (8 * ch) * VSTR + r;
        vp[0 * VSTR] = (bf16)(w.x & 0xffffu); vp[1 * VSTR] = (bf16)(w.x >> 16); vp[2 * VSTR] = (bf16)(w.y & 0xffffu); vp[3 * VSTR] = (bf16)(w.y >> 16);
        vp[4 * VSTR] = (bf16)(w.z & 0xffffu); vp[5 * VSTR] = (bf16)(w.z >> 16); vp[6 * VSTR] = (bf16)(w.w & 0xffffu); vp[7 * VSTR] = (bf16)(w.w >> 16); }
}
template <int HDK, int HDV, class P>
__device__ __forceinline__ void compute_tile(const LAS unsigned char* buf, const P& pol, int j, int lane, const bf16x8 (&qf)[HDK / 16], f32x16 (&o)[HDV / 32], float& m, float& l) {
    typedef Geo<HDK, HDV> G;
    const LAS bf16* Ks = (const LAS bf16*)buf; const LAS bf16* Vt = (const LAS bf16*)(buf + G::KBYTES);
    const int r = lane & 31, h = lane >> 5;
    f32x16 s[2];
#pragma unroll
    for (int kb = 0; kb < 2; ++kb) {
#pragma unroll
        for (int e = 0; e < 16; ++e) s[kb][e] = 0.f;
#pragma unroll
        for (int ks = 0; ks < HDK / 16; ++ks) { const bf16x8 a = *(const LAS bf16x8*)(Ks + (32 * kb + r) * G::KSTR + 16 * ks + 8 * h);
            s[kb] = __builtin_amdgcn_mfma_f32_32x32x16_bf16(a, qf[ks], s[kb], 0, 0, 0); }
    }
    pol.transform(j, s, lane);
    float mx = -INFINITY;
#pragma unroll
    for (int kb = 0; kb < 2; ++kb)
#pragma unroll
        for (int e = 0; e < 16; ++e) mx = fmaxf(mx, s[kb][e]);
    mx = fmaxf(mx, __shfl_xor(mx, 32));
    const float mn = fmaxf(m, mx), mref = (mn == -INFINITY) ? 0.f : mn;
    const float corr = __expf(m - mref);
    float rs = 0.f;
#pragma unroll
    for (int kb = 0; kb < 2; ++kb)
#pragma unroll
        for (int e = 0; e < 16; ++e) { s[kb][e] = __expf(s[kb][e] - mref); rs += s[kb][e]; }
    rs += __shfl_xor(rs, 32);
    l = l * corr + rs; m = mn;
#pragma unroll
    for (int blk = 0; blk < HDV / 32; ++blk)
#pragma unroll
        for (int e = 0; e < 16; ++e) o[blk][e] *= corr;
#pragma unroll
    for (int kb = 0; kb < 2; ++kb)
#pragma unroll
        for (int s2 = 0; s2 < 2; ++s2) {
            v4u pw; pw.x = pg8::cvt_pk_bf16(s[kb][8 * s2 + 0], s[kb][8 * s2 + 1]); pw.y = pg8::cvt_pk_bf16(s[kb][8 * s2 + 2], s[kb][8 * s2 + 3]);
            pw.z = pg8::cvt_pk_bf16(s[kb][8 * s2 + 4], s[kb][8 * s2 + 5]); pw.w = pg8::cvt_pk_bf16(s[kb][8 * s2 + 6], s[kb][8 * s2 + 7]);
            const bf16x8 pf = __builtin_bit_cast(bf16x8, pw);
#pragma unroll
            for (int blk = 0; blk < HDV / 32; ++blk) { const LAS bf16* vp = Vt + (32 * blk + r) * VSTR + 32 * kb + 16 * s2 + 4 * h;
                const bf16x4 lo = *(const LAS bf16x4*)vp, hi = *(const LAS bf16x4*)(vp + 8);
                const bf16x8 a = __builtin_shufflevector(lo, hi, 0, 1, 2, 3, 4, 5, 6, 7);
                o[blk] = __builtin_amdgcn_mfma_f32_32x32x16_bf16(a, pf, o[blk], 0, 0, 0); }
        }
}
template <int HDK, int HDV, bool KV_SAME, class P>
__device__ __forceinline__ void run(LAS unsigned char* lds, const P& pol, unsigned tmask, int tid, int lane, const bf16x8 (&qf)[HDK / 16], f32x16 (&o)[HDV / 32], float& m, float& l) {
    typedef Geo<HDK, HDV> G;
    if (tmask == 0u) return;
    Stage<HDK, HDV, KV_SAME> st;
    int j = __builtin_ctz(tmask); tmask &= tmask - 1u; int cur = 0;
    load_tile<HDK, HDV, KV_SAME>(st, pol, j, tid); store_tile<HDK, HDV, KV_SAME>(st, lds, tid);
    __syncthreads();
    for (;;) {
        const bool more = tmask != 0u; int jn = 0;
        if (more) { jn = __builtin_ctz(tmask); tmask &= tmask - 1u; load_tile<HDK, HDV, KV_SAME>(st, pol, jn, tid); }
        compute_tile<HDK, HDV>(lds + cur * G::BUF, pol, j, lane, qf, o, m, l);
        if (!more) break;
        store_tile<HDK, HDV, KV_SAME>(st, lds + (cur ^ 1) * G::BUF, tid);
        __syncthreads();
        cur ^= 1; j = jn;
    }
    __syncthreads();
}
}

__device__ __forceinline__ void build_bias_table(const Frame& F, LAS float* tab, int nheads, int relc0) {
    const float* rel = F.in[I_REL];
    for (int i = F.tid; i < nheads * 129; i += 512) { const int hh = i / 129, d = i % 129; tab[hh * 132 + d] = rel[rel_bucket(d) * 16 + relc0 + hh]; }
    __syncthreads();
}
struct BandPol {
    const bf16* kbase; const bf16* vbase; int ld; int tq, tq0, W; const LAS float* bl;
    __device__ __forceinline__ const bf16* krow(int j, int r) const { return kbase + (size_t)(64 * j + r) * ld; }
    __device__ __forceinline__ const bf16* vrow(int j, int r) const { return vbase + (size_t)(64 * j + r) * ld; }
    __device__ __forceinline__ void transform(int j, fa::f32x16 (&s)[2], int lane) const {
        const int k0 = 64 * j, h = lane >> 5;
        if (tq0 - (k0 + 63) >= 128 && (tq0 + 31) - k0 < W) {
            const float b31 = bl[128];
#pragma unroll
            for (int kb = 0; kb < 2; ++kb)
#pragma unroll
                for (int e = 0; e < 16; ++e) s[kb][e] = s[kb][e] * 0.125f + b31;
        } else {
#pragma unroll
            for (int kb = 0; kb < 2; ++kb)
#pragma unroll
                for (int e = 0; e < 16; ++e) { const int key = k0 + 32 * kb + 8 * (e >> 2) + 4 * h + (e & 3); const int dist = tq - key;
                    const int di = dist < 0 ? 0 : (dist > 128 ? 128 : dist);
                    const float v = s[kb][e] * 0.125f + bl[di];
                    s[kb][e] = (dist >= 0 && dist < W) ? v : -INFINITY; }
        }
    }
};
__device__ __forceinline__ void win_phase_mfma(const Frame& F) {
    bf16* P1 = (bf16*)(F.ws + WS_P1); const bf16* OC = (const bf16*)(F.ws + WS_OCMP); const bf16* OS = (const bf16*)(F.ws + WS_OSLC);
    LAS float* tab = (LAS float*)(F.lds + 36864);
    build_bias_table(F, tab, 16, 0);
    const int h = F.lane >> 5;
    for (int u = blockIdx.x; u < NB * 2 * 64; u += F.G) {
        const int b = u >> 7, g = (u >> 6) & 1, qt = u & 63, tq0 = 32 * qt, head = g * 8 + F.wave, tq = tq0 + (F.lane & 31);
        const size_t row = (size_t)b * S + tq;
        fa::bf16x8 qf[4];
#pragma unroll
        for (int ks = 0; ks < 4; ++ks) qf[ks] = *(const fa::bf16x8*)(P1 + row * P1_LD + C1_Q + head * 64 + 16 * ks + 8 * h);
        fa::f32x16 o[2];
#pragma unroll
        for (int blk = 0; blk < 2; ++blk)
#pragma unroll
            for (int e = 0; e < 16; ++e) o[blk][e] = 0.f;
        float m = -INFINITY, l = 0.f;
        const int jlo = (tq0 - 511 > 0 ? tq0 - 511 : 0) >> 6, jhi = (tq0 + 31) >> 6;
        const unsigned tmask = (jhi >= 31 ? 0xffffffffu : ((1u << (jhi + 1)) - 1u)) & ~((1u << jlo) - 1u);
        BandPol pol{P1 + (size_t)b * S * P1_LD + C1_KW + g * 64, P1 + (size_t)b * S * P1_LD + C1_VW + g * 64, P1_LD, tq, tq0, 512, tab + head * 132};
        fa::run<64, 64, false>(F.lds, pol, tmask, F.tid, F.lane, qf, o, m, l);
        const float inv = 1.f / l;
        const bf16* gr = P1 + row * P1_LD + C1_GL + head * 3;
        const float g0 = 1.f / (1.f + __expf(-bf2f(gr[0]))), g1 = 1.f / (1.f + __expf(-bf2f(gr[1]))), g2 = 1.f / (1.f + __expf(-bf2f(gr[2])));
#pragma unroll
        for (int blk = 0; blk < 2; ++blk)
#pragma unroll
            for (int jj = 0; jj < 4; ++jj) { const int d0 = 32 * blk + 8 * jj + 4 * h;
                const v2u cw = *(const v2u*)(OC + row * D + head * 64 + d0), sw = *(const v2u*)(OS + row * D + head * 64 + d0);
                const float r0 = g0 * bflo(cw.x) + g1 * bflo(sw.x) + g2 * o[blk][4 * jj + 0] * inv, r1 = g0 * bfhi(cw.x) + g1 * bfhi(sw.x) + g2 * o[blk][4 * jj + 1] * inv;
                const float r2 = g0 * bflo(cw.y) + g1 * bflo(sw.y) + g2 * o[blk][4 * jj + 2] * inv, r3 = g0 * bfhi(cw.y) + g1 * bfhi(sw.y) + g2 * o[blk][4 * jj + 3] * inv;
                v2u ow; ow.x = pk2(r0, r1); ow.y = pk2(r2, r3);
                *(v2u*)(P1 + row * P1_LD + C1_Q + head * 64 + d0) = ow; }
    }
}
__device__ __forceinline__ void swa_phase_mfma(const Frame& F) {
    bf16* P0 = (bf16*)(F.ws + WS_P0); const float* sinks = F.in[I_EV_SINK];
    LAS float* tab = (LAS float*)(F.lds + 36864);
    build_bias_table(F, tab, 8, 8);
    const int h = F.lane >> 5;
    for (int u = blockIdx.x; u < NB * 2 * 32; u += F.G) {
        const int b = u >> 6, kvh = (u >> 5) & 1, t0 = 64 * (u & 31), head = kvh * 4 + (F.wave & 3), tq0 = t0 + 32 * (F.wave >> 2), tq = tq0 + (F.lane & 31);
        const size_t row = (size_t)b * S + tq;
        fa::bf16x8 qf[4];
#pragma unroll
        for (int ks = 0; ks < 4; ++ks) qf[ks] = *(const fa::bf16x8*)(P0 + row * P0_LD + C0_QB + head * 64 + 16 * ks + 8 * h);
        fa::f32x16 o[2];
#pragma unroll
        for (int blk = 0; blk < 2; ++blk)
#pragma unroll
            for (int e = 0; e < 16; ++e) o[blk][e] = 0.f;
        float m = sinks[head], l = 1.f;
        const int jlo = (t0 - 127 > 0 ? t0 - 127 : 0) >> 6, jhi = t0 >> 6;
        const unsigned tmask = (jhi >= 31 ? 0xffffffffu : ((1u << (jhi + 1)) - 1u)) & ~((1u << jlo) - 1u);
        BandPol pol{P0 + (size_t)b * S * P0_LD + C0_KB + kvh * 64, P0 + (size_t)b * S * P0_LD + C0_VB + kvh * 64, P0_LD, tq, tq0, 128, tab + head * 132};
        fa::run<64, 64, false>(F.lds, pol, tmask, F.tid, F.lane, qf, o, m, l);
        const float inv = 1.f / l;
#pragma unroll
        for (int blk = 0; blk < 2; ++blk)
#pragma unroll
            for (int jj = 0; jj < 4; ++jj) { const int d0 = 32 * blk + 8 * jj + 4 * h;
                v2u ow; ow.x = pk2(o[blk][4 * jj + 0] * inv, o[blk][4 * jj + 1] * inv); ow.y = pk2(o[blk][4 * jj + 2] * inv, o[blk][4 * jj + 3] * inv);
                *(v2u*)(P0 + row * P0_LD + C0_QB + head * 64 + d0) = ow; }
    }
}

struct XaPol {
    const bf16* kbase;
    __device__ __forceinline__ const bf16* krow(int j, int r) const { return kbase + (size_t)(64 * j + r) * 1024; }
    __device__ __forceinline__ const bf16* vrow(int j, int r) const { return kbase + (size_t)(64 * j + r) * 1024 + 512; }
    __device__ __forceinline__ void transform(int, fa::f32x16 (&s)[2], int) const {
#pragma unroll
        for (int kb = 0; kb < 2; ++kb)
#pragma unroll
            for (int e = 0; e < 16; ++e) s[kb][e] *= 0.08838834764831845f;
    }
};
__device__ __forceinline__ void xattn_phase_mfma(const Frame& F, const bf16* Q, const bf16* KV, bf16* O) {
    const int h = F.lane >> 5;
    for (int u = blockIdx.x; u < NB * 4 * 8; u += F.G) {
        const int b = u >> 5, head = (u >> 3) & 3, qt = u & 7, tq = 256 * qt + 32 * F.wave + (F.lane & 31);
        const size_t row = (size_t)b * S + tq;
        fa::bf16x8 qf[8];
#pragma unroll
        for (int ks = 0; ks < 8; ++ks) qf[ks] = *(const fa::bf16x8*)(Q + row * 512 + head * 128 + 16 * ks + 8 * h);
        fa::f32x16 o[4];
#pragma unroll
        for (int blk = 0; blk < 4; ++blk)
#pragma unroll
            for (int e = 0; e < 16; ++e) o[blk][e] = 0.f;
        float m = -INFINITY, l = 0.f;
        XaPol pol{KV + (size_t)b * MEML * 1024 + head * 128};
        fa::run<128, 128, false>(F.lds, pol, 0xFu, F.tid, F.lane, qf, o, m, l);
        const float inv = 1.f / l;
#pragma unroll
        for (int blk = 0; blk < 4; ++blk)
#pragma unroll
            for (int jj = 0; jj < 4; ++jj) { const int d0 = 32 * blk + 8 * jj + 4 * h;
                v2u ow; ow.x = pk2(o[blk][4 * jj + 0] * inv, o[blk][4 * jj + 1] * inv); ow.y = pk2(o[blk][4 * jj + 2] * inv, o[blk][4 * jj + 3] * inv);
                *(v2u*)(O + row * 512 + head * 128 + d0) = ow; }
    }
}
struct DsaPol {
    const bf16* cbase; const unsigned* mrow; int tq; const LAS float* bl;
    __device__ __forceinline__ const bf16* krow(int j, int r) const { return cbase + (size_t)(64 * j + r) * 128; }
    __device__ __forceinline__ const bf16* vrow(int j, int r) const { return krow(j, r); }
    __device__ __forceinline__ void transform(int j, fa::f32x16 (&s)[2], int lane) const {
        const int k0 = 64 * j, h = lane >> 5; const v2u mw = *(const v2u*)(mrow + 2 * j);
#pragma unroll
        for (int kb = 0; kb < 2; ++kb) { const unsigned w = kb ? mw.y : mw.x;
#pragma unroll
            for (int e = 0; e < 16; ++e) { const int kin = 8 * (e >> 2) + 4 * h + (e & 3); const int dist = tq - (k0 + 32 * kb + kin);
                const int di = dist < 0 ? 0 : (dist > 128 ? 128 : dist);
                const float v = s[kb][e] * 0.125f + bl[di];
                s[kb][e] = ((w >> kin) & 1u) ? v : -INFINITY; } }
    }
};
__device__ __forceinline__ void dsa_phase_mfma(const Frame& F) {
    bf16* P0 = (bf16*)(F.ws + WS_P0); const bf16* CN = (const bf16*)(F.ws + WS_CN); const unsigned* MASK = (const unsigned*)(F.ws + WS_MASK);
    LAS float* tab = (LAS float*)(F.lds + 73728);
    build_bias_table(F, tab, 8, 0);
    const int h = F.lane >> 5;
    for (int u = blockIdx.x; u < NB * 64; u += F.G) {
        const int rr = u / F.G, c = u % F.G; const int qt = (rr & 1) ? 63 - (c & 63) : (c & 63), b = (rr * (F.G >> 6) + (c >> 6)) % NB;
        const int tq0 = 32 * qt, tq = tq0 + (F.lane & 31), head = F.wave;
        const size_t row = (size_t)b * S + tq;
        fa::bf16x8 qf[8];
#pragma unroll
        for (int ks = 0; ks < 8; ++ks) qf[ks] = *(const fa::bf16x8*)(P0 + row * P0_LD + C0_QLAT + head * 128 + 16 * ks + 8 * h);
        fa::f32x16 o[4];
#pragma unroll
        for (int blk = 0; blk < 4; ++blk)
#pragma unroll
            for (int e = 0; e < 16; ++e) o[blk][e] = 0.f;
        float m = -INFINITY, l = 0.f;
        const int jhi = (tq0 + 31) >> 6; const unsigned tmask = jhi >= 31 ? 0xffffffffu : ((1u << (jhi + 1)) - 1u);
        DsaPol pol{CN + (size_t)b * S * 128, MASK + row * 64, tq, tab + head * 132};
        fa::run<128, 128, true>(F.lds, pol, tmask, F.tid, F.lane, qf, o, m, l);
        const float inv = 1.f / l;
#pragma unroll
        for (int blk = 0; blk < 4; ++blk)
#pragma unroll
            for (int jj = 0; jj < 4; ++jj) { const int d0 = 32 * blk + 8 * jj + 4 * h;
                v2u ow; ow.x = pk2(o[blk][4 * jj + 0] * inv, o[blk][4 * jj + 1] * inv); ow.y = pk2(o[blk][4 * jj + 2] * inv, o[blk][4 * jj + 3] * inv);
                *(v2u*)(P0 + row * P0_LD + C0_QLAT + head * 128 + d0) = ow; }
    }
}
struct SlcPol {
    const bf16* kbase; const bf16* vbase; unsigned sel; int tq; const LAS float* bl;
    __device__ __forceinline__ const bf16* krow(int j, int r) const { return kbase + (size_t)(64 * j + r) * P1_LD; }
    __device__ __forceinline__ const bf16* vrow(int j, int r) const { return vbase + (size_t)(64 * j + r) * P1_LD; }
    __device__ __forceinline__ void transform(int j, fa::f32x16 (&s)[2], int lane) const {
        const int k0 = 64 * j, h = lane >> 5; const bool on = (sel >> j) & 1u;
#pragma unroll
        for (int kb = 0; kb < 2; ++kb)
#pragma unroll
            for (int e = 0; e < 16; ++e) { const int dist = tq - (k0 + 32 * kb + 8 * (e >> 2) + 4 * h + (e & 3));
                const int di = dist < 0 ? 0 : (dist > 128 ? 128 : dist);
                const float v = s[kb][e] * 0.125f + bl[di];
                s[kb][e] = (on && dist >= 0) ? v : -INFINITY; }
    }
};
__device__ __forceinline__ void slc_phase_mfma(const Frame& F) {
    const bf16* P1 = (const bf16*)(F.ws + WS_P1); const unsigned* SELM = (const unsigned*)(F.ws + WS_SELM); bf16* OS = (bf16*)(F.ws + WS_OSLC);
    LAS float* tab = (LAS float*)(F.lds + 36864);
    build_bias_table(F, tab, 16, 0);
    const int h = F.lane >> 5;
    for (int u = blockIdx.x; u < NB * 2 * 64; u += F.G) {
        const int rr = u / F.G, c = u % F.G; const int qt = (rr & 1) ? 63 - (c & 63) : (c & 63), bg = (rr * (F.G >> 6) + (c >> 6)) % (NB * 2), b = bg >> 1, g = bg & 1;
        const int tq0 = 32 * qt, tq = tq0 + (F.lane & 31), head = g * 8 + F.wave;
        const size_t row = (size_t)b * S + tq;
        fa::bf16x8 qf[4];
#pragma unroll
        for (int ks = 0; ks < 4; ++ks) qf[ks] = *(const fa::bf16x8*)(P1 + row * P1_LD + C1_Q + head * 64 + 16 * ks + 8 * h);
        fa::f32x16 o[2];
#pragma unroll
        for (int blk = 0; blk < 2; ++blk)
#pragma unroll
            for (int e = 0; e < 16; ++e) o[blk][e] = 0.f;
        float m = -INFINITY, l = 0.f;
        const unsigned sel = SELM[row * 2 + g]; unsigned tm = sel;
#pragma unroll
        for (int of = 1; of < 32; of <<= 1) tm |= (unsigned)__shfl_xor((int)tm, of);
        tm = (unsigned)__builtin_amdgcn_readfirstlane((int)tm);
        SlcPol pol{P1 + (size_t)b * S * P1_LD + C1_KS + g * 64, P1 + (size_t)b * S * P1_LD + C1_VS + g * 64, sel, tq, tab + head * 132};
        fa::run<64, 64, false>(F.lds, pol, tm, F.tid, F.lane, qf, o, m, l);
        const float inv = 1.f / l;
#pragma unroll
        for (int blk = 0; blk < 2; ++blk)
#pragma unroll
            for (int jj = 0; jj < 4; ++jj) { const int d0 = 32 * blk + 8 * jj + 4 * h;
                v2u ow; ow.x = pk2(o[blk][4 * jj + 0] * inv, o[blk][4 * jj + 1] * inv); ow.y = pk2(o[blk][4 * jj + 2] * inv, o[blk][4 * jj + 3] * inv);
                *(v2u*)(OS + row * D + head * 64 + d0) = ow; }
    }
}

__device__ __forceinline__ void idx_phase_mfma(const Frame& F) {
    const bf16* P0 = (const bf16*)(F.ws + WS_P0); unsigned* MASK = (unsigned*)(F.ws + WS_MASK);
    LAS float* sc = (LAS float*)F.lds;
    const int r = F.lane & 31, hh = F.lane >> 5;
    const int head_r = (r & 3) + 4 * ((r >> 3) & 1), ql_r = 2 * (r >> 4) + ((r >> 2) & 1);
    for (int item = blockIdx.x; item < NB * (S / 8); item += F.G) {
        const int b = item / (S / 8), t0 = (item % (S / 8)) * 8;
        const int rb = F.wave & 1, kq = F.wave >> 1;
        fa::bf16x8 qa[4];
        { const bf16* qp = P0 + (size_t)(b * S + t0 + 4 * rb + ql_r) * P0_LD + C0_QI + head_r * 64 + 8 * hh;
#pragma unroll
          for (int ks = 0; ks < 4; ++ks) qa[ks] = *(const fa::bf16x8*)(qp + 16 * ks); }
        float wv[2][8];
#pragma unroll
        for (int qq = 0; qq < 2; ++qq) { ld8bf(P0 + (size_t)(b * S + t0 + 4 * rb + 2 * qq + hh) * P0_LD + C0_WI, wv[qq]);
#pragma unroll
            for (int e = 0; e < 8; ++e) wv[qq][e] *= (0.35355339059f * 0.125f); }
        const int nkb = (t0 + 8 + 31) >> 5;
        for (int kb = kq; kb < nkb; kb += 4) {
            const bf16* kp = P0 + (size_t)(b * S + 32 * kb + r) * P0_LD + C0_KI + 8 * hh;
            fa::f32x16 c;
#pragma unroll
            for (int e = 0; e < 16; ++e) c[e] = 0.f;
#pragma unroll
            for (int ks = 0; ks < 4; ++ks) { const fa::bf16x8 kf = *(const fa::bf16x8*)(kp + 16 * ks); c = __builtin_amdgcn_mfma_f32_32x32x16_bf16(qa[ks], kf, c, 0, 0, 0); }
            float s0 = 0.f, s1 = 0.f;
#pragma unroll
            for (int e = 0; e < 8; ++e) { s0 += wv[0][e] * fmaxf(c[e], 0.f); s1 += wv[1][e] * fmaxf(c[8 + e], 0.f); }
            sc[(4 * rb + hh) * 2048 + 32 * kb + r] = s0; sc[(4 * rb + 2 + hh) * 2048 + 32 * kb + r] = s1;
        }
        __syncthreads();
        {
            const int q = F.wave, t = t0 + q, n = t + 1, row = b * S + t; unsigned myword = 0u;
            if (n <= 256) { const int cb = n - 32 * F.lane; myword = cb >= 32 ? 0xffffffffu : (cb <= 0 ? 0u : ((1u << cb) - 1u)); }
            else {
                LAS unsigned* uk = (LAS unsigned*)(sc + q * 2048);
#pragma unroll 4
                for (int i = 0; i < 32; ++i) { const int s = F.lane + 64 * i; const unsigned k = (s < n) ? fkey(sc[q * 2048 + s]) : 0u; uk[s] = k; }
                LDS_WAIT();
                unsigned prefix = 0u;
#pragma unroll 1
                for (int bit = 31; bit >= 0; --bit) { const unsigned cand = prefix | (1u << bit); int c = 0;
#pragma unroll 8
                    for (int i = 0; i < 32; ++i) c += (uk[F.lane + 64 * i] >= cand) ? 1 : 0;
#pragma unroll
                    for (int o = 1; o < 64; o <<= 1) c += __shfl_xor(c, o);
                    if (c >= 256) prefix = cand; }
                int cgt = 0;
#pragma unroll 8
                for (int i = 0; i < 32; ++i) cgt += (uk[F.lane + 64 * i] > prefix) ? 1 : 0;
#pragma unroll
                for (int o = 1; o < 64; o <<= 1) cgt += __shfl_xor(cgt, o);
                const int need = 256 - cgt; int run = 0;
#pragma unroll 1
                for (int i = 0; i < 32; ++i) { const unsigned u = uk[F.lane + 64 * i]; const bool eq = (u == prefix); const unsigned long long em = __ballot(eq); const int rank = run + __popcll(em & ((1ull << F.lane) - 1ull));
                    const bool sel = (u > prefix) || (eq && rank < need); run += __popcll(em);
                    const unsigned long long sm = __ballot(sel);
                    if (F.lane == 2 * i) myword = (unsigned)sm; if (F.lane == 2 * i + 1) myword = (unsigned)(sm >> 32); }
            }
            MASK[(size_t)row * 64 + F.lane] = myword;
        }
        __syncthreads();
    }
}
__device__ __forceinline__ void cmp_phase_mfma(const Frame& F) {
    typedef fa::Geo<64, 64> G;
    const bf16* P1 = (const bf16*)(F.ws + WS_P1); const bf16* KC = (const bf16*)(F.ws + WS_KC); const bf16* VC = (const bf16*)(F.ws + WS_VC);
    bf16* OC = (bf16*)(F.ws + WS_OCMP); unsigned* SELM = (unsigned*)(F.ws + WS_SELM);
    LAS float* tab = (LAS float*)(F.lds + 36864); LAS float* part = (LAS float*)(F.lds + 49152);
    build_bias_table(F, tab, 16, 0);
    const int r = F.lane & 31, h = F.lane >> 5;
    for (int u = blockIdx.x; u < NB * 2 * 64; u += F.G) {
        const int b = u >> 7, g = (u >> 6) & 1, qt = u & 63, tq0 = 32 * qt, head = g * 8 + F.wave, tq = tq0 + r;
        const size_t row = (size_t)b * S + tq;
        const int nv = (tq >= 31) ? ((tq - 31) / 16 + 1) : 0;
        const int ntile = (tq0 >= 1024) ? 2 : 1;
        {
            struct CPol { const bf16* kb; const bf16* vb; __device__ __forceinline__ const bf16* krow(int j, int rr) const { return kb + (size_t)(64 * j + rr) * 64; } __device__ __forceinline__ const bf16* vrow(int j, int rr) const { return vb + (size_t)(64 * j + rr) * 64; } };
            CPol cp{KC + (size_t)(b * 2 + g) * 128 * 64, VC + (size_t)(b * 2 + g) * 128 * 64};
            for (int t = 0; t < ntile; ++t) { fa::Stage<64, 64, false> st; fa::load_tile<64, 64, false>(st, cp, t, F.tid); fa::store_tile<64, 64, false>(st, F.lds + t * G::BUF, F.tid); }
        }
        fa::bf16x8 qf[4];
#pragma unroll
        for (int ks = 0; ks < 4; ++ks) qf[ks] = *(const fa::bf16x8*)(P1 + row * P1_LD + C1_Q + head * 64 + 16 * ks + 8 * h);
        __syncthreads();
        fa::f32x16 s[2][2];
        const LAS float* bl = tab + head * 132;
#pragma unroll
        for (int t = 0; t < 2; ++t) {
            const LAS bf16* Ks = (const LAS bf16*)(F.lds + t * G::BUF);
#pragma unroll
            for (int kb = 0; kb < 2; ++kb) {
#pragma unroll
                for (int e = 0; e < 16; ++e) s[t][kb][e] = 0.f;
                if (t < ntile) {
#pragma unroll
                    for (int ks = 0; ks < 4; ++ks) { const fa::bf16x8 a = *(const LAS fa::bf16x8*)(Ks + (32 * kb + r) * G::KSTR + 16 * ks + 8 * h); s[t][kb] = __builtin_amdgcn_mfma_f32_32x32x16_bf16(a, qf[ks], s[t][kb], 0, 0, 0); }
                }
#pragma unroll
                for (int e = 0; e < 16; ++e) { const int n = 64 * t + 32 * kb + 8 * (e >> 2) + 4 * h + (e & 3); const int dist = tq - (16 * n + 31); const int di = dist < 0 ? 0 : (dist > 128 ? 128 : dist);
                    s[t][kb][e] = (n < nv) ? (s[t][kb][e] * 0.125f + bl[di]) : -INFINITY; }
            }
        }
        float mx = -INFINITY;
#pragma unroll
        for (int t = 0; t < 2; ++t)
#pragma unroll
            for (int kb = 0; kb < 2; ++kb)
#pragma unroll
                for (int e = 0; e < 16; ++e) mx = fmaxf(mx, s[t][kb][e]);
        mx = fmaxf(mx, __shfl_xor(mx, 32));
        const float mref = (mx == -INFINITY) ? 0.f : mx; float rs = 0.f;
#pragma unroll
        for (int t = 0; t < 2; ++t)
#pragma unroll
            for (int kb = 0; kb < 2; ++kb)
#pragma unroll
                for (int e = 0; e < 16; ++e) { s[t][kb][e] = __expf(s[t][kb][e] - mref); rs += s[t][kb][e]; }
        rs += __shfl_xor(rs, 32);
        const float inv = (nv > 0) ? 1.f / rs : 0.f;
#pragma unroll
        for (int t = 0; t < 2; ++t)
#pragma unroll
            for (int kb = 0; kb < 2; ++kb)
#pragma unroll
                for (int e = 0; e < 16; ++e) s[t][kb][e] *= inv;
        {
            float sum4[16], p3[16];
#pragma unroll
            for (int t = 0; t < 2; ++t)
#pragma unroll
                for (int kb = 0; kb < 2; ++kb)
#pragma unroll
                    for (int jj = 0; jj < 4; ++jj) { const int G4 = 8 * t + 4 * kb + jj; sum4[G4] = (s[t][kb][4 * jj] + s[t][kb][4 * jj + 1]) + (s[t][kb][4 * jj + 2] + s[t][kb][4 * jj + 3]); p3[G4] = s[t][kb][4 * jj + 3]; }
            LAS float* pw = part + (F.wave * 32 + r) * 32;
#pragma unroll
            for (int G4 = 0; G4 < 16; ++G4) { const float pr = __shfl_xor(p3[G4], 32);
                const float prm1 = (G4 > 0) ? __shfl_xor(p3[G4 > 0 ? G4 - 1 : 0], 32) : 0.f;
                const float v = sum4[G4] + (h ? pr : prm1);
                pw[2 * G4 + h] = v; }
        }
        fa::f32x16 o[2];
#pragma unroll
        for (int blk = 0; blk < 2; ++blk)
#pragma unroll
            for (int e = 0; e < 16; ++e) o[blk][e] = 0.f;
#pragma unroll
        for (int t = 0; t < 2; ++t) {
            if (t < ntile) {
                const LAS bf16* Vt = (const LAS bf16*)(F.lds + t * G::BUF + G::KBYTES);
#pragma unroll
                for (int kb = 0; kb < 2; ++kb)
#pragma unroll
                    for (int s2 = 0; s2 < 2; ++s2) {
                        v4u pw4; pw4.x = pg8::cvt_pk_bf16(s[t][kb][8 * s2 + 0], s[t][kb][8 * s2 + 1]); pw4.y = pg8::cvt_pk_bf16(s[t][kb][8 * s2 + 2], s[t][kb][8 * s2 + 3]);
                        pw4.z = pg8::cvt_pk_bf16(s[t][kb][8 * s2 + 4], s[t][kb][8 * s2 + 5]); pw4.w = pg8::cvt_pk_bf16(s[t][kb][8 * s2 + 6], s[t][kb][8 * s2 + 7]);
                        const fa::bf16x8 pf = __builtin_bit_cast(fa::bf16x8, pw4);
#pragma unroll
                        for (int blk = 0; blk < 2; ++blk) { const LAS bf16* vp = Vt + (32 * blk + r) * fa::VSTR + 32 * kb + 16 * s2 + 4 * h;
                            const fa::bf16x4 lo = *(const LAS fa::bf16x4*)vp, hi = *(const LAS fa::bf16x4*)(vp + 8);
                            o[blk] = __builtin_amdgcn_mfma_f32_32x32x16_bf16(__builtin_shufflevector(lo, hi, 0, 1, 2, 3, 4, 5, 6, 7), pf, o[blk], 0, 0, 0); }
                    }
            }
        }
#pragma unroll
        for (int blk = 0; blk < 2; ++blk)
#pragma unroll
            for (int jj = 0; jj < 4; ++jj) { const int d0 = 32 * blk + 8 * jj + 4 * h;
                v2u ow; ow.x = pk2(o[blk][4 * jj + 0], o[blk][4 * jj + 1]); ow.y = pk2(o[blk][4 * jj + 2], o[blk][4 * jj + 3]);
                *(v2u*)(OC + row * D + head * 64 + d0) = ow; }
        __syncthreads();
#pragma unroll 1
        for (int it = 0; it < 2; ++it) {
            const int ql = 4 * F.wave + 2 * it + h, j = r, t = tq0 + ql; float p = 0.f;
#pragma unroll
            for (int w8 = 0; w8 < 8; ++w8) p += part[(w8 * 32 + ql) * 32 + j];
            const int blkq = t >> 6; const bool adm = (64 * j <= t); const bool forced = (j == 0) || (j == blkq) || (j == blkq - 1);
            const float scj = adm ? (p + (forced ? 1.0e6f : 0.f)) : -1.0e30f;
            int rank = 0;
#pragma unroll 1
            for (int i = 0; i < 32; ++i) { const float si = __shfl(scj, (F.lane & 32) | i); rank += (si > scj || (si == scj && i < j)) ? 1 : 0; }
            const unsigned long long sm = __ballot(adm && rank < 8);
            if (r == 0) SELM[((size_t)b * S + t) * 2 + g] = h ? (unsigned)(sm >> 32) : (unsigned)sm;
        }
        __syncthreads();
    }
}

__device__ __forceinline__ void cmp_prep(const Frame& F) {
    tconv(F, F.in[I_OD_W1K], 128, 2048, 128, 256, (bf16*)(F.ws + WS_W1T), 2048, NOGRP, 0);
    tconv(F, F.in[I_OD_W1V], 128, 2048, 128, 256, (bf16*)(F.ws + WS_W1T) + (size_t)256 * 2048, 2048, NOGRP, 0);
    if (blockIdx.x == 0 && F.tid < 256) { const int which = F.tid >> 7, j = F.tid & 127; const float* pe = which ? F.in[I_OD_PEV] : F.in[I_OD_PEK]; const float* w1 = which ? F.in[I_OD_W1V] : F.in[I_OD_W1K]; float a = 0.f;
        for (int kk = 0; kk < 2048; ++kk) a += pe[kk] * w1[(size_t)kk * 128 + j];
        ((float*)(F.ws + WS_PEB))[F.tid] = a; }
}
__device__ __forceinline__ void cmp_w2_phase(const Frame& F) {
    const float* Hd = (const float*)(F.ws + WS_HIDC);
    for (int rw = F.gw; rw < 2 * 4096; rw += F.NGW) {
        const int which = rw >> 12, g = (rw >> 11) & 1, b = (rw >> 7) & 15, n = rw & 127;
        const float* w2 = which ? F.in[I_OD_W2V] : F.in[I_OD_W2K];
        bf16* outp = (bf16*)(F.ws + (which ? WS_VC : WS_KC)) + ((size_t)(b * 2 + g) * 128 + n) * 64;
        float a = 0.f;
        if (n < NCMP) { const float h0 = Hd[(size_t)rw * 128 + F.lane], h1 = Hd[(size_t)rw * 128 + 64 + F.lane];
#pragma unroll 8
            for (int j = 0; j < 64; ++j) { a += __shfl(h0, j) * w2[j * 64 + F.lane]; }
#pragma unroll 8
            for (int j = 0; j < 64; ++j) { a += __shfl(h1, j) * w2[(64 + j) * 64 + F.lane]; } }
        outp[F.lane] = (bf16)f2bf(a);
    }
}

constexpr int NPHASE = 35;
__global__ void __launch_bounds__(NWAVES * 64, 2) skel_fwd(Args args) {
    extern __shared__ __attribute__((aligned(16))) unsigned char lds[];
    Frame F;
    F.lds = (LAS unsigned char*)lds; F.ws = args.ws; F.acc = args.out; F.in = args.in;
    F.tid = threadIdx.x; F.lane = F.tid & 63; F.wave = __builtin_amdgcn_readfirstlane(F.tid >> 6);
    F.G = gridDim.x; F.gw = blockIdx.x * NWAVES + F.wave; F.NGW = F.G * NWAVES;
    volatile LAS unsigned* MISC = (volatile LAS unsigned*)(F.lds + MISC_OFF);
    for (int u = F.tid; u < (LDS_BYTES - LDSCTL_OFF) / 4; u += NWAVES * 64) ((LAS unsigned*)(F.lds + LDSCTL_OFF))[u] = 0u;
    __syncthreads();
    unsigned* ctl = (unsigned*)(args.ws + WS_CTL);
    XcdBarrier bar; bar.bar = ctl + CW_BAR; bar.x = 0; bar.st = nullptr;
    const int lo = args.ph_lo, hi = args.ph_hi;
    if (hi - lo > 1) {
        bar = xcd_barrier_post(ctl + CW_BAR, MISC + 8);
        if (threadIdx.x == 0) { unsigned nloc, nx; xcd_barrier_complete(ctl + CW_BAR, bar.x, nloc, nx); MISC[8] = nloc; MISC[9] = nx; }
        __syncthreads();
    }
#ifndef PH_LO
#define PH_LO 0
#define PH_HI 99
#endif
#define IN(k) ((k) >= PH_LO && (k) < PH_HI && lo <= (k) && (k) < hi && fresh(F))
#define SEAM(k) do { if (IN(k) && IN((k) + 1)) xcd_barrier(bar); } while (0)
    unsigned char* ws = args.ws;
    const int bx = blockIdx.x;

    if (IN(0)) { prologue(F); } SEAM(0);
    if (IN(1)) {
        { pg8::StaticSched<256 * 2048, 256 * 2048> Sd{(const char*)(ws + WS_HB), (const char*)(ws + W_IN0), M / 256, P0_LD / 256, F.G, bx, F.wave};
          pg8::EpiBf16 E{(bf16*)(ws + WS_P0), P0_LD}; pg8::gemm_phase<1024, 2048, 2048>(F.lds, Sd, E); }
        for (int i = 0; i < 2; ++i) {
          pg8::StaticSched<256 * 2048, 256 * 2048> Sd{(const char*)(ws + WS_MEMB), (const char*)(ws + W_XKV + (size_t)i * 1024 * 1024 * 2), MMEM / 256, 4, F.G, (bx + 128 * (i + 1)) % F.G, F.wave};
          pg8::EpiBf16 E{(bf16*)(ws + WS_XKV + (size_t)i * MMEM * 1024 * 2), 1024}; pg8::gemm_phase<1024, 2048, 2048>(F.lds, Sd, E); }
    } SEAM(1);
    if (IN(2)) { cn_phase(F); idx_phase_mfma(F); swa_phase_mfma(F); } SEAM(2);
    if (IN(3)) { dsa_phase_mfma(F); } SEAM(3);
    if (IN(4)) { pg8::StaticSched<256 * P0_LD * 2, 256 * 1536 * 2> Sd{(const char*)(ws + WS_P0), (const char*)(ws + W_OUT0), M / 256, 4, F.G, bx, F.wave};
                 pg8::EpiAcc E{F.acc, D}; pg8::gemm_phase<1536, P0_LD * 2, 1536 * 2>(F.lds, Sd, E); } SEAM(4);
    if (IN(5)) { ln_phase<0>(F, 0); } SEAM(5);
    if (IN(6)) { pg8::StaticSched<256 * 2048, 256 * 2048> Sd{(const char*)(ws + WS_HB), (const char*)(ws + W_XQ), M / 256, 2, F.G, bx, F.wave};
                 pg8::EpiBf16 E{(bf16*)(ws + WS_QX0), 512}; pg8::gemm_phase<1024, 2048, 2048>(F.lds, Sd, E); } SEAM(6);
    if (IN(7)) { xattn_phase_mfma(F, (const bf16*)(ws + WS_QX0), (const bf16*)(ws + WS_XKV), (bf16*)(ws + WS_OX0)); } SEAM(7);
    if (IN(8)) { pg8::StaticSched<256 * 1024, 256 * 1024> Sd{(const char*)(ws + WS_OX0), (const char*)(ws + W_XO), M / 256, 4, F.G, bx, F.wave};
                 pg8::EpiAcc E{F.acc, D}; pg8::gemm_phase<512, 1024, 1024>(F.lds, Sd, E); } SEAM(8);
    if (IN(9)) { ln_phase<0>(F, 1); } SEAM(9);
    if (IN(10)) { pg8::StaticSched<256 * 2048, 256 * 2048> Sd{(const char*)(ws + WS_HB), (const char*)(ws + W_FGU), M / 256, 2 * DFF / 256, F.G, bx, F.wave};
                  pg8::EpiSwiglu E{(bf16*)(ws + WS_HID), DFF, 0}; pg8::gemm_phase<1024, 2048, 2048>(F.lds, Sd, E); } SEAM(10);
    if (IN(11)) { pg8::StaticSched<256 * DFF * 2, 256 * DFF * 2> Sd{(const char*)(ws + WS_HID), (const char*)(ws + W_FD), M / 256, 4, F.G, bx, F.wave};
                  pg8::EpiAcc E{F.acc, D}; pg8::gemm_phase<DFF, DFF * 2, DFF * 2>(F.lds, Sd, E); } SEAM(11);
    if (IN(12)) { ln_phase<0>(F, 2); cmp_prep(F); } SEAM(12);
    if (IN(13)) { pg8::StaticSched<256 * 2048, 256 * 2048> Sd{(const char*)(ws + WS_HB), (const char*)(ws + W_IN1), M / 256, P1_LD / 256, F.G, bx, F.wave};
                  pg8::EpiBf16 E{(bf16*)(ws + WS_P1), P1_LD}; pg8::gemm_phase<1024, 2048, 2048>(F.lds, Sd, E); } SEAM(13);
    if (IN(14)) { pg8::CmpSched Sd{(const char*)(ws + WS_P1), (const char*)(ws + WS_W1T), F.G, bx, F.wave};
                  pg8::EpiCmpHid E{(float*)(ws + WS_HIDC), (const float*)(ws + WS_PEB)}; pg8::gemm_phase<2048, 16 * P1_LD * 2, 2048 * 2, P1_LD * 2, (long)S * P1_LD * 2>(F.lds, Sd, E); } SEAM(14);
    if (IN(15)) { cmp_w2_phase(F); } SEAM(15);
    if (IN(16)) { cmp_phase_mfma(F); } SEAM(16);
    if (IN(17)) { slc_phase_mfma(F); } SEAM(17);
    if (IN(18)) { win_phase_mfma(F); } SEAM(18);
    if (IN(19)) { pg8::StaticSched<256 * P1_LD * 2, 256 * 2048> Sd{(const char*)(ws + WS_P1), (const char*)(ws + W_OUT1), M / 256, 4, F.G, bx, F.wave};
                  pg8::EpiAcc E{F.acc, D}; pg8::gemm_phase<1024, P1_LD * 2, 2048>(F.lds, Sd, E); } SEAM(19);
    if (IN(20)) { ln_phase<0>(F, 3); } SEAM(20);
    if (IN(21)) { pg8::StaticSched<256 * 2048, 256 * 2048> Sd{(const char*)(ws + WS_HB), (const char*)(ws + W_XQ + (size_t)512 * 1024 * 2), M / 256, 2, F.G, bx, F.wave};
                  pg8::EpiBf16 E{(bf16*)(ws + WS_QX1), 512}; pg8::gemm_phase<1024, 2048, 2048>(F.lds, Sd, E); } SEAM(21);
    if (IN(22)) { xattn_phase_mfma(F, (const bf16*)(ws + WS_QX1), (const bf16*)(ws + WS_XKV + (size_t)MMEM * 1024 * 2), (bf16*)(ws + WS_OX1)); } SEAM(22);
    if (IN(23)) { pg8::StaticSched<256 * 1024, 256 * 1024> Sd{(const char*)(ws + WS_OX1), (const char*)(ws + W_XO + (size_t)1024 * 512 * 2), M / 256, 4, F.G, bx, F.wave};
                  pg8::EpiAcc E{F.acc, D}; pg8::gemm_phase<512, 1024, 1024>(F.lds, Sd, E); } SEAM(23);
    if (IN(24)) { ln_phase<1>(F, 4); } SEAM(24);
    if (IN(25)) { moe_dispatch(F); } SEAM(25);
#pragma unroll 1
    for (int ch = 0; ch < 4; ++ch) {
        const int pa = 26 + 2 * ch, pb = 27 + 2 * ch;
        const int* tile_exp = (const int*)(ws + WS_TILEEXP);
        if (IN(pa) || IN(pb)) {
            const int slot = ch >> 1; const int s0 = tile_exp[512 + slot], s1 = tile_exp[512 + slot + 1];
            int t0 = s0 + (ch & 1) * MOE_CHUNK_TILES, t1 = (ch & 1) ? s1 : (s0 + MOE_CHUNK_TILES < s1 ? s0 + MOE_CHUNK_TILES : s1);
            if (t0 > s1) t0 = s1; int nT = t1 - t0; if (nT < 0) nT = 0; if (nT > MOE_CHUNK_TILES) nT = MOE_CHUNK_TILES;
            if (IN(pa)) { pg8::MoeSched<WS_PERMA, W_MGU, 256 * 2048, 256 * 2048, (size_t)7168 * 2048, 0> Sd{ws, t0, nT, 2 * DFFE / 256, F.G, bx, F.wave};
                          pg8::EpiSwiglu E{(bf16*)(ws + WS_HIDM), DFFE, 1}; pg8::gemm_phase<1024, 2048, 2048>(F.lds, Sd, E); }
            if (IN(pa) && IN(pb)) xcd_barrier(bar);
            if (IN(pb)) { pg8::MoeSched<WS_HIDM, W_MD, 256 * DFFE * 2, 256 * DFFE * 2, (size_t)1024 * DFFE * 2, 1> Sd{ws, t0, nT, 4, F.G, bx, F.wave};
                          pg8::EpiMoeDown E{F.acc, ws}; pg8::gemm_phase<DFFE, DFFE * 2, DFFE * 2>(F.lds, Sd, E); }
            if (IN(pb) && IN(pb + 1)) xcd_barrier(bar);
        }
    }
    if (IN(34)) { ln_phase<2>(F, 5); }
#undef IN
#undef SEAM
}

extern "C" void kernel_launch(void* const* d_in, const int* in_sizes, int n_in, void* d_out, int out_size, void* d_ws, size_t ws_size, hipStream_t stream) {
    static int grid = 0;
    if (grid == 0) {
        if (n_in != 30 || out_size != M * D || ws_size < WS_END) { fprintf(stderr, "kernel_launch: unexpected shapes (n_in %d, out %d, ws %zu < %zu); nothing launched\n", n_in, out_size, ws_size, (size_t)WS_END); grid = -1; return; }
        int dev = 0, cus = 0, per_cu = 0;
        if (hipGetDevice(&dev) != hipSuccess || hipDeviceGetAttribute(&cus, hipDeviceAttributeMultiprocessorCount, dev) != hipSuccess) { grid = -1; return; }
        if (hipFuncSetAttribute((const void*)skel_fwd, hipFuncAttributeMaxDynamicSharedMemorySize, LDS_BYTES) != hipSuccess) { fprintf(stderr, "kernel_launch: hipFuncSetAttribute failed\n"); grid = -1; return; }
        if (hipOccupancyMaxActiveBlocksPerMultiprocessor(&per_cu, (const void*)skel_fwd, NWAVES * 64, LDS_BYTES) != hipSuccess || per_cu < 1)
            fprintf(stderr, "kernel_launch: occupancy query reports %d workgroups per CU\n", per_cu);
        (void)hipGetLastError();
        grid = cus;
    }
    if (grid < 0) return;
    if (hipMemsetAsync((char*)d_ws + WS_CTL, 0, CTL_ZERO_BYTES, stream) != hipSuccess) return;
    Args a{};
    for (int i = 0; i < 30; ++i) a.in[i] = (const float*)d_in[i];
    a.out = (float*)d_out; a.ws = (unsigned char*)d_ws;
#if MK_ONE_LAUNCH
    a.ph_lo = 0; a.ph_hi = NPHASE;
    hipLaunchKernelGGL(skel_fwd, dim3(grid), dim3(NWAVES * 64), LDS_BYTES, stream, a);
#else
    for (int p = 0; p < NPHASE; ++p) { a.ph_lo = p; a.ph_hi = p + 1; hipLaunchKernelGGL(skel_fwd, dim3(grid), dim3(NWAVES * 64), LDS_BYTES, stream, a); }
#endif
}
```

```cpp
#include <hip/hip_runtime.h>
#include <cstdio>
#include <cstdint>

#ifndef MK_ONE_LAUNCH
#define MK_ONE_LAUNCH 1
#endif

constexpr size_t ROWTOK_OFF = 5u * 1048576u + 512u * 1024u, ROWW_OFF = 6u * 1048576u, TILEEXP_OFF = 6u * 1048576u + 512u * 1024u, DUMMY_OFF = 7u * 1048576u;
namespace pg8 {
#define PG8_LAS __attribute__((address_space(3)))
typedef unsigned short bf16_t;
typedef short bf16x8 __attribute__((ext_vector_type(8)));
typedef float f32x4 __attribute__((ext_vector_type(4)));
typedef unsigned u32x4 __attribute__((ext_vector_type(4)));
constexpr int BM = 256, BK = 64, HALF = 128, HTB = HALF * BK * 2, STAGE_BYTES = 8 * HTB, NXCD = 8, WGM = 8;

__host__ __device__ __forceinline__ int lds_byte(int r, int c) { const int st = (r >> 4) * 2 + (c >> 5), rr = r & 15, cc = c & 31, ob = rr * 64 + cc * 2; return st * 1024 + (ob ^ (((ob >> 9) & 1) << 5)); }
__host__ __device__ __forceinline__ void stage_rc(int b, int& R, int& C) { const int st = b / 1024, sb = b % 1024, swz = sb ^ (((sb >> 9) & 1) << 5); R = (st >> 1) * 16 + swz / 64; C = (st & 1) * 32 + (swz % 64) / 2; }
__host__ __device__ __forceinline__ int perm32(int rho) { const int n = rho >> 4, i = rho & 15; return 8 * (i >> 2) + 4 * n + (i & 3); }

__device__ __forceinline__ const void* opaque_uniform(const void* p) {
    unsigned lo = __builtin_amdgcn_readfirstlane((unsigned)(unsigned long long)p), hi = __builtin_amdgcn_readfirstlane((unsigned)((unsigned long long)p >> 32));
    asm volatile("" : "+s"(lo), "+s"(hi)); return (const void*)(((unsigned long long)hi << 32) | lo); }
struct Unit { int pm, pn, aux; const char* a; const char* b; };

__device__ __forceinline__ void tile_of(int wgid, int nM, int nN, int& pm, int& pn) {
    const int nwg = nM * nN;
    { const int q = nwg / NXCD, r = nwg % NXCD, xcd = wgid % NXCD, off = wgid / NXCD; wgid = (xcd < r ? xcd * (q + 1) : r * (q + 1) + (xcd - r) * q) + off; }
    const int nig = WGM * nN, gid = wgid / nig, fm = gid * WGM, gsz = (nM - fm) < WGM ? (nM - fm) : WGM;
    pm = fm + ((wgid % nig) % gsz); pn = (wgid % nig) / gsz;
}
template <size_t A_TILE, size_t B_TILE>
struct StaticSched {
    const char* A; const char* B; int nM, nN, G, c, wave;
    __device__ __forceinline__ bool next(int i, Unit& u) const {
        const long L = (long)i * G + c; if (L >= (long)nM * nN) return false;
        int pm, pn; tile_of((int)L, nM, nN, pm, pn);
        u.pm = pm; u.pn = pn; u.aux = 0; u.a = A + (size_t)pm * A_TILE; u.b = B + (size_t)pn * B_TILE; return true;
    }
};
template <size_t A_OFF, size_t B_OFF, size_t A_TILE, size_t B_TILE, size_t B_EXP, int A_LOCAL>
struct MoeSched {
    const unsigned char* ws; int t0, nT, nN, G, c, wave;
    __device__ __forceinline__ bool next(int i, Unit& u) const {
        const long L = (long)i * G + c; if (L >= (long)nT * nN) return false;
        int pml, pn; tile_of((int)L, nT, nN, pml, pn);
        const unsigned char* wsb = (const unsigned char*)opaque_uniform(ws);
        const int pm = t0 + pml; const int e = __builtin_amdgcn_readfirstlane(((const int*)(wsb + TILEEXP_OFF))[pm]);
        u.pm = pm; u.pn = pn; u.aux = pml; u.a = (const char*)wsb + A_OFF + (size_t)(A_LOCAL ? pml : pm) * A_TILE; u.b = (const char*)wsb + B_OFF + (size_t)e * B_EXP + (size_t)pn * B_TILE; return true;
    }
};

__device__ __forceinline__ unsigned cvt_pk_bf16(float lo, float hi) { unsigned r; asm volatile("v_cvt_pk_bf16_f32 %0, %1, %2" : "=v"(r) : "v"(lo), "v"(hi)); return r; }

struct EpiBf16 {
    static constexpr bool PERM = true;
    bf16_t* O; int ldc;
    __device__ __forceinline__ void operator()(const f32x4 (&acc)[2][2][4][2], const Unit& u, int wr, int wc, int fr, int fq) const {
        const int row0 = u.pm * BM + wr * 64 + fr, col0 = u.pn * BM + wc * 32 + 8 * fq;
#pragma unroll
        for (int ai = 0; ai < 2; ++ai)
#pragma unroll
            for (int m = 0; m < 4; ++m) { bf16_t* rowp = O + (size_t)(row0 + ai * HALF + m * 16) * ldc + col0;
#pragma unroll
                for (int bj = 0; bj < 2; ++bj) { const f32x4 v0 = acc[ai][bj][m][0], v1 = acc[ai][bj][m][1];
                    u32x4 w; w.x = cvt_pk_bf16(v0[0], v0[1]); w.y = cvt_pk_bf16(v0[2], v0[3]); w.z = cvt_pk_bf16(v1[0], v1[1]); w.w = cvt_pk_bf16(v1[2], v1[3]);
                    *(u32x4*)(rowp + bj * HALF) = w; } }
    }
};
struct EpiAcc {
    static constexpr bool PERM = false;
    float* C; int ldc;
    __device__ __forceinline__ void operator()(const f32x4 (&acc)[2][2][4][2], const Unit& u, int wr, int wc, int fr, int fq) const {
        const int row0 = u.pm * BM + wr * 64 + fr, col0 = u.pn * BM + wc * 32 + 4 * fq;
#pragma unroll
        for (int ai = 0; ai < 2; ++ai)
#pragma unroll
            for (int m = 0; m < 4; ++m) { float* rowp = C + (size_t)(row0 + ai * HALF + m * 16) * ldc + col0;
                f32x4 o[2][2];
#pragma unroll
                for (int bj = 0; bj < 2; ++bj)
#pragma unroll
                    for (int n = 0; n < 2; ++n) o[bj][n] = *(const f32x4*)(rowp + bj * HALF + n * 16);
#pragma unroll
                for (int bj = 0; bj < 2; ++bj)
#pragma unroll
                    for (int n = 0; n < 2; ++n) *(f32x4*)(rowp + bj * HALF + n * 16) = o[bj][n] + acc[ai][bj][m][n]; }
    }
};
__device__ __forceinline__ float silu_f(float x) { return x / (1.0f + __expf(-x)); }
struct EpiSwiglu {
    static constexpr bool PERM = true;
    bf16_t* O; int ldc; int row_local;
    __device__ __forceinline__ void operator()(const f32x4 (&acc)[2][2][4][2], const Unit& u, int wr, int wc, int fr, int fq) const {
        const int row0 = (row_local ? u.aux : u.pm) * BM + wr * 64 + fr, col0 = u.pn * HALF + wc * 32 + 8 * fq;
#pragma unroll
        for (int ai = 0; ai < 2; ++ai)
#pragma unroll
            for (int m = 0; m < 4; ++m) { bf16_t* rowp = O + (size_t)(row0 + ai * HALF + m * 16) * ldc + col0;
                const f32x4 g0 = acc[ai][0][m][0], g1 = acc[ai][0][m][1], u0 = acc[ai][1][m][0], u1 = acc[ai][1][m][1];
                float h[8];
#pragma unroll
                for (int j = 0; j < 4; ++j) { h[j] = silu_f(g0[j]) * u0[j]; h[4 + j] = silu_f(g1[j]) * u1[j]; }
                u32x4 w; w.x = cvt_pk_bf16(h[0], h[1]); w.y = cvt_pk_bf16(h[2], h[3]); w.z = cvt_pk_bf16(h[4], h[5]); w.w = cvt_pk_bf16(h[6], h[7]);
                *(u32x4*)rowp = w; }
    }
};
struct EpiMoeDown {
    static constexpr bool PERM = false;
    float* C; unsigned char* ws;
    __device__ __forceinline__ void operator()(const f32x4 (&acc)[2][2][4][2], const Unit& u, int wr, int wc, int fr, int fq) const {
        const int row0 = u.pm * BM + wr * 64 + fr, col0 = u.pn * BM + wc * 32 + 4 * fq;
        unsigned char* wsb = (unsigned char*)opaque_uniform(ws);
        const int* rowtok = (const int*)(wsb + ROWTOK_OFF); const float* roww = (const float*)(wsb + ROWW_OFF); float* dummy = (float*)(wsb + DUMMY_OFF);
#pragma unroll
        for (int ai = 0; ai < 2; ++ai)
#pragma unroll
            for (int m = 0; m < 4; ++m) { const int r = row0 + ai * HALF + m * 16; const int tok = rowtok[r]; const float w = roww[r];
                float* rowp = (tok >= 0 ? C + (size_t)tok * 1024 : dummy) + col0;
                f32x4 o[2][2];
#pragma unroll
                for (int bj = 0; bj < 2; ++bj)
#pragma unroll
                    for (int n = 0; n < 2; ++n) o[bj][n] = *(const f32x4*)(rowp + bj * HALF + n * 16);
#pragma unroll
                for (int bj = 0; bj < 2; ++bj)
#pragma unroll
                    for (int n = 0; n < 2; ++n) *(f32x4*)(rowp + bj * HALF + n * 16) = o[bj][n] + acc[ai][bj][m][n] * w; }
    }
};

__device__ __forceinline__ float gelu_tanh_f(float x) { const float u = 0.7978845608028654f * (x + 0.044715f * x * x * x); const float e = __expf(2.f * u); return 0.5f * x * (1.f + (1.f - 2.f / (e + 1.f))); }
struct EpiCmpHid {
    static constexpr bool PERM = false;
    float* Hd; const float* bias;
    __device__ __forceinline__ void operator()(const f32x4 (&acc)[2][2][4][2], const Unit& u, int wr, int wc, int fr, int fq) const {
        const int row0 = u.pm * BM + wr * 64 + fr, col0 = wc * 32 + 4 * fq;
        f32x4 bv[2];
#pragma unroll
        for (int n = 0; n < 2; ++n) bv[n] = *(const f32x4*)(bias + u.aux * 128 + col0 + n * 16);
#pragma unroll
        for (int ai = 0; ai < 2; ++ai)
#pragma unroll
            for (int m = 0; m < 4; ++m) { float* rowp = Hd + (size_t)(row0 + ai * HALF + m * 16) * 128 + col0;
#pragma unroll
                for (int n = 0; n < 2; ++n) { const f32x4 v = acc[ai][0][m][n] + bv[n]; f32x4 o;
#pragma unroll
                    for (int j = 0; j < 4; ++j) o[j] = gelu_tanh_f(v[j]);
                    *(f32x4*)(rowp + n * 16) = o; } }
    }
};
struct CmpSched {
    const char* P1b; const char* W1T; int G, c, wave;
    __device__ __forceinline__ bool next(int i, Unit& u) const {
        const int L = i * G + c; if (L >= 32) return false;
        const int which = L >> 4, tile = L & 15, g = tile >> 3, b0 = 2 * (tile & 7);
        u.pm = L; u.pn = 0; u.aux = which; u.a = P1b + ((size_t)b0 * 2048 * 2048 + (which ? 1152 : 1024) + g * 64) * 2; u.b = W1T + (size_t)which * 256 * 2048 * 2; return true;
    }
};

template <int K, int lda_b, int ldb_b, long KSTEP_A = 128, long HSTEP_A = 128L * lda_b, class Epi, class Sched>
__device__ __forceinline__ void gemm_phase(PG8_LAS unsigned char* lds, const Sched& S, const Epi& E) {
    int tid_ = (int)__builtin_amdgcn_mbcnt_hi(~0u, __builtin_amdgcn_mbcnt_lo(~0u, 0u)); asm volatile("" : "+v"(tid_)); tid_ += S.wave * 64;
    const int tid = tid_, wid = __builtin_amdgcn_readfirstlane(tid >> 6), lane = tid & 63, wr = wid >> 2, wc = wid & 3, fr = lane & 15, fq = lane >> 4;
    constexpr int nt = K / BK;
    unsigned voffA[2], voffB[2];
#pragma unroll
    for (int i = 0; i < 2; ++i) { int R, C; stage_rc(tid * 16 + i * 8192, R, C); const int Rb = Epi::PERM ? ((R & ~31) + perm32(R & 31)) : R;
        voffA[i] = (unsigned)(R * lda_b + C * 2); voffB[i] = (unsigned)(Rb * ldb_b + C * 2); }
    const size_t kstep = (size_t)(BK * 2), kstepA = (size_t)KSTEP_A;
    const size_t hstepA = (size_t)HSTEP_A, hstepB = (size_t)HALF * ldb_b;
    const unsigned ldsw = (unsigned)wid * 1024u;
    const int aoff = lds_byte(wr * 64 + fr, fq * 8), boff = lds_byte(wc * 32 + fr, fq * 8);
#define PG8_SA(b, h) (((b) * 2 + (h)) * HTB)
#define PG8_SB(b, h) ((4 + (b) * 2 + (h)) * HTB)
#define PG8_STAGE(bufoff, gbase, voff) do { _Pragma("unroll") for (int _i = 0; _i < 2; ++_i) \
        __builtin_amdgcn_global_load_lds((const unsigned*)((const char*)(gbase) + (voff)[_i]), (PG8_LAS unsigned*)(lds + (bufoff) + ldsw + _i * 8192), 16, 0, 0); } while (0)
#define PG8_LDA(dst, b, h) do { _Pragma("unroll") for (int m = 0; m < 4; ++m) _Pragma("unroll") for (int k = 0; k < 2; ++k) dst[m][k] = *(const PG8_LAS bf16x8*)(lds + PG8_SA(b, h) + aoff + m * 2048 + k * 1024); } while (0)
#define PG8_LDB(dst, b, h) do { _Pragma("unroll") for (int n = 0; n < 2; ++n) _Pragma("unroll") for (int k = 0; k < 2; ++k) dst[n][k] = *(const PG8_LAS bf16x8*)(lds + PG8_SB(b, h) + boff + n * 2048 + k * 1024); } while (0)
#define PG8_MMA(ai, bj, At, Bt) do { __builtin_amdgcn_s_setprio(1); _Pragma("unroll") for (int m = 0; m < 4; ++m) _Pragma("unroll") for (int n = 0; n < 2; ++n) _Pragma("unroll") for (int k = 0; k < 2; ++k) \
        acc[ai][bj][m][n] = __builtin_amdgcn_mfma_f32_16x16x32_bf16(Bt[n][k], At[m][k], acc[ai][bj][m][n], 0, 0, 0); __builtin_amdgcn_s_setprio(0); } while (0)
#define PG8_WAIT_V(n) asm volatile("s_waitcnt vmcnt(" #n ")" ::: "memory")
#define PG8_WAIT_L(n) asm volatile("s_waitcnt lgkmcnt(" #n ")" ::: "memory")
#define PG8_BAR __builtin_amdgcn_s_barrier()
#define PG8_SCHED __builtin_amdgcn_sched_barrier(0)
    Unit cur, nxt; int ui = 0;
    if (!S.next(0, cur)) return;
    f32x4 acc[2][2][4][2];
#pragma unroll
    for (int a = 0; a < 2; ++a)
#pragma unroll
        for (int b = 0; b < 2; ++b)
#pragma unroll
            for (int m = 0; m < 4; ++m)
#pragma unroll
                for (int n = 0; n < 2; ++n) acc[a][b][m][n] = (f32x4){0.f, 0.f, 0.f, 0.f};
    bf16x8 At[4][2], B0[2][2], B1[2][2];
    const char* cA = cur.a; const char* cB = cur.b;
    PG8_STAGE(PG8_SB(0, 0), cB, voffB); PG8_STAGE(PG8_SB(0, 1), cB + hstepB, voffB); PG8_STAGE(PG8_SA(0, 0), cA, voffA); PG8_STAGE(PG8_SA(0, 1), cA + hstepA, voffA);
    if (wr == 1) PG8_BAR;
    PG8_WAIT_V(2); PG8_BAR;
    PG8_STAGE(PG8_SB(1, 0), cB + kstep, voffB); PG8_STAGE(PG8_SA(1, 0), cA + kstepA, voffA); PG8_STAGE(PG8_SB(1, 1), cB + hstepB + kstep, voffB);
    PG8_WAIT_V(6); PG8_BAR;
    for (;;) {
        const bool has_next = S.next(ui + 1, nxt);
        const char* nA = has_next ? nxt.a : cA; const char* nB = has_next ? nxt.b : cB;
        for (int t = 0; t < nt; t += 2) {
            const bool last = (t == nt - 2);
            const char* a1 = cA + (size_t)(t + 1) * kstepA;
            const char* a2 = last ? nA : cA + (size_t)(t + 2) * kstepA; const char* b2 = last ? nB : cB + (size_t)(t + 2) * kstep;
            const char* a3 = a2 + kstepA; const char* b3 = b2 + kstep;
            PG8_LDB(B0, 0, 0); PG8_LDB(B1, 0, 1); PG8_SCHED; PG8_LDA(At, 0, 0); PG8_STAGE(PG8_SA(1, 1), a1 + hstepA, voffA);
            PG8_WAIT_V(8); PG8_WAIT_L(0); PG8_BAR; PG8_MMA(0, 0, At, B0); PG8_MMA(0, 1, At, B1); PG8_BAR; PG8_SCHED;
            PG8_LDA(At, 0, 1); PG8_STAGE(PG8_SB(0, 0), b2, voffB); PG8_STAGE(PG8_SB(0, 1), b2 + hstepB, voffB); PG8_STAGE(PG8_SA(0, 0), a2, voffA);
            PG8_WAIT_V(8); PG8_WAIT_L(0); PG8_BAR; PG8_MMA(1, 0, At, B0); PG8_MMA(1, 1, At, B1); PG8_BAR; PG8_SCHED;
            PG8_LDB(B0, 1, 0); PG8_LDB(B1, 1, 1); PG8_SCHED; PG8_LDA(At, 1, 0); PG8_STAGE(PG8_SA(0, 1), a2 + hstepA, voffA);
            PG8_WAIT_V(8); PG8_WAIT_L(0); PG8_BAR; PG8_MMA(0, 0, At, B0); PG8_MMA(0, 1, At, B1); PG8_BAR; PG8_SCHED;
            PG8_LDA(At, 1, 1); PG8_STAGE(PG8_SB(1, 0), b3, voffB); PG8_STAGE(PG8_SB(1, 1), b3 + hstepB, voffB); PG8_STAGE(PG8_SA(1, 0), a3, voffA);
            PG8_WAIT_V(8); PG8_WAIT_L(0); PG8_BAR; PG8_MMA(1, 0, At, B0); PG8_MMA(1, 1, At, B1); PG8_BAR; PG8_SCHED;
        }
        if (wr == 0) PG8_BAR;
        E(acc, cur, wr, wc, fr, fq);
        if (!has_next) break;
#pragma unroll
        for (int a = 0; a < 2; ++a)
#pragma unroll
            for (int b = 0; b < 2; ++b)
#pragma unroll
                for (int m = 0; m < 4; ++m)
#pragma unroll
                    for (int n = 0; n < 2; ++n) acc[a][b][m][n] = (f32x4){0.f, 0.f, 0.f, 0.f};
        cur = nxt; cA = nA; cB = nB; ++ui;
        if (wr == 1) PG8_BAR;
    }
    PG8_WAIT_V(0);
    PG8_BAR;
#undef PG8_SA
#undef PG8_SB
#undef PG8_STAGE
#undef PG8_LDA
#undef PG8_LDB
#undef PG8_MMA
#undef PG8_WAIT_V
#undef PG8_WAIT_L
#undef PG8_BAR
#undef PG8_SCHED
}
}

constexpr int NWAVES = 8;
constexpr int D = 1024, NB = 16, S = 2048, M = NB * S, MEML = 256, MMEM = NB * MEML;
constexpr float LN_EPS = 1e-5f, ALPHA = 1.41421356237f;
constexpr int P0_LD = 2560, C0_QLAT = 0, C0_QB = 1024, C0_CKV = 1536, C0_QI = 1664, C0_KI = 2176, C0_KB = 2240, C0_VB = 2368, C0_WI = 2496;
constexpr int P1_LD = 2048, C1_Q = 0, C1_KC = 1024, C1_VC = 1152, C1_KS = 1280, C1_VS = 1408, C1_KW = 1536, C1_VW = 1664, C1_GL = 1792;
constexpr int EVEN_COLS = 1992, ODD_COLS = 1840;
constexpr int DFF = 2816, DFFE = 3584, NE = 8, NCMP = 127;
constexpr int MOE_CHUNK_TILES = 68, MOE_MAX_TILES = 272;

constexpr size_t MiB = 1u << 20;
constexpr size_t WS_CTL = 0, CTL_ZERO_BYTES = 1 * MiB;
constexpr size_t WS_KC = 2 * MiB, WS_VC = 3 * MiB;
constexpr size_t WS_SELM = 4 * MiB;
constexpr size_t WS_RTE = 4 * MiB + 512 * 1024;
constexpr size_t WS_RTW = 5 * MiB;
constexpr size_t WS_ROWTOK = ROWTOK_OFF; static_assert(ROWTOK_OFF == 5 * MiB + 512 * 1024, "");
constexpr size_t WS_ROWW = ROWW_OFF;
constexpr size_t WS_TILEEXP = TILEEXP_OFF; constexpr size_t WS_DUMMY = DUMMY_OFF;
constexpr size_t WS_W = 8 * MiB;
constexpr size_t W_IN0 = WS_W;
constexpr size_t W_OUT0 = W_IN0 + (size_t)2560 * 1024 * 2;
constexpr size_t W_IN1 = W_OUT0 + (size_t)1024 * 1536 * 2;
constexpr size_t W_OUT1 = W_IN1 + (size_t)2048 * 1024 * 2;
constexpr size_t W_XQ = W_OUT1 + (size_t)1024 * 1024 * 2;
constexpr size_t W_XKV = W_XQ + (size_t)2 * 512 * 1024 * 2;
constexpr size_t W_XO = W_XKV + (size_t)2 * 1024 * 1024 * 2;
constexpr size_t W_FGU = W_XO + (size_t)2 * 1024 * 512 * 2;
constexpr size_t W_FD = W_FGU + (size_t)5632 * 1024 * 2;
constexpr size_t W_MGU = W_FD + (size_t)1024 * 2816 * 2;
constexpr size_t W_MD = W_MGU + (size_t)8 * 7168 * 1024 * 2;
constexpr size_t W_END = W_MD + (size_t)8 * 1024 * 3584 * 2;
static_assert(W_END <= 215 * MiB, "weights");
constexpr size_t WS_HB = 215 * MiB;
constexpr size_t WS_XKV = 279 * MiB;
constexpr size_t WS_SCR = 295 * MiB;
constexpr size_t WS_P0 = WS_SCR;
constexpr size_t WS_CN = WS_SCR + 160 * MiB;
constexpr size_t WS_MASK = WS_SCR + 168 * MiB;
constexpr size_t WS_MEMB = WS_SCR + 176 * MiB;
constexpr size_t WS_QX0 = WS_SCR + 184 * MiB, WS_OX0 = WS_SCR + 216 * MiB;
constexpr size_t WS_HID = WS_SCR;
constexpr size_t WS_P1 = WS_SCR;
constexpr size_t WS_OCMP = WS_SCR + 128 * MiB, WS_OSLC = WS_SCR + 192 * MiB;
constexpr size_t WS_W1T = WS_SCR + 192 * MiB, WS_HIDC = WS_SCR + 196 * MiB, WS_PEB = WS_SCR + 200 * MiB;
constexpr size_t WS_QX1 = WS_SCR, WS_OX1 = WS_SCR + 32 * MiB;
constexpr size_t WS_PERMA = WS_SCR;
constexpr size_t WS_HIDM = WS_SCR + 136 * MiB;
constexpr size_t WS_END = WS_SCR + 256 * MiB;
static_assert(WS_HIDM + (size_t)MOE_CHUNK_TILES * 256 * DFFE * 2 <= WS_END, "ws");
constexpr int CW_BAR = 4096;
constexpr int CW_CNT = 16384;
constexpr int CW_CUR = 16384 + 64;

constexpr int RING_BYTES = 131072, LDSCTL_OFF = RING_BYTES, MISC_OFF = LDSCTL_OFF + 320, LDS_BYTES = 147456;

#define GAS __attribute__((address_space(1)))
#define LAS __attribute__((address_space(3)))
typedef unsigned short bf16;
typedef unsigned v4u __attribute__((ext_vector_type(4)));
typedef unsigned v2u __attribute__((ext_vector_type(2)));
typedef float f32x4 __attribute__((ext_vector_type(4)));
#define LDS_WAIT() asm volatile("s_waitcnt lgkmcnt(0)" ::: "memory")
#define WAVE_SYNC() asm volatile("s_waitcnt vmcnt(0) lgkmcnt(0)" ::: "memory")
__device__ __forceinline__ unsigned f2bf(float f) { unsigned u = __builtin_bit_cast(unsigned, f); return (u + 0x7fffu + ((u >> 16) & 1u)) >> 16; }
__device__ __forceinline__ unsigned pk2(float lo, float hi) { return f2bf(lo) | (f2bf(hi) << 16); }
__device__ __forceinline__ float bf2f(bf16 b) { return __builtin_bit_cast(float, (unsigned)b << 16); }
__device__ __forceinline__ float bflo(unsigned w) { return __builtin_bit_cast(float, w << 16); }
__device__ __forceinline__ float bfhi(unsigned w) { return __builtin_bit_cast(float, w & 0xffff0000u); }
__device__ __forceinline__ void ld8bf(const bf16* p, float* f) { const v4u w = *(const v4u*)p; f[0] = bflo(w.x); f[1] = bfhi(w.x); f[2] = bflo(w.y); f[3] = bfhi(w.y); f[4] = bflo(w.z); f[5] = bfhi(w.z); f[6] = bflo(w.w); f[7] = bfhi(w.w); }
__device__ __forceinline__ float wave_sum(float v) {
#pragma unroll
    for (int o = 1; o < 64; o <<= 1) v += __shfl_xor(v, o);
    return v;
}
__device__ __forceinline__ float wave_max(float v) {
#pragma unroll
    for (int o = 1; o < 64; o <<= 1) v = fmaxf(v, __shfl_xor(v, o));
    return v;
}
__device__ const unsigned char BKT[112] = {16, 16, 16, 17, 17, 18, 18, 18, 19, 19, 19, 20, 20, 20, 20, 21, 21, 21, 21, 22, 22, 22, 22, 22, 23, 23, 23, 23, 23, 23, 24, 24, 24, 24, 24, 24, 25, 25, 25, 25, 25, 25, 25, 26, 26, 26, 26, 26, 26, 26, 26,
    27, 27, 27, 27, 27, 27, 27, 27, 27, 27, 28, 28, 28, 28, 28, 28, 28, 28, 28, 28, 29, 29, 29, 29, 29, 29, 29, 29, 29, 29, 29, 29, 30, 30, 30, 30, 30, 30, 30, 30, 30, 30, 30, 30, 30, 30, 31, 31, 31, 31, 31, 31, 31, 31, 31, 31, 31, 31, 31, 31, 31};
__device__ __forceinline__ int rel_bucket(int n) { return n < 16 ? n : (n >= 128 ? 31 : (int)BKT[n - 16]); }

#define XB_TMO      128
#define XB_XCNT(j)  (256  + 64 * (j))
#define XB_XSUB(j)  (1280 + 64 * (j))
#define XB_XGEN(j)  (2304 + 64 * (j))
#define XB_TOP      3328
#define XB_TOPGEN   3392
#define XCD_BAR_WORDS 3456
#define XB_SPIN_CAP (1u << 22)
__device__ __forceinline__ unsigned xb_ld(unsigned* p)              { return __hip_atomic_load(p, __ATOMIC_RELAXED, __HIP_MEMORY_SCOPE_AGENT); }
__device__ __forceinline__ unsigned xb_add(unsigned* p, unsigned v) { return __hip_atomic_fetch_add(p, v, __ATOMIC_RELAXED, __HIP_MEMORY_SCOPE_AGENT); }
__device__ __forceinline__ unsigned xb_xcc_id() { return (unsigned)__builtin_amdgcn_s_getreg((3 << 11) | 20) & 0xFu; }
#define XB_SPIN(cond, bar) do { unsigned _sp = 0; while (cond) { __builtin_amdgcn_s_sleep(1); \
    if ((++_sp & 255u) == 0u) { if (xb_ld(&(bar)[XB_TMO])) break; if (_sp > XB_SPIN_CAP) { atomicAdd(&(bar)[XB_TMO], 1u); break; } } } } while (0)
struct XcdBarrier { unsigned* bar; unsigned x; volatile LAS unsigned* st; };
__device__ __forceinline__ XcdBarrier xcd_barrier_post(unsigned* bar, volatile LAS unsigned* st) {
    XcdBarrier b; b.bar = bar; b.x = xb_xcc_id(); b.st = st;
    if (threadIdx.x == 0) (void)xb_add(&bar[XB_XCNT(b.x)], 1u);
    return b;
}
__device__ __forceinline__ void xcd_barrier_complete(unsigned* bar, unsigned x, unsigned& nloc, unsigned& nx) {
    const unsigned G = gridDim.x * gridDim.y * gridDim.z;
    unsigned sum, cnt, mine, sp = 0u;
    for (;;) {
        sum = 0u; cnt = 0u; mine = 0u;
#pragma unroll
        for (unsigned j = 0; j < 16; ++j) { const unsigned c = xb_ld(&bar[XB_XCNT(j)]); sum += c; cnt += (c > 0u) ? 1u : 0u; mine = (j == x) ? c : mine; }
        if (sum == G) break;
        __builtin_amdgcn_s_sleep(1);
        if ((++sp & 255u) == 0u) { if (xb_ld(&bar[XB_TMO])) break; if (sp > XB_SPIN_CAP) { atomicAdd(&bar[XB_TMO], 1u); break; } }
    }
    nloc = mine > 0u ? mine : 1u; nx = cnt > 0u ? cnt : 1u;
}
__device__ __forceinline__ void xcd_barrier(const XcdBarrier& b) {
    asm volatile("s_waitcnt vmcnt(0)" ::: "memory");
    __syncthreads();
    if (threadIdx.x == 0) {
        unsigned* bar = b.bar;
        __builtin_amdgcn_s_waitcnt(0);
        unsigned nloc = b.st[0], nx = b.st[1];
        const unsigned old = xb_add(&bar[XB_XSUB(b.x)], 1u);
        const unsigned gen = old / nloc;
        if (old + 1u == (gen + 1u) * nloc) {
            __builtin_amdgcn_fence(__ATOMIC_RELEASE, "agent");
            asm volatile("s_waitcnt vmcnt(0)" ::: "memory");
            const unsigned og = xb_add(&bar[XB_TOP], 1u);
            const unsigned tg = og / nx;
            if (og + 1u == (tg + 1u) * nx) xb_add(&bar[XB_TOPGEN], 1u);
            else XB_SPIN(xb_ld(&bar[XB_TOPGEN]) == tg, bar);
            __builtin_amdgcn_fence(__ATOMIC_ACQUIRE, "agent");
            xb_add(&bar[XB_XGEN(b.x)], 1u);
            asm volatile("s_waitcnt vmcnt(0)" ::: "memory");
        } else {
            XB_SPIN(xb_ld(&bar[XB_XGEN(b.x)]) == gen, bar);
            __builtin_amdgcn_fence(__ATOMIC_ACQUIRE, "agent");
            asm volatile("s_waitcnt vmcnt(0)" ::: "memory");
        }
    }
    __syncthreads();
}

struct Args { const float* in[30]; float* out; unsigned char* ws; int ph_lo, ph_hi; };
enum { I_X = 0, I_MEM, I_REL, I_EV_WIN, I_EV_GAIN, I_EV_WUK, I_EV_WUV, I_EV_SINK, I_EV_WOUT, I_OD_WIN, I_OD_PEK, I_OD_W1K, I_OD_W2K, I_OD_PEV, I_OD_W1V, I_OD_W2V, I_OD_WOUT,
       I_XA_WQ, I_XA_WK, I_XA_WV, I_XA_WO, I_FF_G, I_FF_U, I_FF_D, I_MOE_R, I_MOE_G, I_MOE_U, I_MOE_D, I_LN_G, I_LN_B };

struct Frame {
    LAS unsigned char* lds;
    unsigned char* ws; float* acc;
    const float* const* in;
    int tid, lane, wave, G, gw, NGW;
};

__device__ __forceinline__ bool fresh(Frame& F) { int l = (int)__builtin_amdgcn_mbcnt_hi(~0u, __builtin_amdgcn_mbcnt_lo(~0u, 0u)); asm volatile("" : "+v"(l)); F.lane = l; F.tid = F.wave * 64 + l; return true; }
__device__ __forceinline__ void tconv_item(const float* W, int ldw, int ncols, bf16* WT, int ldt, int grp, int gstride, LAS float* scr, int kb, int nb, int lane) {
    const int k0 = 64 * kb, n0 = 32 * nb;
    const int kr = lane >> 3, n4 = (lane & 7) * 4;
    f32x4 v[8];
#pragma unroll
    for (int i = 0; i < 8; ++i) v[i] = (n0 + n4 < ncols) ? *(const f32x4*)(W + (size_t)(k0 + 8 * i + kr) * ldw + n0 + n4) : (f32x4){0.f, 0.f, 0.f, 0.f};
#pragma unroll
    for (int i = 0; i < 8; ++i) { LAS float* d = scr + (8 * i + kr) * 33 + n4; d[0] = v[i].x; d[1] = v[i].y; d[2] = v[i].z; d[3] = v[i].w; }
    LDS_WAIT();
    const int c = lane & 7;
#pragma unroll
    for (int j = 0; j < 4; ++j) { const int nn = (lane >> 3) + 8 * j, n = n0 + nn; const LAS float* s = scr + (8 * c) * 33 + nn;
        v4u o; o.x = pk2(s[0 * 33], s[1 * 33]); o.y = pk2(s[2 * 33], s[3 * 33]); o.z = pk2(s[4 * 33], s[5 * 33]); o.w = pk2(s[6 * 33], s[7 * 33]);
        const int row = (n / grp) * gstride + (n % grp);
        *(v4u*)(WT + (size_t)row * ldt + k0 + 8 * c) = o; }
    LDS_WAIT();
}
__device__ __forceinline__ void tconv(const Frame& F, const float* W, int ldw, int K, int ncols, int npad, bf16* WT, int ldt, int grp, int gstride) {
    LAS float* scr = (LAS float*)(F.lds + F.wave * 16384);
    const int nkb = K / 64, nnb = npad / 32;
    for (int it = F.gw; it < nkb * nnb; it += F.NGW) tconv_item(W, ldw, ncols, WT, ldt, grp, gstride, scr, it / nnb, it % nnb, F.lane);
}
constexpr int NOGRP = 1 << 30;

__device__ __forceinline__ void prologue(const Frame& F) {
    unsigned char* ws = F.ws;
    const int gt = F.gw * 64 + F.lane, NT = F.NGW * 64;
    bf16* win0 = (bf16*)(ws + W_IN0);
    const float* evw = F.in[I_EV_WIN];
    tconv(F, evw + 512, EVEN_COLS, 1024, 128, 128, win0 + (size_t)C0_CKV * 1024, 1024, NOGRP, 0);
    tconv(F, evw + 640, EVEN_COLS, 1024, 512, 512, win0 + (size_t)C0_QI * 1024, 1024, NOGRP, 0);
    tconv(F, evw + 1152, EVEN_COLS, 1024, 64, 64, win0 + (size_t)C0_KI * 1024, 1024, NOGRP, 0);
    tconv(F, evw + 1216, EVEN_COLS, 1024, 8, 64, win0 + (size_t)C0_WI * 1024, 1024, NOGRP, 0);
    tconv(F, evw + 1224, EVEN_COLS, 1024, 512, 512, win0 + (size_t)C0_QB * 1024, 1024, NOGRP, 0);
    tconv(F, evw + 1736, EVEN_COLS, 1024, 128, 128, win0 + (size_t)C0_KB * 1024, 1024, NOGRP, 0);
    tconv(F, evw + 1864, EVEN_COLS, 1024, 128, 128, win0 + (size_t)C0_VB * 1024, 1024, NOGRP, 0);
    bf16* wout0 = (bf16*)(ws + W_OUT0);
    const float* evo = F.in[I_EV_WOUT];
    tconv(F, evo + (size_t)512 * 1024, 1024, 512, 1024, 1024, wout0 + 1024, 1536, NOGRP, 0);
    tconv(F, F.in[I_OD_WIN], ODD_COLS, 1024, ODD_COLS, 2048, (bf16*)(ws + W_IN1), 1024, NOGRP, 0);
    tconv(F, F.in[I_OD_WOUT], 1024, 1024, 1024, 1024, (bf16*)(ws + W_OUT1), 1024, NOGRP, 0);
    for (int i = 0; i < 2; ++i) {
        tconv(F, F.in[I_XA_WQ] + (size_t)i * 1024 * 512, 512, 1024, 512, 512, (bf16*)(ws + W_XQ) + (size_t)i * 512 * 1024, 1024, NOGRP, 0);
        tconv(F, F.in[I_XA_WK] + (size_t)i * 1024 * 512, 512, 1024, 512, 512, (bf16*)(ws + W_XKV) + (size_t)i * 1024 * 1024, 1024, NOGRP, 0);
        tconv(F, F.in[I_XA_WV] + (size_t)i * 1024 * 512, 512, 1024, 512, 512, (bf16*)(ws + W_XKV) + (size_t)i * 1024 * 1024 + (size_t)512 * 1024, 1024, NOGRP, 0);
        tconv(F, F.in[I_XA_WO] + (size_t)i * 512 * 1024, 1024, 512, 1024, 1024, (bf16*)(ws + W_XO) + (size_t)i * 1024 * 512, 512, NOGRP, 0);
    }
    tconv(F, F.in[I_FF_G], DFF, 1024, DFF, DFF, (bf16*)(ws + W_FGU), 1024, 128, 256);
    tconv(F, F.in[I_FF_U], DFF, 1024, DFF, DFF, (bf16*)(ws + W_FGU) + (size_t)128 * 1024, 1024, 128, 256);
    tconv(F, F.in[I_FF_D], 1024, DFF, 1024, 1024, (bf16*)(ws + W_FD), DFF, NOGRP, 0);
    for (int e = 0; e < NE; ++e) {
        tconv(F, F.in[I_MOE_G] + (size_t)e * 1024 * DFFE, DFFE, 1024, DFFE, DFFE, (bf16*)(ws + W_MGU) + (size_t)e * 7168 * 1024, 1024, 128, 256);
        tconv(F, F.in[I_MOE_U] + (size_t)e * 1024 * DFFE, DFFE, 1024, DFFE, DFFE, (bf16*)(ws + W_MGU) + (size_t)e * 7168 * 1024 + (size_t)128 * 1024, 1024, 128, 256);
        tconv(F, F.in[I_MOE_D] + (size_t)e * DFFE * 1024, 1024, DFFE, 1024, 1024, (bf16*)(ws + W_MD) + (size_t)e * 1024 * DFFE, DFFE, NOGRP, 0);
    }
    __syncthreads();
    {
        const float* wuk = F.in[I_EV_WUK]; const float* wuv = F.in[I_EV_WUV];
        LAS float* As = (LAS float*)F.lds; LAS float* Bs = As + 128 * 65;
        for (int item = blockIdx.x; item < 256; item += F.G) {
            const int h = (item >> 4) & 7, tt = item & 15;
            if (item < 128) {
                const int k0 = 64 * tt;
                for (int i = F.tid; i < 4096; i += 512) { const int kk = i >> 6, d = i & 63; As[kk * 65 + d] = evw[(size_t)(k0 + kk) * EVEN_COLS + h * 64 + d]; }
                for (int i = F.tid; i < 8192; i += 512) Bs[i] = wuk[(size_t)h * 8192 + i];
                __syncthreads();
                const int kk = F.tid & 63, cg = F.tid >> 6; float acc[16];
#pragma unroll
                for (int j = 0; j < 16; ++j) acc[j] = 0.f;
#pragma unroll 4
                for (int d = 0; d < 64; ++d) { const float a = As[kk * 65 + d];
#pragma unroll
                    for (int j = 0; j < 16; ++j) acc[j] += a * Bs[d * 128 + cg * 16 + j]; }
#pragma unroll
                for (int j = 0; j < 16; ++j) win0[(size_t)(C0_QLAT + h * 128 + cg * 16 + j) * 1024 + k0 + kk] = (bf16)f2bf(acc[j]);
            } else {
                const int n0 = 64 * tt;
                for (int i = F.tid; i < 8192; i += 512) { const int c = i >> 6, d = i & 63; As[c * 65 + d] = wuv[(size_t)h * 8192 + i]; }
                for (int i = F.tid; i < 4096; i += 512) { const int d = i >> 6, nn = i & 63; Bs[i] = evo[(size_t)(h * 64 + d) * 1024 + n0 + nn]; }
                __syncthreads();
                const int c = F.tid & 127, ng = F.tid >> 7; float acc[16];
#pragma unroll
                for (int j = 0; j < 16; ++j) acc[j] = 0.f;
#pragma unroll 4
                for (int d = 0; d < 64; ++d) { const float a = As[c * 65 + d];
#pragma unroll
                    for (int j = 0; j < 16; ++j) acc[j] += a * Bs[d * 64 + ng * 16 + j]; }
#pragma unroll
                for (int j = 0; j < 16; ++j) wout0[(size_t)(n0 + ng * 16 + j) * 1536 + h * 128 + c] = (bf16)f2bf(acc[j]);
            }
            __syncthreads();
        }
    }
    {
        const f32x4* x4 = (const f32x4*)F.in[I_X]; v2u* hb = (v2u*)(ws + WS_HB); f32x4* a4 = (f32x4*)F.acc;
        for (int i = gt; i < M * D / 4; i += 4 * NT) { f32x4 v[4];
#pragma unroll
            for (int j = 0; j < 4; ++j) v[j] = x4[i + j * NT];
#pragma unroll
            for (int j = 0; j < 4; ++j) { v2u o; o.x = pk2(v[j].x, v[j].y); o.y = pk2(v[j].z, v[j].w); hb[i + j * NT] = o; a4[i + j * NT] = v[j] * ALPHA; } }
        const f32x4* m4 = (const f32x4*)F.in[I_MEM]; v2u* mb = (v2u*)(ws + WS_MEMB);
        for (int i = gt; i < MMEM * D / 4; i += 4 * NT) { f32x4 v[4];
#pragma unroll
            for (int j = 0; j < 4; ++j) v[j] = m4[i + j * NT];
#pragma unroll
            for (int j = 0; j < 4; ++j) { v2u o; o.x = pk2(v[j].x, v[j].y); o.y = pk2(v[j].z, v[j].w); mb[i + j * NT] = o; } }
    }
}

template <int MODE>
__device__ __forceinline__ void ln_phase(const Frame& F, int li) {
    const float* g = F.in[I_LN_G] + (size_t)li * D; const float* bb = F.in[I_LN_B] + (size_t)li * D;
    LAS int* lcnt = (LAS int*)F.lds;
    if (MODE == 1) { if (F.tid < 16) lcnt[F.tid] = 0; __syncthreads(); }
    for (int row = F.gw; row < M; row += F.NGW) {
        f32x4* p = (f32x4*)(F.acc + (size_t)row * D) + F.lane;
        f32x4 v[4]; float s = 0.f;
#pragma unroll
        for (int j = 0; j < 4; ++j) { v[j] = p[64 * j]; s += (v[j].x + v[j].y) + (v[j].z + v[j].w); }
        const float mean = wave_sum(s) * (1.f / D); float s2 = 0.f;
#pragma unroll
        for (int j = 0; j < 4; ++j) { v[j] = v[j] - mean; s2 += (v[j].x * v[j].x + v[j].y * v[j].y) + (v[j].z * v[j].z + v[j].w * v[j].w); }
        const float rstd = 1.f / sqrtf(wave_sum(s2) * (1.f / D) + LN_EPS);
#pragma unroll
        for (int j = 0; j < 4; ++j) { const f32x4 gg = ((const f32x4*)g)[F.lane + 64 * j], b4 = ((const f32x4*)bb)[F.lane + 64 * j]; v[j] = v[j] * rstd * gg + b4; }
        if (MODE == 2) {
#pragma unroll
            for (int j = 0; j < 4; ++j) p[64 * j] = v[j];
        } else {
            v2u* hb = (v2u*)(F.ws + WS_HB + (size_t)row * D * 2) + F.lane;
#pragma unroll
            for (int j = 0; j < 4; ++j) { v2u o; o.x = pk2(v[j].x, v[j].y); o.y = pk2(v[j].z, v[j].w); hb[64 * j] = o; p[64 * j] = v[j] * ALPHA; }
        }
        if (MODE == 1) {
            const float* wr = F.in[I_MOE_R]; float lg[8];
#pragma unroll
            for (int e = 0; e < 8; ++e) lg[e] = 0.f;
#pragma unroll
            for (int j = 0; j < 4; ++j)
#pragma unroll
                for (int i = 0; i < 4; ++i) { const int c = 4 * (F.lane + 64 * j) + i; const f32x4 w0 = *(const f32x4*)(wr + (size_t)c * 8), w1 = *(const f32x4*)(wr + (size_t)c * 8 + 4); const float y = v[j][i];
                    lg[0] += y * w0.x; lg[1] += y * w0.y; lg[2] += y * w0.z; lg[3] += y * w0.w; lg[4] += y * w1.x; lg[5] += y * w1.y; lg[6] += y * w1.z; lg[7] += y * w1.w; }
#pragma unroll
            for (int e = 0; e < 8; ++e) lg[e] = wave_sum(lg[e]);
            int e0 = 0; float v0 = lg[0];
#pragma unroll
            for (int e = 1; e < 8; ++e) if (lg[e] > v0) { v0 = lg[e]; e0 = e; }
            int e1 = -1; float v1 = -3.0e38f;
#pragma unroll
            for (int e = 0; e < 8; ++e) if (e != e0 && lg[e] > v1) { v1 = lg[e]; e1 = e; }
            const float w0 = 1.f / (1.f + __expf(v1 - v0)), w1 = 1.f - w0;
            if (F.lane == 0) { int* rte = (int*)(F.ws + WS_RTE); float* rtw = (float*)(F.ws + WS_RTW); rte[2 * row] = e0; rte[2 * row + 1] = e1; rtw[2 * row] = w0; rtw[2 * row + 1] = w1;
                atomicAdd((int*)&lcnt[e0], 1); atomicAdd((int*)&lcnt[8 + e1], 1); }
        }
    }
    if (MODE == 1) { __syncthreads(); if (F.tid < 16) { const int c = lcnt[F.tid]; if (c) atomicAdd((unsigned*)(F.ws + WS_CTL) + CW_CNT + F.tid, (unsigned)c); } }
}

__device__ __forceinline__ void moe_dispatch(const Frame& F) {
    unsigned* ctl = (unsigned*)(F.ws + WS_CTL);
    int* tile_exp = (int*)(F.ws + WS_TILEEXP); int* rowtok = (int*)(F.ws + WS_ROWTOK); float* roww = (float*)(F.ws + WS_ROWW);
    LAS int* seg = (LAS int*)F.lds;
    if (F.tid == 0) { int run = 0;
#pragma unroll 1
        for (int sgi = 0; sgi < 16; ++sgi) { if ((sgi & 7) == 0) seg[32 + (sgi >> 3)] = run >> 8; seg[sgi] = run; const int c = (int)__hip_atomic_load(ctl + CW_CNT + sgi, __ATOMIC_RELAXED, __HIP_MEMORY_SCOPE_AGENT); seg[16 + sgi] = c; run += (c + 255) & ~255; }
        seg[34] = run >> 8; }
    __syncthreads();
    if (blockIdx.x == 0) {
#pragma unroll 1
        for (int sgi = 0; sgi < 16; ++sgi) { const int c = seg[16 + sgi], st = seg[sgi], en = st + ((c + 255) & ~255);
            for (int t = (st >> 8) + F.tid; t < (en >> 8); t += 512) tile_exp[t] = sgi & 7;
            for (int r = st + c + F.tid; r < en; r += 512) { rowtok[r] = -1; roww[r] = 0.f; } }
        if (F.tid < 3) tile_exp[512 + F.tid] = seg[32 + F.tid];
    }
    const int* rte = (const int*)(F.ws + WS_RTE); const float* rtw = (const float*)(F.ws + WS_RTW);
    for (int base = F.gw * 64; base < M; base += F.NGW * 64) {
        const int tok = base + F.lane; const int e0 = rte[2 * tok], e1 = rte[2 * tok + 1]; const float w0 = rtw[2 * tok], w1 = rtw[2 * tok + 1];
        int pos0 = 0, pos1 = 0;
#pragma unroll 1
        for (int sgi = 0; sgi < 16; ++sgi) { const bool mine = (sgi < 8) ? (e0 == sgi) : (e1 == sgi - 8);
            const unsigned long long bal = __ballot(mine);
            if (bal) { const int n = __popcll(bal); unsigned b0 = 0; if (F.lane == 0) b0 = atomicAdd(ctl + CW_CUR + sgi, (unsigned)n); b0 = __shfl(b0, 0);
                const int rank = __popcll(bal & ((1ull << F.lane) - 1ull));
                if (mine) { const int pos = seg[sgi] + (int)b0 + rank; if (sgi < 8) pos0 = pos; else pos1 = pos; } } }
        rowtok[pos0] = tok; roww[pos0] = w0; rowtok[pos1] = tok; roww[pos1] = w1;
#pragma unroll 1
        for (int i = 0; i < 64; ++i) { const int tk = base + i; const int p0 = __shfl(pos0, i), p1 = __shfl(pos1, i);
            const v4u* src = (const v4u*)(F.ws + WS_HB + (size_t)tk * D * 2);
            v4u* d0 = (v4u*)(F.ws + WS_PERMA + (size_t)p0 * D * 2); v4u* d1 = (v4u*)(F.ws + WS_PERMA + (size_t)p1 * D * 2);
            const v4u a = src[F.lane], b = src[F.lane + 64]; d0[F.lane] = a; d0[F.lane + 64] = b; d1[F.lane] = a; d1[F.lane + 64] = b; }
    }
    __syncthreads();
}

__device__ __forceinline__ void cn_phase(const Frame& F) {
    const bf16* P0 = (const bf16*)(F.ws + WS_P0); bf16* CN = (bf16*)(F.ws + WS_CN); const float* gain = F.in[I_EV_GAIN];
    for (int row = F.gw; row < M; row += F.NGW) {
        const unsigned w = *(const unsigned*)(P0 + (size_t)row * P0_LD + C0_CKV + 2 * F.lane); const float a = bflo(w), b = bfhi(w);
        const float ms = wave_sum(a * a + b * b) * (1.f / 128.f); const float r = 1.f / sqrtf(ms + LN_EPS);
        *(unsigned*)(CN + (size_t)row * 128 + 2 * F.lane) = pk2(a * r * gain[2 * F.lane], b * r * gain[2 * F.lane + 1]);
    }
}

__device__ __forceinline__ unsigned fkey(float x) { unsigned b = __builtin_bit_cast(unsigned, x); if (b == 0x80000000u) b = 0u; return (b & 0x80000000u) ? ~b : (b | 0x80000000u); }
__device__ __forceinline__ void idx_phase(const Frame& F) {
    const bf16* P0 = (const bf16*)(F.ws + WS_P0); unsigned* MASK = (unsigned*)(F.ws + WS_MASK);
    LAS float* qi_s = (LAS float*)F.lds; LAS float* wi_s = qi_s + 4096; LAS float* sc = wi_s + 64;
    for (int item = blockIdx.x; item < NB * (S / 8); item += F.G) {
        const int b = item / (S / 8), t0 = (item % (S / 8)) * 8;
        for (int i = F.tid; i < 4096; i += 512) { const int q = i >> 9, e = i & 511; qi_s[i] = bf2f(P0[(size_t)(b * S + t0 + q) * P0_LD + C0_QI + e]); }
        if (F.tid < 64) { const int q = F.tid >> 3, h = F.tid & 7; wi_s[F.tid] = bf2f(P0[(size_t)(b * S + t0 + q) * P0_LD + C0_WI + h]) * (0.35355339059f * 0.125f); }
        __syncthreads();
        const int nk = t0 + 8;
        for (int s = F.tid; s < nk; s += 512) {
            float kf[64]; const bf16* kr = P0 + (size_t)(b * S + s) * P0_LD + C0_KI;
#pragma unroll
            for (int j = 0; j < 8; ++j) ld8bf(kr + 8 * j, kf + 8 * j);
#pragma unroll 1
            for (int q = 0; q < 8; ++q) { float a = 0.f;
#pragma unroll 1
                for (int h = 0; h < 8; ++h) { const LAS float* qp = qi_s + q * 512 + h * 64; float dot = 0.f;
#pragma unroll
                    for (int d = 0; d < 64; ++d) dot += qp[d] * kf[d];
                    a += wi_s[q * 8 + h] * fmaxf(dot, 0.f); }
                sc[q * 2048 + s] = a; }
        }
        __syncthreads();
        {
            const int q = F.wave, t = t0 + q, n = t + 1, row = b * S + t; unsigned myword = 0u;
            if (n <= 256) { const int cb = n - 32 * F.lane; myword = cb >= 32 ? 0xffffffffu : (cb <= 0 ? 0u : ((1u << cb) - 1u)); }
            else {
                LAS unsigned* uk = (LAS unsigned*)(sc + q * 2048);
#pragma unroll 4
                for (int i = 0; i < 32; ++i) { const int s = F.lane + 64 * i; const unsigned k = (s < n) ? fkey(sc[q * 2048 + s]) : 0u; uk[s] = k; }
                LDS_WAIT();
                unsigned prefix = 0u;
#pragma unroll 1
                for (int bit = 31; bit >= 0; --bit) { const unsigned cand = prefix | (1u << bit); int c = 0;
#pragma unroll 8
                    for (int i = 0; i < 32; ++i) c += (uk[F.lane + 64 * i] >= cand) ? 1 : 0;
#pragma unroll
                    for (int o = 1; o < 64; o <<= 1) c += __shfl_xor(c, o);
                    if (c >= 256) prefix = cand; }
                int cgt = 0;
#pragma unroll 8
                for (int i = 0; i < 32; ++i) cgt += (uk[F.lane + 64 * i] > prefix) ? 1 : 0;
#pragma unroll
                for (int o = 1; o < 64; o <<= 1) cgt += __shfl_xor(cgt, o);
                const int need = 256 - cgt; int run = 0;
#pragma unroll 1
                for (int i = 0; i < 32; ++i) { const unsigned u = uk[F.lane + 64 * i]; const bool eq = (u == prefix); const unsigned long long em = __ballot(eq); const int rank = run + __popcll(em & ((1ull << F.lane) - 1ull));
                    const bool sel = (u > prefix) || (eq && rank < need); run += __popcll(em);
                    const unsigned long long sm = __ballot(sel);
                    if (F.lane == 2 * i) myword = (unsigned)sm; if (F.lane == 2 * i + 1) myword = (unsigned)(sm >> 32); }
            }
            MASK[(size_t)row * 64 + F.lane] = myword;
        }
        __syncthreads();
    }
}

__device__ __forceinline__ void dsa_phase(const Frame& F) {
    bf16* P0 = (bf16*)(F.ws + WS_P0); const bf16* CN = (const bf16*)(F.ws + WS_CN); const unsigned* MASK = (const unsigned*)(F.ws + WS_MASK); const float* rel = F.in[I_REL];
    LAS float* ql = (LAS float*)(F.lds + F.wave * 13312); LAS float* pl = ql + 1024; LAS int* idx = (LAS int*)(pl + 2048);
    for (int row = F.gw; row < M; row += F.NGW) {
        const int b = row / S, t = row % S;
        const unsigned w = MASK[(size_t)row * 64 + F.lane]; const int c = __popc(w);
        int incl = c;
#pragma unroll
        for (int o = 1; o < 64; o <<= 1) { const int v = __shfl_up(incl, o); if (F.lane >= o) incl += v; }
        const int total = __shfl(incl, 63); int pos = incl - c; unsigned ww = w;
        while (ww) { const int bit = __ffs(ww) - 1; idx[pos++] = 32 * F.lane + bit; ww &= ww - 1u; }
#pragma unroll
        for (int i = 0; i < 16; ++i) ql[F.lane + 64 * i] = bf2f(P0[(size_t)row * P0_LD + C0_QLAT + F.lane + 64 * i]);
        WAVE_SYNC();
        float lg[4][8]; bool val[4];
#pragma unroll
        for (int kk = 0; kk < 4; ++kk) { const int k = F.lane + 64 * kk; val[kk] = k < total; const int key = val[kk] ? idx[k] : 0;
            float a[8];
#pragma unroll
            for (int h = 0; h < 8; ++h) a[h] = 0.f;
            const bf16* cr = CN + (size_t)(b * S + key) * 128;
#pragma unroll 1
            for (int j = 0; j < 16; ++j) { float cv[8]; ld8bf(cr + 8 * j, cv);
#pragma unroll
                for (int h = 0; h < 8; ++h)
#pragma unroll
                    for (int i = 0; i < 8; ++i) a[h] += ql[h * 128 + 8 * j + i] * cv[i]; }
            const int bk = rel_bucket(t - key);
#pragma unroll
            for (int h = 0; h < 8; ++h) lg[kk][h] = val[kk] ? (a[h] * 0.125f + rel[bk * 16 + h]) : -1.0e30f;
        }
#pragma unroll
        for (int h = 0; h < 8; ++h) { float m = fmaxf(fmaxf(lg[0][h], lg[1][h]), fmaxf(lg[2][h], lg[3][h])); m = wave_max(m);
            float e[4], s = 0.f;
#pragma unroll
            for (int kk = 0; kk < 4; ++kk) { e[kk] = val[kk] ? __expf(lg[kk][h] - m) : 0.f; s += e[kk]; }
            s = wave_sum(s); const float inv = 1.f / s;
#pragma unroll
            for (int kk = 0; kk < 4; ++kk) pl[h * 256 + F.lane + 64 * kk] = e[kk] * inv; }
        WAVE_SYNC();
        float a0[8], a1[8];
#pragma unroll
        for (int h = 0; h < 8; ++h) { a0[h] = 0.f; a1[h] = 0.f; }
        for (int k = 0; k < total; ++k) { const int key = idx[k]; const unsigned pr = *(const unsigned*)(CN + (size_t)(b * S + key) * 128 + 2 * F.lane); const float vx = bflo(pr), vy = bfhi(pr);
#pragma unroll
            for (int h = 0; h < 8; ++h) { const float p = pl[h * 256 + k]; a0[h] += p * vx; a1[h] += p * vy; } }
#pragma unroll
        for (int h = 0; h < 8; ++h) *(unsigned*)(P0 + (size_t)row * P0_LD + C0_QLAT + h * 128 + 2 * F.lane) = pk2(a0[h], a1[h]);
        WAVE_SYNC();
    }
}

template <int W, int NH, int GRPSZ, bool SINK, bool NSA>
__device__ __forceinline__ void banded_phase(const Frame& F, bf16* P, int ld, int cq, int ck, int cv, int relc0) {
    const float* rel = F.in[I_REL]; const float* sinks = F.in[I_EV_SINK];
    const bf16* OC = (const bf16*)(F.ws + WS_OCMP); const bf16* OS = (const bf16*)(F.ws + WS_OSLC);
    constexpr int NTG = S / 64;
    for (int it = F.gw; it < NB * NH * NTG; it += F.NGW) {
        const int tg = it % NTG, h = (it / NTG) % NH, b = it / (NTG * NH);
        const int t = tg * 64 + F.lane, row = b * S + t, kvh = h / GRPSZ;
        float q[64], acc[64];
        { const bf16* qr = P + (size_t)row * ld + cq + h * 64;
#pragma unroll
          for (int j = 0; j < 8; ++j) ld8bf(qr + 8 * j, q + 8 * j); }
#pragma unroll
        for (int d = 0; d < 64; ++d) acc[d] = 0.f;
        float m = SINK ? sinks[h] : -1.0e30f, l = SINK ? 1.f : 0.f;
#pragma unroll 1
        for (int j = 0; j < W; ++j) { const int s = t - j;
            const float bias = rel[rel_bucket(j) * 16 + relc0 + h];
            if (s >= 0) { const bf16* kr = P + (size_t)(b * S + s) * ld + ck + kvh * 64; float dot = 0.f;
#pragma unroll
                for (int jj = 0; jj < 8; ++jj) { float kf[8]; ld8bf(kr + 8 * jj, kf);
#pragma unroll
                    for (int i = 0; i < 8; ++i) dot += q[8 * jj + i] * kf[i]; }
                const float lgt = dot * 0.125f + bias, mn = fmaxf(m, lgt), corr = __expf(m - mn), p = __expf(lgt - mn);
                l = l * corr + p; m = mn;
                const bf16* vr = P + (size_t)(b * S + s) * ld + cv + kvh * 64;
#pragma unroll
                for (int jj = 0; jj < 8; ++jj) { float vf[8]; ld8bf(vr + 8 * jj, vf);
#pragma unroll
                    for (int i = 0; i < 8; ++i) acc[8 * jj + i] = acc[8 * jj + i] * corr + p * vf[i]; } } }
        const float inv = 1.f / l;
        float g0 = 0.f, g1 = 0.f, g2 = 1.f;
        if (NSA) { const bf16* gr = P + (size_t)row * ld + C1_GL + h * 3; g0 = 1.f / (1.f + __expf(-bf2f(gr[0]))); g1 = 1.f / (1.f + __expf(-bf2f(gr[1]))); g2 = 1.f / (1.f + __expf(-bf2f(gr[2]))); }
        bf16* orow = P + (size_t)row * ld + cq + h * 64;
#pragma unroll
        for (int jj = 0; jj < 8; ++jj) { float o[8];
#pragma unroll
            for (int i = 0; i < 8; ++i) o[i] = acc[8 * jj + i] * inv;
            if (NSA) { float c8[8], s8[8]; ld8bf(OC + (size_t)row * D + h * 64 + 8 * jj, c8); ld8bf(OS + (size_t)row * D + h * 64 + 8 * jj, s8);
#pragma unroll
                for (int i = 0; i < 8; ++i) o[i] = g0 * c8[i] + g1 * s8[i] + g2 * o[i]; }
            v4u w; w.x = pk2(o[0], o[1]); w.y = pk2(o[2], o[3]); w.z = pk2(o[4], o[5]); w.w = pk2(o[6], o[7]);
            *(v4u*)(orow + 8 * jj) = w; }
    }
}

__device__ __forceinline__ void xattn_phase(const Frame& F, const bf16* Q, const bf16* KV, bf16* O) {
    for (int it = F.gw; it < NB * 4 * (S / 32); it += F.NGW) {
        const int tg = it % (S / 32), h = (it / (S / 32)) % 4, b = it / ((S / 32) * 4);
        const int tok = tg * 32 + (F.lane >> 1), half = F.lane & 1, row = b * S + tok;
        float q[64], acc[64];
        { const bf16* qr = Q + (size_t)row * 512 + h * 128 + half * 64;
#pragma unroll
          for (int j = 0; j < 8; ++j) ld8bf(qr + 8 * j, q + 8 * j); }
#pragma unroll
        for (int d = 0; d < 64; ++d) acc[d] = 0.f;
        float m = -1.0e30f, l = 0.f;
#pragma unroll 1
        for (int mm = 0; mm < MEML; ++mm) { const bf16* kr = KV + (size_t)(b * MEML + mm) * 1024 + h * 128 + half * 64; float dot = 0.f;
#pragma unroll
            for (int jj = 0; jj < 8; ++jj) { float kf[8]; ld8bf(kr + 8 * jj, kf);
#pragma unroll
                for (int i = 0; i < 8; ++i) dot += q[8 * jj + i] * kf[i]; }
            dot += __shfl_xor(dot, 1);
            const float lgt = dot * 0.08838834764831845f, mn = fmaxf(m, lgt), corr = __expf(m - mn), p = __expf(lgt - mn);
            l = l * corr + p; m = mn;
            const bf16* vr = kr + 512;
#pragma unroll
            for (int jj = 0; jj < 8; ++jj) { float vf[8]; ld8bf(vr + 8 * jj, vf);
#pragma unroll
                for (int i = 0; i < 8; ++i) acc[8 * jj + i] = acc[8 * jj + i] * corr + p * vf[i]; } }
        const float inv = 1.f / l; bf16* orow = O + (size_t)row * 512 + h * 128 + half * 64;
#pragma unroll
        for (int jj = 0; jj < 8; ++jj) { v4u w; w.x = pk2(acc[8 * jj] * inv, acc[8 * jj + 1] * inv); w.y = pk2(acc[8 * jj + 2] * inv, acc[8 * jj + 3] * inv); w.z = pk2(acc[8 * jj + 4] * inv, acc[8 * jj + 5] * inv); w.w = pk2(acc[8 * jj + 6] * inv, acc[8 * jj + 7] * inv);
            *(v4u*)(orow + 8 * jj) = w; }
    }
}

__device__ __forceinline__ float gelu_tanh(float x) { const float u = 0.7978845608028654f * (x + 0.044715f * x * x * x); return 0.5f * x * (1.f + tanhf(u)); }
__device__ __forceinline__ void cmp_mlp_phase(const Frame& F) {
    const bf16* P1 = (const bf16*)(F.ws + WS_P1);
    LAS float* blk = (LAS float*)F.lds; LAS float* part = blk + 2048; LAS float* hid = part + 512;
    for (int item = blockIdx.x; item < 2 * NB * NCMP * 2; item += F.G) {
        const int g = item & 1, n = (item >> 1) % NCMP, b = ((item >> 1) / NCMP) % NB, which = (item >> 1) / (NCMP * NB);
        const float* pe = which ? F.in[I_OD_PEV] : F.in[I_OD_PEK]; const float* w1 = which ? F.in[I_OD_W1V] : F.in[I_OD_W1K]; const float* w2 = which ? F.in[I_OD_W2V] : F.in[I_OD_W2K];
        bf16* outp = (bf16*)(F.ws + (which ? WS_VC : WS_KC)) + ((size_t)(b * 2 + g) * 128 + n) * 64;
        const int col0 = (which ? C1_VC : C1_KC) + g * 64;
        for (int i = F.tid; i < 2048; i += 512) { const int l = i >> 6, d = i & 63; blk[i] = bf2f(P1[(size_t)(b * S + 16 * n + l) * P1_LD + col0 + d]) + pe[i]; }
        __syncthreads();
        { const int j = F.tid & 127, pp = F.tid >> 7; float a = 0.f; const float* wp = w1 + (size_t)(pp * 512) * 128 + j; const LAS float* bp = blk + pp * 512;
#pragma unroll 8
          for (int kk = 0; kk < 512; ++kk) a += bp[kk] * wp[(size_t)kk * 128];
          part[F.tid] = a; }
        __syncthreads();
        if (F.tid < 128) hid[F.tid] = gelu_tanh((part[F.tid] + part[F.tid + 128]) + (part[F.tid + 256] + part[F.tid + 384]));
        __syncthreads();
        if (F.tid < 64) { float a = 0.f;
#pragma unroll 8
            for (int j = 0; j < 128; ++j) a += hid[j] * w2[j * 64 + F.tid];
            outp[F.tid] = (bf16)f2bf(a); if (n == NCMP - 1) outp[64 + F.tid] = 0; }
        __syncthreads();
    }
}

__device__ __forceinline__ void cmp_attn_phase(const Frame& F) {
    const bf16* P1 = (const bf16*)(F.ws + WS_P1); const float* KC = (const float*)(F.ws + WS_KC); const float* VC = (const float*)(F.ws + WS_VC);
    bf16* OC = (bf16*)(F.ws + WS_OCMP); unsigned* SELM = (unsigned*)(F.ws + WS_SELM); const float* rel = F.in[I_REL];
    LAS float* qs = (LAS float*)(F.lds + F.wave * 8192); LAS float* pl = qs + 512; LAS float* psum = pl + 1024;
    for (int it = F.gw; it < M * 2; it += F.NGW) {
        const int g = it & 1, row = it >> 1, b = row / S, t = row % S;
        const int nv = (t >= 31) ? ((t - 31) / 16 + 1) : 0;
#pragma unroll
        for (int i = 0; i < 8; ++i) qs[F.lane + 64 * i] = bf2f(P1[(size_t)row * P1_LD + C1_Q + g * 512 + F.lane + 64 * i]);
        WAVE_SYNC();
        float lg[2][8]; bool val[2];
#pragma unroll
        for (int kk = 0; kk < 2; ++kk) { const int n = F.lane + 64 * kk; val[kk] = n < nv; const int nn = val[kk] ? n : 0;
            const float* kr = KC + ((size_t)(b * NCMP + nn) * 2 + g) * 64; float a[8];
#pragma unroll
            for (int h = 0; h < 8; ++h) a[h] = 0.f;
#pragma unroll 1
            for (int j = 0; j < 16; ++j) { const f32x4 kv = *(const f32x4*)(kr + 4 * j);
#pragma unroll
                for (int h = 0; h < 8; ++h) a[h] += qs[h * 64 + 4 * j] * kv.x + qs[h * 64 + 4 * j + 1] * kv.y + qs[h * 64 + 4 * j + 2] * kv.z + qs[h * 64 + 4 * j + 3] * kv.w; }
            const int bk = rel_bucket(val[kk] ? (t - (16 * nn + 31)) : 0);
#pragma unroll
            for (int h = 0; h < 8; ++h) lg[kk][h] = val[kk] ? (a[h] * 0.125f + rel[bk * 16 + g * 8 + h]) : -1.0e30f; }
        float ps[2] = {0.f, 0.f};
#pragma unroll
        for (int h = 0; h < 8; ++h) { float m = wave_max(fmaxf(lg[0][h], lg[1][h]));
            float e0 = val[0] ? __expf(lg[0][h] - m) : 0.f, e1 = val[1] ? __expf(lg[1][h] - m) : 0.f;
            const float s = wave_sum(e0 + e1); const float inv = (nv > 0) ? 1.f / s : 0.f; e0 *= inv; e1 *= inv;
            pl[h * 128 + F.lane] = e0; pl[h * 128 + 64 + F.lane] = e1; ps[0] += e0; ps[1] += e1; }
        psum[F.lane] = ps[0]; psum[64 + F.lane] = ps[1];
        WAVE_SYNC();
        float scj = -3.0e38f; bool adm = false;
        if (F.lane < 32) { const int j = F.lane; float p = 0.f;
#pragma unroll
            for (int n = 4 * j - 1; n <= 4 * j + 3; ++n) if (n >= 0 && n < NCMP) p += psum[n];
            const int blkq = t >> 6; adm = (64 * j <= t); const bool forced = (j == 0) || (j == blkq) || (j == blkq - 1);
            scj = adm ? (p + (forced ? 1.0e6f : 0.f)) : -1.0e30f; }
        int rank = 0;
#pragma unroll 1
        for (int i = 0; i < 32; ++i) { const float si = __shfl(scj, i); rank += (si > scj || (si == scj && i < F.lane)) ? 1 : 0; }
        const unsigned long long sm = __ballot(F.lane < 32 && adm && rank < 8);
        if (F.lane == 0) SELM[(size_t)row * 2 + g] = (unsigned)sm;
        float o[8];
#pragma unroll
        for (int h = 0; h < 8; ++h) o[h] = 0.f;
        for (int n = 0; n < nv; ++n) { const float v = VC[((size_t)(b * NCMP + n) * 2 + g) * 64 + F.lane];
#pragma unroll
            for (int h = 0; h < 8; ++h) o[h] += pl[h * 128 + n] * v; }
#pragma unroll
        for (int h = 0; h < 8; ++h) OC[(size_t)row * D + (g * 8 + h) * 64 + F.lane] = (bf16)f2bf(o[h]);
        WAVE_SYNC();
    }
}

__device__ __forceinline__ void slc_attn_phase(const Frame& F) {
    const bf16* P1 = (const bf16*)(F.ws + WS_P1); const unsigned* SELM = (const unsigned*)(F.ws + WS_SELM); bf16* OS = (bf16*)(F.ws + WS_OSLC); const float* rel = F.in[I_REL];
    LAS float* qs = (LAS float*)(F.lds + F.wave * 4096); LAS float* pb = qs + 512;
    for (int it = F.gw; it < M * 2; it += F.NGW) {
        const int g = it & 1, row = it >> 1, b = row / S, t = row % S;
#pragma unroll
        for (int i = 0; i < 8; ++i) qs[F.lane + 64 * i] = bf2f(P1[(size_t)row * P1_LD + C1_Q + g * 512 + F.lane + 64 * i]);
        WAVE_SYNC();
        unsigned sel = SELM[(size_t)row * 2 + g];
        float m[8], l[8], acc[8];
#pragma unroll
        for (int h = 0; h < 8; ++h) { m[h] = -1.0e30f; l[h] = 0.f; acc[h] = 0.f; }
        while (sel) { const int jb = __ffs(sel) - 1; sel &= sel - 1u;
            const int kpos = 64 * jb + F.lane; const bool valid = kpos <= t;
            const bf16* kr = P1 + (size_t)(b * S + kpos) * P1_LD + C1_KS + g * 64; float a[8];
#pragma unroll
            for (int h = 0; h < 8; ++h) a[h] = 0.f;
#pragma unroll 1
            for (int j = 0; j < 8; ++j) { float kf[8]; ld8bf(kr + 8 * j, kf);
#pragma unroll
                for (int h = 0; h < 8; ++h)
#pragma unroll
                    for (int i = 0; i < 8; ++i) a[h] += qs[h * 64 + 8 * j + i] * kf[i]; }
            const int bk = rel_bucket(valid ? (t - kpos) : 0);
            float corr[8];
#pragma unroll
            for (int h = 0; h < 8; ++h) { const float lgt = valid ? (a[h] * 0.125f + rel[bk * 16 + g * 8 + h]) : -1.0e30f;
                const float bm = wave_max(lgt), mn = fmaxf(m[h], bm); corr[h] = __expf(m[h] - mn); const float p = valid ? __expf(lgt - mn) : 0.f;
                l[h] = l[h] * corr[h] + wave_sum(p); m[h] = mn; pb[h * 64 + F.lane] = p; }
            WAVE_SYNC();
            const bf16* vb = P1 + (size_t)(b * S + 64 * jb) * P1_LD + C1_VS + g * 64 + F.lane;
            float add[8];
#pragma unroll
            for (int h = 0; h < 8; ++h) add[h] = 0.f;
            for (int k = 0; k < 64; ++k) { const float v = bf2f(vb[(size_t)k * P1_LD]);
#pragma unroll
                for (int h = 0; h < 8; ++h) add[h] += pb[h * 64 + k] * v; }
#pragma unroll
            for (int h = 0; h < 8; ++h) acc[h] = acc[h] * corr[h] + add[h];
            WAVE_SYNC();
        }
#pragma unroll
        for (int h = 0; h < 8; ++h) OS[(size_t)row * D + (g * 8 + h) * 64 + F.lane] = (bf16)f2bf(acc[h] / l[h]);
    }
}

namespace fa {
typedef short bf16x8 __attribute__((ext_vector_type(8)));
typedef short bf16x4 __attribute__((ext_vector_type(4)));
typedef float f32x16 __attribute__((ext_vector_type(16)));
constexpr int VSTR = 68;
template <int HDK, int HDV> struct Geo { static constexpr int KSTR = HDK + 8, KBYTES = 64 * KSTR * 2, VBYTES = HDV * VSTR * 2, BUF = KBYTES + VBYTES; };
template <int HDK, int HDV, bool KV_SAME> struct Stage { v4u k[HDK / 64]; v4u v[KV_SAME ? 1 : HDV / 64]; };

template <int HDK, int HDV, bool KV_SAME, class P>
__device__ __forceinline__ void load_tile(Stage<HDK, HDV, KV_SAME>& st, const P& pol, int j, int tid) {
#pragma unroll
    for (int i = 0; i < HDK / 64; ++i) { const int c = tid + 512 * i, r = c / (HDK / 8), ch = c % (HDK / 8); st.k[i] = *(const v4u*)(pol.krow(j, r) + 8 * ch); }
    if (!KV_SAME) {
#pragma unroll
        for (int i = 0; i < HDV / 64; ++i) { const int c = tid + 512 * i, r = c / (HDV / 8), ch = c % (HDV / 8); st.v[i] = *(const v4u*)(pol.vrow(j, r) + 8 * ch); }
    }
}
template <int HDK, int HDV, bool KV_SAME>
__device__ __forceinline__ void store_tile(const Stage<HDK, HDV, KV_SAME>& st, LAS unsigned char* buf, int tid) {
    typedef Geo<HDK, HDV> G;
    LAS bf16* Ks = (LAS bf16*)buf; LAS bf16* Vt = (LAS bf16*)(buf + G::KBYTES);
#pragma unroll
    for (int i = 0; i < HDK / 64; ++i) { const int c = tid + 512 * i, r = c / (HDK / 8), ch = c % (HDK / 8); *(LAS v4u*)(Ks + r * G::KSTR + 8 * ch) = st.k[i]; }
#pragma unroll
    for (int i = 0; i < HDV / 64; ++i) { const int c = tid + 512 * i, r = c / (HDV / 8), ch = c % (HDV / 8); const v4u w = KV_SAME ? st.k[i] : st.v[i];
        LAS bf16* vp = Vt + (8 * ch) * VSTR + r;
        vp[0 * VSTR] = (bf16)(w.x & 0xffffu); vp[1 * VSTR] = (bf16)(w.x >> 16); vp[2 * VSTR] = (bf16)(w.y & 0xffffu); vp[3 * VSTR] = (bf16)(w.y >> 16);
        vp[4 * VSTR] = (bf16)(w.z & 0xffffu); vp[5 * VSTR] = (bf16)(w.z >> 16); vp[6 * VSTR] = (bf16)(w.w & 0xffffu); vp[7 * VSTR] = (bf16)(w.w >> 16); }
}
template <int HDK, int HDV, class P>
__device__ __forceinline__ void compute_tile(const LAS unsigned char* buf, const P& pol, int j, int lane, const bf16x8 (&qf)[HDK / 16], f32x16 (&o)[HDV / 32], float& m, float& l) {
    typedef Geo<HDK, HDV> G;
    const LAS bf16* Ks = (const LAS bf16*)buf; const LAS bf16* Vt = (const LAS bf16*)(buf + G::KBYTES);
    const int r = lane & 31, h = lane >> 5;
    f32x16 s[2];
#pragma unroll
    for (int kb = 0; kb < 2; ++kb) {
#pragma unroll
        for (int e = 0; e < 16; ++e) s[kb][e] = 0.f;
#pragma unroll
        for (int ks = 0; ks < HDK / 16; ++ks) { const bf16x8 a = *(const LAS bf16x8*)(Ks + (32 * kb + r) * G::KSTR + 16 * ks + 8 * h);
            s[kb] = __builtin_amdgcn_mfma_f32_32x32x16_bf16(a, qf[ks], s[kb], 0, 0, 0); }
    }
    pol.transform(j, s, lane);
    float mx = -INFINITY;
#pragma unroll
    for (int kb = 0; kb < 2; ++kb)
#pragma unroll
        for (int e = 0; e < 16; ++e) mx = fmaxf(mx, s[kb][e]);
    mx = fmaxf(mx, __shfl_xor(mx, 32));
    const float mn = fmaxf(m, mx), mref = (mn == -INFINITY) ? 0.f : mn;
    const float corr = __expf(m - mref);
    float rs = 0.f;
#pragma unroll
    for (int kb = 0; kb < 2; ++kb)
#pragma unroll
        for (int e = 0; e < 16; ++e) { s[kb][e] = __expf(s[kb][e] - mref); rs += s[kb][e]; }
    rs += __shfl_xor(rs, 32);
    l = l * corr + rs; m = mn;
#pragma unroll
    for (int blk = 0; blk < HDV / 32; ++blk)
#pragma unroll
        for (int e = 0; e < 16; ++e) o[blk][e] *= corr;
#pragma unroll
    for (int kb = 0; kb < 2; ++kb)
#pragma unroll
        for (int s2 = 0; s2 < 2; ++s2) {
            v4u pw; pw.x = pg8::cvt_pk_bf16(s[kb][8 * s2 + 0], s[kb][8 * s2 + 1]); pw.y = pg8::cvt_pk_bf16(s[kb][8 * s2 + 2], s[kb][8 * s2 + 3]);
            pw.z = pg8::cvt_pk_bf16(s[kb][8 * s2 + 4], s[kb][8 * s2 + 5]); pw.w = pg8::cvt_pk_bf16(s[kb][8 * s2 + 6], s[kb][8 * s2 + 7]);
            const bf16x8 pf = __builtin_bit_cast(bf16x8, pw);
#pragma unroll
            for (int blk = 0; blk < HDV / 32; ++blk) { const LAS bf16* vp = Vt + (32 * blk + r) * VSTR + 32 * kb + 16 * s2 + 4 * h;
                const bf16x4 lo = *(const LAS bf16x4*)vp, hi = *(const LAS bf16x4*)(vp + 8);
                const bf16x8 a = __builtin_shufflevector(lo, hi, 0, 1, 2, 3, 4, 5, 6, 7);
                o[blk] = __builtin_amdgcn_mfma_f32_32x32x16_bf16(a, pf, o[blk], 0, 0, 0); }
        }
}
template <int HDK, int HDV, bool KV_SAME, class P>
__device__ __forceinline__ void run(LAS unsigned char* lds, const P& pol, unsigned tmask, int tid, int lane, const bf16x8 (&qf)[HDK / 16], f32x16 (&o)[HDV / 32], float& m, float& l) {
    typedef Geo<HDK, HDV> G;
    if (tmask == 0u) return;
    Stage<HDK, HDV, KV_SAME> st;
    int j = __builtin_ctz(tmask); tmask &= tmask - 1u; int cur = 0;
    load_tile<HDK, HDV, KV_SAME>(st, pol, j, tid); store_tile<HDK, HDV, KV_SAME>(st, lds, tid);
    __syncthreads();
    for (;;) {
        const bool more = tmask != 0u; int jn = 0;
        if (more) { jn = __builtin_ctz(tmask); tmask &= tmask - 1u; load_tile<HDK, HDV, KV_SAME>(st, pol, jn, tid); }
        compute_tile<HDK, HDV>(lds + cur * G::BUF, pol, j, lane, qf, o, m, l);
        if (!more) break;
        store_tile<HDK, HDV, KV_SAME>(st, lds + (cur ^ 1) * G::BUF, tid);
        __syncthreads();
        cur ^= 1; j = jn;
    }
    __syncthreads();
}
}

__device__ __forceinline__ void build_bias_table(const Frame& F, LAS float* tab, int nheads, int relc0) {
    const float* rel = F.in[I_REL];
    for (int i = F.tid; i < nheads * 129; i += 512) { const int hh = i / 129, d = i % 129; tab[hh * 132 + d] = rel[rel_bucket(d) * 16 + relc0 + hh]; }
    __syncthreads();
}
struct BandPol {
    const bf16* kbase; const bf16* vbase; int ld; int tq, tq0, W; const LAS float* bl;
    __device__ __forceinline__ const bf16* krow(int j, int r) const { return kbase + (size_t)(64 * j + r) * ld; }
    __device__ __forceinline__ const bf16* vrow(int j, int r) const { return vbase + (size_t)(64 * j + r) * ld; }
    __device__ __forceinline__ void transform(int j, fa::f32x16 (&s)[2], int lane) const {
        const int k0 = 64 * j, h = lane >> 5;
        if (tq0 - (k0 + 63) >= 128 && (tq0 + 31) - k0 < W) {
            const float b31 = bl[128];
#pragma unroll
            for (int kb = 0; kb < 2; ++kb)
#pragma unroll
                for (int e = 0; e < 16; ++e) s[kb][e] = s[kb][e] * 0.125f + b31;
        } else {
#pragma unroll
            for (int kb = 0; kb < 2; ++kb)
#pragma unroll
                for (int e = 0; e < 16; ++e) { const int key = k0 + 32 * kb + 8 * (e >> 2) + 4 * h + (e & 3); const int dist = tq - key;
                    const int di = dist < 0 ? 0 : (dist > 128 ? 128 : dist);
                    const float v = s[kb][e] * 0.125f + bl[di];
                    s[kb][e] = (dist >= 0 && dist < W) ? v : -INFINITY; }
        }
    }
};
__device__ __forceinline__ void win_phase_mfma(const Frame& F) {
    bf16* P1 = (bf16*)(F.ws + WS_P1); const bf16* OC = (const bf16*)(F.ws + WS_OCMP); const bf16* OS = (const bf16*)(F.ws + WS_OSLC);
    LAS float* tab = (LAS float*)(F.lds + 36864);
    build_bias_table(F, tab, 16, 0);
    const int h = F.lane >> 5;
    for (int u = blockIdx.x; u < NB * 2 * 64; u += F.G) {
        const int b = u >> 7, g = (u >> 6) & 1, qt = u & 63, tq0 = 32 * qt, head = g * 8 + F.wave, tq = tq0 + (F.lane & 31);
        const size_t row = (size_t)b * S + tq;
        fa::bf16x8 qf[4];
#pragma unroll
        for (int ks = 0; ks < 4; ++ks) qf[ks] = *(const fa::bf16x8*)(P1 + row * P1_LD + C1_Q + head * 64 + 16 * ks + 8 * h);
        fa::f32x16 o[2];
#pragma unroll
        for (int blk = 0; blk < 2; ++blk)
#pragma unroll
            for (int e = 0; e < 16; ++e) o[blk][e] = 0.f;
        float m = -INFINITY, l = 0.f;
        const int jlo = (tq0 - 511 > 0 ? tq0 - 511 : 0) >> 6, jhi = (tq0 + 31) >> 6;
        const unsigned tmask = (jhi >= 31 ? 0xffffffffu : ((1u << (jhi + 1)) - 1u)) & ~((1u << jlo) - 1u);
        BandPol pol{P1 + (size_t)b * S * P1_LD + C1_KW + g * 64, P1 + (size_t)b * S * P1_LD + C1_VW + g * 64, P1_LD, tq, tq0, 512, tab + head * 132};
        fa::run<64, 64, false>(F.lds, pol, tmask, F.tid, F.lane, qf, o, m, l);
        const float inv = 1.f / l;
        const bf16* gr = P1 + row * P1_LD + C1_GL + head * 3;
        const float g0 = 1.f / (1.f + __expf(-bf2f(gr[0]))), g1 = 1.f / (1.f + __expf(-bf2f(gr[1]))), g2 = 1.f / (1.f + __expf(-bf2f(gr[2])));
#pragma unroll
        for (int blk = 0; blk < 2; ++blk)
#pragma unroll
            for (int jj = 0; jj < 4; ++jj) { const int d0 = 32 * blk + 8 * jj + 4 * h;
                const v2u cw = *(const v2u*)(OC + row * D + head * 64 + d0), sw = *(const v2u*)(OS + row * D + head * 64 + d0);
                const float r0 = g0 * bflo(cw.x) + g1 * bflo(sw.x) + g2 * o[blk][4 * jj + 0] * inv, r1 = g0 * bfhi(cw.x) + g1 * bfhi(sw.x) + g2 * o[blk][4 * jj + 1] * inv;
                const float r2 = g0 * bflo(cw.y) + g1 * bflo(sw.y) + g2 * o[blk][4 * jj + 2] * inv, r3 = g0 * bfhi(cw.y) + g1 * bfhi(sw.y) + g2 * o[blk][4 * jj + 3] * inv;
                v2u ow; ow.x = pk2(r0, r1); ow.y = pk2(r2, r3);
                *(v2u*)(P1 + row * P1_LD + C1_Q + head * 64 + d0) = ow; }
    }
}
__device__ __forceinline__ void swa_phase_mfma(const Frame& F) {
    bf16* P0 = (bf16*)(F.ws + WS_P0); const float* sinks = F.in[I_EV_SINK];
    LAS float* tab = (LAS float*)(F.lds + 36864);
    build_bias_table(F, tab, 8, 8);
    const int h = F.lane >> 5;
    for (int u = blockIdx.x; u < NB * 2 * 32; u += F.G) {
        const int b = u >> 6, kvh = (u >> 5) & 1, t0 = 64 * (u & 31), head = kvh * 4 + (F.wave & 3), tq0 = t0 + 32 * (F.wave >> 2), tq = tq0 + (F.lane & 31);
        const size_t row = (size_t)b * S + tq;
        fa::bf16x8 qf[4];
#pragma unroll
        for (int ks = 0; ks < 4; ++ks) qf[ks] = *(const fa::bf16x8*)(P0 + row * P0_LD + C0_QB + head * 64 + 16 * ks + 8 * h);
        fa::f32x16 o[2];
#pragma unroll
        for (int blk = 0; blk < 2; ++blk)
#pragma unroll
            for (int e = 0; e < 16; ++e) o[blk][e] = 0.f;
        float m = sinks[head], l = 1.f;
        const int jlo = (t0 - 127 > 0 ? t0 - 127 : 0) >> 6, jhi = t0 >> 6;
        const unsigned tmask = (jhi >= 31 ? 0xffffffffu : ((1u << (jhi + 1)) - 1u)) & ~((1u << jlo) - 1u);
        BandPol pol{P0 + (size_t)b * S * P0_LD + C0_KB + kvh * 64, P0 + (size_t)b * S * P0_LD + C0_VB + kvh * 64, P0_LD, tq, tq0, 128, tab + head * 132};
        fa::run<64, 64, false>(F.lds, pol, tmask, F.tid, F.lane, qf, o, m, l);
        const float inv = 1.f / l;
#pragma unroll
        for (int blk = 0; blk < 2; ++blk)
#pragma unroll
            for (int jj = 0; jj < 4; ++jj) { const int d0 = 32 * blk + 8 * jj + 4 * h;
                v2u ow; ow.x = pk2(o[blk][4 * jj + 0] * inv, o[blk][4 * jj + 1] * inv); ow.y = pk2(o[blk][4 * jj + 2] * inv, o[blk][4 * jj + 3] * inv);
                *(v2u*)(P0 + row * P0_LD + C0_QB + head * 64 + d0) = ow; }
    }
}

struct XaPol {
    const bf16* kbase;
    __device__ __forceinline__ const bf16* krow(int j, int r) const { return kbase + (size_t)(64 * j + r) * 1024; }
    __device__ __forceinline__ const bf16* vrow(int j, int r) const { return kbase + (size_t)(64 * j + r) * 1024 + 512; }
    __device__ __forceinline__ void transform(int, fa::f32x16 (&s)[2], int) const {
#pragma unroll
        for (int kb = 0; kb < 2; ++kb)
#pragma unroll
            for (int e = 0; e < 16; ++e) s[kb][e] *= 0.08838834764831845f;
    }
};
__device__ __forceinline__ void xattn_phase_mfma(const Frame& F, const bf16* Q, const bf16* KV, bf16* O) {
    const int h = F.lane >> 5;
    for (int u = blockIdx.x; u < NB * 4 * 8; u += F.G) {
        const int b = u >> 5, head = (u >> 3) & 3, qt = u & 7, tq = 256 * qt + 32 * F.wave + (F.lane & 31);
        const size_t row = (size_t)b * S + tq;
        fa::bf16x8 qf[8];
#pragma unroll
        for (int ks = 0; ks < 8; ++ks) qf[ks] = *(const fa::bf16x8*)(Q + row * 512 + head * 128 + 16 * ks + 8 * h);
        fa::f32x16 o[4];
#pragma unroll
        for (int blk = 0; blk < 4; ++blk)
#pragma unroll
            for (int e = 0; e < 16; ++e) o[blk][e] = 0.f;
        float m = -INFINITY, l = 0.f;
        XaPol pol{KV + (size_t)b * MEML * 1024 + head * 128};
        fa::run<128, 128, false>(F.lds, pol, 0xFu, F.tid, F.lane, qf, o, m, l);
        const float inv = 1.f / l;
#pragma unroll
        for (int blk = 0; blk < 4; ++blk)
#pragma unroll
            for (int jj = 0; jj < 4; ++jj) { const int d0 = 32 * blk + 8 * jj + 4 * h;
                v2u ow; ow.x = pk2(o[blk][4 * jj + 0] * inv, o[blk][4 * jj + 1] * inv); ow.y = pk2(o[blk][4 * jj + 2] * inv, o[blk][4 * jj + 3] * inv);
                *(v2u*)(O + row * 512 + head * 128 + d0) = ow; }
    }
}
struct DsaPol {
    const bf16* cbase; const unsigned* mrow; int tq; const LAS float* bl;
    __device__ __forceinline__ const bf16* krow(int j, int r) const { return cbase + (size_t)(64 * j + r) * 128; }
    __device__ __forceinline__ const bf16* vrow(int j, int r) const { return krow(j, r); }
    __device__ __forceinline__ void transform(int j, fa::f32x16 (&s)[2], int lane) const {
        const int k0 = 64 * j, h = lane >> 5; const v2u mw = *(const v2u*)(mrow + 2 * j);
#pragma unroll
        for (int kb = 0; kb < 2; ++kb) { const unsigned w = kb ? mw.y : mw.x;
#pragma unroll
            for (int e = 0; e < 16; ++e) { const int kin = 8 * (e >> 2) + 4 * h + (e & 3); const int dist = tq - (k0 + 32 * kb + kin);
                const int di = dist < 0 ? 0 : (dist > 128 ? 128 : dist);
                const float v = s[kb][e] * 0.125f + bl[di];
                s[kb][e] = ((w >> kin) & 1u) ? v : -INFINITY; } }
    }
};
__device__ __forceinline__ void dsa_phase_mfma(const Frame& F) {
    bf16* P0 = (bf16*)(F.ws + WS_P0); const bf16* CN = (const bf16*)(F.ws + WS_CN); const unsigned* MASK = (const unsigned*)(F.ws + WS_MASK);
    LAS float* tab = (LAS float*)(F.lds + 73728);
    build_bias_table(F, tab, 8, 0);
    const int h = F.lane >> 5;
    for (int u = blockIdx.x; u < NB * 64; u += F.G) {
        const int rr = u / F.G, c = u % F.G; const int qt = (rr & 1) ? 63 - (c & 63) : (c & 63), b = (rr * (F.G >> 6) + (c >> 6)) % NB;
        const int tq0 = 32 * qt, tq = tq0 + (F.lane & 31), head = F.wave;
        const size_t row = (size_t)b * S + tq;
        fa::bf16x8 qf[8];
#pragma unroll
        for (int ks = 0; ks < 8; ++ks) qf[ks] = *(const fa::bf16x8*)(P0 + row * P0_LD + C0_QLAT + head * 128 + 16 * ks + 8 * h);
        fa::f32x16 o[4];
#pragma unroll
        for (int blk = 0; blk < 4; ++blk)
#pragma unroll
            for (int e = 0; e < 16; ++e) o[blk][e] = 0.f;
        float m = -INFINITY, l = 0.f;
        const int jhi = (tq0 + 31) >> 6; const unsigned tmask = jhi >= 31 ? 0xffffffffu : ((1u << (jhi + 1)) - 1u);
        DsaPol pol{CN + (size_t)b * S * 128, MASK + row * 64, tq, tab + head * 132};
        fa::run<128, 128, true>(F.lds, pol, tmask, F.tid, F.lane, qf, o, m, l);
        const float inv = 1.f / l;
#pragma unroll
        for (int blk = 0; blk < 4; ++blk)
#pragma unroll
            for (int jj = 0; jj < 4; ++jj) { const int d0 = 32 * blk + 8 * jj + 4 * h;
                v2u ow; ow.x = pk2(o[blk][4 * jj + 0] * inv, o[blk][4 * jj + 1] * inv); ow.y = pk2(o[blk][4 * jj + 2] * inv, o[blk][4 * jj + 3] * inv);
                *(v2u*)(P0 + row * P0_LD + C0_QLAT + head * 128 + d0) = ow; }
    }
}
struct SlcPol {
    const bf16* kbase; const bf16* vbase; unsigned sel; int tq; const LAS float* bl;
    __device__ __forceinline__ const bf16* krow(int j, int r) const { return kbase + (size_t)(64 * j + r) * P1_LD; }
    __device__ __forceinline__ const bf16* vrow(int j, int r) const { return vbase + (size_t)(64 * j + r) * P1_LD; }
    __device__ __forceinline__ void transform(int j, fa::f32x16 (&s)[2], int lane) const {
        const int k0 = 64 * j, h = lane >> 5; const bool on = (sel >> j) & 1u;
#pragma unroll
        for (int kb = 0; kb < 2; ++kb)
#pragma unroll
            for (int e = 0; e < 16; ++e) { const int dist = tq - (k0 + 32 * kb + 8 * (e >> 2) + 4 * h + (e & 3));
                const int di = dist < 0 ? 0 : (dist > 128 ? 128 : dist);
                const float v = s[kb][e] * 0.125f + bl[di];
                s[kb][e] = (on && dist >= 0) ? v : -INFINITY; }
    }
};
__device__ __forceinline__ void slc_phase_mfma(const Frame& F) {
    const bf16* P1 = (const bf16*)(F.ws + WS_P1); const unsigned* SELM = (const unsigned*)(F.ws + WS_SELM); bf16* OS = (bf16*)(F.ws + WS_OSLC);
    LAS float* tab = (LAS float*)(F.lds + 36864);
    build_bias_table(F, tab, 16, 0);
    const int h = F.lane >> 5;
    for (int u = blockIdx.x; u < NB * 2 * 64; u += F.G) {
        const int rr = u / F.G, c = u % F.G; const int qt = (rr & 1) ? 63 - (c & 63) : (c & 63), bg = (rr * (F.G >> 6) + (c >> 6)) % (NB * 2), b = bg >> 1, g = bg & 1;
        const int tq0 = 32 * qt, tq = tq0 + (F.lane & 31), head = g * 8 + F.wave;
        const size_t row = (size_t)b * S + tq;
        fa::bf16x8 qf[4];
#pragma unroll
        for (int ks = 0; ks < 4; ++ks) qf[ks] = *(const fa::bf16x8*)(P1 + row * P1_LD + C1_Q + head * 64 + 16 * ks + 8 * h);
        fa::f32x16 o[2];
#pragma unroll
        for (int blk = 0; blk < 2; ++blk)
#pragma unroll
            for (int e = 0; e < 16; ++e) o[blk][e] = 0.f;
        float m = -INFINITY, l = 0.f;
        const unsigned sel = SELM[row * 2 + g]; unsigned tm = sel;
#pragma unroll
        for (int of = 1; of < 32; of <<= 1) tm |= (unsigned)__shfl_xor((int)tm, of);
        tm = (unsigned)__builtin_amdgcn_readfirstlane((int)tm);
        SlcPol pol{P1 + (size_t)b * S * P1_LD + C1_KS + g * 64, P1 + (size_t)b * S * P1_LD + C1_VS + g * 64, sel, tq, tab + head * 132};
        fa::run<64, 64, false>(F.lds, pol, tm, F.tid, F.lane, qf, o, m, l);
        const float inv = 1.f / l;
#pragma unroll
        for (int blk = 0; blk < 2; ++blk)
#pragma unroll
            for (int jj = 0; jj < 4; ++jj) { const int d0 = 32 * blk + 8 * jj + 4 * h;
                v2u ow; ow.x = pk2(o[blk][4 * jj + 0] * inv, o[blk][4 * jj + 1] * inv); ow.y = pk2(o[blk][4 * jj + 2] * inv, o[blk][4 * jj + 3] * inv);
                *(v2u*)(OS + row * D + head * 64 + d0) = ow; }
    }
}

__device__ __forceinline__ void idx_phase_mfma(const Frame& F) {
    const bf16* P0 = (const bf16*)(F.ws + WS_P0); unsigned* MASK = (unsigned*)(F.ws + WS_MASK);
    LAS float* sc = (LAS float*)F.lds;
    const int r = F.lane & 31, hh = F.lane >> 5;
    const int head_r = (r & 3) + 4 * ((r >> 3) & 1), ql_r = 2 * (r >> 4) + ((r >> 2) & 1);
    for (int item = blockIdx.x; item < NB * (S / 8); item += F.G) {
        const int b = item / (S / 8), t0 = (item % (S / 8)) * 8;
        const int rb = F.wave & 1, kq = F.wave >> 1;
        fa::bf16x8 qa[4];
        { const bf16* qp = P0 + (size_t)(b * S + t0 + 4 * rb + ql_r) * P0_LD + C0_QI + head_r * 64 + 8 * hh;
#pragma unroll
          for (int ks = 0; ks < 4; ++ks) qa[ks] = *(const fa::bf16x8*)(qp + 16 * ks); }
        float wv[2][8];
#pragma unroll
        for (int qq = 0; qq < 2; ++qq) { ld8bf(P0 + (size_t)(b * S + t0 + 4 * rb + 2 * qq + hh) * P0_LD + C0_WI, wv[qq]);
#pragma unroll
            for (int e = 0; e < 8; ++e) wv[qq][e] *= (0.35355339059f * 0.125f); }
        const int nkb = (t0 + 8 + 31) >> 5;
        for (int kb = kq; kb < nkb; kb += 4) {
            const bf16* kp = P0 + (size_t)(b * S + 32 * kb + r) * P0_LD + C0_KI + 8 * hh;
            fa::f32x16 c;
#pragma unroll
            for (int e = 0; e < 16; ++e) c[e] = 0.f;
#pragma unroll
            for (int ks = 0; ks < 4; ++ks) { const fa::bf16x8 kf = *(const fa::bf16x8*)(kp + 16 * ks); c = __builtin_amdgcn_mfma_f32_32x32x16_bf16(qa[ks], kf, c, 0, 0, 0); }
            float s0 = 0.f, s1 = 0.f;
#pragma unroll
            for (int e = 0; e < 8; ++e) { s0 += wv[0][e] * fmaxf(c[e], 0.f); s1 += wv[1][e] * fmaxf(c[8 + e], 0.f); }
            sc[(4 * rb + hh) * 2048 + 32 * kb + r] = s0; sc[(4 * rb + 2 + hh) * 2048 + 32 * kb + r] = s1;
        }
        __syncthreads();
        {
            const int q = F.wave, t = t0 + q, n = t + 1, row = b * S + t; unsigned myword = 0u;
            if (n <= 256) { const int cb = n - 32 * F.lane; myword = cb >= 32 ? 0xffffffffu : (cb <= 0 ? 0u : ((1u << cb) - 1u)); }
            else {
                unsigned uu[32];
#pragma unroll
                for (int i = 0; i < 32; ++i) { const int s = F.lane + 64 * i; uu[i] = (s < n) ? fkey(sc[q * 2048 + s]) : 0u; }
                unsigned prefix = 0u;
#pragma unroll 1
                for (int bit = 31; bit >= 0; --bit) { const unsigned cand = prefix | (1u << bit); int c = 0;
#pragma unroll
                    for (int i = 0; i < 32; ++i) { asm volatile("" : "+s"(c), "+v"(uu[i])); c += __popcll(__ballot(uu[i] >= cand)); }
                    if (c >= 256) prefix = cand; }
                int cgt = 0;
#pragma unroll
                for (int i = 0; i < 32; ++i) { asm volatile("" : "+s"(cgt), "+v"(uu[i])); cgt += __popcll(__ballot(uu[i] > prefix)); }
                const int need = 256 - cgt; int run = 0;
#pragma unroll
                for (int i = 0; i < 32; ++i) { asm volatile("" : "+s"(run), "+v"(uu[i])); const unsigned u = uu[i]; const bool eq = (u == prefix); const unsigned long long em = __ballot(eq); const int rank = run + __popcll(em & ((1ull << F.lane) - 1ull));
                    const bool sel = (u > prefix) || (eq && rank < need); run += __popcll(em);
                    const unsigned long long sm = __ballot(sel);
                    if (F.lane == 2 * i) myword = (unsigned)sm; if (F.lane == 2 * i + 1) myword = (unsigned)(sm >> 32); }
            }
            MASK[(size_t)row * 64 + F.lane] = myword;
        }
        __syncthreads();
    }
}
__device__ __forceinline__ void cmp_phase_mfma(const Frame& F) {
    typedef fa::Geo<64, 64> G;
    const bf16* P1 = (const bf16*)(F.ws + WS_P1); const bf16* KC = (const bf16*)(F.ws + WS_KC); const bf16* VC = (const bf16*)(F.ws + WS_VC);
    bf16* OC = (bf16*)(F.ws + WS_OCMP); unsigned* SELM = (unsigned*)(F.ws + WS_SELM);
    LAS float* tab = (LAS float*)(F.lds + 36864); LAS float* part = (LAS float*)(F.lds + 49152);
    build_bias_table(F, tab, 16, 0);
    const int r = F.lane & 31, h = F.lane >> 5;
    for (int u = blockIdx.x; u < NB * 2 * 64; u += F.G) {
        const int b = u >> 7, g = (u >> 6) & 1, qt = u & 63, tq0 = 32 * qt, head = g * 8 + F.wave, tq = tq0 + r;
        const size_t row = (size_t)b * S + tq;
        const int nv = (tq >= 31) ? ((tq - 31) / 16 + 1) : 0;
        const int ntile = (tq0 >= 1024) ? 2 : 1;
        {
            struct CPol { const bf16* kb; const bf16* vb; __device__ __forceinline__ const bf16* krow(int j, int rr) const { return kb + (size_t)(64 * j + rr) * 64; } __device__ __forceinline__ const bf16* vrow(int j, int rr) const { return vb + (size_t)(64 * j + rr) * 64; } };
            CPol cp{KC + (size_t)(b * 2 + g) * 128 * 64, VC + (size_t)(b * 2 + g) * 128 * 64};
            for (int t = 0; t < ntile; ++t) { fa::Stage<64, 64, false> st; fa::load_tile<64, 64, false>(st, cp, t, F.tid); fa::store_tile<64, 64, false>(st, F.lds + t * G::BUF, F.tid); }
        }
        fa::bf16x8 qf[4];
#pragma unroll
        for (int ks = 0; ks < 4; ++ks) qf[ks] = *(const fa::bf16x8*)(P1 + row * P1_LD + C1_Q + head * 64 + 16 * ks + 8 * h);
        __syncthreads();
        fa::f32x16 s[2][2];
        const LAS float* bl = tab + head * 132;
#pragma unroll
        for (int t = 0; t < 2; ++t) {
            const LAS bf16* Ks = (const LAS bf16*)(F.lds + t * G::BUF);
#pragma unroll
            for (int kb = 0; kb < 2; ++kb) {
#pragma unroll
                for (int e = 0; e < 16; ++e) s[t][kb][e] = 0.f;
                if (t < ntile) {
#pragma unroll
                    for (int ks = 0; ks < 4; ++ks) { const fa::bf16x8 a = *(const LAS fa::bf16x8*)(Ks + (32 * kb + r) * G::KSTR + 16 * ks + 8 * h); s[t][kb] = __builtin_amdgcn_mfma_f32_32x32x16_bf16(a, qf[ks], s[t][kb], 0, 0, 0); }
                }
#pragma unroll
                for (int e = 0; e < 16; ++e) { const int n = 64 * t + 32 * kb + 8 * (e >> 2) + 4 * h + (e & 3); const int dist = tq - (16 * n + 31); const int di = dist < 0 ? 0 : (dist > 128 ? 128 : dist);
                    s[t][kb][e] = (n < nv) ? (s[t][kb][e] * 0.125f + bl[di]) : -INFINITY; }
            }
        }
        float mx = -INFINITY;
#pragma unroll
        for (int t = 0; t < 2; ++t)
#pragma unroll
            for (int kb = 0; kb < 2; ++kb)
#pragma unroll
                for (int e = 0; e < 16; ++e) mx = fmaxf(mx, s[t][kb][e]);
        mx = fmaxf(mx, __shfl_xor(mx, 32));
        const float mref = (mx == -INFINITY) ? 0.f : mx; float rs = 0.f;
#pragma unroll
        for (int t = 0; t < 2; ++t)
#pragma unroll
            for (int kb = 0; kb < 2; ++kb)
#pragma unroll
                for (int e = 0; e < 16; ++e) { s[t][kb][e] = __expf(s[t][kb][e] - mref); rs += s[t][kb][e]; }
        rs += __shfl_xor(rs, 32);
        const float inv = (nv > 0) ? 1.f / rs : 0.f;
#pragma unroll
        for (int t = 0; t < 2; ++t)
#pragma unroll
            for (int kb = 0; kb < 2; ++kb)
#pragma unroll
                for (int e = 0; e < 16; ++e) s[t][kb][e] *= inv;
        {
            float sum4[16], p3[16];
#pragma unroll
            for (int t = 0; t < 2; ++t)
#pragma unroll
                for (int kb = 0; kb < 2; ++kb)
#pragma unroll
                    for (int jj = 0; jj < 4; ++jj) { const int G4 = 8 * t + 4 * kb + jj; sum4[G4] = (s[t][kb][4 * jj] + s[t][kb][4 * jj + 1]) + (s[t][kb][4 * jj + 2] + s[t][kb][4 * jj + 3]); p3[G4] = s[t][kb][4 * jj + 3]; }
            LAS float* pw = part + (F.wave * 32 + r) * 32;
#pragma unroll
            for (int G4 = 0; G4 < 16; ++G4) { const float pr = __shfl_xor(p3[G4], 32);
                const float prm1 = (G4 > 0) ? __shfl_xor(p3[G4 > 0 ? G4 - 1 : 0], 32) : 0.f;
                const float v = sum4[G4] + (h ? pr : prm1);
                pw[2 * G4 + h] = v; }
        }
        fa::f32x16 o[2];
#pragma unroll
        for (int blk = 0; blk < 2; ++blk)
#pragma unroll
            for (int e = 0; e < 16; ++e) o[blk][e] = 0.f;
#pragma unroll
        for (int t = 0; t < 2; ++t) {
            if (t < ntile) {
                const LAS bf16* Vt = (const LAS bf16*)(F.lds + t * G::BUF + G::KBYTES);
#pragma unroll
                for (int kb = 0; kb < 2; ++kb)
#pragma unroll
                    for (int s2 = 0; s2 < 2; ++s2) {
                        v4u pw4; pw4.x = pg8::cvt_pk_bf16(s[t][kb][8 * s2 + 0], s[t][kb][8 * s2 + 1]); pw4.y = pg8::cvt_pk_bf16(s[t][kb][8 * s2 + 2], s[t][kb][8 * s2 + 3]);
                        pw4.z = pg8::cvt_pk_bf16(s[t][kb][8 * s2 + 4], s[t][kb][8 * s2 + 5]); pw4.w = pg8::cvt_pk_bf16(s[t][kb][8 * s2 + 6], s[t][kb][8 * s2 + 7]);
                        const fa::bf16x8 pf = __builtin_bit_cast(fa::bf16x8, pw4);
#pragma unroll
                        for (int blk = 0; blk < 2; ++blk) { const LAS bf16* vp = Vt + (32 * blk + r) * fa::VSTR + 32 * kb + 16 * s2 + 4 * h;
                            const fa::bf16x4 lo = *(const LAS fa::bf16x4*)vp, hi = *(const LAS fa::bf16x4*)(vp + 8);
                            o[blk] = __builtin_amdgcn_mfma_f32_32x32x16_bf16(__builtin_shufflevector(lo, hi, 0, 1, 2, 3, 4, 5, 6, 7), pf, o[blk], 0, 0, 0); }
                    }
            }
        }
#pragma unroll
        for (int blk = 0; blk < 2; ++blk)
#pragma unroll
            for (int jj = 0; jj < 4; ++jj) { const int d0 = 32 * blk + 8 * jj + 4 * h;
                v2u ow; ow.x = pk2(o[blk][4 * jj + 0], o[blk][4 * jj + 1]); ow.y = pk2(o[blk][4 * jj + 2], o[blk][4 * jj + 3]);
                *(v2u*)(OC + row * D + head * 64 + d0) = ow; }
        __syncthreads();
#pragma unroll 1
        for (int it = 0; it < 2; ++it) {
            const int ql = 4 * F.wave + 2 * it + h, j = r, t = tq0 + ql; float p = 0.f;
#pragma unroll
            for (int w8 = 0; w8 < 8; ++w8) p += part[(w8 * 32 + ql) * 32 + j];
            const int blkq = t >> 6; const bool adm = (64 * j <= t); const bool forced = (j == 0) || (j == blkq) || (j == blkq - 1);
            const float scj = adm ? (p + (forced ? 1.0e6f : 0.f)) : -1.0e30f;
            int rank = 0;
#pragma unroll 1
            for (int i = 0; i < 32; ++i) { const float si = __shfl(scj, (F.lane & 32) | i); rank += (si > scj || (si == scj && i < j)) ? 1 : 0; }
            const unsigned long long sm = __ballot(adm && rank < 8);
            if (r == 0) SELM[((size_t)b * S + t) * 2 + g] = h ? (unsigned)(sm >> 32) : (unsigned)sm;
        }
        __syncthreads();
    }
}

__device__ __forceinline__ void cmp_prep(const Frame& F) {
    tconv(F, F.in[I_OD_W1K], 128, 2048, 128, 256, (bf16*)(F.ws + WS_W1T), 2048, NOGRP, 0);
    tconv(F, F.in[I_OD_W1V], 128, 2048, 128, 256, (bf16*)(F.ws + WS_W1T) + (size_t)256 * 2048, 2048, NOGRP, 0);
    if (blockIdx.x == 0 && F.tid < 256) { const int which = F.tid >> 7, j = F.tid & 127; const float* pe = which ? F.in[I_OD_PEV] : F.in[I_OD_PEK]; const float* w1 = which ? F.in[I_OD_W1V] : F.in[I_OD_W1K]; float a = 0.f;
        for (int kk = 0; kk < 2048; ++kk) a += pe[kk] * w1[(size_t)kk * 128 + j];
        ((float*)(F.ws + WS_PEB))[F.tid] = a; }
}
__device__ __forceinline__ void cmp_w2_phase(const Frame& F) {
    const float* Hd = (const float*)(F.ws + WS_HIDC);
    for (int rw = F.gw; rw < 2 * 4096; rw += F.NGW) {
        const int which = rw >> 12, g = (rw >> 11) & 1, b = (rw >> 7) & 15, n = rw & 127;
        const float* w2 = which ? F.in[I_OD_W2V] : F.in[I_OD_W2K];
        bf16* outp = (bf16*)(F.ws + (which ? WS_VC : WS_KC)) + ((size_t)(b * 2 + g) * 128 + n) * 64;
        float a = 0.f;
        if (n < NCMP) { const float h0 = Hd[(size_t)rw * 128 + F.lane], h1 = Hd[(size_t)rw * 128 + 64 + F.lane];
#pragma unroll 8
            for (int j = 0; j < 64; ++j) { a += __shfl(h0, j) * w2[j * 64 + F.lane]; }
#pragma unroll 8
            for (int j = 0; j < 64; ++j) { a += __shfl(h1, j) * w2[(64 + j) * 64 + F.lane]; } }
        outp[F.lane] = (bf16)f2bf(a);
    }
}

constexpr int NPHASE = 35;
__global__ void __launch_bounds__(NWAVES * 64, 2) skel_fwd(Args args) {
    extern __shared__ __attribute__((aligned(16))) unsigned char lds[];
    Frame F;
    F.lds = (LAS unsigned char*)lds; F.ws = args.ws; F.acc = args.out; F.in = args.in;
    F.tid = threadIdx.x; F.lane = F.tid & 63; F.wave = __builtin_amdgcn_readfirstlane(F.tid >> 6);
    F.G = gridDim.x; F.gw = blockIdx.x * NWAVES + F.wave; F.NGW = F.G * NWAVES;
    volatile LAS unsigned* MISC = (volatile LAS unsigned*)(F.lds + MISC_OFF);
    for (int u = F.tid; u < (LDS_BYTES - LDSCTL_OFF) / 4; u += NWAVES * 64) ((LAS unsigned*)(F.lds + LDSCTL_OFF))[u] = 0u;
    __syncthreads();
    unsigned* ctl = (unsigned*)(args.ws + WS_CTL);
    XcdBarrier bar; bar.bar = ctl + CW_BAR; bar.x = 0; bar.st = nullptr;
    const int lo = args.ph_lo, hi = args.ph_hi;
    if (hi - lo > 1) {
        bar = xcd_barrier_post(ctl + CW_BAR, MISC + 8);
        if (threadIdx.x == 0) { unsigned nloc, nx; xcd_barrier_complete(ctl + CW_BAR, bar.x, nloc, nx); MISC[8] = nloc; MISC[9] = nx; }
        __syncthreads();
    }
#ifndef PH_LO
#define PH_LO 0
#define PH_HI 99
#endif
#define IN(k) ((k) >= PH_LO && (k) < PH_HI && lo <= (k) && (k) < hi && fresh(F))
#define SEAM(k) do { if (IN(k) && IN((k) + 1)) xcd_barrier(bar); } while (0)
    unsigned char* ws = args.ws;
    const int bx = blockIdx.x;

    if (IN(0)) { prologue(F); } SEAM(0);
    if (IN(1)) {
        { pg8::StaticSched<256 * 2048, 256 * 2048> Sd{(const char*)(ws + WS_HB), (const char*)(ws + W_IN0), M / 256, P0_LD / 256, F.G, bx, F.wave};
          pg8::EpiBf16 E{(bf16*)(ws + WS_P0), P0_LD}; pg8::gemm_phase<1024, 2048, 2048>(F.lds, Sd, E); }
        for (int i = 0; i < 2; ++i) {
          pg8::StaticSched<256 * 2048, 256 * 2048> Sd{(const char*)(ws + WS_MEMB), (const char*)(ws + W_XKV + (size_t)i * 1024 * 1024 * 2), MMEM / 256, 4, F.G, (bx + 128 * (i + 1)) % F.G, F.wave};
          pg8::EpiBf16 E{(bf16*)(ws + WS_XKV + (size_t)i * MMEM * 1024 * 2), 1024}; pg8::gemm_phase<1024, 2048, 2048>(F.lds, Sd, E); }
    } SEAM(1);
    if (IN(2)) { cn_phase(F); idx_phase_mfma(F); swa_phase_mfma(F); } SEAM(2);
    if (IN(3)) { dsa_phase_mfma(F); } SEAM(3);
    if (IN(4)) { pg8::StaticSched<256 * P0_LD * 2, 256 * 1536 * 2> Sd{(const char*)(ws + WS_P0), (const char*)(ws + W_OUT0), M / 256, 4, F.G, bx, F.wave};
                 pg8::EpiAcc E{F.acc, D}; pg8::gemm_phase<1536, P0_LD * 2, 1536 * 2>(F.lds, Sd, E); } SEAM(4);
    if (IN(5)) { ln_phase<0>(F, 0); } SEAM(5);
    if (IN(6)) { pg8::StaticSched<256 * 2048, 256 * 2048> Sd{(const char*)(ws + WS_HB), (const char*)(ws + W_XQ), M / 256, 2, F.G, bx, F.wave};
                 pg8::EpiBf16 E{(bf16*)(ws + WS_QX0), 512}; pg8::gemm_phase<1024, 2048, 2048>(F.lds, Sd, E); } SEAM(6);
    if (IN(7)) { xattn_phase_mfma(F, (const bf16*)(ws + WS_QX0), (const bf16*)(ws + WS_XKV), (bf16*)(ws + WS_OX0)); } SEAM(7);
    if (IN(8)) { pg8::StaticSched<256 * 1024, 256 * 1024> Sd{(const char*)(ws + WS_OX0), (const char*)(ws + W_XO), M / 256, 4, F.G, bx, F.wave};
                 pg8::EpiAcc E{F.acc, D}; pg8::gemm_phase<512, 1024, 1024>(F.lds, Sd, E); } SEAM(8);
    if (IN(9)) { ln_phase<0>(F, 1); } SEAM(9);
    if (IN(10)) { pg8::StaticSched<256 * 2048, 256 * 2048> Sd{(const char*)(ws + WS_HB), (const char*)(ws + W_FGU), M / 256, 2 * DFF / 256, F.G, bx, F.wave};
                  pg8::EpiSwiglu E{(bf16*)(ws + WS_HID), DFF, 0}; pg8::gemm_phase<1024, 2048, 2048>(F.lds, Sd, E); } SEAM(10);
    if (IN(11)) { pg8::StaticSched<256 * DFF * 2, 256 * DFF * 2> Sd{(const char*)(ws + WS_HID), (const char*)(ws + W_FD), M / 256, 4, F.G, bx, F.wave};
                  pg8::EpiAcc E{F.acc, D}; pg8::gemm_phase<DFF, DFF * 2, DFF * 2>(F.lds, Sd, E); } SEAM(11);
    if (IN(12)) { ln_phase<0>(F, 2); cmp_prep(F); } SEAM(12);
    if (IN(13)) { pg8::StaticSched<256 * 2048, 256 * 2048> Sd{(const char*)(ws + WS_HB), (const char*)(ws + W_IN1), M / 256, P1_LD / 256, F.G, bx, F.wave};
                  pg8::EpiBf16 E{(bf16*)(ws + WS_P1), P1_LD}; pg8::gemm_phase<1024, 2048, 2048>(F.lds, Sd, E); } SEAM(13);
    if (IN(14)) { pg8::CmpSched Sd{(const char*)(ws + WS_P1), (const char*)(ws + WS_W1T), F.G, bx, F.wave};
                  pg8::EpiCmpHid E{(float*)(ws + WS_HIDC), (const float*)(ws + WS_PEB)}; pg8::gemm_phase<2048, 16 * P1_LD * 2, 2048 * 2, P1_LD * 2, (long)S * P1_LD * 2>(F.lds, Sd, E); } SEAM(14);
    if (IN(15)) { cmp_w2_phase(F); } SEAM(15);
    if (IN(16)) { cmp_phase_mfma(F); } SEAM(16);
    if (IN(17)) { slc_phase_mfma(F); } SEAM(17);
    if (IN(18)) { win_phase_mfma(F); } SEAM(18);
    if (IN(19)) { pg8::StaticSched<256 * P1_LD * 2, 256 * 2048> Sd{(const char*)(ws + WS_P1), (const char*)(ws + W_OUT1), M / 256, 4, F.G, bx, F.wave};
                  pg8::EpiAcc E{F.acc, D}; pg8::gemm_phase<1024, P1_LD * 2, 2048>(F.lds, Sd, E); } SEAM(19);
    if (IN(20)) { ln_phase<0>(F, 3); } SEAM(20);
    if (IN(21)) { pg8::StaticSched<256 * 2048, 256 * 2048> Sd{(const char*)(ws + WS_HB), (const char*)(ws + W_XQ + (size_t)512 * 1024 * 2), M / 256, 2, F.G, bx, F.wave};
                  pg8::EpiBf16 E{(bf16*)(ws + WS_QX1), 512}; pg8::gemm_phase<1024, 2048, 2048>(F.lds, Sd, E); } SEAM(21);
    if (IN(22)) { xattn_phase_mfma(F, (const bf16*)(ws + WS_QX1), (const bf16*)(ws + WS_XKV + (size_t)MMEM * 1024 * 2), (bf16*)(ws + WS_OX1)); } SEAM(22);
    if (IN(23)) { pg8::StaticSched<256 * 1024, 256 * 1024> Sd{(const char*)(ws + WS_OX1), (const char*)(ws + W_XO + (size_t)1024 * 512 * 2), M / 256, 4, F.G, bx, F.wave};
                  pg8::EpiAcc E{F.acc, D}; pg8::gemm_phase<512, 1024, 1024>(F.lds, Sd, E); } SEAM(23);
    if (IN(24)) { ln_phase<1>(F, 4); } SEAM(24);
    if (IN(25)) { moe_dispatch(F); } SEAM(25);
#pragma unroll 1
    for (int ch = 0; ch < 4; ++ch) {
        const int pa = 26 + 2 * ch, pb = 27 + 2 * ch;
        const int* tile_exp = (const int*)(ws + WS_TILEEXP);
        if (IN(pa) || IN(pb)) {
            const int slot = ch >> 1; const int s0 = tile_exp[512 + slot], s1 = tile_exp[512 + slot + 1];
            int t0 = s0 + (ch & 1) * MOE_CHUNK_TILES, t1 = (ch & 1) ? s1 : (s0 + MOE_CHUNK_TILES < s1 ? s0 + MOE_CHUNK_TILES : s1);
            if (t0 > s1) t0 = s1; int nT = t1 - t0; if (nT < 0) nT = 0; if (nT > MOE_CHUNK_TILES) nT = MOE_CHUNK_TILES;
            if (IN(pa)) { pg8::MoeSched<WS_PERMA, W_MGU, 256 * 2048, 256 * 2048, (size_t)7168 * 2048, 0> Sd{ws, t0, nT, 2 * DFFE / 256, F.G, bx, F.wave};
                          pg8::EpiSwiglu E{(bf16*)(ws + WS_HIDM), DFFE, 1}; pg8::gemm_phase<1024, 2048, 2048>(F.lds, Sd, E); }
            if (IN(pa) && IN(pb)) xcd_barrier(bar);
            if (IN(pb)) { pg8::MoeSched<WS_HIDM, W_MD, 256 * DFFE * 2, 256 * DFFE * 2, (size_t)1024 * DFFE * 2, 1> Sd{ws, t0, nT, 4, F.G, bx, F.wave};
                          pg8::EpiMoeDown E{F.acc, ws}; pg8::gemm_phase<DFFE, DFFE * 2, DFFE * 2>(F.lds, Sd, E); }
            if (IN(pb) && IN(pb + 1)) xcd_barrier(bar);
        }
    }
    if (IN(34)) { ln_phase<2>(F, 5); }
#undef IN
#undef SEAM
}

extern "C" void kernel_launch(void* const* d_in, const int* in_sizes, int n_in, void* d_out, int out_size, void* d_ws, size_t ws_size, hipStream_t stream) {
    static int grid = 0;
    if (grid == 0) {
        if (n_in != 30 || out_size != M * D || ws_size < WS_END) { fprintf(stderr, "kernel_launch: unexpected shapes (n_in %d, out %d, ws %zu < %zu); nothing launched\n", n_in, out_size, ws_size, (size_t)WS_END); grid = -1; return; }
        int dev = 0, cus = 0, per_cu = 0;
        if (hipGetDevice(&dev) != hipSuccess || hipDeviceGetAttribute(&cus, hipDeviceAttributeMultiprocessorCount, dev) != hipSuccess) { grid = -1; return; }
        if (hipFuncSetAttribute((const void*)skel_fwd, hipFuncAttributeMaxDynamicSharedMemorySize, LDS_BYTES) != hipSuccess) { fprintf(stderr, "kernel_launch: hipFuncSetAttribute failed\n"); grid = -1; return; }
        if (hipOccupancyMaxActiveBlocksPerMultiprocessor(&per_cu, (const void*)skel_fwd, NWAVES * 64, LDS_BYTES) != hipSuccess || per_cu < 1)
            fprintf(stderr, "kernel_launch: occupancy query reports %d workgroups per CU\n", per_cu);
        (void)hipGetLastError();
        grid = cus;
    }
    if (grid < 0) return;
    if (hipMemsetAsync((char*)d_ws + WS_CTL, 0, CTL_ZERO_BYTES, stream) != hipSuccess) return;
    Args a{};
    for (int i = 0; i < 30; ++i) a.in[i] = (const float*)d_in[i];
    a.out = (float*)d_out; a.ws = (unsigned char*)d_ws;
#if MK_ONE_LAUNCH
    a.ph_lo = 0; a.ph_hi = NPHASE;
    hipLaunchKernelGGL(skel_fwd, dim3(grid), dim3(NWAVES * 64), LDS_BYTES, stream, a);
#else
    for (int p = 0; p < NPHASE; ++p) { a.ph_lo = p; a.ph_hi = p + 1; hipLaunchKernelGGL(skel_fwd, dim3(grid), dim3(NWAVES * 64), LDS_BYTES, stream, a); }
#endif
}
```

```cpp
#include <hip/hip_runtime.h>
#include <cstdio>
#include <cstdint>

#ifndef PROBE_ID
#define PROBE_ID 0
#endif
#ifndef PROBE_AMP
#define PROBE_AMP 4
#endif
#ifndef PROBE_MASK
#define PROBE_MASK 0ull
#endif
#define PROBE_SEL(ph) ((PROBE_MASK >> (ph)) & 1ull)
#if PROBE_ID
#define PROBE_T0 ((volatile __attribute__((address_space(3))) unsigned long long*)(unsigned)(131072 + 320 + 64))
#define PROBE_ACC ((volatile __attribute__((address_space(3))) unsigned long long*)(unsigned)(131072 + 320 + 72))
#define PROBE_WINW ((volatile __attribute__((address_space(3))) unsigned*)(unsigned)(131072 + 320 + 80))
#define PROBE_WIN(ph, on, tid) do { if (PROBE_SEL(ph) && blockIdx.x == 0 && (tid) == 0) { *PROBE_WINW = (on); } } while (0)
#define PROBE_START(id, tid) do { if ((id) == PROBE_ID && blockIdx.x == 0 && (tid) == 0 && *PROBE_WINW) { *PROBE_T0 = __builtin_amdgcn_s_memtime(); } } while (0)
#define PROBE_STOP(id, tid) do { if ((id) == PROBE_ID && blockIdx.x == 0 && (tid) == 0 && *PROBE_WINW) { *PROBE_ACC = *PROBE_ACC + (__builtin_amdgcn_s_memtime() - *PROBE_T0); } } while (0)
#define PROBE_STARTF(id, tid) do { if ((id) == PROBE_ID && blockIdx.x == 0 && (tid) == 0) { *PROBE_T0 = __builtin_amdgcn_s_memtime(); } } while (0)
#define PROBE_STOPF(id, tid) do { if ((id) == PROBE_ID && blockIdx.x == 0 && (tid) == 0) { *PROBE_ACC = *PROBE_ACC + (__builtin_amdgcn_s_memtime() - *PROBE_T0); } } while (0)
#define PROBE_SPIN(tid) do { if (blockIdx.x == 0 && (tid) == 0) { const unsigned long long t0_ = __builtin_amdgcn_s_memtime(), w_ = *PROBE_ACC * PROBE_AMP; while (__builtin_amdgcn_s_memtime() - t0_ < w_) __builtin_amdgcn_s_sleep(8); } } while (0)
#else
#define PROBE_WIN(ph, on, tid) do {} while (0)
#define PROBE_START(id, tid) do {} while (0)
#define PROBE_STOP(id, tid) do {} while (0)
#define PROBE_STARTF(id, tid) do {} while (0)
#define PROBE_STOPF(id, tid) do {} while (0)
#define PROBE_SPIN(tid) do {} while (0)
#endif
#ifndef WG_A
#define WG_A 4
#endif
#ifndef WG_A1
#define WG_A1 WG_A
#endif
#ifndef WG_B
#define WG_B 8
#endif
#ifndef MK_ONE_LAUNCH
#define MK_ONE_LAUNCH 1
#endif

constexpr size_t ROWTOK_OFF = 5u * 1048576u + 512u * 1024u, ROWW_OFF = 6u * 1048576u, TILEEXP_OFF = 6u * 1048576u + 512u * 1024u, DUMMY_OFF = 7u * 1048576u;
namespace pg8 {
#define PG8_LAS __attribute__((address_space(3)))
typedef unsigned short bf16_t;
typedef short bf16x8 __attribute__((ext_vector_type(8)));
typedef float f32x4 __attribute__((ext_vector_type(4)));
typedef unsigned u32x4 __attribute__((ext_vector_type(4)));
constexpr int BM = 256, BK = 64, HALF = 128, HTB = HALF * BK * 2, STAGE_BYTES = 8 * HTB, NXCD = 8, WGM = 4;

__host__ __device__ __forceinline__ int lds_byte(int r, int c) { const int st = (r >> 4) * 2 + (c >> 5), rr = r & 15, cc = c & 31, ob = rr * 64 + cc * 2; return st * 1024 + (ob ^ (((ob >> 9) & 1) << 5)); }
__host__ __device__ __forceinline__ void stage_rc(int b, int& R, int& C) { const int st = b / 1024, sb = b % 1024, swz = sb ^ (((sb >> 9) & 1) << 5); R = (st >> 1) * 16 + swz / 64; C = (st & 1) * 32 + (swz % 64) / 2; }
__host__ __device__ __forceinline__ int perm32(int rho) { const int n = rho >> 4, i = rho & 15; return 8 * (i >> 2) + 4 * n + (i & 3); }

__device__ __forceinline__ const void* opaque_uniform(const void* p) {
    unsigned lo = __builtin_amdgcn_readfirstlane((unsigned)(unsigned long long)p), hi = __builtin_amdgcn_readfirstlane((unsigned)((unsigned long long)p >> 32));
    asm volatile("" : "+s"(lo), "+s"(hi)); return (const void*)(((unsigned long long)hi << 32) | lo); }
struct Unit { int pm, pn, aux; const char* a; const char* b; };

template <int WG = WGM>
__device__ __forceinline__ void tile_of(int wgid, int nM, int nN, int& pm, int& pn) {
    const int nwg = nM * nN;
    { const int q = nwg / NXCD, r = nwg % NXCD, xcd = wgid % NXCD, off = wgid / NXCD; wgid = (xcd < r ? xcd * (q + 1) : r * (q + 1) + (xcd - r) * q) + off; }
    const int nig = WG * nN, gid = wgid / nig, fm = gid * WG, gsz = (nM - fm) < WG ? (nM - fm) : WG;
    pm = fm + ((wgid % nig) % gsz); pn = (wgid % nig) / gsz;
}
template <size_t A_TILE, size_t B_TILE, int WG = WGM>
struct StaticSched {
    const char* A; const char* B; int nM, nN, G, c, wave;
    __device__ __forceinline__ bool next(int i, Unit& u) const {
        const long L = (long)i * G + c; if (L >= (long)nM * nN) return false;
        int pm, pn; tile_of<WG>((int)L, nM, nN, pm, pn);
        u.pm = pm; u.pn = pn; u.aux = 0; u.a = A + (size_t)pm * A_TILE; u.b = B + (size_t)pn * B_TILE; return true;
    }
};
template <size_t A_OFF, size_t B_OFF, size_t A_TILE, size_t B_TILE, size_t B_EXP, int A_LOCAL, int WG = WGM>
struct MoeSched {
    const unsigned char* ws; int t0, nT, nN, G, c, wave; const unsigned char* alt;
    __device__ __forceinline__ bool next(int i, Unit& u) const {
        const long L = (long)i * G + c; if (L >= (long)nT * nN) return false;
        int pml, pn; tile_of<WG>((int)L, nT, nN, pml, pn);
        const unsigned char* wsb = (const unsigned char*)opaque_uniform(ws);
        const int pm = t0 + pml; const int e = __builtin_amdgcn_readfirstlane(((const int*)(wsb + TILEEXP_OFF))[pm]);
        u.pm = pm; u.pn = pn; u.aux = pml; u.a = A_LOCAL ? ((pml < 64 ? (const char*)wsb + A_OFF : (const char*)opaque_uniform(alt)) + (size_t)(pml & 63) * A_TILE) : ((const char*)wsb + A_OFF + (size_t)pm * A_TILE); u.b = (const char*)wsb + B_OFF + (size_t)e * B_EXP + (size_t)pn * B_TILE; return true;
    }
};

__device__ __forceinline__ unsigned cvt_pk_bf16(float lo, float hi) { unsigned r; asm volatile("v_cvt_pk_bf16_f32 %0, %1, %2" : "=v"(r) : "v"(lo), "v"(hi)); return r; }

struct EpiBf16 {
    static constexpr bool PERM = true;
    bf16_t* O; int ldc;
    __device__ __forceinline__ void operator()(const f32x4 (&acc)[2][2][4][2], const Unit& u, int wr, int wc, int fr, int fq) const {
        const int row0 = u.pm * BM + wr * 64 + fr, col0 = u.pn * BM + wc * 32 + 8 * fq;
#pragma unroll
        for (int ai = 0; ai < 2; ++ai)
#pragma unroll
            for (int m = 0; m < 4; ++m) { bf16_t* rowp = O + (size_t)(row0 + ai * HALF + m * 16) * ldc + col0;
#pragma unroll
                for (int bj = 0; bj < 2; ++bj) { const f32x4 v0 = acc[ai][bj][m][0], v1 = acc[ai][bj][m][1];
                    u32x4 w; w.x = cvt_pk_bf16(v0[0], v0[1]); w.y = cvt_pk_bf16(v0[2], v0[3]); w.z = cvt_pk_bf16(v1[0], v1[1]); w.w = cvt_pk_bf16(v1[2], v1[3]);
                    *(u32x4*)(rowp + bj * HALF) = w; } }
    }
};
struct EpiAcc {
    static constexpr bool PERM = false;
    float* C; int ldc;
    __device__ __forceinline__ void operator()(const f32x4 (&acc)[2][2][4][2], const Unit& u, int wr, int wc, int fr, int fq) const {
        const int row0 = u.pm * BM + wr * 64 + fr, col0 = u.pn * BM + wc * 32 + 4 * fq;
#pragma unroll
        for (int ai = 0; ai < 2; ++ai)
#pragma unroll
            for (int m = 0; m < 4; ++m) { float* rowp = C + (size_t)(row0 + ai * HALF + m * 16) * ldc + col0;
                f32x4 o[2][2];
#pragma unroll
                for (int bj = 0; bj < 2; ++bj)
#pragma unroll
                    for (int n = 0; n < 2; ++n) o[bj][n] = *(const f32x4*)(rowp + bj * HALF + n * 16);
#pragma unroll
                for (int bj = 0; bj < 2; ++bj)
#pragma unroll
                    for (int n = 0; n < 2; ++n) *(f32x4*)(rowp + bj * HALF + n * 16) = o[bj][n] + acc[ai][bj][m][n]; }
    }
};
struct EpiSumB {
    static constexpr bool PERM = true;
    const bf16_t* H; bf16_t* O;
    __device__ __forceinline__ void operator()(const f32x4 (&acc)[2][2][4][2], const Unit& u, int wr, int wc, int fr, int fq) const {
        const int row0 = u.pm * BM + wr * 64 + fr, col0 = u.pn * BM + wc * 32 + 8 * fq;
#pragma unroll
        for (int ai = 0; ai < 2; ++ai)
#pragma unroll
            for (int m = 0; m < 4; ++m) { const size_t off = (size_t)(row0 + ai * HALF + m * 16) * 1024 + col0;
                u32x4 hw[2];
#pragma unroll
                for (int bj = 0; bj < 2; ++bj) hw[bj] = *(const u32x4*)(H + off + bj * HALF);
#pragma unroll
                for (int bj = 0; bj < 2; ++bj) { const f32x4 v0 = acc[ai][bj][m][0], v1 = acc[ai][bj][m][1]; const u32x4 h = hw[bj]; const float A = 1.41421356237f;
                    u32x4 w; w.x = cvt_pk_bf16(v0[0] + A * __builtin_bit_cast(float, h.x << 16), v0[1] + A * __builtin_bit_cast(float, h.x & 0xffff0000u));
                    w.y = cvt_pk_bf16(v0[2] + A * __builtin_bit_cast(float, h.y << 16), v0[3] + A * __builtin_bit_cast(float, h.y & 0xffff0000u));
                    w.z = cvt_pk_bf16(v1[0] + A * __builtin_bit_cast(float, h.z << 16), v1[1] + A * __builtin_bit_cast(float, h.z & 0xffff0000u));
                    w.w = cvt_pk_bf16(v1[2] + A * __builtin_bit_cast(float, h.w << 16), v1[3] + A * __builtin_bit_cast(float, h.w & 0xffff0000u));
                    *(u32x4*)(O + off + bj * HALF) = w; } }
    }
};
__device__ __forceinline__ float silu_f(float x) { return x / (1.0f + __expf(-x)); }
struct EpiSwiglu {
    static constexpr bool PERM = true;
    bf16_t* O; int ldc; int row_local; bf16_t* O2;
    __device__ __forceinline__ void operator()(const f32x4 (&acc)[2][2][4][2], const Unit& u, int wr, int wc, int fr, int fq) const {
        const int row0 = (row_local ? (u.aux & 63) : u.pm) * BM + wr * 64 + fr, col0 = u.pn * HALF + wc * 32 + 8 * fq;
        bf16_t* Ob = (row_local && u.aux >= 64) ? O2 : O;
#pragma unroll
        for (int ai = 0; ai < 2; ++ai)
#pragma unroll
            for (int m = 0; m < 4; ++m) { bf16_t* rowp = Ob + (size_t)(row0 + ai * HALF + m * 16) * ldc + col0;
                const f32x4 g0 = acc[ai][0][m][0], g1 = acc[ai][0][m][1], u0 = acc[ai][1][m][0], u1 = acc[ai][1][m][1];
                float h[8];
#pragma unroll
                for (int j = 0; j < 4; ++j) { h[j] = silu_f(g0[j]) * u0[j]; h[4 + j] = silu_f(g1[j]) * u1[j]; }
                u32x4 w; w.x = cvt_pk_bf16(h[0], h[1]); w.y = cvt_pk_bf16(h[2], h[3]); w.z = cvt_pk_bf16(h[4], h[5]); w.w = cvt_pk_bf16(h[6], h[7]);
                *(u32x4*)rowp = w; }
    }
};
struct EpiMoeDown {
    static constexpr bool PERM = false;
    float* C; unsigned char* ws;
    __device__ __forceinline__ void operator()(const f32x4 (&acc)[2][2][4][2], const Unit& u, int wr, int wc, int fr, int fq) const {
        const int row0 = u.pm * BM + wr * 64 + fr, col0 = u.pn * BM + wc * 32 + 4 * fq;
        unsigned char* wsb = (unsigned char*)opaque_uniform(ws);
        const int* rowtok = (const int*)(wsb + ROWTOK_OFF); const float* roww = (const float*)(wsb + ROWW_OFF); float* dummy = (float*)(wsb + DUMMY_OFF);
#pragma unroll
        for (int ai = 0; ai < 2; ++ai)
#pragma unroll
            for (int m = 0; m < 4; ++m) { const int r = row0 + ai * HALF + m * 16; const int tok = rowtok[r]; const float w = roww[r];
                float* rowp = (tok >= 0 ? C + (size_t)tok * 1024 : dummy) + col0;
                f32x4 o[2][2];
#pragma unroll
                for (int bj = 0; bj < 2; ++bj)
#pragma unroll
                    for (int n = 0; n < 2; ++n) o[bj][n] = *(const f32x4*)(rowp + bj * HALF + n * 16);
#pragma unroll
                for (int bj = 0; bj < 2; ++bj)
#pragma unroll
                    for (int n = 0; n < 2; ++n) *(f32x4*)(rowp + bj * HALF + n * 16) = o[bj][n] + acc[ai][bj][m][n] * w; }
    }
};

__device__ __forceinline__ float gelu_tanh_f(float x) { const float u = 0.7978845608028654f * (x + 0.044715f * x * x * x); const float e = __expf(2.f * u); return 0.5f * x * (1.f + (1.f - 2.f / (e + 1.f))); }
struct EpiCmpHid {
    static constexpr bool PERM = false;
    float* Hd; const float* bias;
    __device__ __forceinline__ void operator()(const f32x4 (&acc)[2][2][4][2], const Unit& u, int wr, int wc, int fr, int fq) const {
        const int row0 = u.pm * BM + wr * 64 + fr, col0 = wc * 32 + 4 * fq;
        f32x4 bv[2];
#pragma unroll
        for (int n = 0; n < 2; ++n) bv[n] = *(const f32x4*)(bias + u.aux * 128 + col0 + n * 16);
#pragma unroll
        for (int ai = 0; ai < 2; ++ai)
#pragma unroll
            for (int m = 0; m < 4; ++m) { float* rowp = Hd + (size_t)(row0 + ai * HALF + m * 16) * 128 + col0;
#pragma unroll
                for (int n = 0; n < 2; ++n) { const f32x4 v = acc[ai][0][m][n] + bv[n]; f32x4 o;
#pragma unroll
                    for (int j = 0; j < 4; ++j) o[j] = gelu_tanh_f(v[j]);
                    *(f32x4*)(rowp + n * 16) = o; } }
    }
};
struct CmpSched {
    const char* P1b; const char* W1T; int G, c, wave;
    __device__ __forceinline__ bool next(int i, Unit& u) const {
        const int L = i * G + c; if (L >= 32) return false;
        const int which = L >> 4, tile = L & 15, g = tile >> 3, b0 = 2 * (tile & 7);
        u.pm = L; u.pn = 0; u.aux = which; u.a = P1b + ((size_t)b0 * 2048 * 2048 + (which ? 1152 : 1024) + g * 64) * 2; u.b = W1T + (size_t)which * 256 * 2048 * 2; return true;
    }
};

template <int K, int lda_b, int ldb_b, long KSTEP_A = 128, long HSTEP_A = 128L * lda_b, class Epi, class Sched>
__device__ __forceinline__ void gemm_phase(PG8_LAS unsigned char* lds, const Sched& S, const Epi& E) {
    int tid_ = (int)__builtin_amdgcn_mbcnt_hi(~0u, __builtin_amdgcn_mbcnt_lo(~0u, 0u)); asm volatile("" : "+v"(tid_)); tid_ += S.wave * 64;
    const int tid = tid_, wid = __builtin_amdgcn_readfirstlane(tid >> 6), lane = tid & 63, wr = wid >> 2, wc = wid & 3, fr = lane & 15, fq = lane >> 4;
    constexpr int nt = K / BK;
    unsigned voffA[2], voffB[2];
#pragma unroll
    for (int i = 0; i < 2; ++i) { int R, C; stage_rc(tid * 16 + i * 8192, R, C); const int Rb = Epi::PERM ? ((R & ~31) + perm32(R & 31)) : R;
        voffA[i] = (unsigned)(R * lda_b + C * 2); voffB[i] = (unsigned)(Rb * ldb_b + C * 2); }
    const size_t kstep = (size_t)(BK * 2), kstepA = (size_t)KSTEP_A;
    const size_t hstepA = (size_t)HSTEP_A, hstepB = (size_t)HALF * ldb_b;
    const unsigned ldsw = (unsigned)wid * 1024u;
    const int aoff = lds_byte(wr * 64 + fr, fq * 8), boff = lds_byte(wc * 32 + fr, fq * 8);
#define PG8_SA(b, h) (((b) * 2 + (h)) * HTB)
#define PG8_SB(b, h) ((4 + (b) * 2 + (h)) * HTB)
#define PG8_STAGE(bufoff, gbase, voff) do { _Pragma("unroll") for (int _i = 0; _i < 2; ++_i) \
        __builtin_amdgcn_global_load_lds((const unsigned*)((const char*)(gbase) + (voff)[_i]), (PG8_LAS unsigned*)(lds + (bufoff) + ldsw + _i * 8192), 16, 0, 0); } while (0)
#define PG8_LDA(dst, b, h) do { _Pragma("unroll") for (int m = 0; m < 4; ++m) _Pragma("unroll") for (int k = 0; k < 2; ++k) dst[m][k] = *(const PG8_LAS bf16x8*)(lds + PG8_SA(b, h) + aoff + m * 2048 + k * 1024); } while (0)
#define PG8_LDB(dst, b, h) do { _Pragma("unroll") for (int n = 0; n < 2; ++n) _Pragma("unroll") for (int k = 0; k < 2; ++k) dst[n][k] = *(const PG8_LAS bf16x8*)(lds + PG8_SB(b, h) + boff + n * 2048 + k * 1024); } while (0)
#define PG8_MMA(ai, bj, At, Bt) do { __builtin_amdgcn_s_setprio(1); _Pragma("unroll") for (int m = 0; m < 4; ++m) _Pragma("unroll") for (int n = 0; n < 2; ++n) _Pragma("unroll") for (int k = 0; k < 2; ++k) \
        acc[ai][bj][m][n] = __builtin_amdgcn_mfma_f32_16x16x32_bf16(Bt[n][k], At[m][k], acc[ai][bj][m][n], 0, 0, 0); __builtin_amdgcn_s_setprio(0); } while (0)
#define PG8_WAIT_V(n) asm volatile("s_waitcnt vmcnt(" #n ")" ::: "memory")
#define PG8_WAIT_L(n) asm volatile("s_waitcnt lgkmcnt(" #n ")" ::: "memory")
#define PG8_BAR __builtin_amdgcn_s_barrier()
#define PG8_SCHED __builtin_amdgcn_sched_barrier(0)
    Unit cur, nxt; int ui = 0;
    if (!S.next(0, cur)) return;
    f32x4 acc[2][2][4][2];
#pragma unroll
    for (int a = 0; a < 2; ++a)
#pragma unroll
        for (int b = 0; b < 2; ++b)
#pragma unroll
            for (int m = 0; m < 4; ++m)
#pragma unroll
                for (int n = 0; n < 2; ++n) acc[a][b][m][n] = (f32x4){0.f, 0.f, 0.f, 0.f};
    bf16x8 At[4][2], B0[2][2], B1[2][2];
    const char* cA = cur.a; const char* cB = cur.b;
    PG8_STAGE(PG8_SB(0, 0), cB, voffB); PG8_STAGE(PG8_SB(0, 1), cB + hstepB, voffB); PG8_STAGE(PG8_SA(0, 0), cA, voffA); PG8_STAGE(PG8_SA(0, 1), cA + hstepA, voffA);
    if (wr == 1) PG8_BAR;
    PG8_WAIT_V(2); PG8_BAR;
    PG8_STAGE(PG8_SB(1, 0), cB + kstep, voffB); PG8_STAGE(PG8_SA(1, 0), cA + kstepA, voffA); PG8_STAGE(PG8_SB(1, 1), cB + hstepB + kstep, voffB);
    PG8_WAIT_V(6); PG8_BAR;
    for (;;) {
        const bool has_next = S.next(ui + 1, nxt);
        const char* nA = has_next ? nxt.a : cA; const char* nB = has_next ? nxt.b : cB;
        for (int t = 0; t < nt; t += 2) {
            const bool last = (t == nt - 2);
            const char* a1 = cA + (size_t)(t + 1) * kstepA;
            const char* a2 = last ? nA : cA + (size_t)(t + 2) * kstepA; const char* b2 = last ? nB : cB + (size_t)(t + 2) * kstep;
            const char* a3 = a2 + kstepA; const char* b3 = b2 + kstep;
            PG8_LDB(B0, 0, 0); PG8_LDB(B1, 0, 1); PG8_SCHED; PG8_LDA(At, 0, 0); PG8_STAGE(PG8_SA(1, 1), a1 + hstepA, voffA);
            PG8_WAIT_V(8); PG8_WAIT_L(0); PG8_BAR; PG8_MMA(0, 0, At, B0); PG8_MMA(0, 1, At, B1); PG8_BAR; PG8_SCHED;
            PG8_LDA(At, 0, 1); PG8_STAGE(PG8_SB(0, 0), b2, voffB); PG8_STAGE(PG8_SB(0, 1), b2 + hstepB, voffB); PG8_STAGE(PG8_SA(0, 0), a2, voffA);
            PG8_WAIT_V(8); PG8_WAIT_L(0); PG8_BAR; PG8_MMA(1, 0, At, B0); PG8_MMA(1, 1, At, B1); PG8_BAR; PG8_SCHED;
            PG8_LDB(B0, 1, 0); PG8_LDB(B1, 1, 1); PG8_SCHED; PG8_LDA(At, 1, 0); PG8_STAGE(PG8_SA(0, 1), a2 + hstepA, voffA);
            PG8_WAIT_V(8); PG8_WAIT_L(0); PG8_BAR; PG8_MMA(0, 0, At, B0); PG8_MMA(0, 1, At, B1); PG8_BAR; PG8_SCHED;
            PG8_LDA(At, 1, 1); PG8_STAGE(PG8_SB(1, 0), b3, voffB); PG8_STAGE(PG8_SB(1, 1), b3 + hstepB, voffB); PG8_STAGE(PG8_SA(1, 0), a3, voffA);
            PG8_WAIT_V(8); PG8_WAIT_L(0); PG8_BAR; PG8_MMA(1, 0, At, B0); PG8_MMA(1, 1, At, B1); PG8_BAR; PG8_SCHED;
        }
        if (wr == 0) PG8_BAR;
        E(acc, cur, wr, wc, fr, fq);
        if (!has_next) break;
#pragma unroll
        for (int a = 0; a < 2; ++a)
#pragma unroll
            for (int b = 0; b < 2; ++b)
#pragma unroll
                for (int m = 0; m < 4; ++m)
#pragma unroll
                    for (int n = 0; n < 2; ++n) acc[a][b][m][n] = (f32x4){0.f, 0.f, 0.f, 0.f};
        cur = nxt; cA = nA; cB = nB; ++ui;
        if (wr == 1) PG8_BAR;
    }
    PG8_WAIT_V(0);
    PG8_BAR;
#undef PG8_SA
#undef PG8_SB
#undef PG8_STAGE
#undef PG8_LDA
#undef PG8_LDB
#undef PG8_MMA
#undef PG8_WAIT_V
#undef PG8_WAIT_L
#undef PG8_BAR
#undef PG8_SCHED
}
}

constexpr int NWAVES = 8;
constexpr int D = 1024, NB = 16, S = 2048, M = NB * S, MEML = 256, MMEM = NB * MEML;
constexpr float LN_EPS = 1e-5f, ALPHA = 1.41421356237f;
constexpr int P0_LD = 2560, C0_QLAT = 0, C0_QB = 1024, C0_CKV = 1536, C0_QI = 1664, C0_KI = 2176, C0_KB = 2240, C0_VB = 2368, C0_WI = 2496;
constexpr int P1_LD = 2048, C1_Q = 0, C1_KC = 1024, C1_VC = 1152, C1_KS = 1280, C1_VS = 1408, C1_KW = 1536, C1_VW = 1664, C1_GL = 1792;
constexpr int EVEN_COLS = 1992, ODD_COLS = 1840;
constexpr int DFF = 2816, DFFE = 3584, NE = 8, NCMP = 127;
constexpr int MOE_CHUNK_TILES = 68, MOE_MAX_TILES = 272;

constexpr size_t MiB = 1u << 20;
constexpr size_t WS_CTL = 0, CTL_ZERO_BYTES = 1 * MiB;
constexpr size_t WS_KC = 2 * MiB, WS_VC = 3 * MiB;
constexpr size_t WS_SELM = 4 * MiB;
constexpr size_t WS_RTE = 4 * MiB + 512 * 1024;
constexpr size_t WS_RTW = 5 * MiB;
constexpr size_t WS_ROWTOK = ROWTOK_OFF; static_assert(ROWTOK_OFF == 5 * MiB + 512 * 1024, "");
constexpr size_t WS_ROWW = ROWW_OFF;
constexpr size_t WS_TILEEXP = TILEEXP_OFF; constexpr size_t WS_DUMMY = DUMMY_OFF;
constexpr size_t WS_W = 8 * MiB;
constexpr size_t W_IN0 = WS_W;
constexpr size_t W_OUT0 = W_IN0 + (size_t)2560 * 1024 * 2;
constexpr size_t W_IN1 = W_OUT0 + (size_t)1024 * 1536 * 2;
constexpr size_t W_OUT1 = W_IN1 + (size_t)2048 * 1024 * 2;
constexpr size_t W_XQ = W_OUT1 + (size_t)1024 * 1024 * 2;
constexpr size_t W_XKV = W_XQ + (size_t)2 * 512 * 1024 * 2;
constexpr size_t W_XO = W_XKV + (size_t)2 * 1024 * 1024 * 2;
constexpr size_t W_FGU = W_XO + (size_t)2 * 1024 * 512 * 2;
constexpr size_t W_FD = W_FGU + (size_t)5632 * 1024 * 2;
constexpr size_t W_MGU = W_FD + (size_t)1024 * 2816 * 2;
constexpr size_t W_MD = W_MGU + (size_t)8 * 7168 * 1024 * 2;
constexpr size_t W_END = W_MD + (size_t)8 * 1024 * 3584 * 2;
static_assert(W_END <= 215 * MiB, "weights");
constexpr size_t WS_HB = 215 * MiB;
constexpr size_t WS_XKV = 279 * MiB;
constexpr size_t WS_SCR = 295 * MiB;
constexpr size_t WS_P0 = WS_SCR;
constexpr size_t WS_CN = WS_SCR + 160 * MiB;
constexpr size_t WS_MASK = WS_SCR + 168 * MiB;
constexpr size_t WS_MEMB = WS_SCR + 176 * MiB;
constexpr size_t WS_QX0 = WS_SCR + 184 * MiB, WS_OX0 = WS_SCR + 216 * MiB;
constexpr size_t WS_HID = WS_SCR;
constexpr size_t WS_P1 = WS_SCR;
constexpr size_t WS_OCMP = WS_SCR + 128 * MiB, WS_OSLC = WS_SCR + 192 * MiB;
constexpr size_t WS_W1T = WS_SCR + 192 * MiB, WS_HIDC = WS_SCR + 196 * MiB, WS_PEB = WS_SCR + 200 * MiB;
constexpr size_t WS_QX1 = WS_SCR, WS_OX1 = WS_SCR + 32 * MiB;
constexpr size_t WS_PERMA = WS_SCR;
constexpr size_t WS_HIDM = WS_SCR + 136 * MiB;
constexpr size_t WS_END = WS_SCR + 256 * MiB;
static_assert(WS_HIDM + (size_t)MOE_CHUNK_TILES * 256 * DFFE * 2 <= WS_END, "ws");
constexpr int CW_BAR = 4096;
constexpr int CW_CNT = 16384;
constexpr int CW_CUR = 16384 + 64;

constexpr int RING_BYTES = 131072, LDSCTL_OFF = RING_BYTES, MISC_OFF = LDSCTL_OFF + 320, LDS_BYTES = 147456;

#define GAS __attribute__((address_space(1)))
#define LAS __attribute__((address_space(3)))
typedef unsigned short bf16;
typedef unsigned v4u __attribute__((ext_vector_type(4)));
typedef unsigned v2u __attribute__((ext_vector_type(2)));
typedef float f32x4 __attribute__((ext_vector_type(4)));
#define LDS_WAIT() asm volatile("s_waitcnt lgkmcnt(0)" ::: "memory")
#define WAVE_SYNC() asm volatile("s_waitcnt vmcnt(0) lgkmcnt(0)" ::: "memory")
__device__ __forceinline__ unsigned f2bf(float f) { unsigned u = __builtin_bit_cast(unsigned, f); return (u + 0x7fffu + ((u >> 16) & 1u)) >> 16; }
__device__ __forceinline__ unsigned pk2(float lo, float hi) { return f2bf(lo) | (f2bf(hi) << 16); }
__device__ __forceinline__ float bf2f(bf16 b) { return __builtin_bit_cast(float, (unsigned)b << 16); }
__device__ __forceinline__ float bflo(unsigned w) { return __builtin_bit_cast(float, w << 16); }
__device__ __forceinline__ float bfhi(unsigned w) { return __builtin_bit_cast(float, w & 0xffff0000u); }
__device__ __forceinline__ void ld8bf(const bf16* p, float* f) { const v4u w = *(const v4u*)p; f[0] = bflo(w.x); f[1] = bfhi(w.x); f[2] = bflo(w.y); f[3] = bfhi(w.y); f[4] = bflo(w.z); f[5] = bfhi(w.z); f[6] = bflo(w.w); f[7] = bfhi(w.w); }
__device__ __forceinline__ float wave_sum(float v) {
#pragma unroll
    for (int o = 1; o < 64; o <<= 1) v += __shfl_xor(v, o);
    return v;
}
__device__ __forceinline__ float dpp_f(float v, int ctrl_unused);
#define DPP_ADD_F(v, ctrl, rmask) v += __builtin_bit_cast(float, __builtin_amdgcn_update_dpp(0, __builtin_bit_cast(int, v), ctrl, rmask, 0xf, false))
__device__ __forceinline__ float wave_sum_fast(float v) {
    DPP_ADD_F(v, 0xB1, 0xf); DPP_ADD_F(v, 0x4E, 0xf); DPP_ADD_F(v, 0x141, 0xf); DPP_ADD_F(v, 0x140, 0xf); DPP_ADD_F(v, 0x142, 0xa); DPP_ADD_F(v, 0x143, 0xc);
    return __builtin_bit_cast(float, __builtin_amdgcn_readlane(__builtin_bit_cast(int, v), 63));
}
__device__ __forceinline__ float wave_max(float v) {
#pragma unroll
    for (int o = 1; o < 64; o <<= 1) v = fmaxf(v, __shfl_xor(v, o));
    return v;
}
__device__ const unsigned char BKT[112] = {16, 16, 16, 17, 17, 18, 18, 18, 19, 19, 19, 20, 20, 20, 20, 21, 21, 21, 21, 22, 22, 22, 22, 22, 23, 23, 23, 23, 23, 23, 24, 24, 24, 24, 24, 24, 25, 25, 25, 25, 25, 25, 25, 26, 26, 26, 26, 26, 26, 26, 26,
    27, 27, 27, 27, 27, 27, 27, 27, 27, 27, 28, 28, 28, 28, 28, 28, 28, 28, 28, 28, 29, 29, 29, 29, 29, 29, 29, 29, 29, 29, 29, 29, 30, 30, 30, 30, 30, 30, 30, 30, 30, 30, 30, 30, 30, 30, 31, 31, 31, 31, 31, 31, 31, 31, 31, 31, 31, 31, 31, 31, 31};
__device__ __forceinline__ int rel_bucket(int n) { return n < 16 ? n : (n >= 128 ? 31 : (int)BKT[n - 16]); }

#define XB_TMO      128
#define XB_XCNT(j)  (256  + 64 * (j))
#define XB_XSUB(j)  (1280 + 64 * (j))
#define XB_XGEN(j)  (2304 + 64 * (j))
#define XB_TOP      3328
#define XB_TOPGEN   3392
#define XCD_BAR_WORDS 3456
#define XB_SPIN_CAP (1u << 22)
__device__ __forceinline__ unsigned xb_ld(unsigned* p)              { return __hip_atomic_load(p, __ATOMIC_RELAXED, __HIP_MEMORY_SCOPE_AGENT); }
__device__ __forceinline__ unsigned xb_add(unsigned* p, unsigned v) { return __hip_atomic_fetch_add(p, v, __ATOMIC_RELAXED, __HIP_MEMORY_SCOPE_AGENT); }
__device__ __forceinline__ unsigned xb_xcc_id() { return (unsigned)__builtin_amdgcn_s_getreg((3 << 11) | 20) & 0xFu; }
#define XB_SPIN(cond, bar) do { unsigned _sp = 0; while (cond) { __builtin_amdgcn_s_sleep(1); \
    if ((++_sp & 255u) == 0u) { if (xb_ld(&(bar)[XB_TMO])) break; if (_sp > XB_SPIN_CAP) { atomicAdd(&(bar)[XB_TMO], 1u); break; } } } } while (0)
struct XcdBarrier { unsigned* bar; unsigned x; volatile LAS unsigned* st; };
__device__ __forceinline__ XcdBarrier xcd_barrier_post(unsigned* bar, volatile LAS unsigned* st) {
    XcdBarrier b; b.bar = bar; b.x = xb_xcc_id(); b.st = st;
    if (threadIdx.x == 0) (void)xb_add(&bar[XB_XCNT(b.x)], 1u);
    return b;
}
__device__ __forceinline__ void xcd_barrier_complete(unsigned* bar, unsigned x, unsigned& nloc, unsigned& nx) {
    const unsigned G = gridDim.x * gridDim.y * gridDim.z;
    unsigned sum, cnt, mine, sp = 0u;
    for (;;) {
        sum = 0u; cnt = 0u; mine = 0u;
#pragma unroll
        for (unsigned j = 0; j < 16; ++j) { const unsigned c = xb_ld(&bar[XB_XCNT(j)]); sum += c; cnt += (c > 0u) ? 1u : 0u; mine = (j == x) ? c : mine; }
        if (sum == G) break;
        __builtin_amdgcn_s_sleep(1);
        if ((++sp & 255u) == 0u) { if (xb_ld(&bar[XB_TMO])) break; if (sp > XB_SPIN_CAP) { atomicAdd(&bar[XB_TMO], 1u); break; } }
    }
    nloc = mine > 0u ? mine : 1u; nx = cnt > 0u ? cnt : 1u;
}
__device__ __forceinline__ void xcd_barrier(const XcdBarrier& b) {
    asm volatile("s_waitcnt vmcnt(0)" ::: "memory");
    __syncthreads();
    if (threadIdx.x == 0) {
        unsigned* bar = b.bar;
        __builtin_amdgcn_s_waitcnt(0);
        unsigned nloc = b.st[0], nx = b.st[1];
        const unsigned old = xb_add(&bar[XB_XSUB(b.x)], 1u);
        const unsigned gen = old / nloc;
        if (old + 1u == (gen + 1u) * nloc) {
            __builtin_amdgcn_fence(__ATOMIC_RELEASE, "agent");
            asm volatile("s_waitcnt vmcnt(0)" ::: "memory");
            const unsigned og = xb_add(&bar[XB_TOP], 1u);
            const unsigned tg = og / nx;
            if (og + 1u == (tg + 1u) * nx) xb_add(&bar[XB_TOPGEN], 1u);
            else XB_SPIN(xb_ld(&bar[XB_TOPGEN]) == tg, bar);
            __builtin_amdgcn_fence(__ATOMIC_ACQUIRE, "agent");
            xb_add(&bar[XB_XGEN(b.x)], 1u);
            asm volatile("s_waitcnt vmcnt(0)" ::: "memory");
        } else {
            XB_SPIN(xb_ld(&bar[XB_XGEN(b.x)]) == gen, bar);
            __builtin_amdgcn_fence(__ATOMIC_ACQUIRE, "agent");
            asm volatile("s_waitcnt vmcnt(0)" ::: "memory");
        }
    }
    __syncthreads();
}

struct Args { const float* in[30]; float* out; unsigned char* ws; int ph_lo, ph_hi; };
enum { I_X = 0, I_MEM, I_REL, I_EV_WIN, I_EV_GAIN, I_EV_WUK, I_EV_WUV, I_EV_SINK, I_EV_WOUT, I_OD_WIN, I_OD_PEK, I_OD_W1K, I_OD_W2K, I_OD_PEV, I_OD_W1V, I_OD_W2V, I_OD_WOUT,
       I_XA_WQ, I_XA_WK, I_XA_WV, I_XA_WO, I_FF_G, I_FF_U, I_FF_D, I_MOE_R, I_MOE_G, I_MOE_U, I_MOE_D, I_LN_G, I_LN_B };

struct Frame {
    LAS unsigned char* lds;
    unsigned char* ws; float* acc;
    const float* const* in;
    int tid, lane, wave, G, gw, NGW;
};

__device__ __forceinline__ bool fresh(Frame& F, unsigned char*& ws, unsigned char* ws0, float* acc0) { int l = (int)__builtin_amdgcn_mbcnt_hi(~0u, __builtin_amdgcn_mbcnt_lo(~0u, 0u)); asm volatile("" : "+v"(l)); F.lane = l; F.tid = F.wave * 64 + l;
    ws = (unsigned char*)pg8::opaque_uniform(ws0); F.ws = ws; F.acc = (float*)pg8::opaque_uniform(acc0); return true; }
__device__ __forceinline__ bool probe_open(Frame& F, int k) { PROBE_WIN(k, 1u, F.tid); PROBE_START(1, F.tid); return true; }
__device__ __forceinline__ void probe_close(Frame& F, int k) { if (PROBE_SEL(k)) { PROBE_STOP(1, F.tid); } PROBE_WIN(k, 0u, F.tid); }
__device__ __forceinline__ void tconv_item(const float* W, int ldw, int ncols, bf16* WT, int ldt, int grp, int gstride, LAS float* scr, int kb, int nb, int lane) {
    const int k0 = 64 * kb, n0 = 32 * nb;
    const int kr = lane >> 3, n4 = (lane & 7) * 4;
    f32x4 v[8];
#pragma unroll
    for (int i = 0; i < 8; ++i) v[i] = (n0 + n4 < ncols) ? *(const f32x4*)(W + (size_t)(k0 + 8 * i + kr) * ldw + n0 + n4) : (f32x4){0.f, 0.f, 0.f, 0.f};
#pragma unroll
    for (int i = 0; i < 8; ++i) { LAS float* d = scr + (8 * i + kr) * 33 + n4; d[0] = v[i].x; d[1] = v[i].y; d[2] = v[i].z; d[3] = v[i].w; }
    LDS_WAIT();
    const int c = lane & 7;
#pragma unroll
    for (int j = 0; j < 4; ++j) { const int nn = (lane >> 3) + 8 * j, n = n0 + nn; const LAS float* s = scr + (8 * c) * 33 + nn;
        v4u o; o.x = pk2(s[0 * 33], s[1 * 33]); o.y = pk2(s[2 * 33], s[3 * 33]); o.z = pk2(s[4 * 33], s[5 * 33]); o.w = pk2(s[6 * 33], s[7 * 33]);
        const int row = (n / grp) * gstride + (n % grp);
        *(v4u*)(WT + (size_t)row * ldt + k0 + 8 * c) = o; }
    LDS_WAIT();
}
__device__ __forceinline__ void tconv(const Frame& F, const float* W, int ldw, int K, int ncols, int npad, bf16* WT, int ldt, int grp, int gstride) {
    LAS float* scr = (LAS float*)(F.lds + F.wave * 16384);
    const int nkb = K / 64, nnb = npad / 32;
    for (int it = F.gw; it < nkb * nnb; it += F.NGW) tconv_item(W, ldw, ncols, WT, ldt, grp, gstride, scr, it / nnb, it % nnb, F.lane);
}
constexpr int NOGRP = 1 << 30;

__device__ __forceinline__ void prologue(const Frame& F) {
    unsigned char* ws = F.ws;
    const int gt = F.gw * 64 + F.lane, NT = F.NGW * 64;
    bf16* win0 = (bf16*)(ws + W_IN0);
    const float* evw = F.in[I_EV_WIN];
    tconv(F, evw + 512, EVEN_COLS, 1024, 128, 128, win0 + (size_t)C0_CKV * 1024, 1024, NOGRP, 0);
    tconv(F, evw + 640, EVEN_COLS, 1024, 512, 512, win0 + (size_t)C0_QI * 1024, 1024, NOGRP, 0);
    tconv(F, evw + 1152, EVEN_COLS, 1024, 64, 64, win0 + (size_t)C0_KI * 1024, 1024, NOGRP, 0);
    tconv(F, evw + 1216, EVEN_COLS, 1024, 8, 64, win0 + (size_t)C0_WI * 1024, 1024, NOGRP, 0);
    tconv(F, evw + 1224, EVEN_COLS, 1024, 512, 512, win0 + (size_t)C0_QB * 1024, 1024, NOGRP, 0);
    tconv(F, evw + 1736, EVEN_COLS, 1024, 128, 128, win0 + (size_t)C0_KB * 1024, 1024, NOGRP, 0);
    tconv(F, evw + 1864, EVEN_COLS, 1024, 128, 128, win0 + (size_t)C0_VB * 1024, 1024, NOGRP, 0);
    bf16* wout0 = (bf16*)(ws + W_OUT0);
    const float* evo = F.in[I_EV_WOUT];
    tconv(F, evo + (size_t)512 * 1024, 1024, 512, 1024, 1024, wout0 + 1024, 1536, NOGRP, 0);
    tconv(F, F.in[I_OD_WIN], ODD_COLS, 1024, ODD_COLS, 2048, (bf16*)(ws + W_IN1), 1024, NOGRP, 0);
    tconv(F, F.in[I_OD_WOUT], 1024, 1024, 1024, 1024, (bf16*)(ws + W_OUT1), 1024, NOGRP, 0);
    for (int i = 0; i < 2; ++i) {
        tconv(F, F.in[I_XA_WQ] + (size_t)i * 1024 * 512, 512, 1024, 512, 512, (bf16*)(ws + W_XQ) + (size_t)i * 512 * 1024, 1024, NOGRP, 0);
        tconv(F, F.in[I_XA_WK] + (size_t)i * 1024 * 512, 512, 1024, 512, 512, (bf16*)(ws + W_XKV) + (size_t)i * 1024 * 1024, 1024, NOGRP, 0);
        tconv(F, F.in[I_XA_WV] + (size_t)i * 1024 * 512, 512, 1024, 512, 512, (bf16*)(ws + W_XKV) + (size_t)i * 1024 * 1024 + (size_t)512 * 1024, 1024, NOGRP, 0);
        tconv(F, F.in[I_XA_WO] + (size_t)i * 512 * 1024, 1024, 512, 1024, 1024, (bf16*)(ws + W_XO) + (size_t)i * 1024 * 512, 512, NOGRP, 0);
    }
    tconv(F, F.in[I_FF_G], DFF, 1024, DFF, DFF, (bf16*)(ws + W_FGU), 1024, 128, 256);
    tconv(F, F.in[I_FF_U], DFF, 1024, DFF, DFF, (bf16*)(ws + W_FGU) + (size_t)128 * 1024, 1024, 128, 256);
    tconv(F, F.in[I_FF_D], 1024, DFF, 1024, 1024, (bf16*)(ws + W_FD), DFF, NOGRP, 0);
    for (int e = 0; e < NE; ++e) {
        tconv(F, F.in[I_MOE_G] + (size_t)e * 1024 * DFFE, DFFE, 1024, DFFE, DFFE, (bf16*)(ws + W_MGU) + (size_t)e * 7168 * 1024, 1024, 128, 256);
        tconv(F, F.in[I_MOE_U] + (size_t)e * 1024 * DFFE, DFFE, 1024, DFFE, DFFE, (bf16*)(ws + W_MGU) + (size_t)e * 7168 * 1024 + (size_t)128 * 1024, 1024, 128, 256);
        tconv(F, F.in[I_MOE_D] + (size_t)e * DFFE * 1024, 1024, DFFE, 1024, 1024, (bf16*)(ws + W_MD) + (size_t)e * 1024 * DFFE, DFFE, NOGRP, 0);
    }
    __syncthreads();
    {
        const float* wuk = F.in[I_EV_WUK]; const float* wuv = F.in[I_EV_WUV];
        LAS float* As = (LAS float*)F.lds; LAS float* Bs = As + 128 * 65;
        for (int item = blockIdx.x; item < 256; item += F.G) {
            const int h = (item >> 4) & 7, tt = item & 15;
            if (item < 128) {
                const int k0 = 64 * tt;
                for (int i = F.tid; i < 4096; i += 512) { const int kk = i >> 6, d = i & 63; As[kk * 65 + d] = evw[(size_t)(k0 + kk) * EVEN_COLS + h * 64 + d]; }
                for (int i = F.tid; i < 8192; i += 512) Bs[i] = wuk[(size_t)h * 8192 + i];
                __syncthreads();
                const int kk = F.tid & 63, cg = F.tid >> 6; float acc[16];
#pragma unroll
                for (int j = 0; j < 16; ++j) acc[j] = 0.f;
#pragma unroll 4
                for (int d = 0; d < 64; ++d) { const float a = As[kk * 65 + d];
#pragma unroll
                    for (int j = 0; j < 16; ++j) acc[j] += a * Bs[d * 128 + cg * 16 + j]; }
#pragma unroll
                for (int j = 0; j < 16; ++j) win0[(size_t)(C0_QLAT + h * 128 + cg * 16 + j) * 1024 + k0 + kk] = (bf16)f2bf(acc[j]);
            } else {
                const int n0 = 64 * tt;
                for (int i = F.tid; i < 8192; i += 512) { const int c = i >> 6, d = i & 63; As[c * 65 + d] = wuv[(size_t)h * 8192 + i]; }
                for (int i = F.tid; i < 4096; i += 512) { const int d = i >> 6, nn = i & 63; Bs[i] = evo[(size_t)(h * 64 + d) * 1024 + n0 + nn]; }
                __syncthreads();
                const int c = F.tid & 127, ng = F.tid >> 7; float acc[16];
#pragma unroll
                for (int j = 0; j < 16; ++j) acc[j] = 0.f;
#pragma unroll 4
                for (int d = 0; d < 64; ++d) { const float a = As[c * 65 + d];
#pragma unroll
                    for (int j = 0; j < 16; ++j) acc[j] += a * Bs[d * 64 + ng * 16 + j]; }
#pragma unroll
                for (int j = 0; j < 16; ++j) wout0[(size_t)(n0 + ng * 16 + j) * 1536 + h * 128 + c] = (bf16)f2bf(acc[j]);
            }
            __syncthreads();
        }
    }
    {
        const f32x4* x4 = (const f32x4*)F.in[I_X]; v2u* hb = (v2u*)(ws + WS_HB);
        for (int i = gt; i < M * D / 4; i += 4 * NT) { f32x4 v[4];
#pragma unroll
            for (int j = 0; j < 4; ++j) v[j] = x4[i + j * NT];
#pragma unroll
            for (int j = 0; j < 4; ++j) { v2u o; o.x = pk2(v[j].x, v[j].y); o.y = pk2(v[j].z, v[j].w); hb[i + j * NT] = o; } }
        const f32x4* m4 = (const f32x4*)F.in[I_MEM]; v2u* mb = (v2u*)(ws + WS_MEMB);
        for (int i = gt; i < MMEM * D / 4; i += 4 * NT) { f32x4 v[4];
#pragma unroll
            for (int j = 0; j < 4; ++j) v[j] = m4[i + j * NT];
#pragma unroll
            for (int j = 0; j < 4; ++j) { v2u o; o.x = pk2(v[j].x, v[j].y); o.y = pk2(v[j].z, v[j].w); mb[i + j * NT] = o; } }
    }
}

template <int MODE>
__device__ __forceinline__ void ln_phase(const Frame& F, int li, const bf16* sumb) {
    const float* g = F.in[I_LN_G] + (size_t)li * D; const float* bb = F.in[I_LN_B] + (size_t)li * D;
    LAS int* lcnt = (LAS int*)F.lds;
    if (MODE == 1) { if (F.tid < 16) lcnt[F.tid] = 0; __syncthreads(); }
    f32x4 rw[MODE == 1 ? 32 : 1];
    if (MODE == 1) { const float* wr = F.in[I_MOE_R];
#pragma unroll
        for (int j = 0; j < 4; ++j)
#pragma unroll
            for (int i = 0; i < 4; ++i) { const int c = 4 * (F.lane + 64 * j) + i; rw[(4 * j + i) * 2] = *(const f32x4*)(wr + (size_t)c * 8); rw[(4 * j + i) * 2 + 1] = *(const f32x4*)(wr + (size_t)c * 8 + 4); } }
    for (int row = F.gw; row < M; row += F.NGW) {
        f32x4* p = (f32x4*)(F.acc + (size_t)row * D) + F.lane;
        f32x4 v[4]; float s = 0.f;
        if (MODE == 2) { const v2u* hp = (const v2u*)(F.ws + WS_HB + (size_t)row * D * 2) + F.lane;
#pragma unroll
            for (int j = 0; j < 4; ++j) { const v2u a = hp[64 * j]; v[j] = (f32x4){bflo(a.x), bfhi(a.x), bflo(a.y), bfhi(a.y)} * ALPHA; }
        } else { const v2u* sp = (const v2u*)(sumb + (size_t)row * D) + F.lane;
#pragma unroll
            for (int j = 0; j < 4; ++j) { const v2u a = sp[64 * j]; v[j] = (f32x4){bflo(a.x), bfhi(a.x), bflo(a.y), bfhi(a.y)}; } }
        if (MODE == 2) {
            const int p0 = ((const int*)(F.ws + WS_RTE))[2 * row], p1 = ((const int*)(F.ws + WS_RTE))[2 * row + 1]; const float w0 = ((const float*)(F.ws + WS_RTW))[2 * row], w1 = ((const float*)(F.ws + WS_RTW))[2 * row + 1];
            const v2u* y0 = (const v2u*)(F.ws + WS_PERMA + (size_t)p0 * D * 2) + F.lane; const v2u* y1 = (const v2u*)(F.ws + WS_PERMA + (size_t)p1 * D * 2) + F.lane;
#pragma unroll
            for (int j = 0; j < 4; ++j) { const v2u a = y0[64 * j], b = y1[64 * j];
                v[j].x += w0 * bflo(a.x) + w1 * bflo(b.x); v[j].y += w0 * bfhi(a.x) + w1 * bfhi(b.x); v[j].z += w0 * bflo(a.y) + w1 * bflo(b.y); v[j].w += w0 * bfhi(a.y) + w1 * bfhi(b.y); } }
#pragma unroll
        for (int j = 0; j < 4; ++j) s += (v[j].x + v[j].y) + (v[j].z + v[j].w);
        const float mean = wave_sum_fast(s) * (1.f / D); float s2 = 0.f;
#pragma unroll
        for (int j = 0; j < 4; ++j) { v[j] = v[j] - mean; s2 += (v[j].x * v[j].x + v[j].y * v[j].y) + (v[j].z * v[j].z + v[j].w * v[j].w); }
        const float rstd = 1.f / sqrtf(wave_sum_fast(s2) * (1.f / D) + LN_EPS);
#pragma unroll
        for (int j = 0; j < 4; ++j) { const f32x4 gg = ((const f32x4*)g)[F.lane + 64 * j], b4 = ((const f32x4*)bb)[F.lane + 64 * j]; v[j] = v[j] * rstd * gg + b4; }
        if (MODE == 2) {
#pragma unroll
            for (int j = 0; j < 4; ++j) p[64 * j] = v[j];
        } else {
            v2u* hb = (v2u*)(F.ws + WS_HB + (size_t)row * D * 2) + F.lane;
#pragma unroll
            for (int j = 0; j < 4; ++j) { v2u o; o.x = pk2(v[j].x, v[j].y); o.y = pk2(v[j].z, v[j].w); hb[64 * j] = o; }
        }
        if (MODE == 1) {
            float lg[8];
#pragma unroll
            for (int e = 0; e < 8; ++e) lg[e] = 0.f;
#pragma unroll
            for (int j = 0; j < 4; ++j)
#pragma unroll
                for (int i = 0; i < 4; ++i) { const f32x4 w0 = rw[(4 * j + i) * 2], w1 = rw[(4 * j + i) * 2 + 1]; const float y = v[j][i];
                    lg[0] += y * w0.x; lg[1] += y * w0.y; lg[2] += y * w0.z; lg[3] += y * w0.w; lg[4] += y * w1.x; lg[5] += y * w1.y; lg[6] += y * w1.z; lg[7] += y * w1.w; }
#pragma unroll
            for (int e = 0; e < 8; ++e) lg[e] = wave_sum_fast(lg[e]);
            int e0 = 0; float v0 = lg[0];
#pragma unroll
            for (int e = 1; e < 8; ++e) if (lg[e] > v0) { v0 = lg[e]; e0 = e; }
            int e1 = -1; float v1 = -3.0e38f;
#pragma unroll
            for (int e = 0; e < 8; ++e) if (e != e0 && lg[e] > v1) { v1 = lg[e]; e1 = e; }
            const float w0 = 1.f / (1.f + __expf(v1 - v0)), w1 = 1.f - w0;
            if (F.lane == 0) { int* rte = (int*)(F.ws + WS_RTE); float* rtw = (float*)(F.ws + WS_RTW); rte[2 * row] = e0; rte[2 * row + 1] = e1; rtw[2 * row] = w0; rtw[2 * row + 1] = w1;
                atomicAdd((int*)&lcnt[e0], 1); atomicAdd((int*)&lcnt[8 + e1], 1); }
        }
    }
    if (MODE == 1) { __syncthreads(); if (F.tid < 16) { const int c = lcnt[F.tid]; if (c) atomicAdd((unsigned*)(F.ws + WS_CTL) + CW_CNT + F.tid, (unsigned)c); } }
}

__device__ __forceinline__ void moe_dispatch(const Frame& F) {
    unsigned* ctl = (unsigned*)(F.ws + WS_CTL);
    int* tile_exp = (int*)(F.ws + WS_TILEEXP); int* rowtok = (int*)(F.ws + WS_ROWTOK); float* roww = (float*)(F.ws + WS_ROWW);
    LAS int* seg = (LAS int*)F.lds;
    if (F.tid == 0) { int run = 0;
#pragma unroll 1
        for (int sgi = 0; sgi < 16; ++sgi) { if ((sgi & 7) == 0) seg[32 + (sgi >> 3)] = run >> 8; seg[sgi] = run; const int c = (int)__hip_atomic_load(ctl + CW_CNT + sgi, __ATOMIC_RELAXED, __HIP_MEMORY_SCOPE_AGENT); seg[16 + sgi] = c; run += (c + 255) & ~255; }
        seg[34] = run >> 8; }
    __syncthreads();
    if (blockIdx.x == 0) {
#pragma unroll 1
        for (int sgi = 0; sgi < 16; ++sgi) { const int c = seg[16 + sgi], st = seg[sgi], en = st + ((c + 255) & ~255);
            for (int t = (st >> 8) + F.tid; t < (en >> 8); t += 512) tile_exp[t] = sgi & 7;
            for (int r = st + c + F.tid; r < en; r += 512) { rowtok[r] = -1; roww[r] = 0.f; } }
        if (F.tid < 3) tile_exp[512 + F.tid] = seg[32 + F.tid];
    }
    const int* rte = (const int*)(F.ws + WS_RTE); const float* rtw = (const float*)(F.ws + WS_RTW);
    LAS int* lcnt = seg + 64; LAS int* gb = seg + 96; LAS int* posl = seg + 128;
    for (int chunk = blockIdx.x; chunk < M / 128; chunk += F.G) {
        if (F.tid < 16) lcnt[F.tid] = 0;
        __syncthreads();
        const int tok = chunk * 128 + (F.tid & 127); int e0 = 0, e1 = 0, r0 = 0, r1 = 0;
        if (F.tid < 128) { e0 = rte[2 * tok]; e1 = rte[2 * tok + 1]; r0 = atomicAdd((int*)&lcnt[e0], 1); r1 = atomicAdd((int*)&lcnt[8 + e1], 1); }
        __syncthreads();
        if (F.tid < 16) { const int c = lcnt[F.tid]; gb[F.tid] = c ? (int)atomicAdd(ctl + CW_CUR + F.tid, (unsigned)c) : 0; }
        __syncthreads();
        if (F.tid < 128) { const int p0 = seg[e0] + gb[e0] + r0, p1 = seg[8 + e1] + gb[8 + e1] + r1; posl[2 * F.tid] = p0; posl[2 * F.tid + 1] = p1;
            ((int*)(F.ws + WS_RTE))[2 * tok] = p0; ((int*)(F.ws + WS_RTE))[2 * tok + 1] = p1; }
        __syncthreads();
#pragma unroll 1
        for (int i0 = 0; i0 < 16; i0 += 8) {
            v4u a[8], b[8];
#pragma unroll
            for (int k = 0; k < 8; ++k) { const v4u* src = (const v4u*)(F.ws + WS_HB + (size_t)(chunk * 128 + F.wave * 16 + i0 + k) * D * 2); a[k] = src[F.lane]; b[k] = src[F.lane + 64]; }
#pragma unroll
            for (int k = 0; k < 8; ++k) { const int p0 = posl[2 * (F.wave * 16 + i0 + k)], p1 = posl[2 * (F.wave * 16 + i0 + k) + 1];
                v4u* d0 = (v4u*)(F.ws + WS_PERMA + (size_t)p0 * D * 2); v4u* d1 = (v4u*)(F.ws + WS_PERMA + (size_t)p1 * D * 2);
                d0[F.lane] = a[k]; d0[F.lane + 64] = b[k]; d1[F.lane] = a[k]; d1[F.lane + 64] = b[k]; } }
        __syncthreads();
    }
    __syncthreads();
}

__device__ __forceinline__ void cn_phase(const Frame& F) {
    const bf16* P0 = (const bf16*)(F.ws + WS_P0); bf16* CN = (bf16*)(F.ws + WS_CN); const float* gain = F.in[I_EV_GAIN];
    const float g0 = gain[2 * F.lane], g1 = gain[2 * F.lane + 1];
    for (int row0 = F.gw * 8; row0 < M; row0 += F.NGW * 8) {
        unsigned w[8];
#pragma unroll
        for (int i = 0; i < 8; ++i) w[i] = *(const unsigned*)(P0 + (size_t)(row0 + i) * P0_LD + C0_CKV + 2 * F.lane);
#pragma unroll
        for (int i = 0; i < 8; ++i) { const float a = bflo(w[i]), b = bfhi(w[i]);
            const float ms = wave_sum_fast(a * a + b * b) * (1.f / 128.f); const float r = 1.f / sqrtf(ms + LN_EPS);
            *(unsigned*)(CN + (size_t)(row0 + i) * 128 + 2 * F.lane) = pk2(a * r * g0, b * r * g1); }
    }
}

__device__ __forceinline__ unsigned fkey(float x) { unsigned b = __builtin_bit_cast(unsigned, x); if (b == 0x80000000u) b = 0u; return (b & 0x80000000u) ? ~b : (b | 0x80000000u); }
__device__ __forceinline__ void idx_phase(const Frame& F) {
    const bf16* P0 = (const bf16*)(F.ws + WS_P0); unsigned* MASK = (unsigned*)(F.ws + WS_MASK);
    LAS float* qi_s = (LAS float*)F.lds; LAS float* wi_s = qi_s + 4096; LAS float* sc = wi_s + 64;
    for (int item = blockIdx.x; item < NB * (S / 8); item += F.G) {
        const int b = item / (S / 8), t0 = (item % (S / 8)) * 8;
        for (int i = F.tid; i < 4096; i += 512) { const int q = i >> 9, e = i & 511; qi_s[i] = bf2f(P0[(size_t)(b * S + t0 + q) * P0_LD + C0_QI + e]); }
        if (F.tid < 64) { const int q = F.tid >> 3, h = F.tid & 7; wi_s[F.tid] = bf2f(P0[(size_t)(b * S + t0 + q) * P0_LD + C0_WI + h]) * (0.35355339059f * 0.125f); }
        __syncthreads();
        const int nk = t0 + 8;
        for (int s = F.tid; s < nk; s += 512) {
            float kf[64]; const bf16* kr = P0 + (size_t)(b * S + s) * P0_LD + C0_KI;
#pragma unroll
            for (int j = 0; j < 8; ++j) ld8bf(kr + 8 * j, kf + 8 * j);
#pragma unroll 1
            for (int q = 0; q < 8; ++q) { float a = 0.f;
#pragma unroll 1
                for (int h = 0; h < 8; ++h) { const LAS float* qp = qi_s + q * 512 + h * 64; float dot = 0.f;
#pragma unroll
                    for (int d = 0; d < 64; ++d) dot += qp[d] * kf[d];
                    a += wi_s[q * 8 + h] * fmaxf(dot, 0.f); }
                sc[q * 2048 + s] = a; }
        }
        __syncthreads();
        {
            const int q = F.wave, t = t0 + q, n = t + 1, row = b * S + t; unsigned myword = 0u;
            if (n <= 256) { const int cb = n - 32 * F.lane; myword = cb >= 32 ? 0xffffffffu : (cb <= 0 ? 0u : ((1u << cb) - 1u)); }
            else {
                LAS unsigned* uk = (LAS unsigned*)(sc + q * 2048);
#pragma unroll 4
                for (int i = 0; i < 32; ++i) { const int s = F.lane + 64 * i; const unsigned k = (s < n) ? fkey(sc[q * 2048 + s]) : 0u; uk[s] = k; }
                LDS_WAIT();
                unsigned prefix = 0u;
#pragma unroll 1
                for (int bit = 31; bit >= 0; --bit) { const unsigned cand = prefix | (1u << bit); int c = 0;
#pragma unroll 8
                    for (int i = 0; i < 32; ++i) c += (uk[F.lane + 64 * i] >= cand) ? 1 : 0;
#pragma unroll
                    for (int o = 1; o < 64; o <<= 1) c += __shfl_xor(c, o);
                    if (c >= 256) prefix = cand; }
                int cgt = 0;
#pragma unroll 8
                for (int i = 0; i < 32; ++i) cgt += (uk[F.lane + 64 * i] > prefix) ? 1 : 0;
#pragma unroll
                for (int o = 1; o < 64; o <<= 1) cgt += __shfl_xor(cgt, o);
                const int need = 256 - cgt; int run = 0;
#pragma unroll 1
                for (int i = 0; i < 32; ++i) { const unsigned u = uk[F.lane + 64 * i]; const bool eq = (u == prefix); const unsigned long long em = __ballot(eq); const int rank = run + __popcll(em & ((1ull << F.lane) - 1ull));
                    const bool sel = (u > prefix) || (eq && rank < need); run += __popcll(em);
                    const unsigned long long sm = __ballot(sel);
                    if (F.lane == 2 * i) myword = (unsigned)sm; if (F.lane == 2 * i + 1) myword = (unsigned)(sm >> 32); }
            }
            MASK[(size_t)row * 64 + F.lane] = myword;
        }
        __syncthreads();
    }
}

__device__ __forceinline__ void dsa_phase(const Frame& F) {
    bf16* P0 = (bf16*)(F.ws + WS_P0); const bf16* CN = (const bf16*)(F.ws + WS_CN); const unsigned* MASK = (const unsigned*)(F.ws + WS_MASK); const float* rel = F.in[I_REL];
    LAS float* ql = (LAS float*)(F.lds + F.wave * 13312); LAS float* pl = ql + 1024; LAS int* idx = (LAS int*)(pl + 2048);
    for (int row = F.gw; row < M; row += F.NGW) {
        const int b = row / S, t = row % S;
        const unsigned w = MASK[(size_t)row * 64 + F.lane]; const int c = __popc(w);
        int incl = c;
#pragma unroll
        for (int o = 1; o < 64; o <<= 1) { const int v = __shfl_up(incl, o); if (F.lane >= o) incl += v; }
        const int total = __shfl(incl, 63); int pos = incl - c; unsigned ww = w;
        while (ww) { const int bit = __ffs(ww) - 1; idx[pos++] = 32 * F.lane + bit; ww &= ww - 1u; }
#pragma unroll
        for (int i = 0; i < 16; ++i) ql[F.lane + 64 * i] = bf2f(P0[(size_t)row * P0_LD + C0_QLAT + F.lane + 64 * i]);
        WAVE_SYNC();
        float lg[4][8]; bool val[4];
#pragma unroll
        for (int kk = 0; kk < 4; ++kk) { const int k = F.lane + 64 * kk; val[kk] = k < total; const int key = val[kk] ? idx[k] : 0;
            float a[8];
#pragma unroll
            for (int h = 0; h < 8; ++h) a[h] = 0.f;
            const bf16* cr = CN + (size_t)(b * S + key) * 128;
#pragma unroll 1
            for (int j = 0; j < 16; ++j) { float cv[8]; ld8bf(cr + 8 * j, cv);
#pragma unroll
                for (int h = 0; h < 8; ++h)
#pragma unroll
                    for (int i = 0; i < 8; ++i) a[h] += ql[h * 128 + 8 * j + i] * cv[i]; }
            const int bk = rel_bucket(t - key);
#pragma unroll
            for (int h = 0; h < 8; ++h) lg[kk][h] = val[kk] ? (a[h] * 0.125f + rel[bk * 16 + h]) : -1.0e30f;
        }
#pragma unroll
        for (int h = 0; h < 8; ++h) { float m = fmaxf(fmaxf(lg[0][h], lg[1][h]), fmaxf(lg[2][h], lg[3][h])); m = wave_max(m);
            float e[4], s = 0.f;
#pragma unroll
            for (int kk = 0; kk < 4; ++kk) { e[kk] = val[kk] ? __expf(lg[kk][h] - m) : 0.f; s += e[kk]; }
            s = wave_sum(s); const float inv = 1.f / s;
#pragma unroll
            for (int kk = 0; kk < 4; ++kk) pl[h * 256 + F.lane + 64 * kk] = e[kk] * inv; }
        WAVE_SYNC();
        float a0[8], a1[8];
#pragma unroll
        for (int h = 0; h < 8; ++h) { a0[h] = 0.f; a1[h] = 0.f; }
        for (int k = 0; k < total; ++k) { const int key = idx[k]; const unsigned pr = *(const unsigned*)(CN + (size_t)(b * S + key) * 128 + 2 * F.lane); const float vx = bflo(pr), vy = bfhi(pr);
#pragma unroll
            for (int h = 0; h < 8; ++h) { const float p = pl[h * 256 + k]; a0[h] += p * vx; a1[h] += p * vy; } }
#pragma unroll
        for (int h = 0; h < 8; ++h) *(unsigned*)(P0 + (size_t)row * P0_LD + C0_QLAT + h * 128 + 2 * F.lane) = pk2(a0[h], a1[h]);
        WAVE_SYNC();
    }
}

template <int W, int NH, int GRPSZ, bool SINK, bool NSA>
__device__ __forceinline__ void banded_phase(const Frame& F, bf16* P, int ld, int cq, int ck, int cv, int relc0) {
    const float* rel = F.in[I_REL]; const float* sinks = F.in[I_EV_SINK];
    const bf16* OC = (const bf16*)(F.ws + WS_OCMP); const bf16* OS = (const bf16*)(F.ws + WS_OSLC);
    constexpr int NTG = S / 64;
    for (int it = F.gw; it < NB * NH * NTG; it += F.NGW) {
        const int tg = it % NTG, h = (it / NTG) % NH, b = it / (NTG * NH);
        const int t = tg * 64 + F.lane, row = b * S + t, kvh = h / GRPSZ;
        float q[64], acc[64];
        { const bf16* qr = P + (size_t)row * ld + cq + h * 64;
#pragma unroll
          for (int j = 0; j < 8; ++j) ld8bf(qr + 8 * j, q + 8 * j); }
#pragma unroll
        for (int d = 0; d < 64; ++d) acc[d] = 0.f;
        float m = SINK ? sinks[h] : -1.0e30f, l = SINK ? 1.f : 0.f;
#pragma unroll 1
        for (int j = 0; j < W; ++j) { const int s = t - j;
            const float bias = rel[rel_bucket(j) * 16 + relc0 + h];
            if (s >= 0) { const bf16* kr = P + (size_t)(b * S + s) * ld + ck + kvh * 64; float dot = 0.f;
#pragma unroll
                for (int jj = 0; jj < 8; ++jj) { float kf[8]; ld8bf(kr + 8 * jj, kf);
#pragma unroll
                    for (int i = 0; i < 8; ++i) dot += q[8 * jj + i] * kf[i]; }
                const float lgt = dot * 0.125f + bias, mn = fmaxf(m, lgt), corr = __expf(m - mn), p = __expf(lgt - mn);
                l = l * corr + p; m = mn;
                const bf16* vr = P + (size_t)(b * S + s) * ld + cv + kvh * 64;
#pragma unroll
                for (int jj = 0; jj < 8; ++jj) { float vf[8]; ld8bf(vr + 8 * jj, vf);
#pragma unroll
                    for (int i = 0; i < 8; ++i) acc[8 * jj + i] = acc[8 * jj + i] * corr + p * vf[i]; } } }
        const float inv = 1.f / l;
        float g0 = 0.f, g1 = 0.f, g2 = 1.f;
        if (NSA) { const bf16* gr = P + (size_t)row * ld + C1_GL + h * 3; g0 = 1.f / (1.f + __expf(-bf2f(gr[0]))); g1 = 1.f / (1.f + __expf(-bf2f(gr[1]))); g2 = 1.f / (1.f + __expf(-bf2f(gr[2]))); }
        bf16* orow = P + (size_t)row * ld + cq + h * 64;
#pragma unroll
        for (int jj = 0; jj < 8; ++jj) { float o[8];
#pragma unroll
            for (int i = 0; i < 8; ++i) o[i] = acc[8 * jj + i] * inv;
            if (NSA) { float c8[8], s8[8]; ld8bf(OC + (size_t)row * D + h * 64 + 8 * jj, c8); ld8bf(OS + (size_t)row * D + h * 64 + 8 * jj, s8);
#pragma unroll
                for (int i = 0; i < 8; ++i) o[i] = g0 * c8[i] + g1 * s8[i] + g2 * o[i]; }
            v4u w; w.x = pk2(o[0], o[1]); w.y = pk2(o[2], o[3]); w.z = pk2(o[4], o[5]); w.w = pk2(o[6], o[7]);
            *(v4u*)(orow + 8 * jj) = w; }
    }
}

__device__ __forceinline__ void xattn_phase(const Frame& F, const bf16* Q, const bf16* KV, bf16* O) {
    for (int it = F.gw; it < NB * 4 * (S / 32); it += F.NGW) {
        const int tg = it % (S / 32), h = (it / (S / 32)) % 4, b = it / ((S / 32) * 4);
        const int tok = tg * 32 + (F.lane >> 1), half = F.lane & 1, row = b * S + tok;
        float q[64], acc[64];
        { const bf16* qr = Q + (size_t)row * 512 + h * 128 + half * 64;
#pragma unroll
          for (int j = 0; j < 8; ++j) ld8bf(qr + 8 * j, q + 8 * j); }
#pragma unroll
        for (int d = 0; d < 64; ++d) acc[d] = 0.f;
        float m = -1.0e30f, l = 0.f;
#pragma unroll 1
        for (int mm = 0; mm < MEML; ++mm) { const bf16* kr = KV + (size_t)(b * MEML + mm) * 1024 + h * 128 + half * 64; float dot = 0.f;
#pragma unroll
            for (int jj = 0; jj < 8; ++jj) { float kf[8]; ld8bf(kr + 8 * jj, kf);
#pragma unroll
                for (int i = 0; i < 8; ++i) dot += q[8 * jj + i] * kf[i]; }
            dot += __shfl_xor(dot, 1);
            const float lgt = dot * 0.08838834764831845f, mn = fmaxf(m, lgt), corr = __expf(m - mn), p = __expf(lgt - mn);
            l = l * corr + p; m = mn;
            const bf16* vr = kr + 512;
#pragma unroll
            for (int jj = 0; jj < 8; ++jj) { float vf[8]; ld8bf(vr + 8 * jj, vf);
#pragma unroll
                for (int i = 0; i < 8; ++i) acc[8 * jj + i] = acc[8 * jj + i] * corr + p * vf[i]; } }
        const float inv = 1.f / l; bf16* orow = O + (size_t)row * 512 + h * 128 + half * 64;
#pragma unroll
        for (int jj = 0; jj < 8; ++jj) { v4u w; w.x = pk2(acc[8 * jj] * inv, acc[8 * jj + 1] * inv); w.y = pk2(acc[8 * jj + 2] * inv, acc[8 * jj + 3] * inv); w.z = pk2(acc[8 * jj + 4] * inv, acc[8 * jj + 5] * inv); w.w = pk2(acc[8 * jj + 6] * inv, acc[8 * jj + 7] * inv);
            *(v4u*)(orow + 8 * jj) = w; }
    }
}

__device__ __forceinline__ float gelu_tanh(float x) { const float u = 0.7978845608028654f * (x + 0.044715f * x * x * x); return 0.5f * x * (1.f + tanhf(u)); }
__device__ __forceinline__ void cmp_mlp_phase(const Frame& F) {
    const bf16* P1 = (const bf16*)(F.ws + WS_P1);
    LAS float* blk = (LAS float*)F.lds; LAS float* part = blk + 2048; LAS float* hid = part + 512;
    for (int item = blockIdx.x; item < 2 * NB * NCMP * 2; item += F.G) {
        const int g = item & 1, n = (item >> 1) % NCMP, b = ((item >> 1) / NCMP) % NB, which = (item >> 1) / (NCMP * NB);
        const float* pe = which ? F.in[I_OD_PEV] : F.in[I_OD_PEK]; const float* w1 = which ? F.in[I_OD_W1V] : F.in[I_OD_W1K]; const float* w2 = which ? F.in[I_OD_W2V] : F.in[I_OD_W2K];
        bf16* outp = (bf16*)(F.ws + (which ? WS_VC : WS_KC)) + ((size_t)(b * 2 + g) * 128 + n) * 64;
        const int col0 = (which ? C1_VC : C1_KC) + g * 64;
        for (int i = F.tid; i < 2048; i += 512) { const int l = i >> 6, d = i & 63; blk[i] = bf2f(P1[(size_t)(b * S + 16 * n + l) * P1_LD + col0 + d]) + pe[i]; }
        __syncthreads();
        { const int j = F.tid & 127, pp = F.tid >> 7; float a = 0.f; const float* wp = w1 + (size_t)(pp * 512) * 128 + j; const LAS float* bp = blk + pp * 512;
#pragma unroll 8
          for (int kk = 0; kk < 512; ++kk) a += bp[kk] * wp[(size_t)kk * 128];
          part[F.tid] = a; }
        __syncthreads();
        if (F.tid < 128) hid[F.tid] = gelu_tanh((part[F.tid] + part[F.tid + 128]) + (part[F.tid + 256] + part[F.tid + 384]));
        __syncthreads();
        if (F.tid < 64) { float a = 0.f;
#pragma unroll 8
            for (int j = 0; j < 128; ++j) a += hid[j] * w2[j * 64 + F.tid];
            outp[F.tid] = (bf16)f2bf(a); if (n == NCMP - 1) outp[64 + F.tid] = 0; }
        __syncthreads();
    }
}

__device__ __forceinline__ void cmp_attn_phase(const Frame& F) {
    const bf16* P1 = (const bf16*)(F.ws + WS_P1); const float* KC = (const float*)(F.ws + WS_KC); const float* VC = (const float*)(F.ws + WS_VC);
    bf16* OC = (bf16*)(F.ws + WS_OCMP); unsigned* SELM = (unsigned*)(F.ws + WS_SELM); const float* rel = F.in[I_REL];
    LAS float* qs = (LAS float*)(F.lds + F.wave * 8192); LAS float* pl = qs + 512; LAS float* psum = pl + 1024;
    for (int it = F.gw; it < M * 2; it += F.NGW) {
        const int g = it & 1, row = it >> 1, b = row / S, t = row % S;
        const int nv = (t >= 31) ? ((t - 31) / 16 + 1) : 0;
#pragma unroll
        for (int i = 0; i < 8; ++i) qs[F.lane + 64 * i] = bf2f(P1[(size_t)row * P1_LD + C1_Q + g * 512 + F.lane + 64 * i]);
        WAVE_SYNC();
        float lg[2][8]; bool val[2];
#pragma unroll
        for (int kk = 0; kk < 2; ++kk) { const int n = F.lane + 64 * kk; val[kk] = n < nv; const int nn = val[kk] ? n : 0;
            const float* kr = KC + ((size_t)(b * NCMP + nn) * 2 + g) * 64; float a[8];
#pragma unroll
            for (int h = 0; h < 8; ++h) a[h] = 0.f;
#pragma unroll 1
            for (int j = 0; j < 16; ++j) { const f32x4 kv = *(const f32x4*)(kr + 4 * j);
#pragma unroll
                for (int h = 0; h < 8; ++h) a[h] += qs[h * 64 + 4 * j] * kv.x + qs[h * 64 + 4 * j + 1] * kv.y + qs[h * 64 + 4 * j + 2] * kv.z + qs[h * 64 + 4 * j + 3] * kv.w; }
            const int bk = rel_bucket(val[kk] ? (t - (16 * nn + 31)) : 0);
#pragma unroll
            for (int h = 0; h < 8; ++h) lg[kk][h] = val[kk] ? (a[h] * 0.125f + rel[bk * 16 + g * 8 + h]) : -1.0e30f; }
        float ps[2] = {0.f, 0.f};
#pragma unroll
        for (int h = 0; h < 8; ++h) { float m = wave_max(fmaxf(lg[0][h], lg[1][h]));
            float e0 = val[0] ? __expf(lg[0][h] - m) : 0.f, e1 = val[1] ? __expf(lg[1][h] - m) : 0.f;
            const float s = wave_sum(e0 + e1); const float inv = (nv > 0) ? 1.f / s : 0.f; e0 *= inv; e1 *= inv;
            pl[h * 128 + F.lane] = e0; pl[h * 128 + 64 + F.lane] = e1; ps[0] += e0; ps[1] += e1; }
        psum[F.lane] = ps[0]; psum[64 + F.lane] = ps[1];
        WAVE_SYNC();
        float scj = -3.0e38f; bool adm = false;
        if (F.lane < 32) { const int j = F.lane; float p = 0.f;
#pragma unroll
            for (int n = 4 * j - 1; n <= 4 * j + 3; ++n) if (n >= 0 && n < NCMP) p += psum[n];
            const int blkq = t >> 6; adm = (64 * j <= t); const bool forced = (j == 0) || (j == blkq) || (j == blkq - 1);
            scj = adm ? (p + (forced ? 1.0e6f : 0.f)) : -1.0e30f; }
        int rank = 0;
#pragma unroll 1
        for (int i = 0; i < 32; ++i) { const float si = __shfl(scj, i); rank += (si > scj || (si == scj && i < F.lane)) ? 1 : 0; }
        const unsigned long long sm = __ballot(F.lane < 32 && adm && rank < 8);
        if (F.lane == 0) SELM[(size_t)row * 2 + g] = (unsigned)sm;
        float o[8];
#pragma unroll
        for (int h = 0; h < 8; ++h) o[h] = 0.f;
        for (int n = 0; n < nv; ++n) { const float v = VC[((size_t)(b * NCMP + n) * 2 + g) * 64 + F.lane];
#pragma unroll
            for (int h = 0; h < 8; ++h) o[h] += pl[h * 128 + n] * v; }
#pragma unroll
        for (int h = 0; h < 8; ++h) OC[(size_t)row * D + (g * 8 + h) * 64 + F.lane] = (bf16)f2bf(o[h]);
        WAVE_SYNC();
    }
}

__device__ __forceinline__ void slc_attn_phase(const Frame& F) {
    const bf16* P1 = (const bf16*)(F.ws + WS_P1); const unsigned* SELM = (const unsigned*)(F.ws + WS_SELM); bf16* OS = (bf16*)(F.ws + WS_OSLC); const float* rel = F.in[I_REL];
    LAS float* qs = (LAS float*)(F.lds + F.wave * 4096); LAS float* pb = qs + 512;
    for (int it = F.gw; it < M * 2; it += F.NGW) {
        const int g = it & 1, row = it >> 1, b = row / S, t = row % S;
#pragma unroll
        for (int i = 0; i < 8; ++i) qs[F.lane + 64 * i] = bf2f(P1[(size_t)row * P1_LD + C1_Q + g * 512 + F.lane + 64 * i]);
        WAVE_SYNC();
        unsigned sel = SELM[(size_t)row * 2 + g];
        float m[8], l[8], acc[8];
#pragma unroll
        for (int h = 0; h < 8; ++h) { m[h] = -1.0e30f; l[h] = 0.f; acc[h] = 0.f; }
        while (sel) { const int jb = __ffs(sel) - 1; sel &= sel - 1u;
            const int kpos = 64 * jb + F.lane; const bool valid = kpos <= t;
            const bf16* kr = P1 + (size_t)(b * S + kpos) * P1_LD + C1_KS + g * 64; float a[8];
#pragma unroll
            for (int h = 0; h < 8; ++h) a[h] = 0.f;
#pragma unroll 1
            for (int j = 0; j < 8; ++j) { float kf[8]; ld8bf(kr + 8 * j, kf);
#pragma unroll
                for (int h = 0; h < 8; ++h)
#pragma unroll
                    for (int i = 0; i < 8; ++i) a[h] += qs[h * 64 + 8 * j + i] * kf[i]; }
            const int bk = rel_bucket(valid ? (t - kpos) : 0);
            float corr[8];
#pragma unroll
            for (int h = 0; h < 8; ++h) { const float lgt = valid ? (a[h] * 0.125f + rel[bk * 16 + g * 8 + h]) : -1.0e30f;
                const float bm = wave_max(lgt), mn = fmaxf(m[h], bm); corr[h] = __expf(m[h] - mn); const float p = valid ? __expf(lgt - mn) : 0.f;
                l[h] = l[h] * corr[h] + wave_sum(p); m[h] = mn; pb[h * 64 + F.lane] = p; }
            WAVE_SYNC();
            const bf16* vb = P1 + (size_t)(b * S + 64 * jb) * P1_LD + C1_VS + g * 64 + F.lane;
            float add[8];
#pragma unroll
            for (int h = 0; h < 8; ++h) add[h] = 0.f;
            for (int k = 0; k < 64; ++k) { const float v = bf2f(vb[(size_t)k * P1_LD]);
#pragma unroll
                for (int h = 0; h < 8; ++h) add[h] += pb[h * 64 + k] * v; }
#pragma unroll
            for (int h = 0; h < 8; ++h) acc[h] = acc[h] * corr[h] + add[h];
            WAVE_SYNC();
        }
#pragma unroll
        for (int h = 0; h < 8; ++h) OS[(size_t)row * D + (g * 8 + h) * 64 + F.lane] = (bf16)f2bf(acc[h] / l[h]);
    }
}

namespace fa {
typedef short bf16x8 __attribute__((ext_vector_type(8)));
typedef short bf16x4 __attribute__((ext_vector_type(4)));
typedef float f32x16 __attribute__((ext_vector_type(16)));
constexpr int VSTR = 68;
__device__ __forceinline__ float xhalf_max(float x) { const auto r = __builtin_amdgcn_permlane32_swap(__builtin_bit_cast(unsigned, x), __builtin_bit_cast(unsigned, x), false, false);
    return fmaxf(__builtin_bit_cast(float, (unsigned)r[0]), __builtin_bit_cast(float, (unsigned)r[1])); }
__device__ __forceinline__ float xhalf_sum(float x) { const auto r = __builtin_amdgcn_permlane32_swap(__builtin_bit_cast(unsigned, x), __builtin_bit_cast(unsigned, x), false, false);
    return __builtin_bit_cast(float, (unsigned)r[0]) + __builtin_bit_cast(float, (unsigned)r[1]); }
template <int HDK, int HDV> struct Geo { static constexpr int KSTR = HDK + 8, KBYTES = 64 * KSTR * 2, VBYTES = HDV * VSTR * 2, BUF = KBYTES + VBYTES; };
template <int HDK, int HDV, bool KV_SAME> struct Stage { v4u k[HDK / 64]; v4u v[KV_SAME ? 1 : HDV / 64]; };

template <int HDK, int HDV, bool KV_SAME, class P>
__device__ __forceinline__ void load_tile(Stage<HDK, HDV, KV_SAME>& st, const P& pol, int j, int tid) {
#pragma unroll
    for (int i = 0; i < HDK / 64; ++i) { const int c = tid + 512 * i, r = c / (HDK / 8), ch = c % (HDK / 8); st.k[i] = *(const v4u*)(pol.krow(j, r) + 8 * ch); }
    if (!KV_SAME) {
#pragma unroll
        for (int i = 0; i < HDV / 64; ++i) { const int c = tid + 512 * i, r = c / (HDV / 8), ch = c % (HDV / 8); st.v[i] = *(const v4u*)(pol.vrow(j, r) + 8 * ch); }
    }
}
template <int HDK, int HDV, bool KV_SAME>
__device__ __forceinline__ void store_tile(const Stage<HDK, HDV, KV_SAME>& st, LAS unsigned char* buf, int tid) {
    typedef Geo<HDK, HDV> G;
    LAS bf16* Ks = (LAS bf16*)buf; LAS bf16* Vt = (LAS bf16*)(buf + G::KBYTES);
#pragma unroll
    for (int i = 0; i < HDK / 64; ++i) { const int c = tid + 512 * i, r = c / (HDK / 8), ch = c % (HDK / 8); *(LAS v4u*)(Ks + r * G::KSTR + 8 * ch) = st.k[i]; }
#pragma unroll
    for (int i = 0; i < HDV / 64; ++i) { const int c = tid + 512 * i, r = c / (HDV / 8), ch = c % (HDV / 8); const v4u w = KV_SAME ? st.k[i] : st.v[i];
        LAS bf16* vp = Vt + (8 * ch) * VSTR + r;
        vp[0 * VSTR] = (bf16)(w.x & 0xffffu); vp[1 * VSTR] = (bf16)(w.x >> 16); vp[2 * VSTR] = (bf16)(w.y & 0xffffu); vp[3 * VSTR] = (bf16)(w.y >> 16);
        vp[4 * VSTR] = (bf16)(w.z & 0xffffu); vp[5 * VSTR] = (bf16)(w.z >> 16); vp[6 * VSTR] = (bf16)(w.w & 0xffffu); vp[7 * VSTR] = (bf16)(w.w >> 16); }
}
template <int HDK, int HDV, class P>
__device__ __forceinline__ void compute_tile(const LAS unsigned char* buf, const P& pol, int j, int lane, const bf16x8 (&qf)[HDK / 16], f32x16 (&o)[HDV / 32], float& m, float& l) {
    typedef Geo<HDK, HDV> G;
    const LAS bf16* Ks = (const LAS bf16*)buf; const LAS bf16* Vt = (const LAS bf16*)(buf + G::KBYTES);
    const int r = lane & 31, h = lane >> 5;
    f32x16 s[2];
#pragma unroll
    for (int kb = 0; kb < 2; ++kb) {
#pragma unroll
        for (int e = 0; e < 16; ++e) s[kb][e] = 0.f;
#pragma unroll
        for (int ks = 0; ks < HDK / 16; ++ks) { const bf16x8 a = *(const LAS bf16x8*)(Ks + (32 * kb + r) * G::KSTR + 16 * ks + 8 * h);
            s[kb] = __builtin_amdgcn_mfma_f32_32x32x16_bf16(a, qf[ks], s[kb], 0, 0, 0); }
        if (HDK > 64) __builtin_amdgcn_sched_barrier(0);
    }
    bf16x8 vf[HDV == 64 ? 8 : 1];
    if (HDV == 64) {
#pragma unroll
        for (int kb = 0; kb < 2; ++kb)
#pragma unroll
            for (int s2 = 0; s2 < 2; ++s2)
#pragma unroll
                for (int blk = 0; blk < 2; ++blk) { const LAS bf16* vp = Vt + (32 * blk + r) * VSTR + 32 * kb + 16 * s2 + 4 * h;
                    const bf16x4 lo = *(const LAS bf16x4*)vp, hi = *(const LAS bf16x4*)(vp + 8);
                    vf[HDV == 64 ? (kb * 4 + s2 * 2 + blk) : 0] = __builtin_shufflevector(lo, hi, 0, 1, 2, 3, 4, 5, 6, 7); }
    }
    float mref, mn, rs = 0.f;
    if (pol.fast(j)) {
        const float b2 = pol.lane_bias2(j), c2 = pol.c2;
        float mx = -INFINITY;
#pragma unroll
        for (int kb = 0; kb < 2; ++kb)
#pragma unroll
            for (int e = 0; e < 16; ++e) mx = fmaxf(mx, s[kb][e]);
        mx = fa::xhalf_max(mx);
        mn = fmaxf(m, mx * c2 + b2); mref = (mn == -INFINITY) ? 0.f : mn;
        const float off = b2 - mref;
#pragma unroll
        for (int kb = 0; kb < 2; ++kb)
#pragma unroll
            for (int e = 0; e < 16; ++e) { s[kb][e] = __builtin_amdgcn_exp2f(__builtin_fmaf(s[kb][e], c2, off)); rs += s[kb][e]; }
    } else {
        pol.transform(j, s, lane);
        float mx = -INFINITY;
#pragma unroll
        for (int kb = 0; kb < 2; ++kb)
#pragma unroll
            for (int e = 0; e < 16; ++e) mx = fmaxf(mx, s[kb][e]);
        mx = fa::xhalf_max(mx);
        mn = fmaxf(m, mx); mref = (mn == -INFINITY) ? 0.f : mn;
#pragma unroll
        for (int kb = 0; kb < 2; ++kb)
#pragma unroll
            for (int e = 0; e < 16; ++e) { s[kb][e] = __builtin_amdgcn_exp2f(s[kb][e] - mref); rs += s[kb][e]; }
    }
    rs = fa::xhalf_sum(rs);
    const float corr = __builtin_amdgcn_exp2f(m - mref);
    m = mn;
    if (__any(corr != 1.f)) {
        l = l * corr + rs;
#pragma unroll
        for (int blk = 0; blk < HDV / 32; ++blk)
#pragma unroll
            for (int e = 0; e < 16; ++e) o[blk][e] *= corr;
    } else l += rs;
#pragma unroll
    for (int kb = 0; kb < 2; ++kb)
#pragma unroll
        for (int s2 = 0; s2 < 2; ++s2) {
            v4u pw; pw.x = pg8::cvt_pk_bf16(s[kb][8 * s2 + 0], s[kb][8 * s2 + 1]); pw.y = pg8::cvt_pk_bf16(s[kb][8 * s2 + 2], s[kb][8 * s2 + 3]);
            pw.z = pg8::cvt_pk_bf16(s[kb][8 * s2 + 4], s[kb][8 * s2 + 5]); pw.w = pg8::cvt_pk_bf16(s[kb][8 * s2 + 6], s[kb][8 * s2 + 7]);
            const bf16x8 pf = __builtin_bit_cast(bf16x8, pw);
#pragma unroll
            for (int blk = 0; blk < HDV / 32; ++blk) {
                bf16x8 a;
                if (HDV == 64) a = vf[HDV == 64 ? (kb * 4 + s2 * 2 + blk) : 0];
                else { const LAS bf16* vp = Vt + (32 * blk + r) * VSTR + 32 * kb + 16 * s2 + 4 * h;
                    const bf16x4 lo = *(const LAS bf16x4*)vp, hi = *(const LAS bf16x4*)(vp + 8);
                    a = __builtin_shufflevector(lo, hi, 0, 1, 2, 3, 4, 5, 6, 7); }
                o[blk] = __builtin_amdgcn_mfma_f32_32x32x16_bf16(a, pf, o[blk], 0, 0, 0); }
            if (HDV > 64) __builtin_amdgcn_sched_barrier(0);
        }
}
template <int HDK, int HDV, bool KV_SAME, class P>
__device__ __forceinline__ void run(LAS unsigned char* lds, P& pol, unsigned tmask, int tid, int lane, const bf16x8 (&qf)[HDK / 16], f32x16 (&o)[HDV / 32], float& m, float& l) {
    typedef Geo<HDK, HDV> G;
    if (tmask == 0u) return;
    Stage<HDK, HDV, KV_SAME> sa, sb;
    int j0 = __builtin_ctz(tmask); tmask &= tmask - 1u;
    pol.prefetch(j0); pol.advance();
    load_tile<HDK, HDV, KV_SAME>(sa, pol, j0, tid);
    int j1 = -1; if (tmask) { j1 = __builtin_ctz(tmask); tmask &= tmask - 1u; load_tile<HDK, HDV, KV_SAME>(sb, pol, j1, tid); pol.prefetch(j1); }
    store_tile<HDK, HDV, KV_SAME>(sa, lds, tid);
    __syncthreads();
    int cur = 0;
    for (;;) {
        PROBE_START(4, tid);
        int j2 = -1; if (tmask) { j2 = __builtin_ctz(tmask); tmask &= tmask - 1u; load_tile<HDK, HDV, KV_SAME>(sa, pol, j2, tid); }
        PROBE_STOP(4, tid); PROBE_START(2, tid);
        compute_tile<HDK, HDV>(lds + cur * G::BUF, pol, j0, lane, qf, o, m, l);
        PROBE_STOP(2, tid);
        if (j1 < 0) break;
        PROBE_START(3, tid);
        store_tile<HDK, HDV, KV_SAME>(sb, lds + (cur ^ 1) * G::BUF, tid);
        pol.advance(); if (j2 >= 0) pol.prefetch(j2);
        PROBE_STOP(3, tid); PROBE_START(5, tid);
        __syncthreads(); cur ^= 1;
        PROBE_STOP(5, tid); PROBE_START(4, tid);
        int j3 = -1; if (tmask) { j3 = __builtin_ctz(tmask); tmask &= tmask - 1u; load_tile<HDK, HDV, KV_SAME>(sb, pol, j3, tid); }
        PROBE_STOP(4, tid); PROBE_START(2, tid);
        compute_tile<HDK, HDV>(lds + cur * G::BUF, pol, j1, lane, qf, o, m, l);
        PROBE_STOP(2, tid);
        if (j2 < 0) break;
        PROBE_START(3, tid);
        store_tile<HDK, HDV, KV_SAME>(sa, lds + (cur ^ 1) * G::BUF, tid);
        pol.advance(); if (j3 >= 0) pol.prefetch(j3);
        PROBE_STOP(3, tid); PROBE_START(5, tid);
        __syncthreads(); cur ^= 1;
        PROBE_STOP(5, tid);
        j0 = j2; j1 = j3;
    }
    __syncthreads();
}
template <int HDK, int HDV, bool KV_SAME, class P>
__device__ __forceinline__ void run1(LAS unsigned char* lds, P& pol, unsigned tmask, int tid, int lane, const bf16x8 (&qf)[HDK / 16], f32x16 (&o)[HDV / 32], float& m, float& l) {
    typedef Geo<HDK, HDV> G;
    if (tmask == 0u) return;
    Stage<HDK, HDV, KV_SAME> st;
    int j = __builtin_ctz(tmask); tmask &= tmask - 1u; int cur = 0;
    pol.prefetch(j); pol.advance();
    load_tile<HDK, HDV, KV_SAME>(st, pol, j, tid); store_tile<HDK, HDV, KV_SAME>(st, lds, tid);
    __syncthreads();
    for (;;) {
        const bool more = tmask != 0u; int jn = 0;
        if (more) { jn = __builtin_ctz(tmask); tmask &= tmask - 1u; load_tile<HDK, HDV, KV_SAME>(st, pol, jn, tid); pol.prefetch(jn); }
        compute_tile<HDK, HDV>(lds + cur * G::BUF, pol, j, lane, qf, o, m, l);
        if (!more) break;
        store_tile<HDK, HDV, KV_SAME>(st, lds + (cur ^ 1) * G::BUF, tid);
        pol.advance();
        __syncthreads();
        cur ^= 1; j = jn;
    }
    __syncthreads();
}
}

__device__ __forceinline__ void build_bias_table(const Frame& F, LAS float* tab, int nheads, int relc0) {
    const float* rel = F.in[I_REL];
    for (int i = F.tid; i < nheads * 129; i += 512) { const int hh = i / 129, d = i % 129; tab[hh * 132 + d] = rel[rel_bucket(d) * 16 + relc0 + hh] * 1.4426950408889634f; }
    __syncthreads();
}
struct BandPol {
    __device__ __forceinline__ void prefetch(int) {} __device__ __forceinline__ void advance() {}
    const bf16* kbase; const bf16* vbase; int ld; int tq, tq0, W; const LAS float* bl;
    static constexpr float c2 = 0.125f * 1.4426950408889634f;
    __device__ __forceinline__ const bf16* krow(int j, int r) const { return kbase + (size_t)(64 * j + r) * ld; }
    __device__ __forceinline__ const bf16* vrow(int j, int r) const { return vbase + (size_t)(64 * j + r) * ld; }
    __device__ __forceinline__ bool fast(int j) const { const int k0 = 64 * j; return tq0 - (k0 + 63) >= 128 && (tq0 + 31) - k0 < W; }
    __device__ __forceinline__ float lane_bias2(int) const { return bl[128]; }
    __device__ __forceinline__ void transform(int j, fa::f32x16 (&s)[2], int lane) const {
        const int k0 = 64 * j, h = lane >> 5;
        if (tq0 - (k0 + 63) >= 128) {
            const float b31 = bl[128]; const int dbase = tq - k0 - 4 * h;
#pragma unroll
            for (int kb = 0; kb < 2; ++kb)
#pragma unroll
                for (int e = 0; e < 16; ++e) { const int dist = dbase - (32 * kb + 8 * (e >> 2) + (e & 3)); s[kb][e] = (dist < W) ? __builtin_fmaf(s[kb][e], c2, b31) : -INFINITY; }
        } else {
#pragma unroll
            for (int kb = 0; kb < 2; ++kb)
#pragma unroll
                for (int e = 0; e < 16; ++e) { const int key = k0 + 32 * kb + 8 * (e >> 2) + 4 * h + (e & 3); const int dist = tq - key;
                    const int di = dist < 0 ? 0 : (dist > 128 ? 128 : dist);
                    const float v = __builtin_fmaf(s[kb][e], c2, bl[di]);
                    s[kb][e] = (dist >= 0 && dist < W) ? v : -INFINITY; }
        }
    }
};
__device__ __forceinline__ void win_phase_mfma(const Frame& F) {
    bf16* P1 = (bf16*)(F.ws + WS_P1); const bf16* OC = (const bf16*)(F.ws + WS_OCMP); const bf16* OS = (const bf16*)(F.ws + WS_OSLC);
    LAS float* tab = (LAS float*)(F.lds + 36864);
    build_bias_table(F, tab, 16, 0);
    const int h = F.lane >> 5;
    for (int u = blockIdx.x; u < NB * 2 * 64; u += F.G) {
        const int rr_ = u / F.G, c_ = u % F.G; const int qt = (rr_ & 1) ? 63 - (c_ & 63) : (c_ & 63), bg = (rr_ * (F.G >> 6) + (c_ >> 6)) % (NB * 2), b = bg >> 1, g = bg & 1;
        const int tq0 = 32 * qt, head = g * 8 + F.wave, tq = tq0 + (F.lane & 31);
        const size_t row = (size_t)b * S + tq;
        fa::bf16x8 qf[4];
#pragma unroll
        for (int ks = 0; ks < 4; ++ks) qf[ks] = *(const fa::bf16x8*)(P1 + row * P1_LD + C1_Q + head * 64 + 16 * ks + 8 * h);
        fa::f32x16 o[2];
#pragma unroll
        for (int blk = 0; blk < 2; ++blk)
#pragma unroll
            for (int e = 0; e < 16; ++e) o[blk][e] = 0.f;
        float m = -INFINITY, l = 0.f;
        const int jlo = (tq0 - 511 > 0 ? tq0 - 511 : 0) >> 6, jhi = (tq0 + 31) >> 6;
        const unsigned tmask = (jhi >= 31 ? 0xffffffffu : ((1u << (jhi + 1)) - 1u)) & ~((1u << jlo) - 1u);
        BandPol pol{P1 + (size_t)b * S * P1_LD + C1_KW + g * 64, P1 + (size_t)b * S * P1_LD + C1_VW + g * 64, P1_LD, tq, tq0, 512, tab + head * 132};
        fa::run<64, 64, false>(F.lds, pol, tmask, F.tid, F.lane, qf, o, m, l);
        const float inv = 1.f / l;
        const bf16* gr = P1 + row * P1_LD + C1_GL + head * 3;
        const float g0 = 1.f / (1.f + __expf(-bf2f(gr[0]))), g1 = 1.f / (1.f + __expf(-bf2f(gr[1]))), g2 = 1.f / (1.f + __expf(-bf2f(gr[2])));
#pragma unroll
        for (int blk = 0; blk < 2; ++blk)
#pragma unroll
            for (int jj = 0; jj < 4; ++jj) { const int d0 = 32 * blk + 8 * jj + 4 * h;
                const v2u cw = *(const v2u*)(OC + row * D + head * 64 + d0), sw = *(const v2u*)(OS + row * D + head * 64 + d0);
                const float r0 = g0 * bflo(cw.x) + g1 * bflo(sw.x) + g2 * o[blk][4 * jj + 0] * inv, r1 = g0 * bfhi(cw.x) + g1 * bfhi(sw.x) + g2 * o[blk][4 * jj + 1] * inv;
                const float r2 = g0 * bflo(cw.y) + g1 * bflo(sw.y) + g2 * o[blk][4 * jj + 2] * inv, r3 = g0 * bfhi(cw.y) + g1 * bfhi(sw.y) + g2 * o[blk][4 * jj + 3] * inv;
                v2u ow; ow.x = pk2(r0, r1); ow.y = pk2(r2, r3);
                *(v2u*)(P1 + row * P1_LD + C1_Q + head * 64 + d0) = ow; }
    }
}
__device__ __forceinline__ void swa_phase_mfma(const Frame& F) {
    bf16* P0 = (bf16*)(F.ws + WS_P0); const float* sinks = F.in[I_EV_SINK];
    LAS float* tab = (LAS float*)(F.lds + 36864);
    build_bias_table(F, tab, 8, 8);
    const int h = F.lane >> 5;
    for (int u = blockIdx.x; u < NB * 2 * 32; u += F.G) {
        const int b = u >> 6, kvh = (u >> 5) & 1, t0 = 64 * (u & 31), head = kvh * 4 + (F.wave & 3), tq0 = t0 + 32 * (F.wave >> 2), tq = tq0 + (F.lane & 31);
        const size_t row = (size_t)b * S + tq;
        fa::bf16x8 qf[4];
#pragma unroll
        for (int ks = 0; ks < 4; ++ks) qf[ks] = *(const fa::bf16x8*)(P0 + row * P0_LD + C0_QB + head * 64 + 16 * ks + 8 * h);
        fa::f32x16 o[2];
#pragma unroll
        for (int blk = 0; blk < 2; ++blk)
#pragma unroll
            for (int e = 0; e < 16; ++e) o[blk][e] = 0.f;
        float m = sinks[head] * 1.4426950408889634f, l = 1.f;
        const int jlo = (t0 - 127 > 0 ? t0 - 127 : 0) >> 6, jhi = t0 >> 6;
        const unsigned tmask = (jhi >= 31 ? 0xffffffffu : ((1u << (jhi + 1)) - 1u)) & ~((1u << jlo) - 1u);
        BandPol pol{P0 + (size_t)b * S * P0_LD + C0_KB + kvh * 64, P0 + (size_t)b * S * P0_LD + C0_VB + kvh * 64, P0_LD, tq, tq0, 128, tab + head * 132};
        fa::run<64, 64, false>(F.lds, pol, tmask, F.tid, F.lane, qf, o, m, l);
        const float inv = 1.f / l;
#pragma unroll
        for (int blk = 0; blk < 2; ++blk)
#pragma unroll
            for (int jj = 0; jj < 4; ++jj) { const int d0 = 32 * blk + 8 * jj + 4 * h;
                v2u ow; ow.x = pk2(o[blk][4 * jj + 0] * inv, o[blk][4 * jj + 1] * inv); ow.y = pk2(o[blk][4 * jj + 2] * inv, o[blk][4 * jj + 3] * inv);
                *(v2u*)(P0 + row * P0_LD + C0_QB + head * 64 + d0) = ow; }
    }
}

struct XaPol {
    __device__ __forceinline__ void prefetch(int) {} __device__ __forceinline__ void advance() {}
    const bf16* kbase;
    static constexpr float c2 = 0.08838834764831845f * 1.4426950408889634f;
    __device__ __forceinline__ const bf16* krow(int j, int r) const { return kbase + (size_t)(64 * j + r) * 1024; }
    __device__ __forceinline__ const bf16* vrow(int j, int r) const { return kbase + (size_t)(64 * j + r) * 1024 + 512; }
    __device__ __forceinline__ bool fast(int) const { return true; }
    __device__ __forceinline__ float lane_bias2(int) const { return 0.f; }
    __device__ __forceinline__ void transform(int, fa::f32x16 (&)[2], int) const {}
};
__device__ __forceinline__ void xattn_phase_mfma(const Frame& F, const bf16* Q, const bf16* KV, bf16* O) {
    const int h = F.lane >> 5;
    for (int u2 = 2 * blockIdx.x; u2 < NB * 4 * 8; u2 += 2 * F.G)
    for (int hp = 0; hp < 2; ++hp) {
        int pm, pn; pg8::tile_of(u2 >> 1, M / 256, 2, pm, pn);
        const int b = pm >> 3, qt = pm & 7, head = 2 * pn + hp, tq = 256 * qt + 32 * F.wave + (F.lane & 31);
        const size_t row = (size_t)b * S + tq;
        fa::bf16x8 qf[8];
#pragma unroll
        for (int ks = 0; ks < 8; ++ks) qf[ks] = *(const fa::bf16x8*)(Q + row * 512 + head * 128 + 16 * ks + 8 * h);
        fa::f32x16 o[4];
#pragma unroll
        for (int blk = 0; blk < 4; ++blk)
#pragma unroll
            for (int e = 0; e < 16; ++e) o[blk][e] = 0.f;
        float m = -INFINITY, l = 0.f;
        XaPol pol{KV + (size_t)b * MEML * 1024 + head * 128};
        fa::run<128, 128, false>(F.lds, pol, 0xFu, F.tid, F.lane, qf, o, m, l);
        const float inv = 1.f / l;
#pragma unroll
        for (int blk = 0; blk < 4; ++blk)
#pragma unroll
            for (int jj = 0; jj < 4; ++jj) { const int d0 = 32 * blk + 8 * jj + 4 * h;
                v2u ow; ow.x = pk2(o[blk][4 * jj + 0] * inv, o[blk][4 * jj + 1] * inv); ow.y = pk2(o[blk][4 * jj + 2] * inv, o[blk][4 * jj + 3] * inv);
                *(v2u*)(O + row * 512 + head * 128 + d0) = ow; }
    }
}
struct DsaPol {
    const bf16* cbase; const unsigned* mrow; int tq, tq0; const LAS float* bl; v2u mwc, mwn;
    static constexpr float c2 = 0.125f * 1.4426950408889634f;
    __device__ __forceinline__ const bf16* krow(int j, int r) const { return cbase + (size_t)(64 * j + r) * 128; }
    __device__ __forceinline__ const bf16* vrow(int j, int r) const { return krow(j, r); }
    __device__ __forceinline__ bool fast(int) const { return false; }
    __device__ __forceinline__ float lane_bias2(int) const { return 0.f; }
    __device__ __forceinline__ void prefetch(int j) { mwn = *(const v2u*)(mrow + 2 * j); }
    __device__ __forceinline__ void advance() { mwc = mwn; }
    __device__ __forceinline__ void transform(int j, fa::f32x16 (&s)[2], int lane) const {
        const int k0 = 64 * j, h = lane >> 5;
#pragma unroll
        for (int kb = 0; kb < 2; ++kb) { const unsigned w = (kb ? mwc.y : mwc.x) >> (4 * h);
#pragma unroll
            for (int e = 0; e < 16; ++e) { const int bit = 8 * (e >> 2) + (e & 3); const int kin = bit + 4 * h; const int dist = tq - (k0 + 32 * kb + kin);
                const int di = dist < 0 ? 0 : (dist > 128 ? 128 : dist); const int mm = ((int)(w << (31 - bit))) >> 31;
                const unsigned vb = __builtin_bit_cast(unsigned, __builtin_fmaf(s[kb][e], c2, bl[di]));
                s[kb][e] = __builtin_bit_cast(float, (vb & (unsigned)mm) | (0xff800000u & ~(unsigned)mm)); } }
    }
};
__device__ __forceinline__ void dsa_phase_mfma(const Frame& F) {
    bf16* P0 = (bf16*)(F.ws + WS_P0); const bf16* CN = (const bf16*)(F.ws + WS_CN); const unsigned* MASK = (const unsigned*)(F.ws + WS_MASK);
    LAS float* tab = (LAS float*)(F.lds + 73728);
    build_bias_table(F, tab, 8, 0);
    const int h = F.lane >> 5;
    for (int u = blockIdx.x; u < NB * 64; u += F.G) {
        const int rr = u / F.G, c = u % F.G; const int qt = (rr & 1) ? 63 - (c & 63) : (c & 63), b = (rr * (F.G >> 6) + (c >> 6)) % NB;
        const int tq0 = 32 * qt, tq = tq0 + (F.lane & 31), head = F.wave;
        const size_t row = (size_t)b * S + tq;
        fa::bf16x8 qf[8];
#pragma unroll
        for (int ks = 0; ks < 8; ++ks) qf[ks] = *(const fa::bf16x8*)(P0 + row * P0_LD + C0_QLAT + head * 128 + 16 * ks + 8 * h);
        fa::f32x16 o[4];
#pragma unroll
        for (int blk = 0; blk < 4; ++blk)
#pragma unroll
            for (int e = 0; e < 16; ++e) o[blk][e] = 0.f;
        float m = -INFINITY, l = 0.f;
        const int jhi = (tq0 + 31) >> 6; const unsigned tmask = jhi >= 31 ? 0xffffffffu : ((1u << (jhi + 1)) - 1u);
        DsaPol pol{CN + (size_t)b * S * 128, MASK + row * 64, tq, tq0, tab + head * 132, (v2u){0u, 0u}, (v2u){0u, 0u}};
        fa::run1<128, 128, true>(F.lds, pol, tmask, F.tid, F.lane, qf, o, m, l);
        const float inv = 1.f / l;
#pragma unroll
        for (int blk = 0; blk < 4; ++blk)
#pragma unroll
            for (int jj = 0; jj < 4; ++jj) { const int d0 = 32 * blk + 8 * jj + 4 * h;
                v2u ow; ow.x = pk2(o[blk][4 * jj + 0] * inv, o[blk][4 * jj + 1] * inv); ow.y = pk2(o[blk][4 * jj + 2] * inv, o[blk][4 * jj + 3] * inv);
                *(v2u*)(P0 + row * P0_LD + C0_QLAT + head * 128 + d0) = ow; }
    }
}
struct SlcPol {
    __device__ __forceinline__ void prefetch(int) {} __device__ __forceinline__ void advance() {}
    const bf16* kbase; const bf16* vbase; unsigned sel; int tq, tq0; const LAS float* bl;
    static constexpr float c2 = 0.125f * 1.4426950408889634f;
    __device__ __forceinline__ const bf16* krow(int j, int r) const { return kbase + (size_t)(64 * j + r) * P1_LD; }
    __device__ __forceinline__ const bf16* vrow(int j, int r) const { return vbase + (size_t)(64 * j + r) * P1_LD; }
    __device__ __forceinline__ bool fast(int j) const { return tq0 - (64 * j + 63) >= 128; }
    __device__ __forceinline__ float lane_bias2(int j) const { return ((sel >> j) & 1u) ? bl[128] : -INFINITY; }
    __device__ __forceinline__ void transform(int j, fa::f32x16 (&s)[2], int lane) const {
        const int k0 = 64 * j, h = lane >> 5; const bool on = (sel >> j) & 1u;
#pragma unroll
        for (int kb = 0; kb < 2; ++kb)
#pragma unroll
            for (int e = 0; e < 16; ++e) { const int dist = tq - (k0 + 32 * kb + 8 * (e >> 2) + 4 * h + (e & 3));
                const int di = dist < 0 ? 0 : (dist > 128 ? 128 : dist);
                const float v = __builtin_fmaf(s[kb][e], c2, bl[di]);
                s[kb][e] = (on && dist >= 0) ? v : -INFINITY; }
    }
};
__device__ __forceinline__ void slc_phase_mfma(const Frame& F) {
    const bf16* P1 = (const bf16*)(F.ws + WS_P1); const unsigned* SELM = (const unsigned*)(F.ws + WS_SELM); bf16* OS = (bf16*)(F.ws + WS_OSLC);
    LAS float* tab = (LAS float*)(F.lds + 36864);
    build_bias_table(F, tab, 16, 0);
    const int h = F.lane >> 5;
    for (int u = blockIdx.x; u < NB * 2 * 64; u += F.G) {
        const int rr = u / F.G, c = u % F.G; const int qt = (rr & 1) ? 63 - (c & 63) : (c & 63), bg = (rr * (F.G >> 6) + (c >> 6)) % (NB * 2), b = bg >> 1, g = bg & 1;
        const int tq0 = 32 * qt, tq = tq0 + (F.lane & 31), head = g * 8 + F.wave;
        const size_t row = (size_t)b * S + tq;
        fa::bf16x8 qf[4];
#pragma unroll
        for (int ks = 0; ks < 4; ++ks) qf[ks] = *(const fa::bf16x8*)(P1 + row * P1_LD + C1_Q + head * 64 + 16 * ks + 8 * h);
        fa::f32x16 o[2];
#pragma unroll
        for (int blk = 0; blk < 2; ++blk)
#pragma unroll
            for (int e = 0; e < 16; ++e) o[blk][e] = 0.f;
        float m = -INFINITY, l = 0.f;
        const unsigned sel = SELM[row * 2 + g]; unsigned tm = sel;
#pragma unroll
        for (int of = 1; of < 32; of <<= 1) tm |= (unsigned)__shfl_xor((int)tm, of);
        tm = (unsigned)__builtin_amdgcn_readfirstlane((int)tm);
        SlcPol pol{P1 + (size_t)b * S * P1_LD + C1_KS + g * 64, P1 + (size_t)b * S * P1_LD + C1_VS + g * 64, sel, tq, tq0, tab + head * 132};
        fa::run<64, 64, false>(F.lds, pol, tm, F.tid, F.lane, qf, o, m, l);
        const float inv = 1.f / l;
#pragma unroll
        for (int blk = 0; blk < 2; ++blk)
#pragma unroll
            for (int jj = 0; jj < 4; ++jj) { const int d0 = 32 * blk + 8 * jj + 4 * h;
                v2u ow; ow.x = pk2(o[blk][4 * jj + 0] * inv, o[blk][4 * jj + 1] * inv); ow.y = pk2(o[blk][4 * jj + 2] * inv, o[blk][4 * jj + 3] * inv);
                *(v2u*)(OS + row * D + head * 64 + d0) = ow; }
    }
}

__device__ __forceinline__ int wave_sum_dpp(int v) {
    v += __builtin_amdgcn_update_dpp(0, v, 0xB1, 0xf, 0xf, false);
    v += __builtin_amdgcn_update_dpp(0, v, 0x4E, 0xf, 0xf, false);
    v += __builtin_amdgcn_update_dpp(0, v, 0x141, 0xf, 0xf, false);
    v += __builtin_amdgcn_update_dpp(0, v, 0x140, 0xf, 0xf, false);
    v += __builtin_amdgcn_update_dpp(0, v, 0x142, 0xa, 0xf, false);
    v += __builtin_amdgcn_update_dpp(0, v, 0x143, 0xc, 0xf, false);
    return __builtin_amdgcn_readlane(v, 63);
}
template <bool GT>
__device__ __forceinline__ int count4(unsigned u0, unsigned u1, unsigned u2, unsigned u3, unsigned cand) {
    unsigned long long m0, m1, m2, m3; int t0, t1, t2, t3;
    if (GT)
        asm volatile("v_cmp_gt_u32_e64 %0, %8, %12\n\tv_cmp_gt_u32_e64 %1, %9, %12\n\tv_cmp_gt_u32_e64 %2, %10, %12\n\tv_cmp_gt_u32_e64 %3, %11, %12\n\t"
                     "s_bcnt1_i32_b64 %4, %0\n\ts_bcnt1_i32_b64 %5, %1\n\ts_bcnt1_i32_b64 %6, %2\n\ts_bcnt1_i32_b64 %7, %3"
                     : "=&s"(m0), "=&s"(m1), "=&s"(m2), "=&s"(m3), "=&s"(t0), "=&s"(t1), "=&s"(t2), "=&s"(t3) : "v"(u0), "v"(u1), "v"(u2), "v"(u3), "s"(cand) : "scc");
    else
        asm volatile("v_cmp_ge_u32_e64 %0, %8, %12\n\tv_cmp_ge_u32_e64 %1, %9, %12\n\tv_cmp_ge_u32_e64 %2, %10, %12\n\tv_cmp_ge_u32_e64 %3, %11, %12\n\t"
                     "s_bcnt1_i32_b64 %4, %0\n\ts_bcnt1_i32_b64 %5, %1\n\ts_bcnt1_i32_b64 %6, %2\n\ts_bcnt1_i32_b64 %7, %3"
                     : "=&s"(m0), "=&s"(m1), "=&s"(m2), "=&s"(m3), "=&s"(t0), "=&s"(t1), "=&s"(t2), "=&s"(t3) : "v"(u0), "v"(u1), "v"(u2), "v"(u3), "s"(cand) : "scc");
    return (t0 + t1) + (t2 + t3);
}
__device__ __forceinline__ void idx_phase_mfma(const Frame& F) {
    const bf16* P0 = (const bf16*)(F.ws + WS_P0); unsigned* MASK = (unsigned*)(F.ws + WS_MASK);
    LAS float* sc = (LAS float*)F.lds;
    const int r = F.lane & 31, hh = F.lane >> 5;
    const int head_r = (r & 3) + 4 * ((r >> 3) & 1), ql_r = 2 * (r >> 4) + ((r >> 2) & 1);
    fa::bf16x8 qaN[2][4]; v4u wvN[2][2];
#define IDX_DECODE(item_, b_, t0_) { const int it_i = (item_) / F.G, it_c = (item_) % F.G; b_ = (F.G == S / 8) ? it_i : (item_) / (S / 8); t0_ = ((F.G == S / 8) ? ((it_c + 16 * it_i) & (S / 8 - 1)) : ((item_) % (S / 8))) * 8; }
#define IDX_LOAD(item_) { int b_, t0_; IDX_DECODE(item_, b_, t0_); \
        _Pragma("unroll") for (int rb = 0; rb < 2; ++rb) { const bf16* qp = P0 + (size_t)(b_ * S + t0_ + 4 * rb + ql_r) * P0_LD + C0_QI + head_r * 64 + 8 * hh; \
            _Pragma("unroll") for (int ks = 0; ks < 4; ++ks) qaN[rb][ks] = *(const fa::bf16x8*)(qp + 16 * ks); \
            _Pragma("unroll") for (int qq = 0; qq < 2; ++qq) wvN[rb][qq] = *(const v4u*)(P0 + (size_t)(b_ * S + t0_ + 4 * rb + 2 * qq + hh) * P0_LD + C0_WI); } }
    if ((int)blockIdx.x < NB * (S / 8)) IDX_LOAD(blockIdx.x);
    for (int item = blockIdx.x; item < NB * (S / 8); item += F.G) {
        int b, t0; IDX_DECODE(item, b, t0);
        fa::bf16x8 qa[2][4]; float wv[2][2][8];
#pragma unroll
        for (int rb = 0; rb < 2; ++rb) {
#pragma unroll
            for (int ks = 0; ks < 4; ++ks) qa[rb][ks] = qaN[rb][ks];
#pragma unroll
            for (int qq = 0; qq < 2; ++qq) { const v4u w = wvN[rb][qq]; const float sc8 = 0.35355339059f * 0.125f;
                wv[rb][qq][0] = bflo(w.x) * sc8; wv[rb][qq][1] = bfhi(w.x) * sc8; wv[rb][qq][2] = bflo(w.y) * sc8; wv[rb][qq][3] = bfhi(w.y) * sc8;
                wv[rb][qq][4] = bflo(w.z) * sc8; wv[rb][qq][5] = bfhi(w.z) * sc8; wv[rb][qq][6] = bflo(w.w) * sc8; wv[rb][qq][7] = bfhi(w.w) * sc8; } }
        const int nkb = (t0 + 8 + 31) >> 5;
        PROBE_START(9, F.tid);
#pragma unroll 1
        for (int kb0 = F.wave; kb0 < nkb; kb0 += 32) {
            fa::bf16x8 kf[4][4];
#pragma unroll
            for (int i = 0; i < 4; ++i) { const int kb = (kb0 + 8 * i < 64) ? kb0 + 8 * i : 63; const bf16* kp = P0 + (size_t)(b * S + 32 * kb + r) * P0_LD + C0_KI + 8 * hh;
#pragma unroll
                for (int ks = 0; ks < 4; ++ks) kf[i][ks] = *(const fa::bf16x8*)(kp + 16 * ks); }
#pragma unroll
            for (int i = 0; i < 4; ++i) { const int kb = kb0 + 8 * i;
                if (kb < nkb) {
#pragma unroll
                    for (int rb = 0; rb < 2; ++rb) { fa::f32x16 c;
#pragma unroll
                        for (int e = 0; e < 16; ++e) c[e] = 0.f;
#pragma unroll
                        for (int ks = 0; ks < 4; ++ks) c = __builtin_amdgcn_mfma_f32_32x32x16_bf16(qa[rb][ks], kf[i][ks], c, 0, 0, 0);
                        float s0 = 0.f, s1 = 0.f;
#pragma unroll
                        for (int e = 0; e < 8; ++e) { s0 += wv[rb][0][e] * fmaxf(c[e], 0.f); s1 += wv[rb][1][e] * fmaxf(c[8 + e], 0.f); }
                        sc[(4 * rb + hh) * 2048 + 32 * kb + r] = s0; sc[(4 * rb + 2 + hh) * 2048 + 32 * kb + r] = s1; } } }
        }
        if (item + F.G < NB * (S / 8)) IDX_LOAD(item + F.G);
        PROBE_STOP(9, F.tid);
        __syncthreads();
        PROBE_START(10, F.tid);
        {
            const int q = F.wave, t = t0 + q, n = t + 1, row = b * S + t; unsigned myword = 0u;
            if (n <= 256) { const int cb = n - 32 * F.lane; myword = cb >= 32 ? 0xffffffffu : (cb <= 0 ? 0u : ((1u << cb) - 1u)); }
            else {
                unsigned uu[32];
#pragma unroll
                for (int i = 0; i < 32; ++i) { const int s = F.lane + 64 * i; uu[i] = (s < n) ? fkey(sc[q * 2048 + s]) : 0u; }
                unsigned prefix = 0u; bool exact = false;
#pragma unroll 1
                for (int bit = 31; bit >= 0; --bit) { const unsigned cand = prefix | (1u << bit); int c0 = 0, c1 = 0, c2 = 0, c3 = 0;
#pragma unroll
                    for (int i = 0; i < 32; i += 4) { c0 += (uu[i] >= cand) ? 1 : 0; c1 += (uu[i + 1] >= cand) ? 1 : 0; c2 += (uu[i + 2] >= cand) ? 1 : 0; c3 += (uu[i + 3] >= cand) ? 1 : 0; }
                    const int c = wave_sum_dpp((c0 + c1) + (c2 + c3));
                    if (c >= 256) { prefix = cand; if (c == 256) { exact = true; break; } } }
                int cgt = 0;
                if (!exact) { int g0 = 0, g1 = 0;
#pragma unroll
                    for (int i = 0; i < 32; i += 2) { g0 += (uu[i] > prefix) ? 1 : 0; g1 += (uu[i + 1] > prefix) ? 1 : 0; }
                    cgt = wave_sum_dpp(g0 + g1); }
                if (exact) {
#pragma unroll
                    for (int i = 0; i < 32; ++i) { const unsigned long long sm = __ballot(uu[i] >= prefix);
                        if (F.lane == 2 * i) myword = (unsigned)sm; if (F.lane == 2 * i + 1) myword = (unsigned)(sm >> 32); }
                } else {
                    const int need = 256 - cgt; int run = 0;
#pragma unroll
                    for (int i = 0; i < 32; ++i) { asm volatile("" : "+s"(run), "+v"(uu[i])); const unsigned u = uu[i]; const bool eq = (u == prefix); const unsigned long long em = __ballot(eq); const int rank = run + __popcll(em & ((1ull << F.lane) - 1ull));
                        const bool sel = (u > prefix) || (eq && rank < need); run += __popcll(em);
                        const unsigned long long sm = __ballot(sel);
                        if (F.lane == 2 * i) myword = (unsigned)sm; if (F.lane == 2 * i + 1) myword = (unsigned)(sm >> 32); }
                }
            }
            MASK[(size_t)row * 64 + F.lane] = myword;
        }
        PROBE_STOP(10, F.tid);
        __syncthreads();
    }
}
#undef IDX_DECODE
#undef IDX_LOAD
__device__ __forceinline__ void cmp_phase_mfma(const Frame& F) {
    typedef fa::Geo<64, 64> G;
    const bf16* P1 = (const bf16*)(F.ws + WS_P1); const bf16* KC = (const bf16*)(F.ws + WS_KC); const bf16* VC = (const bf16*)(F.ws + WS_VC);
    bf16* OC = (bf16*)(F.ws + WS_OCMP); unsigned* SELM = (unsigned*)(F.ws + WS_SELM);
    LAS float* tab = (LAS float*)(F.lds + 36864); LAS float* part = (LAS float*)(F.lds + 49152);
    build_bias_table(F, tab, 16, 0);
    const int r = F.lane & 31, h = F.lane >> 5;
    for (int u = blockIdx.x; u < NB * 2 * 64; u += F.G) {
        const int rr_ = u / F.G, c_ = u % F.G; const int qt = (rr_ & 1) ? 63 - (c_ & 63) : (c_ & 63), bg = (rr_ * (F.G >> 6) + (c_ >> 6)) % (NB * 2), b = bg >> 1, g = bg & 1;
        const int tq0 = 32 * qt, head = g * 8 + F.wave, tq = tq0 + r;
        const size_t row = (size_t)b * S + tq;
        const int nv = (tq >= 31) ? ((tq - 31) / 16 + 1) : 0;
        const int ntile = (tq0 >= 1024) ? 2 : 1;
        {
            struct CPol { const bf16* kb; const bf16* vb; __device__ __forceinline__ const bf16* krow(int j, int rr) const { return kb + (size_t)(64 * j + rr) * 64; } __device__ __forceinline__ const bf16* vrow(int j, int rr) const { return vb + (size_t)(64 * j + rr) * 64; } };
            CPol cp{KC + (size_t)(b * 2 + g) * 128 * 64, VC + (size_t)(b * 2 + g) * 128 * 64};
            for (int t = 0; t < ntile; ++t) { fa::Stage<64, 64, false> st; fa::load_tile<64, 64, false>(st, cp, t, F.tid); fa::store_tile<64, 64, false>(st, F.lds + t * G::BUF, F.tid); }
        }
        fa::bf16x8 qf[4];
#pragma unroll
        for (int ks = 0; ks < 4; ++ks) qf[ks] = *(const fa::bf16x8*)(P1 + row * P1_LD + C1_Q + head * 64 + 16 * ks + 8 * h);
        __syncthreads();
        fa::f32x16 s[2][2];
        const LAS float* bl = tab + head * 132;
#pragma unroll
        for (int t = 0; t < 2; ++t) {
            const LAS bf16* Ks = (const LAS bf16*)(F.lds + t * G::BUF);
#pragma unroll
            for (int kb = 0; kb < 2; ++kb) {
#pragma unroll
                for (int e = 0; e < 16; ++e) s[t][kb][e] = 0.f;
                if (t < ntile) {
#pragma unroll
                    for (int ks = 0; ks < 4; ++ks) { const fa::bf16x8 a = *(const LAS fa::bf16x8*)(Ks + (32 * kb + r) * G::KSTR + 16 * ks + 8 * h); s[t][kb] = __builtin_amdgcn_mfma_f32_32x32x16_bf16(a, qf[ks], s[t][kb], 0, 0, 0); }
                }
#pragma unroll
                for (int e = 0; e < 16; ++e) { const int n = 64 * t + 32 * kb + 8 * (e >> 2) + 4 * h + (e & 3); const int dist = tq - (16 * n + 31); const int di = dist < 0 ? 0 : (dist > 128 ? 128 : dist);
                    s[t][kb][e] = (n < nv) ? __builtin_fmaf(s[t][kb][e], 0.125f * 1.4426950408889634f, bl[di]) : -INFINITY; }
            }
        }
        float mx = -INFINITY;
#pragma unroll
        for (int t = 0; t < 2; ++t)
#pragma unroll
            for (int kb = 0; kb < 2; ++kb)
#pragma unroll
                for (int e = 0; e < 16; ++e) mx = fmaxf(mx, s[t][kb][e]);
        mx = fa::xhalf_max(mx);
        const float mref = (mx == -INFINITY) ? 0.f : mx; float rs = 0.f;
#pragma unroll
        for (int t = 0; t < 2; ++t)
#pragma unroll
            for (int kb = 0; kb < 2; ++kb)
#pragma unroll
                for (int e = 0; e < 16; ++e) { s[t][kb][e] = __builtin_amdgcn_exp2f(s[t][kb][e] - mref); rs += s[t][kb][e]; }
        rs = fa::xhalf_sum(rs);
        const float inv = (nv > 0) ? 1.f / rs : 0.f;
#pragma unroll
        for (int t = 0; t < 2; ++t)
#pragma unroll
            for (int kb = 0; kb < 2; ++kb)
#pragma unroll
                for (int e = 0; e < 16; ++e) s[t][kb][e] *= inv;
        {
            float sum4[16], p3[16];
#pragma unroll
            for (int t = 0; t < 2; ++t)
#pragma unroll
                for (int kb = 0; kb < 2; ++kb)
#pragma unroll
                    for (int jj = 0; jj < 4; ++jj) { const int G4 = 8 * t + 4 * kb + jj; sum4[G4] = (s[t][kb][4 * jj] + s[t][kb][4 * jj + 1]) + (s[t][kb][4 * jj + 2] + s[t][kb][4 * jj + 3]); p3[G4] = s[t][kb][4 * jj + 3]; }
            LAS float* pw = part + (F.wave * 32 + r) * 32;
            float prt[16];
#pragma unroll
            for (int G4 = 0; G4 < 16; ++G4) { const auto rr = __builtin_amdgcn_permlane32_swap(__builtin_bit_cast(unsigned, p3[G4]), __builtin_bit_cast(unsigned, p3[G4]), false, false);
                prt[G4] = __builtin_bit_cast(float, h ? (unsigned)rr[0] : (unsigned)rr[1]); }
#pragma unroll
            for (int G4 = 0; G4 < 16; ++G4) { const float prm1 = (G4 > 0) ? prt[G4 > 0 ? G4 - 1 : 0] : 0.f;
                const float v = sum4[G4] + (h ? prt[G4] : prm1);
                pw[2 * G4 + h] = v; }
        }
        fa::f32x16 o[2];
#pragma unroll
        for (int blk = 0; blk < 2; ++blk)
#pragma unroll
            for (int e = 0; e < 16; ++e) o[blk][e] = 0.f;
#pragma unroll
        for (int t = 0; t < 2; ++t) {
            if (t < ntile) {
                const LAS bf16* Vt = (const LAS bf16*)(F.lds + t * G::BUF + G::KBYTES);
#pragma unroll
                for (int kb = 0; kb < 2; ++kb)
#pragma unroll
                    for (int s2 = 0; s2 < 2; ++s2) {
                        v4u pw4; pw4.x = pg8::cvt_pk_bf16(s[t][kb][8 * s2 + 0], s[t][kb][8 * s2 + 1]); pw4.y = pg8::cvt_pk_bf16(s[t][kb][8 * s2 + 2], s[t][kb][8 * s2 + 3]);
                        pw4.z = pg8::cvt_pk_bf16(s[t][kb][8 * s2 + 4], s[t][kb][8 * s2 + 5]); pw4.w = pg8::cvt_pk_bf16(s[t][kb][8 * s2 + 6], s[t][kb][8 * s2 + 7]);
                        const fa::bf16x8 pf = __builtin_bit_cast(fa::bf16x8, pw4);
#pragma unroll
                        for (int blk = 0; blk < 2; ++blk) { const LAS bf16* vp = Vt + (32 * blk + r) * fa::VSTR + 32 * kb + 16 * s2 + 4 * h;
                            const fa::bf16x4 lo = *(const LAS fa::bf16x4*)vp, hi = *(const LAS fa::bf16x4*)(vp + 8);
                            o[blk] = __builtin_amdgcn_mfma_f32_32x32x16_bf16(__builtin_shufflevector(lo, hi, 0, 1, 2, 3, 4, 5, 6, 7), pf, o[blk], 0, 0, 0); }
                    }
            }
        }
#pragma unroll
        for (int blk = 0; blk < 2; ++blk)
#pragma unroll
            for (int jj = 0; jj < 4; ++jj) { const int d0 = 32 * blk + 8 * jj + 4 * h;
                v2u ow; ow.x = pk2(o[blk][4 * jj + 0], o[blk][4 * jj + 1]); ow.y = pk2(o[blk][4 * jj + 2], o[blk][4 * jj + 3]);
                *(v2u*)(OC + row * D + head * 64 + d0) = ow; }
        __syncthreads();
#pragma unroll 1
        for (int it = 0; it < 2; ++it) {
            const int ql = 4 * F.wave + 2 * it + h, j = r, t = tq0 + ql; float p = 0.f;
#pragma unroll
            for (int w8 = 0; w8 < 8; ++w8) p += part[(w8 * 32 + ql) * 32 + j];
            const int blkq = t >> 6; const bool adm = (64 * j <= t); const bool forced = (j == 0) || (j == blkq) || (j == blkq - 1);
            const float scj = adm ? (p + (forced ? 1.0e6f : 0.f)) : -1.0e30f;
            int rank = 0;
#pragma unroll 1
            for (int i = 0; i < 32; ++i) { const float si = __shfl(scj, (F.lane & 32) | i); rank += (si > scj || (si == scj && i < j)) ? 1 : 0; }
            const unsigned long long sm = __ballot(adm && rank < 8);
            if (r == 0) SELM[((size_t)b * S + t) * 2 + g] = h ? (unsigned)(sm >> 32) : (unsigned)sm;
        }
        __syncthreads();
    }
}

__device__ __forceinline__ void cmp_prep(const Frame& F) {
    tconv(F, F.in[I_OD_W1K], 128, 2048, 128, 256, (bf16*)(F.ws + WS_W1T), 2048, NOGRP, 0);
    tconv(F, F.in[I_OD_W1V], 128, 2048, 128, 256, (bf16*)(F.ws + WS_W1T) + (size_t)256 * 2048, 2048, NOGRP, 0);
    if (blockIdx.x == 0 && F.tid < 256) { const int which = F.tid >> 7, j = F.tid & 127; const float* pe = which ? F.in[I_OD_PEV] : F.in[I_OD_PEK]; const float* w1 = which ? F.in[I_OD_W1V] : F.in[I_OD_W1K]; float a = 0.f;
        for (int kk = 0; kk < 2048; ++kk) a += pe[kk] * w1[(size_t)kk * 128 + j];
        ((float*)(F.ws + WS_PEB))[F.tid] = a; }
}
__device__ __forceinline__ void cmp_w2_phase(const Frame& F) {
    const float* Hd = (const float*)(F.ws + WS_HIDC);
    LAS float* w2s = (LAS float*)F.lds;
    for (int i = F.tid; i < 2 * 8192; i += 512) w2s[i] = (i < 8192) ? F.in[I_OD_W2K][i] : F.in[I_OD_W2V][i - 8192];
    __syncthreads();
    for (int rw0 = F.gw * 4; rw0 < 2 * 4096; rw0 += F.NGW * 4) {
        float h0[4], h1[4];
#pragma unroll
        for (int k = 0; k < 4; ++k) { h0[k] = Hd[(size_t)(rw0 + k) * 128 + F.lane]; h1[k] = Hd[(size_t)(rw0 + k) * 128 + 64 + F.lane]; }
#pragma unroll
        for (int k = 0; k < 4; ++k) { const int rw = rw0 + k; const int which = rw >> 12, g = (rw >> 11) & 1, b = (rw >> 7) & 15, n = rw & 127;
            const LAS float* w2 = w2s + which * 8192;
            bf16* outp = (bf16*)(F.ws + (which ? WS_VC : WS_KC)) + ((size_t)(b * 2 + g) * 128 + n) * 64;
            float a = 0.f;
            if (n < NCMP) {
#pragma unroll 16
                for (int j = 0; j < 64; ++j) a += __builtin_bit_cast(float, __builtin_amdgcn_readlane(__builtin_bit_cast(int, h0[k]), j)) * w2[j * 64 + F.lane];
#pragma unroll 16
                for (int j = 0; j < 64; ++j) a += __builtin_bit_cast(float, __builtin_amdgcn_readlane(__builtin_bit_cast(int, h1[k]), j)) * w2[(64 + j) * 64 + F.lane]; }
            outp[F.lane] = (bf16)f2bf(a); }
    }
}

constexpr int NPHASE = 29;
__global__ void __launch_bounds__(NWAVES * 64, 2) skel_fwd(Args args) {
    extern __shared__ __attribute__((aligned(16))) unsigned char lds[];
    Frame F;
    F.lds = (LAS unsigned char*)lds; F.ws = args.ws; F.acc = args.out; F.in = args.in;
    F.tid = threadIdx.x; F.lane = F.tid & 63; F.wave = __builtin_amdgcn_readfirstlane(F.tid >> 6);
    F.G = gridDim.x; F.gw = blockIdx.x * NWAVES + F.wave; F.NGW = F.G * NWAVES;
    volatile LAS unsigned* MISC = (volatile LAS unsigned*)(F.lds + MISC_OFF);
    for (int u = F.tid; u < (LDS_BYTES - LDSCTL_OFF) / 4; u += NWAVES * 64) ((LAS unsigned*)(F.lds + LDSCTL_OFF))[u] = 0u;
    __syncthreads();
    unsigned* ctl = (unsigned*)(args.ws + WS_CTL);
    XcdBarrier bar; bar.bar = ctl + CW_BAR; bar.x = 0; bar.st = nullptr;
    const int lo = args.ph_lo, hi = args.ph_hi;
    if (hi - lo > 1) {
        bar = xcd_barrier_post(ctl + CW_BAR, MISC + 8);
        if (threadIdx.x == 0) { unsigned nloc, nx; xcd_barrier_complete(ctl + CW_BAR, bar.x, nloc, nx); MISC[8] = nloc; MISC[9] = nx; }
        __syncthreads();
    }
#ifndef PH_LO
#define PH_LO 0
#define PH_HI 99
#endif
#define IN(k) ((k) >= PH_LO && (k) < PH_HI && lo <= (k) && (k) < hi && fresh(F, ws, args.ws, args.out) && probe_open(F, (k)))
#define SEAM(k) do { if ((lo <= (k) && (k) < hi) && (lo <= (k) + 1 && (k) + 1 < hi)) xcd_barrier(bar); probe_close(F, (k)); } while (0)
    unsigned char* ws = args.ws;
    const int bx = blockIdx.x;

    if (IN(0)) { prologue(F); } SEAM(0);
    if (IN(1)) {
        { pg8::StaticSched<256 * 2048, 256 * 2048, WG_A1> Sd{(const char*)(ws + WS_HB), (const char*)(ws + W_IN0), M / 256, P0_LD / 256, F.G, bx, F.wave};
          pg8::EpiBf16 E{(bf16*)(ws + WS_P0), P0_LD}; pg8::gemm_phase<1024, 2048, 2048>(F.lds, Sd, E); }
        for (int i = 0; i < 2; ++i) {
          pg8::StaticSched<256 * 2048, 256 * 2048> Sd{(const char*)(ws + WS_MEMB), (const char*)(ws + W_XKV + (size_t)i * 1024 * 1024 * 2), MMEM / 256, 4, F.G, (bx + 128 * (i + 1)) % F.G, F.wave};
          pg8::EpiBf16 E{(bf16*)(ws + WS_XKV + (size_t)i * MMEM * 1024 * 2), 1024}; pg8::gemm_phase<1024, 2048, 2048>(F.lds, Sd, E); }
    } SEAM(1);
    if (IN(2)) { PROBE_START(6, F.tid); cn_phase(F); PROBE_STOP(6, F.tid); PROBE_START(7, F.tid); idx_phase_mfma(F); PROBE_STOP(7, F.tid); PROBE_START(8, F.tid); swa_phase_mfma(F); PROBE_STOP(8, F.tid); } SEAM(2);
    if (IN(3)) { dsa_phase_mfma(F); } SEAM(3);
    if (IN(4)) { pg8::StaticSched<256 * P0_LD * 2, 256 * 1536 * 2, WG_B> Sd{(const char*)(ws + WS_P0), (const char*)(ws + W_OUT0), M / 256, 4, F.G, bx, F.wave};
                 pg8::EpiSumB E{(const bf16*)(ws + WS_HB), (bf16*)F.acc}; pg8::gemm_phase<1536, P0_LD * 2, 1536 * 2>(F.lds, Sd, E); } SEAM(4);
    if (IN(5)) { ln_phase<0>(F, 0, (const bf16*)F.acc); } SEAM(5);
    if (IN(6)) { pg8::StaticSched<256 * 2048, 256 * 2048> Sd{(const char*)(ws + WS_HB), (const char*)(ws + W_XQ), M / 256, 2, F.G, bx, F.wave};
                 pg8::EpiBf16 E{(bf16*)(ws + WS_QX0), 512}; pg8::gemm_phase<1024, 2048, 2048>(F.lds, Sd, E); asm volatile("s_waitcnt vmcnt(0)" ::: "memory"); __syncthreads(); xattn_phase_mfma(F, (const bf16*)(ws + WS_QX0), (const bf16*)(ws + WS_XKV), (bf16*)(ws + WS_OX0)); } SEAM(6);
    if (IN(7)) { pg8::StaticSched<256 * 1024, 256 * 1024, WG_B> Sd{(const char*)(ws + WS_OX0), (const char*)(ws + W_XO), M / 256, 4, F.G, bx, F.wave};
                 pg8::EpiSumB E{(const bf16*)(ws + WS_HB), (bf16*)F.acc}; pg8::gemm_phase<512, 1024, 1024>(F.lds, Sd, E); } SEAM(7);
    if (IN(8)) { ln_phase<0>(F, 1, (const bf16*)F.acc); } SEAM(8);
    if (IN(9)) { pg8::StaticSched<256 * 2048, 256 * 2048, WG_A> Sd{(const char*)(ws + WS_HB), (const char*)(ws + W_FGU), M / 256, 2 * DFF / 256, F.G, bx, F.wave};
                  pg8::EpiSwiglu E{(bf16*)(ws + WS_HID), DFF, 0, nullptr}; pg8::gemm_phase<1024, 2048, 2048>(F.lds, Sd, E); } SEAM(9);
    if (IN(10)) { pg8::StaticSched<256 * DFF * 2, 256 * DFF * 2, WG_B> Sd{(const char*)(ws + WS_HID), (const char*)(ws + W_FD), M / 256, 4, F.G, bx, F.wave};
                  pg8::EpiSumB E{(const bf16*)(ws + WS_HB), (bf16*)F.acc}; pg8::gemm_phase<DFF, DFF * 2, DFF * 2>(F.lds, Sd, E); } SEAM(10);
    if (IN(11)) { ln_phase<0>(F, 2, (const bf16*)F.acc); cmp_prep(F); } SEAM(11);
    if (IN(12)) { pg8::StaticSched<256 * 2048, 256 * 2048, WG_A1> Sd{(const char*)(ws + WS_HB), (const char*)(ws + W_IN1), M / 256, P1_LD / 256, F.G, bx, F.wave};
                  pg8::EpiBf16 E{(bf16*)(ws + WS_P1), P1_LD}; pg8::gemm_phase<1024, 2048, 2048>(F.lds, Sd, E); } SEAM(12);
    if (IN(13)) { pg8::CmpSched Sd{(const char*)(ws + WS_P1), (const char*)(ws + WS_W1T), F.G, bx, F.wave};
                  pg8::EpiCmpHid E{(float*)(ws + WS_HIDC), (const float*)(ws + WS_PEB)}; pg8::gemm_phase<2048, 16 * P1_LD * 2, 2048 * 2, P1_LD * 2, (long)S * P1_LD * 2>(F.lds, Sd, E); } SEAM(13);
    if (IN(14)) { cmp_w2_phase(F); } SEAM(14);
    if (IN(15)) { cmp_phase_mfma(F); asm volatile("s_waitcnt vmcnt(0)" ::: "memory"); __syncthreads(); slc_phase_mfma(F); asm volatile("s_waitcnt vmcnt(0)" ::: "memory"); __syncthreads(); win_phase_mfma(F); } SEAM(15);
    if (IN(16)) { pg8::StaticSched<256 * P1_LD * 2, 256 * 2048, WG_B> Sd{(const char*)(ws + WS_P1), (const char*)(ws + W_OUT1), M / 256, 4, F.G, bx, F.wave};
                  pg8::EpiSumB E{(const bf16*)(ws + WS_HB), (bf16*)F.acc}; pg8::gemm_phase<1024, P1_LD * 2, 2048>(F.lds, Sd, E); } SEAM(16);
    if (IN(17)) { ln_phase<0>(F, 3, (const bf16*)F.acc); } SEAM(17);
    if (IN(18)) { pg8::StaticSched<256 * 2048, 256 * 2048> Sd{(const char*)(ws + WS_HB), (const char*)(ws + W_XQ + (size_t)512 * 1024 * 2), M / 256, 2, F.G, bx, F.wave};
                  pg8::EpiBf16 E{(bf16*)(ws + WS_QX1), 512}; pg8::gemm_phase<1024, 2048, 2048>(F.lds, Sd, E); asm volatile("s_waitcnt vmcnt(0)" ::: "memory"); __syncthreads(); xattn_phase_mfma(F, (const bf16*)(ws + WS_QX1), (const bf16*)(ws + WS_XKV + (size_t)MMEM * 1024 * 2), (bf16*)(ws + WS_OX1)); } SEAM(18);
    if (IN(19)) { pg8::StaticSched<256 * 1024, 256 * 1024, WG_B> Sd{(const char*)(ws + WS_OX1), (const char*)(ws + W_XO + (size_t)1024 * 512 * 2), M / 256, 4, F.G, bx, F.wave};
                  pg8::EpiSumB E{(const bf16*)(ws + WS_HB), (bf16*)(ws + WS_SCR + 64 * MiB)}; pg8::gemm_phase<512, 1024, 1024>(F.lds, Sd, E); } SEAM(19);
    if (IN(20)) { ln_phase<1>(F, 4, (const bf16*)(ws + WS_SCR + 64 * MiB)); } SEAM(20);
    if (IN(21)) { moe_dispatch(F); } SEAM(21);
#pragma unroll 1
    for (int ch = 0; ch < 3; ++ch) {
        const int pa = 22 + 2 * ch, pb = 23 + 2 * ch;
        const int* tile_exp = (const int*)(ws + WS_TILEEXP);
        if (IN(pa) || IN(pb)) {
            const int s1 = tile_exp[514];
            int t0 = 128 * ch, t1 = (ch == 2) ? s1 : (t0 + 128 < s1 ? t0 + 128 : s1);
            if (t0 > s1) t0 = s1; int nT = t1 - t0; if (nT < 0) nT = 0; if (nT > 128) nT = 128;
            PROBE_STARTF(11, F.tid);
            if (IN(pa)) { pg8::MoeSched<WS_PERMA, W_MGU, 256 * 2048, 256 * 2048, (size_t)7168 * 2048, 0, WG_A> Sd{ws, t0, nT, 2 * DFFE / 256, F.G, bx, F.wave, nullptr};
                          pg8::EpiSwiglu E{(bf16*)(ws + WS_HIDM), DFFE, 1, (bf16*)args.out}; pg8::gemm_phase<1024, 2048, 2048>(F.lds, Sd, E); }
            if (IN(pa) && IN(pb)) xcd_barrier(bar);
            PROBE_STOPF(11, F.tid); PROBE_STARTF(12, F.tid);
            if (IN(pb)) { pg8::MoeSched<WS_HIDM, W_MD, 256 * DFFE * 2, 256 * DFFE * 2, (size_t)1024 * DFFE * 2, 1, WG_B> Sd{ws, t0, nT, 4, F.G, bx, F.wave, (const unsigned char*)args.out};
                          pg8::EpiBf16 E{(bf16*)(ws + WS_PERMA), 1024}; pg8::gemm_phase<DFFE, DFFE * 2, DFFE * 2>(F.lds, Sd, E); }
            if (IN(pb) && IN(pb + 1)) xcd_barrier(bar);
            PROBE_STOPF(12, F.tid);
        }
    }
    if (IN(28)) { ln_phase<2>(F, 5, nullptr); }
    PROBE_SPIN(F.tid);
#undef IN
#undef SEAM
}

extern "C" void kernel_launch(void* const* d_in, const int* in_sizes, int n_in, void* d_out, int out_size, void* d_ws, size_t ws_size, hipStream_t stream) {
    static int grid = 0;
    if (grid == 0) {
        if (n_in != 30 || out_size != M * D || ws_size < WS_END) { fprintf(stderr, "kernel_launch: unexpected shapes (n_in %d, out %d, ws %zu < %zu); nothing launched\n", n_in, out_size, ws_size, (size_t)WS_END); grid = -1; return; }
        int dev = 0, cus = 0, per_cu = 0;
        if (hipGetDevice(&dev) != hipSuccess || hipDeviceGetAttribute(&cus, hipDeviceAttributeMultiprocessorCount, dev) != hipSuccess) { grid = -1; return; }
        if (hipFuncSetAttribute((const void*)skel_fwd, hipFuncAttributeMaxDynamicSharedMemorySize, LDS_BYTES) != hipSuccess) { fprintf(stderr, "kernel_launch: hipFuncSetAttribute failed\n"); grid = -1; return; }
        if (hipOccupancyMaxActiveBlocksPerMultiprocessor(&per_cu, (const void*)skel_fwd, NWAVES * 64, LDS_BYTES) != hipSuccess || per_cu < 1)
            fprintf(stderr, "kernel_launch: occupancy query reports %d workgroups per CU\n", per_cu);
        (void)hipGetLastError();
        grid = cus;
    }
    if (grid < 0) return;
    if (hipMemsetAsync((char*)d_ws + WS_CTL, 0, CTL_ZERO_BYTES, stream) != hipSuccess) return;
    Args a{};
    for (int i = 0; i < 30; ++i) a.in[i] = (const float*)d_in[i];
    a.out = (float*)d_out; a.ws = (unsigned char*)d_ws;
#if MK_ONE_LAUNCH
    a.ph_lo = 0; a.ph_hi = NPHASE;
    hipLaunchKernelGGL(skel_fwd, dim3(grid), dim3(NWAVES * 64), LDS_BYTES, stream, a);
#else
    for (int p = 0; p < NPHASE; ++p) { a.ph_lo = p; a.ph_hi = p + 1; hipLaunchKernelGGL(skel_fwd, dim3(grid), dim3(NWAVES * 64), LDS_BYTES, stream, a); }
#endif
}
```

```cpp
#include <hip/hip_runtime.h>
#include <cstdio>
#include <cstdint>

#ifndef PROBE_ID
#define PROBE_ID 0
#endif
#ifndef PROBE_AMP
#define PROBE_AMP 4
#endif
#ifndef PROBE_MASK
#define PROBE_MASK 0ull
#endif
#define PROBE_SEL(ph) ((PROBE_MASK >> (ph)) & 1ull)
#if PROBE_ID
#define PROBE_T0 ((volatile __attribute__((address_space(3))) unsigned long long*)(unsigned)(131072 + 320 + 64))
#define PROBE_ACC ((volatile __attribute__((address_space(3))) unsigned long long*)(unsigned)(131072 + 320 + 72))
#define PROBE_WINW ((volatile __attribute__((address_space(3))) unsigned*)(unsigned)(131072 + 320 + 80))
#define PROBE_WIN(ph, on, tid) do { if (PROBE_SEL(ph) && blockIdx.x == 0 && (tid) == 0) { *PROBE_WINW = (on); } } while (0)
#define PROBE_START(id, tid) do { if ((id) == PROBE_ID && blockIdx.x == 0 && (tid) == 0 && *PROBE_WINW) { *PROBE_T0 = __builtin_amdgcn_s_memtime(); } } while (0)
#define PROBE_STOP(id, tid) do { if ((id) == PROBE_ID && blockIdx.x == 0 && (tid) == 0 && *PROBE_WINW) { *PROBE_ACC = *PROBE_ACC + (__builtin_amdgcn_s_memtime() - *PROBE_T0); } } while (0)
#define PROBE_STARTF(id, tid) do { if ((id) == PROBE_ID && blockIdx.x == 0 && (tid) == 0) { *PROBE_T0 = __builtin_amdgcn_s_memtime(); } } while (0)
#define PROBE_STOPF(id, tid) do { if ((id) == PROBE_ID && blockIdx.x == 0 && (tid) == 0) { *PROBE_ACC = *PROBE_ACC + (__builtin_amdgcn_s_memtime() - *PROBE_T0); } } while (0)
#define PROBE_SPIN(tid) do { if (blockIdx.x == 0 && (tid) == 0) { const unsigned long long t0_ = __builtin_amdgcn_s_memtime(), w_ = *PROBE_ACC * PROBE_AMP; while (__builtin_amdgcn_s_memtime() - t0_ < w_) __builtin_amdgcn_s_sleep(8); } } while (0)
#else
#define PROBE_WIN(ph, on, tid) do {} while (0)
#define PROBE_START(id, tid) do {} while (0)
#define PROBE_STOP(id, tid) do {} while (0)
#define PROBE_STARTF(id, tid) do {} while (0)
#define PROBE_STOPF(id, tid) do {} while (0)
#define PROBE_SPIN(tid) do {} while (0)
#endif
#ifndef MK_ONE_LAUNCH
#define MK_ONE_LAUNCH 1
#endif

constexpr size_t ROWTOK_OFF = 5u * 1048576u + 512u * 1024u, ROWW_OFF = 6u * 1048576u, TILEEXP_OFF = 6u * 1048576u + 512u * 1024u, DUMMY_OFF = 7u * 1048576u;
namespace pg8 {
#define PG8_LAS __attribute__((address_space(3)))
typedef unsigned short bf16_t;
typedef short bf16x8 __attribute__((ext_vector_type(8)));
typedef float f32x4 __attribute__((ext_vector_type(4)));
typedef unsigned u32x4 __attribute__((ext_vector_type(4)));
constexpr int BM = 256, BK = 64, HALF = 128, HTB = HALF * BK * 2, STAGE_BYTES = 8 * HTB, NXCD = 8, WGM = 4;

__host__ __device__ __forceinline__ int lds_byte(int r, int c) { const int st = (r >> 4) * 2 + (c >> 5), rr = r & 15, cc = c & 31, ob = rr * 64 + cc * 2; return st * 1024 + (ob ^ (((ob >> 9) & 1) << 5)); }
__host__ __device__ __forceinline__ void stage_rc(int b, int& R, int& C) { const int st = b / 1024, sb = b % 1024, swz = sb ^ (((sb >> 9) & 1) << 5); R = (st >> 1) * 16 + swz / 64; C = (st & 1) * 32 + (swz % 64) / 2; }
__host__ __device__ __forceinline__ int perm32(int rho) { const int n = rho >> 4, i = rho & 15; return 8 * (i >> 2) + 4 * n + (i & 3); }

__device__ __forceinline__ const void* opaque_uniform(const void* p) {
    unsigned lo = __builtin_amdgcn_readfirstlane((unsigned)(unsigned long long)p), hi = __builtin_amdgcn_readfirstlane((unsigned)((unsigned long long)p >> 32));
    asm volatile("" : "+s"(lo), "+s"(hi));
    const __attribute__((address_space(1))) void* g = (const __attribute__((address_space(1))) void*)(((unsigned long long)hi << 32) | lo);
    return (const void*)g; }
struct Unit { int pm, pn, aux; const char* a; const char* b; };

__device__ __forceinline__ void tile_of(int wgid, int nM, int nN, int& pm, int& pn) {
    const int nwg = nM * nN;
    { const int q = nwg / NXCD, r = nwg % NXCD, xcd = wgid % NXCD, off = wgid / NXCD; wgid = (xcd < r ? xcd * (q + 1) : r * (q + 1) + (xcd - r) * q) + off; }
    const int nig = WGM * nN, gid = wgid / nig, fm = gid * WGM, gsz = (nM - fm) < WGM ? (nM - fm) : WGM;
    pm = fm + ((wgid % nig) % gsz); pn = (wgid % nig) / gsz;
}
template <size_t A_TILE, size_t B_TILE>
struct StaticSched {
    const char* A; const char* B; int nM, nN, G, c, wave;
    __device__ __forceinline__ bool next(int i, Unit& u) const {
        const long L = (long)i * G + c; if (L >= (long)nM * nN) return false;
        int pm, pn; tile_of((int)L, nM, nN, pm, pn);
        u.pm = pm; u.pn = pn; u.aux = 0; u.a = A + (size_t)pm * A_TILE; u.b = B + (size_t)pn * B_TILE; return true;
    }
};
template <size_t A_OFF, size_t B_OFF, size_t A_TILE, size_t B_TILE, size_t B_EXP, int A_LOCAL>
struct MoeSched {
    const unsigned char* ws; int t0, nT, nN, G, c, wave; const unsigned char* alt;
    __device__ __forceinline__ bool next(int i, Unit& u) const {
        const long L = (long)i * G + c; if (L >= (long)nT * nN) return false;
        int pml, pn; tile_of((int)L, nT, nN, pml, pn);
        const unsigned char* wsb = (const unsigned char*)opaque_uniform(ws);
        const int pm = t0 + pml; const int e = __builtin_amdgcn_readfirstlane(((const int*)(wsb + TILEEXP_OFF))[pm]);
        u.pm = pm; u.pn = pn; u.aux = pml; u.a = A_LOCAL ? ((pml < 64 ? (const char*)wsb + A_OFF : (const char*)opaque_uniform(alt)) + (size_t)(pml & 63) * A_TILE) : ((const char*)wsb + A_OFF + (size_t)pm * A_TILE); u.b = (const char*)wsb + B_OFF + (size_t)e * B_EXP + (size_t)pn * B_TILE; return true;
    }
};

__device__ __forceinline__ unsigned cvt_pk_bf16(float lo, float hi) { unsigned r; asm volatile("v_cvt_pk_bf16_f32 %0, %1, %2" : "=v"(r) : "v"(lo), "v"(hi)); return r; }

struct EpiBf16 {
    static constexpr bool PERM = true;
    bf16_t* O; int ldc;
    __device__ __forceinline__ void operator()(const f32x4 (&acc)[2][2][4][2], const Unit& u, int wr, int wc, int fr, int fq) const {
        const int row0 = u.pm * BM + wr * 64 + fr, col0 = u.pn * BM + wc * 32 + 8 * fq;
#pragma unroll
        for (int ai = 0; ai < 2; ++ai)
#pragma unroll
            for (int m = 0; m < 4; ++m) { bf16_t* rowp = O + (size_t)(row0 + ai * HALF + m * 16) * ldc + col0;
#pragma unroll
                for (int bj = 0; bj < 2; ++bj) { const f32x4 v0 = acc[ai][bj][m][0], v1 = acc[ai][bj][m][1];
                    u32x4 w; w.x = cvt_pk_bf16(v0[0], v0[1]); w.y = cvt_pk_bf16(v0[2], v0[3]); w.z = cvt_pk_bf16(v1[0], v1[1]); w.w = cvt_pk_bf16(v1[2], v1[3]);
                    *(u32x4*)(rowp + bj * HALF) = w; } }
    }
};
struct EpiAcc {
    static constexpr bool PERM = false;
    float* C; int ldc;
    __device__ __forceinline__ void operator()(const f32x4 (&acc)[2][2][4][2], const Unit& u, int wr, int wc, int fr, int fq) const {
        const int row0 = u.pm * BM + wr * 64 + fr, col0 = u.pn * BM + wc * 32 + 4 * fq;
#pragma unroll
        for (int ai = 0; ai < 2; ++ai)
#pragma unroll
            for (int m = 0; m < 4; ++m) { float* rowp = C + (size_t)(row0 + ai * HALF + m * 16) * ldc + col0;
                f32x4 o[2][2];
#pragma unroll
                for (int bj = 0; bj < 2; ++bj)
#pragma unroll
                    for (int n = 0; n < 2; ++n) o[bj][n] = *(const f32x4*)(rowp + bj * HALF + n * 16);
#pragma unroll
                for (int bj = 0; bj < 2; ++bj)
#pragma unroll
                    for (int n = 0; n < 2; ++n) *(f32x4*)(rowp + bj * HALF + n * 16) = o[bj][n] + acc[ai][bj][m][n]; }
    }
};
struct EpiSumB {
    static constexpr bool PERM = true;
    const bf16_t* H; bf16_t* O;
    __device__ __forceinline__ void operator()(const f32x4 (&acc)[2][2][4][2], const Unit& u, int wr, int wc, int fr, int fq) const {
        const int row0 = u.pm * BM + wr * 64 + fr, col0 = u.pn * BM + wc * 32 + 8 * fq;
#pragma unroll
        for (int ai = 0; ai < 2; ++ai)
#pragma unroll
            for (int m = 0; m < 4; ++m) { const size_t off = (size_t)(row0 + ai * HALF + m * 16) * 1024 + col0;
                u32x4 hw[2];
#pragma unroll
                for (int bj = 0; bj < 2; ++bj) hw[bj] = *(const u32x4*)(H + off + bj * HALF);
#pragma unroll
                for (int bj = 0; bj < 2; ++bj) { const f32x4 v0 = acc[ai][bj][m][0], v1 = acc[ai][bj][m][1]; const u32x4 h = hw[bj]; const float A = 1.41421356237f;
                    u32x4 w; w.x = cvt_pk_bf16(v0[0] + A * __builtin_bit_cast(float, h.x << 16), v0[1] + A * __builtin_bit_cast(float, h.x & 0xffff0000u));
                    w.y = cvt_pk_bf16(v0[2] + A * __builtin_bit_cast(float, h.y << 16), v0[3] + A * __builtin_bit_cast(float, h.y & 0xffff0000u));
                    w.z = cvt_pk_bf16(v1[0] + A * __builtin_bit_cast(float, h.z << 16), v1[1] + A * __builtin_bit_cast(float, h.z & 0xffff0000u));
                    w.w = cvt_pk_bf16(v1[2] + A * __builtin_bit_cast(float, h.w << 16), v1[3] + A * __builtin_bit_cast(float, h.w & 0xffff0000u));
                    *(u32x4*)(O + off + bj * HALF) = w; } }
    }
};
__device__ __forceinline__ float silu_f(float x) { return x / (1.0f + __expf(-x)); }
struct EpiSwiglu {
    static constexpr bool PERM = true;
    bf16_t* O; int ldc; int row_local; bf16_t* O2;
    __device__ __forceinline__ void operator()(const f32x4 (&acc)[2][2][4][2], const Unit& u, int wr, int wc, int fr, int fq) const {
        const int row0 = (row_local ? (u.aux & 63) : u.pm) * BM + wr * 64 + fr, col0 = u.pn * HALF + wc * 32 + 8 * fq;
        bf16_t* Ob = (row_local && u.aux >= 64) ? O2 : O;
#pragma unroll
        for (int ai = 0; ai < 2; ++ai)
#pragma unroll
            for (int m = 0; m < 4; ++m) { bf16_t* rowp = Ob + (size_t)(row0 + ai * HALF + m * 16) * ldc + col0;
                const f32x4 g0 = acc[ai][0][m][0], g1 = acc[ai][0][m][1], u0 = acc[ai][1][m][0], u1 = acc[ai][1][m][1];
                float h[8];
#pragma unroll
                for (int j = 0; j < 4; ++j) { h[j] = silu_f(g0[j]) * u0[j]; h[4 + j] = silu_f(g1[j]) * u1[j]; }
                u32x4 w; w.x = cvt_pk_bf16(h[0], h[1]); w.y = cvt_pk_bf16(h[2], h[3]); w.z = cvt_pk_bf16(h[4], h[5]); w.w = cvt_pk_bf16(h[6], h[7]);
                *(u32x4*)rowp = w; }
    }
};
struct EpiMoeDown {
    static constexpr bool PERM = false;
    float* C; unsigned char* ws;
    __device__ __forceinline__ void operator()(const f32x4 (&acc)[2][2][4][2], const Unit& u, int wr, int wc, int fr, int fq) const {
        const int row0 = u.pm * BM + wr * 64 + fr, col0 = u.pn * BM + wc * 32 + 4 * fq;
        unsigned char* wsb = (unsigned char*)opaque_uniform(ws);
        const int* rowtok = (const int*)(wsb + ROWTOK_OFF); const float* roww = (const float*)(wsb + ROWW_OFF); float* dummy = (float*)(wsb + DUMMY_OFF);
#pragma unroll
        for (int ai = 0; ai < 2; ++ai)
#pragma unroll
            for (int m = 0; m < 4; ++m) { const int r = row0 + ai * HALF + m * 16; const int tok = rowtok[r]; const float w = roww[r];
                float* rowp = (tok >= 0 ? C + (size_t)tok * 1024 : dummy) + col0;
                f32x4 o[2][2];
#pragma unroll
                for (int bj = 0; bj < 2; ++bj)
#pragma unroll
                    for (int n = 0; n < 2; ++n) o[bj][n] = *(const f32x4*)(rowp + bj * HALF + n * 16);
#pragma unroll
                for (int bj = 0; bj < 2; ++bj)
#pragma unroll
                    for (int n = 0; n < 2; ++n) *(f32x4*)(rowp + bj * HALF + n * 16) = o[bj][n] + acc[ai][bj][m][n] * w; }
    }
};

__device__ __forceinline__ float gelu_tanh_f(float x) { const float u = 0.7978845608028654f * (x + 0.044715f * x * x * x); const float e = __expf(2.f * u); return 0.5f * x * (1.f + (1.f - 2.f / (e + 1.f))); }
struct EpiCmpHid {
    static constexpr bool PERM = false;
    float* Hd; const float* bias;
    __device__ __forceinline__ void operator()(const f32x4 (&acc)[2][2][4][2], const Unit& u, int wr, int wc, int fr, int fq) const {
        const int row0 = u.pm * BM + wr * 64 + fr, col0 = wc * 32 + 4 * fq;
        f32x4 bv[2];
#pragma unroll
        for (int n = 0; n < 2; ++n) bv[n] = *(const f32x4*)(bias + u.aux * 128 + col0 + n * 16);
#pragma unroll
        for (int ai = 0; ai < 2; ++ai)
#pragma unroll
            for (int m = 0; m < 4; ++m) { float* rowp = Hd + (size_t)(row0 + ai * HALF + m * 16) * 128 + col0;
#pragma unroll
                for (int n = 0; n < 2; ++n) { const f32x4 v = acc[ai][0][m][n] + bv[n]; f32x4 o;
#pragma unroll
                    for (int j = 0; j < 4; ++j) o[j] = gelu_tanh_f(v[j]);
                    *(f32x4*)(rowp + n * 16) = o; } }
    }
};
struct CmpSched {
    const char* P1b; const char* W1T; int G, c, wave;
    __device__ __forceinline__ bool next(int i, Unit& u) const {
        const int L = i * G + c; if (L >= 32) return false;
        const int which = L >> 4, tile = L & 15, g = tile >> 3, b0 = 2 * (tile & 7);
        u.pm = L; u.pn = 0; u.aux = which; u.a = P1b + ((size_t)b0 * 2048 * 2048 + (which ? 1152 : 1024) + g * 64) * 2; u.b = W1T + (size_t)which * 256 * 2048 * 2; return true;
    }
};

template <int K, int lda_b, int ldb_b, long KSTEP_A = 128, long HSTEP_A = 128L * lda_b, class Epi, class Sched>
__device__ __forceinline__ void gemm_phase(PG8_LAS unsigned char* lds, const Sched& S, const Epi& E) {
    int tid_ = (int)__builtin_amdgcn_mbcnt_hi(~0u, __builtin_amdgcn_mbcnt_lo(~0u, 0u)); asm volatile("" : "+v"(tid_)); tid_ += S.wave * 64;
    const int tid = tid_, wid = __builtin_amdgcn_readfirstlane(tid >> 6), lane = tid & 63, wr = wid >> 2, wc = wid & 3, fr = lane & 15, fq = lane >> 4;
    constexpr int nt = K / BK;
    unsigned voffA[2], voffB[2];
#pragma unroll
    for (int i = 0; i < 2; ++i) { int R, C; stage_rc(tid * 16 + i * 8192, R, C); const int Rb = Epi::PERM ? ((R & ~31) + perm32(R & 31)) : R;
        voffA[i] = (unsigned)(R * lda_b + C * 2); voffB[i] = (unsigned)(Rb * ldb_b + C * 2); }
    const size_t kstep = (size_t)(BK * 2), kstepA = (size_t)KSTEP_A;
    const size_t hstepA = (size_t)HSTEP_A, hstepB = (size_t)HALF * ldb_b;
    const unsigned ldsw = (unsigned)wid * 1024u;
    const int aoff = lds_byte(wr * 64 + fr, fq * 8), boff = lds_byte(wc * 32 + fr, fq * 8);
#define PG8_SA(b, h) (((b) * 2 + (h)) * HTB)
#define PG8_SB(b, h) ((4 + (b) * 2 + (h)) * HTB)
#define PG8_STAGE(bufoff, gbase, voff) do { _Pragma("unroll") for (int _i = 0; _i < 2; ++_i) \
        __builtin_amdgcn_global_load_lds((const unsigned*)((const char*)(gbase) + (voff)[_i]), (PG8_LAS unsigned*)(lds + (bufoff) + ldsw + _i * 8192), 16, 0, 0); } while (0)
#define PG8_LDA(dst, b, h) do { _Pragma("unroll") for (int m = 0; m < 4; ++m) _Pragma("unroll") for (int k = 0; k < 2; ++k) dst[m][k] = *(const PG8_LAS bf16x8*)(lds + PG8_SA(b, h) + aoff + m * 2048 + k * 1024); } while (0)
#define PG8_LDB(dst, b, h) do { _Pragma("unroll") for (int n = 0; n < 2; ++n) _Pragma("unroll") for (int k = 0; k < 2; ++k) dst[n][k] = *(const PG8_LAS bf16x8*)(lds + PG8_SB(b, h) + boff + n * 2048 + k * 1024); } while (0)
#define PG8_MMA(ai, bj, At, Bt) do { __builtin_amdgcn_s_setprio(1); _Pragma("unroll") for (int m = 0; m < 4; ++m) _Pragma("unroll") for (int n = 0; n < 2; ++n) _Pragma("unroll") for (int k = 0; k < 2; ++k) \
        acc[ai][bj][m][n] = __builtin_amdgcn_mfma_f32_16x16x32_bf16(Bt[n][k], At[m][k], acc[ai][bj][m][n], 0, 0, 0); __builtin_amdgcn_s_setprio(0); } while (0)
#define PG8_WAIT_V(n) asm volatile("s_waitcnt vmcnt(" #n ")" ::: "memory")
#define PG8_WAIT_L(n) asm volatile("s_waitcnt lgkmcnt(" #n ")" ::: "memory")
#define PG8_BAR __builtin_amdgcn_s_barrier()
#define PG8_SCHED __builtin_amdgcn_sched_barrier(0)
    Unit cur, nxt; int ui = 0;
    if (!S.next(0, cur)) return;
    f32x4 acc[2][2][4][2];
#pragma unroll
    for (int a = 0; a < 2; ++a)
#pragma unroll
        for (int b = 0; b < 2; ++b)
#pragma unroll
            for (int m = 0; m < 4; ++m)
#pragma unroll
                for (int n = 0; n < 2; ++n) acc[a][b][m][n] = (f32x4){0.f, 0.f, 0.f, 0.f};
    bf16x8 At[4][2], B0[2][2], B1[2][2];
    const char* cA = cur.a; const char* cB = cur.b;
    PG8_STAGE(PG8_SB(0, 0), cB, voffB); PG8_STAGE(PG8_SB(0, 1), cB + hstepB, voffB); PG8_STAGE(PG8_SA(0, 0), cA, voffA); PG8_STAGE(PG8_SA(0, 1), cA + hstepA, voffA);
    if (wr == 1) PG8_BAR;
    PG8_WAIT_V(2); PG8_BAR;
    PG8_STAGE(PG8_SB(1, 0), cB + kstep, voffB); PG8_STAGE(PG8_SA(1, 0), cA + kstepA, voffA); PG8_STAGE(PG8_SB(1, 1), cB + hstepB + kstep, voffB);
    PG8_WAIT_V(6); PG8_BAR;
    for (;;) {
        const bool has_next = S.next(ui + 1, nxt);
        const char* nA = has_next ? nxt.a : cA; const char* nB = has_next ? nxt.b : cB;
        for (int t = 0; t < nt; t += 2) {
            const bool last = (t == nt - 2);
            const char* a1 = cA + (size_t)(t + 1) * kstepA;
            const char* a2 = last ? nA : cA + (size_t)(t + 2) * kstepA; const char* b2 = last ? nB : cB + (size_t)(t + 2) * kstep;
            const char* a3 = a2 + kstepA; const char* b3 = b2 + kstep;
            PG8_LDB(B0, 0, 0); PG8_LDB(B1, 0, 1); PG8_SCHED; PG8_LDA(At, 0, 0); PG8_STAGE(PG8_SA(1, 1), a1 + hstepA, voffA);
            PG8_WAIT_V(8); PG8_WAIT_L(0); PG8_BAR; PG8_MMA(0, 0, At, B0); PG8_MMA(0, 1, At, B1); PG8_BAR; PG8_SCHED;
            PG8_LDA(At, 0, 1); PG8_STAGE(PG8_SB(0, 0), b2, voffB); PG8_STAGE(PG8_SB(0, 1), b2 + hstepB, voffB); PG8_STAGE(PG8_SA(0, 0), a2, voffA);
            PG8_WAIT_V(8); PG8_WAIT_L(0); PG8_BAR; PG8_MMA(1, 0, At, B0); PG8_MMA(1, 1, At, B1); PG8_BAR; PG8_SCHED;
            PG8_LDB(B0, 1, 0); PG8_LDB(B1, 1, 1); PG8_SCHED; PG8_LDA(At, 1, 0); PG8_STAGE(PG8_SA(0, 1), a2 + hstepA, voffA);
            PG8_WAIT_V(8); PG8_WAIT_L(0); PG8_BAR; PG8_MMA(0, 0, At, B0); PG8_MMA(0, 1, At, B1); PG8_BAR; PG8_SCHED;
            PG8_LDA(At, 1, 1); PG8_STAGE(PG8_SB(1, 0), b3, voffB); PG8_STAGE(PG8_SB(1, 1), b3 + hstepB, voffB); PG8_STAGE(PG8_SA(1, 0), a3, voffA);
            PG8_WAIT_V(8); PG8_WAIT_L(0); PG8_BAR; PG8_MMA(1, 0, At, B0); PG8_MMA(1, 1, At, B1); PG8_BAR; PG8_SCHED;
        }
        if (wr == 0) PG8_BAR;
        E(acc, cur, wr, wc, fr, fq);
        if (!has_next) break;
#pragma unroll
        for (int a = 0; a < 2; ++a)
#pragma unroll
            for (int b = 0; b < 2; ++b)
#pragma unroll
                for (int m = 0; m < 4; ++m)
#pragma unroll
                    for (int n = 0; n < 2; ++n) acc[a][b][m][n] = (f32x4){0.f, 0.f, 0.f, 0.f};
        cur = nxt; cA = nA; cB = nB; ++ui;
        if (wr == 1) PG8_BAR;
    }
    PG8_WAIT_V(0);
    PG8_BAR;
#undef PG8_SA
#undef PG8_SB
#undef PG8_STAGE
#undef PG8_LDA
#undef PG8_LDB
#undef PG8_MMA
#undef PG8_WAIT_V
#undef PG8_WAIT_L
#undef PG8_BAR
#undef PG8_SCHED
}
}

constexpr int NWAVES = 8;
constexpr int D = 1024, NB = 16, S = 2048, M = NB * S, MEML = 256, MMEM = NB * MEML;
constexpr float LN_EPS = 1e-5f, ALPHA = 1.41421356237f;
constexpr int P0_LD = 2560, C0_QLAT = 0, C0_QB = 1024, C0_CKV = 1536, C0_QI = 1664, C0_KI = 2176, C0_KB = 2240, C0_VB = 2368, C0_WI = 2496;
constexpr int P1_LD = 2048, C1_Q = 0, C1_KC = 1024, C1_VC = 1152, C1_KS = 1280, C1_VS = 1408, C1_KW = 1536, C1_VW = 1664, C1_GL = 1792;
constexpr int EVEN_COLS = 1992, ODD_COLS = 1840;
constexpr int DFF = 2816, DFFE = 3584, NE = 8, NCMP = 127;
constexpr int MOE_CHUNK_TILES = 68, MOE_MAX_TILES = 272;

constexpr size_t MiB = 1u << 20;
constexpr size_t WS_CTL = 0, CTL_ZERO_BYTES = 1 * MiB;
constexpr size_t WS_KC = 2 * MiB, WS_VC = 3 * MiB;
constexpr size_t WS_SELM = 4 * MiB;
constexpr size_t WS_RTE = 4 * MiB + 512 * 1024;
constexpr size_t WS_RTW = 5 * MiB;
constexpr size_t WS_ROWTOK = ROWTOK_OFF; static_assert(ROWTOK_OFF == 5 * MiB + 512 * 1024, "");
constexpr size_t WS_ROWW = ROWW_OFF;
constexpr size_t WS_TILEEXP = TILEEXP_OFF; constexpr size_t WS_DUMMY = DUMMY_OFF;
constexpr size_t WS_W = 8 * MiB;
constexpr size_t W_IN0 = WS_W;
constexpr size_t W_OUT0 = W_IN0 + (size_t)2560 * 1024 * 2;
constexpr size_t W_IN1 = W_OUT0 + (size_t)1024 * 1536 * 2;
constexpr size_t W_OUT1 = W_IN1 + (size_t)2048 * 1024 * 2;
constexpr size_t W_XQ = W_OUT1 + (size_t)1024 * 1024 * 2;
constexpr size_t W_XKV = W_XQ + (size_t)2 * 512 * 1024 * 2;
constexpr size_t W_XO = W_XKV + (size_t)2 * 1024 * 1024 * 2;
constexpr size_t W_FGU = W_XO + (size_t)2 * 1024 * 512 * 2;
constexpr size_t W_FD = W_FGU + (size_t)5632 * 1024 * 2;
constexpr size_t W_MGU = W_FD + (size_t)1024 * 2816 * 2;
constexpr size_t W_MD = W_MGU + (size_t)8 * 7168 * 1024 * 2;
constexpr size_t W_END = W_MD + (size_t)8 * 1024 * 3584 * 2;
static_assert(W_END <= 215 * MiB, "weights");
constexpr size_t WS_HB = 215 * MiB;
constexpr size_t WS_XKV = 279 * MiB;
constexpr size_t WS_SCR = 295 * MiB;
constexpr size_t WS_P0 = WS_SCR;
constexpr size_t WS_CN = WS_SCR + 160 * MiB;
constexpr size_t WS_MASK = WS_SCR + 168 * MiB;
constexpr size_t WS_MEMB = WS_SCR + 176 * MiB;
constexpr size_t WS_QX0 = WS_SCR + 184 * MiB, WS_OX0 = WS_SCR + 216 * MiB;
constexpr size_t WS_HID = WS_SCR;
constexpr size_t WS_P1 = WS_SCR;
constexpr size_t WS_OCMP = WS_SCR + 128 * MiB, WS_OSLC = WS_SCR + 192 * MiB;
constexpr size_t WS_W1T = WS_SCR + 192 * MiB, WS_HIDC = WS_SCR + 196 * MiB, WS_PEB = WS_SCR + 200 * MiB;
constexpr size_t WS_QX1 = WS_SCR, WS_OX1 = WS_SCR + 32 * MiB;
constexpr size_t WS_PERMA = WS_SCR;
constexpr size_t WS_HIDM = WS_SCR + 136 * MiB;
constexpr size_t WS_END = WS_SCR + 256 * MiB;
static_assert(WS_HIDM + (size_t)MOE_CHUNK_TILES * 256 * DFFE * 2 <= WS_END, "ws");
constexpr int CW_BAR = 4096;
constexpr int CW_CNT = 16384;
constexpr int CW_CUR = 16384 + 64;

constexpr int RING_BYTES = 131072, LDSCTL_OFF = RING_BYTES, MISC_OFF = LDSCTL_OFF + 320, LDS_BYTES = 147456;

#define GAS __attribute__((address_space(1)))
#define LAS __attribute__((address_space(3)))
typedef unsigned short bf16;
typedef unsigned v4u __attribute__((ext_vector_type(4)));
typedef unsigned v2u __attribute__((ext_vector_type(2)));
typedef float f32x4 __attribute__((ext_vector_type(4)));
#define LDS_WAIT() asm volatile("s_waitcnt lgkmcnt(0)" ::: "memory")
#define WAVE_SYNC() asm volatile("s_waitcnt vmcnt(0) lgkmcnt(0)" ::: "memory")
__device__ __forceinline__ unsigned f2bf(float f) { unsigned u = __builtin_bit_cast(unsigned, f); return (u + 0x7fffu + ((u >> 16) & 1u)) >> 16; }
__device__ __forceinline__ unsigned pk2(float lo, float hi) { return f2bf(lo) | (f2bf(hi) << 16); }
__device__ __forceinline__ float bf2f(bf16 b) { return __builtin_bit_cast(float, (unsigned)b << 16); }
__device__ __forceinline__ float bflo(unsigned w) { return __builtin_bit_cast(float, w << 16); }
__device__ __forceinline__ float bfhi(unsigned w) { return __builtin_bit_cast(float, w & 0xffff0000u); }
__device__ __forceinline__ void ld8bf(const bf16* p, float* f) { const v4u w = *(const v4u*)p; f[0] = bflo(w.x); f[1] = bfhi(w.x); f[2] = bflo(w.y); f[3] = bfhi(w.y); f[4] = bflo(w.z); f[5] = bfhi(w.z); f[6] = bflo(w.w); f[7] = bfhi(w.w); }
__device__ __forceinline__ float wave_sum(float v) {
#pragma unroll
    for (int o = 1; o < 64; o <<= 1) v += __shfl_xor(v, o);
    return v;
}
__device__ __forceinline__ float dpp_f(float v, int ctrl_unused);
#define DPP_ADD_F(v, ctrl, rmask) v += __builtin_bit_cast(float, __builtin_amdgcn_update_dpp(0, __builtin_bit_cast(int, v), ctrl, rmask, 0xf, false))
__device__ __forceinline__ float wave_sum_fast(float v) {
    DPP_ADD_F(v, 0xB1, 0xf); DPP_ADD_F(v, 0x4E, 0xf); DPP_ADD_F(v, 0x141, 0xf); DPP_ADD_F(v, 0x140, 0xf); DPP_ADD_F(v, 0x142, 0xa); DPP_ADD_F(v, 0x143, 0xc);
    return __builtin_bit_cast(float, __builtin_amdgcn_readlane(__builtin_bit_cast(int, v), 63));
}
__device__ __forceinline__ float wave_max(float v) {
#pragma unroll
    for (int o = 1; o < 64; o <<= 1) v = fmaxf(v, __shfl_xor(v, o));
    return v;
}
__device__ const unsigned char BKT[112] = {16, 16, 16, 17, 17, 18, 18, 18, 19, 19, 19, 20, 20, 20, 20, 21, 21, 21, 21, 22, 22, 22, 22, 22, 23, 23, 23, 23, 23, 23, 24, 24, 24, 24, 24, 24, 25, 25, 25, 25, 25, 25, 25, 26, 26, 26, 26, 26, 26, 26, 26,
    27, 27, 27, 27, 27, 27, 27, 27, 27, 27, 28, 28, 28, 28, 28, 28, 28, 28, 28, 28, 29, 29, 29, 29, 29, 29, 29, 29, 29, 29, 29, 29, 30, 30, 30, 30, 30, 30, 30, 30, 30, 30, 30, 30, 30, 30, 31, 31, 31, 31, 31, 31, 31, 31, 31, 31, 31, 31, 31, 31, 31};
__device__ __forceinline__ int rel_bucket(int n) { return n < 16 ? n : (n >= 128 ? 31 : (int)BKT[n - 16]); }

#define XB_TMO      128
#define XB_XCNT(j)  (256  + 64 * (j))
#define XB_XSUB(j)  (1280 + 64 * (j))
#define XB_XGEN(j)  (2304 + 64 * (j))
#define XB_TOP      3328
#define XB_TOPGEN   3392
#define XCD_BAR_WORDS 3456
#define XB_SPIN_CAP (1u << 22)
__device__ __forceinline__ unsigned xb_ld(unsigned* p)              { return __hip_atomic_load(p, __ATOMIC_RELAXED, __HIP_MEMORY_SCOPE_AGENT); }
__device__ __forceinline__ unsigned xb_add(unsigned* p, unsigned v) { return __hip_atomic_fetch_add(p, v, __ATOMIC_RELAXED, __HIP_MEMORY_SCOPE_AGENT); }
__device__ __forceinline__ unsigned xb_xcc_id() { return (unsigned)__builtin_amdgcn_s_getreg((3 << 11) | 20) & 0xFu; }
#define XB_SPIN(cond, bar) do { unsigned _sp = 0; while (cond) { __builtin_amdgcn_s_sleep(1); \
    if ((++_sp & 255u) == 0u) { if (xb_ld(&(bar)[XB_TMO])) break; if (_sp > XB_SPIN_CAP) { atomicAdd(&(bar)[XB_TMO], 1u); break; } } } } while (0)
struct XcdBarrier { unsigned* bar; unsigned x; volatile LAS unsigned* st; };
__device__ __forceinline__ XcdBarrier xcd_barrier_post(unsigned* bar, volatile LAS unsigned* st) {
    XcdBarrier b; b.bar = bar; b.x = xb_xcc_id(); b.st = st;
    if (threadIdx.x == 0) (void)xb_add(&bar[XB_XCNT(b.x)], 1u);
    return b;
}
__device__ __forceinline__ void xcd_barrier_complete(unsigned* bar, unsigned x, unsigned& nloc, unsigned& nx) {
    const unsigned G = gridDim.x * gridDim.y * gridDim.z;
    unsigned sum, cnt, mine, sp = 0u;
    for (;;) {
        sum = 0u; cnt = 0u; mine = 0u;
#pragma unroll
        for (unsigned j = 0; j < 16; ++j) { const unsigned c = xb_ld(&bar[XB_XCNT(j)]); sum += c; cnt += (c > 0u) ? 1u : 0u; mine = (j == x) ? c : mine; }
        if (sum == G) break;
        __builtin_amdgcn_s_sleep(1);
        if ((++sp & 255u) == 0u) { if (xb_ld(&bar[XB_TMO])) break; if (sp > XB_SPIN_CAP) { atomicAdd(&bar[XB_TMO], 1u); break; } }
    }
    nloc = mine > 0u ? mine : 1u; nx = cnt > 0u ? cnt : 1u;
}
__device__ __forceinline__ void xcd_barrier(const XcdBarrier& b, int tid) {
    asm volatile("s_waitcnt vmcnt(0)" ::: "memory");
    __syncthreads();
    if (tid == 0) {
        unsigned* bar = b.bar;
        __builtin_amdgcn_s_waitcnt(0);
        unsigned nloc = b.st[0], nx = b.st[1];
        const unsigned old = xb_add(&bar[XB_XSUB(b.x)], 1u);
        const unsigned gen = old / nloc;
        if (old + 1u == (gen + 1u) * nloc) {
            __builtin_amdgcn_fence(__ATOMIC_RELEASE, "agent");
            asm volatile("s_waitcnt vmcnt(0)" ::: "memory");
            const unsigned og = xb_add(&bar[XB_TOP], 1u);
            const unsigned tg = og / nx;
            if (og + 1u == (tg + 1u) * nx) xb_add(&bar[XB_TOPGEN], 1u);
            else XB_SPIN(xb_ld(&bar[XB_TOPGEN]) == tg, bar);
            __builtin_amdgcn_fence(__ATOMIC_ACQUIRE, "agent");
            xb_add(&bar[XB_XGEN(b.x)], 1u);
            asm volatile("s_waitcnt vmcnt(0)" ::: "memory");
        } else {
            XB_SPIN(xb_ld(&bar[XB_XGEN(b.x)]) == gen, bar);
            __builtin_amdgcn_fence(__ATOMIC_ACQUIRE, "agent");
            asm volatile("s_waitcnt vmcnt(0)" ::: "memory");
        }
    }
    __syncthreads();
}

struct Args { const float* in[30]; float* out; unsigned char* ws; int ph_lo, ph_hi; };
enum { I_X = 0, I_MEM, I_REL, I_EV_WIN, I_EV_GAIN, I_EV_WUK, I_EV_WUV, I_EV_SINK, I_EV_WOUT, I_OD_WIN, I_OD_PEK, I_OD_W1K, I_OD_W2K, I_OD_PEV, I_OD_W1V, I_OD_W2V, I_OD_WOUT,
       I_XA_WQ, I_XA_WK, I_XA_WV, I_XA_WO, I_FF_G, I_FF_U, I_FF_D, I_MOE_R, I_MOE_G, I_MOE_U, I_MOE_D, I_LN_G, I_LN_B };

struct Frame {
    LAS unsigned char* lds;
    unsigned char* ws; float* acc;
    const float* const* in;
    int tid, lane, wave, G, gw, NGW;
};

__device__ __forceinline__ bool fresh(Frame& F, unsigned char*& ws, unsigned char* ws0, float* acc0) { int l = (int)__builtin_amdgcn_mbcnt_hi(~0u, __builtin_amdgcn_mbcnt_lo(~0u, 0u)); asm volatile("" : "+v"(l)); F.lane = l; F.tid = F.wave * 64 + l;
    ws = (unsigned char*)pg8::opaque_uniform(ws0); F.ws = ws; F.acc = (float*)pg8::opaque_uniform(acc0); return true; }
__device__ __forceinline__ bool probe_open(Frame& F, int k) { PROBE_WIN(k, 1u, F.tid); PROBE_START(1, F.tid); return true; }
__device__ __forceinline__ void probe_close(Frame& F, int k) { if (PROBE_SEL(k)) { PROBE_STOP(1, F.tid); } PROBE_WIN(k, 0u, F.tid); }
__device__ __forceinline__ void tconv_item(const float* W, int ldw, int ncols, bf16* WT, int ldt, int grp, int gstride, LAS float* scr, int kb, int nb, int lane) {
    const int k0 = 64 * kb, n0 = 32 * nb;
    const int kr = lane >> 3, n4 = (lane & 7) * 4;
    f32x4 v[8];
#pragma unroll
    for (int i = 0; i < 8; ++i) v[i] = (n0 + n4 < ncols) ? *(const f32x4*)(W + (size_t)(k0 + 8 * i + kr) * ldw + n0 + n4) : (f32x4){0.f, 0.f, 0.f, 0.f};
#pragma unroll
    for (int i = 0; i < 8; ++i) { LAS float* d = scr + (8 * i + kr) * 33 + n4; d[0] = v[i].x; d[1] = v[i].y; d[2] = v[i].z; d[3] = v[i].w; }
    LDS_WAIT();
    const int c = lane & 7;
#pragma unroll
    for (int j = 0; j < 4; ++j) { const int nn = (lane >> 3) + 8 * j, n = n0 + nn; const LAS float* s = scr + (8 * c) * 33 + nn;
        v4u o; o.x = pk2(s[0 * 33], s[1 * 33]); o.y = pk2(s[2 * 33], s[3 * 33]); o.z = pk2(s[4 * 33], s[5 * 33]); o.w = pk2(s[6 * 33], s[7 * 33]);
        const int row = (n / grp) * gstride + (n % grp);
        *(v4u*)(WT + (size_t)row * ldt + k0 + 8 * c) = o; }
    LDS_WAIT();
}
__device__ __forceinline__ void tconv(const Frame& F, const float* W, int ldw, int K, int ncols, int npad, bf16* WT, int ldt, int grp, int gstride) {
    LAS float* scr = (LAS float*)(F.lds + F.wave * 16384);
    const int nkb = K / 64, nnb = npad / 32;
    for (int it = F.gw; it < nkb * nnb; it += F.NGW) tconv_item(W, ldw, ncols, WT, ldt, grp, gstride, scr, it / nnb, it % nnb, F.lane);
}
constexpr int NOGRP = 1 << 30;

__device__ __forceinline__ void prologue(const Frame& F) {
    unsigned char* ws = F.ws;
    const int gt = F.gw * 64 + F.lane, NT = F.NGW * 64;
    bf16* win0 = (bf16*)(ws + W_IN0);
    const float* evw = F.in[I_EV_WIN];
    tconv(F, evw + 512, EVEN_COLS, 1024, 128, 128, win0 + (size_t)C0_CKV * 1024, 1024, NOGRP, 0);
    tconv(F, evw + 640, EVEN_COLS, 1024, 512, 512, win0 + (size_t)C0_QI * 1024, 1024, NOGRP, 0);
    tconv(F, evw + 1152, EVEN_COLS, 1024, 64, 64, win0 + (size_t)C0_KI * 1024, 1024, NOGRP, 0);
    tconv(F, evw + 1216, EVEN_COLS, 1024, 8, 64, win0 + (size_t)C0_WI * 1024, 1024, NOGRP, 0);
    tconv(F, evw + 1224, EVEN_COLS, 1024, 512, 512, win0 + (size_t)C0_QB * 1024, 1024, NOGRP, 0);
    tconv(F, evw + 1736, EVEN_COLS, 1024, 128, 128, win0 + (size_t)C0_KB * 1024, 1024, NOGRP, 0);
    tconv(F, evw + 1864, EVEN_COLS, 1024, 128, 128, win0 + (size_t)C0_VB * 1024, 1024, NOGRP, 0);
    bf16* wout0 = (bf16*)(ws + W_OUT0);
    const float* evo = F.in[I_EV_WOUT];
    tconv(F, evo + (size_t)512 * 1024, 1024, 512, 1024, 1024, wout0 + 1024, 1536, NOGRP, 0);
    tconv(F, F.in[I_OD_WIN], ODD_COLS, 1024, ODD_COLS, 2048, (bf16*)(ws + W_IN1), 1024, NOGRP, 0);
    tconv(F, F.in[I_OD_WOUT], 1024, 1024, 1024, 1024, (bf16*)(ws + W_OUT1), 1024, NOGRP, 0);
    for (int i = 0; i < 2; ++i) {
        tconv(F, F.in[I_XA_WQ] + (size_t)i * 1024 * 512, 512, 1024, 512, 512, (bf16*)(ws + W_XQ) + (size_t)i * 512 * 1024, 1024, NOGRP, 0);
        tconv(F, F.in[I_XA_WK] + (size_t)i * 1024 * 512, 512, 1024, 512, 512, (bf16*)(ws + W_XKV) + (size_t)i * 1024 * 1024, 1024, NOGRP, 0);
        tconv(F, F.in[I_XA_WV] + (size_t)i * 1024 * 512, 512, 1024, 512, 512, (bf16*)(ws + W_XKV) + (size_t)i * 1024 * 1024 + (size_t)512 * 1024, 1024, NOGRP, 0);
        tconv(F, F.in[I_XA_WO] + (size_t)i * 512 * 1024, 1024, 512, 1024, 1024, (bf16*)(ws + W_XO) + (size_t)i * 1024 * 512, 512, NOGRP, 0);
    }
    tconv(F, F.in[I_FF_G], DFF, 1024, DFF, DFF, (bf16*)(ws + W_FGU), 1024, 128, 256);
    tconv(F, F.in[I_FF_U], DFF, 1024, DFF, DFF, (bf16*)(ws + W_FGU) + (size_t)128 * 1024, 1024, 128, 256);
    tconv(F, F.in[I_FF_D], 1024, DFF, 1024, 1024, (bf16*)(ws + W_FD), DFF, NOGRP, 0);
    for (int e = 0; e < NE; ++e) {
        tconv(F, F.in[I_MOE_G] + (size_t)e * 1024 * DFFE, DFFE, 1024, DFFE, DFFE, (bf16*)(ws + W_MGU) + (size_t)e * 7168 * 1024, 1024, 128, 256);
        tconv(F, F.in[I_MOE_U] + (size_t)e * 1024 * DFFE, DFFE, 1024, DFFE, DFFE, (bf16*)(ws + W_MGU) + (size_t)e * 7168 * 1024 + (size_t)128 * 1024, 1024, 128, 256);
        tconv(F, F.in[I_MOE_D] + (size_t)e * DFFE * 1024, 1024, DFFE, 1024, 1024, (bf16*)(ws + W_MD) + (size_t)e * 1024 * DFFE, DFFE, NOGRP, 0);
    }
    __syncthreads();
    {
        const float* wuk = F.in[I_EV_WUK]; const float* wuv = F.in[I_EV_WUV];
        LAS float* As = (LAS float*)F.lds; LAS float* Bs = As + 128 * 65;
        for (int item = blockIdx.x; item < 256; item += F.G) {
            const int h = (item >> 4) & 7, tt = item & 15;
            if (item < 128) {
                const int k0 = 64 * tt;
                for (int i = F.tid; i < 4096; i += 512) { const int kk = i >> 6, d = i & 63; As[kk * 65 + d] = evw[(size_t)(k0 + kk) * EVEN_COLS + h * 64 + d]; }
                for (int i = F.tid; i < 8192; i += 512) Bs[i] = wuk[(size_t)h * 8192 + i];
                __syncthreads();
                const int kk = F.tid & 63, cg = F.tid >> 6; float acc[16];
#pragma unroll
                for (int j = 0; j < 16; ++j) acc[j] = 0.f;
#pragma unroll 4
                for (int d = 0; d < 64; ++d) { const float a = As[kk * 65 + d];
#pragma unroll
                    for (int j = 0; j < 16; ++j) acc[j] += a * Bs[d * 128 + cg * 16 + j]; }
#pragma unroll
                for (int j = 0; j < 16; ++j) win0[(size_t)(C0_QLAT + h * 128 + cg * 16 + j) * 1024 + k0 + kk] = (bf16)f2bf(acc[j]);
            } else {
                const int n0 = 64 * tt;
                for (int i = F.tid; i < 8192; i += 512) { const int c = i >> 6, d = i & 63; As[c * 65 + d] = wuv[(size_t)h * 8192 + i]; }
                for (int i = F.tid; i < 4096; i += 512) { const int d = i >> 6, nn = i & 63; Bs[i] = evo[(size_t)(h * 64 + d) * 1024 + n0 + nn]; }
                __syncthreads();
                const int c = F.tid & 127, ng = F.tid >> 7; float acc[16];
#pragma unroll
                for (int j = 0; j < 16; ++j) acc[j] = 0.f;
#pragma unroll 4
                for (int d = 0; d < 64; ++d) { const float a = As[c * 65 + d];
#pragma unroll
                    for (int j = 0; j < 16; ++j) acc[j] += a * Bs[d * 64 + ng * 16 + j]; }
#pragma unroll
                for (int j = 0; j < 16; ++j) wout0[(size_t)(n0 + ng * 16 + j) * 1536 + h * 128 + c] = (bf16)f2bf(acc[j]);
            }
            __syncthreads();
        }
    }
    {
        const f32x4* x4 = (const f32x4*)F.in[I_X]; v2u* hb = (v2u*)(ws + WS_HB);
        for (int i = gt; i < M * D / 4; i += 4 * NT) { f32x4 v[4];
#pragma unroll
            for (int j = 0; j < 4; ++j) v[j] = x4[i + j * NT];
#pragma unroll
            for (int j = 0; j < 4; ++j) { v2u o; o.x = pk2(v[j].x, v[j].y); o.y = pk2(v[j].z, v[j].w); hb[i + j * NT] = o; } }
        const f32x4* m4 = (const f32x4*)F.in[I_MEM]; v2u* mb = (v2u*)(ws + WS_MEMB);
        for (int i = gt; i < MMEM * D / 4; i += 4 * NT) { f32x4 v[4];
#pragma unroll
            for (int j = 0; j < 4; ++j) v[j] = m4[i + j * NT];
#pragma unroll
            for (int j = 0; j < 4; ++j) { v2u o; o.x = pk2(v[j].x, v[j].y); o.y = pk2(v[j].z, v[j].w); mb[i + j * NT] = o; } }
    }
}

template <int MODE>
__device__ __forceinline__ void ln_phase(const Frame& F, int li, const bf16* sumb) {
    const float* g = F.in[I_LN_G] + (size_t)li * D; const float* bb = F.in[I_LN_B] + (size_t)li * D;
    LAS int* lcnt = (LAS int*)F.lds;
    if (MODE == 1) { if (F.tid < 16) lcnt[F.tid] = 0; __syncthreads(); }
    f32x4 rw[MODE == 1 ? 32 : 1];
    if (MODE == 1) { const float* wr = F.in[I_MOE_R];
#pragma unroll
        for (int j = 0; j < 4; ++j)
#pragma unroll
            for (int i = 0; i < 4; ++i) { const int c = 4 * (F.lane + 64 * j) + i; rw[(4 * j + i) * 2] = *(const f32x4*)(wr + (size_t)c * 8); rw[(4 * j + i) * 2 + 1] = *(const f32x4*)(wr + (size_t)c * 8 + 4); } }
    for (int row = F.gw; row < M; row += F.NGW) {
        f32x4* p = (f32x4*)(F.acc + (size_t)row * D) + F.lane;
        f32x4 v[4]; float s = 0.f;
        if (MODE == 2) { const v2u* hp = (const v2u*)(F.ws + WS_HB + (size_t)row * D * 2) + F.lane;
#pragma unroll
            for (int j = 0; j < 4; ++j) { const v2u a = hp[64 * j]; v[j] = (f32x4){bflo(a.x), bfhi(a.x), bflo(a.y), bfhi(a.y)} * ALPHA; }
        } else { const v2u* sp = (const v2u*)(sumb + (size_t)row * D) + F.lane;
#pragma unroll
            for (int j = 0; j < 4; ++j) { const v2u a = sp[64 * j]; v[j] = (f32x4){bflo(a.x), bfhi(a.x), bflo(a.y), bfhi(a.y)}; } }
        if (MODE == 2) {
            const int p0 = ((const int*)(F.ws + WS_RTE))[2 * row], p1 = ((const int*)(F.ws + WS_RTE))[2 * row + 1]; const float w0 = ((const float*)(F.ws + WS_RTW))[2 * row], w1 = ((const float*)(F.ws + WS_RTW))[2 * row + 1];
            const v2u* y0 = (const v2u*)(F.ws + WS_PERMA + (size_t)p0 * D * 2) + F.lane; const v2u* y1 = (const v2u*)(F.ws + WS_PERMA + (size_t)p1 * D * 2) + F.lane;
#pragma unroll
            for (int j = 0; j < 4; ++j) { const v2u a = y0[64 * j], b = y1[64 * j];
                v[j].x += w0 * bflo(a.x) + w1 * bflo(b.x); v[j].y += w0 * bfhi(a.x) + w1 * bfhi(b.x); v[j].z += w0 * bflo(a.y) + w1 * bflo(b.y); v[j].w += w0 * bfhi(a.y) + w1 * bfhi(b.y); } }
#pragma unroll
        for (int j = 0; j < 4; ++j) s += (v[j].x + v[j].y) + (v[j].z + v[j].w);
        const float mean = wave_sum_fast(s) * (1.f / D); float s2 = 0.f;
#pragma unroll
        for (int j = 0; j < 4; ++j) { v[j] = v[j] - mean; s2 += (v[j].x * v[j].x + v[j].y * v[j].y) + (v[j].z * v[j].z + v[j].w * v[j].w); }
        const float rstd = 1.f / sqrtf(wave_sum_fast(s2) * (1.f / D) + LN_EPS);
#pragma unroll
        for (int j = 0; j < 4; ++j) { const f32x4 gg = ((const f32x4*)g)[F.lane + 64 * j], b4 = ((const f32x4*)bb)[F.lane + 64 * j]; v[j] = v[j] * rstd * gg + b4; }
        if (MODE == 2) {
#pragma unroll
            for (int j = 0; j < 4; ++j) p[64 * j] = v[j];
        } else {
            v2u* hb = (v2u*)(F.ws + WS_HB + (size_t)row * D * 2) + F.lane;
#pragma unroll
            for (int j = 0; j < 4; ++j) { v2u o; o.x = pk2(v[j].x, v[j].y); o.y = pk2(v[j].z, v[j].w); hb[64 * j] = o; }
        }
        if (MODE == 1) {
            float lg[8];
#pragma unroll
            for (int e = 0; e < 8; ++e) lg[e] = 0.f;
#pragma unroll
            for (int j = 0; j < 4; ++j)
#pragma unroll
                for (int i = 0; i < 4; ++i) { const f32x4 w0 = rw[(4 * j + i) * 2], w1 = rw[(4 * j + i) * 2 + 1]; const float y = v[j][i];
                    lg[0] += y * w0.x; lg[1] += y * w0.y; lg[2] += y * w0.z; lg[3] += y * w0.w; lg[4] += y * w1.x; lg[5] += y * w1.y; lg[6] += y * w1.z; lg[7] += y * w1.w; }
#pragma unroll
            for (int e = 0; e < 8; ++e) lg[e] = wave_sum_fast(lg[e]);
            int e0 = 0; float v0 = lg[0];
#pragma unroll
            for (int e = 1; e < 8; ++e) if (lg[e] > v0) { v0 = lg[e]; e0 = e; }
            int e1 = -1; float v1 = -3.0e38f;
#pragma unroll
            for (int e = 0; e < 8; ++e) if (e != e0 && lg[e] > v1) { v1 = lg[e]; e1 = e; }
            const float w0 = 1.f / (1.f + __expf(v1 - v0)), w1 = 1.f - w0;
            if (F.lane == 0) { int* rte = (int*)(F.ws + WS_RTE); float* rtw = (float*)(F.ws + WS_RTW); rte[2 * row] = e0; rte[2 * row + 1] = e1; rtw[2 * row] = w0; rtw[2 * row + 1] = w1;
                __hip_atomic_fetch_add(&lcnt[e0], 1, __ATOMIC_RELAXED, __HIP_MEMORY_SCOPE_WORKGROUP); __hip_atomic_fetch_add(&lcnt[8 + e1], 1, __ATOMIC_RELAXED, __HIP_MEMORY_SCOPE_WORKGROUP); }
        }
    }
    if (MODE == 1) { __syncthreads(); if (F.tid < 16) { const int c = lcnt[F.tid]; if (c) atomicAdd((unsigned*)(F.ws + WS_CTL) + CW_CNT + F.tid, (unsigned)c); } }
}

__device__ __forceinline__ void moe_dispatch(const Frame& F) {
    unsigned* ctl = (unsigned*)(F.ws + WS_CTL);
    int* tile_exp = (int*)(F.ws + WS_TILEEXP); int* rowtok = (int*)(F.ws + WS_ROWTOK); float* roww = (float*)(F.ws + WS_ROWW);
    LAS int* seg = (LAS int*)F.lds;
    if (F.tid == 0) { int run = 0;
#pragma unroll 1
        for (int sgi = 0; sgi < 16; ++sgi) { if ((sgi & 7) == 0) seg[32 + (sgi >> 3)] = run >> 8; seg[sgi] = run; const int c = (int)__hip_atomic_load(ctl + CW_CNT + sgi, __ATOMIC_RELAXED, __HIP_MEMORY_SCOPE_AGENT); seg[16 + sgi] = c; run += (c + 255) & ~255; }
        seg[34] = run >> 8; }
    __syncthreads();
    if (blockIdx.x == 0) {
#pragma unroll 1
        for (int sgi = 0; sgi < 16; ++sgi) { const int c = seg[16 + sgi], st = seg[sgi], en = st + ((c + 255) & ~255);
            for (int t = (st >> 8) + F.tid; t < (en >> 8); t += 512) tile_exp[t] = sgi & 7;
            for (int r = st + c + F.tid; r < en; r += 512) { rowtok[r] = -1; roww[r] = 0.f; } }
        if (F.tid < 3) tile_exp[512 + F.tid] = seg[32 + F.tid];
    }
    const int* rte = (const int*)(F.ws + WS_RTE); const float* rtw = (const float*)(F.ws + WS_RTW);
    LAS int* lcnt = seg + 64; LAS int* gb = seg + 96; LAS int* posl = seg + 128;
    for (int chunk = blockIdx.x; chunk < M / 128; chunk += F.G) {
        if (F.tid < 16) lcnt[F.tid] = 0;
        __syncthreads();
        const int tok = chunk * 128 + (F.tid & 127); int e0 = 0, e1 = 0, r0 = 0, r1 = 0;
        if (F.tid < 128) { e0 = rte[2 * tok]; e1 = rte[2 * tok + 1]; r0 = __hip_atomic_fetch_add(&lcnt[e0], 1, __ATOMIC_RELAXED, __HIP_MEMORY_SCOPE_WORKGROUP); r1 = __hip_atomic_fetch_add(&lcnt[8 + e1], 1, __ATOMIC_RELAXED, __HIP_MEMORY_SCOPE_WORKGROUP); }
        __syncthreads();
        if (F.tid < 16) { const int c = lcnt[F.tid]; gb[F.tid] = c ? (int)atomicAdd(ctl + CW_CUR + F.tid, (unsigned)c) : 0; }
        __syncthreads();
        if (F.tid < 128) { const int p0 = seg[e0] + gb[e0] + r0, p1 = seg[8 + e1] + gb[8 + e1] + r1; posl[2 * F.tid] = p0; posl[2 * F.tid + 1] = p1;
            ((int*)(F.ws + WS_RTE))[2 * tok] = p0; ((int*)(F.ws + WS_RTE))[2 * tok + 1] = p1; }
        __syncthreads();
#pragma unroll 1
        for (int i0 = 0; i0 < 16; i0 += 8) {
            v4u a[8], b[8];
#pragma unroll
            for (int k = 0; k < 8; ++k) { const v4u* src = (const v4u*)(F.ws + WS_HB + (size_t)(chunk * 128 + F.wave * 16 + i0 + k) * D * 2); a[k] = src[F.lane]; b[k] = src[F.lane + 64]; }
#pragma unroll
            for (int k = 0; k < 8; ++k) { const int p0 = posl[2 * (F.wave * 16 + i0 + k)], p1 = posl[2 * (F.wave * 16 + i0 + k) + 1];
                v4u* d0 = (v4u*)(F.ws + WS_PERMA + (size_t)p0 * D * 2); v4u* d1 = (v4u*)(F.ws + WS_PERMA + (size_t)p1 * D * 2);
                d0[F.lane] = a[k]; d0[F.lane + 64] = b[k]; d1[F.lane] = a[k]; d1[F.lane + 64] = b[k]; } }
        __syncthreads();
    }
    __syncthreads();
}

__device__ __forceinline__ void cn_phase(const Frame& F) {
    const bf16* P0 = (const bf16*)(F.ws + WS_P0); bf16* CN = (bf16*)(F.ws + WS_CN); const float* gain = F.in[I_EV_GAIN];
    const float g0 = gain[2 * F.lane], g1 = gain[2 * F.lane + 1];
    for (int row0 = F.gw * 8; row0 < M; row0 += F.NGW * 8) {
        unsigned w[8];
#pragma unroll
        for (int i = 0; i < 8; ++i) w[i] = *(const unsigned*)(P0 + (size_t)(row0 + i) * P0_LD + C0_CKV + 2 * F.lane);
#pragma unroll
        for (int i = 0; i < 8; ++i) { const float a = bflo(w[i]), b = bfhi(w[i]);
            const float ms = wave_sum_fast(a * a + b * b) * (1.f / 128.f); const float r = 1.f / sqrtf(ms + LN_EPS);
            *(unsigned*)(CN + (size_t)(row0 + i) * 128 + 2 * F.lane) = pk2(a * r * g0, b * r * g1); }
    }
}

__device__ __forceinline__ unsigned fkey(float x) { unsigned b = __builtin_bit_cast(unsigned, x); if (b == 0x80000000u) b = 0u; return (b & 0x80000000u) ? ~b : (b | 0x80000000u); }
__device__ __forceinline__ void idx_phase(const Frame& F) {
    const bf16* P0 = (const bf16*)(F.ws + WS_P0); unsigned* MASK = (unsigned*)(F.ws + WS_MASK);
    LAS float* qi_s = (LAS float*)F.lds; LAS float* wi_s = qi_s + 4096; LAS float* sc = wi_s + 64;
    for (int item = blockIdx.x; item < NB * (S / 8); item += F.G) {
        const int b = item / (S / 8), t0 = (item % (S / 8)) * 8;
        for (int i = F.tid; i < 4096; i += 512) { const int q = i >> 9, e = i & 511; qi_s[i] = bf2f(P0[(size_t)(b * S + t0 + q) * P0_LD + C0_QI + e]); }
        if (F.tid < 64) { const int q = F.tid >> 3, h = F.tid & 7; wi_s[F.tid] = bf2f(P0[(size_t)(b * S + t0 + q) * P0_LD + C0_WI + h]) * (0.35355339059f * 0.125f); }
        __syncthreads();
        const int nk = t0 + 8;
        for (int s = F.tid; s < nk; s += 512) {
            float kf[64]; const bf16* kr = P0 + (size_t)(b * S + s) * P0_LD + C0_KI;
#pragma unroll
            for (int j = 0; j < 8; ++j) ld8bf(kr + 8 * j, kf + 8 * j);
#pragma unroll 1
            for (int q = 0; q < 8; ++q) { float a = 0.f;
#pragma unroll 1
                for (int h = 0; h < 8; ++h) { const LAS float* qp = qi_s + q * 512 + h * 64; float dot = 0.f;
#pragma unroll
                    for (int d = 0; d < 64; ++d) dot += qp[d] * kf[d];
                    a += wi_s[q * 8 + h] * fmaxf(dot, 0.f); }
                sc[q * 2048 + s] = a; }
        }
        __syncthreads();
        {
            const int q = F.wave, t = t0 + q, n = t + 1, row = b * S + t; unsigned myword = 0u;
            if (n <= 256) { const int cb = n - 32 * F.lane; myword = cb >= 32 ? 0xffffffffu : (cb <= 0 ? 0u : ((1u << cb) - 1u)); }
            else {
                LAS unsigned* uk = (LAS unsigned*)(sc + q * 2048);
#pragma unroll 4
                for (int i = 0; i < 32; ++i) { const int s = F.lane + 64 * i; const unsigned k = (s < n) ? fkey(sc[q * 2048 + s]) : 0u; uk[s] = k; }
                LDS_WAIT();
                unsigned prefix = 0u;
#pragma unroll 1
                for (int bit = 31; bit >= 0; --bit) { const unsigned cand = prefix | (1u << bit); int c = 0;
#pragma unroll 8
                    for (int i = 0; i < 32; ++i) c += (uk[F.lane + 64 * i] >= cand) ? 1 : 0;
#pragma unroll
                    for (int o = 1; o < 64; o <<= 1) c += __shfl_xor(c, o);
                    if (c >= 256) prefix = cand; }
                int cgt = 0;
#pragma unroll 8
                for (int i = 0; i < 32; ++i) cgt += (uk[F.lane + 64 * i] > prefix) ? 1 : 0;
#pragma unroll
                for (int o = 1; o < 64; o <<= 1) cgt += __shfl_xor(cgt, o);
                const int need = 256 - cgt; int run = 0;
#pragma unroll 1
                for (int i = 0; i < 32; ++i) { const unsigned u = uk[F.lane + 64 * i]; const bool eq = (u == prefix); const unsigned long long em = __ballot(eq); const int rank = run + __popcll(em & ((1ull << F.lane) - 1ull));
                    const bool sel = (u > prefix) || (eq && rank < need); run += __popcll(em);
                    const unsigned long long sm = __ballot(sel);
                    if (F.lane == 2 * i) myword = (unsigned)sm; if (F.lane == 2 * i + 1) myword = (unsigned)(sm >> 32); }
            }
            MASK[(size_t)row * 64 + F.lane] = myword;
        }
        __syncthreads();
    }
}

__device__ __forceinline__ void dsa_phase(const Frame& F) {
    bf16* P0 = (bf16*)(F.ws + WS_P0); const bf16* CN = (const bf16*)(F.ws + WS_CN); const unsigned* MASK = (const unsigned*)(F.ws + WS_MASK); const float* rel = F.in[I_REL];
    LAS float* ql = (LAS float*)(F.lds + F.wave * 13312); LAS float* pl = ql + 1024; LAS int* idx = (LAS int*)(pl + 2048);
    for (int row = F.gw; row < M; row += F.NGW) {
        const int b = row / S, t = row % S;
        const unsigned w = MASK[(size_t)row * 64 + F.lane]; const int c = __popc(w);
        int incl = c;
#pragma unroll
        for (int o = 1; o < 64; o <<= 1) { const int v = __shfl_up(incl, o); if (F.lane >= o) incl += v; }
        const int total = __shfl(incl, 63); int pos = incl - c; unsigned ww = w;
        while (ww) { const int bit = __ffs(ww) - 1; idx[pos++] = 32 * F.lane + bit; ww &= ww - 1u; }
#pragma unroll
        for (int i = 0; i < 16; ++i) ql[F.lane + 64 * i] = bf2f(P0[(size_t)row * P0_LD + C0_QLAT + F.lane + 64 * i]);
        WAVE_SYNC();
        float lg[4][8]; bool val[4];
#pragma unroll
        for (int kk = 0; kk < 4; ++kk) { const int k = F.lane + 64 * kk; val[kk] = k < total; const int key = val[kk] ? idx[k] : 0;
            float a[8];
#pragma unroll
            for (int h = 0; h < 8; ++h) a[h] = 0.f;
            const bf16* cr = CN + (size_t)(b * S + key) * 128;
#pragma unroll 1
            for (int j = 0; j < 16; ++j) { float cv[8]; ld8bf(cr + 8 * j, cv);
#pragma unroll
                for (int h = 0; h < 8; ++h)
#pragma unroll
                    for (int i = 0; i < 8; ++i) a[h] += ql[h * 128 + 8 * j + i] * cv[i]; }
            const int bk = rel_bucket(t - key);
#pragma unroll
            for (int h = 0; h < 8; ++h) lg[kk][h] = val[kk] ? (a[h] * 0.125f + rel[bk * 16 + h]) : -1.0e30f;
        }
#pragma unroll
        for (int h = 0; h < 8; ++h) { float m = fmaxf(fmaxf(lg[0][h], lg[1][h]), fmaxf(lg[2][h], lg[3][h])); m = wave_max(m);
            float e[4], s = 0.f;
#pragma unroll
            for (int kk = 0; kk < 4; ++kk) { e[kk] = val[kk] ? __expf(lg[kk][h] - m) : 0.f; s += e[kk]; }
            s = wave_sum(s); const float inv = 1.f / s;
#pragma unroll
            for (int kk = 0; kk < 4; ++kk) pl[h * 256 + F.lane + 64 * kk] = e[kk] * inv; }
        WAVE_SYNC();
        float a0[8], a1[8];
#pragma unroll
        for (int h = 0; h < 8; ++h) { a0[h] = 0.f; a1[h] = 0.f; }
        for (int k = 0; k < total; ++k) { const int key = idx[k]; const unsigned pr = *(const unsigned*)(CN + (size_t)(b * S + key) * 128 + 2 * F.lane); const float vx = bflo(pr), vy = bfhi(pr);
#pragma unroll
            for (int h = 0; h < 8; ++h) { const float p = pl[h * 256 + k]; a0[h] += p * vx; a1[h] += p * vy; } }
#pragma unroll
        for (int h = 0; h < 8; ++h) *(unsigned*)(P0 + (size_t)row * P0_LD + C0_QLAT + h * 128 + 2 * F.lane) = pk2(a0[h], a1[h]);
        WAVE_SYNC();
    }
}

template <int W, int NH, int GRPSZ, bool SINK, bool NSA>
__device__ __forceinline__ void banded_phase(const Frame& F, bf16* P, int ld, int cq, int ck, int cv, int relc0) {
    const float* rel = F.in[I_REL]; const float* sinks = F.in[I_EV_SINK];
    const bf16* OC = (const bf16*)(F.ws + WS_OCMP); const bf16* OS = (const bf16*)(F.ws + WS_OSLC);
    constexpr int NTG = S / 64;
    for (int it = F.gw; it < NB * NH * NTG; it += F.NGW) {
        const int tg = it % NTG, h = (it / NTG) % NH, b = it / (NTG * NH);
        const int t = tg * 64 + F.lane, row = b * S + t, kvh = h / GRPSZ;
        float q[64], acc[64];
        { const bf16* qr = P + (size_t)row * ld + cq + h * 64;
#pragma unroll
          for (int j = 0; j < 8; ++j) ld8bf(qr + 8 * j, q + 8 * j); }
#pragma unroll
        for (int d = 0; d < 64; ++d) acc[d] = 0.f;
        float m = SINK ? sinks[h] : -1.0e30f, l = SINK ? 1.f : 0.f;
#pragma unroll 1
        for (int j = 0; j < W; ++j) { const int s = t - j;
            const float bias = rel[rel_bucket(j) * 16 + relc0 + h];
            if (s >= 0) { const bf16* kr = P + (size_t)(b * S + s) * ld + ck + kvh * 64; float dot = 0.f;
#pragma unroll
                for (int jj = 0; jj < 8; ++jj) { float kf[8]; ld8bf(kr + 8 * jj, kf);
#pragma unroll
                    for (int i = 0; i < 8; ++i) dot += q[8 * jj + i] * kf[i]; }
                const float lgt = dot * 0.125f + bias, mn = fmaxf(m, lgt), corr = __expf(m - mn), p = __expf(lgt - mn);
                l = l * corr + p; m = mn;
                const bf16* vr = P + (size_t)(b * S + s) * ld + cv + kvh * 64;
#pragma unroll
                for (int jj = 0; jj < 8; ++jj) { float vf[8]; ld8bf(vr + 8 * jj, vf);
#pragma unroll
                    for (int i = 0; i < 8; ++i) acc[8 * jj + i] = acc[8 * jj + i] * corr + p * vf[i]; } } }
        const float inv = 1.f / l;
        float g0 = 0.f, g1 = 0.f, g2 = 1.f;
        if (NSA) { const bf16* gr = P + (size_t)row * ld + C1_GL + h * 3; g0 = 1.f / (1.f + __expf(-bf2f(gr[0]))); g1 = 1.f / (1.f + __expf(-bf2f(gr[1]))); g2 = 1.f / (1.f + __expf(-bf2f(gr[2]))); }
        bf16* orow = P + (size_t)row * ld + cq + h * 64;
#pragma unroll
        for (int jj = 0; jj < 8; ++jj) { float o[8];
#pragma unroll
            for (int i = 0; i < 8; ++i) o[i] = acc[8 * jj + i] * inv;
            if (NSA) { float c8[8], s8[8]; ld8bf(OC + (size_t)row * D + h * 64 + 8 * jj, c8); ld8bf(OS + (size_t)row * D + h * 64 + 8 * jj, s8);
#pragma unroll
                for (int i = 0; i < 8; ++i) o[i] = g0 * c8[i] + g1 * s8[i] + g2 * o[i]; }
            v4u w; w.x = pk2(o[0], o[1]); w.y = pk2(o[2], o[3]); w.z = pk2(o[4], o[5]); w.w = pk2(o[6], o[7]);
            *(v4u*)(orow + 8 * jj) = w; }
    }
}

__device__ __forceinline__ void xattn_phase(const Frame& F, const bf16* Q, const bf16* KV, bf16* O) {
    for (int it = F.gw; it < NB * 4 * (S / 32); it += F.NGW) {
        const int tg = it % (S / 32), h = (it / (S / 32)) % 4, b = it / ((S / 32) * 4);
        const int tok = tg * 32 + (F.lane >> 1), half = F.lane & 1, row = b * S + tok;
        float q[64], acc[64];
        { const bf16* qr = Q + (size_t)row * 512 + h * 128 + half * 64;
#pragma unroll
          for (int j = 0; j < 8; ++j) ld8bf(qr + 8 * j, q + 8 * j); }
#pragma unroll
        for (int d = 0; d < 64; ++d) acc[d] = 0.f;
        float m = -1.0e30f, l = 0.f;
#pragma unroll 1
        for (int mm = 0; mm < MEML; ++mm) { const bf16* kr = KV + (size_t)(b * MEML + mm) * 1024 + h * 128 + half * 64; float dot = 0.f;
#pragma unroll
            for (int jj = 0; jj < 8; ++jj) { float kf[8]; ld8bf(kr + 8 * jj, kf);
#pragma unroll
                for (int i = 0; i < 8; ++i) dot += q[8 * jj + i] * kf[i]; }
            dot += __shfl_xor(dot, 1);
            const float lgt = dot * 0.08838834764831845f, mn = fmaxf(m, lgt), corr = __expf(m - mn), p = __expf(lgt - mn);
            l = l * corr + p; m = mn;
            const bf16* vr = kr + 512;
#pragma unroll
            for (int jj = 0; jj < 8; ++jj) { float vf[8]; ld8bf(vr + 8 * jj, vf);
#pragma unroll
                for (int i = 0; i < 8; ++i) acc[8 * jj + i] = acc[8 * jj + i] * corr + p * vf[i]; } }
        const float inv = 1.f / l; bf16* orow = O + (size_t)row * 512 + h * 128 + half * 64;
#pragma unroll
        for (int jj = 0; jj < 8; ++jj) { v4u w; w.x = pk2(acc[8 * jj] * inv, acc[8 * jj + 1] * inv); w.y = pk2(acc[8 * jj + 2] * inv, acc[8 * jj + 3] * inv); w.z = pk2(acc[8 * jj + 4] * inv, acc[8 * jj + 5] * inv); w.w = pk2(acc[8 * jj + 6] * inv, acc[8 * jj + 7] * inv);
            *(v4u*)(orow + 8 * jj) = w; }
    }
}

__device__ __forceinline__ float gelu_tanh(float x) { const float u = 0.7978845608028654f * (x + 0.044715f * x * x * x); return 0.5f * x * (1.f + tanhf(u)); }
__device__ __forceinline__ void cmp_mlp_phase(const Frame& F) {
    const bf16* P1 = (const bf16*)(F.ws + WS_P1);
    LAS float* blk = (LAS float*)F.lds; LAS float* part = blk + 2048; LAS float* hid = part + 512;
    for (int item = blockIdx.x; item < 2 * NB * NCMP * 2; item += F.G) {
        const int g = item & 1, n = (item >> 1) % NCMP, b = ((item >> 1) / NCMP) % NB, which = (item >> 1) / (NCMP * NB);
        const float* pe = which ? F.in[I_OD_PEV] : F.in[I_OD_PEK]; const float* w1 = which ? F.in[I_OD_W1V] : F.in[I_OD_W1K]; const float* w2 = which ? F.in[I_OD_W2V] : F.in[I_OD_W2K];
        bf16* outp = (bf16*)(F.ws + (which ? WS_VC : WS_KC)) + ((size_t)(b * 2 + g) * 128 + n) * 64;
        const int col0 = (which ? C1_VC : C1_KC) + g * 64;
        for (int i = F.tid; i < 2048; i += 512) { const int l = i >> 6, d = i & 63; blk[i] = bf2f(P1[(size_t)(b * S + 16 * n + l) * P1_LD + col0 + d]) + pe[i]; }
        __syncthreads();
        { const int j = F.tid & 127, pp = F.tid >> 7; float a = 0.f; const float* wp = w1 + (size_t)(pp * 512) * 128 + j; const LAS float* bp = blk + pp * 512;
#pragma unroll 8
          for (int kk = 0; kk < 512; ++kk) a += bp[kk] * wp[(size_t)kk * 128];
          part[F.tid] = a; }
        __syncthreads();
        if (F.tid < 128) hid[F.tid] = gelu_tanh((part[F.tid] + part[F.tid + 128]) + (part[F.tid + 256] + part[F.tid + 384]));
        __syncthreads();
        if (F.tid < 64) { float a = 0.f;
#pragma unroll 8
            for (int j = 0; j < 128; ++j) a += hid[j] * w2[j * 64 + F.tid];
            outp[F.tid] = (bf16)f2bf(a); if (n == NCMP - 1) outp[64 + F.tid] = 0; }
        __syncthreads();
    }
}

__device__ __forceinline__ void cmp_attn_phase(const Frame& F) {
    const bf16* P1 = (const bf16*)(F.ws + WS_P1); const float* KC = (const float*)(F.ws + WS_KC); const float* VC = (const float*)(F.ws + WS_VC);
    bf16* OC = (bf16*)(F.ws + WS_OCMP); unsigned* SELM = (unsigned*)(F.ws + WS_SELM); const float* rel = F.in[I_REL];
    LAS float* qs = (LAS float*)(F.lds + F.wave * 8192); LAS float* pl = qs + 512; LAS float* psum = pl + 1024;
    for (int it = F.gw; it < M * 2; it += F.NGW) {
        const int g = it & 1, row = it >> 1, b = row / S, t = row % S;
        const int nv = (t >= 31) ? ((t - 31) / 16 + 1) : 0;
#pragma unroll
        for (int i = 0; i < 8; ++i) qs[F.lane + 64 * i] = bf2f(P1[(size_t)row * P1_LD + C1_Q + g * 512 + F.lane + 64 * i]);
        WAVE_SYNC();
        float lg[2][8]; bool val[2];
#pragma unroll
        for (int kk = 0; kk < 2; ++kk) { const int n = F.lane + 64 * kk; val[kk] = n < nv; const int nn = val[kk] ? n : 0;
            const float* kr = KC + ((size_t)(b * NCMP + nn) * 2 + g) * 64; float a[8];
#pragma unroll
            for (int h = 0; h < 8; ++h) a[h] = 0.f;
#pragma unroll 1
            for (int j = 0; j < 16; ++j) { const f32x4 kv = *(const f32x4*)(kr + 4 * j);
#pragma unroll
                for (int h = 0; h < 8; ++h) a[h] += qs[h * 64 + 4 * j] * kv.x + qs[h * 64 + 4 * j + 1] * kv.y + qs[h * 64 + 4 * j + 2] * kv.z + qs[h * 64 + 4 * j + 3] * kv.w; }
            const int bk = rel_bucket(val[kk] ? (t - (16 * nn + 31)) : 0);
#pragma unroll
            for (int h = 0; h < 8; ++h) lg[kk][h] = val[kk] ? (a[h] * 0.125f + rel[bk * 16 + g * 8 + h]) : -1.0e30f; }
        float ps[2] = {0.f, 0.f};
#pragma unroll
        for (int h = 0; h < 8; ++h) { float m = wave_max(fmaxf(lg[0][h], lg[1][h]));
            float e0 = val[0] ? __expf(lg[0][h] - m) : 0.f, e1 = val[1] ? __expf(lg[1][h] - m) : 0.f;
            const float s = wave_sum(e0 + e1); const float inv = (nv > 0) ? 1.f / s : 0.f; e0 *= inv; e1 *= inv;
            pl[h * 128 + F.lane] = e0; pl[h * 128 + 64 + F.lane] = e1; ps[0] += e0; ps[1] += e1; }
        psum[F.lane] = ps[0]; psum[64 + F.lane] = ps[1];
        WAVE_SYNC();
        float scj = -3.0e38f; bool adm = false;
        if (F.lane < 32) { const int j = F.lane; float p = 0.f;
#pragma unroll
            for (int n = 4 * j - 1; n <= 4 * j + 3; ++n) if (n >= 0 && n < NCMP) p += psum[n];
            const int blkq = t >> 6; adm = (64 * j <= t); const bool forced = (j == 0) || (j == blkq) || (j == blkq - 1);
            scj = adm ? (p + (forced ? 1.0e6f : 0.f)) : -1.0e30f; }
        int rank = 0;
#pragma unroll 1
        for (int i = 0; i < 32; ++i) { const float si = __shfl(scj, i); rank += (si > scj || (si == scj && i < F.lane)) ? 1 : 0; }
        const unsigned long long sm = __ballot(F.lane < 32 && adm && rank < 8);
        if (F.lane == 0) SELM[(size_t)row * 2 + g] = (unsigned)sm;
        float o[8];
#pragma unroll
        for (int h = 0; h < 8; ++h) o[h] = 0.f;
        for (int n = 0; n < nv; ++n) { const float v = VC[((size_t)(b * NCMP + n) * 2 + g) * 64 + F.lane];
#pragma unroll
            for (int h = 0; h < 8; ++h) o[h] += pl[h * 128 + n] * v; }
#pragma unroll
        for (int h = 0; h < 8; ++h) OC[(size_t)row * D + (g * 8 + h) * 64 + F.lane] = (bf16)f2bf(o[h]);
        WAVE_SYNC();
    }
}

__device__ __forceinline__ void slc_attn_phase(const Frame& F) {
    const bf16* P1 = (const bf16*)(F.ws + WS_P1); const unsigned* SELM = (const unsigned*)(F.ws + WS_SELM); bf16* OS = (bf16*)(F.ws + WS_OSLC); const float* rel = F.in[I_REL];
    LAS float* qs = (LAS float*)(F.lds + F.wave * 4096); LAS float* pb = qs + 512;
    for (int it = F.gw; it < M * 2; it += F.NGW) {
        const int g = it & 1, row = it >> 1, b = row / S, t = row % S;
#pragma unroll
        for (int i = 0; i < 8; ++i) qs[F.lane + 64 * i] = bf2f(P1[(size_t)row * P1_LD + C1_Q + g * 512 + F.lane + 64 * i]);
        WAVE_SYNC();
        unsigned sel = SELM[(size_t)row * 2 + g];
        float m[8], l[8], acc[8];
#pragma unroll
        for (int h = 0; h < 8; ++h) { m[h] = -1.0e30f; l[h] = 0.f; acc[h] = 0.f; }
        while (sel) { const int jb = __ffs(sel) - 1; sel &= sel - 1u;
            const int kpos = 64 * jb + F.lane; const bool valid = kpos <= t;
            const bf16* kr = P1 + (size_t)(b * S + kpos) * P1_LD + C1_KS + g * 64; float a[8];
#pragma unroll
            for (int h = 0; h < 8; ++h) a[h] = 0.f;
#pragma unroll 1
            for (int j = 0; j < 8; ++j) { float kf[8]; ld8bf(kr + 8 * j, kf);
#pragma unroll
                for (int h = 0; h < 8; ++h)
#pragma unroll
                    for (int i = 0; i < 8; ++i) a[h] += qs[h * 64 + 8 * j + i] * kf[i]; }
            const int bk = rel_bucket(valid ? (t - kpos) : 0);
            float corr[8];
#pragma unroll
            for (int h = 0; h < 8; ++h) { const float lgt = valid ? (a[h] * 0.125f + rel[bk * 16 + g * 8 + h]) : -1.0e30f;
                const float bm = wave_max(lgt), mn = fmaxf(m[h], bm); corr[h] = __expf(m[h] - mn); const float p = valid ? __expf(lgt - mn) : 0.f;
                l[h] = l[h] * corr[h] + wave_sum(p); m[h] = mn; pb[h * 64 + F.lane] = p; }
            WAVE_SYNC();
            const bf16* vb = P1 + (size_t)(b * S + 64 * jb) * P1_LD + C1_VS + g * 64 + F.lane;
            float add[8];
#pragma unroll
            for (int h = 0; h < 8; ++h) add[h] = 0.f;
            for (int k = 0; k < 64; ++k) { const float v = bf2f(vb[(size_t)k * P1_LD]);
#pragma unroll
                for (int h = 0; h < 8; ++h) add[h] += pb[h * 64 + k] * v; }
#pragma unroll
            for (int h = 0; h < 8; ++h) acc[h] = acc[h] * corr[h] + add[h];
            WAVE_SYNC();
        }
#pragma unroll
        for (int h = 0; h < 8; ++h) OS[(size_t)row * D + (g * 8 + h) * 64 + F.lane] = (bf16)f2bf(acc[h] / l[h]);
    }
}

namespace fa {
typedef short bf16x8 __attribute__((ext_vector_type(8)));
typedef short bf16x4 __attribute__((ext_vector_type(4)));
typedef float f32x16 __attribute__((ext_vector_type(16)));
constexpr int VSTR = 68;
__device__ __forceinline__ float xhalf_max(float x) { const auto r = __builtin_amdgcn_permlane32_swap(__builtin_bit_cast(unsigned, x), __builtin_bit_cast(unsigned, x), false, false);
    return fmaxf(__builtin_bit_cast(float, (unsigned)r[0]), __builtin_bit_cast(float, (unsigned)r[1])); }
__device__ __forceinline__ float xhalf_sum(float x) { const auto r = __builtin_amdgcn_permlane32_swap(__builtin_bit_cast(unsigned, x), __builtin_bit_cast(unsigned, x), false, false);
    return __builtin_bit_cast(float, (unsigned)r[0]) + __builtin_bit_cast(float, (unsigned)r[1]); }
template <int HDK, int HDV> struct Geo { static constexpr int KSTR = HDK + 8, KBYTES = 64 * KSTR * 2, VBYTES = HDV * VSTR * 2, BUF = KBYTES + VBYTES; };
template <int HDK, int HDV, bool KV_SAME> struct Stage { v4u k[HDK / 64]; v4u v[KV_SAME ? 1 : HDV / 64]; };

template <int HDK, int HDV, bool KV_SAME, class P>
__device__ __forceinline__ void load_tile(Stage<HDK, HDV, KV_SAME>& st, const P& pol, int j, int tid) {
#pragma unroll
    for (int i = 0; i < HDK / 64; ++i) { const int c = tid + 512 * i, r = c / (HDK / 8), ch = c % (HDK / 8); st.k[i] = *(const v4u*)(pol.krow(j, r) + 8 * ch); }
    if (!KV_SAME) {
#pragma unroll
        for (int i = 0; i < HDV / 64; ++i) { const int c = tid + 512 * i, r = c / (HDV / 8), ch = c % (HDV / 8); st.v[i] = *(const v4u*)(pol.vrow(j, r) + 8 * ch); }
    }
}
template <int HDK, int HDV, bool KV_SAME>
__device__ __forceinline__ void store_tile(const Stage<HDK, HDV, KV_SAME>& st, LAS unsigned char* buf, int tid) {
    typedef Geo<HDK, HDV> G;
    LAS bf16* Ks = (LAS bf16*)buf; LAS bf16* Vt = (LAS bf16*)(buf + G::KBYTES);
#pragma unroll
    for (int i = 0; i < HDK / 64; ++i) { const int c = tid + 512 * i, r = c / (HDK / 8), ch = c % (HDK / 8); *(LAS v4u*)(Ks + r * G::KSTR + 8 * ch) = st.k[i]; }
#pragma unroll
    for (int i = 0; i < HDV / 64; ++i) { const int c = tid + 512 * i, r = c / (HDV / 8), ch = c % (HDV / 8); const v4u w = KV_SAME ? st.k[i] : st.v[i];
        LAS bf16* vp = Vt + (8 * ch) * VSTR + r;
        vp[0 * VSTR] = (bf16)(w.x & 0xffffu); vp[1 * VSTR] = (bf16)(w.x >> 16); vp[2 * VSTR] = (bf16)(w.y & 0xffffu); vp[3 * VSTR] = (bf16)(w.y >> 16);
        vp[4 * VSTR] = (bf16)(w.z & 0xffffu); vp[5 * VSTR] = (bf16)(w.z >> 16); vp[6 * VSTR] = (bf16)(w.w & 0xffffu); vp[7 * VSTR] = (bf16)(w.w >> 16); }
}
template <int HDK, int HDV, class P>
__device__ __forceinline__ void compute_tile(const LAS unsigned char* buf, const P& pol, int j, int lane, const bf16x8 (&qf)[HDK / 16], f32x16 (&o)[HDV / 32], float& m, float& l) {
    typedef Geo<HDK, HDV> G;
    const LAS bf16* Ks = (const LAS bf16*)buf; const LAS bf16* Vt = (const LAS bf16*)(buf + G::KBYTES);
    const int r = lane & 31, h = lane >> 5;
    f32x16 s[2];
#pragma unroll
    for (int kb = 0; kb < 2; ++kb) {
#pragma unroll
        for (int e = 0; e < 16; ++e) s[kb][e] = 0.f;
#pragma unroll
        for (int ks = 0; ks < HDK / 16; ++ks) { const bf16x8 a = *(const LAS bf16x8*)(Ks + (32 * kb + r) * G::KSTR + 16 * ks + 8 * h);
            s[kb] = __builtin_amdgcn_mfma_f32_32x32x16_bf16(a, qf[ks], s[kb], 0, 0, 0); }
        if (HDK > 64) __builtin_amdgcn_sched_barrier(0);
    }
    bf16x8 vf[HDV == 64 ? 8 : 1];
    if (HDV == 64) {
#pragma unroll
        for (int kb = 0; kb < 2; ++kb)
#pragma unroll
            for (int s2 = 0; s2 < 2; ++s2)
#pragma unroll
                for (int blk = 0; blk < 2; ++blk) { const LAS bf16* vp = Vt + (32 * blk + r) * VSTR + 32 * kb + 16 * s2 + 4 * h;
                    const bf16x4 lo = *(const LAS bf16x4*)vp, hi = *(const LAS bf16x4*)(vp + 8);
                    vf[HDV == 64 ? (kb * 4 + s2 * 2 + blk) : 0] = __builtin_shufflevector(lo, hi, 0, 1, 2, 3, 4, 5, 6, 7); }
    }
    float mref, mn, rs = 0.f;
    if (pol.fast(j)) {
        const float b2 = pol.lane_bias2(j), c2 = pol.c2;
        float mx = -INFINITY;
#pragma unroll
        for (int kb = 0; kb < 2; ++kb)
#pragma unroll
            for (int e = 0; e < 16; ++e) mx = fmaxf(mx, s[kb][e]);
        mx = fa::xhalf_max(mx);
        mn = fmaxf(m, mx * c2 + b2); mref = (mn == -INFINITY) ? 0.f : mn;
        const float off = b2 - mref;
#pragma unroll
        for (int kb = 0; kb < 2; ++kb)
#pragma unroll
            for (int e = 0; e < 16; ++e) { s[kb][e] = __builtin_amdgcn_exp2f(__builtin_fmaf(s[kb][e], c2, off)); rs += s[kb][e]; }
    } else {
        pol.transform(j, s, lane);
        float mx = -INFINITY;
#pragma unroll
        for (int kb = 0; kb < 2; ++kb)
#pragma unroll
            for (int e = 0; e < 16; ++e) mx = fmaxf(mx, s[kb][e]);
        mx = fa::xhalf_max(mx);
        mn = fmaxf(m, mx); mref = (mn == -INFINITY) ? 0.f : mn;
#pragma unroll
        for (int kb = 0; kb < 2; ++kb)
#pragma unroll
            for (int e = 0; e < 16; ++e) { s[kb][e] = __builtin_amdgcn_exp2f(s[kb][e] - mref); rs += s[kb][e]; }
    }
    rs = fa::xhalf_sum(rs);
    const float corr = __builtin_amdgcn_exp2f(m - mref);
    m = mn;
    if (__any(corr != 1.f)) {
        l = l * corr + rs;
#pragma unroll
        for (int blk = 0; blk < HDV / 32; ++blk)
#pragma unroll
            for (int e = 0; e < 16; ++e) o[blk][e] *= corr;
    } else l += rs;
#pragma unroll
    for (int kb = 0; kb < 2; ++kb)
#pragma unroll
        for (int s2 = 0; s2 < 2; ++s2) {
            v4u pw; pw.x = pg8::cvt_pk_bf16(s[kb][8 * s2 + 0], s[kb][8 * s2 + 1]); pw.y = pg8::cvt_pk_bf16(s[kb][8 * s2 + 2], s[kb][8 * s2 + 3]);
            pw.z = pg8::cvt_pk_bf16(s[kb][8 * s2 + 4], s[kb][8 * s2 + 5]); pw.w = pg8::cvt_pk_bf16(s[kb][8 * s2 + 6], s[kb][8 * s2 + 7]);
            const bf16x8 pf = __builtin_bit_cast(bf16x8, pw);
#pragma unroll
            for (int blk = 0; blk < HDV / 32; ++blk) {
                bf16x8 a;
                if (HDV == 64) a = vf[HDV == 64 ? (kb * 4 + s2 * 2 + blk) : 0];
                else { const LAS bf16* vp = Vt + (32 * blk + r) * VSTR + 32 * kb + 16 * s2 + 4 * h;
                    const bf16x4 lo = *(const LAS bf16x4*)vp, hi = *(const LAS bf16x4*)(vp + 8);
                    a = __builtin_shufflevector(lo, hi, 0, 1, 2, 3, 4, 5, 6, 7); }
                o[blk] = __builtin_amdgcn_mfma_f32_32x32x16_bf16(a, pf, o[blk], 0, 0, 0); }
            if (HDV > 64) __builtin_amdgcn_sched_barrier(0);
        }
}
template <int HDK, int HDV, bool KV_SAME, class P>
__device__ __forceinline__ void run(LAS unsigned char* lds, P& pol, unsigned tmask, int tid, int lane, const bf16x8 (&qf)[HDK / 16], f32x16 (&o)[HDV / 32], float& m, float& l) {
    typedef Geo<HDK, HDV> G;
    if (tmask == 0u) return;
    Stage<HDK, HDV, KV_SAME> sa, sb;
    int j0 = __builtin_ctz(tmask); tmask &= tmask - 1u;
    pol.prefetch(j0); pol.advance();
    load_tile<HDK, HDV, KV_SAME>(sa, pol, j0, tid);
    int j1 = -1; if (tmask) { j1 = __builtin_ctz(tmask); tmask &= tmask - 1u; load_tile<HDK, HDV, KV_SAME>(sb, pol, j1, tid); pol.prefetch(j1); }
    store_tile<HDK, HDV, KV_SAME>(sa, lds, tid);
    __syncthreads();
    int cur = 0;
    for (;;) {
        PROBE_START(4, tid);
        int j2 = -1; if (tmask) { j2 = __builtin_ctz(tmask); tmask &= tmask - 1u; load_tile<HDK, HDV, KV_SAME>(sa, pol, j2, tid); }
        PROBE_STOP(4, tid); PROBE_START(2, tid);
        compute_tile<HDK, HDV>(lds + cur * G::BUF, pol, j0, lane, qf, o, m, l);
        PROBE_STOP(2, tid);
        if (j1 < 0) break;
        PROBE_START(3, tid);
        store_tile<HDK, HDV, KV_SAME>(sb, lds + (cur ^ 1) * G::BUF, tid);
        pol.advance(); if (j2 >= 0) pol.prefetch(j2);
        PROBE_STOP(3, tid); PROBE_START(5, tid);
        __syncthreads(); cur ^= 1;
        PROBE_STOP(5, tid); PROBE_START(4, tid);
        int j3 = -1; if (tmask) { j3 = __builtin_ctz(tmask); tmask &= tmask - 1u; load_tile<HDK, HDV, KV_SAME>(sb, pol, j3, tid); }
        PROBE_STOP(4, tid); PROBE_START(2, tid);
        compute_tile<HDK, HDV>(lds + cur * G::BUF, pol, j1, lane, qf, o, m, l);
        PROBE_STOP(2, tid);
        if (j2 < 0) break;
        PROBE_START(3, tid);
        store_tile<HDK, HDV, KV_SAME>(sa, lds + (cur ^ 1) * G::BUF, tid);
        pol.advance(); if (j3 >= 0) pol.prefetch(j3);
        PROBE_STOP(3, tid); PROBE_START(5, tid);
        __syncthreads(); cur ^= 1;
        PROBE_STOP(5, tid);
        j0 = j2; j1 = j3;
    }
    __syncthreads();
}
template <int HDK, int HDV, bool KV_SAME, class P>
__device__ __forceinline__ void run1(LAS unsigned char* lds, P& pol, unsigned tmask, int tid, int lane, const bf16x8 (&qf)[HDK / 16], f32x16 (&o)[HDV / 32], float& m, float& l) {
    typedef Geo<HDK, HDV> G;
    if (tmask == 0u) return;
    Stage<HDK, HDV, KV_SAME> st;
    int j = __builtin_ctz(tmask); tmask &= tmask - 1u; int cur = 0;
    pol.prefetch(j); pol.advance();
    load_tile<HDK, HDV, KV_SAME>(st, pol, j, tid); store_tile<HDK, HDV, KV_SAME>(st, lds, tid);
    __syncthreads();
    for (;;) {
        const bool more = tmask != 0u; int jn = 0;
        if (more) { jn = __builtin_ctz(tmask); tmask &= tmask - 1u; load_tile<HDK, HDV, KV_SAME>(st, pol, jn, tid); pol.prefetch(jn); }
        compute_tile<HDK, HDV>(lds + cur * G::BUF, pol, j, lane, qf, o, m, l);
        if (!more) break;
        store_tile<HDK, HDV, KV_SAME>(st, lds + (cur ^ 1) * G::BUF, tid);
        pol.advance();
        __syncthreads();
        cur ^= 1; j = jn;
    }
    __syncthreads();
}
}

__device__ __forceinline__ void build_bias_table(const Frame& F, LAS float* tab, int nheads, int relc0) {
    const float* rel = F.in[I_REL];
    for (int i = F.tid; i < nheads * 129; i += 512) { const int hh = i / 129, d = i % 129; tab[hh * 132 + d] = rel[rel_bucket(d) * 16 + relc0 + hh] * 1.4426950408889634f; }
    __syncthreads();
}
struct BandPol {
    __device__ __forceinline__ void prefetch(int) {} __device__ __forceinline__ void advance() {}
    const bf16* kbase; const bf16* vbase; int ld; int tq, tq0, W; const LAS float* bl;
    static constexpr float c2 = 0.125f * 1.4426950408889634f;
    __device__ __forceinline__ const bf16* krow(int j, int r) const { return kbase + (size_t)(64 * j + r) * ld; }
    __device__ __forceinline__ const bf16* vrow(int j, int r) const { return vbase + (size_t)(64 * j + r) * ld; }
    __device__ __forceinline__ bool fast(int j) const { const int k0 = 64 * j; return tq0 - (k0 + 63) >= 128 && (tq0 + 31) - k0 < W; }
    __device__ __forceinline__ float lane_bias2(int) const { return bl[128]; }
    __device__ __forceinline__ void transform(int j, fa::f32x16 (&s)[2], int lane) const {
        const int k0 = 64 * j, h = lane >> 5;
        if (tq0 - (k0 + 63) >= 128) {
            const float b31 = bl[128]; const int dbase = tq - k0 - 4 * h;
#pragma unroll
            for (int kb = 0; kb < 2; ++kb)
#pragma unroll
                for (int e = 0; e < 16; ++e) { const int dist = dbase - (32 * kb + 8 * (e >> 2) + (e & 3)); s[kb][e] = (dist < W) ? __builtin_fmaf(s[kb][e], c2, b31) : -INFINITY; }
        } else {
#pragma unroll
            for (int kb = 0; kb < 2; ++kb)
#pragma unroll
                for (int e = 0; e < 16; ++e) { const int key = k0 + 32 * kb + 8 * (e >> 2) + 4 * h + (e & 3); const int dist = tq - key;
                    const int di = dist < 0 ? 0 : (dist > 128 ? 128 : dist);
                    const float v = __builtin_fmaf(s[kb][e], c2, bl[di]);
                    s[kb][e] = (dist >= 0 && dist < W) ? v : -INFINITY; }
        }
    }
};
__device__ __forceinline__ void win_phase_mfma(const Frame& F) {
    bf16* P1 = (bf16*)(F.ws + WS_P1); const bf16* OC = (const bf16*)(F.ws + WS_OCMP); const bf16* OS = (const bf16*)(F.ws + WS_OSLC);
    LAS float* tab = (LAS float*)(F.lds + 36864);
    build_bias_table(F, tab, 16, 0);
    const int h = F.lane >> 5;
    for (int u = blockIdx.x; u < NB * 2 * 64; u += F.G) {
        const int rr_ = u / F.G, c_ = u % F.G; const int qt = (rr_ & 1) ? 63 - (c_ & 63) : (c_ & 63), bg = (rr_ * (F.G >> 6) + (c_ >> 6)) % (NB * 2), b = bg >> 1, g = bg & 1;
        const int tq0 = 32 * qt, head = g * 8 + F.wave, tq = tq0 + (F.lane & 31);
        const size_t row = (size_t)b * S + tq;
        fa::bf16x8 qf[4];
#pragma unroll
        for (int ks = 0; ks < 4; ++ks) qf[ks] = *(const fa::bf16x8*)(P1 + row * P1_LD + C1_Q + head * 64 + 16 * ks + 8 * h);
        fa::f32x16 o[2];
#pragma unroll
        for (int blk = 0; blk < 2; ++blk)
#pragma unroll
            for (int e = 0; e < 16; ++e) o[blk][e] = 0.f;
        float m = -INFINITY, l = 0.f;
        const int jlo = (tq0 - 511 > 0 ? tq0 - 511 : 0) >> 6, jhi = (tq0 + 31) >> 6;
        const unsigned tmask = (jhi >= 31 ? 0xffffffffu : ((1u << (jhi + 1)) - 1u)) & ~((1u << jlo) - 1u);
        BandPol pol{P1 + (size_t)b * S * P1_LD + C1_KW + g * 64, P1 + (size_t)b * S * P1_LD + C1_VW + g * 64, P1_LD, tq, tq0, 512, tab + head * 132};
        fa::run<64, 64, false>(F.lds, pol, tmask, F.tid, F.lane, qf, o, m, l);
        const float inv = 1.f / l;
        const bf16* gr = P1 + row * P1_LD + C1_GL + head * 3;
        const float g0 = 1.f / (1.f + __expf(-bf2f(gr[0]))), g1 = 1.f / (1.f + __expf(-bf2f(gr[1]))), g2 = 1.f / (1.f + __expf(-bf2f(gr[2])));
#pragma unroll
        for (int blk = 0; blk < 2; ++blk)
#pragma unroll
            for (int jj = 0; jj < 4; ++jj) { const int d0 = 32 * blk + 8 * jj + 4 * h;
                const v2u cw = *(const v2u*)(OC + row * D + head * 64 + d0), sw = *(const v2u*)(OS + row * D + head * 64 + d0);
                const float r0 = g0 * bflo(cw.x) + g1 * bflo(sw.x) + g2 * o[blk][4 * jj + 0] * inv, r1 = g0 * bfhi(cw.x) + g1 * bfhi(sw.x) + g2 * o[blk][4 * jj + 1] * inv;
                const float r2 = g0 * bflo(cw.y) + g1 * bflo(sw.y) + g2 * o[blk][4 * jj + 2] * inv, r3 = g0 * bfhi(cw.y) + g1 * bfhi(sw.y) + g2 * o[blk][4 * jj + 3] * inv;
                v2u ow; ow.x = pk2(r0, r1); ow.y = pk2(r2, r3);
                *(v2u*)(P1 + row * P1_LD + C1_Q + head * 64 + d0) = ow; }
    }
}
__device__ __forceinline__ void swa_phase_mfma(const Frame& F) {
    bf16* P0 = (bf16*)(F.ws + WS_P0); const float* sinks = F.in[I_EV_SINK];
    LAS float* tab = (LAS float*)(F.lds + 36864);
    build_bias_table(F, tab, 8, 8);
    const int h = F.lane >> 5;
    for (int u = blockIdx.x; u < NB * 2 * 32; u += F.G) {
        const int b = u >> 6, kvh = (u >> 5) & 1, t0 = 64 * (u & 31), head = kvh * 4 + (F.wave & 3), tq0 = t0 + 32 * (F.wave >> 2), tq = tq0 + (F.lane & 31);
        const size_t row = (size_t)b * S + tq;
        fa::bf16x8 qf[4];
#pragma unroll
        for (int ks = 0; ks < 4; ++ks) qf[ks] = *(const fa::bf16x8*)(P0 + row * P0_LD + C0_QB + head * 64 + 16 * ks + 8 * h);
        fa::f32x16 o[2];
#pragma unroll
        for (int blk = 0; blk < 2; ++blk)
#pragma unroll
            for (int e = 0; e < 16; ++e) o[blk][e] = 0.f;
        float m = sinks[head] * 1.4426950408889634f, l = 1.f;
        const int jlo = (t0 - 127 > 0 ? t0 - 127 : 0) >> 6, jhi = t0 >> 6;
        const unsigned tmask = (jhi >= 31 ? 0xffffffffu : ((1u << (jhi + 1)) - 1u)) & ~((1u << jlo) - 1u);
        BandPol pol{P0 + (size_t)b * S * P0_LD + C0_KB + kvh * 64, P0 + (size_t)b * S * P0_LD + C0_VB + kvh * 64, P0_LD, tq, tq0, 128, tab + head * 132};
        fa::run<64, 64, false>(F.lds, pol, tmask, F.tid, F.lane, qf, o, m, l);
        const float inv = 1.f / l;
#pragma unroll
        for (int blk = 0; blk < 2; ++blk)
#pragma unroll
            for (int jj = 0; jj < 4; ++jj) { const int d0 = 32 * blk + 8 * jj + 4 * h;
                v2u ow; ow.x = pk2(o[blk][4 * jj + 0] * inv, o[blk][4 * jj + 1] * inv); ow.y = pk2(o[blk][4 * jj + 2] * inv, o[blk][4 * jj + 3] * inv);
                *(v2u*)(P0 + row * P0_LD + C0_QB + head * 64 + d0) = ow; }
    }
}

struct XaPol {
    __device__ __forceinline__ void prefetch(int) {} __device__ __forceinline__ void advance() {}
    const bf16* kbase;
    static constexpr float c2 = 0.08838834764831845f * 1.4426950408889634f;
    __device__ __forceinline__ const bf16* krow(int j, int r) const { return kbase + (size_t)(64 * j + r) * 1024; }
    __device__ __forceinline__ const bf16* vrow(int j, int r) const { return kbase + (size_t)(64 * j + r) * 1024 + 512; }
    __device__ __forceinline__ bool fast(int) const { return true; }
    __device__ __forceinline__ float lane_bias2(int) const { return 0.f; }
    __device__ __forceinline__ void transform(int, fa::f32x16 (&)[2], int) const {}
};
__device__ __forceinline__ void xattn_phase_mfma(const Frame& F, const bf16* Q, const bf16* KV, bf16* O) {
    const int h = F.lane >> 5;
    for (int u2 = 2 * blockIdx.x; u2 < NB * 4 * 8; u2 += 2 * F.G)
    for (int hp = 0; hp < 2; ++hp) {
        int pm, pn; pg8::tile_of(u2 >> 1, M / 256, 2, pm, pn);
        const int b = pm >> 3, qt = pm & 7, head = 2 * pn + hp, tq = 256 * qt + 32 * F.wave + (F.lane & 31);
        const size_t row = (size_t)b * S + tq;
        fa::bf16x8 qf[8];
#pragma unroll
        for (int ks = 0; ks < 8; ++ks) qf[ks] = *(const fa::bf16x8*)(Q + row * 512 + head * 128 + 16 * ks + 8 * h);
        fa::f32x16 o[4];
#pragma unroll
        for (int blk = 0; blk < 4; ++blk)
#pragma unroll
            for (int e = 0; e < 16; ++e) o[blk][e] = 0.f;
        float m = -INFINITY, l = 0.f;
        XaPol pol{KV + (size_t)b * MEML * 1024 + head * 128};
        fa::run<128, 128, false>(F.lds, pol, 0xFu, F.tid, F.lane, qf, o, m, l);
        const float inv = 1.f / l;
#pragma unroll
        for (int blk = 0; blk < 4; ++blk)
#pragma unroll
            for (int jj = 0; jj < 4; ++jj) { const int d0 = 32 * blk + 8 * jj + 4 * h;
                v2u ow; ow.x = pk2(o[blk][4 * jj + 0] * inv, o[blk][4 * jj + 1] * inv); ow.y = pk2(o[blk][4 * jj + 2] * inv, o[blk][4 * jj + 3] * inv);
                *(v2u*)(O + row * 512 + head * 128 + d0) = ow; }
    }
}
struct DsaPol {
    const bf16* cbase; const unsigned* mrow; int tq, tq0; const LAS float* bl; v2u mwc, mwn;
    static constexpr float c2 = 0.125f * 1.4426950408889634f;
    __device__ __forceinline__ const bf16* krow(int j, int r) const { return cbase + (size_t)(64 * j + r) * 128; }
    __device__ __forceinline__ const bf16* vrow(int j, int r) const { return krow(j, r); }
    __device__ __forceinline__ bool fast(int) const { return false; }
    __device__ __forceinline__ float lane_bias2(int) const { return 0.f; }
    __device__ __forceinline__ void prefetch(int j) { mwn = *(const v2u*)(mrow + 2 * j); }
    __device__ __forceinline__ void advance() { mwc = mwn; }
    __device__ __forceinline__ void transform(int j, fa::f32x16 (&s)[2], int lane) const {
        const int k0 = 64 * j, h = lane >> 5;
#pragma unroll
        for (int kb = 0; kb < 2; ++kb) { const unsigned w = (kb ? mwc.y : mwc.x) >> (4 * h);
#pragma unroll
            for (int e = 0; e < 16; ++e) { const int bit = 8 * (e >> 2) + (e & 3); const int kin = bit + 4 * h; const int dist = tq - (k0 + 32 * kb + kin);
                const int di = dist < 0 ? 0 : (dist > 128 ? 128 : dist); const int mm = ((int)(w << (31 - bit))) >> 31;
                const unsigned vb = __builtin_bit_cast(unsigned, __builtin_fmaf(s[kb][e], c2, bl[di]));
                s[kb][e] = __builtin_bit_cast(float, (vb & (unsigned)mm) | (0xff800000u & ~(unsigned)mm)); } }
    }
};
__device__ __forceinline__ void dsa_phase_mfma(const Frame& F) {
    bf16* P0 = (bf16*)(F.ws + WS_P0); const bf16* CN = (const bf16*)(F.ws + WS_CN); const unsigned* MASK = (const unsigned*)(F.ws + WS_MASK);
    LAS float* tab = (LAS float*)(F.lds + 73728);
    build_bias_table(F, tab, 8, 0);
    const int h = F.lane >> 5;
    for (int u = blockIdx.x; u < NB * 64; u += F.G) {
        const int rr = u / F.G, c = u % F.G; const int qt = (rr & 1) ? 63 - (c & 63) : (c & 63), b = (rr * (F.G >> 6) + (c >> 6)) % NB;
        const int tq0 = 32 * qt, tq = tq0 + (F.lane & 31), head = F.wave;
        const size_t row = (size_t)b * S + tq;
        fa::bf16x8 qf[8];
#pragma unroll
        for (int ks = 0; ks < 8; ++ks) qf[ks] = *(const fa::bf16x8*)(P0 + row * P0_LD + C0_QLAT + head * 128 + 16 * ks + 8 * h);
        fa::f32x16 o[4];
#pragma unroll
        for (int blk = 0; blk < 4; ++blk)
#pragma unroll
            for (int e = 0; e < 16; ++e) o[blk][e] = 0.f;
        float m = -INFINITY, l = 0.f;
        const int jhi = (tq0 + 31) >> 6; const unsigned tmask = jhi >= 31 ? 0xffffffffu : ((1u << (jhi + 1)) - 1u);
        DsaPol pol{CN + (size_t)b * S * 128, MASK + row * 64, tq, tq0, tab + head * 132, (v2u){0u, 0u}, (v2u){0u, 0u}};
        fa::run1<128, 128, true>(F.lds, pol, tmask, F.tid, F.lane, qf, o, m, l);
        const float inv = 1.f / l;
#pragma unroll
        for (int blk = 0; blk < 4; ++blk)
#pragma unroll
            for (int jj = 0; jj < 4; ++jj) { const int d0 = 32 * blk + 8 * jj + 4 * h;
                v2u ow; ow.x = pk2(o[blk][4 * jj + 0] * inv, o[blk][4 * jj + 1] * inv); ow.y = pk2(o[blk][4 * jj + 2] * inv, o[blk][4 * jj + 3] * inv);
                *(v2u*)(P0 + row * P0_LD + C0_QLAT + head * 128 + d0) = ow; }
    }
}
struct SlcPol {
    __device__ __forceinline__ void prefetch(int) {} __device__ __forceinline__ void advance() {}
    const bf16* kbase; const bf16* vbase; unsigned sel; int tq, tq0; const LAS float* bl;
    static constexpr float c2 = 0.125f * 1.4426950408889634f;
    __device__ __forceinline__ const bf16* krow(int j, int r) const { return kbase + (size_t)(64 * j + r) * P1_LD; }
    __device__ __forceinline__ const bf16* vrow(int j, int r) const { return vbase + (size_t)(64 * j + r) * P1_LD; }
    __device__ __forceinline__ bool fast(int j) const { return tq0 - (64 * j + 63) >= 128; }
    __device__ __forceinline__ float lane_bias2(int j) const { return ((sel >> j) & 1u) ? bl[128] : -INFINITY; }
    __device__ __forceinline__ void transform(int j, fa::f32x16 (&s)[2], int lane) const {
        const int k0 = 64 * j, h = lane >> 5; const bool on = (sel >> j) & 1u;
#pragma unroll
        for (int kb = 0; kb < 2; ++kb)
#pragma unroll
            for (int e = 0; e < 16; ++e) { const int dist = tq - (k0 + 32 * kb + 8 * (e >> 2) + 4 * h + (e & 3));
                const int di = dist < 0 ? 0 : (dist > 128 ? 128 : dist);
                const float v = __builtin_fmaf(s[kb][e], c2, bl[di]);
                s[kb][e] = (on && dist >= 0) ? v : -INFINITY; }
    }
};
__device__ __forceinline__ void slc_phase_mfma(const Frame& F) {
    const bf16* P1 = (const bf16*)(F.ws + WS_P1); const unsigned* SELM = (const unsigned*)(F.ws + WS_SELM); bf16* OS = (bf16*)(F.ws + WS_OSLC);
    LAS float* tab = (LAS float*)(F.lds + 36864);
    build_bias_table(F, tab, 16, 0);
    const int h = F.lane >> 5;
    for (int u = blockIdx.x; u < NB * 2 * 64; u += F.G) {
        const int rr = u / F.G, c = u % F.G; const int qt = (rr & 1) ? 63 - (c & 63) : (c & 63), bg = (rr * (F.G >> 6) + (c >> 6)) % (NB * 2), b = bg >> 1, g = bg & 1;
        const int tq0 = 32 * qt, tq = tq0 + (F.lane & 31), head = g * 8 + F.wave;
        const size_t row = (size_t)b * S + tq;
        fa::bf16x8 qf[4];
#pragma unroll
        for (int ks = 0; ks < 4; ++ks) qf[ks] = *(const fa::bf16x8*)(P1 + row * P1_LD + C1_Q + head * 64 + 16 * ks + 8 * h);
        fa::f32x16 o[2];
#pragma unroll
        for (int blk = 0; blk < 2; ++blk)
#pragma unroll
            for (int e = 0; e < 16; ++e) o[blk][e] = 0.f;
        float m = -INFINITY, l = 0.f;
        const unsigned sel = SELM[row * 2 + g]; unsigned tm = sel;
#pragma unroll
        for (int of = 1; of < 32; of <<= 1) tm |= (unsigned)__shfl_xor((int)tm, of);
        tm = (unsigned)__builtin_amdgcn_readfirstlane((int)tm);
        SlcPol pol{P1 + (size_t)b * S * P1_LD + C1_KS + g * 64, P1 + (size_t)b * S * P1_LD + C1_VS + g * 64, sel, tq, tq0, tab + head * 132};
        fa::run<64, 64, false>(F.lds, pol, tm, F.tid, F.lane, qf, o, m, l);
        const float inv = 1.f / l;
#pragma unroll
        for (int blk = 0; blk < 2; ++blk)
#pragma unroll
            for (int jj = 0; jj < 4; ++jj) { const int d0 = 32 * blk + 8 * jj + 4 * h;
                v2u ow; ow.x = pk2(o[blk][4 * jj + 0] * inv, o[blk][4 * jj + 1] * inv); ow.y = pk2(o[blk][4 * jj + 2] * inv, o[blk][4 * jj + 3] * inv);
                *(v2u*)(OS + row * D + head * 64 + d0) = ow; }
    }
}

__device__ __forceinline__ int wave_sum_dpp(int v) {
    v += __builtin_amdgcn_update_dpp(0, v, 0xB1, 0xf, 0xf, false);
    v += __builtin_amdgcn_update_dpp(0, v, 0x4E, 0xf, 0xf, false);
    v += __builtin_amdgcn_update_dpp(0, v, 0x141, 0xf, 0xf, false);
    v += __builtin_amdgcn_update_dpp(0, v, 0x140, 0xf, 0xf, false);
    v += __builtin_amdgcn_update_dpp(0, v, 0x142, 0xa, 0xf, false);
    v += __builtin_amdgcn_update_dpp(0, v, 0x143, 0xc, 0xf, false);
    return __builtin_amdgcn_readlane(v, 63);
}
template <bool GT>
__device__ __forceinline__ int count4(unsigned u0, unsigned u1, unsigned u2, unsigned u3, unsigned cand) {
    unsigned long long m0, m1, m2, m3; int t0, t1, t2, t3;
    if (GT)
        asm volatile("v_cmp_gt_u32_e64 %0, %8, %12\n\tv_cmp_gt_u32_e64 %1, %9, %12\n\tv_cmp_gt_u32_e64 %2, %10, %12\n\tv_cmp_gt_u32_e64 %3, %11, %12\n\t"
                     "s_bcnt1_i32_b64 %4, %0\n\ts_bcnt1_i32_b64 %5, %1\n\ts_bcnt1_i32_b64 %6, %2\n\ts_bcnt1_i32_b64 %7, %3"
                     : "=&s"(m0), "=&s"(m1), "=&s"(m2), "=&s"(m3), "=&s"(t0), "=&s"(t1), "=&s"(t2), "=&s"(t3) : "v"(u0), "v"(u1), "v"(u2), "v"(u3), "s"(cand) : "scc");
    else
        asm volatile("v_cmp_ge_u32_e64 %0, %8, %12\n\tv_cmp_ge_u32_e64 %1, %9, %12\n\tv_cmp_ge_u32_e64 %2, %10, %12\n\tv_cmp_ge_u32_e64 %3, %11, %12\n\t"
                     "s_bcnt1_i32_b64 %4, %0\n\ts_bcnt1_i32_b64 %5, %1\n\ts_bcnt1_i32_b64 %6, %2\n\ts_bcnt1_i32_b64 %7, %3"
                     : "=&s"(m0), "=&s"(m1), "=&s"(m2), "=&s"(m3), "=&s"(t0), "=&s"(t1), "=&s"(t2), "=&s"(t3) : "v"(u0), "v"(u1), "v"(u2), "v"(u3), "s"(cand) : "scc");
    return (t0 + t1) + (t2 + t3);
}
__device__ __forceinline__ void idx_phase_mfma(const Frame& F) {
    const bf16* P0 = (const bf16*)(F.ws + WS_P0); unsigned* MASK = (unsigned*)(F.ws + WS_MASK);
    LAS float* sc = (LAS float*)F.lds;
    const int r = F.lane & 31, hh = F.lane >> 5;
    const int head_r = (r & 3) + 4 * ((r >> 3) & 1), ql_r = 2 * (r >> 4) + ((r >> 2) & 1);
    fa::bf16x8 qaN[2][4]; v4u wvN[2][2];
#define IDX_DECODE(item_, b_, t0_) { const int it_i = (item_) / F.G, it_c = (item_) % F.G; b_ = (F.G == S / 8) ? it_i : (item_) / (S / 8); t0_ = ((F.G == S / 8) ? ((it_c + 16 * it_i) & (S / 8 - 1)) : ((item_) % (S / 8))) * 8; }
#define IDX_LOAD(item_) { int b_, t0_; IDX_DECODE(item_, b_, t0_); \
        _Pragma("unroll") for (int rb = 0; rb < 2; ++rb) { const bf16* qp = P0 + (size_t)(b_ * S + t0_ + 4 * rb + ql_r) * P0_LD + C0_QI + head_r * 64 + 8 * hh; \
            _Pragma("unroll") for (int ks = 0; ks < 4; ++ks) qaN[rb][ks] = *(const fa::bf16x8*)(qp + 16 * ks); \
            _Pragma("unroll") for (int qq = 0; qq < 2; ++qq) wvN[rb][qq] = *(const v4u*)(P0 + (size_t)(b_ * S + t0_ + 4 * rb + 2 * qq + hh) * P0_LD + C0_WI); } }
    if ((int)blockIdx.x < NB * (S / 8)) IDX_LOAD(blockIdx.x);
    for (int item = blockIdx.x; item < NB * (S / 8); item += F.G) {
        int b, t0; IDX_DECODE(item, b, t0);
        fa::bf16x8 qa[2][4]; float wv[2][2][8];
#pragma unroll
        for (int rb = 0; rb < 2; ++rb) {
#pragma unroll
            for (int ks = 0; ks < 4; ++ks) qa[rb][ks] = qaN[rb][ks];
#pragma unroll
            for (int qq = 0; qq < 2; ++qq) { const v4u w = wvN[rb][qq]; const float sc8 = 0.35355339059f * 0.125f;
                wv[rb][qq][0] = bflo(w.x) * sc8; wv[rb][qq][1] = bfhi(w.x) * sc8; wv[rb][qq][2] = bflo(w.y) * sc8; wv[rb][qq][3] = bfhi(w.y) * sc8;
                wv[rb][qq][4] = bflo(w.z) * sc8; wv[rb][qq][5] = bfhi(w.z) * sc8; wv[rb][qq][6] = bflo(w.w) * sc8; wv[rb][qq][7] = bfhi(w.w) * sc8; } }
        const int nkb = (t0 + 8 + 31) >> 5;
        PROBE_START(9, F.tid);
#pragma unroll 1
        for (int kb0 = F.wave; kb0 < nkb; kb0 += 32) {
            fa::bf16x8 kf[4][4];
#pragma unroll
            for (int i = 0; i < 4; ++i) { const int kb = (kb0 + 8 * i < 64) ? kb0 + 8 * i : 63; const bf16* kp = P0 + (size_t)(b * S + 32 * kb + r) * P0_LD + C0_KI + 8 * hh;
#pragma unroll
                for (int ks = 0; ks < 4; ++ks) kf[i][ks] = *(const fa::bf16x8*)(kp + 16 * ks); }
#pragma unroll
            for (int i = 0; i < 4; ++i) { const int kb = kb0 + 8 * i;
                if (kb < nkb) {
#pragma unroll
                    for (int rb = 0; rb < 2; ++rb) { fa::f32x16 c;
#pragma unroll
                        for (int e = 0; e < 16; ++e) c[e] = 0.f;
#pragma unroll
                        for (int ks = 0; ks < 4; ++ks) c = __builtin_amdgcn_mfma_f32_32x32x16_bf16(qa[rb][ks], kf[i][ks], c, 0, 0, 0);
                        float s0 = 0.f, s1 = 0.f;
#pragma unroll
                        for (int e = 0; e < 8; ++e) { s0 += wv[rb][0][e] * fmaxf(c[e], 0.f); s1 += wv[rb][1][e] * fmaxf(c[8 + e], 0.f); }
                        sc[(4 * rb + hh) * 2048 + 32 * kb + r] = s0; sc[(4 * rb + 2 + hh) * 2048 + 32 * kb + r] = s1; } } }
        }
        if (item + F.G < NB * (S / 8)) IDX_LOAD(item + F.G);
        PROBE_STOP(9, F.tid);
        __syncthreads();
        PROBE_START(10, F.tid);
        {
            const int q = F.wave, t = t0 + q, n = t + 1, row = b * S + t; unsigned myword = 0u;
            if (n <= 256) { const int cb = n - 32 * F.lane; myword = cb >= 32 ? 0xffffffffu : (cb <= 0 ? 0u : ((1u << cb) - 1u)); }
            else {
                unsigned uu[32];
#pragma unroll
                for (int i = 0; i < 32; ++i) { const int s = F.lane + 64 * i; uu[i] = (s < n) ? fkey(sc[q * 2048 + s]) : 0u; }
                unsigned prefix = 0u; bool exact = false;
#pragma unroll 1
                for (int bit = 31; bit >= 0; --bit) { const unsigned cand = prefix | (1u << bit); int c0 = 0, c1 = 0, c2 = 0, c3 = 0;
#pragma unroll
                    for (int i = 0; i < 32; i += 4) { c0 += (uu[i] >= cand) ? 1 : 0; c1 += (uu[i + 1] >= cand) ? 1 : 0; c2 += (uu[i + 2] >= cand) ? 1 : 0; c3 += (uu[i + 3] >= cand) ? 1 : 0; }
                    const int c = wave_sum_dpp((c0 + c1) + (c2 + c3));
                    if (c >= 256) { prefix = cand; if (c == 256) { exact = true; break; } } }
                int cgt = 0;
                if (!exact) { int g0 = 0, g1 = 0;
#pragma unroll
                    for (int i = 0; i < 32; i += 2) { g0 += (uu[i] > prefix) ? 1 : 0; g1 += (uu[i + 1] > prefix) ? 1 : 0; }
                    cgt = wave_sum_dpp(g0 + g1); }
                if (exact) {
#pragma unroll
                    for (int i = 0; i < 32; ++i) { const unsigned long long sm = __ballot(uu[i] >= prefix);
                        if (F.lane == 2 * i) myword = (unsigned)sm; if (F.lane == 2 * i + 1) myword = (unsigned)(sm >> 32); }
                } else {
                    const int need = 256 - cgt; int run = 0;
#pragma unroll
                    for (int i = 0; i < 32; ++i) { asm volatile("" : "+s"(run), "+v"(uu[i])); const unsigned u = uu[i]; const bool eq = (u == prefix); const unsigned long long em = __ballot(eq); const int rank = run + __popcll(em & ((1ull << F.lane) - 1ull));
                        const bool sel = (u > prefix) || (eq && rank < need); run += __popcll(em);
                        const unsigned long long sm = __ballot(sel);
                        if (F.lane == 2 * i) myword = (unsigned)sm; if (F.lane == 2 * i + 1) myword = (unsigned)(sm >> 32); }
                }
            }
            MASK[(size_t)row * 64 + F.lane] = myword;
        }
        PROBE_STOP(10, F.tid);
        __syncthreads();
    }
}
#undef IDX_DECODE
#undef IDX_LOAD
__device__ __forceinline__ void cmp_phase_mfma(const Frame& F) {
    typedef fa::Geo<64, 64> G;
    const bf16* P1 = (const bf16*)(F.ws + WS_P1); const bf16* KC = (const bf16*)(F.ws + WS_KC); const bf16* VC = (const bf16*)(F.ws + WS_VC);
    bf16* OC = (bf16*)(F.ws + WS_OCMP); unsigned* SELM = (unsigned*)(F.ws + WS_SELM);
    LAS float* tab = (LAS float*)(F.lds + 36864); LAS float* part = (LAS float*)(F.lds + 49152);
    build_bias_table(F, tab, 16, 0);
    const int r = F.lane & 31, h = F.lane >> 5;
    for (int u = blockIdx.x; u < NB * 2 * 64; u += F.G) {
        const int rr_ = u / F.G, c_ = u % F.G; const int qt = (rr_ & 1) ? 63 - (c_ & 63) : (c_ & 63), bg = (rr_ * (F.G >> 6) + (c_ >> 6)) % (NB * 2), b = bg >> 1, g = bg & 1;
        const int tq0 = 32 * qt, head = g * 8 + F.wave, tq = tq0 + r;
        const size_t row = (size_t)b * S + tq;
        const int nv = (tq >= 31) ? ((tq - 31) / 16 + 1) : 0;
        const int ntile = (tq0 >= 1024) ? 2 : 1;
        {
            struct CPol { const bf16* kb; const bf16* vb; __device__ __forceinline__ const bf16* krow(int j, int rr) const { return kb + (size_t)(64 * j + rr) * 64; } __device__ __forceinline__ const bf16* vrow(int j, int rr) const { return vb + (size_t)(64 * j + rr) * 64; } };
            CPol cp{KC + (size_t)(b * 2 + g) * 128 * 64, VC + (size_t)(b * 2 + g) * 128 * 64};
            for (int t = 0; t < ntile; ++t) { fa::Stage<64, 64, false> st; fa::load_tile<64, 64, false>(st, cp, t, F.tid); fa::store_tile<64, 64, false>(st, F.lds + t * G::BUF, F.tid); }
        }
        fa::bf16x8 qf[4];
#pragma unroll
        for (int ks = 0; ks < 4; ++ks) qf[ks] = *(const fa::bf16x8*)(P1 + row * P1_LD + C1_Q + head * 64 + 16 * ks + 8 * h);
        __syncthreads();
        fa::f32x16 s[2][2];
        const LAS float* bl = tab + head * 132;
#pragma unroll
        for (int t = 0; t < 2; ++t) {
            const LAS bf16* Ks = (const LAS bf16*)(F.lds + t * G::BUF);
#pragma unroll
            for (int kb = 0; kb < 2; ++kb) {
#pragma unroll
                for (int e = 0; e < 16; ++e) s[t][kb][e] = 0.f;
                if (t < ntile) {
#pragma unroll
                    for (int ks = 0; ks < 4; ++ks) { const fa::bf16x8 a = *(const LAS fa::bf16x8*)(Ks + (32 * kb + r) * G::KSTR + 16 * ks + 8 * h); s[t][kb] = __builtin_amdgcn_mfma_f32_32x32x16_bf16(a, qf[ks], s[t][kb], 0, 0, 0); }
                }
#pragma unroll
                for (int e = 0; e < 16; ++e) { const int n = 64 * t + 32 * kb + 8 * (e >> 2) + 4 * h + (e & 3); const int dist = tq - (16 * n + 31); const int di = dist < 0 ? 0 : (dist > 128 ? 128 : dist);
                    s[t][kb][e] = (n < nv) ? __builtin_fmaf(s[t][kb][e], 0.125f * 1.4426950408889634f, bl[di]) : -INFINITY; }
            }
        }
        float mx = -INFINITY;
#pragma unroll
        for (int t = 0; t < 2; ++t)
#pragma unroll
            for (int kb = 0; kb < 2; ++kb)
#pragma unroll
                for (int e = 0; e < 16; ++e) mx = fmaxf(mx, s[t][kb][e]);
        mx = fa::xhalf_max(mx);
        const float mref = (mx == -INFINITY) ? 0.f : mx; float rs = 0.f;
#pragma unroll
        for (int t = 0; t < 2; ++t)
#pragma unroll
            for (int kb = 0; kb < 2; ++kb)
#pragma unroll
                for (int e = 0; e < 16; ++e) { s[t][kb][e] = __builtin_amdgcn_exp2f(s[t][kb][e] - mref); rs += s[t][kb][e]; }
        rs = fa::xhalf_sum(rs);
        const float inv = (nv > 0) ? 1.f / rs : 0.f;
#pragma unroll
        for (int t = 0; t < 2; ++t)
#pragma unroll
            for (int kb = 0; kb < 2; ++kb)
#pragma unroll
                for (int e = 0; e < 16; ++e) s[t][kb][e] *= inv;
        {
            float sum4[16], p3[16];
#pragma unroll
            for (int t = 0; t < 2; ++t)
#pragma unroll
                for (int kb = 0; kb < 2; ++kb)
#pragma unroll
                    for (int jj = 0; jj < 4; ++jj) { const int G4 = 8 * t + 4 * kb + jj; sum4[G4] = (s[t][kb][4 * jj] + s[t][kb][4 * jj + 1]) + (s[t][kb][4 * jj + 2] + s[t][kb][4 * jj + 3]); p3[G4] = s[t][kb][4 * jj + 3]; }
            LAS float* pw = part + (F.wave * 32 + r) * 32;
            float prt[16];
#pragma unroll
            for (int G4 = 0; G4 < 16; ++G4) { const auto rr = __builtin_amdgcn_permlane32_swap(__builtin_bit_cast(unsigned, p3[G4]), __builtin_bit_cast(unsigned, p3[G4]), false, false);
                prt[G4] = __builtin_bit_cast(float, h ? (unsigned)rr[0] : (unsigned)rr[1]); }
#pragma unroll
            for (int G4 = 0; G4 < 16; ++G4) { const float prm1 = (G4 > 0) ? prt[G4 > 0 ? G4 - 1 : 0] : 0.f;
                const float v = sum4[G4] + (h ? prt[G4] : prm1);
                pw[2 * G4 + h] = v; }
        }
        fa::f32x16 o[2];
#pragma unroll
        for (int blk = 0; blk < 2; ++blk)
#pragma unroll
            for (int e = 0; e < 16; ++e) o[blk][e] = 0.f;
#pragma unroll
        for (int t = 0; t < 2; ++t) {
            if (t < ntile) {
                const LAS bf16* Vt = (const LAS bf16*)(F.lds + t * G::BUF + G::KBYTES);
#pragma unroll
                for (int kb = 0; kb < 2; ++kb)
#pragma unroll
                    for (int s2 = 0; s2 < 2; ++s2) {
                        v4u pw4; pw4.x = pg8::cvt_pk_bf16(s[t][kb][8 * s2 + 0], s[t][kb][8 * s2 + 1]); pw4.y = pg8::cvt_pk_bf16(s[t][kb][8 * s2 + 2], s[t][kb][8 * s2 + 3]);
                        pw4.z = pg8::cvt_pk_bf16(s[t][kb][8 * s2 + 4], s[t][kb][8 * s2 + 5]); pw4.w = pg8::cvt_pk_bf16(s[t][kb][8 * s2 + 6], s[t][kb][8 * s2 + 7]);
                        const fa::bf16x8 pf = __builtin_bit_cast(fa::bf16x8, pw4);
#pragma unroll
                        for (int blk = 0; blk < 2; ++blk) { const LAS bf16* vp = Vt + (32 * blk + r) * fa::VSTR + 32 * kb + 16 * s2 + 4 * h;
                            const fa::bf16x4 lo = *(const LAS fa::bf16x4*)vp, hi = *(const LAS fa::bf16x4*)(vp + 8);
                            o[blk] = __builtin_amdgcn_mfma_f32_32x32x16_bf16(__builtin_shufflevector(lo, hi, 0, 1, 2, 3, 4, 5, 6, 7), pf, o[blk], 0, 0, 0); }
                    }
            }
        }
#pragma unroll
        for (int blk = 0; blk < 2; ++blk)
#pragma unroll
            for (int jj = 0; jj < 4; ++jj) { const int d0 = 32 * blk + 8 * jj + 4 * h;
                v2u ow; ow.x = pk2(o[blk][4 * jj + 0], o[blk][4 * jj + 1]); ow.y = pk2(o[blk][4 * jj + 2], o[blk][4 * jj + 3]);
                *(v2u*)(OC + row * D + head * 64 + d0) = ow; }
        __syncthreads();
#pragma unroll 1
        for (int it = 0; it < 2; ++it) {
            const int ql = 4 * F.wave + 2 * it + h, j = r, t = tq0 + ql; float p = 0.f;
#pragma unroll
            for (int w8 = 0; w8 < 8; ++w8) p += part[(w8 * 32 + ql) * 32 + j];
            const int blkq = t >> 6; const bool adm = (64 * j <= t); const bool forced = (j == 0) || (j == blkq) || (j == blkq - 1);
            const float scj = adm ? (p + (forced ? 1.0e6f : 0.f)) : -1.0e30f;
            int rank = 0;
#pragma unroll 1
            for (int i = 0; i < 32; ++i) { const float si = __shfl(scj, (F.lane & 32) | i); rank += (si > scj || (si == scj && i < j)) ? 1 : 0; }
            const unsigned long long sm = __ballot(adm && rank < 8);
            if (r == 0) SELM[((size_t)b * S + t) * 2 + g] = h ? (unsigned)(sm >> 32) : (unsigned)sm;
        }
        __syncthreads();
    }
}

__device__ __forceinline__ void cmp_prep(const Frame& F) {
    tconv(F, F.in[I_OD_W1K], 128, 2048, 128, 256, (bf16*)(F.ws + WS_W1T), 2048, NOGRP, 0);
    tconv(F, F.in[I_OD_W1V], 128, 2048, 128, 256, (bf16*)(F.ws + WS_W1T) + (size_t)256 * 2048, 2048, NOGRP, 0);
    if (blockIdx.x == 0 && F.tid < 256) { const int which = F.tid >> 7, j = F.tid & 127; const float* pe = which ? F.in[I_OD_PEV] : F.in[I_OD_PEK]; const float* w1 = which ? F.in[I_OD_W1V] : F.in[I_OD_W1K]; float a = 0.f;
        for (int kk = 0; kk < 2048; ++kk) a += pe[kk] * w1[(size_t)kk * 128 + j];
        ((float*)(F.ws + WS_PEB))[F.tid] = a; }
}
__device__ __forceinline__ void cmp_w2_phase(const Frame& F) {
    const float* Hd = (const float*)(F.ws + WS_HIDC);
    LAS float* w2s = (LAS float*)F.lds;
    for (int i = F.tid; i < 2 * 8192; i += 512) w2s[i] = (i < 8192) ? F.in[I_OD_W2K][i] : F.in[I_OD_W2V][i - 8192];
    __syncthreads();
    for (int rw0 = F.gw * 4; rw0 < 2 * 4096; rw0 += F.NGW * 4) {
        float h0[4], h1[4];
#pragma unroll
        for (int k = 0; k < 4; ++k) { h0[k] = Hd[(size_t)(rw0 + k) * 128 + F.lane]; h1[k] = Hd[(size_t)(rw0 + k) * 128 + 64 + F.lane]; }
#pragma unroll
        for (int k = 0; k < 4; ++k) { const int rw = rw0 + k; const int which = rw >> 12, g = (rw >> 11) & 1, b = (rw >> 7) & 15, n = rw & 127;
            const LAS float* w2 = w2s + which * 8192;
            bf16* outp = (bf16*)(F.ws + (which ? WS_VC : WS_KC)) + ((size_t)(b * 2 + g) * 128 + n) * 64;
            float a = 0.f;
            if (n < NCMP) {
#pragma unroll 16
                for (int j = 0; j < 64; ++j) a += __builtin_bit_cast(float, __builtin_amdgcn_readlane(__builtin_bit_cast(int, h0[k]), j)) * w2[j * 64 + F.lane];
#pragma unroll 16
                for (int j = 0; j < 64; ++j) a += __builtin_bit_cast(float, __builtin_amdgcn_readlane(__builtin_bit_cast(int, h1[k]), j)) * w2[(64 + j) * 64 + F.lane]; }
            outp[F.lane] = (bf16)f2bf(a); }
    }
}

constexpr int NPHASE = 29;
__global__ void __launch_bounds__(NWAVES * 64, 2) skel_fwd(Args args) {
    extern __shared__ __attribute__((aligned(16))) unsigned char lds[];
    Frame F;
    F.lds = (LAS unsigned char*)lds; F.ws = args.ws; F.acc = args.out; F.in = args.in;
    F.tid = threadIdx.x; F.lane = F.tid & 63; F.wave = __builtin_amdgcn_readfirstlane(F.tid >> 6);
    F.G = gridDim.x; F.gw = blockIdx.x * NWAVES + F.wave; F.NGW = F.G * NWAVES;
    volatile LAS unsigned* MISC = (volatile LAS unsigned*)(F.lds + MISC_OFF);
    for (int u = F.tid; u < (LDS_BYTES - LDSCTL_OFF) / 4; u += NWAVES * 64) ((LAS unsigned*)(F.lds + LDSCTL_OFF))[u] = 0u;
    __syncthreads();
    unsigned* ctl = (unsigned*)(args.ws + WS_CTL);
    XcdBarrier bar; bar.bar = ctl + CW_BAR; bar.x = 0; bar.st = nullptr;
    const int lo = args.ph_lo, hi = args.ph_hi;
    if (hi - lo > 1) {
        bar = xcd_barrier_post(ctl + CW_BAR, MISC + 8);
        if (threadIdx.x == 0) { unsigned nloc, nx; xcd_barrier_complete(ctl + CW_BAR, bar.x, nloc, nx); MISC[8] = nloc; MISC[9] = nx; }
        __syncthreads();
    }
#ifndef PH_LO
#define PH_LO 0
#define PH_HI 99
#endif
#define IN(k) ((k) >= PH_LO && (k) < PH_HI && lo <= (k) && (k) < hi && fresh(F, ws, args.ws, args.out) && probe_open(F, (k)))
#define SEAM(k) do { if ((lo <= (k) && (k) < hi) && (lo <= (k) + 1 && (k) + 1 < hi)) xcd_barrier(bar, F.tid); probe_close(F, (k)); } while (0)
    unsigned char* ws = args.ws;
    const int bx = blockIdx.x;

    if (IN(0)) { prologue(F); } SEAM(0);
    if (IN(1)) {
        { pg8::StaticSched<256 * 2048, 256 * 2048> Sd{(const char*)(ws + WS_HB), (const char*)(ws + W_IN0), M / 256, P0_LD / 256, F.G, bx, F.wave};
          pg8::EpiBf16 E{(bf16*)(ws + WS_P0), P0_LD}; pg8::gemm_phase<1024, 2048, 2048>(F.lds, Sd, E); }
        for (int i = 0; i < 2; ++i) {
          pg8::StaticSched<256 * 2048, 256 * 2048> Sd{(const char*)(ws + WS_MEMB), (const char*)(ws + W_XKV + (size_t)i * 1024 * 1024 * 2), MMEM / 256, 4, F.G, (bx + 128 * (i + 1)) % F.G, F.wave};
          pg8::EpiBf16 E{(bf16*)(ws + WS_XKV + (size_t)i * MMEM * 1024 * 2), 1024}; pg8::gemm_phase<1024, 2048, 2048>(F.lds, Sd, E); }
    } SEAM(1);
    if (IN(2)) { PROBE_START(6, F.tid); cn_phase(F); PROBE_STOP(6, F.tid); PROBE_START(7, F.tid); idx_phase_mfma(F); PROBE_STOP(7, F.tid); PROBE_START(8, F.tid); swa_phase_mfma(F); PROBE_STOP(8, F.tid); } SEAM(2);
    if (IN(3)) { dsa_phase_mfma(F); } SEAM(3);
    if (IN(4)) { pg8::StaticSched<256 * P0_LD * 2, 256 * 1536 * 2> Sd{(const char*)(ws + WS_P0), (const char*)(ws + W_OUT0), M / 256, 4, F.G, bx, F.wave};
                 pg8::EpiSumB E{(const bf16*)(ws + WS_HB), (bf16*)F.acc}; pg8::gemm_phase<1536, P0_LD * 2, 1536 * 2>(F.lds, Sd, E); } SEAM(4);
    if (IN(5)) { ln_phase<0>(F, 0, (const bf16*)F.acc); } SEAM(5);
    if (IN(6)) { pg8::StaticSched<256 * 2048, 256 * 2048> Sd{(const char*)(ws + WS_HB), (const char*)(ws + W_XQ), M / 256, 2, F.G, bx, F.wave};
                 pg8::EpiBf16 E{(bf16*)(ws + WS_QX0), 512}; pg8::gemm_phase<1024, 2048, 2048>(F.lds, Sd, E); asm volatile("s_waitcnt vmcnt(0)" ::: "memory"); __syncthreads(); xattn_phase_mfma(F, (const bf16*)(ws + WS_QX0), (const bf16*)(ws + WS_XKV), (bf16*)(ws + WS_OX0)); } SEAM(6);
    if (IN(7)) { pg8::StaticSched<256 * 1024, 256 * 1024> Sd{(const char*)(ws + WS_OX0), (const char*)(ws + W_XO), M / 256, 4, F.G, bx, F.wave};
                 pg8::EpiSumB E{(const bf16*)(ws + WS_HB), (bf16*)F.acc}; pg8::gemm_phase<512, 1024, 1024>(F.lds, Sd, E); } SEAM(7);
    if (IN(8)) { ln_phase<0>(F, 1, (const bf16*)F.acc); } SEAM(8);
    if (IN(9)) { pg8::StaticSched<256 * 2048, 256 * 2048> Sd{(const char*)(ws + WS_HB), (const char*)(ws + W_FGU), M / 256, 2 * DFF / 256, F.G, bx, F.wave};
                  pg8::EpiSwiglu E{(bf16*)(ws + WS_HID), DFF, 0, nullptr}; pg8::gemm_phase<1024, 2048, 2048>(F.lds, Sd, E); } SEAM(9);
    if (IN(10)) { pg8::StaticSched<256 * DFF * 2, 256 * DFF * 2> Sd{(const char*)(ws + WS_HID), (const char*)(ws + W_FD), M / 256, 4, F.G, bx, F.wave};
                  pg8::EpiSumB E{(const bf16*)(ws + WS_HB), (bf16*)F.acc}; pg8::gemm_phase<DFF, DFF * 2, DFF * 2>(F.lds, Sd, E); } SEAM(10);
    if (IN(11)) { ln_phase<0>(F, 2, (const bf16*)F.acc); cmp_prep(F); } SEAM(11);
    if (IN(12)) { pg8::StaticSched<256 * 2048, 256 * 2048> Sd{(const char*)(ws + WS_HB), (const char*)(ws + W_IN1), M / 256, P1_LD / 256, F.G, bx, F.wave};
                  pg8::EpiBf16 E{(bf16*)(ws + WS_P1), P1_LD}; pg8::gemm_phase<1024, 2048, 2048>(F.lds, Sd, E); } SEAM(12);
    if (IN(13)) { pg8::CmpSched Sd{(const char*)(ws + WS_P1), (const char*)(ws + WS_W1T), F.G, bx, F.wave};
                  pg8::EpiCmpHid E{(float*)(ws + WS_HIDC), (const float*)(ws + WS_PEB)}; pg8::gemm_phase<2048, 16 * P1_LD * 2, 2048 * 2, P1_LD * 2, (long)S * P1_LD * 2>(F.lds, Sd, E); } SEAM(13);
    if (IN(14)) { cmp_w2_phase(F); } SEAM(14);
    if (IN(15)) { cmp_phase_mfma(F); asm volatile("s_waitcnt vmcnt(0)" ::: "memory"); __syncthreads(); slc_phase_mfma(F); asm volatile("s_waitcnt vmcnt(0)" ::: "memory"); __syncthreads(); win_phase_mfma(F); } SEAM(15);
    if (IN(16)) { pg8::StaticSched<256 * P1_LD * 2, 256 * 2048> Sd{(const char*)(ws + WS_P1), (const char*)(ws + W_OUT1), M / 256, 4, F.G, bx, F.wave};
                  pg8::EpiSumB E{(const bf16*)(ws + WS_HB), (bf16*)F.acc}; pg8::gemm_phase<1024, P1_LD * 2, 2048>(F.lds, Sd, E); } SEAM(16);
    if (IN(17)) { ln_phase<0>(F, 3, (const bf16*)F.acc); } SEAM(17);
    if (IN(18)) { pg8::StaticSched<256 * 2048, 256 * 2048> Sd{(const char*)(ws + WS_HB), (const char*)(ws + W_XQ + (size_t)512 * 1024 * 2), M / 256, 2, F.G, bx, F.wave};
                  pg8::EpiBf16 E{(bf16*)(ws + WS_QX1), 512}; pg8::gemm_phase<1024, 2048, 2048>(F.lds, Sd, E); asm volatile("s_waitcnt vmcnt(0)" ::: "memory"); __syncthreads(); xattn_phase_mfma(F, (const bf16*)(ws + WS_QX1), (const bf16*)(ws + WS_XKV + (size_t)MMEM * 1024 * 2), (bf16*)(ws + WS_OX1)); } SEAM(18);
    if (IN(19)) { pg8::StaticSched<256 * 1024, 256 * 1024> Sd{(const char*)(ws + WS_OX1), (const char*)(ws + W_XO + (size_t)1024 * 512 * 2), M / 256, 4, F.G, bx, F.wave};
                  pg8::EpiSumB E{(const bf16*)(ws + WS_HB), (bf16*)(ws + WS_SCR + 64 * MiB)}; pg8::gemm_phase<512, 1024, 1024>(F.lds, Sd, E); } SEAM(19);
    if (IN(20)) { ln_phase<1>(F, 4, (const bf16*)(ws + WS_SCR + 64 * MiB)); } SEAM(20);
    if (IN(21)) { moe_dispatch(F); } SEAM(21);
#pragma unroll 1
    for (int ch = 0; ch < 3; ++ch) {
        const int pa = 22 + 2 * ch, pb = 23 + 2 * ch;
        const int* tile_exp = (const int*)(ws + WS_TILEEXP);
        if (IN(pa) || IN(pb)) {
            const int s1 = tile_exp[514];
            int t0 = 128 * ch, t1 = (ch == 2) ? s1 : (t0 + 128 < s1 ? t0 + 128 : s1);
            if (t0 > s1) t0 = s1; int nT = t1 - t0; if (nT < 0) nT = 0; if (nT > 128) nT = 128;
            PROBE_STARTF(11, F.tid);
            if (IN(pa)) { pg8::MoeSched<WS_PERMA, W_MGU, 256 * 2048, 256 * 2048, (size_t)7168 * 2048, 0> Sd{ws, t0, nT, 2 * DFFE / 256, F.G, bx, F.wave, nullptr};
                          pg8::EpiSwiglu E{(bf16*)(ws + WS_HIDM), DFFE, 1, (bf16*)args.out}; pg8::gemm_phase<1024, 2048, 2048>(F.lds, Sd, E); }
            if (IN(pa) && IN(pb)) xcd_barrier(bar, F.tid);
            PROBE_STOPF(11, F.tid); PROBE_STARTF(12, F.tid);
            if (IN(pb)) { pg8::MoeSched<WS_HIDM, W_MD, 256 * DFFE * 2, 256 * DFFE * 2, (size_t)1024 * DFFE * 2, 1> Sd{ws, t0, nT, 4, F.G, bx, F.wave, (const unsigned char*)args.out};
                          pg8::EpiBf16 E{(bf16*)(ws + WS_PERMA), 1024}; pg8::gemm_phase<DFFE, DFFE * 2, DFFE * 2>(F.lds, Sd, E); }
            if (IN(pb) && IN(pb + 1)) xcd_barrier(bar, F.tid);
            PROBE_STOPF(12, F.tid);
        }
    }
    if (IN(28)) { ln_phase<2>(F, 5, nullptr); }
    PROBE_SPIN(F.tid);
#undef IN
#undef SEAM
}

extern "C" void kernel_launch(void* const* d_in, const int* in_sizes, int n_in, void* d_out, int out_size, void* d_ws, size_t ws_size, hipStream_t stream) {
    static int grid = 0;
    if (grid == 0) {
        if (n_in != 30 || out_size != M * D || ws_size < WS_END) { fprintf(stderr, "kernel_launch: unexpected shapes (n_in %d, out %d, ws %zu < %zu); nothing launched\n", n_in, out_size, ws_size, (size_t)WS_END); grid = -1; return; }
        int dev = 0, cus = 0, per_cu = 0;
        if (hipGetDevice(&dev) != hipSuccess || hipDeviceGetAttribute(&cus, hipDeviceAttributeMultiprocessorCount, dev) != hipSuccess) { grid = -1; return; }
        if (hipFuncSetAttribute((const void*)skel_fwd, hipFuncAttributeMaxDynamicSharedMemorySize, LDS_BYTES) != hipSuccess) { fprintf(stderr, "kernel_launch: hipFuncSetAttribute failed\n"); grid = -1; return; }
        if (hipOccupancyMaxActiveBlocksPerMultiprocessor(&per_cu, (const void*)skel_fwd, NWAVES * 64, LDS_BYTES) != hipSuccess || per_cu < 1)
            fprintf(stderr, "kernel_launch: occupancy query reports %d workgroups per CU\n", per_cu);
        (void)hipGetLastError();
        grid = cus;
    }
    if (grid < 0) return;
    if (hipMemsetAsync((char*)d_ws + WS_CTL, 0, CTL_ZERO_BYTES, stream) != hipSuccess) return;
    Args a{};
    for (int i = 0; i < 30; ++i) a.in[i] = (const float*)d_in[i];
    a.out = (float*)d_out; a.ws = (unsigned char*)d_ws;
#if MK_ONE_LAUNCH
    a.ph_lo = 0; a.ph_hi = NPHASE;
    hipLaunchKernelGGL(skel_fwd, dim3(grid), dim3(NWAVES * 64), LDS_BYTES, stream, a);
#else
    for (int p = 0; p < NPHASE; ++p) { a.ph_lo = p; a.ph_hi = p + 1; hipLaunchKernelGGL(skel_fwd, dim3(grid), dim3(NWAVES * 64), LDS_BYTES, stream, a); }
#endif
}
```

```cpp
#include <hip/hip_runtime.h>
#include <cstdio>
#include <cstdint>

#ifndef PROBE_ID
#define PROBE_ID 0
#endif
#ifndef PROBE_AMP
#define PROBE_AMP 4
#endif
#ifndef PROBE_MASK
#define PROBE_MASK 0ull
#endif
#define PROBE_SEL(ph) ((PROBE_MASK >> (ph)) & 1ull)
#if PROBE_ID
#define PROBE_T0 ((volatile __attribute__((address_space(3))) unsigned long long*)(unsigned)(131072 + 320 + 64))
#define PROBE_ACC ((volatile __attribute__((address_space(3))) unsigned long long*)(unsigned)(131072 + 320 + 72))
#define PROBE_WINW ((volatile __attribute__((address_space(3))) unsigned*)(unsigned)(131072 + 320 + 80))
#define PROBE_WIN(ph, on, tid) do { if (PROBE_SEL(ph) && blockIdx.x == 0 && (tid) == 0) { *PROBE_WINW = (on); } } while (0)
#define PROBE_START(id, tid) do { if ((id) == PROBE_ID && blockIdx.x == 0 && (tid) == 0 && *PROBE_WINW) { *PROBE_T0 = __builtin_amdgcn_s_memtime(); } } while (0)
#define PROBE_STOP(id, tid) do { if ((id) == PROBE_ID && blockIdx.x == 0 && (tid) == 0 && *PROBE_WINW) { *PROBE_ACC = *PROBE_ACC + (__builtin_amdgcn_s_memtime() - *PROBE_T0); } } while (0)
#define PROBE_STARTF(id, tid) do { if ((id) == PROBE_ID && blockIdx.x == 0 && (tid) == 0) { *PROBE_T0 = __builtin_amdgcn_s_memtime(); } } while (0)
#define PROBE_STOPF(id, tid) do { if ((id) == PROBE_ID && blockIdx.x == 0 && (tid) == 0) { *PROBE_ACC = *PROBE_ACC + (__builtin_amdgcn_s_memtime() - *PROBE_T0); } } while (0)
#define PROBE_SPIN(tid) do { if (blockIdx.x == 0 && (tid) == 0) { const unsigned long long t0_ = __builtin_amdgcn_s_memtime(), w_ = *PROBE_ACC * PROBE_AMP; while (__builtin_amdgcn_s_memtime() - t0_ < w_) __builtin_amdgcn_s_sleep(8); } } while (0)
#else
#define PROBE_WIN(ph, on, tid) do {} while (0)
#define PROBE_START(id, tid) do {} while (0)
#define PROBE_STOP(id, tid) do {} while (0)
#define PROBE_STARTF(id, tid) do {} while (0)
#define PROBE_STOPF(id, tid) do {} while (0)
#define PROBE_SPIN(tid) do {} while (0)
#endif
#ifndef MK_ONE_LAUNCH
#define MK_ONE_LAUNCH 1
#endif

constexpr size_t ROWTOK_OFF = 5u * 1048576u + 512u * 1024u, ROWW_OFF = 6u * 1048576u, TILEEXP_OFF = 6u * 1048576u + 512u * 1024u, DUMMY_OFF = 7u * 1048576u;
namespace pg8 {
#define PG8_LAS __attribute__((address_space(3)))
typedef unsigned short bf16_t;
typedef short bf16x8 __attribute__((ext_vector_type(8)));
typedef float f32x4 __attribute__((ext_vector_type(4)));
typedef unsigned u32x4 __attribute__((ext_vector_type(4)));
constexpr int BM = 256, BK = 64, HALF = 128, HTB = HALF * BK * 2, STAGE_BYTES = 8 * HTB, NXCD = 8, WGM = 4;

__host__ __device__ __forceinline__ int lds_byte(int r, int c) { const int st = (r >> 4) * 2 + (c >> 5), rr = r & 15, cc = c & 31, ob = rr * 64 + cc * 2; return st * 1024 + (ob ^ (((ob >> 9) & 1) << 5)); }
__host__ __device__ __forceinline__ void stage_rc(int b, int& R, int& C) { const int st = b / 1024, sb = b % 1024, swz = sb ^ (((sb >> 9) & 1) << 5); R = (st >> 1) * 16 + swz / 64; C = (st & 1) * 32 + (swz % 64) / 2; }
__host__ __device__ __forceinline__ int perm32(int rho) { const int n = rho >> 4, i = rho & 15; return 8 * (i >> 2) + 4 * n + (i & 3); }

__device__ __forceinline__ const void* opaque_uniform(const void* p) {
    unsigned lo = __builtin_amdgcn_readfirstlane((unsigned)(unsigned long long)p), hi = __builtin_amdgcn_readfirstlane((unsigned)((unsigned long long)p >> 32));
    asm volatile("" : "+s"(lo), "+s"(hi));
    const __attribute__((address_space(1))) void* g = (const __attribute__((address_space(1))) void*)(((unsigned long long)hi << 32) | lo);
    return (const void*)g; }
struct Unit { int pm, pn, aux; const char* a; const char* b; };

__device__ __forceinline__ void tile_of(int wgid, int nM, int nN, int& pm, int& pn) {
    const int nwg = nM * nN;
    { const int q = nwg / NXCD, r = nwg % NXCD, xcd = wgid % NXCD, off = wgid / NXCD; wgid = (xcd < r ? xcd * (q + 1) : r * (q + 1) + (xcd - r) * q) + off; }
    const int nig = WGM * nN, gid = wgid / nig, fm = gid * WGM, gsz = (nM - fm) < WGM ? (nM - fm) : WGM;
    pm = fm + ((wgid % nig) % gsz); pn = (wgid % nig) / gsz;
}
template <size_t A_TILE, size_t B_TILE>
struct StaticSched {
    const char* A; const char* B; int nM, nN, G, c, wave;
    __device__ __forceinline__ bool next(int i, Unit& u) const {
        const long L = (long)i * G + c; if (L >= (long)nM * nN) return false;
        int pm, pn; tile_of((int)L, nM, nN, pm, pn);
        u.pm = pm; u.pn = pn; u.aux = 0; u.a = A + (size_t)pm * A_TILE; u.b = B + (size_t)pn * B_TILE; return true;
    }
};
template <size_t A_OFF, size_t B_OFF, size_t A_TILE, size_t B_TILE, size_t B_EXP, int A_LOCAL>
struct MoeSched {
    const unsigned char* ws; int t0, nT, nN, G, c, wave; const unsigned char* alt;
    __device__ __forceinline__ bool next(int i, Unit& u) const {
        const long L = (long)i * G + c; if (L >= (long)nT * nN) return false;
        int pml, pn; tile_of((int)L, nT, nN, pml, pn);
        const unsigned char* wsb = (const unsigned char*)opaque_uniform(ws);
        const int pm = t0 + pml; const int e = __builtin_amdgcn_readfirstlane(((const int*)(wsb + TILEEXP_OFF))[pm]);
        u.pm = pm; u.pn = pn; u.aux = pml; u.a = A_LOCAL ? ((pml < 64 ? (const char*)wsb + A_OFF : (const char*)opaque_uniform(alt)) + (size_t)(pml & 63) * A_TILE) : ((const char*)wsb + A_OFF + (size_t)pm * A_TILE); u.b = (const char*)wsb + B_OFF + (size_t)e * B_EXP + (size_t)pn * B_TILE; return true;
    }
};

__device__ __forceinline__ unsigned cvt_pk_bf16(float lo, float hi) { unsigned r; asm volatile("v_cvt_pk_bf16_f32 %0, %1, %2" : "=v"(r) : "v"(lo), "v"(hi)); return r; }

struct EpiBf16 {
    static constexpr bool PERM = true;
    bf16_t* O; int ldc;
    __device__ __forceinline__ void operator()(const f32x4 (&acc)[2][2][4][2], const Unit& u, int wr, int wc, int fr, int fq) const {
        const int row0 = u.pm * BM + wr * 64 + fr, col0 = u.pn * BM + wc * 32 + 8 * fq;
#pragma unroll
        for (int ai = 0; ai < 2; ++ai)
#pragma unroll
            for (int m = 0; m < 4; ++m) { bf16_t* rowp = O + (size_t)(row0 + ai * HALF + m * 16) * ldc + col0;
#pragma unroll
                for (int bj = 0; bj < 2; ++bj) { const f32x4 v0 = acc[ai][bj][m][0], v1 = acc[ai][bj][m][1];
                    u32x4 w; w.x = cvt_pk_bf16(v0[0], v0[1]); w.y = cvt_pk_bf16(v0[2], v0[3]); w.z = cvt_pk_bf16(v1[0], v1[1]); w.w = cvt_pk_bf16(v1[2], v1[3]);
                    *(u32x4*)(rowp + bj * HALF) = w; } }
    }
};
struct EpiAcc {
    static constexpr bool PERM = false;
    float* C; int ldc;
    __device__ __forceinline__ void operator()(const f32x4 (&acc)[2][2][4][2], const Unit& u, int wr, int wc, int fr, int fq) const {
        const int row0 = u.pm * BM + wr * 64 + fr, col0 = u.pn * BM + wc * 32 + 4 * fq;
#pragma unroll
        for (int ai = 0; ai < 2; ++ai)
#pragma unroll
            for (int m = 0; m < 4; ++m) { float* rowp = C + (size_t)(row0 + ai * HALF + m * 16) * ldc + col0;
                f32x4 o[2][2];
#pragma unroll
                for (int bj = 0; bj < 2; ++bj)
#pragma unroll
                    for (int n = 0; n < 2; ++n) o[bj][n] = *(const f32x4*)(rowp + bj * HALF + n * 16);
#pragma unroll
                for (int bj = 0; bj < 2; ++bj)
#pragma unroll
                    for (int n = 0; n < 2; ++n) *(f32x4*)(rowp + bj * HALF + n * 16) = o[bj][n] + acc[ai][bj][m][n]; }
    }
};
struct EpiSumB {
    static constexpr bool PERM = true;
    const bf16_t* H; bf16_t* O;
    __device__ __forceinline__ void operator()(const f32x4 (&acc)[2][2][4][2], const Unit& u, int wr, int wc, int fr, int fq) const {
        const int row0 = u.pm * BM + wr * 64 + fr, col0 = u.pn * BM + wc * 32 + 8 * fq;
#pragma unroll
        for (int ai = 0; ai < 2; ++ai)
#pragma unroll
            for (int m = 0; m < 4; ++m) { const size_t off = (size_t)(row0 + ai * HALF + m * 16) * 1024 + col0;
                u32x4 hw[2];
#pragma unroll
                for (int bj = 0; bj < 2; ++bj) hw[bj] = *(const u32x4*)(H + off + bj * HALF);
#pragma unroll
                for (int bj = 0; bj < 2; ++bj) { const f32x4 v0 = acc[ai][bj][m][0], v1 = acc[ai][bj][m][1]; const u32x4 h = hw[bj]; const float A = 1.41421356237f;
                    u32x4 w; w.x = cvt_pk_bf16(v0[0] + A * __builtin_bit_cast(float, h.x << 16), v0[1] + A * __builtin_bit_cast(float, h.x & 0xffff0000u));
                    w.y = cvt_pk_bf16(v0[2] + A * __builtin_bit_cast(float, h.y << 16), v0[3] + A * __builtin_bit_cast(float, h.y & 0xffff0000u));
                    w.z = cvt_pk_bf16(v1[0] + A * __builtin_bit_cast(float, h.z << 16), v1[1] + A * __builtin_bit_cast(float, h.z & 0xffff0000u));
                    w.w = cvt_pk_bf16(v1[2] + A * __builtin_bit_cast(float, h.w << 16), v1[3] + A * __builtin_bit_cast(float, h.w & 0xffff0000u));
                    *(u32x4*)(O + off + bj * HALF) = w; } }
    }
};
__device__ __forceinline__ float silu_f(float x) { return x / (1.0f + __expf(-x)); }
struct EpiSwiglu {
    static constexpr bool PERM = true;
    bf16_t* O; int ldc; int row_local; bf16_t* O2;
    __device__ __forceinline__ void operator()(const f32x4 (&acc)[2][2][4][2], const Unit& u, int wr, int wc, int fr, int fq) const {
        const int row0 = (row_local ? (u.aux & 63) : u.pm) * BM + wr * 64 + fr, col0 = u.pn * HALF + wc * 32 + 8 * fq;
        bf16_t* Ob = (row_local && u.aux >= 64) ? O2 : O;
#pragma unroll
        for (int ai = 0; ai < 2; ++ai)
#pragma unroll
            for (int m = 0; m < 4; ++m) { bf16_t* rowp = Ob + (size_t)(row0 + ai * HALF + m * 16) * ldc + col0;
                const f32x4 g0 = acc[ai][0][m][0], g1 = acc[ai][0][m][1], u0 = acc[ai][1][m][0], u1 = acc[ai][1][m][1];
                float h[8];
#pragma unroll
                for (int j = 0; j < 4; ++j) { h[j] = silu_f(g0[j]) * u0[j]; h[4 + j] = silu_f(g1[j]) * u1[j]; }
                u32x4 w; w.x = cvt_pk_bf16(h[0], h[1]); w.y = cvt_pk_bf16(h[2], h[3]); w.z = cvt_pk_bf16(h[4], h[5]); w.w = cvt_pk_bf16(h[6], h[7]);
                *(u32x4*)rowp = w; }
    }
};
struct EpiMoeDown {
    static constexpr bool PERM = false;
    float* C; unsigned char* ws;
    __device__ __forceinline__ void operator()(const f32x4 (&acc)[2][2][4][2], const Unit& u, int wr, int wc, int fr, int fq) const {
        const int row0 = u.pm * BM + wr * 64 + fr, col0 = u.pn * BM + wc * 32 + 4 * fq;
        unsigned char* wsb = (unsigned char*)opaque_uniform(ws);
        const int* rowtok = (const int*)(wsb + ROWTOK_OFF); const float* roww = (const float*)(wsb + ROWW_OFF); float* dummy = (float*)(wsb + DUMMY_OFF);
#pragma unroll
        for (int ai = 0; ai < 2; ++ai)
#pragma unroll
            for (int m = 0; m < 4; ++m) { const int r = row0 + ai * HALF + m * 16; const int tok = rowtok[r]; const float w = roww[r];
                float* rowp = (tok >= 0 ? C + (size_t)tok * 1024 : dummy) + col0;
                f32x4 o[2][2];
#pragma unroll
                for (int bj = 0; bj < 2; ++bj)
#pragma unroll
                    for (int n = 0; n < 2; ++n) o[bj][n] = *(const f32x4*)(rowp + bj * HALF + n * 16);
#pragma unroll
                for (int bj = 0; bj < 2; ++bj)
#pragma unroll
                    for (int n = 0; n < 2; ++n) *(f32x4*)(rowp + bj * HALF + n * 16) = o[bj][n] + acc[ai][bj][m][n] * w; }
    }
};

__device__ __forceinline__ float gelu_tanh_f(float x) { const float u = 0.7978845608028654f * (x + 0.044715f * x * x * x); const float e = __expf(2.f * u); return 0.5f * x * (1.f + (1.f - 2.f / (e + 1.f))); }
struct EpiCmpHid {
    static constexpr bool PERM = false;
    float* Hd; const float* bias;
    __device__ __forceinline__ void operator()(const f32x4 (&acc)[2][2][4][2], const Unit& u, int wr, int wc, int fr, int fq) const {
        const int row0 = u.pm * BM + wr * 64 + fr, col0 = wc * 32 + 4 * fq;
        f32x4 bv[2];
#pragma unroll
        for (int n = 0; n < 2; ++n) bv[n] = *(const f32x4*)(bias + u.aux * 128 + col0 + n * 16);
#pragma unroll
        for (int ai = 0; ai < 2; ++ai)
#pragma unroll
            for (int m = 0; m < 4; ++m) { float* rowp = Hd + (size_t)(row0 + ai * HALF + m * 16) * 128 + col0;
#pragma unroll
                for (int n = 0; n < 2; ++n) { const f32x4 v = acc[ai][0][m][n] + bv[n]; f32x4 o;
#pragma unroll
                    for (int j = 0; j < 4; ++j) o[j] = gelu_tanh_f(v[j]);
                    *(f32x4*)(rowp + n * 16) = o; } }
    }
};
struct CmpSched {
    const char* P1b; const char* W1T; int G, c, wave;
    __device__ __forceinline__ bool next(int i, Unit& u) const {
        const int L = i * G + c; if (L >= 32) return false;
        const int which = L >> 4, tile = L & 15, g = tile >> 3, b0 = 2 * (tile & 7);
        u.pm = L; u.pn = 0; u.aux = which; u.a = P1b + ((size_t)b0 * 2048 * 2048 + (which ? 1152 : 1024) + g * 64) * 2; u.b = W1T + (size_t)which * 256 * 2048 * 2; return true;
    }
};

template <int K, int lda_b, int ldb_b, long KSTEP_A = 128, long HSTEP_A = 128L * lda_b, class Epi, class Sched>
__device__ __forceinline__ void gemm_phase(PG8_LAS unsigned char* lds, const Sched& S, const Epi& E) {
    int tid_ = (int)__builtin_amdgcn_mbcnt_hi(~0u, __builtin_amdgcn_mbcnt_lo(~0u, 0u)); asm volatile("" : "+v"(tid_)); tid_ += S.wave * 64;
    const int tid = tid_, wid = __builtin_amdgcn_readfirstlane(tid >> 6), lane = tid & 63, wr = wid >> 2, wc = wid & 3, fr = lane & 15, fq = lane >> 4;
    constexpr int nt = K / BK;
    unsigned voffA[2], voffB[2];
#pragma unroll
    for (int i = 0; i < 2; ++i) { int R, C; stage_rc(tid * 16 + i * 8192, R, C); const int Rb = Epi::PERM ? ((R & ~31) + perm32(R & 31)) : R;
        voffA[i] = (unsigned)(R * lda_b + C * 2); voffB[i] = (unsigned)(Rb * ldb_b + C * 2); }
    const size_t kstep = (size_t)(BK * 2), kstepA = (size_t)KSTEP_A;
    const size_t hstepA = (size_t)HSTEP_A, hstepB = (size_t)HALF * ldb_b;
    const unsigned ldsw = (unsigned)wid * 1024u;
    const int aoff = lds_byte(wr * 64 + fr, fq * 8), boff = lds_byte(wc * 32 + fr, fq * 8);
#define PG8_SA(b, h) (((b) * 2 + (h)) * HTB)
#define PG8_SB(b, h) ((4 + (b) * 2 + (h)) * HTB)
#define PG8_STAGE(bufoff, gbase, voff) do { _Pragma("unroll") for (int _i = 0; _i < 2; ++_i) \
        __builtin_amdgcn_global_load_lds((const unsigned*)((const char*)(gbase) + (voff)[_i]), (PG8_LAS unsigned*)(lds + (bufoff) + ldsw + _i * 8192), 16, 0, 0); } while (0)
#define PG8_LDA(dst, b, h) do { _Pragma("unroll") for (int m = 0; m < 4; ++m) _Pragma("unroll") for (int k = 0; k < 2; ++k) dst[m][k] = *(const PG8_LAS bf16x8*)(lds + PG8_SA(b, h) + aoff + m * 2048 + k * 1024); } while (0)
#define PG8_LDB(dst, b, h) do { _Pragma("unroll") for (int n = 0; n < 2; ++n) _Pragma("unroll") for (int k = 0; k < 2; ++k) dst[n][k] = *(const PG8_LAS bf16x8*)(lds + PG8_SB(b, h) + boff + n * 2048 + k * 1024); } while (0)
#define PG8_MMA(ai, bj, At, Bt) do { __builtin_amdgcn_s_setprio(1); _Pragma("unroll") for (int m = 0; m < 4; ++m) _Pragma("unroll") for (int n = 0; n < 2; ++n) _Pragma("unroll") for (int k = 0; k < 2; ++k) \
        acc[ai][bj][m][n] = __builtin_amdgcn_mfma_f32_16x16x32_bf16(Bt[n][k], At[m][k], acc[ai][bj][m][n], 0, 0, 0); __builtin_amdgcn_s_setprio(0); } while (0)
#define PG8_WAIT_V(n) asm volatile("s_waitcnt vmcnt(" #n ")" ::: "memory")
#define PG8_WAIT_L(n) asm volatile("s_waitcnt lgkmcnt(" #n ")" ::: "memory")
#define PG8_BAR __builtin_amdgcn_s_barrier()
#define PG8_SCHED __builtin_amdgcn_sched_barrier(0)
    Unit cur, nxt; int ui = 0;
    if (!S.next(0, cur)) return;
    f32x4 acc[2][2][4][2];
#pragma unroll
    for (int a = 0; a < 2; ++a)
#pragma unroll
        for (int b = 0; b < 2; ++b)
#pragma unroll
            for (int m = 0; m < 4; ++m)
#pragma unroll
                for (int n = 0; n < 2; ++n) acc[a][b][m][n] = (f32x4){0.f, 0.f, 0.f, 0.f};
    bf16x8 At[4][2], B0[2][2], B1[2][2];
    const char* cA = cur.a; const char* cB = cur.b;
    PG8_STAGE(PG8_SB(0, 0), cB, voffB); PG8_STAGE(PG8_SB(0, 1), cB + hstepB, voffB); PG8_STAGE(PG8_SA(0, 0), cA, voffA); PG8_STAGE(PG8_SA(0, 1), cA + hstepA, voffA);
    if (wr == 1) PG8_BAR;
    PG8_WAIT_V(2); PG8_BAR;
    PG8_STAGE(PG8_SB(1, 0), cB + kstep, voffB); PG8_STAGE(PG8_SA(1, 0), cA + kstepA, voffA); PG8_STAGE(PG8_SB(1, 1), cB + hstepB + kstep, voffB);
    PG8_WAIT_V(6); PG8_BAR;
    for (;;) {
        const bool has_next = S.next(ui + 1, nxt);
        const char* nA = has_next ? nxt.a : cA; const char* nB = has_next ? nxt.b : cB;
        for (int t = 0; t < nt; t += 2) {
            const bool last = (t == nt - 2);
            const char* a1 = cA + (size_t)(t + 1) * kstepA;
            const char* a2 = last ? nA : cA + (size_t)(t + 2) * kstepA; const char* b2 = last ? nB : cB + (size_t)(t + 2) * kstep;
            const char* a3 = a2 + kstepA; const char* b3 = b2 + kstep;
            PG8_LDB(B0, 0, 0); PG8_LDB(B1, 0, 1); PG8_SCHED; PG8_LDA(At, 0, 0); PG8_STAGE(PG8_SA(1, 1), a1 + hstepA, voffA);
            PG8_WAIT_V(8); PG8_WAIT_L(0); PG8_BAR; PG8_MMA(0, 0, At, B0); PG8_MMA(0, 1, At, B1); PG8_BAR; PG8_SCHED;
            PG8_LDA(At, 0, 1); PG8_STAGE(PG8_SB(0, 0), b2, voffB); PG8_STAGE(PG8_SB(0, 1), b2 + hstepB, voffB); PG8_STAGE(PG8_SA(0, 0), a2, voffA);
            PG8_WAIT_V(8); PG8_WAIT_L(0); PG8_BAR; PG8_MMA(1, 0, At, B0); PG8_MMA(1, 1, At, B1); PG8_BAR; PG8_SCHED;
            PG8_LDB(B0, 1, 0); PG8_LDB(B1, 1, 1); PG8_SCHED; PG8_LDA(At, 1, 0); PG8_STAGE(PG8_SA(0, 1), a2 + hstepA, voffA);
            PG8_WAIT_V(8); PG8_WAIT_L(0); PG8_BAR; PG8_MMA(0, 0, At, B0); PG8_MMA(0, 1, At, B1); PG8_BAR; PG8_SCHED;
            PG8_LDA(At, 1, 1); PG8_STAGE(PG8_SB(1, 0), b3, voffB); PG8_STAGE(PG8_SB(1, 1), b3 + hstepB, voffB); PG8_STAGE(PG8_SA(1, 0), a3, voffA);
            PG8_WAIT_V(8); PG8_WAIT_L(0); PG8_BAR; PG8_MMA(1, 0, At, B0); PG8_MMA(1, 1, At, B1); PG8_BAR; PG8_SCHED;
        }
        if (wr == 0) PG8_BAR;
        E(acc, cur, wr, wc, fr, fq);
        if (!has_next) break;
#pragma unroll
        for (int a = 0; a < 2; ++a)
#pragma unroll
            for (int b = 0; b < 2; ++b)
#pragma unroll
                for (int m = 0; m < 4; ++m)
#pragma unroll
                    for (int n = 0; n < 2; ++n) acc[a][b][m][n] = (f32x4){0.f, 0.f, 0.f, 0.f};
        cur = nxt; cA = nA; cB = nB; ++ui;
        if (wr == 1) PG8_BAR;
    }
    PG8_WAIT_V(0);
    PG8_BAR;
#undef PG8_SA
#undef PG8_SB
#undef PG8_STAGE
#undef PG8_LDA
#undef PG8_LDB
#undef PG8_MMA
#undef PG8_WAIT_V
#undef PG8_WAIT_L
#undef PG8_BAR
#undef PG8_SCHED
}
}

constexpr int NWAVES = 8;
constexpr int D = 1024, NB = 16, S = 2048, M = NB * S, MEML = 256, MMEM = NB * MEML;
constexpr float LN_EPS = 1e-5f, ALPHA = 1.41421356237f;
constexpr int P0_LD = 2560, C0_QLAT = 0, C0_QB = 1024, C0_CKV = 1536, C0_QI = 1664, C0_KI = 2176, C0_KB = 2240, C0_VB = 2368, C0_WI = 2496;
constexpr int P1_LD = 2048, C1_Q = 0, C1_KC = 1024, C1_VC = 1152, C1_KS = 1280, C1_VS = 1408, C1_KW = 1536, C1_VW = 1664, C1_GL = 1792;
constexpr int EVEN_COLS = 1992, ODD_COLS = 1840;
constexpr int DFF = 2816, DFFE = 3584, NE = 8, NCMP = 127;
constexpr int MOE_CHUNK_TILES = 68, MOE_MAX_TILES = 272;

constexpr size_t MiB = 1u << 20;
constexpr size_t WS_CTL = 0, CTL_ZERO_BYTES = 1 * MiB;
constexpr size_t WS_KC = 2 * MiB, WS_VC = 3 * MiB;
constexpr size_t WS_SELM = 4 * MiB;
constexpr size_t WS_RTE = 4 * MiB + 512 * 1024;
constexpr size_t WS_RTW = 5 * MiB;
constexpr size_t WS_ROWTOK = ROWTOK_OFF; static_assert(ROWTOK_OFF == 5 * MiB + 512 * 1024, "");
constexpr size_t WS_ROWW = ROWW_OFF;
constexpr size_t WS_TILEEXP = TILEEXP_OFF; constexpr size_t WS_DUMMY = DUMMY_OFF;
constexpr size_t WS_W = 8 * MiB;
constexpr size_t W_IN0 = WS_W;
constexpr size_t W_OUT0 = W_IN0 + (size_t)2560 * 1024 * 2;
constexpr size_t W_IN1 = W_OUT0 + (size_t)1024 * 1536 * 2;
constexpr size_t W_OUT1 = W_IN1 + (size_t)2048 * 1024 * 2;
constexpr size_t W_XQ = W_OUT1 + (size_t)1024 * 1024 * 2;
constexpr size_t W_XKV = W_XQ + (size_t)2 * 512 * 1024 * 2;
constexpr size_t W_XO = W_XKV + (size_t)2 * 1024 * 1024 * 2;
constexpr size_t W_FGU = W_XO + (size_t)2 * 1024 * 512 * 2;
constexpr size_t W_FD = W_FGU + (size_t)5632 * 1024 * 2;
constexpr size_t W_MGU = W_FD + (size_t)1024 * 2816 * 2;
constexpr size_t W_MD = W_MGU + (size_t)8 * 7168 * 1024 * 2;
constexpr size_t W_END = W_MD + (size_t)8 * 1024 * 3584 * 2;
static_assert(W_END <= 215 * MiB, "weights");
constexpr size_t WS_HB = 215 * MiB;
constexpr size_t WS_XKV = 279 * MiB;
constexpr size_t WS_SCR = 295 * MiB;
constexpr size_t WS_P0 = WS_SCR;
constexpr size_t WS_CN = WS_SCR + 160 * MiB;
constexpr size_t WS_MASK = WS_SCR + 168 * MiB;
constexpr size_t WS_MEMB = WS_SCR + 176 * MiB;
constexpr size_t WS_QX0 = WS_SCR + 184 * MiB, WS_OX0 = WS_SCR + 216 * MiB;
constexpr size_t WS_HID = WS_SCR;
constexpr size_t WS_P1 = WS_SCR;
constexpr size_t WS_OCMP = WS_SCR + 128 * MiB, WS_OSLC = WS_SCR + 192 * MiB;
constexpr size_t WS_W1T = WS_SCR + 192 * MiB, WS_HIDC = WS_SCR + 196 * MiB, WS_PEB = WS_SCR + 200 * MiB;
constexpr size_t WS_QX1 = WS_SCR, WS_OX1 = WS_SCR + 32 * MiB;
constexpr size_t WS_PERMA = WS_SCR;
constexpr size_t WS_HIDM = WS_SCR + 136 * MiB;
constexpr size_t WS_END = WS_SCR + 256 * MiB;
static_assert(WS_HIDM + (size_t)MOE_CHUNK_TILES * 256 * DFFE * 2 <= WS_END, "ws");
constexpr int CW_BAR = 4096;
constexpr int CW_CNT = 16384;
constexpr int CW_CUR = 16384 + 64;

constexpr int RING_BYTES = 131072, LDSCTL_OFF = RING_BYTES, MISC_OFF = LDSCTL_OFF + 320, LDS_BYTES = 147456;

#define GAS __attribute__((address_space(1)))
#define LAS __attribute__((address_space(3)))
typedef unsigned short bf16;
typedef unsigned v4u __attribute__((ext_vector_type(4)));
typedef unsigned v2u __attribute__((ext_vector_type(2)));
typedef float f32x4 __attribute__((ext_vector_type(4)));
#define LDS_WAIT() asm volatile("s_waitcnt lgkmcnt(0)" ::: "memory")
#define WAVE_SYNC() asm volatile("s_waitcnt vmcnt(0) lgkmcnt(0)" ::: "memory")
__device__ __forceinline__ unsigned f2bf(float f) { unsigned u = __builtin_bit_cast(unsigned, f); return (u + 0x7fffu + ((u >> 16) & 1u)) >> 16; }
__device__ __forceinline__ unsigned pk2(float lo, float hi) { return f2bf(lo) | (f2bf(hi) << 16); }
__device__ __forceinline__ float bf2f(bf16 b) { return __builtin_bit_cast(float, (unsigned)b << 16); }
__device__ __forceinline__ float bflo(unsigned w) { return __builtin_bit_cast(float, w << 16); }
__device__ __forceinline__ float bfhi(unsigned w) { return __builtin_bit_cast(float, w & 0xffff0000u); }
__device__ __forceinline__ void ld8bf(const bf16* p, float* f) { const v4u w = *(const v4u*)p; f[0] = bflo(w.x); f[1] = bfhi(w.x); f[2] = bflo(w.y); f[3] = bfhi(w.y); f[4] = bflo(w.z); f[5] = bfhi(w.z); f[6] = bflo(w.w); f[7] = bfhi(w.w); }
__device__ __forceinline__ float wave_sum(float v) {
#pragma unroll
    for (int o = 1; o < 64; o <<= 1) v += __shfl_xor(v, o);
    return v;
}
__device__ __forceinline__ float dpp_f(float v, int ctrl_unused);
#define DPP_ADD_F(v, ctrl, rmask) v += __builtin_bit_cast(float, __builtin_amdgcn_update_dpp(0, __builtin_bit_cast(int, v), ctrl, rmask, 0xf, false))
__device__ __forceinline__ float wave_sum_fast(float v) {
    DPP_ADD_F(v, 0xB1, 0xf); DPP_ADD_F(v, 0x4E, 0xf); DPP_ADD_F(v, 0x141, 0xf); DPP_ADD_F(v, 0x140, 0xf); DPP_ADD_F(v, 0x142, 0xa); DPP_ADD_F(v, 0x143, 0xc);
    return __builtin_bit_cast(float, __builtin_amdgcn_readlane(__builtin_bit_cast(int, v), 63));
}
__device__ __forceinline__ float wave_max(float v) {
#pragma unroll
    for (int o = 1; o < 64; o <<= 1) v = fmaxf(v, __shfl_xor(v, o));
    return v;
}
__device__ const unsigned char BKT[112] = {16, 16, 16, 17, 17, 18, 18, 18, 19, 19, 19, 20, 20, 20, 20, 21, 21, 21, 21, 22, 22, 22, 22, 22, 23, 23, 23, 23, 23, 23, 24, 24, 24, 24, 24, 24, 25, 25, 25, 25, 25, 25, 25, 26, 26, 26, 26, 26, 26, 26, 26,
    27, 27, 27, 27, 27, 27, 27, 27, 27, 27, 28, 28, 28, 28, 28, 28, 28, 28, 28, 28, 29, 29, 29, 29, 29, 29, 29, 29, 29, 29, 29, 29, 30, 30, 30, 30, 30, 30, 30, 30, 30, 30, 30, 30, 30, 30, 31, 31, 31, 31, 31, 31, 31, 31, 31, 31, 31, 31, 31, 31, 31};
__device__ __forceinline__ int rel_bucket(int n) { return n < 16 ? n : (n >= 128 ? 31 : (int)BKT[n - 16]); }

#define XB_TMO      128
#define XB_XCNT(j)  (256  + 64 * (j))
#define XB_XSUB(j)  (1280 + 64 * (j))
#define XB_XGEN(j)  (2304 + 64 * (j))
#define XB_TOP      3328
#define XB_TOPGEN   3392
#define XCD_BAR_WORDS 3456
#define XB_SPIN_CAP (1u << 22)
__device__ __forceinline__ unsigned xb_ld(unsigned* p)              { return __hip_atomic_load(p, __ATOMIC_RELAXED, __HIP_MEMORY_SCOPE_AGENT); }
__device__ __forceinline__ unsigned xb_add(unsigned* p, unsigned v) { return __hip_atomic_fetch_add(p, v, __ATOMIC_RELAXED, __HIP_MEMORY_SCOPE_AGENT); }
__device__ __forceinline__ unsigned xb_xcc_id() { return (unsigned)__builtin_amdgcn_s_getreg((3 << 11) | 20) & 0xFu; }
#define XB_SPIN(cond, bar) do { unsigned _sp = 0; while (cond) { __builtin_amdgcn_s_sleep(1); \
    if ((++_sp & 255u) == 0u) { if (xb_ld(&(bar)[XB_TMO])) break; if (_sp > XB_SPIN_CAP) { atomicAdd(&(bar)[XB_TMO], 1u); break; } } } } while (0)
struct XcdBarrier { unsigned* bar; unsigned x; volatile LAS unsigned* st; };
__device__ __forceinline__ XcdBarrier xcd_barrier_post(unsigned* bar, volatile LAS unsigned* st) {
    XcdBarrier b; b.bar = bar; b.x = xb_xcc_id(); b.st = st;
    if (threadIdx.x == 0) (void)xb_add(&bar[XB_XCNT(b.x)], 1u);
    return b;
}
__device__ __forceinline__ void xcd_barrier_complete(unsigned* bar, unsigned x, unsigned& nloc, unsigned& nx) {
    const unsigned G = gridDim.x * gridDim.y * gridDim.z;
    unsigned sum, cnt, mine, sp = 0u;
    for (;;) {
        sum = 0u; cnt = 0u; mine = 0u;
#pragma unroll
        for (unsigned j = 0; j < 16; ++j) { const unsigned c = xb_ld(&bar[XB_XCNT(j)]); sum += c; cnt += (c > 0u) ? 1u : 0u; mine = (j == x) ? c : mine; }
        if (sum == G) break;
        __builtin_amdgcn_s_sleep(1);
        if ((++sp & 255u) == 0u) { if (xb_ld(&bar[XB_TMO])) break; if (sp > XB_SPIN_CAP) { atomicAdd(&bar[XB_TMO], 1u); break; } }
    }
    nloc = mine > 0u ? mine : 1u; nx = cnt > 0u ? cnt : 1u;
}
__device__ __forceinline__ void xcd_barrier(const XcdBarrier& b, int tid) {
    asm volatile("s_waitcnt vmcnt(0)" ::: "memory");
    __syncthreads();
    if (tid == 0) {
        unsigned* bar = b.bar;
        __builtin_amdgcn_s_waitcnt(0);
        unsigned nloc = b.st[0], nx = b.st[1];
        const unsigned old = xb_add(&bar[XB_XSUB(b.x)], 1u);
        const unsigned gen = old / nloc;
        if (old + 1u == (gen + 1u) * nloc) {
            __builtin_amdgcn_fence(__ATOMIC_RELEASE, "agent");
            asm volatile("s_waitcnt vmcnt(0)" ::: "memory");
            const unsigned og = xb_add(&bar[XB_TOP], 1u);
            const unsigned tg = og / nx;
            if (og + 1u == (tg + 1u) * nx) xb_add(&bar[XB_TOPGEN], 1u);
            else XB_SPIN(xb_ld(&bar[XB_TOPGEN]) == tg, bar);
            __builtin_amdgcn_fence(__ATOMIC_ACQUIRE, "agent");
            xb_add(&bar[XB_XGEN(b.x)], 1u);
            asm volatile("s_waitcnt vmcnt(0)" ::: "memory");
        } else {
            XB_SPIN(xb_ld(&bar[XB_XGEN(b.x)]) == gen, bar);
            __builtin_amdgcn_fence(__ATOMIC_ACQUIRE, "agent");
            asm volatile("s_waitcnt vmcnt(0)" ::: "memory");
        }
    }
    __syncthreads();
}

struct Args { const float* in[30]; float* out; unsigned char* ws; int ph_lo, ph_hi; };
enum { I_X = 0, I_MEM, I_REL, I_EV_WIN, I_EV_GAIN, I_EV_WUK, I_EV_WUV, I_EV_SINK, I_EV_WOUT, I_OD_WIN, I_OD_PEK, I_OD_W1K, I_OD_W2K, I_OD_PEV, I_OD_W1V, I_OD_W2V, I_OD_WOUT,
       I_XA_WQ, I_XA_WK, I_XA_WV, I_XA_WO, I_FF_G, I_FF_U, I_FF_D, I_MOE_R, I_MOE_G, I_MOE_U, I_MOE_D, I_LN_G, I_LN_B };

struct Frame {
    LAS unsigned char* lds;
    unsigned char* ws; float* acc;
    const float* const* in;
    int tid, lane, wave, G, gw, NGW;
};

__device__ __forceinline__ bool fresh(Frame& F, unsigned char*& ws, unsigned char* ws0, float* acc0) { int l = (int)__builtin_amdgcn_mbcnt_hi(~0u, __builtin_amdgcn_mbcnt_lo(~0u, 0u)); asm volatile("" : "+v"(l)); F.lane = l; F.tid = F.wave * 64 + l;
    ws = (unsigned char*)pg8::opaque_uniform(ws0); F.ws = ws; F.acc = (float*)pg8::opaque_uniform(acc0); return true; }
__device__ __forceinline__ bool probe_open(Frame& F, int k) { PROBE_WIN(k, 1u, F.tid); PROBE_START(1, F.tid); return true; }
__device__ __forceinline__ void probe_close(Frame& F, int k) { if (PROBE_SEL(k)) { PROBE_STOP(1, F.tid); } PROBE_WIN(k, 0u, F.tid); }
__device__ __forceinline__ void tconv_item(const float* W, int ldw, int ncols, bf16* WT, int ldt, int grp, int gstride, LAS float* scr, int kb, int nb, int lane) {
    const int k0 = 64 * kb, n0 = 32 * nb;
    const int kr = lane >> 3, n4 = (lane & 7) * 4;
    f32x4 v[8];
#pragma unroll
    for (int i = 0; i < 8; ++i) v[i] = (n0 + n4 < ncols) ? *(const f32x4*)(W + (size_t)(k0 + 8 * i + kr) * ldw + n0 + n4) : (f32x4){0.f, 0.f, 0.f, 0.f};
#pragma unroll
    for (int i = 0; i < 8; ++i) { LAS float* d = scr + (8 * i + kr) * 33 + n4; d[0] = v[i].x; d[1] = v[i].y; d[2] = v[i].z; d[3] = v[i].w; }
    LDS_WAIT();
    const int c = lane & 7;
#pragma unroll
    for (int j = 0; j < 4; ++j) { const int nn = (lane >> 3) + 8 * j, n = n0 + nn; const LAS float* s = scr + (8 * c) * 33 + nn;
        v4u o; o.x = pk2(s[0 * 33], s[1 * 33]); o.y = pk2(s[2 * 33], s[3 * 33]); o.z = pk2(s[4 * 33], s[5 * 33]); o.w = pk2(s[6 * 33], s[7 * 33]);
        const int row = (n / grp) * gstride + (n % grp);
        *(v4u*)(WT + (size_t)row * ldt + k0 + 8 * c) = o; }
    LDS_WAIT();
}
__device__ __forceinline__ void tconv(const Frame& F, const float* W, int ldw, int K, int ncols, int npad, bf16* WT, int ldt, int grp, int gstride) {
    LAS float* scr = (LAS float*)(F.lds + F.wave * 16384);
    const int nkb = K / 64, nnb = npad / 32;
    for (int it = F.gw; it < nkb * nnb; it += F.NGW) tconv_item(W, ldw, ncols, WT, ldt, grp, gstride, scr, it / nnb, it % nnb, F.lane);
}
constexpr int NOGRP = 1 << 30;

__device__ __forceinline__ void prologue(const Frame& F) {
    unsigned char* ws = F.ws;
    const int gt = F.gw * 64 + F.lane, NT = F.NGW * 64;
    bf16* win0 = (bf16*)(ws + W_IN0);
    const float* evw = F.in[I_EV_WIN];
    tconv(F, evw + 512, EVEN_COLS, 1024, 128, 128, win0 + (size_t)C0_CKV * 1024, 1024, NOGRP, 0);
    tconv(F, evw + 640, EVEN_COLS, 1024, 512, 512, win0 + (size_t)C0_QI * 1024, 1024, NOGRP, 0);
    tconv(F, evw + 1152, EVEN_COLS, 1024, 64, 64, win0 + (size_t)C0_KI * 1024, 1024, NOGRP, 0);
    tconv(F, evw + 1216, EVEN_COLS, 1024, 8, 64, win0 + (size_t)C0_WI * 1024, 1024, NOGRP, 0);
    tconv(F, evw + 1224, EVEN_COLS, 1024, 512, 512, win0 + (size_t)C0_QB * 1024, 1024, NOGRP, 0);
    tconv(F, evw + 1736, EVEN_COLS, 1024, 128, 128, win0 + (size_t)C0_KB * 1024, 1024, NOGRP, 0);
    tconv(F, evw + 1864, EVEN_COLS, 1024, 128, 128, win0 + (size_t)C0_VB * 1024, 1024, NOGRP, 0);
    bf16* wout0 = (bf16*)(ws + W_OUT0);
    const float* evo = F.in[I_EV_WOUT];
    tconv(F, evo + (size_t)512 * 1024, 1024, 512, 1024, 1024, wout0 + 1024, 1536, NOGRP, 0);
    tconv(F, F.in[I_OD_WIN], ODD_COLS, 1024, ODD_COLS, 2048, (bf16*)(ws + W_IN1), 1024, NOGRP, 0);
    tconv(F, F.in[I_OD_WOUT], 1024, 1024, 1024, 1024, (bf16*)(ws + W_OUT1), 1024, NOGRP, 0);
    for (int i = 0; i < 2; ++i) {
        tconv(F, F.in[I_XA_WQ] + (size_t)i * 1024 * 512, 512, 1024, 512, 512, (bf16*)(ws + W_XQ) + (size_t)i * 512 * 1024, 1024, NOGRP, 0);
        tconv(F, F.in[I_XA_WK] + (size_t)i * 1024 * 512, 512, 1024, 512, 512, (bf16*)(ws + W_XKV) + (size_t)i * 1024 * 1024, 1024, NOGRP, 0);
        tconv(F, F.in[I_XA_WV] + (size_t)i * 1024 * 512, 512, 1024, 512, 512, (bf16*)(ws + W_XKV) + (size_t)i * 1024 * 1024 + (size_t)512 * 1024, 1024, NOGRP, 0);
        tconv(F, F.in[I_XA_WO] + (size_t)i * 512 * 1024, 1024, 512, 1024, 1024, (bf16*)(ws + W_XO) + (size_t)i * 1024 * 512, 512, NOGRP, 0);
    }
    tconv(F, F.in[I_FF_G], DFF, 1024, DFF, DFF, (bf16*)(ws + W_FGU), 1024, 128, 256);
    tconv(F, F.in[I_FF_U], DFF, 1024, DFF, DFF, (bf16*)(ws + W_FGU) + (size_t)128 * 1024, 1024, 128, 256);
    tconv(F, F.in[I_FF_D], 1024, DFF, 1024, 1024, (bf16*)(ws + W_FD), DFF, NOGRP, 0);
    for (int e = 0; e < NE; ++e) {
        tconv(F, F.in[I_MOE_G] + (size_t)e * 1024 * DFFE, DFFE, 1024, DFFE, DFFE, (bf16*)(ws + W_MGU) + (size_t)e * 7168 * 1024, 1024, 128, 256);
        tconv(F, F.in[I_MOE_U] + (size_t)e * 1024 * DFFE, DFFE, 1024, DFFE, DFFE, (bf16*)(ws + W_MGU) + (size_t)e * 7168 * 1024 + (size_t)128 * 1024, 1024, 128, 256);
        tconv(F, F.in[I_MOE_D] + (size_t)e * DFFE * 1024, 1024, DFFE, 1024, 1024, (bf16*)(ws + W_MD) + (size_t)e * 1024 * DFFE, DFFE, NOGRP, 0);
    }
    __syncthreads();
    {
        const float* wuk = F.in[I_EV_WUK]; const float* wuv = F.in[I_EV_WUV];
        LAS float* As = (LAS float*)F.lds; LAS float* Bs = As + 128 * 65;
        for (int item = blockIdx.x; item < 256; item += F.G) {
            const int h = (item >> 4) & 7, tt = item & 15;
            if (item < 128) {
                const int k0 = 64 * tt;
                for (int i = F.tid; i < 4096; i += 512) { const int kk = i >> 6, d = i & 63; As[kk * 65 + d] = evw[(size_t)(k0 + kk) * EVEN_COLS + h * 64 + d]; }
                for (int i = F.tid; i < 8192; i += 512) Bs[i] = wuk[(size_t)h * 8192 + i];
                __syncthreads();
                const int kk = F.tid & 63, cg = F.tid >> 6; float acc[16];
#pragma unroll
                for (int j = 0; j < 16; ++j) acc[j] = 0.f;
#pragma unroll 4
                for (int d = 0; d < 64; ++d) { const float a = As[kk * 65 + d];
#pragma unroll
                    for (int j = 0; j < 16; ++j) acc[j] += a * Bs[d * 128 + cg * 16 + j]; }
#pragma unroll
                for (int j = 0; j < 16; ++j) win0[(size_t)(C0_QLAT + h * 128 + cg * 16 + j) * 1024 + k0 + kk] = (bf16)f2bf(acc[j]);
            } else {
                const int n0 = 64 * tt;
                for (int i = F.tid; i < 8192; i += 512) { const int c = i >> 6, d = i & 63; As[c * 65 + d] = wuv[(size_t)h * 8192 + i]; }
                for (int i = F.tid; i < 4096; i += 512) { const int d = i >> 6, nn = i & 63; Bs[i] = evo[(size_t)(h * 64 + d) * 1024 + n0 + nn]; }
                __syncthreads();
                const int c = F.tid & 127, ng = F.tid >> 7; float acc[16];
#pragma unroll
                for (int j = 0; j < 16; ++j) acc[j] = 0.f;
#pragma unroll 4
                for (int d = 0; d < 64; ++d) { const float a = As[c * 65 + d];
#pragma unroll
                    for (int j = 0; j < 16; ++j) acc[j] += a * Bs[d * 64 + ng * 16 + j]; }
#pragma unroll
                for (int j = 0; j < 16; ++j) wout0[(size_t)(n0 + ng * 16 + j) * 1536 + h * 128 + c] = (bf16)f2bf(acc[j]);
            }
            __syncthreads();
        }
    }
    {
        const f32x4* x4 = (const f32x4*)F.in[I_X]; v2u* hb = (v2u*)(ws + WS_HB);
        for (int i = gt; i < M * D / 4; i += 4 * NT) { f32x4 v[4];
#pragma unroll
            for (int j = 0; j < 4; ++j) v[j] = x4[i + j * NT];
#pragma unroll
            for (int j = 0; j < 4; ++j) { v2u o; o.x = pk2(v[j].x, v[j].y); o.y = pk2(v[j].z, v[j].w); hb[i + j * NT] = o; } }
        const f32x4* m4 = (const f32x4*)F.in[I_MEM]; v2u* mb = (v2u*)(ws + WS_MEMB);
        for (int i = gt; i < MMEM * D / 4; i += 4 * NT) { f32x4 v[4];
#pragma unroll
            for (int j = 0; j < 4; ++j) v[j] = m4[i + j * NT];
#pragma unroll
            for (int j = 0; j < 4; ++j) { v2u o; o.x = pk2(v[j].x, v[j].y); o.y = pk2(v[j].z, v[j].w); mb[i + j * NT] = o; } }
    }
}

template <int MODE>
__device__ __forceinline__ void ln_phase(const Frame& F, int li, const bf16* sumb) {
    const float* g = F.in[I_LN_G] + (size_t)li * D; const float* bb = F.in[I_LN_B] + (size_t)li * D;
    LAS int* lcnt = (LAS int*)F.lds;
    if (MODE == 1) { if (F.tid < 16) lcnt[F.tid] = 0; __syncthreads(); }
    f32x4 rw[MODE == 1 ? 32 : 1];
    if (MODE == 1) { const float* wr = F.in[I_MOE_R];
#pragma unroll
        for (int j = 0; j < 4; ++j)
#pragma unroll
            for (int i = 0; i < 4; ++i) { const int c = 4 * (F.lane + 64 * j) + i; rw[(4 * j + i) * 2] = *(const f32x4*)(wr + (size_t)c * 8); rw[(4 * j + i) * 2 + 1] = *(const f32x4*)(wr + (size_t)c * 8 + 4); } }
    for (int row = F.gw; row < M; row += F.NGW) {
        f32x4* p = (f32x4*)(F.acc + (size_t)row * D) + F.lane;
        f32x4 v[4]; float s = 0.f;
        if (MODE == 2) { const v2u* hp = (const v2u*)(F.ws + WS_HB + (size_t)row * D * 2) + F.lane;
#pragma unroll
            for (int j = 0; j < 4; ++j) { const v2u a = hp[64 * j]; v[j] = (f32x4){bflo(a.x), bfhi(a.x), bflo(a.y), bfhi(a.y)} * ALPHA; }
        } else { const v2u* sp = (const v2u*)(sumb + (size_t)row * D) + F.lane;
#pragma unroll
            for (int j = 0; j < 4; ++j) { const v2u a = sp[64 * j]; v[j] = (f32x4){bflo(a.x), bfhi(a.x), bflo(a.y), bfhi(a.y)}; } }
        if (MODE == 2) {
            const int p0 = ((const int*)(F.ws + WS_RTE))[2 * row], p1 = ((const int*)(F.ws + WS_RTE))[2 * row + 1]; const float w0 = ((const float*)(F.ws + WS_RTW))[2 * row], w1 = ((const float*)(F.ws + WS_RTW))[2 * row + 1];
            const v2u* y0 = (const v2u*)(F.ws + WS_PERMA + (size_t)p0 * D * 2) + F.lane; const v2u* y1 = (const v2u*)(F.ws + WS_PERMA + (size_t)p1 * D * 2) + F.lane;
#pragma unroll
            for (int j = 0; j < 4; ++j) { const v2u a = y0[64 * j], b = y1[64 * j];
                v[j].x += w0 * bflo(a.x) + w1 * bflo(b.x); v[j].y += w0 * bfhi(a.x) + w1 * bfhi(b.x); v[j].z += w0 * bflo(a.y) + w1 * bflo(b.y); v[j].w += w0 * bfhi(a.y) + w1 * bfhi(b.y); } }
#pragma unroll
        for (int j = 0; j < 4; ++j) s += (v[j].x + v[j].y) + (v[j].z + v[j].w);
        const float mean = wave_sum_fast(s) * (1.f / D); float s2 = 0.f;
#pragma unroll
        for (int j = 0; j < 4; ++j) { v[j] = v[j] - mean; s2 += (v[j].x * v[j].x + v[j].y * v[j].y) + (v[j].z * v[j].z + v[j].w * v[j].w); }
        const float rstd = 1.f / sqrtf(wave_sum_fast(s2) * (1.f / D) + LN_EPS);
#pragma unroll
        for (int j = 0; j < 4; ++j) { const f32x4 gg = ((const f32x4*)g)[F.lane + 64 * j], b4 = ((const f32x4*)bb)[F.lane + 64 * j]; v[j] = v[j] * rstd * gg + b4; }
        if (MODE == 2) {
#pragma unroll
            for (int j = 0; j < 4; ++j) p[64 * j] = v[j];
        } else {
            v2u* hb = (v2u*)(F.ws + WS_HB + (size_t)row * D * 2) + F.lane;
#pragma unroll
            for (int j = 0; j < 4; ++j) { v2u o; o.x = pk2(v[j].x, v[j].y); o.y = pk2(v[j].z, v[j].w); hb[64 * j] = o; }
        }
        if (MODE == 1) {
            float lg[8];
#pragma unroll
            for (int e = 0; e < 8; ++e) lg[e] = 0.f;
#pragma unroll
            for (int j = 0; j < 4; ++j)
#pragma unroll
                for (int i = 0; i < 4; ++i) { const f32x4 w0 = rw[(4 * j + i) * 2], w1 = rw[(4 * j + i) * 2 + 1]; const float y = v[j][i];
                    lg[0] += y * w0.x; lg[1] += y * w0.y; lg[2] += y * w0.z; lg[3] += y * w0.w; lg[4] += y * w1.x; lg[5] += y * w1.y; lg[6] += y * w1.z; lg[7] += y * w1.w; }
#pragma unroll
            for (int e = 0; e < 8; ++e) lg[e] = wave_sum_fast(lg[e]);
            int e0 = 0; float v0 = lg[0];
#pragma unroll
            for (int e = 1; e < 8; ++e) if (lg[e] > v0) { v0 = lg[e]; e0 = e; }
            int e1 = -1; float v1 = -3.0e38f;
#pragma unroll
            for (int e = 0; e < 8; ++e) if (e != e0 && lg[e] > v1) { v1 = lg[e]; e1 = e; }
            const float w0 = 1.f / (1.f + __expf(v1 - v0)), w1 = 1.f - w0;
            if (F.lane == 0) { int* rte = (int*)(F.ws + WS_RTE); float* rtw = (float*)(F.ws + WS_RTW); rte[2 * row] = e0; rte[2 * row + 1] = e1; rtw[2 * row] = w0; rtw[2 * row + 1] = w1;
                __hip_atomic_fetch_add(&lcnt[e0], 1, __ATOMIC_RELAXED, __HIP_MEMORY_SCOPE_WORKGROUP); __hip_atomic_fetch_add(&lcnt[8 + e1], 1, __ATOMIC_RELAXED, __HIP_MEMORY_SCOPE_WORKGROUP); }
        }
    }
    if (MODE == 1) { __syncthreads(); if (F.tid < 16) { const int c = lcnt[F.tid]; if (c) atomicAdd((unsigned*)(F.ws + WS_CTL) + CW_CNT + F.tid, (unsigned)c); } }
}

__device__ __forceinline__ void moe_dispatch(const Frame& F) {
    unsigned* ctl = (unsigned*)(F.ws + WS_CTL);
    int* tile_exp = (int*)(F.ws + WS_TILEEXP); int* rowtok = (int*)(F.ws + WS_ROWTOK); float* roww = (float*)(F.ws + WS_ROWW);
    LAS int* seg = (LAS int*)F.lds;
    if (F.tid == 0) { int run = 0;
#pragma unroll 1
        for (int sgi = 0; sgi < 16; ++sgi) { if ((sgi & 7) == 0) seg[32 + (sgi >> 3)] = run >> 8; seg[sgi] = run; const int c = (int)__hip_atomic_load(ctl + CW_CNT + sgi, __ATOMIC_RELAXED, __HIP_MEMORY_SCOPE_AGENT); seg[16 + sgi] = c; run += (c + 255) & ~255; }
        seg[34] = run >> 8; }
    __syncthreads();
    if (blockIdx.x == 0) {
#pragma unroll 1
        for (int sgi = 0; sgi < 16; ++sgi) { const int c = seg[16 + sgi], st = seg[sgi], en = st + ((c + 255) & ~255);
            for (int t = (st >> 8) + F.tid; t < (en >> 8); t += 512) tile_exp[t] = sgi & 7;
            for (int r = st + c + F.tid; r < en; r += 512) { rowtok[r] = -1; roww[r] = 0.f; } }
        if (F.tid < 3) tile_exp[512 + F.tid] = seg[32 + F.tid];
    }
    const int* rte = (const int*)(F.ws + WS_RTE); const float* rtw = (const float*)(F.ws + WS_RTW);
    LAS int* lcnt = seg + 64; LAS int* gb = seg + 96; LAS int* posl = seg + 128;
    for (int chunk = blockIdx.x; chunk < M / 128; chunk += F.G) {
        if (F.tid < 16) lcnt[F.tid] = 0;
        __syncthreads();
        const int tok = chunk * 128 + (F.tid & 127); int e0 = 0, e1 = 0, r0 = 0, r1 = 0;
        if (F.tid < 128) { e0 = rte[2 * tok]; e1 = rte[2 * tok + 1]; r0 = __hip_atomic_fetch_add(&lcnt[e0], 1, __ATOMIC_RELAXED, __HIP_MEMORY_SCOPE_WORKGROUP); r1 = __hip_atomic_fetch_add(&lcnt[8 + e1], 1, __ATOMIC_RELAXED, __HIP_MEMORY_SCOPE_WORKGROUP); }
        __syncthreads();
        if (F.tid < 16) { const int c = lcnt[F.tid]; gb[F.tid] = c ? (int)atomicAdd(ctl + CW_CUR + F.tid, (unsigned)c) : 0; }
        __syncthreads();
        if (F.tid < 128) { const int p0 = seg[e0] + gb[e0] + r0, p1 = seg[8 + e1] + gb[8 + e1] + r1; posl[2 * F.tid] = p0; posl[2 * F.tid + 1] = p1;
            ((int*)(F.ws + WS_RTE))[2 * tok] = p0; ((int*)(F.ws + WS_RTE))[2 * tok + 1] = p1; }
        __syncthreads();
#pragma unroll 1
        for (int i0 = 0; i0 < 16; i0 += 8) {
            v4u a[8], b[8];
#pragma unroll
            for (int k = 0; k < 8; ++k) { const v4u* src = (const v4u*)(F.ws + WS_HB + (size_t)(chunk * 128 + F.wave * 16 + i0 + k) * D * 2); a[k] = src[F.lane]; b[k] = src[F.lane + 64]; }
#pragma unroll
            for (int k = 0; k < 8; ++k) { const int p0 = posl[2 * (F.wave * 16 + i0 + k)], p1 = posl[2 * (F.wave * 16 + i0 + k) + 1];
                v4u* d0 = (v4u*)(F.ws + WS_PERMA + (size_t)p0 * D * 2); v4u* d1 = (v4u*)(F.ws + WS_PERMA + (size_t)p1 * D * 2);
                d0[F.lane] = a[k]; d0[F.lane + 64] = b[k]; d1[F.lane] = a[k]; d1[F.lane + 64] = b[k]; } }
        __syncthreads();
    }
    __syncthreads();
}

__device__ __forceinline__ void cn_phase(const Frame& F) {
    const bf16* P0 = (const bf16*)(F.ws + WS_P0); bf16* CN = (bf16*)(F.ws + WS_CN); const float* gain = F.in[I_EV_GAIN];
    const float g0 = gain[2 * F.lane], g1 = gain[2 * F.lane + 1];
    for (int row0 = F.gw * 8; row0 < M; row0 += F.NGW * 8) {
        unsigned w[8];
#pragma unroll
        for (int i = 0; i < 8; ++i) w[i] = *(const unsigned*)(P0 + (size_t)(row0 + i) * P0_LD + C0_CKV + 2 * F.lane);
#pragma unroll
        for (int i = 0; i < 8; ++i) { const float a = bflo(w[i]), b = bfhi(w[i]);
            const float ms = wave_sum_fast(a * a + b * b) * (1.f / 128.f); const float r = 1.f / sqrtf(ms + LN_EPS);
            *(unsigned*)(CN + (size_t)(row0 + i) * 128 + 2 * F.lane) = pk2(a * r * g0, b * r * g1); }
    }
}

__device__ __forceinline__ unsigned fkey(float x) { unsigned b = __builtin_bit_cast(unsigned, x); if (b == 0x80000000u) b = 0u; return (b & 0x80000000u) ? ~b : (b | 0x80000000u); }
__device__ __forceinline__ void idx_phase(const Frame& F) {
    const bf16* P0 = (const bf16*)(F.ws + WS_P0); unsigned* MASK = (unsigned*)(F.ws + WS_MASK);
    LAS float* qi_s = (LAS float*)F.lds; LAS float* wi_s = qi_s + 4096; LAS float* sc = wi_s + 64;
    for (int item = blockIdx.x; item < NB * (S / 8); item += F.G) {
        const int b = item / (S / 8), t0 = (item % (S / 8)) * 8;
        for (int i = F.tid; i < 4096; i += 512) { const int q = i >> 9, e = i & 511; qi_s[i] = bf2f(P0[(size_t)(b * S + t0 + q) * P0_LD + C0_QI + e]); }
        if (F.tid < 64) { const int q = F.tid >> 3, h = F.tid & 7; wi_s[F.tid] = bf2f(P0[(size_t)(b * S + t0 + q) * P0_LD + C0_WI + h]) * (0.35355339059f * 0.125f); }
        __syncthreads();
        const int nk = t0 + 8;
        for (int s = F.tid; s < nk; s += 512) {
            float kf[64]; const bf16* kr = P0 + (size_t)(b * S + s) * P0_LD + C0_KI;
#pragma unroll
            for (int j = 0; j < 8; ++j) ld8bf(kr + 8 * j, kf + 8 * j);
#pragma unroll 1
            for (int q = 0; q < 8; ++q) { float a = 0.f;
#pragma unroll 1
                for (int h = 0; h < 8; ++h) { const LAS float* qp = qi_s + q * 512 + h * 64; float dot = 0.f;
#pragma unroll
                    for (int d = 0; d < 64; ++d) dot += qp[d] * kf[d];
                    a += wi_s[q * 8 + h] * fmaxf(dot, 0.f); }
                sc[q * 2048 + s] = a; }
        }
        __syncthreads();
        {
            const int q = F.wave, t = t0 + q, n = t + 1, row = b * S + t; unsigned myword = 0u;
            if (n <= 256) { const int cb = n - 32 * F.lane; myword = cb >= 32 ? 0xffffffffu : (cb <= 0 ? 0u : ((1u << cb) - 1u)); }
            else {
                LAS unsigned* uk = (LAS unsigned*)(sc + q * 2048);
#pragma unroll 4
                for (int i = 0; i < 32; ++i) { const int s = F.lane + 64 * i; const unsigned k = (s < n) ? fkey(sc[q * 2048 + s]) : 0u; uk[s] = k; }
                LDS_WAIT();
                unsigned prefix = 0u;
#pragma unroll 1
                for (int bit = 31; bit >= 0; --bit) { const unsigned cand = prefix | (1u << bit); int c = 0;
#pragma unroll 8
                    for (int i = 0; i < 32; ++i) c += (uk[F.lane + 64 * i] >= cand) ? 1 : 0;
#pragma unroll
                    for (int o = 1; o < 64; o <<= 1) c += __shfl_xor(c, o);
                    if (c >= 256) prefix = cand; }
                int cgt = 0;
#pragma unroll 8
                for (int i = 0; i < 32; ++i) cgt += (uk[F.lane + 64 * i] > prefix) ? 1 : 0;
#pragma unroll
                for (int o = 1; o < 64; o <<= 1) cgt += __shfl_xor(cgt, o);
                const int need = 256 - cgt; int run = 0;
#pragma unroll 1
                for (int i = 0; i < 32; ++i) { const unsigned u = uk[F.lane + 64 * i]; const bool eq = (u == prefix); const unsigned long long em = __ballot(eq); const int rank = run + __popcll(em & ((1ull << F.lane) - 1ull));
                    const bool sel = (u > prefix) || (eq && rank < need); run += __popcll(em);
                    const unsigned long long sm = __ballot(sel);
                    if (F.lane == 2 * i) myword = (unsigned)sm; if (F.lane == 2 * i + 1) myword = (unsigned)(sm >> 32); }
            }
            MASK[(size_t)row * 64 + F.lane] = myword;
        }
        __syncthreads();
    }
}

__device__ __forceinline__ void dsa_phase(const Frame& F) {
    bf16* P0 = (bf16*)(F.ws + WS_P0); const bf16* CN = (const bf16*)(F.ws + WS_CN); const unsigned* MASK = (const unsigned*)(F.ws + WS_MASK); const float* rel = F.in[I_REL];
    LAS float* ql = (LAS float*)(F.lds + F.wave * 13312); LAS float* pl = ql + 1024; LAS int* idx = (LAS int*)(pl + 2048);
    for (int row = F.gw; row < M; row += F.NGW) {
        const int b = row / S, t = row % S;
        const unsigned w = MASK[(size_t)row * 64 + F.lane]; const int c = __popc(w);
        int incl = c;
#pragma unroll
        for (int o = 1; o < 64; o <<= 1) { const int v = __shfl_up(incl, o); if (F.lane >= o) incl += v; }
        const int total = __shfl(incl, 63); int pos = incl - c; unsigned ww = w;
        while (ww) { const int bit = __ffs(ww) - 1; idx[pos++] = 32 * F.lane + bit; ww &= ww - 1u; }
#pragma unroll
        for (int i = 0; i < 16; ++i) ql[F.lane + 64 * i] = bf2f(P0[(size_t)row * P0_LD + C0_QLAT + F.lane + 64 * i]);
        WAVE_SYNC();
        float lg[4][8]; bool val[4];
#pragma unroll
        for (int kk = 0; kk < 4; ++kk) { const int k = F.lane + 64 * kk; val[kk] = k < total; const int key = val[kk] ? idx[k] : 0;
            float a[8];
#pragma unroll
            for (int h = 0; h < 8; ++h) a[h] = 0.f;
            const bf16* cr = CN + (size_t)(b * S + key) * 128;
#pragma unroll 1
            for (int j = 0; j < 16; ++j) { float cv[8]; ld8bf(cr + 8 * j, cv);
#pragma unroll
                for (int h = 0; h < 8; ++h)
#pragma unroll
                    for (int i = 0; i < 8; ++i) a[h] += ql[h * 128 + 8 * j + i] * cv[i]; }
            const int bk = rel_bucket(t - key);
#pragma unroll
            for (int h = 0; h < 8; ++h) lg[kk][h] = val[kk] ? (a[h] * 0.125f + rel[bk * 16 + h]) : -1.0e30f;
        }
#pragma unroll
        for (int h = 0; h < 8; ++h) { float m = fmaxf(fmaxf(lg[0][h], lg[1][h]), fmaxf(lg[2][h], lg[3][h])); m = wave_max(m);
            float e[4], s = 0.f;
#pragma unroll
            for (int kk = 0; kk < 4; ++kk) { e[kk] = val[kk] ? __expf(lg[kk][h] - m) : 0.f; s += e[kk]; }
            s = wave_sum(s); const float inv = 1.f / s;
#pragma unroll
            for (int kk = 0; kk < 4; ++kk) pl[h * 256 + F.lane + 64 * kk] = e[kk] * inv; }
        WAVE_SYNC();
        float a0[8], a1[8];
#pragma unroll
        for (int h = 0; h < 8; ++h) { a0[h] = 0.f; a1[h] = 0.f; }
        for (int k = 0; k < total; ++k) { const int key = idx[k]; const unsigned pr = *(const unsigned*)(CN + (size_t)(b * S + key) * 128 + 2 * F.lane); const float vx = bflo(pr), vy = bfhi(pr);
#pragma unroll
            for (int h = 0; h < 8; ++h) { const float p = pl[h * 256 + k]; a0[h] += p * vx; a1[h] += p * vy; } }
#pragma unroll
        for (int h = 0; h < 8; ++h) *(unsigned*)(P0 + (size_t)row * P0_LD + C0_QLAT + h * 128 + 2 * F.lane) = pk2(a0[h], a1[h]);
        WAVE_SYNC();
    }
}

template <int W, int NH, int GRPSZ, bool SINK, bool NSA>
__device__ __forceinline__ void banded_phase(const Frame& F, bf16* P, int ld, int cq, int ck, int cv, int relc0) {
    const float* rel = F.in[I_REL]; const float* sinks = F.in[I_EV_SINK];
    const bf16* OC = (const bf16*)(F.ws + WS_OCMP); const bf16* OS = (const bf16*)(F.ws + WS_OSLC);
    constexpr int NTG = S / 64;
    for (int it = F.gw; it < NB * NH * NTG; it += F.NGW) {
        const int tg = it % NTG, h = (it / NTG) % NH, b = it / (NTG * NH);
        const int t = tg * 64 + F.lane, row = b * S + t, kvh = h / GRPSZ;
        float q[64], acc[64];
        { const bf16* qr = P + (size_t)row * ld + cq + h * 64;
#pragma unroll
          for (int j = 0; j < 8; ++j) ld8bf(qr + 8 * j, q + 8 * j); }
#pragma unroll
        for (int d = 0; d < 64; ++d) acc[d] = 0.f;
        float m = SINK ? sinks[h] : -1.0e30f, l = SINK ? 1.f : 0.f;
#pragma unroll 1
        for (int j = 0; j < W; ++j) { const int s = t - j;
            const float bias = rel[rel_bucket(j) * 16 + relc0 + h];
            if (s >= 0) { const bf16* kr = P + (size_t)(b * S + s) * ld + ck + kvh * 64; float dot = 0.f;
#pragma unroll
                for (int jj = 0; jj < 8; ++jj) { float kf[8]; ld8bf(kr + 8 * jj, kf);
#pragma unroll
                    for (int i = 0; i < 8; ++i) dot += q[8 * jj + i] * kf[i]; }
                const float lgt = dot * 0.125f + bias, mn = fmaxf(m, lgt), corr = __expf(m - mn), p = __expf(lgt - mn);
                l = l * corr + p; m = mn;
                const bf16* vr = P + (size_t)(b * S + s) * ld + cv + kvh * 64;
#pragma unroll
                for (int jj = 0; jj < 8; ++jj) { float vf[8]; ld8bf(vr + 8 * jj, vf);
#pragma unroll
                    for (int i = 0; i < 8; ++i) acc[8 * jj + i] = acc[8 * jj + i] * corr + p * vf[i]; } } }
        const float inv = 1.f / l;
        float g0 = 0.f, g1 = 0.f, g2 = 1.f;
        if (NSA) { const bf16* gr = P + (size_t)row * ld + C1_GL + h * 3; g0 = 1.f / (1.f + __expf(-bf2f(gr[0]))); g1 = 1.f / (1.f + __expf(-bf2f(gr[1]))); g2 = 1.f / (1.f + __expf(-bf2f(gr[2]))); }
        bf16* orow = P + (size_t)row * ld + cq + h * 64;
#pragma unroll
        for (int jj = 0; jj < 8; ++jj) { float o[8];
#pragma unroll
            for (int i = 0; i < 8; ++i) o[i] = acc[8 * jj + i] * inv;
            if (NSA) { float c8[8], s8[8]; ld8bf(OC + (size_t)row * D + h * 64 + 8 * jj, c8); ld8bf(OS + (size_t)row * D + h * 64 + 8 * jj, s8);
#pragma unroll
                for (int i = 0; i < 8; ++i) o[i] = g0 * c8[i] + g1 * s8[i] + g2 * o[i]; }
            v4u w; w.x = pk2(o[0], o[1]); w.y = pk2(o[2], o[3]); w.z = pk2(o[4], o[5]); w.w = pk2(o[6], o[7]);
            *(v4u*)(orow + 8 * jj) = w; }
    }
}

__device__ __forceinline__ void xattn_phase(const Frame& F, const bf16* Q, const bf16* KV, bf16* O) {
    for (int it = F.gw; it < NB * 4 * (S / 32); it += F.NGW) {
        const int tg = it % (S / 32), h = (it / (S / 32)) % 4, b = it / ((S / 32) * 4);
        const int tok = tg * 32 + (F.lane >> 1), half = F.lane & 1, row = b * S + tok;
        float q[64], acc[64];
        { const bf16* qr = Q + (size_t)row * 512 + h * 128 + half * 64;
#pragma unroll
          for (int j = 0; j < 8; ++j) ld8bf(qr + 8 * j, q + 8 * j); }
#pragma unroll
        for (int d = 0; d < 64; ++d) acc[d] = 0.f;
        float m = -1.0e30f, l = 0.f;
#pragma unroll 1
        for (int mm = 0; mm < MEML; ++mm) { const bf16* kr = KV + (size_t)(b * MEML + mm) * 1024 + h * 128 + half * 64; float dot = 0.f;
#pragma unroll
            for (int jj = 0; jj < 8; ++jj) { float kf[8]; ld8bf(kr + 8 * jj, kf);
#pragma unroll
                for (int i = 0; i < 8; ++i) dot += q[8 * jj + i] * kf[i]; }
            dot += __shfl_xor(dot, 1);
            const float lgt = dot * 0.08838834764831845f, mn = fmaxf(m, lgt), corr = __expf(m - mn), p = __expf(lgt - mn);
            l = l * corr + p; m = mn;
            const bf16* vr = kr + 512;
#pragma unroll
            for (int jj = 0; jj < 8; ++jj) { float vf[8]; ld8bf(vr + 8 * jj, vf);
#pragma unroll
                for (int i = 0; i < 8; ++i) acc[8 * jj + i] = acc[8 * jj + i] * corr + p * vf[i]; } }
        const float inv = 1.f / l; bf16* orow = O + (size_t)row * 512 + h * 128 + half * 64;
#pragma unroll
        for (int jj = 0; jj < 8; ++jj) { v4u w; w.x = pk2(acc[8 * jj] * inv, acc[8 * jj + 1] * inv); w.y = pk2(acc[8 * jj + 2] * inv, acc[8 * jj + 3] * inv); w.z = pk2(acc[8 * jj + 4] * inv, acc[8 * jj + 5] * inv); w.w = pk2(acc[8 * jj + 6] * inv, acc[8 * jj + 7] * inv);
            *(v4u*)(orow + 8 * jj) = w; }
    }
}

__device__ __forceinline__ float gelu_tanh(float x) { const float u = 0.7978845608028654f * (x + 0.044715f * x * x * x); return 0.5f * x * (1.f + tanhf(u)); }
__device__ __forceinline__ void cmp_mlp_phase(const Frame& F) {
    const bf16* P1 = (const bf16*)(F.ws + WS_P1);
    LAS float* blk = (LAS float*)F.lds; LAS float* part = blk + 2048; LAS float* hid = part + 512;
    for (int item = blockIdx.x; item < 2 * NB * NCMP * 2; item += F.G) {
        const int g = item & 1, n = (item >> 1) % NCMP, b = ((item >> 1) / NCMP) % NB, which = (item >> 1) / (NCMP * NB);
        const float* pe = which ? F.in[I_OD_PEV] : F.in[I_OD_PEK]; const float* w1 = which ? F.in[I_OD_W1V] : F.in[I_OD_W1K]; const float* w2 = which ? F.in[I_OD_W2V] : F.in[I_OD_W2K];
        bf16* outp = (bf16*)(F.ws + (which ? WS_VC : WS_KC)) + ((size_t)(b * 2 + g) * 128 + n) * 64;
        const int col0 = (which ? C1_VC : C1_KC) + g * 64;
        for (int i = F.tid; i < 2048; i += 512) { const int l = i >> 6, d = i & 63; blk[i] = bf2f(P1[(size_t)(b * S + 16 * n + l) * P1_LD + col0 + d]) + pe[i]; }
        __syncthreads();
        { const int j = F.tid & 127, pp = F.tid >> 7; float a = 0.f; const float* wp = w1 + (size_t)(pp * 512) * 128 + j; const LAS float* bp = blk + pp * 512;
#pragma unroll 8
          for (int kk = 0; kk < 512; ++kk) a += bp[kk] * wp[(size_t)kk * 128];
          part[F.tid] = a; }
        __syncthreads();
        if (F.tid < 128) hid[F.tid] = gelu_tanh((part[F.tid] + part[F.tid + 128]) + (part[F.tid + 256] + part[F.tid + 384]));
        __syncthreads();
        if (F.tid < 64) { float a = 0.f;
#pragma unroll 8
            for (int j = 0; j < 128; ++j) a += hid[j] * w2[j * 64 + F.tid];
            outp[F.tid] = (bf16)f2bf(a); if (n == NCMP - 1) outp[64 + F.tid] = 0; }
        __syncthreads();
    }
}

__device__ __forceinline__ void cmp_attn_phase(const Frame& F) {
    const bf16* P1 = (const bf16*)(F.ws + WS_P1); const float* KC = (const float*)(F.ws + WS_KC); const float* VC = (const float*)(F.ws + WS_VC);
    bf16* OC = (bf16*)(F.ws + WS_OCMP); unsigned* SELM = (unsigned*)(F.ws + WS_SELM); const float* rel = F.in[I_REL];
    LAS float* qs = (LAS float*)(F.lds + F.wave * 8192); LAS float* pl = qs + 512; LAS float* psum = pl + 1024;
    for (int it = F.gw; it < M * 2; it += F.NGW) {
        const int g = it & 1, row = it >> 1, b = row / S, t = row % S;
        const int nv = (t >= 31) ? ((t - 31) / 16 + 1) : 0;
#pragma unroll
        for (int i = 0; i < 8; ++i) qs[F.lane + 64 * i] = bf2f(P1[(size_t)row * P1_LD + C1_Q + g * 512 + F.lane + 64 * i]);
        WAVE_SYNC();
        float lg[2][8]; bool val[2];
#pragma unroll
        for (int kk = 0; kk < 2; ++kk) { const int n = F.lane + 64 * kk; val[kk] = n < nv; const int nn = val[kk] ? n : 0;
            const float* kr = KC + ((size_t)(b * NCMP + nn) * 2 + g) * 64; float a[8];
#pragma unroll
            for (int h = 0; h < 8; ++h) a[h] = 0.f;
#pragma unroll 1
            for (int j = 0; j < 16; ++j) { const f32x4 kv = *(const f32x4*)(kr + 4 * j);
#pragma unroll
                for (int h = 0; h < 8; ++h) a[h] += qs[h * 64 + 4 * j] * kv.x + qs[h * 64 + 4 * j + 1] * kv.y + qs[h * 64 + 4 * j + 2] * kv.z + qs[h * 64 + 4 * j + 3] * kv.w; }
            const int bk = rel_bucket(val[kk] ? (t - (16 * nn + 31)) : 0);
#pragma unroll
            for (int h = 0; h < 8; ++h) lg[kk][h] = val[kk] ? (a[h] * 0.125f + rel[bk * 16 + g * 8 + h]) : -1.0e30f; }
        float ps[2] = {0.f, 0.f};
#pragma unroll
        for (int h = 0; h < 8; ++h) { float m = wave_max(fmaxf(lg[0][h], lg[1][h]));
            float e0 = val[0] ? __expf(lg[0][h] - m) : 0.f, e1 = val[1] ? __expf(lg[1][h] - m) : 0.f;
            const float s = wave_sum(e0 + e1); const float inv = (nv > 0) ? 1.f / s : 0.f; e0 *= inv; e1 *= inv;
            pl[h * 128 + F.lane] = e0; pl[h * 128 + 64 + F.lane] = e1; ps[0] += e0; ps[1] += e1; }
        psum[F.lane] = ps[0]; psum[64 + F.lane] = ps[1];
        WAVE_SYNC();
        float scj = -3.0e38f; bool adm = false;
        if (F.lane < 32) { const int j = F.lane; float p = 0.f;
#pragma unroll
            for (int n = 4 * j - 1; n <= 4 * j + 3; ++n) if (n >= 0 && n < NCMP) p += psum[n];
            const int blkq = t >> 6; adm = (64 * j <= t); const bool forced = (j == 0) || (j == blkq) || (j == blkq - 1);
            scj = adm ? (p + (forced ? 1.0e6f : 0.f)) : -1.0e30f; }
        int rank = 0;
#pragma unroll 1
        for (int i = 0; i < 32; ++i) { const float si = __shfl(scj, i); rank += (si > scj || (si == scj && i < F.lane)) ? 1 : 0; }
        const unsigned long long sm = __ballot(F.lane < 32 && adm && rank < 8);
        if (F.lane == 0) SELM[(size_t)row * 2 + g] = (unsigned)sm;
        float o[8];
#pragma unroll
        for (int h = 0; h < 8; ++h) o[h] = 0.f;
        for (int n = 0; n < nv; ++n) { const float v = VC[((size_t)(b * NCMP + n) * 2 + g) * 64 + F.lane];
#pragma unroll
            for (int h = 0; h < 8; ++h) o[h] += pl[h * 128 + n] * v; }
#pragma unroll
        for (int h = 0; h < 8; ++h) OC[(size_t)row * D + (g * 8 + h) * 64 + F.lane] = (bf16)f2bf(o[h]);
        WAVE_SYNC();
    }
}

__device__ __forceinline__ void slc_attn_phase(const Frame& F) {
    const bf16* P1 = (const bf16*)(F.ws + WS_P1); const unsigned* SELM = (const unsigned*)(F.ws + WS_SELM); bf16* OS = (bf16*)(F.ws + WS_OSLC); const float* rel = F.in[I_REL];
    LAS float* qs = (LAS float*)(F.lds + F.wave * 4096); LAS float* pb = qs + 512;
    for (int it = F.gw; it < M * 2; it += F.NGW) {
        const int g = it & 1, row = it >> 1, b = row / S, t = row % S;
#pragma unroll
        for (int i = 0; i < 8; ++i) qs[F.lane + 64 * i] = bf2f(P1[(size_t)row * P1_LD + C1_Q + g * 512 + F.lane + 64 * i]);
        WAVE_SYNC();
        unsigned sel = SELM[(size_t)row * 2 + g];
        float m[8], l[8], acc[8];
#pragma unroll
        for (int h = 0; h < 8; ++h) { m[h] = -1.0e30f; l[h] = 0.f; acc[h] = 0.f; }
        while (sel) { const int jb = __ffs(sel) - 1; sel &= sel - 1u;
            const int kpos = 64 * jb + F.lane; const bool valid = kpos <= t;
            const bf16* kr = P1 + (size_t)(b * S + kpos) * P1_LD + C1_KS + g * 64; float a[8];
#pragma unroll
            for (int h = 0; h < 8; ++h) a[h] = 0.f;
#pragma unroll 1
            for (int j = 0; j < 8; ++j) { float kf[8]; ld8bf(kr + 8 * j, kf);
#pragma unroll
                for (int h = 0; h < 8; ++h)
#pragma unroll
                    for (int i = 0; i < 8; ++i) a[h] += qs[h * 64 + 8 * j + i] * kf[i]; }
            const int bk = rel_bucket(valid ? (t - kpos) : 0);
            float corr[8];
#pragma unroll
            for (int h = 0; h < 8; ++h) { const float lgt = valid ? (a[h] * 0.125f + rel[bk * 16 + g * 8 + h]) : -1.0e30f;
                const float bm = wave_max(lgt), mn = fmaxf(m[h], bm); corr[h] = __expf(m[h] - mn); const float p = valid ? __expf(lgt - mn) : 0.f;
                l[h] = l[h] * corr[h] + wave_sum(p); m[h] = mn; pb[h * 64 + F.lane] = p; }
            WAVE_SYNC();
            const bf16* vb = P1 + (size_t)(b * S + 64 * jb) * P1_LD + C1_VS + g * 64 + F.lane;
            float add[8];
#pragma unroll
            for (int h = 0; h < 8; ++h) add[h] = 0.f;
            for (int k = 0; k < 64; ++k) { const float v = bf2f(vb[(size_t)k * P1_LD]);
#pragma unroll
                for (int h = 0; h < 8; ++h) add[h] += pb[h * 64 + k] * v; }
#pragma unroll
            for (int h = 0; h < 8; ++h) acc[h] = acc[h] * corr[h] + add[h];
            WAVE_SYNC();
        }
#pragma unroll
        for (int h = 0; h < 8; ++h) OS[(size_t)row * D + (g * 8 + h) * 64 + F.lane] = (bf16)f2bf(acc[h] / l[h]);
    }
}

namespace fa {
typedef short bf16x8 __attribute__((ext_vector_type(8)));
typedef short bf16x4 __attribute__((ext_vector_type(4)));
typedef float f32x16 __attribute__((ext_vector_type(16)));
constexpr int VSTR = 68;
__device__ __forceinline__ float xhalf_max(float x) { const auto r = __builtin_amdgcn_permlane32_swap(__builtin_bit_cast(unsigned, x), __builtin_bit_cast(unsigned, x), false, false);
    return fmaxf(__builtin_bit_cast(float, (unsigned)r[0]), __builtin_bit_cast(float, (unsigned)r[1])); }
__device__ __forceinline__ float xhalf_sum(float x) { const auto r = __builtin_amdgcn_permlane32_swap(__builtin_bit_cast(unsigned, x), __builtin_bit_cast(unsigned, x), false, false);
    return __builtin_bit_cast(float, (unsigned)r[0]) + __builtin_bit_cast(float, (unsigned)r[1]); }
template <int HDK, int HDV> struct Geo { static constexpr int KSTR = HDK + 8, KBYTES = 64 * KSTR * 2, VBYTES = HDV * VSTR * 2, BUF = KBYTES + VBYTES; };
template <int HDK, int HDV, bool KV_SAME> struct Stage { v4u k[HDK / 64]; v4u v[KV_SAME ? 1 : HDV / 64]; };

template <int HDK, int HDV, bool KV_SAME, class P>
__device__ __forceinline__ void load_tile(Stage<HDK, HDV, KV_SAME>& st, const P& pol, int j, int tid) {
#pragma unroll
    for (int i = 0; i < HDK / 64; ++i) { const int c = tid + 512 * i, r = c / (HDK / 8), ch = c % (HDK / 8); st.k[i] = *(const v4u*)(pol.krow(j, r) + 8 * ch); }
    if (!KV_SAME) {
#pragma unroll
        for (int i = 0; i < HDV / 64; ++i) { const int c = tid + 512 * i, r = c / (HDV / 8), ch = c % (HDV / 8); st.v[i] = *(const v4u*)(pol.vrow(j, r) + 8 * ch); }
    }
}
template <int HDK, int HDV, bool KV_SAME>
__device__ __forceinline__ void store_tile(const Stage<HDK, HDV, KV_SAME>& st, LAS unsigned char* buf, int tid) {
    typedef Geo<HDK, HDV> G;
    LAS bf16* Ks = (LAS bf16*)buf; LAS bf16* Vt = (LAS bf16*)(buf + G::KBYTES);
#pragma unroll
    for (int i = 0; i < HDK / 64; ++i) { const int c = tid + 512 * i, r = c / (HDK / 8), ch = c % (HDK / 8); *(LAS v4u*)(Ks + r * G::KSTR + 8 * ch) = st.k[i]; }
#pragma unroll
    for (int i = 0; i < HDV / 64; ++i) { const int c = tid + 512 * i, r = c / (HDV / 8), ch = c % (HDV / 8); const v4u w = KV_SAME ? st.k[i] : st.v[i];
        LAS bf16* vp = Vt + (8 * ch) * VSTR + r;
        vp[0 * VSTR] = (bf16)(w.x & 0xffffu); vp[1 * VSTR] = (bf16)(w.x >> 16); vp[2 * VSTR] = (bf16)(w.y & 0xffffu); vp[3 * VSTR] = (bf16)(w.y >> 16);
        vp[4 * VSTR] = (bf16)(w.z & 0xffffu); vp[5 * VSTR] = (bf16)(w.z >> 16); vp[6 * VSTR] = (bf16)(w.w & 0xffffu); vp[7 * VSTR] = (bf16)(w.w >> 16); }
}
template <int HDK, int HDV, class P>
__device__ __forceinline__ void compute_tile(const LAS unsigned char* buf, const P& pol, int j, int lane, const bf16x8 (&qf)[HDK / 16], f32x16 (&o)[HDV / 32], float& m, float& l) {
    typedef Geo<HDK, HDV> G;
    const LAS bf16* Ks = (const LAS bf16*)buf; const LAS bf16* Vt = (const LAS bf16*)(buf + G::KBYTES);
    const int r = lane & 31, h = lane >> 5;
    f32x16 s[2];
#pragma unroll
    for (int kb = 0; kb < 2; ++kb) {
#pragma unroll
        for (int e = 0; e < 16; ++e) s[kb][e] = 0.f;
#pragma unroll
        for (int ks = 0; ks < HDK / 16; ++ks) { const bf16x8 a = *(const LAS bf16x8*)(Ks + (32 * kb + r) * G::KSTR + 16 * ks + 8 * h);
            s[kb] = __builtin_amdgcn_mfma_f32_32x32x16_bf16(a, qf[ks], s[kb], 0, 0, 0); }
        if (HDK > 64) __builtin_amdgcn_sched_barrier(0);
    }
    bf16x8 vf[HDV == 64 ? 8 : 1];
    if (HDV == 64) {
#pragma unroll
        for (int kb = 0; kb < 2; ++kb)
#pragma unroll
            for (int s2 = 0; s2 < 2; ++s2)
#pragma unroll
                for (int blk = 0; blk < 2; ++blk) { const LAS bf16* vp = Vt + (32 * blk + r) * VSTR + 32 * kb + 16 * s2 + 4 * h;
                    const bf16x4 lo = *(const LAS bf16x4*)vp, hi = *(const LAS bf16x4*)(vp + 8);
                    vf[HDV == 64 ? (kb * 4 + s2 * 2 + blk) : 0] = __builtin_shufflevector(lo, hi, 0, 1, 2, 3, 4, 5, 6, 7); }
    }
    float mref, mn, rs = 0.f;
    if (pol.fast(j)) {
        const float b2 = pol.lane_bias2(j), c2 = pol.c2;
        float mx = -INFINITY;
#pragma unroll
        for (int kb = 0; kb < 2; ++kb)
#pragma unroll
            for (int e = 0; e < 16; ++e) mx = fmaxf(mx, s[kb][e]);
        mx = fa::xhalf_max(mx);
        mn = fmaxf(m, mx * c2 + b2); mref = (mn == -INFINITY) ? 0.f : mn;
        const float off = b2 - mref;
#pragma unroll
        for (int kb = 0; kb < 2; ++kb)
#pragma unroll
            for (int e = 0; e < 16; ++e) { s[kb][e] = __builtin_amdgcn_exp2f(__builtin_fmaf(s[kb][e], c2, off)); rs += s[kb][e]; }
    } else {
        pol.transform(j, s, lane);
        float mx = -INFINITY;
#pragma unroll
        for (int kb = 0; kb < 2; ++kb)
#pragma unroll
            for (int e = 0; e < 16; ++e) mx = fmaxf(mx, s[kb][e]);
        mx = fa::xhalf_max(mx);
        mn = fmaxf(m, mx); mref = (mn == -INFINITY) ? 0.f : mn;
#pragma unroll
        for (int kb = 0; kb < 2; ++kb)
#pragma unroll
            for (int e = 0; e < 16; ++e) { s[kb][e] = __builtin_amdgcn_exp2f(s[kb][e] - mref); rs += s[kb][e]; }
    }
    rs = fa::xhalf_sum(rs);
    const float corr = __builtin_amdgcn_exp2f(m - mref);
    m = mn;
    if (__any(corr != 1.f)) {
        l = l * corr + rs;
#pragma unroll
        for (int blk = 0; blk < HDV / 32; ++blk)
#pragma unroll
            for (int e = 0; e < 16; ++e) o[blk][e] *= corr;
    } else l += rs;
#pragma unroll
    for (int kb = 0; kb < 2; ++kb)
#pragma unroll
        for (int s2 = 0; s2 < 2; ++s2) {
            v4u pw; pw.x = pg8::cvt_pk_bf16(s[kb][8 * s2 + 0], s[kb][8 * s2 + 1]); pw.y = pg8::cvt_pk_bf16(s[kb][8 * s2 + 2], s[kb][8 * s2 + 3]);
            pw.z = pg8::cvt_pk_bf16(s[kb][8 * s2 + 4], s[kb][8 * s2 + 5]); pw.w = pg8::cvt_pk_bf16(s[kb][8 * s2 + 6], s[kb][8 * s2 + 7]);
            const bf16x8 pf = __builtin_bit_cast(bf16x8, pw);
#pragma unroll
            for (int blk = 0; blk < HDV / 32; ++blk) {
                bf16x8 a;
                if (HDV == 64) a = vf[HDV == 64 ? (kb * 4 + s2 * 2 + blk) : 0];
                else { const LAS bf16* vp = Vt + (32 * blk + r) * VSTR + 32 * kb + 16 * s2 + 4 * h;
                    const bf16x4 lo = *(const LAS bf16x4*)vp, hi = *(const LAS bf16x4*)(vp + 8);
                    a = __builtin_shufflevector(lo, hi, 0, 1, 2, 3, 4, 5, 6, 7); }
                o[blk] = __builtin_amdgcn_mfma_f32_32x32x16_bf16(a, pf, o[blk], 0, 0, 0); }
            if (HDV > 64) __builtin_amdgcn_sched_barrier(0);
        }
}
template <int HDK, int HDV, bool KV_SAME, class P>
__device__ __forceinline__ void run(LAS unsigned char* lds, P& pol, unsigned tmask, int tid, int lane, const bf16x8 (&qf)[HDK / 16], f32x16 (&o)[HDV / 32], float& m, float& l) {
    typedef Geo<HDK, HDV> G;
    if (tmask == 0u) return;
    Stage<HDK, HDV, KV_SAME> sa, sb;
    int j0 = __builtin_ctz(tmask); tmask &= tmask - 1u;
    pol.prefetch(j0); pol.advance();
    load_tile<HDK, HDV, KV_SAME>(sa, pol, j0, tid);
    int j1 = -1; if (tmask) { j1 = __builtin_ctz(tmask); tmask &= tmask - 1u; load_tile<HDK, HDV, KV_SAME>(sb, pol, j1, tid); pol.prefetch(j1); }
    store_tile<HDK, HDV, KV_SAME>(sa, lds, tid);
    __syncthreads();
    int cur = 0;
    for (;;) {
        PROBE_START(4, tid);
        int j2 = -1; if (tmask) { j2 = __builtin_ctz(tmask); tmask &= tmask - 1u; load_tile<HDK, HDV, KV_SAME>(sa, pol, j2, tid); }
        PROBE_STOP(4, tid); PROBE_START(2, tid);
        compute_tile<HDK, HDV>(lds + cur * G::BUF, pol, j0, lane, qf, o, m, l);
        PROBE_STOP(2, tid);
        if (j1 < 0) break;
        PROBE_START(3, tid);
        store_tile<HDK, HDV, KV_SAME>(sb, lds + (cur ^ 1) * G::BUF, tid);
        pol.advance(); if (j2 >= 0) pol.prefetch(j2);
        PROBE_STOP(3, tid); PROBE_START(5, tid);
        __syncthreads(); cur ^= 1;
        PROBE_STOP(5, tid); PROBE_START(4, tid);
        int j3 = -1; if (tmask) { j3 = __builtin_ctz(tmask); tmask &= tmask - 1u; load_tile<HDK, HDV, KV_SAME>(sb, pol, j3, tid); }
        PROBE_STOP(4, tid); PROBE_START(2, tid);
        compute_tile<HDK, HDV>(lds + cur * G::BUF, pol, j1, lane, qf, o, m, l);
        PROBE_STOP(2, tid);
        if (j2 < 0) break;
        PROBE_START(3, tid);
        store_tile<HDK, HDV, KV_SAME>(sa, lds + (cur ^ 1) * G::BUF, tid);
        pol.advance(); if (j3 >= 0) pol.prefetch(j3);
        PROBE_STOP(3, tid); PROBE_START(5, tid);
        __syncthreads(); cur ^= 1;
        PROBE_STOP(5, tid);
        j0 = j2; j1 = j3;
    }
    __syncthreads();
}
template <int HDK, int HDV, bool KV_SAME, class P>
__device__ __forceinline__ void run1(LAS unsigned char* lds, P& pol, unsigned tmask, int tid, int lane, const bf16x8 (&qf)[HDK / 16], f32x16 (&o)[HDV / 32], float& m, float& l) {
    typedef Geo<HDK, HDV> G;
    if (tmask == 0u) return;
    Stage<HDK, HDV, KV_SAME> st;
    int j = __builtin_ctz(tmask); tmask &= tmask - 1u; int cur = 0;
    pol.prefetch(j); pol.advance();
    load_tile<HDK, HDV, KV_SAME>(st, pol, j, tid); store_tile<HDK, HDV, KV_SAME>(st, lds, tid);
    __syncthreads();
    for (;;) {
        const bool more = tmask != 0u; int jn = 0;
        if (more) { jn = __builtin_ctz(tmask); tmask &= tmask - 1u; load_tile<HDK, HDV, KV_SAME>(st, pol, jn, tid); pol.prefetch(jn); }
        compute_tile<HDK, HDV>(lds + cur * G::BUF, pol, j, lane, qf, o, m, l);
        if (!more) break;
        store_tile<HDK, HDV, KV_SAME>(st, lds + (cur ^ 1) * G::BUF, tid);
        pol.advance();
        __syncthreads();
        cur ^= 1; j = jn;
    }
    __syncthreads();
}
}

__device__ __forceinline__ void build_bias_table(const Frame& F, LAS float* tab, int nheads, int relc0) {
    const float* rel = F.in[I_REL];
    for (int i = F.tid; i < nheads * 129; i += 512) { const int hh = i / 129, d = i % 129; tab[hh * 132 + d] = rel[rel_bucket(d) * 16 + relc0 + hh] * 1.4426950408889634f; }
    __syncthreads();
}
struct BandPol {
    __device__ __forceinline__ void prefetch(int) {} __device__ __forceinline__ void advance() {}
    const bf16* kbase; const bf16* vbase; int ld; int tq, tq0, W; const LAS float* bl;
    static constexpr float c2 = 0.125f * 1.4426950408889634f;
    __device__ __forceinline__ const bf16* krow(int j, int r) const { return kbase + (size_t)(64 * j + r) * ld; }
    __device__ __forceinline__ const bf16* vrow(int j, int r) const { return vbase + (size_t)(64 * j + r) * ld; }
    __device__ __forceinline__ bool fast(int j) const { const int k0 = 64 * j; return tq0 - (k0 + 63) >= 128 && (tq0 + 31) - k0 < W; }
    __device__ __forceinline__ float lane_bias2(int) const { return bl[128]; }
    __device__ __forceinline__ void transform(int j, fa::f32x16 (&s)[2], int lane) const {
        const int k0 = 64 * j, h = lane >> 5;
        if (tq0 - (k0 + 63) >= 128) {
            const float b31 = bl[128]; const int dbase = tq - k0 - 4 * h;
#pragma unroll
            for (int kb = 0; kb < 2; ++kb)
#pragma unroll
                for (int e = 0; e < 16; ++e) { const int dist = dbase - (32 * kb + 8 * (e >> 2) + (e & 3)); s[kb][e] = (dist < W) ? __builtin_fmaf(s[kb][e], c2, b31) : -INFINITY; }
        } else {
#pragma unroll
            for (int kb = 0; kb < 2; ++kb)
#pragma unroll
                for (int e = 0; e < 16; ++e) { const int key = k0 + 32 * kb + 8 * (e >> 2) + 4 * h + (e & 3); const int dist = tq - key;
                    const int di = dist < 0 ? 0 : (dist > 128 ? 128 : dist);
                    const float v = __builtin_fmaf(s[kb][e], c2, bl[di]);
                    s[kb][e] = (dist >= 0 && dist < W) ? v : -INFINITY; }
        }
    }
};
__device__ __forceinline__ void win_phase_mfma(const Frame& F) {
    bf16* P1 = (bf16*)(F.ws + WS_P1); const bf16* OC = (const bf16*)(F.ws + WS_OCMP); const bf16* OS = (const bf16*)(F.ws + WS_OSLC);
    LAS float* tab = (LAS float*)(F.lds + 36864);
    build_bias_table(F, tab, 16, 0);
    const int h = F.lane >> 5;
    for (int u = blockIdx.x; u < NB * 2 * 64; u += F.G) {
        const int rr_ = u / F.G, c_ = u % F.G; const int qt = (rr_ & 1) ? 63 - (c_ & 63) : (c_ & 63), bg = (rr_ * (F.G >> 6) + (c_ >> 6)) % (NB * 2), b = bg >> 1, g = bg & 1;
        const int tq0 = 32 * qt, head = g * 8 + F.wave, tq = tq0 + (F.lane & 31);
        const size_t row = (size_t)b * S + tq;
        fa::bf16x8 qf[4];
#pragma unroll
        for (int ks = 0; ks < 4; ++ks) qf[ks] = *(const fa::bf16x8*)(P1 + row * P1_LD + C1_Q + head * 64 + 16 * ks + 8 * h);
        fa::f32x16 o[2];
#pragma unroll
        for (int blk = 0; blk < 2; ++blk)
#pragma unroll
            for (int e = 0; e < 16; ++e) o[blk][e] = 0.f;
        float m = -INFINITY, l = 0.f;
        const int jlo = (tq0 - 511 > 0 ? tq0 - 511 : 0) >> 6, jhi = (tq0 + 31) >> 6;
        const unsigned tmask = (jhi >= 31 ? 0xffffffffu : ((1u << (jhi + 1)) - 1u)) & ~((1u << jlo) - 1u);
        BandPol pol{P1 + (size_t)b * S * P1_LD + C1_KW + g * 64, P1 + (size_t)b * S * P1_LD + C1_VW + g * 64, P1_LD, tq, tq0, 512, tab + head * 132};
        fa::run<64, 64, false>(F.lds, pol, tmask, F.tid, F.lane, qf, o, m, l);
        const float inv = 1.f / l;
        const bf16* gr = P1 + row * P1_LD + C1_GL + head * 3;
        const float g0 = 1.f / (1.f + __expf(-bf2f(gr[0]))), g1 = 1.f / (1.f + __expf(-bf2f(gr[1]))), g2 = 1.f / (1.f + __expf(-bf2f(gr[2])));
#pragma unroll
        for (int blk = 0; blk < 2; ++blk)
#pragma unroll
            for (int jj = 0; jj < 4; ++jj) { const int d0 = 32 * blk + 8 * jj + 4 * h;
                const v2u cw = *(const v2u*)(OC + row * D + head * 64 + d0), sw = *(const v2u*)(OS + row * D + head * 64 + d0);
                const float r0 = g0 * bflo(cw.x) + g1 * bflo(sw.x) + g2 * o[blk][4 * jj + 0] * inv, r1 = g0 * bfhi(cw.x) + g1 * bfhi(sw.x) + g2 * o[blk][4 * jj + 1] * inv;
                const float r2 = g0 * bflo(cw.y) + g1 * bflo(sw.y) + g2 * o[blk][4 * jj + 2] * inv, r3 = g0 * bfhi(cw.y) + g1 * bfhi(sw.y) + g2 * o[blk][4 * jj + 3] * inv;
                v2u ow; ow.x = pk2(r0, r1); ow.y = pk2(r2, r3);
                *(v2u*)(P1 + row * P1_LD + C1_Q + head * 64 + d0) = ow; }
    }
}
__device__ __forceinline__ void swa_phase_mfma(const Frame& F) {
    bf16* P0 = (bf16*)(F.ws + WS_P0); const float* sinks = F.in[I_EV_SINK];
    LAS float* tab = (LAS float*)(F.lds + 36864);
    build_bias_table(F, tab, 8, 8);
    const int h = F.lane >> 5;
    for (int u = blockIdx.x; u < NB * 2 * 32; u += F.G) {
        const int b = u >> 6, kvh = (u >> 5) & 1, t0 = 64 * (u & 31), head = kvh * 4 + (F.wave & 3), tq0 = t0 + 32 * (F.wave >> 2), tq = tq0 + (F.lane & 31);
        const size_t row = (size_t)b * S + tq;
        fa::bf16x8 qf[4];
#pragma unroll
        for (int ks = 0; ks < 4; ++ks) qf[ks] = *(const fa::bf16x8*)(P0 + row * P0_LD + C0_QB + head * 64 + 16 * ks + 8 * h);
        fa::f32x16 o[2];
#pragma unroll
        for (int blk = 0; blk < 2; ++blk)
#pragma unroll
            for (int e = 0; e < 16; ++e) o[blk][e] = 0.f;
        float m = sinks[head] * 1.4426950408889634f, l = 1.f;
        const int jlo = (t0 - 127 > 0 ? t0 - 127 : 0) >> 6, jhi = t0 >> 6;
        const unsigned tmask = (jhi >= 31 ? 0xffffffffu : ((1u << (jhi + 1)) - 1u)) & ~((1u << jlo) - 1u);
        BandPol pol{P0 + (size_t)b * S * P0_LD + C0_KB + kvh * 64, P0 + (size_t)b * S * P0_LD + C0_VB + kvh * 64, P0_LD, tq, tq0, 128, tab + head * 132};
        fa::run<64, 64, false>(F.lds, pol, tmask, F.tid, F.lane, qf, o, m, l);
        const float inv = 1.f / l;
#pragma unroll
        for (int blk = 0; blk < 2; ++blk)
#pragma unroll
            for (int jj = 0; jj < 4; ++jj) { const int d0 = 32 * blk + 8 * jj + 4 * h;
                v2u ow; ow.x = pk2(o[blk][4 * jj + 0] * inv, o[blk][4 * jj + 1] * inv); ow.y = pk2(o[blk][4 * jj + 2] * inv, o[blk][4 * jj + 3] * inv);
                *(v2u*)(P0 + row * P0_LD + C0_QB + head * 64 + d0) = ow; }
    }
}

struct XaPol {
    __device__ __forceinline__ void prefetch(int) {} __device__ __forceinline__ void advance() {}
    const bf16* kbase;
    static constexpr float c2 = 0.08838834764831845f * 1.4426950408889634f;
    __device__ __forceinline__ const bf16* krow(int j, int r) const { return kbase + (size_t)(64 * j + r) * 1024; }
    __device__ __forceinline__ const bf16* vrow(int j, int r) const { return kbase + (size_t)(64 * j + r) * 1024 + 512; }
    __device__ __forceinline__ bool fast(int) const { return true; }
    __device__ __forceinline__ float lane_bias2(int) const { return 0.f; }
    __device__ __forceinline__ void transform(int, fa::f32x16 (&)[2], int) const {}
};
__device__ __forceinline__ void xattn_phase_mfma(const Frame& F, const bf16* Q, const bf16* KV, bf16* O) {
    const int h = F.lane >> 5;
    for (int u2 = 2 * blockIdx.x; u2 < NB * 4 * 8; u2 += 2 * F.G)
    for (int hp = 0; hp < 2; ++hp) {
        int pm, pn; pg8::tile_of(u2 >> 1, M / 256, 2, pm, pn);
        const int b = pm >> 3, qt = pm & 7, head = 2 * pn + hp, tq = 256 * qt + 32 * F.wave + (F.lane & 31);
        const size_t row = (size_t)b * S + tq;
        fa::bf16x8 qf[8];
#pragma unroll
        for (int ks = 0; ks < 8; ++ks) qf[ks] = *(const fa::bf16x8*)(Q + row * 512 + head * 128 + 16 * ks + 8 * h);
        fa::f32x16 o[4];
#pragma unroll
        for (int blk = 0; blk < 4; ++blk)
#pragma unroll
            for (int e = 0; e < 16; ++e) o[blk][e] = 0.f;
        float m = -INFINITY, l = 0.f;
        XaPol pol{KV + (size_t)b * MEML * 1024 + head * 128};
        fa::run<128, 128, false>(F.lds, pol, 0xFu, F.tid, F.lane, qf, o, m, l);
        const float inv = 1.f / l;
#pragma unroll
        for (int blk = 0; blk < 4; ++blk)
#pragma unroll
            for (int jj = 0; jj < 4; ++jj) { const int d0 = 32 * blk + 8 * jj + 4 * h;
                v2u ow; ow.x = pk2(o[blk][4 * jj + 0] * inv, o[blk][4 * jj + 1] * inv); ow.y = pk2(o[blk][4 * jj + 2] * inv, o[blk][4 * jj + 3] * inv);
                *(v2u*)(O + row * 512 + head * 128 + d0) = ow; }
    }
}
struct DsaPol {
    const bf16* cbase; const unsigned* mrow; int tq, tq0; const LAS float* bl; v2u mwc, mwn;
    static constexpr float c2 = 0.125f * 1.4426950408889634f;
    __device__ __forceinline__ const bf16* krow(int j, int r) const { return cbase + (size_t)(64 * j + r) * 128; }
    __device__ __forceinline__ const bf16* vrow(int j, int r) const { return krow(j, r); }
    __device__ __forceinline__ bool fast(int) const { return false; }
    __device__ __forceinline__ float lane_bias2(int) const { return 0.f; }
    __device__ __forceinline__ void prefetch(int j) { mwn = *(const v2u*)(mrow + 2 * j); }
    __device__ __forceinline__ void advance() { mwc = mwn; }
    __device__ __forceinline__ void transform(int j, fa::f32x16 (&s)[2], int lane) const {
        const int k0 = 64 * j, h = lane >> 5;
#pragma unroll
        for (int kb = 0; kb < 2; ++kb) { const unsigned w = (kb ? mwc.y : mwc.x) >> (4 * h);
#pragma unroll
            for (int e = 0; e < 16; ++e) { const int bit = 8 * (e >> 2) + (e & 3); const int kin = bit + 4 * h; const int dist = tq - (k0 + 32 * kb + kin);
                const int di = dist < 0 ? 0 : (dist > 128 ? 128 : dist); const int mm = ((int)(w << (31 - bit))) >> 31;
                const unsigned vb = __builtin_bit_cast(unsigned, __builtin_fmaf(s[kb][e], c2, bl[di]));
                s[kb][e] = __builtin_bit_cast(float, (vb & (unsigned)mm) | (0xff800000u & ~(unsigned)mm)); } }
    }
};
__device__ __forceinline__ void dsa_phase_mfma(const Frame& F) {
    bf16* P0 = (bf16*)(F.ws + WS_P0); const bf16* CN = (const bf16*)(F.ws + WS_CN); const unsigned* MASK = (const unsigned*)(F.ws + WS_MASK);
    LAS float* tab = (LAS float*)(F.lds + 73728);
    build_bias_table(F, tab, 8, 0);
    const int h = F.lane >> 5;
    for (int u = blockIdx.x; u < NB * 64; u += F.G) {
        const int rr = u / F.G, c = u % F.G; const int qt = (rr & 1) ? 63 - (c & 63) : (c & 63), b = (rr * (F.G >> 6) + (c >> 6)) % NB;
        const int tq0 = 32 * qt, tq = tq0 + (F.lane & 31), head = F.wave;
        const size_t row = (size_t)b * S + tq;
        fa::bf16x8 qf[8];
#pragma unroll
        for (int ks = 0; ks < 8; ++ks) qf[ks] = *(const fa::bf16x8*)(P0 + row * P0_LD + C0_QLAT + head * 128 + 16 * ks + 8 * h);
        fa::f32x16 o[4];
#pragma unroll
        for (int blk = 0; blk < 4; ++blk)
#pragma unroll
            for (int e = 0; e < 16; ++e) o[blk][e] = 0.f;
        float m = -INFINITY, l = 0.f;
        const int jhi = (tq0 + 31) >> 6; const unsigned tmask = jhi >= 31 ? 0xffffffffu : ((1u << (jhi + 1)) - 1u);
        DsaPol pol{CN + (size_t)b * S * 128, MASK + row * 64, tq, tq0, tab + head * 132, (v2u){0u, 0u}, (v2u){0u, 0u}};
        fa::run<128, 128, true>(F.lds, pol, tmask, F.tid, F.lane, qf, o, m, l);
        const float inv = 1.f / l;
#pragma unroll
        for (int blk = 0; blk < 4; ++blk)
#pragma unroll
            for (int jj = 0; jj < 4; ++jj) { const int d0 = 32 * blk + 8 * jj + 4 * h;
                v2u ow; ow.x = pk2(o[blk][4 * jj + 0] * inv, o[blk][4 * jj + 1] * inv); ow.y = pk2(o[blk][4 * jj + 2] * inv, o[blk][4 * jj + 3] * inv);
                *(v2u*)(P0 + row * P0_LD + C0_QLAT + head * 128 + d0) = ow; }
    }
}
struct SlcPol {
    __device__ __forceinline__ void prefetch(int) {} __device__ __forceinline__ void advance() {}
    const bf16* kbase; const bf16* vbase; unsigned sel; int tq, tq0; const LAS float* bl;
    static constexpr float c2 = 0.125f * 1.4426950408889634f;
    __device__ __forceinline__ const bf16* krow(int j, int r) const { return kbase + (size_t)(64 * j + r) * P1_LD; }
    __device__ __forceinline__ const bf16* vrow(int j, int r) const { return vbase + (size_t)(64 * j + r) * P1_LD; }
    __device__ __forceinline__ bool fast(int j) const { return tq0 - (64 * j + 63) >= 128; }
    __device__ __forceinline__ float lane_bias2(int j) const { return ((sel >> j) & 1u) ? bl[128] : -INFINITY; }
    __device__ __forceinline__ void transform(int j, fa::f32x16 (&s)[2], int lane) const {
        const int k0 = 64 * j, h = lane >> 5; const bool on = (sel >> j) & 1u;
#pragma unroll
        for (int kb = 0; kb < 2; ++kb)
#pragma unroll
            for (int e = 0; e < 16; ++e) { const int dist = tq - (k0 + 32 * kb + 8 * (e >> 2) + 4 * h + (e & 3));
                const int di = dist < 0 ? 0 : (dist > 128 ? 128 : dist);
                const float v = __builtin_fmaf(s[kb][e], c2, bl[di]);
                s[kb][e] = (on && dist >= 0) ? v : -INFINITY; }
    }
};
__device__ __forceinline__ void slc_phase_mfma(const Frame& F) {
    const bf16* P1 = (const bf16*)(F.ws + WS_P1); const unsigned* SELM = (const unsigned*)(F.ws + WS_SELM); bf16* OS = (bf16*)(F.ws + WS_OSLC);
    LAS float* tab = (LAS float*)(F.lds + 36864);
    build_bias_table(F, tab, 16, 0);
    const int h = F.lane >> 5;
    for (int u = blockIdx.x; u < NB * 2 * 64; u += F.G) {
        const int rr = u / F.G, c = u % F.G; const int qt = (rr & 1) ? 63 - (c & 63) : (c & 63), bg = (rr * (F.G >> 6) + (c >> 6)) % (NB * 2), b = bg >> 1, g = bg & 1;
        const int tq0 = 32 * qt, tq = tq0 + (F.lane & 31), head = g * 8 + F.wave;
        const size_t row = (size_t)b * S + tq;
        fa::bf16x8 qf[4];
#pragma unroll
        for (int ks = 0; ks < 4; ++ks) qf[ks] = *(const fa::bf16x8*)(P1 + row * P1_LD + C1_Q + head * 64 + 16 * ks + 8 * h);
        fa::f32x16 o[2];
#pragma unroll
        for (int blk = 0; blk < 2; ++blk)
#pragma unroll
            for (int e = 0; e < 16; ++e) o[blk][e] = 0.f;
        float m = -INFINITY, l = 0.f;
        const unsigned sel = SELM[row * 2 + g]; unsigned tm = sel;
#pragma unroll
        for (int of = 1; of < 32; of <<= 1) tm |= (unsigned)__shfl_xor((int)tm, of);
        tm = (unsigned)__builtin_amdgcn_readfirstlane((int)tm);
        SlcPol pol{P1 + (size_t)b * S * P1_LD + C1_KS + g * 64, P1 + (size_t)b * S * P1_LD + C1_VS + g * 64, sel, tq, tq0, tab + head * 132};
        fa::run<64, 64, false>(F.lds, pol, tm, F.tid, F.lane, qf, o, m, l);
        const float inv = 1.f / l;
#pragma unroll
        for (int blk = 0; blk < 2; ++blk)
#pragma unroll
            for (int jj = 0; jj < 4; ++jj) { const int d0 = 32 * blk + 8 * jj + 4 * h;
                v2u ow; ow.x = pk2(o[blk][4 * jj + 0] * inv, o[blk][4 * jj + 1] * inv); ow.y = pk2(o[blk][4 * jj + 2] * inv, o[blk][4 * jj + 3] * inv);
                *(v2u*)(OS + row * D + head * 64 + d0) = ow; }
    }
}

__device__ __forceinline__ int wave_sum_dpp(int v) {
    v += __builtin_amdgcn_update_dpp(0, v, 0xB1, 0xf, 0xf, false);
    v += __builtin_amdgcn_update_dpp(0, v, 0x4E, 0xf, 0xf, false);
    v += __builtin_amdgcn_update_dpp(0, v, 0x141, 0xf, 0xf, false);
    v += __builtin_amdgcn_update_dpp(0, v, 0x140, 0xf, 0xf, false);
    v += __builtin_amdgcn_update_dpp(0, v, 0x142, 0xa, 0xf, false);
    v += __builtin_amdgcn_update_dpp(0, v, 0x143, 0xc, 0xf, false);
    return __builtin_amdgcn_readlane(v, 63);
}
template <bool GT>
__device__ __forceinline__ int count4(unsigned u0, unsigned u1, unsigned u2, unsigned u3, unsigned cand) {
    unsigned long long m0, m1, m2, m3; int t0, t1, t2, t3;
    if (GT)
        asm volatile("v_cmp_gt_u32_e64 %0, %8, %12\n\tv_cmp_gt_u32_e64 %1, %9, %12\n\tv_cmp_gt_u32_e64 %2, %10, %12\n\tv_cmp_gt_u32_e64 %3, %11, %12\n\t"
                     "s_bcnt1_i32_b64 %4, %0\n\ts_bcnt1_i32_b64 %5, %1\n\ts_bcnt1_i32_b64 %6, %2\n\ts_bcnt1_i32_b64 %7, %3"
                     : "=&s"(m0), "=&s"(m1), "=&s"(m2), "=&s"(m3), "=&s"(t0), "=&s"(t1), "=&s"(t2), "=&s"(t3) : "v"(u0), "v"(u1), "v"(u2), "v"(u3), "s"(cand) : "scc");
    else
        asm volatile("v_cmp_ge_u32_e64 %0, %8, %12\n\tv_cmp_ge_u32_e64 %1, %9, %12\n\tv_cmp_ge_u32_e64 %2, %10, %12\n\tv_cmp_ge_u32_e64 %3, %11, %12\n\t"
                     "s_bcnt1_i32_b64 %4, %0\n\ts_bcnt1_i32_b64 %5, %1\n\ts_bcnt1_i32_b64 %6, %2\n\ts_bcnt1_i32_b64 %7, %3"
                     : "=&s"(m0), "=&s"(m1), "=&s"(m2), "=&s"(m3), "=&s"(t0), "=&s"(t1), "=&s"(t2), "=&s"(t3) : "v"(u0), "v"(u1), "v"(u2), "v"(u3), "s"(cand) : "scc");
    return (t0 + t1) + (t2 + t3);
}
__device__ __forceinline__ void idx_phase_mfma(const Frame& F) {
    const bf16* P0 = (const bf16*)(F.ws + WS_P0); unsigned* MASK = (unsigned*)(F.ws + WS_MASK);
    LAS float* sc = (LAS float*)F.lds;
    const int r = F.lane & 31, hh = F.lane >> 5;
    const int head_r = (r & 3) + 4 * ((r >> 3) & 1), ql_r = 2 * (r >> 4) + ((r >> 2) & 1);
    fa::bf16x8 qaN[2][4]; v4u wvN[2][2];
#define IDX_DECODE(item_, b_, t0_) { const int it_i = (item_) / F.G, it_c = (item_) % F.G; b_ = (F.G == S / 8) ? it_i : (item_) / (S / 8); t0_ = ((F.G == S / 8) ? ((it_c + 16 * it_i) & (S / 8 - 1)) : ((item_) % (S / 8))) * 8; }
#define IDX_LOAD(item_) { int b_, t0_; IDX_DECODE(item_, b_, t0_); \
        _Pragma("unroll") for (int rb = 0; rb < 2; ++rb) { const bf16* qp = P0 + (size_t)(b_ * S + t0_ + 4 * rb + ql_r) * P0_LD + C0_QI + head_r * 64 + 8 * hh; \
            _Pragma("unroll") for (int ks = 0; ks < 4; ++ks) qaN[rb][ks] = *(const fa::bf16x8*)(qp + 16 * ks); \
            _Pragma("unroll") for (int qq = 0; qq < 2; ++qq) wvN[rb][qq] = *(const v4u*)(P0 + (size_t)(b_ * S + t0_ + 4 * rb + 2 * qq + hh) * P0_LD + C0_WI); } }
    if ((int)blockIdx.x < NB * (S / 8)) IDX_LOAD(blockIdx.x);
    for (int item = blockIdx.x; item < NB * (S / 8); item += F.G) {
        int b, t0; IDX_DECODE(item, b, t0);
        fa::bf16x8 qa[2][4]; float wv[2][2][8];
#pragma unroll
        for (int rb = 0; rb < 2; ++rb) {
#pragma unroll
            for (int ks = 0; ks < 4; ++ks) qa[rb][ks] = qaN[rb][ks];
#pragma unroll
            for (int qq = 0; qq < 2; ++qq) { const v4u w = wvN[rb][qq]; const float sc8 = 0.35355339059f * 0.125f;
                wv[rb][qq][0] = bflo(w.x) * sc8; wv[rb][qq][1] = bfhi(w.x) * sc8; wv[rb][qq][2] = bflo(w.y) * sc8; wv[rb][qq][3] = bfhi(w.y) * sc8;
                wv[rb][qq][4] = bflo(w.z) * sc8; wv[rb][qq][5] = bfhi(w.z) * sc8; wv[rb][qq][6] = bflo(w.w) * sc8; wv[rb][qq][7] = bfhi(w.w) * sc8; } }
        const int nkb = (t0 + 8 + 31) >> 5;
        PROBE_START(9, F.tid);
#pragma unroll 1
        for (int kb0 = F.wave; kb0 < nkb; kb0 += 32) {
            fa::bf16x8 kf[4][4];
#pragma unroll
            for (int i = 0; i < 4; ++i) { const int kb = (kb0 + 8 * i < 64) ? kb0 + 8 * i : 63; const bf16* kp = P0 + (size_t)(b * S + 32 * kb + r) * P0_LD + C0_KI + 8 * hh;
#pragma unroll
                for (int ks = 0; ks < 4; ++ks) kf[i][ks] = *(const fa::bf16x8*)(kp + 16 * ks); }
#pragma unroll
            for (int i = 0; i < 4; ++i) { const int kb = kb0 + 8 * i;
                if (kb < nkb) {
#pragma unroll
                    for (int rb = 0; rb < 2; ++rb) { fa::f32x16 c;
#pragma unroll
                        for (int e = 0; e < 16; ++e) c[e] = 0.f;
#pragma unroll
                        for (int ks = 0; ks < 4; ++ks) c = __builtin_amdgcn_mfma_f32_32x32x16_bf16(qa[rb][ks], kf[i][ks], c, 0, 0, 0);
                        float s0 = 0.f, s1 = 0.f;
#pragma unroll
                        for (int e = 0; e < 8; ++e) { s0 += wv[rb][0][e] * fmaxf(c[e], 0.f); s1 += wv[rb][1][e] * fmaxf(c[8 + e], 0.f); }
                        sc[(4 * rb + hh) * 2048 + 32 * kb + r] = s0; sc[(4 * rb + 2 + hh) * 2048 + 32 * kb + r] = s1; } } }
        }
        if (item + F.G < NB * (S / 8)) IDX_LOAD(item + F.G);
        PROBE_STOP(9, F.tid);
        __syncthreads();
        PROBE_START(10, F.tid);
        {
            const int q = F.wave, t = t0 + q, n = t + 1, row = b * S + t; unsigned myword = 0u;
            if (n <= 256) { const int cb = n - 32 * F.lane; myword = cb >= 32 ? 0xffffffffu : (cb <= 0 ? 0u : ((1u << cb) - 1u)); }
            else {
                unsigned uu[32];
#pragma unroll
                for (int i = 0; i < 32; ++i) { const int s = F.lane + 64 * i; uu[i] = (s < n) ? fkey(sc[q * 2048 + s]) : 0u; }
                unsigned prefix = 0u; bool exact = false;
#pragma unroll 1
                for (int bit = 31; bit >= 0; --bit) { const unsigned cand = prefix | (1u << bit); int c0 = 0, c1 = 0, c2 = 0, c3 = 0;
#pragma unroll
                    for (int i = 0; i < 32; i += 4) { c0 += (uu[i] >= cand) ? 1 : 0; c1 += (uu[i + 1] >= cand) ? 1 : 0; c2 += (uu[i + 2] >= cand) ? 1 : 0; c3 += (uu[i + 3] >= cand) ? 1 : 0; }
                    const int c = wave_sum_dpp((c0 + c1) + (c2 + c3));
                    if (c >= 256) { prefix = cand; if (c == 256) { exact = true; break; } } }
                int cgt = 0;
                if (!exact) { int g0 = 0, g1 = 0;
#pragma unroll
                    for (int i = 0; i < 32; i += 2) { g0 += (uu[i] > prefix) ? 1 : 0; g1 += (uu[i + 1] > prefix) ? 1 : 0; }
                    cgt = wave_sum_dpp(g0 + g1); }
                if (exact) {
#pragma unroll
                    for (int i = 0; i < 32; ++i) { const unsigned long long sm = __ballot(uu[i] >= prefix);
                        if (F.lane == 2 * i) myword = (unsigned)sm; if (F.lane == 2 * i + 1) myword = (unsigned)(sm >> 32); }
                } else {
                    const int need = 256 - cgt; int run = 0;
#pragma unroll
                    for (int i = 0; i < 32; ++i) { asm volatile("" : "+s"(run), "+v"(uu[i])); const unsigned u = uu[i]; const bool eq = (u == prefix); const unsigned long long em = __ballot(eq); const int rank = run + __popcll(em & ((1ull << F.lane) - 1ull));
                        const bool sel = (u > prefix) || (eq && rank < need); run += __popcll(em);
                        const unsigned long long sm = __ballot(sel);
                        if (F.lane == 2 * i) myword = (unsigned)sm; if (F.lane == 2 * i + 1) myword = (unsigned)(sm >> 32); }
                }
            }
            MASK[(size_t)row * 64 + F.lane] = myword;
        }
        PROBE_STOP(10, F.tid);
        __syncthreads();
    }
}
#undef IDX_DECODE
#undef IDX_LOAD
__device__ __forceinline__ void cmp_phase_mfma(const Frame& F) {
    typedef fa::Geo<64, 64> G;
    const bf16* P1 = (const bf16*)(F.ws + WS_P1); const bf16* KC = (const bf16*)(F.ws + WS_KC); const bf16* VC = (const bf16*)(F.ws + WS_VC);
    bf16* OC = (bf16*)(F.ws + WS_OCMP); unsigned* SELM = (unsigned*)(F.ws + WS_SELM);
    LAS float* tab = (LAS float*)(F.lds + 36864); LAS float* part = (LAS float*)(F.lds + 49152);
    build_bias_table(F, tab, 16, 0);
    const int r = F.lane & 31, h = F.lane >> 5;
    for (int u = blockIdx.x; u < NB * 2 * 64; u += F.G) {
        const int rr_ = u / F.G, c_ = u % F.G; const int qt = (rr_ & 1) ? 63 - (c_ & 63) : (c_ & 63), bg = (rr_ * (F.G >> 6) + (c_ >> 6)) % (NB * 2), b = bg >> 1, g = bg & 1;
        const int tq0 = 32 * qt, head = g * 8 + F.wave, tq = tq0 + r;
        const size_t row = (size_t)b * S + tq;
        const int nv = (tq >= 31) ? ((tq - 31) / 16 + 1) : 0;
        const int ntile = (tq0 >= 1024) ? 2 : 1;
        {
            struct CPol { const bf16* kb; const bf16* vb; __device__ __forceinline__ const bf16* krow(int j, int rr) const { return kb + (size_t)(64 * j + rr) * 64; } __device__ __forceinline__ const bf16* vrow(int j, int rr) const { return vb + (size_t)(64 * j + rr) * 64; } };
            CPol cp{KC + (size_t)(b * 2 + g) * 128 * 64, VC + (size_t)(b * 2 + g) * 128 * 64};
            for (int t = 0; t < ntile; ++t) { fa::Stage<64, 64, false> st; fa::load_tile<64, 64, false>(st, cp, t, F.tid); fa::store_tile<64, 64, false>(st, F.lds + t * G::BUF, F.tid); }
        }
        fa::bf16x8 qf[4];
#pragma unroll
        for (int ks = 0; ks < 4; ++ks) qf[ks] = *(const fa::bf16x8*)(P1 + row * P1_LD + C1_Q + head * 64 + 16 * ks + 8 * h);
        __syncthreads();
        fa::f32x16 s[2][2];
        const LAS float* bl = tab + head * 132;
#pragma unroll
        for (int t = 0; t < 2; ++t) {
            const LAS bf16* Ks = (const LAS bf16*)(F.lds + t * G::BUF);
#pragma unroll
            for (int kb = 0; kb < 2; ++kb) {
#pragma unroll
                for (int e = 0; e < 16; ++e) s[t][kb][e] = 0.f;
                if (t < ntile) {
#pragma unroll
                    for (int ks = 0; ks < 4; ++ks) { const fa::bf16x8 a = *(const LAS fa::bf16x8*)(Ks + (32 * kb + r) * G::KSTR + 16 * ks + 8 * h); s[t][kb] = __builtin_amdgcn_mfma_f32_32x32x16_bf16(a, qf[ks], s[t][kb], 0, 0, 0); }
                }
#pragma unroll
                for (int e = 0; e < 16; ++e) { const int n = 64 * t + 32 * kb + 8 * (e >> 2) + 4 * h + (e & 3); const int dist = tq - (16 * n + 31); const int di = dist < 0 ? 0 : (dist > 128 ? 128 : dist);
                    s[t][kb][e] = (n < nv) ? __builtin_fmaf(s[t][kb][e], 0.125f * 1.4426950408889634f, bl[di]) : -INFINITY; }
            }
        }
        float mx = -INFINITY;
#pragma unroll
        for (int t = 0; t < 2; ++t)
#pragma unroll
            for (int kb = 0; kb < 2; ++kb)
#pragma unroll
                for (int e = 0; e < 16; ++e) mx = fmaxf(mx, s[t][kb][e]);
        mx = fa::xhalf_max(mx);
        const float mref = (mx == -INFINITY) ? 0.f : mx; float rs = 0.f;
#pragma unroll
        for (int t = 0; t < 2; ++t)
#pragma unroll
            for (int kb = 0; kb < 2; ++kb)
#pragma unroll
                for (int e = 0; e < 16; ++e) { s[t][kb][e] = __builtin_amdgcn_exp2f(s[t][kb][e] - mref); rs += s[t][kb][e]; }
        rs = fa::xhalf_sum(rs);
        const float inv = (nv > 0) ? 1.f / rs : 0.f;
#pragma unroll
        for (int t = 0; t < 2; ++t)
#pragma unroll
            for (int kb = 0; kb < 2; ++kb)
#pragma unroll
                for (int e = 0; e < 16; ++e) s[t][kb][e] *= inv;
        {
            float sum4[16], p3[16];
#pragma unroll
            for (int t = 0; t < 2; ++t)
#pragma unroll
                for (int kb = 0; kb < 2; ++kb)
#pragma unroll
                    for (int jj = 0; jj < 4; ++jj) { const int G4 = 8 * t + 4 * kb + jj; sum4[G4] = (s[t][kb][4 * jj] + s[t][kb][4 * jj + 1]) + (s[t][kb][4 * jj + 2] + s[t][kb][4 * jj + 3]); p3[G4] = s[t][kb][4 * jj + 3]; }
            LAS float* pw = part + (F.wave * 32 + r) * 32;
            float prt[16];
#pragma unroll
            for (int G4 = 0; G4 < 16; ++G4) { const auto rr = __builtin_amdgcn_permlane32_swap(__builtin_bit_cast(unsigned, p3[G4]), __builtin_bit_cast(unsigned, p3[G4]), false, false);
                prt[G4] = __builtin_bit_cast(float, h ? (unsigned)rr[0] : (unsigned)rr[1]); }
#pragma unroll
            for (int G4 = 0; G4 < 16; ++G4) { const float prm1 = (G4 > 0) ? prt[G4 > 0 ? G4 - 1 : 0] : 0.f;
                const float v = sum4[G4] + (h ? prt[G4] : prm1);
                pw[2 * G4 + h] = v; }
        }
        fa::f32x16 o[2];
#pragma unroll
        for (int blk = 0; blk < 2; ++blk)
#pragma unroll
            for (int e = 0; e < 16; ++e) o[blk][e] = 0.f;
#pragma unroll
        for (int t = 0; t < 2; ++t) {
            if (t < ntile) {
                const LAS bf16* Vt = (const LAS bf16*)(F.lds + t * G::BUF + G::KBYTES);
#pragma unroll
                for (int kb = 0; kb < 2; ++kb)
#pragma unroll
                    for (int s2 = 0; s2 < 2; ++s2) {
                        v4u pw4; pw4.x = pg8::cvt_pk_bf16(s[t][kb][8 * s2 + 0], s[t][kb][8 * s2 + 1]); pw4.y = pg8::cvt_pk_bf16(s[t][kb][8 * s2 + 2], s[t][kb][8 * s2 + 3]);
                        pw4.z = pg8::cvt_pk_bf16(s[t][kb][8 * s2 + 4], s[t][kb][8 * s2 + 5]); pw4.w = pg8::cvt_pk_bf16(s[t][kb][8 * s2 + 6], s[t][kb][8 * s2 + 7]);
                        const fa::bf16x8 pf = __builtin_bit_cast(fa::bf16x8, pw4);
#pragma unroll
                        for (int blk = 0; blk < 2; ++blk) { const LAS bf16* vp = Vt + (32 * blk + r) * fa::VSTR + 32 * kb + 16 * s2 + 4 * h;
                            const fa::bf16x4 lo = *(const LAS fa::bf16x4*)vp, hi = *(const LAS fa::bf16x4*)(vp + 8);
                            o[blk] = __builtin_amdgcn_mfma_f32_32x32x16_bf16(__builtin_shufflevector(lo, hi, 0, 1, 2, 3, 4, 5, 6, 7), pf, o[blk], 0, 0, 0); }
                    }
            }
        }
#pragma unroll
        for (int blk = 0; blk < 2; ++blk)
#pragma unroll
            for (int jj = 0; jj < 4; ++jj) { const int d0 = 32 * blk + 8 * jj + 4 * h;
                v2u ow; ow.x = pk2(o[blk][4 * jj + 0], o[blk][4 * jj + 1]); ow.y = pk2(o[blk][4 * jj + 2], o[blk][4 * jj + 3]);
                *(v2u*)(OC + row * D + head * 64 + d0) = ow; }
        __syncthreads();
#pragma unroll 1
        for (int it = 0; it < 2; ++it) {
            const int ql = 4 * F.wave + 2 * it + h, j = r, t = tq0 + ql; float p = 0.f;
#pragma unroll
            for (int w8 = 0; w8 < 8; ++w8) p += part[(w8 * 32 + ql) * 32 + j];
            const int blkq = t >> 6; const bool adm = (64 * j <= t); const bool forced = (j == 0) || (j == blkq) || (j == blkq - 1);
            const float scj = adm ? (p + (forced ? 1.0e6f : 0.f)) : -1.0e30f;
            int rank = 0;
#pragma unroll 1
            for (int i = 0; i < 32; ++i) { const float si = __shfl(scj, (F.lane & 32) | i); rank += (si > scj || (si == scj && i < j)) ? 1 : 0; }
            const unsigned long long sm = __ballot(adm && rank < 8);
            if (r == 0) SELM[((size_t)b * S + t) * 2 + g] = h ? (unsigned)(sm >> 32) : (unsigned)sm;
        }
        __syncthreads();
    }
}

__device__ __forceinline__ void cmp_prep(const Frame& F) {
    tconv(F, F.in[I_OD_W1K], 128, 2048, 128, 256, (bf16*)(F.ws + WS_W1T), 2048, NOGRP, 0);
    tconv(F, F.in[I_OD_W1V], 128, 2048, 128, 256, (bf16*)(F.ws + WS_W1T) + (size_t)256 * 2048, 2048, NOGRP, 0);
    if (blockIdx.x == 0 && F.tid < 256) { const int which = F.tid >> 7, j = F.tid & 127; const float* pe = which ? F.in[I_OD_PEV] : F.in[I_OD_PEK]; const float* w1 = which ? F.in[I_OD_W1V] : F.in[I_OD_W1K]; float a = 0.f;
        for (int kk = 0; kk < 2048; ++kk) a += pe[kk] * w1[(size_t)kk * 128 + j];
        ((float*)(F.ws + WS_PEB))[F.tid] = a; }
}
__device__ __forceinline__ void cmp_w2_phase(const Frame& F) {
    const float* Hd = (const float*)(F.ws + WS_HIDC);
    LAS float* w2s = (LAS float*)F.lds;
    for (int i = F.tid; i < 2 * 8192; i += 512) w2s[i] = (i < 8192) ? F.in[I_OD_W2K][i] : F.in[I_OD_W2V][i - 8192];
    __syncthreads();
    for (int rw0 = F.gw * 4; rw0 < 2 * 4096; rw0 += F.NGW * 4) {
        float h0[4], h1[4];
#pragma unroll
        for (int k = 0; k < 4; ++k) { h0[k] = Hd[(size_t)(rw0 + k) * 128 + F.lane]; h1[k] = Hd[(size_t)(rw0 + k) * 128 + 64 + F.lane]; }
#pragma unroll
        for (int k = 0; k < 4; ++k) { const int rw = rw0 + k; const int which = rw >> 12, g = (rw >> 11) & 1, b = (rw >> 7) & 15, n = rw & 127;
            const LAS float* w2 = w2s + which * 8192;
            bf16* outp = (bf16*)(F.ws + (which ? WS_VC : WS_KC)) + ((size_t)(b * 2 + g) * 128 + n) * 64;
            float a = 0.f;
            if (n < NCMP) {
#pragma unroll 16
                for (int j = 0; j < 64; ++j) a += __builtin_bit_cast(float, __builtin_amdgcn_readlane(__builtin_bit_cast(int, h0[k]), j)) * w2[j * 64 + F.lane];
#pragma unroll 16
                for (int j = 0; j < 64; ++j) a += __builtin_bit_cast(float, __builtin_amdgcn_readlane(__builtin_bit_cast(int, h1[k]), j)) * w2[(64 + j) * 64 + F.lane]; }
            outp[F.lane] = (bf16)f2bf(a); }
    }
}

constexpr int NPHASE = 29;
__global__ void __launch_bounds__(NWAVES * 64, 2) skel_fwd(Args args) {
    extern __shared__ __attribute__((aligned(16))) unsigned char lds[];
    Frame F;
    F.lds = (LAS unsigned char*)lds; F.ws = args.ws; F.acc = args.out; F.in = args.in;
    F.tid = threadIdx.x; F.lane = F.tid & 63; F.wave = __builtin_amdgcn_readfirstlane(F.tid >> 6);
    F.G = gridDim.x; F.gw = blockIdx.x * NWAVES + F.wave; F.NGW = F.G * NWAVES;
    volatile LAS unsigned* MISC = (volatile LAS unsigned*)(F.lds + MISC_OFF);
    for (int u = F.tid; u < (LDS_BYTES - LDSCTL_OFF) / 4; u += NWAVES * 64) ((LAS unsigned*)(F.lds + LDSCTL_OFF))[u] = 0u;
    __syncthreads();
    unsigned* ctl = (unsigned*)(args.ws + WS_CTL);
    XcdBarrier bar; bar.bar = ctl + CW_BAR; bar.x = 0; bar.st = nullptr;
    const int lo = args.ph_lo, hi = args.ph_hi;
    if (hi - lo > 1) {
        bar = xcd_barrier_post(ctl + CW_BAR, MISC + 8);
        if (threadIdx.x == 0) { unsigned nloc, nx; xcd_barrier_complete(ctl + CW_BAR, bar.x, nloc, nx); MISC[8] = nloc; MISC[9] = nx; }
        __syncthreads();
    }
#ifndef PH_LO
#define PH_LO 0
#define PH_HI 99
#endif
#define IN(k) ((k) >= PH_LO && (k) < PH_HI && lo <= (k) && (k) < hi && fresh(F, ws, args.ws, args.out) && probe_open(F, (k)))
#define SEAM(k) do { if ((lo <= (k) && (k) < hi) && (lo <= (k) + 1 && (k) + 1 < hi)) xcd_barrier(bar, F.tid); probe_close(F, (k)); } while (0)
    unsigned char* ws = args.ws;
    const int bx = blockIdx.x;

    if (IN(0)) { prologue(F); } SEAM(0);
    if (IN(1)) {
        { pg8::StaticSched<256 * 2048, 256 * 2048> Sd{(const char*)(ws + WS_HB), (const char*)(ws + W_IN0), M / 256, P0_LD / 256, F.G, bx, F.wave};
          pg8::EpiBf16 E{(bf16*)(ws + WS_P0), P0_LD}; pg8::gemm_phase<1024, 2048, 2048>(F.lds, Sd, E); }
        for (int i = 0; i < 2; ++i) {
          pg8::StaticSched<256 * 2048, 256 * 2048> Sd{(const char*)(ws + WS_MEMB), (const char*)(ws + W_XKV + (size_t)i * 1024 * 1024 * 2), MMEM / 256, 4, F.G, (bx + 128 * (i + 1)) % F.G, F.wave};
          pg8::EpiBf16 E{(bf16*)(ws + WS_XKV + (size_t)i * MMEM * 1024 * 2), 1024}; pg8::gemm_phase<1024, 2048, 2048>(F.lds, Sd, E); }
    } SEAM(1);
    if (IN(2)) { PROBE_START(6, F.tid); cn_phase(F); PROBE_STOP(6, F.tid); PROBE_START(7, F.tid); idx_phase_mfma(F); PROBE_STOP(7, F.tid); PROBE_START(8, F.tid); swa_phase_mfma(F); PROBE_STOP(8, F.tid); } SEAM(2);
    if (IN(3)) { dsa_phase_mfma(F); } SEAM(3);
    if (IN(4)) { pg8::StaticSched<256 * P0_LD * 2, 256 * 1536 * 2> Sd{(const char*)(ws + WS_P0), (const char*)(ws + W_OUT0), M / 256, 4, F.G, bx, F.wave};
                 pg8::EpiSumB E{(const bf16*)(ws + WS_HB), (bf16*)F.acc}; pg8::gemm_phase<1536, P0_LD * 2, 1536 * 2>(F.lds, Sd, E); } SEAM(4);
    if (IN(5)) { ln_phase<0>(F, 0, (const bf16*)F.acc); } SEAM(5);
    if (IN(6)) { pg8::StaticSched<256 * 2048, 256 * 2048> Sd{(const char*)(ws + WS_HB), (const char*)(ws + W_XQ), M / 256, 2, F.G, bx, F.wave};
                 pg8::EpiBf16 E{(bf16*)(ws + WS_QX0), 512}; pg8::gemm_phase<1024, 2048, 2048>(F.lds, Sd, E); asm volatile("s_waitcnt vmcnt(0)" ::: "memory"); __syncthreads(); xattn_phase_mfma(F, (const bf16*)(ws + WS_QX0), (const bf16*)(ws + WS_XKV), (bf16*)(ws + WS_OX0)); } SEAM(6);
    if (IN(7)) { pg8::StaticSched<256 * 1024, 256 * 1024> Sd{(const char*)(ws + WS_OX0), (const char*)(ws + W_XO), M / 256, 4, F.G, bx, F.wave};
                 pg8::EpiSumB E{(const bf16*)(ws + WS_HB), (bf16*)F.acc}; pg8::gemm_phase<512, 1024, 1024>(F.lds, Sd, E); } SEAM(7);
    if (IN(8)) { ln_phase<0>(F, 1, (const bf16*)F.acc); } SEAM(8);
    if (IN(9)) { pg8::StaticSched<256 * 2048, 256 * 2048> Sd{(const char*)(ws + WS_HB), (const char*)(ws + W_FGU), M / 256, 2 * DFF / 256, F.G, bx, F.wave};
                  pg8::EpiSwiglu E{(bf16*)(ws + WS_HID), DFF, 0, nullptr}; pg8::gemm_phase<1024, 2048, 2048>(F.lds, Sd, E); } SEAM(9);
    if (IN(10)) { pg8::StaticSched<256 * DFF * 2, 256 * DFF * 2> Sd{(const char*)(ws + WS_HID), (const char*)(ws + W_FD), M / 256, 4, F.G, bx, F.wave};
                  pg8::EpiSumB E{(const bf16*)(ws + WS_HB), (bf16*)F.acc}; pg8::gemm_phase<DFF, DFF * 2, DFF * 2>(F.lds, Sd, E); } SEAM(10);
    if (IN(11)) { ln_phase<0>(F, 2, (const bf16*)F.acc); cmp_prep(F); } SEAM(11);
    if (IN(12)) { pg8::StaticSched<256 * 2048, 256 * 2048> Sd{(const char*)(ws + WS_HB), (const char*)(ws + W_IN1), M / 256, P1_LD / 256, F.G, bx, F.wave};
                  pg8::EpiBf16 E{(bf16*)(ws + WS_P1), P1_LD}; pg8::gemm_phase<1024, 2048, 2048>(F.lds, Sd, E); } SEAM(12);
    if (IN(13)) { pg8::CmpSched Sd{(const char*)(ws + WS_P1), (const char*)(ws + WS_W1T), F.G, bx, F.wave};
                  pg8::EpiCmpHid E{(float*)(ws + WS_HIDC), (const float*)(ws + WS_PEB)}; pg8::gemm_phase<2048, 16 * P1_LD * 2, 2048 * 2, P1_LD * 2, (long)S * P1_LD * 2>(F.lds, Sd, E); } SEAM(13);
    if (IN(14)) { cmp_w2_phase(F); } SEAM(14);
    if (IN(15)) { cmp_phase_mfma(F); asm volatile("s_waitcnt vmcnt(0)" ::: "memory"); __syncthreads(); slc_phase_mfma(F); asm volatile("s_waitcnt vmcnt(0)" ::: "memory"); __syncthreads(); win_phase_mfma(F); } SEAM(15);
    if (IN(16)) { pg8::StaticSched<256 * P1_LD * 2, 256 * 2048> Sd{(const char*)(ws + WS_P1), (const char*)(ws + W_OUT1), M / 256, 4, F.G, bx, F.wave};
                  pg8::EpiSumB E{(const bf16*)(ws + WS_HB), (bf16*)F.acc}; pg8::gemm_phase<1024, P1_LD * 2, 2048>(F.lds, Sd, E); } SEAM(16);
    if (IN(17)) { ln_phase<0>(F, 3, (const bf16*)F.acc); } SEAM(17);
    if (IN(18)) { pg8::StaticSched<256 * 2048, 256 * 2048> Sd{(const char*)(ws + WS_HB), (const char*)(ws + W_XQ + (size_t)512 * 1024 * 2), M / 256, 2, F.G, bx, F.wave};
                  pg8::EpiBf16 E{(bf16*)(ws + WS_QX1), 512}; pg8::gemm_phase<1024, 2048, 2048>(F.lds, Sd, E); asm volatile("s_waitcnt vmcnt(0)" ::: "memory"); __syncthreads(); xattn_phase_mfma(F, (const bf16*)(ws + WS_QX1), (const bf16*)(ws + WS_XKV + (size_t)MMEM * 1024 * 2), (bf16*)(ws + WS_OX1)); } SEAM(18);
    if (IN(19)) { pg8::StaticSched<256 * 1024, 256 * 1024> Sd{(const char*)(ws + WS_OX1), (const char*)(ws + W_XO + (size_t)1024 * 512 * 2), M / 256, 4, F.G, bx, F.wave};
                  pg8::EpiSumB E{(const bf16*)(ws + WS_HB), (bf16*)(ws + WS_SCR + 64 * MiB)}; pg8::gemm_phase<512, 1024, 1024>(F.lds, Sd, E); } SEAM(19);
    if (IN(20)) { ln_phase<1>(F, 4, (const bf16*)(ws + WS_SCR + 64 * MiB)); } SEAM(20);
    if (IN(21)) { moe_dispatch(F); } SEAM(21);
#pragma unroll 1
    for (int ch = 0; ch < 3; ++ch) {
        const int pa = 22 + 2 * ch, pb = 23 + 2 * ch;
        const int* tile_exp = (const int*)(ws + WS_TILEEXP);
        if (IN(pa) || IN(pb)) {
            const int s1 = tile_exp[514];
            int t0 = 128 * ch, t1 = (ch == 2) ? s1 : (t0 + 128 < s1 ? t0 + 128 : s1);
            if (t0 > s1) t0 = s1; int nT = t1 - t0; if (nT < 0) nT = 0; if (nT > 128) nT = 128;
            PROBE_STARTF(11, F.tid);
            if (IN(pa)) { pg8::MoeSched<WS_PERMA, W_MGU, 256 * 2048, 256 * 2048, (size_t)7168 * 2048, 0> Sd{ws, t0, nT, 2 * DFFE / 256, F.G, bx, F.wave, nullptr};
                          pg8::EpiSwiglu E{(bf16*)(ws + WS_HIDM), DFFE, 1, (bf16*)args.out}; pg8::gemm_phase<1024, 2048, 2048>(F.lds, Sd, E); }
            if (IN(pa) && IN(pb)) xcd_barrier(bar, F.tid);
            PROBE_STOPF(11, F.tid); PROBE_STARTF(12, F.tid);
            if (IN(pb)) { pg8::MoeSched<WS_HIDM, W_MD, 256 * DFFE * 2, 256 * DFFE * 2, (size_t)1024 * DFFE * 2, 1> Sd{ws, t0, nT, 4, F.G, bx, F.wave, (const unsigned char*)args.out};
                          pg8::EpiBf16 E{(bf16*)(ws + WS_PERMA), 1024}; pg8::gemm_phase<DFFE, DFFE * 2, DFFE * 2>(F.lds, Sd, E); }
            if (IN(pb) && IN(pb + 1)) xcd_barrier(bar, F.tid);
            PROBE_STOPF(12, F.tid);
        }
    }
    if (IN(28)) { ln_phase<2>(F, 5, nullptr); }
    PROBE_SPIN(F.tid);
#undef IN
#undef SEAM
}

extern "C" void kernel_launch(void* const* d_in, const int* in_sizes, int n_in, void* d_out, int out_size, void* d_ws, size_t ws_size, hipStream_t stream) {
    static int grid = 0;
    if (grid == 0) {
        if (n_in != 30 || out_size != M * D || ws_size < WS_END) { fprintf(stderr, "kernel_launch: unexpected shapes (n_in %d, out %d, ws %zu < %zu); nothing launched\n", n_in, out_size, ws_size, (size_t)WS_END); grid = -1; return; }
        int dev = 0, cus = 0, per_cu = 0;
        if (hipGetDevice(&dev) != hipSuccess || hipDeviceGetAttribute(&cus, hipDeviceAttributeMultiprocessorCount, dev) != hipSuccess) { grid = -1; return; }
        if (hipFuncSetAttribute((const void*)skel_fwd, hipFuncAttributeMaxDynamicSharedMemorySize, LDS_BYTES) != hipSuccess) { fprintf(stderr, "kernel_launch: hipFuncSetAttribute failed\n"); grid = -1; return; }
        if (hipOccupancyMaxActiveBlocksPerMultiprocessor(&per_cu, (const void*)skel_fwd, NWAVES * 64, LDS_BYTES) != hipSuccess || per_cu < 1)
            fprintf(stderr, "kernel_launch: occupancy query reports %d workgroups per CU\n", per_cu);
        (void)hipGetLastError();
        grid = cus;
    }
    if (grid < 0) return;
    if (hipMemsetAsync((char*)d_ws + WS_CTL, 0, CTL_ZERO_BYTES, stream) != hipSuccess) return;
    Args a{};
    for (int i = 0; i < 30; ++i) a.in[i] = (const float*)d_in[i];
    a.out = (float*)d_out; a.ws = (unsigned char*)d_ws;
#if MK_ONE_LAUNCH
    a.ph_lo = 0; a.ph_hi = NPHASE;
    hipLaunchKernelGGL(skel_fwd, dim3(grid), dim3(NWAVES * 64), LDS_BYTES, stream, a);
#else
    for (int p = 0; p < NPHASE; ++p) { a.ph_lo = p; a.ph_hi = p + 1; hipLaunchKernelGGL(skel_fwd, dim3(grid), dim3(NWAVES * 64), LDS_BYTES, stream, a); }
#endif
}
```

```cpp
#include <hip/hip_runtime.h>
#include <cstdio>
#include <cstdint>

#ifndef PROBE_ID
#define PROBE_ID 0
#endif
#ifndef PROBE_AMP
#define PROBE_AMP 4
#endif
#ifndef PROBE_MASK
#define PROBE_MASK 0ull
#endif
#define PROBE_SEL(ph) ((PROBE_MASK >> (ph)) & 1ull)
#if PROBE_ID
#define PROBE_T0 ((volatile __attribute__((address_space(3))) unsigned long long*)(unsigned)(131072 + 320 + 64))
#define PROBE_ACC ((volatile __attribute__((address_space(3))) unsigned long long*)(unsigned)(131072 + 320 + 72))
#define PROBE_WINW ((volatile __attribute__((address_space(3))) unsigned*)(unsigned)(131072 + 320 + 80))
#define PROBE_WIN(ph, on, tid) do { if (PROBE_SEL(ph) && blockIdx.x == 0 && (tid) == 0) { *PROBE_WINW = (on); } } while (0)
#define PROBE_START(id, tid) do { if ((id) == PROBE_ID && blockIdx.x == 0 && (tid) == 0 && *PROBE_WINW) { *PROBE_T0 = __builtin_amdgcn_s_memtime(); } } while (0)
#define PROBE_STOP(id, tid) do { if ((id) == PROBE_ID && blockIdx.x == 0 && (tid) == 0 && *PROBE_WINW) { *PROBE_ACC = *PROBE_ACC + (__builtin_amdgcn_s_memtime() - *PROBE_T0); } } while (0)
#define PROBE_STARTF(id, tid) do { if ((id) == PROBE_ID && blockIdx.x == 0 && (tid) == 0) { *PROBE_T0 = __builtin_amdgcn_s_memtime(); } } while (0)
#define PROBE_STOPF(id, tid) do { if ((id) == PROBE_ID && blockIdx.x == 0 && (tid) == 0) { *PROBE_ACC = *PROBE_ACC + (__builtin_amdgcn_s_memtime() - *PROBE_T0); } } while (0)
#define PROBE_SPIN(tid) do { if (blockIdx.x == 0 && (tid) == 0) { const unsigned long long t0_ = __builtin_amdgcn_s_memtime(), w_ = *PROBE_ACC * PROBE_AMP; while (__builtin_amdgcn_s_memtime() - t0_ < w_) __builtin_amdgcn_s_sleep(8); } } while (0)
#else
#define PROBE_WIN(ph, on, tid) do {} while (0)
#define PROBE_START(id, tid) do {} while (0)
#define PROBE_STOP(id, tid) do {} while (0)
#define PROBE_STARTF(id, tid) do {} while (0)
#define PROBE_STOPF(id, tid) do {} while (0)
#define PROBE_SPIN(tid) do {} while (0)
#endif
#ifndef MK_ONE_LAUNCH
#define MK_ONE_LAUNCH 1
#endif

constexpr size_t ROWTOK_OFF = 5u * 1048576u + 512u * 1024u, ROWW_OFF = 6u * 1048576u, TILEEXP_OFF = 6u * 1048576u + 512u * 1024u, DUMMY_OFF = 7u * 1048576u;
namespace pg8 {
#define PG8_LAS __attribute__((address_space(3)))
typedef unsigned short bf16_t;
typedef short bf16x8 __attribute__((ext_vector_type(8)));
typedef float f32x4 __attribute__((ext_vector_type(4)));
typedef unsigned u32x4 __attribute__((ext_vector_type(4)));
constexpr int BM = 256, BK = 64, HALF = 128, HTB = HALF * BK * 2, STAGE_BYTES = 8 * HTB, NXCD = 8, WGM = 4;

__host__ __device__ __forceinline__ int lds_byte(int r, int c) { const int st = (r >> 4) * 2 + (c >> 5), rr = r & 15, cc = c & 31, ob = rr * 64 + cc * 2; return st * 1024 + (ob ^ (((ob >> 9) & 1) << 5)); }
__host__ __device__ __forceinline__ void stage_rc(int b, int& R, int& C) { const int st = b / 1024, sb = b % 1024, swz = sb ^ (((sb >> 9) & 1) << 5); R = (st >> 1) * 16 + swz / 64; C = (st & 1) * 32 + (swz % 64) / 2; }
__host__ __device__ __forceinline__ int perm32(int rho) { const int n = rho >> 4, i = rho & 15; return 8 * (i >> 2) + 4 * n + (i & 3); }

__device__ __forceinline__ const void* opaque_uniform(const void* p) {
    unsigned lo = __builtin_amdgcn_readfirstlane((unsigned)(unsigned long long)p), hi = __builtin_amdgcn_readfirstlane((unsigned)((unsigned long long)p >> 32));
    asm volatile("" : "+s"(lo), "+s"(hi));
    const __attribute__((address_space(1))) void* g = (const __attribute__((address_space(1))) void*)(((unsigned long long)hi << 32) | lo);
    return (const void*)g; }
constexpr int MOE_SPLIT = 68, MOE_ALT_TILES = 73, MOE_TAILCAP = MOE_SPLIT + MOE_ALT_TILES - 128;
__device__ __forceinline__ bool moe_slot_alt(int l) { return l >= MOE_SPLIT - MOE_TAILCAP && l < 128; }
__device__ __forceinline__ int moe_slot(int l) { return l >= 128 ? l - 128 : (l < MOE_SPLIT - MOE_TAILCAP ? l + MOE_TAILCAP : l - (MOE_SPLIT - MOE_TAILCAP)); }
struct Unit { int pm, pn, aux; const char* a; const char* b; };

__device__ __forceinline__ void tile_of(int wgid, int nM, int nN, int& pm, int& pn) {
    const int nwg = nM * nN;
    { const int q = nwg / NXCD, r = nwg % NXCD, xcd = wgid % NXCD, off = wgid / NXCD; wgid = (xcd < r ? xcd * (q + 1) : r * (q + 1) + (xcd - r) * q) + off; }
    const int nig = WGM * nN, gid = wgid / nig, fm = gid * WGM, gsz = (nM - fm) < WGM ? (nM - fm) : WGM;
    pm = fm + ((wgid % nig) % gsz); pn = (wgid % nig) / gsz;
}
template <size_t A_TILE, size_t B_TILE>
struct StaticSched {
    const char* A; const char* B; int nM, nN, G, c, wave;
    __device__ __forceinline__ bool next(int i, Unit& u) const {
        const long L = (long)i * G + c; if (L >= (long)nM * nN) return false;
        int pm, pn; tile_of((int)L, nM, nN, pm, pn);
        u.pm = pm; u.pn = pn; u.aux = 0; u.a = A + (size_t)pm * A_TILE; u.b = B + (size_t)pn * B_TILE; return true;
    }
};
template <size_t A_OFF, size_t B_OFF, size_t A_TILE, size_t B_TILE, size_t B_EXP, int A_LOCAL>
struct MoeSched {
    const unsigned char* ws; int t0, nT, nN, G, c, wave; const unsigned char* alt; int loc0;
    __device__ __forceinline__ bool next(int i, Unit& u) const {
        const long L = (long)i * G + c; if (L >= (long)nT * nN) return false;
        int pml, pn; tile_of((int)L, nT, nN, pml, pn);
        const unsigned char* wsb = (const unsigned char*)opaque_uniform(ws);
        const int pm = t0 + pml; const int e = __builtin_amdgcn_readfirstlane(((const int*)(wsb + TILEEXP_OFF))[pm]);
        u.pm = pm; u.pn = pn; u.aux = pml + loc0; u.a = A_LOCAL ? ((moe_slot_alt(pml + loc0) ? (const char*)opaque_uniform(alt) : (const char*)wsb + A_OFF) + (size_t)moe_slot(pml + loc0) * A_TILE) : ((const char*)wsb + A_OFF + (size_t)pm * A_TILE); u.b = (const char*)wsb + B_OFF + (size_t)e * B_EXP + (size_t)pn * B_TILE; return true;
    }
};

template <size_t A_OFF, size_t B_OFF, size_t A_TILE, size_t B_TILE, size_t B_EXP, size_t KOFF>
struct TailSched {
    const unsigned char* ws; int t0, nT, c, wave, loc0;
    __device__ __forceinline__ bool next(int i, Unit& u) const {
        if (i > 0 || c >= 8 * nT) return false;
        const int half = c >= 4 * nT ? 1 : 0, L = c - half * 4 * nT;
        int pml, pn; tile_of(L, nT, 4, pml, pn);
        const unsigned char* wsb = (const unsigned char*)opaque_uniform(ws);
        const int pm = t0 + pml; const int e = __builtin_amdgcn_readfirstlane(((const int*)(wsb + TILEEXP_OFF))[pm]);
        u.pm = pm; u.pn = pn; u.aux = half;
        u.a = (const char*)wsb + A_OFF + (size_t)moe_slot(pml + loc0) * A_TILE + (size_t)half * KOFF;
        u.b = (const char*)wsb + B_OFF + (size_t)e * B_EXP + (size_t)pn * B_TILE + (size_t)half * KOFF; return true;
    }
};

__device__ __forceinline__ unsigned cvt_pk_bf16(float lo, float hi) { unsigned r; asm volatile("v_cvt_pk_bf16_f32 %0, %1, %2" : "=v"(r) : "v"(lo), "v"(hi)); return r; }

struct EpiBf16 {
    static constexpr bool PERM = true;
    bf16_t* O; int ldc;
    __device__ __forceinline__ void operator()(const f32x4 (&acc)[2][2][4][2], const Unit& u, int wr, int wc, int fr, int fq) const {
        const int row0 = u.pm * BM + wr * 64 + fr, col0 = u.pn * BM + wc * 32 + 8 * fq;
#pragma unroll
        for (int ai = 0; ai < 2; ++ai)
#pragma unroll
            for (int m = 0; m < 4; ++m) { bf16_t* rowp = O + (size_t)(row0 + ai * HALF + m * 16) * ldc + col0;
#pragma unroll
                for (int bj = 0; bj < 2; ++bj) { const f32x4 v0 = acc[ai][bj][m][0], v1 = acc[ai][bj][m][1];
                    u32x4 w; w.x = cvt_pk_bf16(v0[0], v0[1]); w.y = cvt_pk_bf16(v0[2], v0[3]); w.z = cvt_pk_bf16(v1[0], v1[1]); w.w = cvt_pk_bf16(v1[2], v1[3]);
                    *(u32x4*)(rowp + bj * HALF) = w; } }
    }
};
struct EpiBf16Two {
    static constexpr bool PERM = true;
    bf16_t* O; bf16_t* O1; int ldc;
    __device__ __forceinline__ void operator()(const f32x4 (&acc)[2][2][4][2], const Unit& u, int wr, int wc, int fr, int fq) const {
        const int row0 = u.pm * BM + wr * 64 + fr, col0 = u.pn * BM + wc * 32 + 8 * fq;
        bf16_t* Ob = u.aux ? O1 : O;
#pragma unroll
        for (int ai = 0; ai < 2; ++ai)
#pragma unroll
            for (int m = 0; m < 4; ++m) { bf16_t* rowp = Ob + (size_t)(row0 + ai * HALF + m * 16) * ldc + col0;
#pragma unroll
                for (int bj = 0; bj < 2; ++bj) { const f32x4 v0 = acc[ai][bj][m][0], v1 = acc[ai][bj][m][1];
                    u32x4 w; w.x = cvt_pk_bf16(v0[0], v0[1]); w.y = cvt_pk_bf16(v0[2], v0[3]); w.z = cvt_pk_bf16(v1[0], v1[1]); w.w = cvt_pk_bf16(v1[2], v1[3]);
                    *(u32x4*)(rowp + bj * HALF) = w; } }
    }
};
struct EpiAcc {
    static constexpr bool PERM = false;
    float* C; int ldc;
    __device__ __forceinline__ void operator()(const f32x4 (&acc)[2][2][4][2], const Unit& u, int wr, int wc, int fr, int fq) const {
        const int row0 = u.pm * BM + wr * 64 + fr, col0 = u.pn * BM + wc * 32 + 4 * fq;
#pragma unroll
        for (int ai = 0; ai < 2; ++ai)
#pragma unroll
            for (int m = 0; m < 4; ++m) { float* rowp = C + (size_t)(row0 + ai * HALF + m * 16) * ldc + col0;
                f32x4 o[2][2];
#pragma unroll
                for (int bj = 0; bj < 2; ++bj)
#pragma unroll
                    for (int n = 0; n < 2; ++n) o[bj][n] = *(const f32x4*)(rowp + bj * HALF + n * 16);
#pragma unroll
                for (int bj = 0; bj < 2; ++bj)
#pragma unroll
                    for (int n = 0; n < 2; ++n) *(f32x4*)(rowp + bj * HALF + n * 16) = o[bj][n] + acc[ai][bj][m][n]; }
    }
};
struct EpiSumB {
    static constexpr bool PERM = true;
    const bf16_t* H; bf16_t* O;
    __device__ __forceinline__ void operator()(const f32x4 (&acc)[2][2][4][2], const Unit& u, int wr, int wc, int fr, int fq) const {
        const int row0 = u.pm * BM + wr * 64 + fr, col0 = u.pn * BM + wc * 32 + 8 * fq;
#pragma unroll
        for (int ai = 0; ai < 2; ++ai)
#pragma unroll
            for (int m = 0; m < 4; ++m) { const size_t off = (size_t)(row0 + ai * HALF + m * 16) * 1024 + col0;
                u32x4 hw[2];
#pragma unroll
                for (int bj = 0; bj < 2; ++bj) hw[bj] = *(const u32x4*)(H + off + bj * HALF);
#pragma unroll
                for (int bj = 0; bj < 2; ++bj) { const f32x4 v0 = acc[ai][bj][m][0], v1 = acc[ai][bj][m][1]; const u32x4 h = hw[bj]; const float A = 1.41421356237f;
                    u32x4 w; w.x = cvt_pk_bf16(v0[0] + A * __builtin_bit_cast(float, h.x << 16), v0[1] + A * __builtin_bit_cast(float, h.x & 0xffff0000u));
                    w.y = cvt_pk_bf16(v0[2] + A * __builtin_bit_cast(float, h.y << 16), v0[3] + A * __builtin_bit_cast(float, h.y & 0xffff0000u));
                    w.z = cvt_pk_bf16(v1[0] + A * __builtin_bit_cast(float, h.z << 16), v1[1] + A * __builtin_bit_cast(float, h.z & 0xffff0000u));
                    w.w = cvt_pk_bf16(v1[2] + A * __builtin_bit_cast(float, h.w << 16), v1[3] + A * __builtin_bit_cast(float, h.w & 0xffff0000u));
                    *(u32x4*)(O + off + bj * HALF) = w; } }
    }
};
__device__ __forceinline__ float silu_f(float x) { return x / (1.0f + __expf(-x)); }
struct EpiSwiglu {
    static constexpr bool PERM = true;
    bf16_t* O; int ldc; int row_local; bf16_t* O2;
    __device__ __forceinline__ void operator()(const f32x4 (&acc)[2][2][4][2], const Unit& u, int wr, int wc, int fr, int fq) const {
        const int row0 = (row_local ? moe_slot(u.aux) : u.pm) * BM + wr * 64 + fr, col0 = u.pn * HALF + wc * 32 + 8 * fq;
        bf16_t* Ob = (row_local && moe_slot_alt(u.aux)) ? O2 : O;
#pragma unroll
        for (int ai = 0; ai < 2; ++ai)
#pragma unroll
            for (int m = 0; m < 4; ++m) { bf16_t* rowp = Ob + (size_t)(row0 + ai * HALF + m * 16) * ldc + col0;
                const f32x4 g0 = acc[ai][0][m][0], g1 = acc[ai][0][m][1], u0 = acc[ai][1][m][0], u1 = acc[ai][1][m][1];
                float h[8];
#pragma unroll
                for (int j = 0; j < 4; ++j) { h[j] = silu_f(g0[j]) * u0[j]; h[4 + j] = silu_f(g1[j]) * u1[j]; }
                u32x4 w; w.x = cvt_pk_bf16(h[0], h[1]); w.y = cvt_pk_bf16(h[2], h[3]); w.z = cvt_pk_bf16(h[4], h[5]); w.w = cvt_pk_bf16(h[6], h[7]);
                *(u32x4*)rowp = w; }
    }
};
struct EpiMoeDown {
    static constexpr bool PERM = false;
    float* C; unsigned char* ws;
    __device__ __forceinline__ void operator()(const f32x4 (&acc)[2][2][4][2], const Unit& u, int wr, int wc, int fr, int fq) const {
        const int row0 = u.pm * BM + wr * 64 + fr, col0 = u.pn * BM + wc * 32 + 4 * fq;
        unsigned char* wsb = (unsigned char*)opaque_uniform(ws);
        const int* rowtok = (const int*)(wsb + ROWTOK_OFF); const float* roww = (const float*)(wsb + ROWW_OFF); float* dummy = (float*)(wsb + DUMMY_OFF);
#pragma unroll
        for (int ai = 0; ai < 2; ++ai)
#pragma unroll
            for (int m = 0; m < 4; ++m) { const int r = row0 + ai * HALF + m * 16; const int tok = rowtok[r]; const float w = roww[r];
                float* rowp = (tok >= 0 ? C + (size_t)tok * 1024 : dummy) + col0;
                f32x4 o[2][2];
#pragma unroll
                for (int bj = 0; bj < 2; ++bj)
#pragma unroll
                    for (int n = 0; n < 2; ++n) o[bj][n] = *(const f32x4*)(rowp + bj * HALF + n * 16);
#pragma unroll
                for (int bj = 0; bj < 2; ++bj)
#pragma unroll
                    for (int n = 0; n < 2; ++n) *(f32x4*)(rowp + bj * HALF + n * 16) = o[bj][n] + acc[ai][bj][m][n] * w; }
    }
};

__device__ __forceinline__ float gelu_tanh_f(float x) { const float u = 0.7978845608028654f * (x + 0.044715f * x * x * x); const float e = __expf(2.f * u); return 0.5f * x * (1.f + (1.f - 2.f / (e + 1.f))); }
struct EpiCmpHid {
    static constexpr bool PERM = false;
    float* Hd; const float* bias;
    __device__ __forceinline__ void operator()(const f32x4 (&acc)[2][2][4][2], const Unit& u, int wr, int wc, int fr, int fq) const {
        const int row0 = u.pm * BM + wr * 64 + fr, col0 = wc * 32 + 4 * fq;
        f32x4 bv[2];
#pragma unroll
        for (int n = 0; n < 2; ++n) bv[n] = *(const f32x4*)(bias + u.aux * 128 + col0 + n * 16);
#pragma unroll
        for (int ai = 0; ai < 2; ++ai)
#pragma unroll
            for (int m = 0; m < 4; ++m) { float* rowp = Hd + (size_t)(row0 + ai * HALF + m * 16) * 128 + col0;
#pragma unroll
                for (int n = 0; n < 2; ++n) { const f32x4 v = acc[ai][0][m][n] + bv[n]; f32x4 o;
#pragma unroll
                    for (int j = 0; j < 4; ++j) o[j] = gelu_tanh_f(v[j]);
                    *(f32x4*)(rowp + n * 16) = o; } }
    }
};
struct CmpSched {
    const char* P1b; const char* W1T; int G, c, wave;
    __device__ __forceinline__ bool next(int i, Unit& u) const {
        const int L = i * G + c; if (L >= 32) return false;
        const int which = L >> 4, tile = L & 15, g = tile >> 3, b0 = 2 * (tile & 7);
        u.pm = L; u.pn = 0; u.aux = which; u.a = P1b + ((size_t)b0 * 2048 * 2048 + (which ? 1152 : 1024) + g * 64) * 2; u.b = W1T + (size_t)which * 256 * 2048 * 2; return true;
    }
};

template <int K, int lda_b, int ldb_b, long KSTEP_A = 128, long HSTEP_A = 128L * lda_b, class Epi, class Sched>
__device__ __forceinline__ void gemm_phase(PG8_LAS unsigned char* lds, const Sched& S, const Epi& E) {
    int tid_ = (int)__builtin_amdgcn_mbcnt_hi(~0u, __builtin_amdgcn_mbcnt_lo(~0u, 0u)); asm volatile("" : "+v"(tid_)); tid_ += S.wave * 64;
    const int tid = tid_, wid = __builtin_amdgcn_readfirstlane(tid >> 6), lane = tid & 63, wr = wid >> 2, wc = wid & 3, fr = lane & 15, fq = lane >> 4;
    constexpr int nt = K / BK;
    unsigned voffA[2], voffB[2];
#pragma unroll
    for (int i = 0; i < 2; ++i) { int R, C; stage_rc(tid * 16 + i * 8192, R, C); const int Rb = Epi::PERM ? ((R & ~31) + perm32(R & 31)) : R;
        voffA[i] = (unsigned)(R * lda_b + C * 2); voffB[i] = (unsigned)(Rb * ldb_b + C * 2); }
    const size_t kstep = (size_t)(BK * 2), kstepA = (size_t)KSTEP_A;
    const size_t hstepA = (size_t)HSTEP_A, hstepB = (size_t)HALF * ldb_b;
    const unsigned ldsw = (unsigned)wid * 1024u;
    const int aoff = lds_byte(wr * 64 + fr, fq * 8), boff = lds_byte(wc * 32 + fr, fq * 8);
#define PG8_SA(b, h) (((b) * 2 + (h)) * HTB)
#define PG8_SB(b, h) ((4 + (b) * 2 + (h)) * HTB)
#define PG8_STAGE(bufoff, gbase, voff) do { _Pragma("unroll") for (int _i = 0; _i < 2; ++_i) \
        __builtin_amdgcn_global_load_lds((const unsigned*)((const char*)(gbase) + (voff)[_i]), (PG8_LAS unsigned*)(lds + (bufoff) + ldsw + _i * 8192), 16, 0, 0); } while (0)
#define PG8_LDA(dst, b, h) do { _Pragma("unroll") for (int m = 0; m < 4; ++m) _Pragma("unroll") for (int k = 0; k < 2; ++k) dst[m][k] = *(const PG8_LAS bf16x8*)(lds + PG8_SA(b, h) + aoff + m * 2048 + k * 1024); } while (0)
#define PG8_LDB(dst, b, h) do { _Pragma("unroll") for (int n = 0; n < 2; ++n) _Pragma("unroll") for (int k = 0; k < 2; ++k) dst[n][k] = *(const PG8_LAS bf16x8*)(lds + PG8_SB(b, h) + boff + n * 2048 + k * 1024); } while (0)
#define PG8_MMA(ai, bj, At, Bt) do { __builtin_amdgcn_s_setprio(1); _Pragma("unroll") for (int m = 0; m < 4; ++m) _Pragma("unroll") for (int n = 0; n < 2; ++n) _Pragma("unroll") for (int k = 0; k < 2; ++k) \
        acc[ai][bj][m][n] = __builtin_amdgcn_mfma_f32_16x16x32_bf16(Bt[n][k], At[m][k], acc[ai][bj][m][n], 0, 0, 0); __builtin_amdgcn_s_setprio(0); } while (0)
#define PG8_WAIT_V(n) asm volatile("s_waitcnt vmcnt(" #n ")" ::: "memory")
#define PG8_WAIT_L(n) asm volatile("s_waitcnt lgkmcnt(" #n ")" ::: "memory")
#define PG8_BAR __builtin_amdgcn_s_barrier()
#define PG8_SCHED __builtin_amdgcn_sched_barrier(0)
    Unit cur, nxt; int ui = 0;
    if (!S.next(0, cur)) return;
    f32x4 acc[2][2][4][2];
#pragma unroll
    for (int a = 0; a < 2; ++a)
#pragma unroll
        for (int b = 0; b < 2; ++b)
#pragma unroll
            for (int m = 0; m < 4; ++m)
#pragma unroll
                for (int n = 0; n < 2; ++n) acc[a][b][m][n] = (f32x4){0.f, 0.f, 0.f, 0.f};
    bf16x8 At[4][2], B0[2][2], B1[2][2];
    const char* cA = cur.a; const char* cB = cur.b;
    PG8_STAGE(PG8_SB(0, 0), cB, voffB); PG8_STAGE(PG8_SB(0, 1), cB + hstepB, voffB); PG8_STAGE(PG8_SA(0, 0), cA, voffA); PG8_STAGE(PG8_SA(0, 1), cA + hstepA, voffA);
    if (wr == 1) PG8_BAR;
    PG8_WAIT_V(2); PG8_BAR;
    PG8_STAGE(PG8_SB(1, 0), cB + kstep, voffB); PG8_STAGE(PG8_SA(1, 0), cA + kstepA, voffA); PG8_STAGE(PG8_SB(1, 1), cB + hstepB + kstep, voffB);
    PG8_WAIT_V(6); PG8_BAR;
    for (;;) {
        const bool has_next = S.next(ui + 1, nxt);
        const char* nA = has_next ? nxt.a : cA; const char* nB = has_next ? nxt.b : cB;
        for (int t = 0; t < nt; t += 2) {
            const bool last = (t == nt - 2);
            const char* a1 = cA + (size_t)(t + 1) * kstepA;
            const char* a2 = last ? nA : cA + (size_t)(t + 2) * kstepA; const char* b2 = last ? nB : cB + (size_t)(t + 2) * kstep;
            const char* a3 = a2 + kstepA; const char* b3 = b2 + kstep;
            PG8_LDB(B0, 0, 0); PG8_LDB(B1, 0, 1); PG8_SCHED; PG8_LDA(At, 0, 0); PG8_STAGE(PG8_SA(1, 1), a1 + hstepA, voffA);
            PG8_WAIT_V(8); PG8_WAIT_L(0); PG8_BAR; PG8_MMA(0, 0, At, B0); PG8_MMA(0, 1, At, B1); PG8_BAR; PG8_SCHED;
            PG8_LDA(At, 0, 1); PG8_STAGE(PG8_SB(0, 0), b2, voffB); PG8_STAGE(PG8_SB(0, 1), b2 + hstepB, voffB); PG8_STAGE(PG8_SA(0, 0), a2, voffA);
            PG8_WAIT_V(8); PG8_WAIT_L(0); PG8_BAR; PG8_MMA(1, 0, At, B0); PG8_MMA(1, 1, At, B1); PG8_BAR; PG8_SCHED;
            PG8_LDB(B0, 1, 0); PG8_LDB(B1, 1, 1); PG8_SCHED; PG8_LDA(At, 1, 0); PG8_STAGE(PG8_SA(0, 1), a2 + hstepA, voffA);
            PG8_WAIT_V(8); PG8_WAIT_L(0); PG8_BAR; PG8_MMA(0, 0, At, B0); PG8_MMA(0, 1, At, B1); PG8_BAR; PG8_SCHED;
            PG8_LDA(At, 1, 1); PG8_STAGE(PG8_SB(1, 0), b3, voffB); PG8_STAGE(PG8_SB(1, 1), b3 + hstepB, voffB); PG8_STAGE(PG8_SA(1, 0), a3, voffA);
            PG8_WAIT_V(8); PG8_WAIT_L(0); PG8_BAR; PG8_MMA(1, 0, At, B0); PG8_MMA(1, 1, At, B1); PG8_BAR; PG8_SCHED;
        }
        if (wr == 0) PG8_BAR;
        E(acc, cur, wr, wc, fr, fq);
        if (!has_next) break;
#pragma unroll
        for (int a = 0; a < 2; ++a)
#pragma unroll
            for (int b = 0; b < 2; ++b)
#pragma unroll
                for (int m = 0; m < 4; ++m)
#pragma unroll
                    for (int n = 0; n < 2; ++n) acc[a][b][m][n] = (f32x4){0.f, 0.f, 0.f, 0.f};
        cur = nxt; cA = nA; cB = nB; ++ui;
        if (wr == 1) PG8_BAR;
    }
    PG8_WAIT_V(0);
    PG8_BAR;
#undef PG8_SA
#undef PG8_SB
#undef PG8_STAGE
#undef PG8_LDA
#undef PG8_LDB
#undef PG8_MMA
#undef PG8_WAIT_V
#undef PG8_WAIT_L
#undef PG8_BAR
#undef PG8_SCHED
}
}

constexpr int NWAVES = 8;
constexpr int D = 1024, NB = 16, S = 2048, M = NB * S, MEML = 256, MMEM = NB * MEML;
constexpr float LN_EPS = 1e-5f, ALPHA = 1.41421356237f;
constexpr int P0_LD = 2560, C0_QLAT = 0, C0_QB = 1024, C0_CKV = 1536, C0_QI = 1664, C0_KI = 2176, C0_KB = 2240, C0_VB = 2368, C0_WI = 2496;
constexpr int P1_LD = 2048, C1_Q = 0, C1_KC = 1024, C1_VC = 1152, C1_KS = 1280, C1_VS = 1408, C1_KW = 1536, C1_VW = 1664, C1_GL = 1792;
constexpr int EVEN_COLS = 1992, ODD_COLS = 1840;
constexpr int DFF = 2816, DFFE = 3584, NE = 8, NCMP = 127;
constexpr int MOE_CHUNK_TILES = 68, MOE_MAX_TILES = 272;

constexpr size_t MiB = 1u << 20;
constexpr size_t WS_CTL = 0, CTL_ZERO_BYTES = 1 * MiB;
constexpr size_t WS_KC = 2 * MiB, WS_VC = 3 * MiB;
constexpr size_t WS_SELM = 4 * MiB;
constexpr size_t WS_RTE = 4 * MiB + 512 * 1024;
constexpr size_t WS_RTW = 5 * MiB;
constexpr size_t WS_ROWTOK = ROWTOK_OFF; static_assert(ROWTOK_OFF == 5 * MiB + 512 * 1024, "");
constexpr size_t WS_ROWW = ROWW_OFF;
constexpr size_t WS_TILEEXP = TILEEXP_OFF; constexpr size_t WS_DUMMY = DUMMY_OFF;
constexpr size_t WS_W = 8 * MiB;
constexpr size_t W_IN0 = WS_W;
constexpr size_t W_OUT0 = W_IN0 + (size_t)2560 * 1024 * 2;
constexpr size_t W_IN1 = W_OUT0 + (size_t)1024 * 1536 * 2;
constexpr size_t W_OUT1 = W_IN1 + (size_t)2048 * 1024 * 2;
constexpr size_t W_XQ = W_OUT1 + (size_t)1024 * 1024 * 2;
constexpr size_t W_XKV = W_XQ + (size_t)2 * 512 * 1024 * 2;
constexpr size_t W_XO = W_XKV + (size_t)2 * 1024 * 1024 * 2;
constexpr size_t W_FGU = W_XO + (size_t)2 * 1024 * 512 * 2;
constexpr size_t W_FD = W_FGU + (size_t)5632 * 1024 * 2;
constexpr size_t W_MGU = W_FD + (size_t)1024 * 2816 * 2;
constexpr size_t W_MD = W_MGU + (size_t)8 * 7168 * 1024 * 2;
constexpr size_t W_END = W_MD + (size_t)8 * 1024 * 3584 * 2;
static_assert(W_END <= 215 * MiB, "weights");
constexpr size_t WS_HB = 215 * MiB;
constexpr size_t WS_XKV = 279 * MiB;
constexpr size_t WS_SCR = 295 * MiB;
constexpr size_t WS_P0 = WS_SCR;
constexpr size_t WS_CN = WS_SCR + 160 * MiB;
constexpr size_t WS_MASK = WS_SCR + 168 * MiB;
constexpr size_t WS_MEMB = WS_SCR + 176 * MiB;
constexpr size_t WS_QX0 = WS_SCR + 184 * MiB, WS_OX0 = WS_SCR + 216 * MiB;
constexpr size_t WS_HID = WS_SCR;
constexpr size_t WS_P1 = WS_SCR;
constexpr size_t WS_OCMP = WS_SCR + 128 * MiB, WS_OSLC = WS_SCR + 192 * MiB;
constexpr size_t WS_W1T = WS_SCR + 192 * MiB, WS_HIDC = WS_SCR + 196 * MiB, WS_PEB = WS_SCR + 200 * MiB;
constexpr size_t WS_QX1 = WS_SCR, WS_OX1 = WS_SCR + 32 * MiB;
constexpr size_t WS_PERMA = WS_SCR;
constexpr size_t WS_HIDM = WS_SCR + 136 * MiB;
constexpr size_t WS_YB = WS_HIDM + (size_t)pg8::MOE_TAILCAP * 256 * DFFE * 2;
constexpr size_t WS_END = WS_SCR + 256 * MiB;
static_assert(WS_HIDM + (size_t)MOE_CHUNK_TILES * 256 * DFFE * 2 <= WS_END, "ws");
constexpr int CW_BAR = 4096;
constexpr int CW_CNT = 16384;
constexpr int CW_CUR = 16384 + 64;

constexpr int RING_BYTES = 131072, LDSCTL_OFF = RING_BYTES, MISC_OFF = LDSCTL_OFF + 320, LDS_BYTES = 147456;

#define GAS __attribute__((address_space(1)))
#define LAS __attribute__((address_space(3)))
typedef unsigned short bf16;
typedef unsigned v4u __attribute__((ext_vector_type(4)));
typedef unsigned v2u __attribute__((ext_vector_type(2)));
typedef float f32x4 __attribute__((ext_vector_type(4)));
#define LDS_WAIT() asm volatile("s_waitcnt lgkmcnt(0)" ::: "memory")
#define WAVE_SYNC() asm volatile("s_waitcnt vmcnt(0) lgkmcnt(0)" ::: "memory")
__device__ __forceinline__ unsigned f2bf(float f) { unsigned u = __builtin_bit_cast(unsigned, f); return (u + 0x7fffu + ((u >> 16) & 1u)) >> 16; }
__device__ __forceinline__ unsigned pk2(float lo, float hi) { return f2bf(lo) | (f2bf(hi) << 16); }
__device__ __forceinline__ float bf2f(bf16 b) { return __builtin_bit_cast(float, (unsigned)b << 16); }
__device__ __forceinline__ float bflo(unsigned w) { return __builtin_bit_cast(float, w << 16); }
__device__ __forceinline__ float bfhi(unsigned w) { return __builtin_bit_cast(float, w & 0xffff0000u); }
__device__ __forceinline__ void ld8bf(const bf16* p, float* f) { const v4u w = *(const v4u*)p; f[0] = bflo(w.x); f[1] = bfhi(w.x); f[2] = bflo(w.y); f[3] = bfhi(w.y); f[4] = bflo(w.z); f[5] = bfhi(w.z); f[6] = bflo(w.w); f[7] = bfhi(w.w); }
__device__ __forceinline__ float wave_sum(float v) {
#pragma unroll
    for (int o = 1; o < 64; o <<= 1) v += __shfl_xor(v, o);
    return v;
}
__device__ __forceinline__ float dpp_f(float v, int ctrl_unused);
#define DPP_ADD_F(v, ctrl, rmask) v += __builtin_bit_cast(float, __builtin_amdgcn_update_dpp(0, __builtin_bit_cast(int, v), ctrl, rmask, 0xf, false))
__device__ __forceinline__ float wave_sum_fast(float v) {
    DPP_ADD_F(v, 0xB1, 0xf); DPP_ADD_F(v, 0x4E, 0xf); DPP_ADD_F(v, 0x141, 0xf); DPP_ADD_F(v, 0x140, 0xf); DPP_ADD_F(v, 0x142, 0xa); DPP_ADD_F(v, 0x143, 0xc);
    return __builtin_bit_cast(float, __builtin_amdgcn_readlane(__builtin_bit_cast(int, v), 63));
}
__device__ __forceinline__ float wave_max(float v) {
#pragma unroll
    for (int o = 1; o < 64; o <<= 1) v = fmaxf(v, __shfl_xor(v, o));
    return v;
}
__device__ const unsigned char BKT[112] = {16, 16, 16, 17, 17, 18, 18, 18, 19, 19, 19, 20, 20, 20, 20, 21, 21, 21, 21, 22, 22, 22, 22, 22, 23, 23, 23, 23, 23, 23, 24, 24, 24, 24, 24, 24, 25, 25, 25, 25, 25, 25, 25, 26, 26, 26, 26, 26, 26, 26, 26,
    27, 27, 27, 27, 27, 27, 27, 27, 27, 27, 28, 28, 28, 28, 28, 28, 28, 28, 28, 28, 29, 29, 29, 29, 29, 29, 29, 29, 29, 29, 29, 29, 30, 30, 30, 30, 30, 30, 30, 30, 30, 30, 30, 30, 30, 30, 31, 31, 31, 31, 31, 31, 31, 31, 31, 31, 31, 31, 31, 31, 31};
__device__ __forceinline__ int rel_bucket(int n) { return n < 16 ? n : (n >= 128 ? 31 : (int)BKT[n - 16]); }

#define XB_TMO      128
#define XB_XCNT(j)  (256  + 64 * (j))
#define XB_XSUB(j)  (1280 + 64 * (j))
#define XB_XGEN(j)  (2304 + 64 * (j))
#define XB_TOP      3328
#define XB_TOPGEN   3392
#define XCD_BAR_WORDS 3456
#define XB_SPIN_CAP (1u << 22)
__device__ __forceinline__ unsigned xb_ld(unsigned* p)              { return __hip_atomic_load(p, __ATOMIC_RELAXED, __HIP_MEMORY_SCOPE_AGENT); }
__device__ __forceinline__ unsigned xb_add(unsigned* p, unsigned v) { return __hip_atomic_fetch_add(p, v, __ATOMIC_RELAXED, __HIP_MEMORY_SCOPE_AGENT); }
__device__ __forceinline__ unsigned xb_xcc_id() { return (unsigned)__builtin_amdgcn_s_getreg((3 << 11) | 20) & 0xFu; }
#define XB_SPIN(cond, bar) do { unsigned _sp = 0; while (cond) { __builtin_amdgcn_s_sleep(1); \
    if ((++_sp & 255u) == 0u) { if (xb_ld(&(bar)[XB_TMO])) break; if (_sp > XB_SPIN_CAP) { atomicAdd(&(bar)[XB_TMO], 1u); break; } } } } while (0)
struct XcdBarrier { unsigned* bar; unsigned x; volatile LAS unsigned* st; };
__device__ __forceinline__ XcdBarrier xcd_barrier_post(unsigned* bar, volatile LAS unsigned* st) {
    XcdBarrier b; b.bar = bar; b.x = xb_xcc_id(); b.st = st;
    if (threadIdx.x == 0) (void)xb_add(&bar[XB_XCNT(b.x)], 1u);
    return b;
}
__device__ __forceinline__ void xcd_barrier_complete(unsigned* bar, unsigned x, unsigned& nloc, unsigned& nx) {
    const unsigned G = gridDim.x * gridDim.y * gridDim.z;
    unsigned sum, cnt, mine, sp = 0u;
    for (;;) {
        sum = 0u; cnt = 0u; mine = 0u;
#pragma unroll
        for (unsigned j = 0; j < 16; ++j) { const unsigned c = xb_ld(&bar[XB_XCNT(j)]); sum += c; cnt += (c > 0u) ? 1u : 0u; mine = (j == x) ? c : mine; }
        if (sum == G) break;
        __builtin_amdgcn_s_sleep(1);
        if ((++sp & 255u) == 0u) { if (xb_ld(&bar[XB_TMO])) break; if (sp > XB_SPIN_CAP) { atomicAdd(&bar[XB_TMO], 1u); break; } }
    }
    nloc = mine > 0u ? mine : 1u; nx = cnt > 0u ? cnt : 1u;
}
__device__ __forceinline__ void xcd_barrier(const XcdBarrier& b, int tid) {
    asm volatile("s_waitcnt vmcnt(0)" ::: "memory");
    __syncthreads();
    if (tid == 0) {
        unsigned* bar = b.bar;
        __builtin_amdgcn_s_waitcnt(0);
        unsigned nloc = b.st[0], nx = b.st[1];
        const unsigned old = xb_add(&bar[XB_XSUB(b.x)], 1u);
        const unsigned gen = old / nloc;
        if (old + 1u == (gen + 1u) * nloc) {
            __builtin_amdgcn_fence(__ATOMIC_RELEASE, "agent");
            asm volatile("s_waitcnt vmcnt(0)" ::: "memory");
            const unsigned og = xb_add(&bar[XB_TOP], 1u);
            const unsigned tg = og / nx;
            if (og + 1u == (tg + 1u) * nx) xb_add(&bar[XB_TOPGEN], 1u);
            else XB_SPIN(xb_ld(&bar[XB_TOPGEN]) == tg, bar);
            __builtin_amdgcn_fence(__ATOMIC_ACQUIRE, "agent");
            xb_add(&bar[XB_XGEN(b.x)], 1u);
            asm volatile("s_waitcnt vmcnt(0)" ::: "memory");
        } else {
            XB_SPIN(xb_ld(&bar[XB_XGEN(b.x)]) == gen, bar);
            __builtin_amdgcn_fence(__ATOMIC_ACQUIRE, "agent");
            asm volatile("s_waitcnt vmcnt(0)" ::: "memory");
        }
    }
    __syncthreads();
}

struct Args { const float* in[30]; float* out; unsigned char* ws; int ph_lo, ph_hi; };
enum { I_X = 0, I_MEM, I_REL, I_EV_WIN, I_EV_GAIN, I_EV_WUK, I_EV_WUV, I_EV_SINK, I_EV_WOUT, I_OD_WIN, I_OD_PEK, I_OD_W1K, I_OD_W2K, I_OD_PEV, I_OD_W1V, I_OD_W2V, I_OD_WOUT,
       I_XA_WQ, I_XA_WK, I_XA_WV, I_XA_WO, I_FF_G, I_FF_U, I_FF_D, I_MOE_R, I_MOE_G, I_MOE_U, I_MOE_D, I_LN_G, I_LN_B };

struct Frame {
    LAS unsigned char* lds;
    unsigned char* ws; float* acc;
    const float* const* in;
    int tid, lane, wave, G, gw, NGW;
};

__device__ __forceinline__ bool fresh(Frame& F, unsigned char*& ws, unsigned char* ws0, float* acc0) { int l = (int)__builtin_amdgcn_mbcnt_hi(~0u, __builtin_amdgcn_mbcnt_lo(~0u, 0u)); asm volatile("" : "+v"(l)); F.lane = l; F.tid = F.wave * 64 + l;
    ws = (unsigned char*)pg8::opaque_uniform(ws0); F.ws = ws; F.acc = (float*)pg8::opaque_uniform(acc0); return true; }
__device__ __forceinline__ bool probe_open(Frame& F, int k) { PROBE_WIN(k, 1u, F.tid); PROBE_START(1, F.tid); return true; }
__device__ __forceinline__ void probe_close(Frame& F, int k) { if (PROBE_SEL(k)) { PROBE_STOP(1, F.tid); } PROBE_WIN(k, 0u, F.tid); }
__device__ __forceinline__ void tconv_item(const float* W, int ldw, int ncols, bf16* WT, int ldt, int grp, int gstride, LAS float* scr, int kb, int nb, int lane) {
    const int k0 = 64 * kb, n0 = 32 * nb;
    const int kr = lane >> 3, n4 = (lane & 7) * 4;
    f32x4 v[8];
#pragma unroll
    for (int i = 0; i < 8; ++i) v[i] = (n0 + n4 < ncols) ? *(const f32x4*)(W + (size_t)(k0 + 8 * i + kr) * ldw + n0 + n4) : (f32x4){0.f, 0.f, 0.f, 0.f};
#pragma unroll
    for (int i = 0; i < 8; ++i) { LAS float* d = scr + (8 * i + kr) * 33 + n4; d[0] = v[i].x; d[1] = v[i].y; d[2] = v[i].z; d[3] = v[i].w; }
    LDS_WAIT();
    const int c = lane & 7;
#pragma unroll
    for (int j = 0; j < 4; ++j) { const int nn = (lane >> 3) + 8 * j, n = n0 + nn; const LAS float* s = scr + (8 * c) * 33 + nn;
        v4u o; o.x = pk2(s[0 * 33], s[1 * 33]); o.y = pk2(s[2 * 33], s[3 * 33]); o.z = pk2(s[4 * 33], s[5 * 33]); o.w = pk2(s[6 * 33], s[7 * 33]);
        const int row = (n / grp) * gstride + (n % grp);
        *(v4u*)(WT + (size_t)row * ldt + k0 + 8 * c) = o; }
    LDS_WAIT();
}
__device__ __forceinline__ void tconv(const Frame& F, int& rot, const float* W, int ldw, int K, int ncols, int npad, bf16* WT, int ldt, int grp, int gstride) {
    LAS float* scr = (LAS float*)(F.lds + F.wave * 16384);
    const int nkb = K / 64, nnb = npad / 32, n = nkb * nnb;
    const int first = (F.gw - rot + F.NGW) % F.NGW; rot = (rot + n) % F.NGW;
    for (int it = first; it < n; it += F.NGW) tconv_item(W, ldw, ncols, WT, ldt, grp, gstride, scr, it / nnb, it % nnb, F.lane);
}
constexpr int NOGRP = 1 << 30;

__device__ __forceinline__ void prologue(const Frame& F) {
    unsigned char* ws = F.ws; int rot = 0;
    const int gt = F.gw * 64 + F.lane, NT = F.NGW * 64;
    bf16* win0 = (bf16*)(ws + W_IN0);
    const float* evw = F.in[I_EV_WIN];
    tconv(F, rot, evw + 512, EVEN_COLS, 1024, 128, 128, win0 + (size_t)C0_CKV * 1024, 1024, NOGRP, 0);
    tconv(F, rot, evw + 640, EVEN_COLS, 1024, 512, 512, win0 + (size_t)C0_QI * 1024, 1024, NOGRP, 0);
    tconv(F, rot, evw + 1152, EVEN_COLS, 1024, 64, 64, win0 + (size_t)C0_KI * 1024, 1024, NOGRP, 0);
    tconv(F, rot, evw + 1216, EVEN_COLS, 1024, 8, 64, win0 + (size_t)C0_WI * 1024, 1024, NOGRP, 0);
    tconv(F, rot, evw + 1224, EVEN_COLS, 1024, 512, 512, win0 + (size_t)C0_QB * 1024, 1024, NOGRP, 0);
    tconv(F, rot, evw + 1736, EVEN_COLS, 1024, 128, 128, win0 + (size_t)C0_KB * 1024, 1024, NOGRP, 0);
    tconv(F, rot, evw + 1864, EVEN_COLS, 1024, 128, 128, win0 + (size_t)C0_VB * 1024, 1024, NOGRP, 0);
    bf16* wout0 = (bf16*)(ws + W_OUT0);
    const float* evo = F.in[I_EV_WOUT];
    tconv(F, rot, evo + (size_t)512 * 1024, 1024, 512, 1024, 1024, wout0 + 1024, 1536, NOGRP, 0);
    tconv(F, rot, F.in[I_OD_WIN], ODD_COLS, 1024, ODD_COLS, 2048, (bf16*)(ws + W_IN1), 1024, NOGRP, 0);
    tconv(F, rot, F.in[I_OD_WOUT], 1024, 1024, 1024, 1024, (bf16*)(ws + W_OUT1), 1024, NOGRP, 0);
    for (int i = 0; i < 2; ++i) {
        tconv(F, rot, F.in[I_XA_WQ] + (size_t)i * 1024 * 512, 512, 1024, 512, 512, (bf16*)(ws + W_XQ) + (size_t)i * 512 * 1024, 1024, NOGRP, 0);
        tconv(F, rot, F.in[I_XA_WK] + (size_t)i * 1024 * 512, 512, 1024, 512, 512, (bf16*)(ws + W_XKV) + (size_t)i * 1024 * 1024, 1024, NOGRP, 0);
        tconv(F, rot, F.in[I_XA_WV] + (size_t)i * 1024 * 512, 512, 1024, 512, 512, (bf16*)(ws + W_XKV) + (size_t)i * 1024 * 1024 + (size_t)512 * 1024, 1024, NOGRP, 0);
        tconv(F, rot, F.in[I_XA_WO] + (size_t)i * 512 * 1024, 1024, 512, 1024, 1024, (bf16*)(ws + W_XO) + (size_t)i * 1024 * 512, 512, NOGRP, 0);
    }
    tconv(F, rot, F.in[I_FF_G], DFF, 1024, DFF, DFF, (bf16*)(ws + W_FGU), 1024, 128, 256);
    tconv(F, rot, F.in[I_FF_U], DFF, 1024, DFF, DFF, (bf16*)(ws + W_FGU) + (size_t)128 * 1024, 1024, 128, 256);
    tconv(F, rot, F.in[I_FF_D], 1024, DFF, 1024, 1024, (bf16*)(ws + W_FD), DFF, NOGRP, 0);
    for (int e = 0; e < NE; ++e) {
        tconv(F, rot, F.in[I_MOE_G] + (size_t)e * 1024 * DFFE, DFFE, 1024, DFFE, DFFE, (bf16*)(ws + W_MGU) + (size_t)e * 7168 * 1024, 1024, 128, 256);
        tconv(F, rot, F.in[I_MOE_U] + (size_t)e * 1024 * DFFE, DFFE, 1024, DFFE, DFFE, (bf16*)(ws + W_MGU) + (size_t)e * 7168 * 1024 + (size_t)128 * 1024, 1024, 128, 256);
        tconv(F, rot, F.in[I_MOE_D] + (size_t)e * DFFE * 1024, 1024, DFFE, 1024, 1024, (bf16*)(ws + W_MD) + (size_t)e * 1024 * DFFE, DFFE, NOGRP, 0);
    }
    __syncthreads();
    {
        const float* wuk = F.in[I_EV_WUK]; const float* wuv = F.in[I_EV_WUV];
        LAS float* As = (LAS float*)F.lds; LAS float* Bs = As + 128 * 65;
        for (int item = blockIdx.x; item < 256; item += F.G) {
            const int h = (item >> 4) & 7, tt = item & 15;
            if (item < 128) {
                const int k0 = 64 * tt;
                for (int i = F.tid; i < 4096; i += 512) { const int kk = i >> 6, d = i & 63; As[kk * 65 + d] = evw[(size_t)(k0 + kk) * EVEN_COLS + h * 64 + d]; }
                for (int i = F.tid; i < 8192; i += 512) Bs[i] = wuk[(size_t)h * 8192 + i];
                __syncthreads();
                const int kk = F.tid & 63, cg = F.tid >> 6; float acc[16];
#pragma unroll
                for (int j = 0; j < 16; ++j) acc[j] = 0.f;
#pragma unroll 4
                for (int d = 0; d < 64; ++d) { const float a = As[kk * 65 + d];
#pragma unroll
                    for (int j = 0; j < 16; ++j) acc[j] += a * Bs[d * 128 + cg * 16 + j]; }
#pragma unroll
                for (int j = 0; j < 16; ++j) win0[(size_t)(C0_QLAT + h * 128 + cg * 16 + j) * 1024 + k0 + kk] = (bf16)f2bf(acc[j]);
            } else {
                const int n0 = 64 * tt;
                for (int i = F.tid; i < 8192; i += 512) { const int c = i >> 6, d = i & 63; As[c * 65 + d] = wuv[(size_t)h * 8192 + i]; }
                for (int i = F.tid; i < 4096; i += 512) { const int d = i >> 6, nn = i & 63; Bs[i] = evo[(size_t)(h * 64 + d) * 1024 + n0 + nn]; }
                __syncthreads();
                const int c = F.tid & 127, ng = F.tid >> 7; float acc[16];
#pragma unroll
                for (int j = 0; j < 16; ++j) acc[j] = 0.f;
#pragma unroll 4
                for (int d = 0; d < 64; ++d) { const float a = As[c * 65 + d];
#pragma unroll
                    for (int j = 0; j < 16; ++j) acc[j] += a * Bs[d * 64 + ng * 16 + j]; }
#pragma unroll
                for (int j = 0; j < 16; ++j) wout0[(size_t)(n0 + ng * 16 + j) * 1536 + h * 128 + c] = (bf16)f2bf(acc[j]);
            }
            __syncthreads();
        }
    }
    {
        const f32x4* x4 = (const f32x4*)F.in[I_X]; v2u* hb = (v2u*)(ws + WS_HB);
        for (int i = gt; i < M * D / 4; i += 4 * NT) { f32x4 v[4];
#pragma unroll
            for (int j = 0; j < 4; ++j) v[j] = x4[i + j * NT];
#pragma unroll
            for (int j = 0; j < 4; ++j) { v2u o; o.x = pk2(v[j].x, v[j].y); o.y = pk2(v[j].z, v[j].w); hb[i + j * NT] = o; } }
        const f32x4* m4 = (const f32x4*)F.in[I_MEM]; v2u* mb = (v2u*)(ws + WS_MEMB);
        for (int i = gt; i < MMEM * D / 4; i += 4 * NT) { f32x4 v[4];
#pragma unroll
            for (int j = 0; j < 4; ++j) v[j] = m4[i + j * NT];
#pragma unroll
            for (int j = 0; j < 4; ++j) { v2u o; o.x = pk2(v[j].x, v[j].y); o.y = pk2(v[j].z, v[j].w); mb[i + j * NT] = o; } }
    }
}

template <int MODE>
__device__ __forceinline__ void ln_phase(const Frame& F, int li, const bf16* sumb, int gw0_ = 0, int ngw_ = 1, int thr = 0x7fffffff) {
    const int GW0 = MODE == 2 ? gw0_ : F.gw, NGWE = MODE == 2 ? ngw_ : F.NGW;
    const float* g = F.in[I_LN_G] + (size_t)li * D; const float* bb = F.in[I_LN_B] + (size_t)li * D;
    LAS int* lcnt = (LAS int*)F.lds;
    if (MODE == 1) { if (F.tid < 16) lcnt[F.tid] = 0; __syncthreads(); }
    f32x4 rw[MODE == 1 ? 32 : 1];
    if (MODE == 1) { const float* wr = F.in[I_MOE_R];
#pragma unroll
        for (int j = 0; j < 4; ++j)
#pragma unroll
            for (int i = 0; i < 4; ++i) { const int c = 4 * (F.lane + 64 * j) + i; rw[(4 * j + i) * 2] = *(const f32x4*)(wr + (size_t)c * 8); rw[(4 * j + i) * 2 + 1] = *(const f32x4*)(wr + (size_t)c * 8 + 4); } }
    f32x4 gv[4], bv[4];
#pragma unroll
    for (int j = 0; j < 4; ++j) { gv[j] = ((const f32x4*)g)[F.lane + 64 * j]; bv[j] = ((const f32x4*)bb)[F.lane + 64 * j]; }
    const int* rtep = (const int*)(F.ws + WS_RTE); const float* rtwp = (const float*)(F.ws + WS_RTW);
    v2u ca[4], cy0[4], cy1[4]; float cw0 = 0.f, cw1 = 0.f; int np0 = 0, np1 = 0; float nw0 = 0.f, nw1 = 0.f;
#define LN_LOADROW(RA, RY0, RY1, rowv, p0v, p1v) do { \
        if (MODE == 2) { const v2u* hp_ = (const v2u*)(F.ws + WS_HB + (size_t)(rowv) * D * 2) + F.lane; const v2u* y0_ = (const v2u*)(F.ws + WS_PERMA + (size_t)(p0v) * D * 2) + F.lane; const v2u* y1_ = (const v2u*)(F.ws + WS_PERMA + (size_t)(p1v) * D * 2) + F.lane; \
            _Pragma("unroll") for (int j = 0; j < 4; ++j) { RA[j] = hp_[64 * j]; RY0[j] = y0_[64 * j]; RY1[j] = y1_[64 * j]; } } \
        else { const v2u* sp_ = (const v2u*)(sumb + (size_t)(rowv) * D) + F.lane; _Pragma("unroll") for (int j = 0; j < 4; ++j) RA[j] = sp_[64 * j]; } } while (0)
    bool crdy = true, nrdy = true;
#define LN_RDY(p0v, p1v) (MODE != 2 || ((p0v) > (p1v) ? (p0v) : (p1v)) < thr)
    if (GW0 < M) {
        if (MODE == 2) { np0 = rtep[2 * GW0]; np1 = rtep[2 * GW0 + 1]; cw0 = rtwp[2 * GW0]; cw1 = rtwp[2 * GW0 + 1]; crdy = LN_RDY(np0, np1); if (!crdy) { np0 = 0; np1 = 0; } }
        LN_LOADROW(ca, cy0, cy1, GW0, np0, np1);
        if (MODE == 2 && GW0 + NGWE < M) { np0 = rtep[2 * (GW0 + NGWE)]; np1 = rtep[2 * (GW0 + NGWE) + 1]; nw0 = rtwp[2 * (GW0 + NGWE)]; nw1 = rtwp[2 * (GW0 + NGWE) + 1]; }
    }
    for (int row = GW0; row < M; row += NGWE) {
        f32x4* p = (f32x4*)(F.acc + (size_t)row * D) + F.lane;
        const int rn = row + NGWE, rnn = rn + NGWE;
        v2u na[4], ny0[4], ny1[4]; float fw0 = 0.f, fw1 = 0.f; int fp0 = 0, fp1 = 0;
        if (rn < M) { nrdy = LN_RDY(np0, np1); if (!nrdy) { np0 = 0; np1 = 0; } LN_LOADROW(na, ny0, ny1, rn, np0, np1); }
        if (MODE == 2 && rnn < M) { fp0 = rtep[2 * rnn]; fp1 = rtep[2 * rnn + 1]; fw0 = rtwp[2 * rnn]; fw1 = rtwp[2 * rnn + 1]; }
        const bool rdy = crdy; crdy = nrdy;
        f32x4 v[4]; float s = 0.f;
#pragma unroll
        for (int j = 0; j < 4; ++j) { const v2u a = ca[j]; v[j] = (f32x4){bflo(a.x), bfhi(a.x), bflo(a.y), bfhi(a.y)}; if (MODE == 2) v[j] = v[j] * ALPHA; }
        if (MODE == 2) {
#pragma unroll
            for (int j = 0; j < 4; ++j) { const v2u a = cy0[j], b = cy1[j];
                v[j].x += cw0 * bflo(a.x) + cw1 * bflo(b.x); v[j].y += cw0 * bfhi(a.x) + cw1 * bfhi(b.x); v[j].z += cw0 * bflo(a.y) + cw1 * bflo(b.y); v[j].w += cw0 * bfhi(a.y) + cw1 * bfhi(b.y); } }
#pragma unroll
        for (int j = 0; j < 4; ++j) { ca[j] = na[j]; cy0[j] = ny0[j]; cy1[j] = ny1[j]; }
        cw0 = nw0; cw1 = nw1; nw0 = fw0; nw1 = fw1; np0 = fp0; np1 = fp1;
#pragma unroll
        for (int j = 0; j < 4; ++j) s += (v[j].x + v[j].y) + (v[j].z + v[j].w);
        const float mean = wave_sum_fast(s) * (1.f / D); float s2 = 0.f;
#pragma unroll
        for (int j = 0; j < 4; ++j) { v[j] = v[j] - mean; s2 += (v[j].x * v[j].x + v[j].y * v[j].y) + (v[j].z * v[j].z + v[j].w * v[j].w); }
        const float rstd = 1.f / sqrtf(wave_sum_fast(s2) * (1.f / D) + LN_EPS);
#pragma unroll
        for (int j = 0; j < 4; ++j) v[j] = v[j] * rstd * gv[j] + bv[j];
        if (MODE == 2) {
            if (rdy) {
#pragma unroll
                for (int j = 0; j < 4; ++j) p[64 * j] = v[j]; }
        } else {
            v2u* hb = (v2u*)(F.ws + WS_HB + (size_t)row * D * 2) + F.lane;
#pragma unroll
            for (int j = 0; j < 4; ++j) { v2u o; o.x = pk2(v[j].x, v[j].y); o.y = pk2(v[j].z, v[j].w); hb[64 * j] = o; }
        }
        if (MODE == 1) {
            float lg[8];
#pragma unroll
            for (int e = 0; e < 8; ++e) lg[e] = 0.f;
#pragma unroll
            for (int j = 0; j < 4; ++j)
#pragma unroll
                for (int i = 0; i < 4; ++i) { const f32x4 w0 = rw[(4 * j + i) * 2], w1 = rw[(4 * j + i) * 2 + 1]; const float y = v[j][i];
                    lg[0] += y * w0.x; lg[1] += y * w0.y; lg[2] += y * w0.z; lg[3] += y * w0.w; lg[4] += y * w1.x; lg[5] += y * w1.y; lg[6] += y * w1.z; lg[7] += y * w1.w; }
#pragma unroll
            for (int e = 0; e < 8; ++e) lg[e] = wave_sum_fast(lg[e]);
            int e0 = 0; float v0 = lg[0];
#pragma unroll
            for (int e = 1; e < 8; ++e) if (lg[e] > v0) { v0 = lg[e]; e0 = e; }
            int e1 = -1; float v1 = -3.0e38f;
#pragma unroll
            for (int e = 0; e < 8; ++e) if (e != e0 && lg[e] > v1) { v1 = lg[e]; e1 = e; }
            const float w0 = 1.f / (1.f + __expf(v1 - v0)), w1 = 1.f - w0;
            if (F.lane == 0) { int* rte = (int*)(F.ws + WS_RTE); float* rtw = (float*)(F.ws + WS_RTW); rte[2 * row] = e0; rte[2 * row + 1] = e1; rtw[2 * row] = w0; rtw[2 * row + 1] = w1;
                __hip_atomic_fetch_add(&lcnt[e0], 1, __ATOMIC_RELAXED, __HIP_MEMORY_SCOPE_WORKGROUP); __hip_atomic_fetch_add(&lcnt[8 + e1], 1, __ATOMIC_RELAXED, __HIP_MEMORY_SCOPE_WORKGROUP); }
        }
    }
    if (MODE == 1) { __syncthreads(); if (F.tid < 16) { const int c = lcnt[F.tid]; if (c) atomicAdd((unsigned*)(F.ws + WS_CTL) + CW_CNT + F.tid, (unsigned)c); } }
}

#undef LN_LOADROW
#undef LN_RDY
__device__ __forceinline__ void ln_final_rest(const Frame& F, int thr) {
    const float* g = F.in[I_LN_G] + (size_t)5 * D; const float* bb = F.in[I_LN_B] + (size_t)5 * D;
    const int* rtep = (const int*)(F.ws + WS_RTE); const float* rtwp = (const float*)(F.ws + WS_RTW);
    for (int base = F.gw; base < M; base += 64 * F.NGW) {
        const int r = base + F.lane * F.NGW; int p0 = 0, p1 = 0;
        if (r < M) { p0 = rtep[2 * r]; p1 = rtep[2 * r + 1]; }
        unsigned long long mask = __ballot(r < M && (p0 > p1 ? p0 : p1) >= thr);
        while (mask) {
            const int k = __builtin_ctzll(mask); mask &= mask - 1;
            const int row = base + k * F.NGW, q0 = __builtin_amdgcn_readlane(p0, k), q1 = __builtin_amdgcn_readlane(p1, k);
            const float w0 = rtwp[2 * row], w1 = rtwp[2 * row + 1];
            const v2u* hp = (const v2u*)(F.ws + WS_HB + (size_t)row * D * 2) + F.lane; const v2u* y0 = (const v2u*)(F.ws + WS_PERMA + (size_t)q0 * D * 2) + F.lane; const v2u* y1 = (const v2u*)(F.ws + WS_PERMA + (size_t)q1 * D * 2) + F.lane;
            const float w0b = q0 >= thr ? w0 : 0.f, w1b = q1 >= thr ? w1 : 0.f;
            const v2u* z0 = (const v2u*)(F.ws + WS_YB + (size_t)(q0 >= thr ? q0 - thr : 0) * D * 2) + F.lane; const v2u* z1 = (const v2u*)(F.ws + WS_YB + (size_t)(q1 >= thr ? q1 - thr : 0) * D * 2) + F.lane;
            f32x4 v[4]; float s = 0.f;
#pragma unroll
            for (int j = 0; j < 4; ++j) { const v2u h = hp[64 * j], a = y0[64 * j], b = y1[64 * j], a2 = z0[64 * j], b2 = z1[64 * j];
                v[j] = (f32x4){bflo(h.x), bfhi(h.x), bflo(h.y), bfhi(h.y)} * ALPHA;
                v[j].x += w0 * bflo(a.x) + w1 * bflo(b.x); v[j].y += w0 * bfhi(a.x) + w1 * bfhi(b.x); v[j].z += w0 * bflo(a.y) + w1 * bflo(b.y); v[j].w += w0 * bfhi(a.y) + w1 * bfhi(b.y);
                v[j].x += w0b * bflo(a2.x) + w1b * bflo(b2.x); v[j].y += w0b * bfhi(a2.x) + w1b * bfhi(b2.x); v[j].z += w0b * bflo(a2.y) + w1b * bflo(b2.y); v[j].w += w0b * bfhi(a2.y) + w1b * bfhi(b2.y);
                s += (v[j].x + v[j].y) + (v[j].z + v[j].w); }
            const float mean = wave_sum_fast(s) * (1.f / D); float s2 = 0.f;
#pragma unroll
            for (int j = 0; j < 4; ++j) { v[j] = v[j] - mean; s2 += (v[j].x * v[j].x + v[j].y * v[j].y) + (v[j].z * v[j].z + v[j].w * v[j].w); }
            const float rstd = 1.f / sqrtf(wave_sum_fast(s2) * (1.f / D) + LN_EPS);
            f32x4* p = (f32x4*)(F.acc + (size_t)row * D) + F.lane;
#pragma unroll
            for (int j = 0; j < 4; ++j) p[64 * j] = v[j] * rstd * ((const f32x4*)g)[F.lane + 64 * j] + ((const f32x4*)bb)[F.lane + 64 * j];
        }
    }
}
__device__ __forceinline__ void moe_dispatch(const Frame& F) {
    unsigned* ctl = (unsigned*)(F.ws + WS_CTL);
    int* tile_exp = (int*)(F.ws + WS_TILEEXP); int* rowtok = (int*)(F.ws + WS_ROWTOK); float* roww = (float*)(F.ws + WS_ROWW);
    LAS int* seg = (LAS int*)F.lds;
    if (F.tid == 0) { int run = 0;
#pragma unroll 1
        for (int sgi = 0; sgi < 16; ++sgi) { if ((sgi & 7) == 0) seg[32 + (sgi >> 3)] = run >> 8; seg[sgi] = run; const int c = (int)__hip_atomic_load(ctl + CW_CNT + sgi, __ATOMIC_RELAXED, __HIP_MEMORY_SCOPE_AGENT); seg[16 + sgi] = c; run += (c + 255) & ~255; }
        seg[34] = run >> 8; }
    __syncthreads();
    if (blockIdx.x == 0) {
#pragma unroll 1
        for (int sgi = 0; sgi < 16; ++sgi) { const int c = seg[16 + sgi], st = seg[sgi], en = st + ((c + 255) & ~255);
            for (int t = (st >> 8) + F.tid; t < (en >> 8); t += 512) tile_exp[t] = sgi & 7;
            for (int r = st + c + F.tid; r < en; r += 512) { rowtok[r] = -1; roww[r] = 0.f; } }
        if (F.tid < 3) tile_exp[512 + F.tid] = seg[32 + F.tid];
    }
    const int* rte = (const int*)(F.ws + WS_RTE); const float* rtw = (const float*)(F.ws + WS_RTW);
    LAS int* lcnt = seg + 64; LAS int* gb = seg + 96; LAS int* posl = seg + 128;
    for (int chunk = blockIdx.x; chunk < M / 128; chunk += F.G) {
        if (F.tid < 16) lcnt[F.tid] = 0;
        __syncthreads();
        const int tok = chunk * 128 + (F.tid & 127); int e0 = 0, e1 = 0, r0 = 0, r1 = 0;
        if (F.tid < 128) { e0 = rte[2 * tok]; e1 = rte[2 * tok + 1]; r0 = __hip_atomic_fetch_add(&lcnt[e0], 1, __ATOMIC_RELAXED, __HIP_MEMORY_SCOPE_WORKGROUP); r1 = __hip_atomic_fetch_add(&lcnt[8 + e1], 1, __ATOMIC_RELAXED, __HIP_MEMORY_SCOPE_WORKGROUP); }
        __syncthreads();
        if (F.tid < 16) { const int c = lcnt[F.tid]; gb[F.tid] = c ? (int)atomicAdd(ctl + CW_CUR + F.tid, (unsigned)c) : 0; }
        __syncthreads();
        if (F.tid < 128) { const int p0 = seg[e0] + gb[e0] + r0, p1 = seg[8 + e1] + gb[8 + e1] + r1; posl[2 * F.tid] = p0; posl[2 * F.tid + 1] = p1;
            ((int*)(F.ws + WS_RTE))[2 * tok] = p0; ((int*)(F.ws + WS_RTE))[2 * tok + 1] = p1; }
        __syncthreads();
#pragma unroll 1
        for (int i0 = 0; i0 < 16; i0 += 8) {
            v4u a[8], b[8];
#pragma unroll
            for (int k = 0; k < 8; ++k) { const v4u* src = (const v4u*)(F.ws + WS_HB + (size_t)(chunk * 128 + F.wave * 16 + i0 + k) * D * 2); a[k] = src[F.lane]; b[k] = src[F.lane + 64]; }
#pragma unroll
            for (int k = 0; k < 8; ++k) { const int p0 = posl[2 * (F.wave * 16 + i0 + k)], p1 = posl[2 * (F.wave * 16 + i0 + k) + 1];
                v4u* d0 = (v4u*)(F.ws + WS_PERMA + (size_t)p0 * D * 2); v4u* d1 = (v4u*)(F.ws + WS_PERMA + (size_t)p1 * D * 2);
                d0[F.lane] = a[k]; d0[F.lane + 64] = b[k]; d1[F.lane] = a[k]; d1[F.lane + 64] = b[k]; } }
        __syncthreads();
    }
    __syncthreads();
}

__device__ __forceinline__ void cn_phase(const Frame& F) {
    const bf16* P0 = (const bf16*)(F.ws + WS_P0); bf16* CN = (bf16*)(F.ws + WS_CN); const float* gain = F.in[I_EV_GAIN];
    const float g0 = gain[2 * F.lane], g1 = gain[2 * F.lane + 1];
    for (int row0 = F.gw * 8; row0 < M; row0 += F.NGW * 8) {
        unsigned w[8];
#pragma unroll
        for (int i = 0; i < 8; ++i) w[i] = *(const unsigned*)(P0 + (size_t)(row0 + i) * P0_LD + C0_CKV + 2 * F.lane);
#pragma unroll
        for (int i = 0; i < 8; ++i) { const float a = bflo(w[i]), b = bfhi(w[i]);
            const float ms = wave_sum_fast(a * a + b * b) * (1.f / 128.f); const float r = 1.f / sqrtf(ms + LN_EPS);
            *(unsigned*)(CN + (size_t)(row0 + i) * 128 + 2 * F.lane) = pk2(a * r * g0, b * r * g1); }
    }
}

__device__ __forceinline__ unsigned fkey(float x) { unsigned b = __builtin_bit_cast(unsigned, x); if (b == 0x80000000u) b = 0u; return (b & 0x80000000u) ? ~b : (b | 0x80000000u); }
__device__ __forceinline__ void idx_phase(const Frame& F) {
    const bf16* P0 = (const bf16*)(F.ws + WS_P0); unsigned* MASK = (unsigned*)(F.ws + WS_MASK);
    LAS float* qi_s = (LAS float*)F.lds; LAS float* wi_s = qi_s + 4096; LAS float* sc = wi_s + 64;
    for (int item = blockIdx.x; item < NB * (S / 8); item += F.G) {
        const int b = item / (S / 8), t0 = (item % (S / 8)) * 8;
        for (int i = F.tid; i < 4096; i += 512) { const int q = i >> 9, e = i & 511; qi_s[i] = bf2f(P0[(size_t)(b * S + t0 + q) * P0_LD + C0_QI + e]); }
        if (F.tid < 64) { const int q = F.tid >> 3, h = F.tid & 7; wi_s[F.tid] = bf2f(P0[(size_t)(b * S + t0 + q) * P0_LD + C0_WI + h]) * (0.35355339059f * 0.125f); }
        __syncthreads();
        const int nk = t0 + 8;
        for (int s = F.tid; s < nk; s += 512) {
            float kf[64]; const bf16* kr = P0 + (size_t)(b * S + s) * P0_LD + C0_KI;
#pragma unroll
            for (int j = 0; j < 8; ++j) ld8bf(kr + 8 * j, kf + 8 * j);
#pragma unroll 1
            for (int q = 0; q < 8; ++q) { float a = 0.f;
#pragma unroll 1
                for (int h = 0; h < 8; ++h) { const LAS float* qp = qi_s + q * 512 + h * 64; float dot = 0.f;
#pragma unroll
                    for (int d = 0; d < 64; ++d) dot += qp[d] * kf[d];
                    a += wi_s[q * 8 + h] * fmaxf(dot, 0.f); }
                sc[q * 2048 + s] = a; }
        }
        __syncthreads();
        {
            const int q = F.wave, t = t0 + q, n = t + 1, row = b * S + t; unsigned myword = 0u;
            if (n <= 256) { const int cb = n - 32 * F.lane; myword = cb >= 32 ? 0xffffffffu : (cb <= 0 ? 0u : ((1u << cb) - 1u)); }
            else {
                LAS unsigned* uk = (LAS unsigned*)(sc + q * 2048);
#pragma unroll 4
                for (int i = 0; i < 32; ++i) { const int s = F.lane + 64 * i; const unsigned k = (s < n) ? fkey(sc[q * 2048 + s]) : 0u; uk[s] = k; }
                LDS_WAIT();
                unsigned prefix = 0u;
#pragma unroll 1
                for (int bit = 31; bit >= 0; --bit) { const unsigned cand = prefix | (1u << bit); int c = 0;
#pragma unroll 8
                    for (int i = 0; i < 32; ++i) c += (uk[F.lane + 64 * i] >= cand) ? 1 : 0;
#pragma unroll
                    for (int o = 1; o < 64; o <<= 1) c += __shfl_xor(c, o);
                    if (c >= 256) prefix = cand; }
                int cgt = 0;
#pragma unroll 8
                for (int i = 0; i < 32; ++i) cgt += (uk[F.lane + 64 * i] > prefix) ? 1 : 0;
#pragma unroll
                for (int o = 1; o < 64; o <<= 1) cgt += __shfl_xor(cgt, o);
                const int need = 256 - cgt; int run = 0;
#pragma unroll 1
                for (int i = 0; i < 32; ++i) { const unsigned u = uk[F.lane + 64 * i]; const bool eq = (u == prefix); const unsigned long long em = __ballot(eq); const int rank = run + __popcll(em & ((1ull << F.lane) - 1ull));
                    const bool sel = (u > prefix) || (eq && rank < need); run += __popcll(em);
                    const unsigned long long sm = __ballot(sel);
                    if (F.lane == 2 * i) myword = (unsigned)sm; if (F.lane == 2 * i + 1) myword = (unsigned)(sm >> 32); }
            }
            MASK[(size_t)row * 64 + F.lane] = myword;
        }
        __syncthreads();
    }
}

__device__ __forceinline__ void dsa_phase(const Frame& F) {
    bf16* P0 = (bf16*)(F.ws + WS_P0); const bf16* CN = (const bf16*)(F.ws + WS_CN); const unsigned* MASK = (const unsigned*)(F.ws + WS_MASK); const float* rel = F.in[I_REL];
    LAS float* ql = (LAS float*)(F.lds + F.wave * 13312); LAS float* pl = ql + 1024; LAS int* idx = (LAS int*)(pl + 2048);
    for (int row = F.gw; row < M; row += F.NGW) {
        const int b = row / S, t = row % S;
        const unsigned w = MASK[(size_t)row * 64 + F.lane]; const int c = __popc(w);
        int incl = c;
#pragma unroll
        for (int o = 1; o < 64; o <<= 1) { const int v = __shfl_up(incl, o); if (F.lane >= o) incl += v; }
        const int total = __shfl(incl, 63); int pos = incl - c; unsigned ww = w;
        while (ww) { const int bit = __ffs(ww) - 1; idx[pos++] = 32 * F.lane + bit; ww &= ww - 1u; }
#pragma unroll
        for (int i = 0; i < 16; ++i) ql[F.lane + 64 * i] = bf2f(P0[(size_t)row * P0_LD + C0_QLAT + F.lane + 64 * i]);
        WAVE_SYNC();
        float lg[4][8]; bool val[4];
#pragma unroll
        for (int kk = 0; kk < 4; ++kk) { const int k = F.lane + 64 * kk; val[kk] = k < total; const int key = val[kk] ? idx[k] : 0;
            float a[8];
#pragma unroll
            for (int h = 0; h < 8; ++h) a[h] = 0.f;
            const bf16* cr = CN + (size_t)(b * S + key) * 128;
#pragma unroll 1
            for (int j = 0; j < 16; ++j) { float cv[8]; ld8bf(cr + 8 * j, cv);
#pragma unroll
                for (int h = 0; h < 8; ++h)
#pragma unroll
                    for (int i = 0; i < 8; ++i) a[h] += ql[h * 128 + 8 * j + i] * cv[i]; }
            const int bk = rel_bucket(t - key);
#pragma unroll
            for (int h = 0; h < 8; ++h) lg[kk][h] = val[kk] ? (a[h] * 0.125f + rel[bk * 16 + h]) : -1.0e30f;
        }
#pragma unroll
        for (int h = 0; h < 8; ++h) { float m = fmaxf(fmaxf(lg[0][h], lg[1][h]), fmaxf(lg[2][h], lg[3][h])); m = wave_max(m);
            float e[4], s = 0.f;
#pragma unroll
            for (int kk = 0; kk < 4; ++kk) { e[kk] = val[kk] ? __expf(lg[kk][h] - m) : 0.f; s += e[kk]; }
            s = wave_sum(s); const float inv = 1.f / s;
#pragma unroll
            for (int kk = 0; kk < 4; ++kk) pl[h * 256 + F.lane + 64 * kk] = e[kk] * inv; }
        WAVE_SYNC();
        float a0[8], a1[8];
#pragma unroll
        for (int h = 0; h < 8; ++h) { a0[h] = 0.f; a1[h] = 0.f; }
        for (int k = 0; k < total; ++k) { const int key = idx[k]; const unsigned pr = *(const unsigned*)(CN + (size_t)(b * S + key) * 128 + 2 * F.lane); const float vx = bflo(pr), vy = bfhi(pr);
#pragma unroll
            for (int h = 0; h < 8; ++h) { const float p = pl[h * 256 + k]; a0[h] += p * vx; a1[h] += p * vy; } }
#pragma unroll
        for (int h = 0; h < 8; ++h) *(unsigned*)(P0 + (size_t)row * P0_LD + C0_QLAT + h * 128 + 2 * F.lane) = pk2(a0[h], a1[h]);
        WAVE_SYNC();
    }
}

template <int W, int NH, int GRPSZ, bool SINK, bool NSA>
__device__ __forceinline__ void banded_phase(const Frame& F, bf16* P, int ld, int cq, int ck, int cv, int relc0) {
    const float* rel = F.in[I_REL]; const float* sinks = F.in[I_EV_SINK];
    const bf16* OC = (const bf16*)(F.ws + WS_OCMP); const bf16* OS = (const bf16*)(F.ws + WS_OSLC);
    constexpr int NTG = S / 64;
    for (int it = F.gw; it < NB * NH * NTG; it += F.NGW) {
        const int tg = it % NTG, h = (it / NTG) % NH, b = it / (NTG * NH);
        const int t = tg * 64 + F.lane, row = b * S + t, kvh = h / GRPSZ;
        float q[64], acc[64];
        { const bf16* qr = P + (size_t)row * ld + cq + h * 64;
#pragma unroll
          for (int j = 0; j < 8; ++j) ld8bf(qr + 8 * j, q + 8 * j); }
#pragma unroll
        for (int d = 0; d < 64; ++d) acc[d] = 0.f;
        float m = SINK ? sinks[h] : -1.0e30f, l = SINK ? 1.f : 0.f;
#pragma unroll 1
        for (int j = 0; j < W; ++j) { const int s = t - j;
            const float bias = rel[rel_bucket(j) * 16 + relc0 + h];
            if (s >= 0) { const bf16* kr = P + (size_t)(b * S + s) * ld + ck + kvh * 64; float dot = 0.f;
#pragma unroll
                for (int jj = 0; jj < 8; ++jj) { float kf[8]; ld8bf(kr + 8 * jj, kf);
#pragma unroll
                    for (int i = 0; i < 8; ++i) dot += q[8 * jj + i] * kf[i]; }
                const float lgt = dot * 0.125f + bias, mn = fmaxf(m, lgt), corr = __expf(m - mn), p = __expf(lgt - mn);
                l = l * corr + p; m = mn;
                const bf16* vr = P + (size_t)(b * S + s) * ld + cv + kvh * 64;
#pragma unroll
                for (int jj = 0; jj < 8; ++jj) { float vf[8]; ld8bf(vr + 8 * jj, vf);
#pragma unroll
                    for (int i = 0; i < 8; ++i) acc[8 * jj + i] = acc[8 * jj + i] * corr + p * vf[i]; } } }
        const float inv = 1.f / l;
        float g0 = 0.f, g1 = 0.f, g2 = 1.f;
        if (NSA) { const bf16* gr = P + (size_t)row * ld + C1_GL + h * 3; g0 = 1.f / (1.f + __expf(-bf2f(gr[0]))); g1 = 1.f / (1.f + __expf(-bf2f(gr[1]))); g2 = 1.f / (1.f + __expf(-bf2f(gr[2]))); }
        bf16* orow = P + (size_t)row * ld + cq + h * 64;
#pragma unroll
        for (int jj = 0; jj < 8; ++jj) { float o[8];
#pragma unroll
            for (int i = 0; i < 8; ++i) o[i] = acc[8 * jj + i] * inv;
            if (NSA) { float c8[8], s8[8]; ld8bf(OC + (size_t)row * D + h * 64 + 8 * jj, c8); ld8bf(OS + (size_t)row * D + h * 64 + 8 * jj, s8);
#pragma unroll
                for (int i = 0; i < 8; ++i) o[i] = g0 * c8[i] + g1 * s8[i] + g2 * o[i]; }
            v4u w; w.x = pk2(o[0], o[1]); w.y = pk2(o[2], o[3]); w.z = pk2(o[4], o[5]); w.w = pk2(o[6], o[7]);
            *(v4u*)(orow + 8 * jj) = w; }
    }
}

__device__ __forceinline__ void xattn_phase(const Frame& F, const bf16* Q, const bf16* KV, bf16* O) {
    for (int it = F.gw; it < NB * 4 * (S / 32); it += F.NGW) {
        const int tg = it % (S / 32), h = (it / (S / 32)) % 4, b = it / ((S / 32) * 4);
        const int tok = tg * 32 + (F.lane >> 1), half = F.lane & 1, row = b * S + tok;
        float q[64], acc[64];
        { const bf16* qr = Q + (size_t)row * 512 + h * 128 + half * 64;
#pragma unroll
          for (int j = 0; j < 8; ++j) ld8bf(qr + 8 * j, q + 8 * j); }
#pragma unroll
        for (int d = 0; d < 64; ++d) acc[d] = 0.f;
        float m = -1.0e30f, l = 0.f;
#pragma unroll 1
        for (int mm = 0; mm < MEML; ++mm) { const bf16* kr = KV + (size_t)(b * MEML + mm) * 1024 + h * 128 + half * 64; float dot = 0.f;
#pragma unroll
            for (int jj = 0; jj < 8; ++jj) { float kf[8]; ld8bf(kr + 8 * jj, kf);
#pragma unroll
                for (int i = 0; i < 8; ++i) dot += q[8 * jj + i] * kf[i]; }
            dot += __shfl_xor(dot, 1);
            const float lgt = dot * 0.08838834764831845f, mn = fmaxf(m, lgt), corr = __expf(m - mn), p = __expf(lgt - mn);
            l = l * corr + p; m = mn;
            const bf16* vr = kr + 512;
#pragma unroll
            for (int jj = 0; jj < 8; ++jj) { float vf[8]; ld8bf(vr + 8 * jj, vf);
#pragma unroll
                for (int i = 0; i < 8; ++i) acc[8 * jj + i] = acc[8 * jj + i] * corr + p * vf[i]; } }
        const float inv = 1.f / l; bf16* orow = O + (size_t)row * 512 + h * 128 + half * 64;
#pragma unroll
        for (int jj = 0; jj < 8; ++jj) { v4u w; w.x = pk2(acc[8 * jj] * inv, acc[8 * jj + 1] * inv); w.y = pk2(acc[8 * jj + 2] * inv, acc[8 * jj + 3] * inv); w.z = pk2(acc[8 * jj + 4] * inv, acc[8 * jj + 5] * inv); w.w = pk2(acc[8 * jj + 6] * inv, acc[8 * jj + 7] * inv);
            *(v4u*)(orow + 8 * jj) = w; }
    }
}

__device__ __forceinline__ float gelu_tanh(float x) { const float u = 0.7978845608028654f * (x + 0.044715f * x * x * x); return 0.5f * x * (1.f + tanhf(u)); }
__device__ __forceinline__ void cmp_mlp_phase(const Frame& F) {
    const bf16* P1 = (const bf16*)(F.ws + WS_P1);
    LAS float* blk = (LAS float*)F.lds; LAS float* part = blk + 2048; LAS float* hid = part + 512;
    for (int item = blockIdx.x; item < 2 * NB * NCMP * 2; item += F.G) {
        const int g = item & 1, n = (item >> 1) % NCMP, b = ((item >> 1) / NCMP) % NB, which = (item >> 1) / (NCMP * NB);
        const float* pe = which ? F.in[I_OD_PEV] : F.in[I_OD_PEK]; const float* w1 = which ? F.in[I_OD_W1V] : F.in[I_OD_W1K]; const float* w2 = which ? F.in[I_OD_W2V] : F.in[I_OD_W2K];
        bf16* outp = (bf16*)(F.ws + (which ? WS_VC : WS_KC)) + ((size_t)(b * 2 + g) * 128 + n) * 64;
        const int col0 = (which ? C1_VC : C1_KC) + g * 64;
        for (int i = F.tid; i < 2048; i += 512) { const int l = i >> 6, d = i & 63; blk[i] = bf2f(P1[(size_t)(b * S + 16 * n + l) * P1_LD + col0 + d]) + pe[i]; }
        __syncthreads();
        { const int j = F.tid & 127, pp = F.tid >> 7; float a = 0.f; const float* wp = w1 + (size_t)(pp * 512) * 128 + j; const LAS float* bp = blk + pp * 512;
#pragma unroll 8
          for (int kk = 0; kk < 512; ++kk) a += bp[kk] * wp[(size_t)kk * 128];
          part[F.tid] = a; }
        __syncthreads();
        if (F.tid < 128) hid[F.tid] = gelu_tanh((part[F.tid] + part[F.tid + 128]) + (part[F.tid + 256] + part[F.tid + 384]));
        __syncthreads();
        if (F.tid < 64) { float a = 0.f;
#pragma unroll 8
            for (int j = 0; j < 128; ++j) a += hid[j] * w2[j * 64 + F.tid];
            outp[F.tid] = (bf16)f2bf(a); if (n == NCMP - 1) outp[64 + F.tid] = 0; }
        __syncthreads();
    }
}

__device__ __forceinline__ void cmp_attn_phase(const Frame& F) {
    const bf16* P1 = (const bf16*)(F.ws + WS_P1); const float* KC = (const float*)(F.ws + WS_KC); const float* VC = (const float*)(F.ws + WS_VC);
    bf16* OC = (bf16*)(F.ws + WS_OCMP); unsigned* SELM = (unsigned*)(F.ws + WS_SELM); const float* rel = F.in[I_REL];
    LAS float* qs = (LAS float*)(F.lds + F.wave * 8192); LAS float* pl = qs + 512; LAS float* psum = pl + 1024;
    for (int it = F.gw; it < M * 2; it += F.NGW) {
        const int g = it & 1, row = it >> 1, b = row / S, t = row % S;
        const int nv = (t >= 31) ? ((t - 31) / 16 + 1) : 0;
#pragma unroll
        for (int i = 0; i < 8; ++i) qs[F.lane + 64 * i] = bf2f(P1[(size_t)row * P1_LD + C1_Q + g * 512 + F.lane + 64 * i]);
        WAVE_SYNC();
        float lg[2][8]; bool val[2];
#pragma unroll
        for (int kk = 0; kk < 2; ++kk) { const int n = F.lane + 64 * kk; val[kk] = n < nv; const int nn = val[kk] ? n : 0;
            const float* kr = KC + ((size_t)(b * NCMP + nn) * 2 + g) * 64; float a[8];
#pragma unroll
            for (int h = 0; h < 8; ++h) a[h] = 0.f;
#pragma unroll 1
            for (int j = 0; j < 16; ++j) { const f32x4 kv = *(const f32x4*)(kr + 4 * j);
#pragma unroll
                for (int h = 0; h < 8; ++h) a[h] += qs[h * 64 + 4 * j] * kv.x + qs[h * 64 + 4 * j + 1] * kv.y + qs[h * 64 + 4 * j + 2] * kv.z + qs[h * 64 + 4 * j + 3] * kv.w; }
            const int bk = rel_bucket(val[kk] ? (t - (16 * nn + 31)) : 0);
#pragma unroll
            for (int h = 0; h < 8; ++h) lg[kk][h] = val[kk] ? (a[h] * 0.125f + rel[bk * 16 + g * 8 + h]) : -1.0e30f; }
        float ps[2] = {0.f, 0.f};
#pragma unroll
        for (int h = 0; h < 8; ++h) { float m = wave_max(fmaxf(lg[0][h], lg[1][h]));
            float e0 = val[0] ? __expf(lg[0][h] - m) : 0.f, e1 = val[1] ? __expf(lg[1][h] - m) : 0.f;
            const float s = wave_sum(e0 + e1); const float inv = (nv > 0) ? 1.f / s : 0.f; e0 *= inv; e1 *= inv;
            pl[h * 128 + F.lane] = e0; pl[h * 128 + 64 + F.lane] = e1; ps[0] += e0; ps[1] += e1; }
        psum[F.lane] = ps[0]; psum[64 + F.lane] = ps[1];
        WAVE_SYNC();
        float scj = -3.0e38f; bool adm = false;
        if (F.lane < 32) { const int j = F.lane; float p = 0.f;
#pragma unroll
            for (int n = 4 * j - 1; n <= 4 * j + 3; ++n) if (n >= 0 && n < NCMP) p += psum[n];
            const int blkq = t >> 6; adm = (64 * j <= t); const bool forced = (j == 0) || (j == blkq) || (j == blkq - 1);
            scj = adm ? (p + (forced ? 1.0e6f : 0.f)) : -1.0e30f; }
        int rank = 0;
#pragma unroll 1
        for (int i = 0; i < 32; ++i) { const float si = __shfl(scj, i); rank += (si > scj || (si == scj && i < F.lane)) ? 1 : 0; }
        const unsigned long long sm = __ballot(F.lane < 32 && adm && rank < 8);
        if (F.lane == 0) SELM[(size_t)row * 2 + g] = (unsigned)sm;
        float o[8];
#pragma unroll
        for (int h = 0; h < 8; ++h) o[h] = 0.f;
        for (int n = 0; n < nv; ++n) { const float v = VC[((size_t)(b * NCMP + n) * 2 + g) * 64 + F.lane];
#pragma unroll
            for (int h = 0; h < 8; ++h) o[h] += pl[h * 128 + n] * v; }
#pragma unroll
        for (int h = 0; h < 8; ++h) OC[(size_t)row * D + (g * 8 + h) * 64 + F.lane] = (bf16)f2bf(o[h]);
        WAVE_SYNC();
    }
}

__device__ __forceinline__ void slc_attn_phase(const Frame& F) {
    const bf16* P1 = (const bf16*)(F.ws + WS_P1); const unsigned* SELM = (const unsigned*)(F.ws + WS_SELM); bf16* OS = (bf16*)(F.ws + WS_OSLC); const float* rel = F.in[I_REL];
    LAS float* qs = (LAS float*)(F.lds + F.wave * 4096); LAS float* pb = qs + 512;
    for (int it = F.gw; it < M * 2; it += F.NGW) {
        const int g = it & 1, row = it >> 1, b = row / S, t = row % S;
#pragma unroll
        for (int i = 0; i < 8; ++i) qs[F.lane + 64 * i] = bf2f(P1[(size_t)row * P1_LD + C1_Q + g * 512 + F.lane + 64 * i]);
        WAVE_SYNC();
        unsigned sel = SELM[(size_t)row * 2 + g];
        float m[8], l[8], acc[8];
#pragma unroll
        for (int h = 0; h < 8; ++h) { m[h] = -1.0e30f; l[h] = 0.f; acc[h] = 0.f; }
        while (sel) { const int jb = __ffs(sel) - 1; sel &= sel - 1u;
            const int kpos = 64 * jb + F.lane; const bool valid = kpos <= t;
            const bf16* kr = P1 + (size_t)(b * S + kpos) * P1_LD + C1_KS + g * 64; float a[8];
#pragma unroll
            for (int h = 0; h < 8; ++h) a[h] = 0.f;
#pragma unroll 1
            for (int j = 0; j < 8; ++j) { float kf[8]; ld8bf(kr + 8 * j, kf);
#pragma unroll
                for (int h = 0; h < 8; ++h)
#pragma unroll
                    for (int i = 0; i < 8; ++i) a[h] += qs[h * 64 + 8 * j + i] * kf[i]; }
            const int bk = rel_bucket(valid ? (t - kpos) : 0);
            float corr[8];
#pragma unroll
            for (int h = 0; h < 8; ++h) { const float lgt = valid ? (a[h] * 0.125f + rel[bk * 16 + g * 8 + h]) : -1.0e30f;
                const float bm = wave_max(lgt), mn = fmaxf(m[h], bm); corr[h] = __expf(m[h] - mn); const float p = valid ? __expf(lgt - mn) : 0.f;
                l[h] = l[h] * corr[h] + wave_sum(p); m[h] = mn; pb[h * 64 + F.lane] = p; }
            WAVE_SYNC();
            const bf16* vb = P1 + (size_t)(b * S + 64 * jb) * P1_LD + C1_VS + g * 64 + F.lane;
            float add[8];
#pragma unroll
            for (int h = 0; h < 8; ++h) add[h] = 0.f;
            for (int k = 0; k < 64; ++k) { const float v = bf2f(vb[(size_t)k * P1_LD]);
#pragma unroll
                for (int h = 0; h < 8; ++h) add[h] += pb[h * 64 + k] * v; }
#pragma unroll
            for (int h = 0; h < 8; ++h) acc[h] = acc[h] * corr[h] + add[h];
            WAVE_SYNC();
        }
#pragma unroll
        for (int h = 0; h < 8; ++h) OS[(size_t)row * D + (g * 8 + h) * 64 + F.lane] = (bf16)f2bf(acc[h] / l[h]);
    }
}

namespace fa {
typedef short bf16x8 __attribute__((ext_vector_type(8)));
typedef short bf16x4 __attribute__((ext_vector_type(4)));
typedef float f32x16 __attribute__((ext_vector_type(16)));
constexpr int VSTR = 68;
__device__ __forceinline__ float xhalf_max(float x) { const auto r = __builtin_amdgcn_permlane32_swap(__builtin_bit_cast(unsigned, x), __builtin_bit_cast(unsigned, x), false, false);
    return fmaxf(__builtin_bit_cast(float, (unsigned)r[0]), __builtin_bit_cast(float, (unsigned)r[1])); }
__device__ __forceinline__ float xhalf_sum(float x) { const auto r = __builtin_amdgcn_permlane32_swap(__builtin_bit_cast(unsigned, x), __builtin_bit_cast(unsigned, x), false, false);
    return __builtin_bit_cast(float, (unsigned)r[0]) + __builtin_bit_cast(float, (unsigned)r[1]); }
template <int HDK, int HDV> struct Geo { static constexpr int KSTR = HDK + 8, KBYTES = 64 * KSTR * 2, VBYTES = HDV * VSTR * 2, BUF = KBYTES + VBYTES; };
template <int HDK, int HDV, bool KV_SAME> struct Stage { v4u k[HDK / 64]; v4u v[KV_SAME ? 1 : HDV / 64]; };

template <int HDK, int HDV, bool KV_SAME, class P>
__device__ __forceinline__ void load_tile(Stage<HDK, HDV, KV_SAME>& st, const P& pol, int j, int tid) {
#pragma unroll
    for (int i = 0; i < HDK / 64; ++i) { const int c = tid + 512 * i, r = c / (HDK / 8), ch = c % (HDK / 8); st.k[i] = *(const v4u*)(pol.krow(j, r) + 8 * ch); }
    if (!KV_SAME) {
#pragma unroll
        for (int i = 0; i < HDV / 64; ++i) { const int c = tid + 512 * i, r = c / (HDV / 8), ch = c % (HDV / 8); st.v[i] = *(const v4u*)(pol.vrow(j, r) + 8 * ch); }
    }
}
template <int HDK, int HDV, bool KV_SAME>
__device__ __forceinline__ void store_tile(const Stage<HDK, HDV, KV_SAME>& st, LAS unsigned char* buf, int tid) {
    typedef Geo<HDK, HDV> G;
    LAS bf16* Ks = (LAS bf16*)buf; LAS bf16* Vt = (LAS bf16*)(buf + G::KBYTES);
#pragma unroll
    for (int i = 0; i < HDK / 64; ++i) { const int c = tid + 512 * i, r = c / (HDK / 8), ch = c % (HDK / 8); *(LAS v4u*)(Ks + r * G::KSTR + 8 * ch) = st.k[i]; }
#pragma unroll
    for (int i = 0; i < HDV / 64; ++i) { const int c = tid + 512 * i, r = c / (HDV / 8), ch = c % (HDV / 8); const v4u w = KV_SAME ? st.k[i] : st.v[i];
        LAS bf16* vp = Vt + (8 * ch) * VSTR + r;
        vp[0 * VSTR] = (bf16)(w.x & 0xffffu); vp[1 * VSTR] = (bf16)(w.x >> 16); vp[2 * VSTR] = (bf16)(w.y & 0xffffu); vp[3 * VSTR] = (bf16)(w.y >> 16);
        vp[4 * VSTR] = (bf16)(w.z & 0xffffu); vp[5 * VSTR] = (bf16)(w.z >> 16); vp[6 * VSTR] = (bf16)(w.w & 0xffffu); vp[7 * VSTR] = (bf16)(w.w >> 16); }
}
template <int HDK, int HDV, class P>
__device__ __forceinline__ void compute_tile(const LAS unsigned char* buf, const P& pol, int j, int lane, const bf16x8 (&qf)[HDK / 16], f32x16 (&o)[HDV / 32], float& m, float& l) {
    typedef Geo<HDK, HDV> G;
    const LAS bf16* Ks = (const LAS bf16*)buf; const LAS bf16* Vt = (const LAS bf16*)(buf + G::KBYTES);
    const int r = lane & 31, h = lane >> 5;
    f32x16 s[2];
#pragma unroll
    for (int kb = 0; kb < 2; ++kb) {
#pragma unroll
        for (int e = 0; e < 16; ++e) s[kb][e] = 0.f;
#pragma unroll
        for (int ks = 0; ks < HDK / 16; ++ks) { const bf16x8 a = *(const LAS bf16x8*)(Ks + (32 * kb + r) * G::KSTR + 16 * ks + 8 * h);
            s[kb] = __builtin_amdgcn_mfma_f32_32x32x16_bf16(a, qf[ks], s[kb], 0, 0, 0); }
        if (HDK > 64) __builtin_amdgcn_sched_barrier(0);
    }
    bf16x8 vf[HDV == 64 ? 8 : 1];
    if (HDV == 64) {
#pragma unroll
        for (int kb = 0; kb < 2; ++kb)
#pragma unroll
            for (int s2 = 0; s2 < 2; ++s2)
#pragma unroll
                for (int blk = 0; blk < 2; ++blk) { const LAS bf16* vp = Vt + (32 * blk + r) * VSTR + 32 * kb + 16 * s2 + 4 * h;
                    const bf16x4 lo = *(const LAS bf16x4*)vp, hi = *(const LAS bf16x4*)(vp + 8);
                    vf[HDV == 64 ? (kb * 4 + s2 * 2 + blk) : 0] = __builtin_shufflevector(lo, hi, 0, 1, 2, 3, 4, 5, 6, 7); }
    }
    float mref, mn, rs = 0.f;
    if (pol.fast(j)) {
        const float b2 = pol.lane_bias2(j), c2 = pol.c2;
        float mx = -INFINITY;
#pragma unroll
        for (int kb = 0; kb < 2; ++kb)
#pragma unroll
            for (int e = 0; e < 16; ++e) mx = fmaxf(mx, s[kb][e]);
        mx = fa::xhalf_max(mx);
        mn = fmaxf(m, mx * c2 + b2); mref = (mn == -INFINITY) ? 0.f : mn;
        const float off = b2 - mref;
#pragma unroll
        for (int kb = 0; kb < 2; ++kb)
#pragma unroll
            for (int e = 0; e < 16; ++e) { s[kb][e] = __builtin_amdgcn_exp2f(__builtin_fmaf(s[kb][e], c2, off)); rs += s[kb][e]; }
    } else {
        pol.transform(j, s, lane);
        float mx = -INFINITY;
#pragma unroll
        for (int kb = 0; kb < 2; ++kb)
#pragma unroll
            for (int e = 0; e < 16; ++e) mx = fmaxf(mx, s[kb][e]);
        mx = fa::xhalf_max(mx);
        mn = fmaxf(m, mx); mref = (mn == -INFINITY) ? 0.f : mn;
#pragma unroll
        for (int kb = 0; kb < 2; ++kb)
#pragma unroll
            for (int e = 0; e < 16; ++e) { s[kb][e] = __builtin_amdgcn_exp2f(s[kb][e] - mref); rs += s[kb][e]; }
    }
    rs = fa::xhalf_sum(rs);
    const float corr = __builtin_amdgcn_exp2f(m - mref);
    m = mn;
    if (__any(corr != 1.f)) {
        l = l * corr + rs;
#pragma unroll
        for (int blk = 0; blk < HDV / 32; ++blk)
#pragma unroll
            for (int e = 0; e < 16; ++e) o[blk][e] *= corr;
    } else l += rs;
#pragma unroll
    for (int kb = 0; kb < 2; ++kb)
#pragma unroll
        for (int s2 = 0; s2 < 2; ++s2) {
            v4u pw; pw.x = pg8::cvt_pk_bf16(s[kb][8 * s2 + 0], s[kb][8 * s2 + 1]); pw.y = pg8::cvt_pk_bf16(s[kb][8 * s2 + 2], s[kb][8 * s2 + 3]);
            pw.z = pg8::cvt_pk_bf16(s[kb][8 * s2 + 4], s[kb][8 * s2 + 5]); pw.w = pg8::cvt_pk_bf16(s[kb][8 * s2 + 6], s[kb][8 * s2 + 7]);
            const bf16x8 pf = __builtin_bit_cast(bf16x8, pw);
#pragma unroll
            for (int blk = 0; blk < HDV / 32; ++blk) {
                bf16x8 a;
                if (HDV == 64) a = vf[HDV == 64 ? (kb * 4 + s2 * 2 + blk) : 0];
                else { const LAS bf16* vp = Vt + (32 * blk + r) * VSTR + 32 * kb + 16 * s2 + 4 * h;
                    const bf16x4 lo = *(const LAS bf16x4*)vp, hi = *(const LAS bf16x4*)(vp + 8);
                    a = __builtin_shufflevector(lo, hi, 0, 1, 2, 3, 4, 5, 6, 7); }
                o[blk] = __builtin_amdgcn_mfma_f32_32x32x16_bf16(a, pf, o[blk], 0, 0, 0); }
            if (HDV > 64) __builtin_amdgcn_sched_barrier(0);
        }
}
template <int HDK, int HDV, bool KV_SAME, class P>
__device__ __forceinline__ void run(LAS unsigned char* lds, P& pol, unsigned tmask, int tid, int lane, const bf16x8 (&qf)[HDK / 16], f32x16 (&o)[HDV / 32], float& m, float& l) {
    typedef Geo<HDK, HDV> G;
    if (tmask == 0u) return;
    Stage<HDK, HDV, KV_SAME> sa, sb;
    int j0 = __builtin_ctz(tmask); tmask &= tmask - 1u;
    pol.prefetch(j0); pol.advance();
    load_tile<HDK, HDV, KV_SAME>(sa, pol, j0, tid);
    int j1 = -1; if (tmask) { j1 = __builtin_ctz(tmask); tmask &= tmask - 1u; load_tile<HDK, HDV, KV_SAME>(sb, pol, j1, tid); pol.prefetch(j1); }
    store_tile<HDK, HDV, KV_SAME>(sa, lds, tid);
    __syncthreads();
    int cur = 0;
    for (;;) {
        PROBE_START(4, tid);
        int j2 = -1; if (tmask) { j2 = __builtin_ctz(tmask); tmask &= tmask - 1u; load_tile<HDK, HDV, KV_SAME>(sa, pol, j2, tid); }
        PROBE_STOP(4, tid); PROBE_START(2, tid);
        compute_tile<HDK, HDV>(lds + cur * G::BUF, pol, j0, lane, qf, o, m, l);
        PROBE_STOP(2, tid);
        if (j1 < 0) break;
        PROBE_START(3, tid);
        store_tile<HDK, HDV, KV_SAME>(sb, lds + (cur ^ 1) * G::BUF, tid);
        pol.advance(); if (j2 >= 0) pol.prefetch(j2);
        PROBE_STOP(3, tid); PROBE_START(5, tid);
        __syncthreads(); cur ^= 1;
        PROBE_STOP(5, tid); PROBE_START(4, tid);
        int j3 = -1; if (tmask) { j3 = __builtin_ctz(tmask); tmask &= tmask - 1u; load_tile<HDK, HDV, KV_SAME>(sb, pol, j3, tid); }
        PROBE_STOP(4, tid); PROBE_START(2, tid);
        compute_tile<HDK, HDV>(lds + cur * G::BUF, pol, j1, lane, qf, o, m, l);
        PROBE_STOP(2, tid);
        if (j2 < 0) break;
        PROBE_START(3, tid);
        store_tile<HDK, HDV, KV_SAME>(sa, lds + (cur ^ 1) * G::BUF, tid);
        pol.advance(); if (j3 >= 0) pol.prefetch(j3);
        PROBE_STOP(3, tid); PROBE_START(5, tid);
        __syncthreads(); cur ^= 1;
        PROBE_STOP(5, tid);
        j0 = j2; j1 = j3;
    }
    __syncthreads();
}
template <int HDK, int HDV, bool KV_SAME, class P>
__device__ __forceinline__ void run1(LAS unsigned char* lds, P& pol, unsigned tmask, int tid, int lane, const bf16x8 (&qf)[HDK / 16], f32x16 (&o)[HDV / 32], float& m, float& l) {
    typedef Geo<HDK, HDV> G;
    if (tmask == 0u) return;
    Stage<HDK, HDV, KV_SAME> st;
    int j = __builtin_ctz(tmask); tmask &= tmask - 1u; int cur = 0;
    pol.prefetch(j); pol.advance();
    load_tile<HDK, HDV, KV_SAME>(st, pol, j, tid); store_tile<HDK, HDV, KV_SAME>(st, lds, tid);
    __syncthreads();
    for (;;) {
        const bool more = tmask != 0u; int jn = 0;
        if (more) { jn = __builtin_ctz(tmask); tmask &= tmask - 1u; load_tile<HDK, HDV, KV_SAME>(st, pol, jn, tid); pol.prefetch(jn); }
        compute_tile<HDK, HDV>(lds + cur * G::BUF, pol, j, lane, qf, o, m, l);
        if (!more) break;
        store_tile<HDK, HDV, KV_SAME>(st, lds + (cur ^ 1) * G::BUF, tid);
        pol.advance();
        __syncthreads();
        cur ^= 1; j = jn;
    }
    __syncthreads();
}
}

__device__ __forceinline__ void build_bias_table(const Frame& F, LAS float* tab, int nheads, int relc0) {
    const float* rel = F.in[I_REL];
    for (int i = F.tid; i < nheads * 129; i += 512) { const int hh = i / 129, d = i % 129; tab[hh * 132 + d] = rel[rel_bucket(d) * 16 + relc0 + hh] * 1.4426950408889634f; }
    __syncthreads();
}
struct BandPol {
    __device__ __forceinline__ void prefetch(int) {} __device__ __forceinline__ void advance() {}
    const bf16* kbase; const bf16* vbase; int ld; int tq, tq0, W; const LAS float* bl;
    static constexpr float c2 = 0.125f * 1.4426950408889634f;
    __device__ __forceinline__ const bf16* krow(int j, int r) const { return kbase + (size_t)(64 * j + r) * ld; }
    __device__ __forceinline__ const bf16* vrow(int j, int r) const { return vbase + (size_t)(64 * j + r) * ld; }
    __device__ __forceinline__ bool fast(int j) const { const int k0 = 64 * j; return tq0 - (k0 + 63) >= 128 && (tq0 + 31) - k0 < W; }
    __device__ __forceinline__ float lane_bias2(int) const { return bl[128]; }
    __device__ __forceinline__ void transform(int j, fa::f32x16 (&s)[2], int lane) const {
        const int k0 = 64 * j, h = lane >> 5;
        if (tq0 - (k0 + 63) >= 128) {
            const float b31 = bl[128]; const int dbase = tq - k0 - 4 * h;
#pragma unroll
            for (int kb = 0; kb < 2; ++kb)
#pragma unroll
                for (int e = 0; e < 16; ++e) { const int dist = dbase - (32 * kb + 8 * (e >> 2) + (e & 3)); s[kb][e] = (dist < W) ? __builtin_fmaf(s[kb][e], c2, b31) : -INFINITY; }
        } else {
#pragma unroll
            for (int kb = 0; kb < 2; ++kb)
#pragma unroll
                for (int e = 0; e < 16; ++e) { const int key = k0 + 32 * kb + 8 * (e >> 2) + 4 * h + (e & 3); const int dist = tq - key;
                    const int di = dist < 0 ? 0 : (dist > 128 ? 128 : dist);
                    const float v = __builtin_fmaf(s[kb][e], c2, bl[di]);
                    s[kb][e] = (dist >= 0 && dist < W) ? v : -INFINITY; }
        }
    }
};
__device__ __forceinline__ void win_phase_mfma(const Frame& F) {
    bf16* P1 = (bf16*)(F.ws + WS_P1); const bf16* OC = (const bf16*)(F.ws + WS_OCMP); const bf16* OS = (const bf16*)(F.ws + WS_OSLC);
    LAS float* tab = (LAS float*)(F.lds + 36864);
    build_bias_table(F, tab, 16, 0);
    const int h = F.lane >> 5;
    for (int u = blockIdx.x; u < NB * 2 * 64; u += F.G) {
        const int rr_ = u / F.G, c_ = u % F.G; const int qb_ = ((c_ & 63) + 16 * (rr_ >> 1)) & 63, qt = (rr_ & 1) ? 63 - qb_ : qb_, bg = (rr_ * (F.G >> 6) + (c_ >> 6)) % (NB * 2), b = bg >> 1, g = bg & 1;
        const int tq0 = 32 * qt, head = g * 8 + F.wave, tq = tq0 + (F.lane & 31);
        const size_t row = (size_t)b * S + tq;
        fa::bf16x8 qf[4];
#pragma unroll
        for (int ks = 0; ks < 4; ++ks) qf[ks] = *(const fa::bf16x8*)(P1 + row * P1_LD + C1_Q + head * 64 + 16 * ks + 8 * h);
        fa::f32x16 o[2];
#pragma unroll
        for (int blk = 0; blk < 2; ++blk)
#pragma unroll
            for (int e = 0; e < 16; ++e) o[blk][e] = 0.f;
        float m = -INFINITY, l = 0.f;
        const int jlo = (tq0 - 511 > 0 ? tq0 - 511 : 0) >> 6, jhi = (tq0 + 31) >> 6;
        const unsigned tmask = (jhi >= 31 ? 0xffffffffu : ((1u << (jhi + 1)) - 1u)) & ~((1u << jlo) - 1u);
        BandPol pol{P1 + (size_t)b * S * P1_LD + C1_KW + g * 64, P1 + (size_t)b * S * P1_LD + C1_VW + g * 64, P1_LD, tq, tq0, 512, tab + head * 132};
        fa::run<64, 64, false>(F.lds, pol, tmask, F.tid, F.lane, qf, o, m, l);
        const float inv = 1.f / l;
        const bf16* gr = P1 + row * P1_LD + C1_GL + head * 3;
        const float g0 = 1.f / (1.f + __expf(-bf2f(gr[0]))), g1 = 1.f / (1.f + __expf(-bf2f(gr[1]))), g2 = 1.f / (1.f + __expf(-bf2f(gr[2])));
#pragma unroll
        for (int blk = 0; blk < 2; ++blk)
#pragma unroll
            for (int jj = 0; jj < 4; ++jj) { const int d0 = 32 * blk + 8 * jj + 4 * h;
                const v2u cw = *(const v2u*)(OC + row * D + head * 64 + d0), sw = *(const v2u*)(OS + row * D + head * 64 + d0);
                const float r0 = g0 * bflo(cw.x) + g1 * bflo(sw.x) + g2 * o[blk][4 * jj + 0] * inv, r1 = g0 * bfhi(cw.x) + g1 * bfhi(sw.x) + g2 * o[blk][4 * jj + 1] * inv;
                const float r2 = g0 * bflo(cw.y) + g1 * bflo(sw.y) + g2 * o[blk][4 * jj + 2] * inv, r3 = g0 * bfhi(cw.y) + g1 * bfhi(sw.y) + g2 * o[blk][4 * jj + 3] * inv;
                v2u ow; ow.x = pk2(r0, r1); ow.y = pk2(r2, r3);
                *(v2u*)(P1 + row * P1_LD + C1_Q + head * 64 + d0) = ow; }
    }
}
__device__ __forceinline__ void swa_phase_mfma(const Frame& F) {
    bf16* P0 = (bf16*)(F.ws + WS_P0); const float* sinks = F.in[I_EV_SINK];
    LAS float* tab = (LAS float*)(F.lds + 36864);
    build_bias_table(F, tab, 8, 8);
    const int h = F.lane >> 5;
    for (int u = blockIdx.x; u < NB * 2 * 32; u += F.G) {
        const int ui_ = u / F.G, uc_ = u % F.G; const int bkv_ = (F.G == 256) ? ((uc_ >> 5) + 8 * ui_) : (u >> 5), tl_ = (F.G == 256) ? (((uc_ & 31) + 8 * ui_) & 31) : (u & 31);
        const int b = bkv_ >> 1, kvh = bkv_ & 1, t0 = 64 * tl_, head = kvh * 4 + (F.wave & 3), tq0 = t0 + 32 * (F.wave >> 2), tq = tq0 + (F.lane & 31);
        const size_t row = (size_t)b * S + tq;
        fa::bf16x8 qf[4];
#pragma unroll
        for (int ks = 0; ks < 4; ++ks) qf[ks] = *(const fa::bf16x8*)(P0 + row * P0_LD + C0_QB + head * 64 + 16 * ks + 8 * h);
        fa::f32x16 o[2];
#pragma unroll
        for (int blk = 0; blk < 2; ++blk)
#pragma unroll
            for (int e = 0; e < 16; ++e) o[blk][e] = 0.f;
        float m = sinks[head] * 1.4426950408889634f, l = 1.f;
        const int jlo = (t0 - 127 > 0 ? t0 - 127 : 0) >> 6, jhi = t0 >> 6;
        const unsigned tmask = (jhi >= 31 ? 0xffffffffu : ((1u << (jhi + 1)) - 1u)) & ~((1u << jlo) - 1u);
        BandPol pol{P0 + (size_t)b * S * P0_LD + C0_KB + kvh * 64, P0 + (size_t)b * S * P0_LD + C0_VB + kvh * 64, P0_LD, tq, tq0, 128, tab + head * 132};
        fa::run<64, 64, false>(F.lds, pol, tmask, F.tid, F.lane, qf, o, m, l);
        const float inv = 1.f / l;
#pragma unroll
        for (int blk = 0; blk < 2; ++blk)
#pragma unroll
            for (int jj = 0; jj < 4; ++jj) { const int d0 = 32 * blk + 8 * jj + 4 * h;
                v2u ow; ow.x = pk2(o[blk][4 * jj + 0] * inv, o[blk][4 * jj + 1] * inv); ow.y = pk2(o[blk][4 * jj + 2] * inv, o[blk][4 * jj + 3] * inv);
                *(v2u*)(P0 + row * P0_LD + C0_QB + head * 64 + d0) = ow; }
    }
}

struct XaPol {
    __device__ __forceinline__ void prefetch(int) {} __device__ __forceinline__ void advance() {}
    const bf16* kbase;
    static constexpr float c2 = 0.08838834764831845f * 1.4426950408889634f;
    __device__ __forceinline__ const bf16* krow(int j, int r) const { return kbase + (size_t)(64 * j + r) * 1024; }
    __device__ __forceinline__ const bf16* vrow(int j, int r) const { return kbase + (size_t)(64 * j + r) * 1024 + 512; }
    __device__ __forceinline__ bool fast(int) const { return true; }
    __device__ __forceinline__ float lane_bias2(int) const { return 0.f; }
    __device__ __forceinline__ void transform(int, fa::f32x16 (&)[2], int) const {}
};
__device__ __forceinline__ void xattn_phase_mfma(const Frame& F, const bf16* Q, const bf16* KV, bf16* O) {
    const int h = F.lane >> 5;
    for (int u2 = 2 * blockIdx.x; u2 < NB * 4 * 8; u2 += 2 * F.G)
    for (int hp = 0; hp < 2; ++hp) {
        int pm, pn; pg8::tile_of(u2 >> 1, M / 256, 2, pm, pn);
        const int b = pm >> 3, qt = pm & 7, head = 2 * pn + hp, tq = 256 * qt + 32 * F.wave + (F.lane & 31);
        const size_t row = (size_t)b * S + tq;
        fa::bf16x8 qf[8];
#pragma unroll
        for (int ks = 0; ks < 8; ++ks) qf[ks] = *(const fa::bf16x8*)(Q + row * 512 + head * 128 + 16 * ks + 8 * h);
        fa::f32x16 o[4];
#pragma unroll
        for (int blk = 0; blk < 4; ++blk)
#pragma unroll
            for (int e = 0; e < 16; ++e) o[blk][e] = 0.f;
        float m = -INFINITY, l = 0.f;
        XaPol pol{KV + (size_t)b * MEML * 1024 + head * 128};
        fa::run<128, 128, false>(F.lds, pol, 0xFu, F.tid, F.lane, qf, o, m, l);
        const float inv = 1.f / l;
#pragma unroll
        for (int blk = 0; blk < 4; ++blk)
#pragma unroll
            for (int jj = 0; jj < 4; ++jj) { const int d0 = 32 * blk + 8 * jj + 4 * h;
                v2u ow; ow.x = pk2(o[blk][4 * jj + 0] * inv, o[blk][4 * jj + 1] * inv); ow.y = pk2(o[blk][4 * jj + 2] * inv, o[blk][4 * jj + 3] * inv);
                *(v2u*)(O + row * 512 + head * 128 + d0) = ow; }
    }
}
struct DsaPol {
    const bf16* cbase; const unsigned* mrow; int tq, tq0; const LAS float* bl; v2u mwc, mwn;
    static constexpr float c2 = 0.125f * 1.4426950408889634f;
    __device__ __forceinline__ const bf16* krow(int j, int r) const { return cbase + (size_t)(64 * j + r) * 128; }
    __device__ __forceinline__ const bf16* vrow(int j, int r) const { return krow(j, r); }
    __device__ __forceinline__ bool fast(int) const { return false; }
    __device__ __forceinline__ float lane_bias2(int) const { return 0.f; }
    __device__ __forceinline__ void prefetch(int j) { mwn = *(const v2u*)(mrow + 2 * j); }
    __device__ __forceinline__ void advance() { mwc = mwn; }
    __device__ __forceinline__ void transform(int j, fa::f32x16 (&s)[2], int lane) const {
        const int k0 = 64 * j, h = lane >> 5;
#pragma unroll
        for (int kb = 0; kb < 2; ++kb) { const unsigned w = (kb ? mwc.y : mwc.x) >> (4 * h);
#pragma unroll
            for (int e = 0; e < 16; ++e) { const int bit = 8 * (e >> 2) + (e & 3); const int kin = bit + 4 * h; const int dist = tq - (k0 + 32 * kb + kin);
                const int di = dist < 0 ? 0 : (dist > 128 ? 128 : dist); const int mm = ((int)(w << (31 - bit))) >> 31;
                const unsigned vb = __builtin_bit_cast(unsigned, __builtin_fmaf(s[kb][e], c2, bl[di]));
                s[kb][e] = __builtin_bit_cast(float, (vb & (unsigned)mm) | (0xff800000u & ~(unsigned)mm)); } }
    }
};
__device__ __forceinline__ void dsa_phase_mfma(const Frame& F) {
    bf16* P0 = (bf16*)(F.ws + WS_P0); const bf16* CN = (const bf16*)(F.ws + WS_CN); const unsigned* MASK = (const unsigned*)(F.ws + WS_MASK);
    LAS float* tab = (LAS float*)(F.lds + 73728);
    build_bias_table(F, tab, 8, 0);
    const int h = F.lane >> 5;
    for (int u = blockIdx.x; u < NB * 64; u += F.G) {
        const int rr = u / F.G, c = u % F.G; const int qt = (rr & 1) ? 63 - (c & 63) : (c & 63), b = (rr * (F.G >> 6) + (c >> 6)) % NB;
        const int tq0 = 32 * qt, tq = tq0 + (F.lane & 31), head = F.wave;
        const size_t row = (size_t)b * S + tq;
        fa::bf16x8 qf[8];
#pragma unroll
        for (int ks = 0; ks < 8; ++ks) qf[ks] = *(const fa::bf16x8*)(P0 + row * P0_LD + C0_QLAT + head * 128 + 16 * ks + 8 * h);
        fa::f32x16 o[4];
#pragma unroll
        for (int blk = 0; blk < 4; ++blk)
#pragma unroll
            for (int e = 0; e < 16; ++e) o[blk][e] = 0.f;
        float m = -INFINITY, l = 0.f;
        const int jhi = (tq0 + 31) >> 6; const unsigned tmask = jhi >= 31 ? 0xffffffffu : ((1u << (jhi + 1)) - 1u);
        DsaPol pol{CN + (size_t)b * S * 128, MASK + row * 64, tq, tq0, tab + head * 132, (v2u){0u, 0u}, (v2u){0u, 0u}};
        fa::run<128, 128, true>(F.lds, pol, tmask, F.tid, F.lane, qf, o, m, l);
        const float inv = 1.f / l;
#pragma unroll
        for (int blk = 0; blk < 4; ++blk)
#pragma unroll
            for (int jj = 0; jj < 4; ++jj) { const int d0 = 32 * blk + 8 * jj + 4 * h;
                v2u ow; ow.x = pk2(o[blk][4 * jj + 0] * inv, o[blk][4 * jj + 1] * inv); ow.y = pk2(o[blk][4 * jj + 2] * inv, o[blk][4 * jj + 3] * inv);
                *(v2u*)(P0 + row * P0_LD + C0_QLAT + head * 128 + d0) = ow; }
    }
}
struct SlcPol {
    __device__ __forceinline__ void prefetch(int) {} __device__ __forceinline__ void advance() {}
    const bf16* kbase; const bf16* vbase; unsigned sel; int tq, tq0; const LAS float* bl;
    static constexpr float c2 = 0.125f * 1.4426950408889634f;
    __device__ __forceinline__ const bf16* krow(int j, int r) const { return kbase + (size_t)(64 * j + r) * P1_LD; }
    __device__ __forceinline__ const bf16* vrow(int j, int r) const { return vbase + (size_t)(64 * j + r) * P1_LD; }
    __device__ __forceinline__ bool fast(int j) const { return tq0 - (64 * j + 63) >= 128; }
    __device__ __forceinline__ float lane_bias2(int j) const { return ((sel >> j) & 1u) ? bl[128] : -INFINITY; }
    __device__ __forceinline__ void transform(int j, fa::f32x16 (&s)[2], int lane) const {
        const int k0 = 64 * j, h = lane >> 5; const bool on = (sel >> j) & 1u;
#pragma unroll
        for (int kb = 0; kb < 2; ++kb)
#pragma unroll
            for (int e = 0; e < 16; ++e) { const int dist = tq - (k0 + 32 * kb + 8 * (e >> 2) + 4 * h + (e & 3));
                const int di = dist < 0 ? 0 : (dist > 128 ? 128 : dist);
                const float v = __builtin_fmaf(s[kb][e], c2, bl[di]);
                s[kb][e] = (on && dist >= 0) ? v : -INFINITY; }
    }
};
__device__ __forceinline__ void slc_phase_mfma(const Frame& F) {
    const bf16* P1 = (const bf16*)(F.ws + WS_P1); const unsigned* SELM = (const unsigned*)(F.ws + WS_SELM); bf16* OS = (bf16*)(F.ws + WS_OSLC);
    LAS float* tab = (LAS float*)(F.lds + 36864);
    build_bias_table(F, tab, 16, 0);
    const int h = F.lane >> 5;
    for (int u = blockIdx.x; u < NB * 2 * 64; u += F.G) {
        const int rr = u / F.G, c = u % F.G; const int qb_ = ((c & 63) + 16 * (rr >> 1)) & 63, qt = (rr & 1) ? 63 - qb_ : qb_,     bg = (rr * (F.G >> 6) + (c >> 6)) % (NB * 2), b = bg >> 1, g = bg & 1;
        const int tq0 = 32 * qt, tq = tq0 + (F.lane & 31), head = g * 8 + F.wave;
        const size_t row = (size_t)b * S + tq;
        fa::bf16x8 qf[4];
#pragma unroll
        for (int ks = 0; ks < 4; ++ks) qf[ks] = *(const fa::bf16x8*)(P1 + row * P1_LD + C1_Q + head * 64 + 16 * ks + 8 * h);
        fa::f32x16 o[2];
#pragma unroll
        for (int blk = 0; blk < 2; ++blk)
#pragma unroll
            for (int e = 0; e < 16; ++e) o[blk][e] = 0.f;
        float m = -INFINITY, l = 0.f;
        const unsigned sel = SELM[row * 2 + g]; unsigned tm = sel;
#pragma unroll
        for (int of = 1; of < 32; of <<= 1) tm |= (unsigned)__shfl_xor((int)tm, of);
        tm = (unsigned)__builtin_amdgcn_readfirstlane((int)tm);
        SlcPol pol{P1 + (size_t)b * S * P1_LD + C1_KS + g * 64, P1 + (size_t)b * S * P1_LD + C1_VS + g * 64, sel, tq, tq0, tab + head * 132};
        fa::run<64, 64, false>(F.lds, pol, tm, F.tid, F.lane, qf, o, m, l);
        const float inv = 1.f / l;
#pragma unroll
        for (int blk = 0; blk < 2; ++blk)
#pragma unroll
            for (int jj = 0; jj < 4; ++jj) { const int d0 = 32 * blk + 8 * jj + 4 * h;
                v2u ow; ow.x = pk2(o[blk][4 * jj + 0] * inv, o[blk][4 * jj + 1] * inv); ow.y = pk2(o[blk][4 * jj + 2] * inv, o[blk][4 * jj + 3] * inv);
                *(v2u*)(OS + row * D + head * 64 + d0) = ow; }
    }
}

__device__ __forceinline__ int wave_sum_dpp(int v) {
    v += __builtin_amdgcn_update_dpp(0, v, 0xB1, 0xf, 0xf, false);
    v += __builtin_amdgcn_update_dpp(0, v, 0x4E, 0xf, 0xf, false);
    v += __builtin_amdgcn_update_dpp(0, v, 0x141, 0xf, 0xf, false);
    v += __builtin_amdgcn_update_dpp(0, v, 0x140, 0xf, 0xf, false);
    v += __builtin_amdgcn_update_dpp(0, v, 0x142, 0xa, 0xf, false);
    v += __builtin_amdgcn_update_dpp(0, v, 0x143, 0xc, 0xf, false);
    return __builtin_amdgcn_readlane(v, 63);
}
template <bool GT>
__device__ __forceinline__ int count4(unsigned u0, unsigned u1, unsigned u2, unsigned u3, unsigned cand) {
    unsigned long long m0, m1, m2, m3; int t0, t1, t2, t3;
    if (GT)
        asm volatile("v_cmp_gt_u32_e64 %0, %8, %12\n\tv_cmp_gt_u32_e64 %1, %9, %12\n\tv_cmp_gt_u32_e64 %2, %10, %12\n\tv_cmp_gt_u32_e64 %3, %11, %12\n\t"
                     "s_bcnt1_i32_b64 %4, %0\n\ts_bcnt1_i32_b64 %5, %1\n\ts_bcnt1_i32_b64 %6, %2\n\ts_bcnt1_i32_b64 %7, %3"
                     : "=&s"(m0), "=&s"(m1), "=&s"(m2), "=&s"(m3), "=&s"(t0), "=&s"(t1), "=&s"(t2), "=&s"(t3) : "v"(u0), "v"(u1), "v"(u2), "v"(u3), "s"(cand) : "scc");
    else
        asm volatile("v_cmp_ge_u32_e64 %0, %8, %12\n\tv_cmp_ge_u32_e64 %1, %9, %12\n\tv_cmp_ge_u32_e64 %2, %10, %12\n\tv_cmp_ge_u32_e64 %3, %11, %12\n\t"
                     "s_bcnt1_i32_b64 %4, %0\n\ts_bcnt1_i32_b64 %5, %1\n\ts_bcnt1_i32_b64 %6, %2\n\ts_bcnt1_i32_b64 %7, %3"
                     : "=&s"(m0), "=&s"(m1), "=&s"(m2), "=&s"(m3), "=&s"(t0), "=&s"(t1), "=&s"(t2), "=&s"(t3) : "v"(u0), "v"(u1), "v"(u2), "v"(u3), "s"(cand) : "scc");
    return (t0 + t1) + (t2 + t3);
}
__device__ __forceinline__ void idx_phase_mfma(const Frame& F) {
    const bf16* P0 = (const bf16*)(F.ws + WS_P0); unsigned* MASK = (unsigned*)(F.ws + WS_MASK);
    LAS float* sc0 = (LAS float*)F.lds;
    const int r = F.lane & 31, hh = F.lane >> 5;
    const int head_r = (r & 3) + 4 * ((r >> 3) & 1), ql_r = 2 * (r >> 4) + ((r >> 2) & 1);
    fa::bf16x8 qaN[2][4]; v4u wvN[2][2];
#define IDX_DECODE(item_, b_, t0_) { const int it_i = (item_) / F.G, it_c = (item_) % F.G; b_ = (F.G == S / 8) ? it_i : (item_) / (S / 8); const int tb_ = (it_c + 16 * it_i) & (S / 8 - 1); t0_ = ((F.G == S / 8) ? ((it_i & 1) ? (S / 8 - 1 - tb_) : tb_) : ((item_) % (S / 8))) * 8; }
#define IDX_LOAD(item_) { int b_, t0_; IDX_DECODE(item_, b_, t0_); \
        _Pragma("unroll") for (int rb = 0; rb < 2; ++rb) { const bf16* qp = P0 + (size_t)(b_ * S + t0_ + 4 * rb + ql_r) * P0_LD + C0_QI + head_r * 64 + 8 * hh; \
            _Pragma("unroll") for (int ks = 0; ks < 4; ++ks) qaN[rb][ks] = *(const fa::bf16x8*)(qp + 16 * ks); \
            _Pragma("unroll") for (int qq = 0; qq < 2; ++qq) wvN[rb][qq] = *(const v4u*)(P0 + (size_t)(b_ * S + t0_ + 4 * rb + 2 * qq + hh) * P0_LD + C0_WI); } }
    if ((int)blockIdx.x < NB * (S / 8)) IDX_LOAD(blockIdx.x);
    for (int item = blockIdx.x; item < NB * (S / 8); item += F.G) {
        int b, t0; IDX_DECODE(item, b, t0);
        LAS float* sc = sc0 + (item & 1) * (8 * 2048);
        fa::bf16x8 qa[2][4]; float wv[2][2][8];
#pragma unroll
        for (int rb = 0; rb < 2; ++rb) {
#pragma unroll
            for (int ks = 0; ks < 4; ++ks) qa[rb][ks] = qaN[rb][ks];
#pragma unroll
            for (int qq = 0; qq < 2; ++qq) { const v4u w = wvN[rb][qq]; const float sc8 = 0.35355339059f * 0.125f;
                wv[rb][qq][0] = bflo(w.x) * sc8; wv[rb][qq][1] = bfhi(w.x) * sc8; wv[rb][qq][2] = bflo(w.y) * sc8; wv[rb][qq][3] = bfhi(w.y) * sc8;
                wv[rb][qq][4] = bflo(w.z) * sc8; wv[rb][qq][5] = bfhi(w.z) * sc8; wv[rb][qq][6] = bflo(w.w) * sc8; wv[rb][qq][7] = bfhi(w.w) * sc8; } }
        const int nkb = (t0 + 8 + 31) >> 5;
        PROBE_START(9, F.tid);
#pragma unroll 1
        for (int kb0 = F.wave; kb0 < nkb; kb0 += 32) {
            fa::bf16x8 kf[4][4];
#pragma unroll
            for (int i = 0; i < 4; ++i) { const int kb = (kb0 + 8 * i < 64) ? kb0 + 8 * i : 63; const bf16* kp = P0 + (size_t)(b * S + 32 * kb + r) * P0_LD + C0_KI + 8 * hh;
#pragma unroll
                for (int ks = 0; ks < 4; ++ks) kf[i][ks] = *(const fa::bf16x8*)(kp + 16 * ks); }
#pragma unroll
            for (int i = 0; i < 4; ++i) { const int kb = kb0 + 8 * i;
                if (kb < nkb) {
#pragma unroll
                    for (int rb = 0; rb < 2; ++rb) { fa::f32x16 c;
#pragma unroll
                        for (int e = 0; e < 16; ++e) c[e] = 0.f;
#pragma unroll
                        for (int ks = 0; ks < 4; ++ks) c = __builtin_amdgcn_mfma_f32_32x32x16_bf16(qa[rb][ks], kf[i][ks], c, 0, 0, 0);
                        float s0 = 0.f, s1 = 0.f;
#pragma unroll
                        for (int e = 0; e < 8; ++e) { s0 += wv[rb][0][e] * fmaxf(c[e], 0.f); s1 += wv[rb][1][e] * fmaxf(c[8 + e], 0.f); }
                        sc[(4 * rb + hh) * 2048 + 32 * kb + r] = s0; sc[(4 * rb + 2 + hh) * 2048 + 32 * kb + r] = s1; } } }
        }
        if (item + F.G < NB * (S / 8)) IDX_LOAD(item + F.G);
        PROBE_STOP(9, F.tid);
        __syncthreads();
        PROBE_START(10, F.tid);
        {
            const int q = F.wave, t = t0 + q, n = t + 1, row = b * S + t; unsigned myword = 0u;
            if (n <= 256) { const int cb = n - 32 * F.lane; myword = cb >= 32 ? 0xffffffffu : (cb <= 0 ? 0u : ((1u << cb) - 1u)); }
            else {
                unsigned uu[32];
#pragma unroll
                for (int i = 0; i < 32; ++i) { const int s = F.lane + 64 * i; uu[i] = (s < n) ? fkey(sc[q * 2048 + s]) : 0u; }
                unsigned prefix = 0u; bool exact = false;
#pragma unroll 1
                for (int bit = 31; bit >= 0; --bit) { const unsigned cand = prefix | (1u << bit); int c0 = 0, c1 = 0, c2 = 0, c3 = 0;
#pragma unroll
                    for (int i = 0; i < 32; i += 4) { c0 += (uu[i] >= cand) ? 1 : 0; c1 += (uu[i + 1] >= cand) ? 1 : 0; c2 += (uu[i + 2] >= cand) ? 1 : 0; c3 += (uu[i + 3] >= cand) ? 1 : 0; }
                    const int c = wave_sum_dpp((c0 + c1) + (c2 + c3));
                    if (c >= 256) { prefix = cand; if (c == 256) { exact = true; break; } } }
                int cgt = 0;
                if (!exact) { int g0 = 0, g1 = 0;
#pragma unroll
                    for (int i = 0; i < 32; i += 2) { g0 += (uu[i] > prefix) ? 1 : 0; g1 += (uu[i + 1] > prefix) ? 1 : 0; }
                    cgt = wave_sum_dpp(g0 + g1); }
                if (exact) {
#pragma unroll
                    for (int i = 0; i < 32; ++i) { const unsigned long long sm = __ballot(uu[i] >= prefix);
                        if (F.lane == 2 * i) myword = (unsigned)sm; if (F.lane == 2 * i + 1) myword = (unsigned)(sm >> 32); }
                } else {
                    const int need = 256 - cgt; int run = 0;
#pragma unroll
                    for (int i = 0; i < 32; ++i) { asm volatile("" : "+s"(run), "+v"(uu[i])); const unsigned u = uu[i]; const bool eq = (u == prefix); const unsigned long long em = __ballot(eq); const int rank = run + __popcll(em & ((1ull << F.lane) - 1ull));
                        const bool sel = (u > prefix) || (eq && rank < need); run += __popcll(em);
                        const unsigned long long sm = __ballot(sel);
                        if (F.lane == 2 * i) myword = (unsigned)sm; if (F.lane == 2 * i + 1) myword = (unsigned)(sm >> 32); }
                }
            }
            MASK[(size_t)row * 64 + F.lane] = myword;
        }
        PROBE_STOP(10, F.tid);
    }
    __syncthreads();
}
#undef IDX_DECODE
#undef IDX_LOAD
__device__ __forceinline__ void cmp_phase_mfma(const Frame& F) {
    typedef fa::Geo<64, 64> G;
    const bf16* P1 = (const bf16*)(F.ws + WS_P1); const bf16* KC = (const bf16*)(F.ws + WS_KC); const bf16* VC = (const bf16*)(F.ws + WS_VC);
    bf16* OC = (bf16*)(F.ws + WS_OCMP); unsigned* SELM = (unsigned*)(F.ws + WS_SELM);
    LAS float* tab = (LAS float*)(F.lds + 36864); LAS float* part = (LAS float*)(F.lds + 49152);
    build_bias_table(F, tab, 16, 0);
    const int r = F.lane & 31, h = F.lane >> 5;
    for (int u = blockIdx.x; u < NB * 2 * 64; u += F.G) {
        const int rr_ = u / F.G, c_ = u % F.G; const int qb_ = ((c_ & 63) + 16 * (rr_ >> 1)) & 63, qt = (rr_ & 1) ? 63 - qb_ : qb_, bg = (rr_ * (F.G >> 6) + (c_ >> 6)) % (NB * 2), b = bg >> 1, g = bg & 1;
        const int tq0 = 32 * qt, head = g * 8 + F.wave, tq = tq0 + r;
        const size_t row = (size_t)b * S + tq;
        const int nv = (tq >= 31) ? ((tq - 31) / 16 + 1) : 0;
        const int ntile = (tq0 >= 1024) ? 2 : 1;
        {
            struct CPol { const bf16* kb; const bf16* vb; __device__ __forceinline__ const bf16* krow(int j, int rr) const { return kb + (size_t)(64 * j + rr) * 64; } __device__ __forceinline__ const bf16* vrow(int j, int rr) const { return vb + (size_t)(64 * j + rr) * 64; } };
            CPol cp{KC + (size_t)(b * 2 + g) * 128 * 64, VC + (size_t)(b * 2 + g) * 128 * 64};
            for (int t = 0; t < ntile; ++t) { fa::Stage<64, 64, false> st; fa::load_tile<64, 64, false>(st, cp, t, F.tid); fa::store_tile<64, 64, false>(st, F.lds + t * G::BUF, F.tid); }
        }
        fa::bf16x8 qf[4];
#pragma unroll
        for (int ks = 0; ks < 4; ++ks) qf[ks] = *(const fa::bf16x8*)(P1 + row * P1_LD + C1_Q + head * 64 + 16 * ks + 8 * h);
        __syncthreads();
        fa::f32x16 s[2][2];
        const LAS float* bl = tab + head * 132;
#pragma unroll
        for (int t = 0; t < 2; ++t) {
            const LAS bf16* Ks = (const LAS bf16*)(F.lds + t * G::BUF);
#pragma unroll
            for (int kb = 0; kb < 2; ++kb) {
#pragma unroll
                for (int e = 0; e < 16; ++e) s[t][kb][e] = 0.f;
                if (t < ntile) {
#pragma unroll
                    for (int ks = 0; ks < 4; ++ks) { const fa::bf16x8 a = *(const LAS fa::bf16x8*)(Ks + (32 * kb + r) * G::KSTR + 16 * ks + 8 * h); s[t][kb] = __builtin_amdgcn_mfma_f32_32x32x16_bf16(a, qf[ks], s[t][kb], 0, 0, 0); }
                }
#pragma unroll
                for (int e = 0; e < 16; ++e) { const int n = 64 * t + 32 * kb + 8 * (e >> 2) + 4 * h + (e & 3); const int dist = tq - (16 * n + 31); const int di = dist < 0 ? 0 : (dist > 128 ? 128 : dist);
                    s[t][kb][e] = (n < nv) ? __builtin_fmaf(s[t][kb][e], 0.125f * 1.4426950408889634f, bl[di]) : -INFINITY; }
            }
        }
        float mx = -INFINITY;
#pragma unroll
        for (int t = 0; t < 2; ++t)
#pragma unroll
            for (int kb = 0; kb < 2; ++kb)
#pragma unroll
                for (int e = 0; e < 16; ++e) mx = fmaxf(mx, s[t][kb][e]);
        mx = fa::xhalf_max(mx);
        const float mref = (mx == -INFINITY) ? 0.f : mx; float rs = 0.f;
#pragma unroll
        for (int t = 0; t < 2; ++t)
#pragma unroll
            for (int kb = 0; kb < 2; ++kb)
#pragma unroll
                for (int e = 0; e < 16; ++e) { s[t][kb][e] = __builtin_amdgcn_exp2f(s[t][kb][e] - mref); rs += s[t][kb][e]; }
        rs = fa::xhalf_sum(rs);
        const float inv = (nv > 0) ? 1.f / rs : 0.f;
#pragma unroll
        for (int t = 0; t < 2; ++t)
#pragma unroll
            for (int kb = 0; kb < 2; ++kb)
#pragma unroll
                for (int e = 0; e < 16; ++e) s[t][kb][e] *= inv;
        {
            float sum4[16], p3[16];
#pragma unroll
            for (int t = 0; t < 2; ++t)
#pragma unroll
                for (int kb = 0; kb < 2; ++kb)
#pragma unroll
                    for (int jj = 0; jj < 4; ++jj) { const int G4 = 8 * t + 4 * kb + jj; sum4[G4] = (s[t][kb][4 * jj] + s[t][kb][4 * jj + 1]) + (s[t][kb][4 * jj + 2] + s[t][kb][4 * jj + 3]); p3[G4] = s[t][kb][4 * jj + 3]; }
            LAS float* pw = part + (F.wave * 32 + r) * 32;
            float prt[16];
#pragma unroll
            for (int G4 = 0; G4 < 16; ++G4) { const auto rr = __builtin_amdgcn_permlane32_swap(__builtin_bit_cast(unsigned, p3[G4]), __builtin_bit_cast(unsigned, p3[G4]), false, false);
                prt[G4] = __builtin_bit_cast(float, h ? (unsigned)rr[0] : (unsigned)rr[1]); }
#pragma unroll
            for (int G4 = 0; G4 < 16; ++G4) { const float prm1 = (G4 > 0) ? prt[G4 > 0 ? G4 - 1 : 0] : 0.f;
                const float v = sum4[G4] + (h ? prt[G4] : prm1);
                pw[2 * G4 + h] = v; }
        }
        fa::f32x16 o[2];
#pragma unroll
        for (int blk = 0; blk < 2; ++blk)
#pragma unroll
            for (int e = 0; e < 16; ++e) o[blk][e] = 0.f;
#pragma unroll
        for (int t = 0; t < 2; ++t) {
            if (t < ntile) {
                const LAS bf16* Vt = (const LAS bf16*)(F.lds + t * G::BUF + G::KBYTES);
#pragma unroll
                for (int kb = 0; kb < 2; ++kb)
#pragma unroll
                    for (int s2 = 0; s2 < 2; ++s2) {
                        v4u pw4; pw4.x = pg8::cvt_pk_bf16(s[t][kb][8 * s2 + 0], s[t][kb][8 * s2 + 1]); pw4.y = pg8::cvt_pk_bf16(s[t][kb][8 * s2 + 2], s[t][kb][8 * s2 + 3]);
                        pw4.z = pg8::cvt_pk_bf16(s[t][kb][8 * s2 + 4], s[t][kb][8 * s2 + 5]); pw4.w = pg8::cvt_pk_bf16(s[t][kb][8 * s2 + 6], s[t][kb][8 * s2 + 7]);
                        const fa::bf16x8 pf = __builtin_bit_cast(fa::bf16x8, pw4);
#pragma unroll
                        for (int blk = 0; blk < 2; ++blk) { const LAS bf16* vp = Vt + (32 * blk + r) * fa::VSTR + 32 * kb + 16 * s2 + 4 * h;
                            const fa::bf16x4 lo = *(const LAS fa::bf16x4*)vp, hi = *(const LAS fa::bf16x4*)(vp + 8);
                            o[blk] = __builtin_amdgcn_mfma_f32_32x32x16_bf16(__builtin_shufflevector(lo, hi, 0, 1, 2, 3, 4, 5, 6, 7), pf, o[blk], 0, 0, 0); }
                    }
            }
        }
#pragma unroll
        for (int blk = 0; blk < 2; ++blk)
#pragma unroll
            for (int jj = 0; jj < 4; ++jj) { const int d0 = 32 * blk + 8 * jj + 4 * h;
                v2u ow; ow.x = pk2(o[blk][4 * jj + 0], o[blk][4 * jj + 1]); ow.y = pk2(o[blk][4 * jj + 2], o[blk][4 * jj + 3]);
                *(v2u*)(OC + row * D + head * 64 + d0) = ow; }
        __syncthreads();
#pragma unroll 1
        for (int it = 0; it < 2; ++it) {
            const int ql = 4 * F.wave + 2 * it + h, j = r, t = tq0 + ql; float p = 0.f;
#pragma unroll
            for (int w8 = 0; w8 < 8; ++w8) p += part[(w8 * 32 + ql) * 32 + j];
            const int blkq = t >> 6; const bool adm = (64 * j <= t); const bool forced = (j == 0) || (j == blkq) || (j == blkq - 1);
            const float scj = adm ? (p + (forced ? 1.0e6f : 0.f)) : -1.0e30f;
            int rank = 0;
#pragma unroll 1
            for (int i = 0; i < 32; ++i) { const float si = __shfl(scj, (F.lane & 32) | i); rank += (si > scj || (si == scj && i < j)) ? 1 : 0; }
            const unsigned long long sm = __ballot(adm && rank < 8);
            if (r == 0) SELM[((size_t)b * S + t) * 2 + g] = h ? (unsigned)(sm >> 32) : (unsigned)sm;
        }
        __syncthreads();
    }
}

__device__ __forceinline__ void cmp_prep(const Frame& F) {
    int rot = 0;
    tconv(F, rot, F.in[I_OD_W1K], 128, 2048, 128, 256, (bf16*)(F.ws + WS_W1T), 2048, NOGRP, 0);
    tconv(F, rot, F.in[I_OD_W1V], 128, 2048, 128, 256, (bf16*)(F.ws + WS_W1T) + (size_t)256 * 2048, 2048, NOGRP, 0);
    if (blockIdx.x == 0 && F.tid < 256) { const int which = F.tid >> 7, j = F.tid & 127; const float* pe = which ? F.in[I_OD_PEV] : F.in[I_OD_PEK]; const float* w1 = which ? F.in[I_OD_W1V] : F.in[I_OD_W1K]; float a = 0.f;
        for (int kk = 0; kk < 2048; ++kk) a += pe[kk] * w1[(size_t)kk * 128 + j];
        ((float*)(F.ws + WS_PEB))[F.tid] = a; }
}
__device__ __forceinline__ void cmp_w2_phase(const Frame& F) {
    const float* Hd = (const float*)(F.ws + WS_HIDC);
    LAS float* w2s = (LAS float*)F.lds;
    for (int i = F.tid; i < 2 * 8192; i += 512) w2s[i] = (i < 8192) ? F.in[I_OD_W2K][i] : F.in[I_OD_W2V][i - 8192];
    __syncthreads();
    for (int rw0 = F.gw * 4; rw0 < 2 * 4096; rw0 += F.NGW * 4) {
        float h0[4], h1[4];
#pragma unroll
        for (int k = 0; k < 4; ++k) { h0[k] = Hd[(size_t)(rw0 + k) * 128 + F.lane]; h1[k] = Hd[(size_t)(rw0 + k) * 128 + 64 + F.lane]; }
#pragma unroll
        for (int k = 0; k < 4; ++k) { const int rw = rw0 + k; const int which = rw >> 12, g = (rw >> 11) & 1, b = (rw >> 7) & 15, n = rw & 127;
            const LAS float* w2 = w2s + which * 8192;
            bf16* outp = (bf16*)(F.ws + (which ? WS_VC : WS_KC)) + ((size_t)(b * 2 + g) * 128 + n) * 64;
            float a = 0.f;
            if (n < NCMP) {
#pragma unroll 16
                for (int j = 0; j < 64; ++j) a += __builtin_bit_cast(float, __builtin_amdgcn_readlane(__builtin_bit_cast(int, h0[k]), j)) * w2[j * 64 + F.lane];
#pragma unroll 16
                for (int j = 0; j < 64; ++j) a += __builtin_bit_cast(float, __builtin_amdgcn_readlane(__builtin_bit_cast(int, h1[k]), j)) * w2[(64 + j) * 64 + F.lane]; }
            outp[F.lane] = (bf16)f2bf(a); }
    }
}

constexpr int NPHASE = 29;
__global__ void __launch_bounds__(NWAVES * 64, 2) skel_fwd(Args args) {
    extern __shared__ __attribute__((aligned(16))) unsigned char lds[];
    Frame F;
    F.lds = (LAS unsigned char*)lds; F.ws = args.ws; F.acc = args.out; F.in = args.in;
    F.tid = threadIdx.x; F.lane = F.tid & 63; F.wave = __builtin_amdgcn_readfirstlane(F.tid >> 6);
    F.G = gridDim.x; F.gw = blockIdx.x * NWAVES + F.wave; F.NGW = F.G * NWAVES;
    volatile LAS unsigned* MISC = (volatile LAS unsigned*)(F.lds + MISC_OFF);
    for (int u = F.tid; u < (LDS_BYTES - LDSCTL_OFF) / 4; u += NWAVES * 64) ((LAS unsigned*)(F.lds + LDSCTL_OFF))[u] = 0u;
    __syncthreads();
    unsigned* ctl = (unsigned*)(args.ws + WS_CTL);
    XcdBarrier bar; bar.bar = ctl + CW_BAR; bar.x = 0; bar.st = nullptr;
    const int lo = args.ph_lo, hi = args.ph_hi;
    if (hi - lo > 1) {
        bar = xcd_barrier_post(ctl + CW_BAR, MISC + 8);
        if (threadIdx.x == 0) { unsigned nloc, nx; xcd_barrier_complete(ctl + CW_BAR, bar.x, nloc, nx); MISC[8] = nloc; MISC[9] = nx; }
        __syncthreads();
    }
#ifndef PH_LO
#define PH_LO 0
#define PH_HI 99
#endif
#define IN(k) ((k) >= PH_LO && (k) < PH_HI && lo <= (k) && (k) < hi && fresh(F, ws, args.ws, args.out) && probe_open(F, (k)))
#define SEAM(k) do { if ((lo <= (k) && (k) < hi) && (lo <= (k) + 1 && (k) + 1 < hi)) xcd_barrier(bar, F.tid); probe_close(F, (k)); } while (0)
    unsigned char* ws = args.ws;
    const int bx = blockIdx.x;

    if (IN(0)) { prologue(F); } SEAM(0);
    if (IN(1)) {
        { pg8::StaticSched<256 * 2048, 256 * 2048> Sd{(const char*)(ws + WS_HB), (const char*)(ws + W_IN0), M / 256, P0_LD / 256, F.G, bx, F.wave};
          pg8::EpiBf16 E{(bf16*)(ws + WS_P0), P0_LD}; pg8::gemm_phase<1024, 2048, 2048>(F.lds, Sd, E); }
        for (int i = 0; i < 2; ++i) {
          pg8::StaticSched<256 * 2048, 256 * 2048> Sd{(const char*)(ws + WS_MEMB), (const char*)(ws + W_XKV + (size_t)i * 1024 * 1024 * 2), MMEM / 256, 4, F.G, (bx + 128 * (i + 1)) % F.G, F.wave};
          pg8::EpiBf16 E{(bf16*)(ws + WS_XKV + (size_t)i * MMEM * 1024 * 2), 1024}; pg8::gemm_phase<1024, 2048, 2048>(F.lds, Sd, E); }
    } SEAM(1);
    if (IN(2)) { PROBE_START(6, F.tid); cn_phase(F); PROBE_STOP(6, F.tid); PROBE_START(7, F.tid); idx_phase_mfma(F); PROBE_STOP(7, F.tid); PROBE_START(8, F.tid); swa_phase_mfma(F); PROBE_STOP(8, F.tid); } SEAM(2);
    if (IN(3)) { dsa_phase_mfma(F); } SEAM(3);
    if (IN(4)) { pg8::StaticSched<256 * P0_LD * 2, 256 * 1536 * 2> Sd{(const char*)(ws + WS_P0), (const char*)(ws + W_OUT0), M / 256, 4, F.G, bx, F.wave};
                 pg8::EpiSumB E{(const bf16*)(ws + WS_HB), (bf16*)F.acc}; pg8::gemm_phase<1536, P0_LD * 2, 1536 * 2>(F.lds, Sd, E); } SEAM(4);
    if (IN(5)) { ln_phase<0>(F, 0, (const bf16*)F.acc); } SEAM(5);
    if (IN(6)) { pg8::StaticSched<256 * 2048, 256 * 2048> Sd{(const char*)(ws + WS_HB), (const char*)(ws + W_XQ), M / 256, 2, F.G, bx, F.wave};
                 pg8::EpiBf16 E{(bf16*)(ws + WS_QX0), 512}; pg8::gemm_phase<1024, 2048, 2048>(F.lds, Sd, E); asm volatile("s_waitcnt vmcnt(0)" ::: "memory"); __syncthreads(); xattn_phase_mfma(F, (const bf16*)(ws + WS_QX0), (const bf16*)(ws + WS_XKV), (bf16*)(ws + WS_OX0)); } SEAM(6);
    if (IN(7)) { pg8::StaticSched<256 * 1024, 256 * 1024> Sd{(const char*)(ws + WS_OX0), (const char*)(ws + W_XO), M / 256, 4, F.G, bx, F.wave};
                 pg8::EpiSumB E{(const bf16*)(ws + WS_HB), (bf16*)F.acc}; pg8::gemm_phase<512, 1024, 1024>(F.lds, Sd, E); } SEAM(7);
    if (IN(8)) { ln_phase<0>(F, 1, (const bf16*)F.acc); } SEAM(8);
    if (IN(9)) { pg8::StaticSched<256 * 2048, 256 * 2048> Sd{(const char*)(ws + WS_HB), (const char*)(ws + W_FGU), M / 256, 2 * DFF / 256, F.G, bx, F.wave};
                  pg8::EpiSwiglu E{(bf16*)(ws + WS_HID), DFF, 0, nullptr}; pg8::gemm_phase<1024, 2048, 2048>(F.lds, Sd, E); } SEAM(9);
    if (IN(10)) { pg8::StaticSched<256 * DFF * 2, 256 * DFF * 2> Sd{(const char*)(ws + WS_HID), (const char*)(ws + W_FD), M / 256, 4, F.G, bx, F.wave};
                  pg8::EpiSumB E{(const bf16*)(ws + WS_HB), (bf16*)F.acc}; pg8::gemm_phase<DFF, DFF * 2, DFF * 2>(F.lds, Sd, E); } SEAM(10);
    if (IN(11)) { ln_phase<0>(F, 2, (const bf16*)F.acc); cmp_prep(F); } SEAM(11);
    if (IN(12)) { pg8::StaticSched<256 * 2048, 256 * 2048> Sd{(const char*)(ws + WS_HB), (const char*)(ws + W_IN1 + (size_t)512 * 2048), M / 256, P1_LD / 256 - 2, F.G, bx, F.wave};
                  pg8::EpiBf16 E{(bf16*)(ws + WS_P1) + 512, P1_LD}; pg8::gemm_phase<1024, 2048, 2048>(F.lds, Sd, E); } SEAM(12);
    if (IN(13)) { { pg8::CmpSched Sd{(const char*)(ws + WS_P1), (const char*)(ws + WS_W1T), F.G, bx, F.wave};
                    pg8::EpiCmpHid E{(float*)(ws + WS_HIDC), (const float*)(ws + WS_PEB)}; pg8::gemm_phase<2048, 16 * P1_LD * 2, 2048 * 2, P1_LD * 2, (long)S * P1_LD * 2>(F.lds, Sd, E); }
                  { const bool split = F.G > 64;
                    pg8::StaticSched<256 * 2048, 256 * 2048> Sd{(const char*)(ws + WS_HB), (const char*)(ws + W_IN1), M / 256, 2, split ? F.G - 32 : F.G, split ? (bx >= 32 ? bx - 32 : (1 << 24)) : bx, F.wave};
                    pg8::EpiBf16 E{(bf16*)(ws + WS_P1), P1_LD}; pg8::gemm_phase<1024, 2048, 2048>(F.lds, Sd, E); } } SEAM(13);
    if (IN(14)) { cmp_w2_phase(F); } SEAM(14);
    if (IN(15)) { cmp_phase_mfma(F); asm volatile("s_waitcnt vmcnt(0)" ::: "memory"); __syncthreads(); slc_phase_mfma(F); asm volatile("s_waitcnt vmcnt(0)" ::: "memory"); __syncthreads(); win_phase_mfma(F); } SEAM(15);
    if (IN(16)) { pg8::StaticSched<256 * P1_LD * 2, 256 * 2048> Sd{(const char*)(ws + WS_P1), (const char*)(ws + W_OUT1), M / 256, 4, F.G, bx, F.wave};
                  pg8::EpiSumB E{(const bf16*)(ws + WS_HB), (bf16*)F.acc}; pg8::gemm_phase<1024, P1_LD * 2, 2048>(F.lds, Sd, E); } SEAM(16);
    if (IN(17)) { ln_phase<0>(F, 3, (const bf16*)F.acc); } SEAM(17);
    if (IN(18)) { pg8::StaticSched<256 * 2048, 256 * 2048> Sd{(const char*)(ws + WS_HB), (const char*)(ws + W_XQ + (size_t)512 * 1024 * 2), M / 256, 2, F.G, bx, F.wave};
                  pg8::EpiBf16 E{(bf16*)(ws + WS_QX1), 512}; pg8::gemm_phase<1024, 2048, 2048>(F.lds, Sd, E); asm volatile("s_waitcnt vmcnt(0)" ::: "memory"); __syncthreads(); xattn_phase_mfma(F, (const bf16*)(ws + WS_QX1), (const bf16*)(ws + WS_XKV + (size_t)MMEM * 1024 * 2), (bf16*)(ws + WS_OX1)); } SEAM(18);
    if (IN(19)) { pg8::StaticSched<256 * 1024, 256 * 1024> Sd{(const char*)(ws + WS_OX1), (const char*)(ws + W_XO + (size_t)1024 * 512 * 2), M / 256, 4, F.G, bx, F.wave};
                  pg8::EpiSumB E{(const bf16*)(ws + WS_HB), (bf16*)(ws + WS_SCR + 64 * MiB)}; pg8::gemm_phase<512, 1024, 1024>(F.lds, Sd, E); } SEAM(19);
    if (IN(20)) { ln_phase<1>(F, 4, (const bf16*)(ws + WS_SCR + 64 * MiB)); } SEAM(20);
    if (IN(21)) { moe_dispatch(F); } SEAM(21);
#pragma unroll 1
    for (int ch = 0; ch < 3; ++ch) {
        const int pa = 22 + 2 * ch, pb = 23 + 2 * ch;
        const int* tile_exp = (const int*)(ws + WS_TILEEXP);
        if (IN(pa) || IN(pb)) {
            const int s1 = tile_exp[514];
            constexpr int CH1 = 128 + pg8::MOE_SPLIT + pg8::MOE_ALT_TILES;
            int t0 = ch == 0 ? 0 : ch == 1 ? 128 : CH1, t1 = ch == 0 ? 128 : ch == 1 ? CH1 : s1;
            if (t1 > s1) t1 = s1; if (t0 > s1) t0 = s1; int nT = t1 - t0; if (nT < 0) nT = 0;
            const int nTd = (ch == 1 && s1 > 256 && s1 <= CH1) ? 128 : nT;
            PROBE_STARTF(11, F.tid);
            if (IN(pa)) { pg8::MoeSched<WS_PERMA, W_MGU, 256 * 2048, 256 * 2048, (size_t)7168 * 2048, 0> Sd{ws, t0, nT, 2 * DFFE / 256, F.G, bx, F.wave, nullptr, 0};
                          pg8::EpiSwiglu E{(bf16*)(ws + WS_HIDM), DFFE, 1, (bf16*)args.out}; pg8::gemm_phase<1024, 2048, 2048>(F.lds, Sd, E); }
            if (IN(pa) && IN(pb) && nT > 0) xcd_barrier(bar, F.tid);
            PROBE_STOPF(11, F.tid); PROBE_STARTF(12, F.tid);
            if (IN(pb)) { pg8::MoeSched<WS_HIDM, W_MD, 256 * DFFE * 2, 256 * DFFE * 2, (size_t)1024 * DFFE * 2, 1> Sd{ws, t0, nTd, 4, F.G, bx, F.wave, (const unsigned char*)args.out, 0};
                          pg8::EpiBf16 E{(bf16*)(ws + WS_PERMA), 1024}; pg8::gemm_phase<DFFE, DFFE * 2, DFFE * 2>(F.lds, Sd, E); }
            if (IN(pb) && IN(pb + 1) && nT > 0) xcd_barrier(bar, F.tid);
            PROBE_STOPF(12, F.tid);
        }
    }
    if (IN(28)) {
        const int s1 = ((const int*)(ws + WS_TILEEXP))[514]; constexpr int CH1 = 128 + pg8::MOE_SPLIT + pg8::MOE_ALT_TILES;
        if (s1 > 256 && s1 <= CH1) {
            const int ntb = 8 * (s1 - 256);
            { pg8::TailSched<WS_HIDM, W_MD, 256 * DFFE * 2, 256 * DFFE * 2, (size_t)1024 * DFFE * 2, (size_t)(DFFE / 2) * 2> Sd{ws, 256, s1 - 256, bx, F.wave, 128};
              pg8::EpiBf16Two E{(bf16*)(ws + WS_PERMA), (bf16*)(ws + WS_YB) - (size_t)65536 * 1024, 1024}; pg8::gemm_phase<DFFE / 2, DFFE * 2, DFFE * 2>(F.lds, Sd, E); }
            if (bx >= ntb) ln_phase<2>(F, 5, nullptr, (bx - ntb) * NWAVES + F.wave, (F.G - ntb) * NWAVES, 65536);
            if (hi - lo > 1) xcd_barrier(bar, F.tid);
            ln_final_rest(F, 65536);
        } else ln_phase<2>(F, 5, nullptr, F.gw, F.NGW);
    }
    PROBE_SPIN(F.tid);
#undef IN
#undef SEAM
}

extern "C" void kernel_launch(void* const* d_in, const int* in_sizes, int n_in, void* d_out, int out_size, void* d_ws, size_t ws_size, hipStream_t stream) {
    static int grid = 0;
    if (grid == 0) {
        if (n_in != 30 || out_size != M * D || ws_size < WS_END) { fprintf(stderr, "kernel_launch: unexpected shapes (n_in %d, out %d, ws %zu < %zu); nothing launched\n", n_in, out_size, ws_size, (size_t)WS_END); grid = -1; return; }
        int dev = 0, cus = 0, per_cu = 0;
        if (hipGetDevice(&dev) != hipSuccess || hipDeviceGetAttribute(&cus, hipDeviceAttributeMultiprocessorCount, dev) != hipSuccess) { grid = -1; return; }
        if (hipFuncSetAttribute((const void*)skel_fwd, hipFuncAttributeMaxDynamicSharedMemorySize, LDS_BYTES) != hipSuccess) { fprintf(stderr, "kernel_launch: hipFuncSetAttribute failed\n"); grid = -1; return; }
        if (hipOccupancyMaxActiveBlocksPerMultiprocessor(&per_cu, (const void*)skel_fwd, NWAVES * 64, LDS_BYTES) != hipSuccess || per_cu < 1)
            fprintf(stderr, "kernel_launch: occupancy query reports %d workgroups per CU\n", per_cu);
        (void)hipGetLastError();
        grid = cus;
    }
    if (grid < 0) return;
    if (hipMemsetAsync((char*)d_ws + WS_CTL, 0, CTL_ZERO_BYTES, stream) != hipSuccess) return;
    Args a{};
    for (int i = 0; i < 30; ++i) a.in[i] = (const float*)d_in[i];
    a.out = (float*)d_out; a.ws = (unsigned char*)d_ws;
#if MK_ONE_LAUNCH
    a.ph_lo = 0; a.ph_hi = NPHASE;
    hipLaunchKernelGGL(skel_fwd, dim3(grid), dim3(NWAVES * 64), LDS_BYTES, stream, a);
#else
    for (int p = 0; p < NPHASE; ++p) { a.ph_lo = p; a.ph_hi = p + 1; hipLaunchKernelGGL(skel_fwd, dim3(grid), dim3(NWAVES * 64), LDS_BYTES, stream, a); }
#endif
}
```
